# Optimizing an MI355X kernel written in HIP

```python
import jax, jax.numpy as jnp
from jax import lax
import numpy as np

D_MODEL = 1024
BATCH = 2
SEQ = 16384
DEPTH = 1
DEC_BATCH = 32
DEC_SEQ = 64
PAST_LEN = 2048

CHUNK = 64
H_A = 4
DK_A = 128
DV_A = 128
K_A = H_A * DK_A
V_A = H_A * DV_A
H_B = 8
DH_B = 64
W_B = H_B * DH_B
N_PAST_CHUNKS = 8
WINDOW = N_PAST_CHUNKS * CHUNK
REL_CLIP = 128
NUM_REL = CHUNK + REL_CLIP
D_FF = -(-8 * D_MODEL // (3 * 256)) * 256
SPLIT_SIZES = [K_A, K_A, V_A, V_A, W_B, W_B, W_B, D_MODEL, D_MODEL]
IN_COLS = int(sum(SPLIT_SIZES))
EPS = 1e-6
NEG = -1e30

kernel_name = 'hgrn2_chunkband_attn_hybrid_step'


def rmsnorm(x, g):
    xf = x.astype(jnp.float32)
    y = xf * lax.rsqrt(jnp.mean(xf * xf, axis=-1, keepdims=True) + EPS) * g.astype(jnp.float32)
    return y.astype(x.dtype)


def hgrn2_recurrence(q, logf, k, v, s0):
    b, l = q.shape[:2]
    c = CHUNK if l % CHUNK == 0 else l
    n = l // c

    def to_chunks(t):
        return t.reshape(b, n, c, *t.shape[2:]).swapaxes(0, 1)

    tri = jnp.tril(jnp.ones((c, c), dtype=bool))

    def step(s, inp):
        qc, lfc, kc, vc = inp
        cum = jnp.cumsum(lfc, axis=1)
        tot = cum[:, -1]
        ref = cum[:, c // 2][:, None]
        a = jnp.einsum('bthk,bshk->bhts', qc * jnp.exp(cum - ref), kc * jnp.exp(ref - cum))
        a = jnp.where(tri, a, 0.0)
        o = (jnp.einsum('bhts,bshv->bthv', a, vc)
             + jnp.einsum('bthk,bhkv->bthv', qc * jnp.exp(cum), s))
        s_new = (jnp.exp(tot)[..., None] * s
                 + jnp.einsum('bshk,bshv->bhkv', kc * jnp.exp(tot[:, None] - cum), vc))
        return s_new, o

    s_fin, o = lax.scan(step, s0, (to_chunks(q), to_chunks(logf), to_chunks(k), to_chunks(v)))
    o = o.swapaxes(0, 1).reshape(b, l, *o.shape[3:])
    return o, s_fin


def band_attention(q, k, v, q_pos, k_pos, rel_bias):
    s = jnp.einsum('bqhd,bkhd->bhqk', q, k).astype(jnp.float32) * (DH_B ** -0.5)
    dist = q_pos[:, None] - k_pos[None, :]
    bias = rel_bias.astype(jnp.float32)[:, jnp.clip(dist, -(CHUNK - 1), REL_CLIP) + (CHUNK - 1)]
    qc = (q_pos // CHUNK)[:, None]
    kc = (k_pos // CHUNK)[None, :]
    mask = (k_pos[None, :] >= 0) & (kc <= qc) & (qc - kc <= N_PAST_CHUNKS)
    s = jnp.where(mask[None, None], s + bias[None], NEG)
    p = jax.nn.softmax(s, axis=-1).astype(v.dtype)
    return jnp.einsum('bhqk,bkhd->bqhd', p, v)


def prompt_band_attention(q, k, v, rel_bias):
    b, l, h, d = q.shape
    n = l // CHUNK
    pad = ((0, 0), (WINDOW, 0), (0, 0), (0, 0))
    kp = jnp.pad(k, pad)
    vp = jnp.pad(v, pad)

    def one_chunk(i):
        start = i * CHUNK
        qc = lax.dynamic_slice_in_dim(q, start, CHUNK, axis=1)
        kc = lax.dynamic_slice_in_dim(kp, start, WINDOW + CHUNK, axis=1)
        vc = lax.dynamic_slice_in_dim(vp, start, WINDOW + CHUNK, axis=1)
        q_pos = start + jnp.arange(CHUNK, dtype=jnp.int32)
        k_pos = start - WINDOW + jnp.arange(WINDOW + CHUNK, dtype=jnp.int32)
        return band_attention(qc, kc, vc, q_pos, k_pos, rel_bias)

    o = lax.map(one_chunk, jnp.arange(n, dtype=jnp.int32))
    return o.swapaxes(0, 1).reshape(b, l, h, d)


def mixer(h, lb, w_in, hgrn_out_norm, w_branch_a, rel_bias, w_branch_b, w_out, s0, kv_cache):
    b, l, _ = h.shape
    p = h @ w_in
    qa, fa, ia, ga, qb, kb, vb, gate_a, gate_b = jnp.split(
        p, list(np.cumsum(SPLIT_SIZES)[:-1]), axis=-1)
    f = lb + (1.0 - lb) * jax.nn.sigmoid(fa.astype(jnp.float32))
    logf = jnp.log(f).reshape(b, l, H_A, DK_A)
    k_a = (1.0 - f).reshape(b, l, H_A, DK_A)
    q_a = jax.nn.silu(qa.astype(jnp.float32)).reshape(b, l, H_A, DK_A)
    v_a = ia.astype(jnp.float32).reshape(b, l, H_A, DV_A)
    o_a, s_fin = hgrn2_recurrence(q_a, logf, k_a, v_a, s0.astype(jnp.float32))
    o_a = o_a * lax.rsqrt(jnp.mean(o_a * o_a, axis=-1, keepdims=True) + EPS)
    o_a = (o_a.reshape(b, l, V_A) * hgrn_out_norm.astype(jnp.float32)).astype(h.dtype)
    y_a = (o_a * jax.nn.silu(ga)) @ w_branch_a
    q_b = qb.reshape(b, l, H_B, DH_B)
    k_b = kb.reshape(b, l, H_B, DH_B)
    v_b = vb.reshape(b, l, H_B, DH_B)
    if kv_cache is None:
        o_b = prompt_band_attention(q_b, k_b, v_b, rel_bias)
        keep = min(WINDOW, l)
        k_rows, v_rows = k_b[:, l - keep:], v_b[:, l - keep:]
    else:
        ck, cv = kv_cache
        w = ck.shape[1]
        q_pos = PAST_LEN + jnp.arange(l, dtype=jnp.int32)
        k_pos = jnp.concatenate([PAST_LEN - w + jnp.arange(w, dtype=jnp.int32), q_pos])
        o_b = band_attention(q_b, jnp.concatenate([ck, k_b], axis=1),
                             jnp.concatenate([cv, v_b], axis=1), q_pos, k_pos, rel_bias)
        k_rows, v_rows = k_b, v_b
    y_b = o_b.reshape(b, l, W_B) @ w_branch_b
    y = (jax.nn.sigmoid(gate_a) * y_a + jax.nn.sigmoid(gate_b) * y_b) @ w_out
    return y, s_fin.astype(h.dtype), k_rows, v_rows


def trunk(x, c, states, caches_k, caches_v, w_ada, b_ada, norm_mix, w_in, hgrn_lb_logits,
          hgrn_out_norm, w_branch_a, rel_bias, w_branch_b, w_out, norm_ffn, w_ffn_in,
          w_ffn_out, norm_final):
    b = x.shape[0]
    lb_all = jnp.cumsum(jax.nn.softmax(hgrn_lb_logits.astype(jnp.float32), axis=0), axis=0)
    new_s, new_k, new_v = [], [], []
    for layer in range(DEPTH):
        mod = jax.nn.silu(c) @ w_ada[layer] + b_ada[layer]
        sh1, sc1, g1, sh2, sc2, g2 = jnp.split(mod[:, None, :], 6, axis=-1)
        h = rmsnorm(x, norm_mix[layer]) * (1.0 + sc1) + sh1
        if states is None:
            s0 = jnp.zeros((b, H_A, DK_A, DV_A), jnp.float32)
            kv = None
        else:
            s0 = states[layer]
            kv = (caches_k[layer], caches_v[layer])
        y, s_fin, k_rows, v_rows = mixer(h, lb_all[layer], w_in[layer], hgrn_out_norm[layer],
                                         w_branch_a[layer], rel_bias[layer], w_branch_b[layer],
                                         w_out[layer], s0, kv)
        x = x + g1 * y
        h = rmsnorm(x, norm_ffn[layer]) * (1.0 + sc2) + sh2
        a, u = jnp.split(h @ w_ffn_in[layer], 2, axis=-1)
        x = x + g2 * ((jax.nn.silu(a) * u) @ w_ffn_out[layer])
        new_s.append(s_fin)
        new_k.append(k_rows)
        new_v.append(v_rows)
    return rmsnorm(x, norm_final), jnp.stack(new_s), jnp.stack(new_k), jnp.stack(new_v)


def setup_inputs(seed: int = 0) -> dict:
    key = jax.random.key(seed)
    ks = jax.random.split(key, 24)
    f32 = jnp.float32

    def nrm(k, shape, scale=1.0):
        return jax.random.normal(k, shape, f32) * scale

    cache_rows = min(WINDOW, PAST_LEN)
    return {
        'x_prompt': nrm(ks[0], (BATCH, SEQ, D_MODEL)),
        'x_sample': nrm(ks[1], (DEC_BATCH, DEC_SEQ, D_MODEL)),
        'c_prompt': nrm(ks[2], (BATCH, D_MODEL)),
        'c_sample': nrm(ks[3], (DEC_BATCH, D_MODEL)),
        'state_hgrn': nrm(ks[4], (DEPTH, DEC_BATCH, H_A, DK_A, DV_A), 0.5),
        'cache_k': nrm(ks[5], (DEPTH, DEC_BATCH, cache_rows, H_B, DH_B)),
        'cache_v': nrm(ks[6], (DEPTH, DEC_BATCH, cache_rows, H_B, DH_B)),
        'w_ada': nrm(ks[7], (DEPTH, D_MODEL, 6 * D_MODEL), 0.5 * D_MODEL ** -0.5),
        'b_ada': nrm(ks[8], (DEPTH, 6 * D_MODEL), 0.02),
        'norm_mix': 1.0 + nrm(ks[9], (DEPTH, D_MODEL), 0.05),
        'w_in': nrm(ks[10], (DEPTH, D_MODEL, IN_COLS), D_MODEL ** -0.5),
        'hgrn_lb_logits': nrm(ks[11], (DEPTH + 1, K_A), 0.1),
        'hgrn_out_norm': 1.0 + nrm(ks[12], (DEPTH, V_A), 0.05),
        'w_branch_a': nrm(ks[13], (DEPTH, V_A, D_MODEL), V_A ** -0.5),
        'rel_bias': nrm(ks[14], (DEPTH, H_B, NUM_REL), 0.5),
        'w_branch_b': nrm(ks[15], (DEPTH, W_B, D_MODEL), W_B ** -0.5),
        'w_out': nrm(ks[16], (DEPTH, D_MODEL, D_MODEL), D_MODEL ** -0.5),
        'norm_ffn': 1.0 + nrm(ks[17], (DEPTH, D_MODEL), 0.05),
        'w_ffn_in': nrm(ks[18], (DEPTH, D_MODEL, 2 * D_FF), D_MODEL ** -0.5),
        'w_ffn_out': nrm(ks[19], (DEPTH, D_FF, D_MODEL), D_FF ** -0.5),
        'norm_final': 1.0 + nrm(ks[20], (D_MODEL,), 0.05),
    }


def reference(x_prompt, x_sample, c_prompt, c_sample, state_hgrn, cache_k, cache_v, w_ada, b_ada,
              norm_mix, w_in, hgrn_lb_logits, hgrn_out_norm, w_branch_a, rel_bias, w_branch_b,
              w_out, norm_ffn, w_ffn_in, w_ffn_out, norm_final):
    y_prompt, s_p, k_p, v_p = trunk(x_prompt, c_prompt, None, None, None, w_ada, b_ada, norm_mix,
                                    w_in, hgrn_lb_logits, hgrn_out_norm, w_branch_a, rel_bias,
                                    w_branch_b, w_out, norm_ffn, w_ffn_in, w_ffn_out, norm_final)
    y_sample, s_s, k_s, v_s = trunk(x_sample, c_sample, state_hgrn, cache_k, cache_v, w_ada, b_ada,
                                    norm_mix, w_in, hgrn_lb_logits, hgrn_out_norm, w_branch_a,
                                    rel_bias, w_branch_b, w_out, norm_ffn, w_ffn_in, w_ffn_out,
                                    norm_final)
    return (y_prompt, y_sample, s_p, k_p, v_p, s_s, k_s, v_s)
```

```cpp
#include <hip/hip_runtime.h>
#include <hip/hip_cooperative_groups.h>
#include <cstdio>
#include <cstdint>
namespace cg = cooperative_groups;
#ifndef PROBE_DUP
#define PROBE_DUP 0
#endif

#define DI __device__ __forceinline__
#define LAS __attribute__((address_space(3)))
typedef unsigned short bf16_t;
typedef short bf16x8 __attribute__((ext_vector_type(8)));
typedef float f32x4 __attribute__((ext_vector_type(4)));
typedef float f32x2 __attribute__((ext_vector_type(2)));
typedef float f32x16 __attribute__((ext_vector_type(16)));
typedef unsigned u32x4 __attribute__((ext_vector_type(4)));
typedef unsigned u32x2 __attribute__((ext_vector_type(2)));
typedef __bf16 bf2_t __attribute__((ext_vector_type(2)));

constexpr int D = 1024, TP = 32768, TS = 2048, T = TP + TS, NCH = T / 64, NBATCH = 34;
constexpr int INC = 5632, FF = 2816;
constexpr float EPS = 1e-6f, LOG2E = 1.4426950408889634f;
constexpr size_t OFF_Y = 0, OFF_SP = (size_t)T * D, OFF_KP = OFF_SP + 131072, OFF_VP = OFF_KP + 524288, OFF_SS = OFF_VP + 524288,
                 OFF_KS = OFF_SS + 2097152, OFF_VS = OFF_KS + 1048576, OUT_TOTAL = OFF_VS + 1048576;
constexpr size_t MiB = 1u << 20;
constexpr size_t WS_MOD = 1 * MiB, WS_DEC = 2 * MiB, WS_SC = 4 * MiB, WS_WADA = 5 * MiB, WS_WIN = 17 * MiB, WS_WAB = 28 * MiB, WS_WO = 30 * MiB,
                 WS_WFI = 32 * MiB, WS_WFO = 43 * MiB, WS_H = 50 * MiB, WS_QOB = 118 * MiB, WS_KA = 186 * MiB, WS_VA = 220 * MiB, WS_GA = 254 * MiB,
                 WS_KB = 288 * MiB, WS_VB = 322 * MiB, WS_CUM = 356 * MiB, WS_SST = 424 * MiB, WS_END = 492 * MiB;
constexpr size_t WS_U = WS_H, WS_M = WS_KA, WS_HID = WS_QOB;
constexpr size_t WS_BAR = 0, BAR_BYTES = 16384;
constexpr int LDS_BYTES = 140 * 1024, LDS_ST_OFF = 136 * 1024;

struct Params {
    const float *x_prompt, *x_sample, *c_prompt, *c_sample, *state, *cache_k, *cache_v, *w_ada, *b_ada, *norm_mix, *w_in, *lb_logits, *out_norm,
                *w_a, *rel_bias, *w_b, *w_out, *norm_ffn, *w_ffn_in, *w_ffn_out, *norm_final;
    float* out; unsigned char* ws;
};

DI int fresh_tid() { int t = threadIdx.x; asm volatile("" : "+v"(t)); return t; }
DI int launder(int v) { asm volatile("" : "+v"(v)); return v; }
DI unsigned pk2(float a, float b) { f32x2 v = {a, b}; bf2_t r = __builtin_convertvector(v, bf2_t); return __builtin_bit_cast(unsigned, r); }
DI float bflo(unsigned u) { return __uint_as_float(u << 16); }
DI float bfhi(unsigned u) { return __uint_as_float(u & 0xffff0000u); }
DI float bf2f(short s) { return __uint_as_float(((unsigned)(unsigned short)s) << 16); }
DI float sigm(float x) { return __builtin_amdgcn_rcpf(1.f + __expf(-x)); }
DI float silu(float x) { return x * sigm(x); }
DI int batch_of(int r) { return r < TP ? (r >> 14) : 2 + ((r - TP) >> 6); }
DI int crow(int reg, int h) { return (reg & 3) + 8 * (reg >> 2) + 4 * h; }
DI bf16x8 pack8(const f32x16& x, int s) {
    u32x4 p; p.x = pk2(x[8 * s], x[8 * s + 1]); p.y = pk2(x[8 * s + 2], x[8 * s + 3]); p.z = pk2(x[8 * s + 4], x[8 * s + 5]); p.w = pk2(x[8 * s + 6], x[8 * s + 7]);
    return __builtin_bit_cast(bf16x8, p);
}
DI bf16x8 pack8f(const float* v) { u32x4 p; p.x = pk2(v[0], v[1]); p.y = pk2(v[2], v[3]); p.z = pk2(v[4], v[5]); p.w = pk2(v[6], v[7]); return __builtin_bit_cast(bf16x8, p); }
DI bf16x8 ident_frag(int ks, int l31, int hf) {
    const int jj = l31 - 16 * ks - 8 * hf; bf16x8 r;
#pragma unroll
    for (int j = 0; j < 8; ++j) r[j] = (j == jj) ? (short)0x3F80 : (short)0;
    return r;
}
#define MFMA32(a, b, c) __builtin_amdgcn_mfma_f32_32x32x16_bf16((a), (b), (c), 0, 0, 0)
DI f32x16 zero16() { f32x16 z;
#pragma unroll
    for (int i = 0; i < 16; ++i) z[i] = 0.f; return z; }

namespace pg8 {
constexpr int BM = 256, BK = 64, HALF = 128, HTB = HALF * BK * 2, STAGE_BYTES = 8 * HTB, NXCD = 8, WGM = 8;
__host__ __device__ __forceinline__ int lds_byte(int r, int c) { const int st = (r >> 4) * 2 + (c >> 5), rr = r & 15, cc = c & 31, ob = rr * 64 + cc * 2; return st * 1024 + (ob ^ (((ob >> 9) & 1) << 5)); }
__host__ __device__ __forceinline__ void stage_rc(int b, int& R, int& C) { const int st = b / 1024, sb = b % 1024, swz = sb ^ (((sb >> 9) & 1) << 5); R = (st >> 1) * 16 + swz / 64; C = (st & 1) * 32 + (swz % 64) / 2; }
__host__ __device__ __forceinline__ int perm32(int rho) { const int n = rho >> 4, i = rho & 15; return 8 * (i >> 2) + 4 * n + (i & 3); }
struct Unit { int pm, pn; };
struct Gemm { const bf16_t* A; const bf16_t* Bt; int M, N, K; };
struct StaticOrder {
    int nM, nN, nwg, G, c;
    __device__ void init(int M, int N, int G_, int c_) { nM = M / BM; nN = N / BM; nwg = nM * nN; G = G_; c = c_; }
    __device__ bool next(int i, Unit& u) const {
        const long L = (long)i * G + c; if (L >= nwg) return false;
        int wgid = (int)L; { const int q = nwg / NXCD, r = nwg % NXCD, xcd = wgid % NXCD, off = wgid / NXCD; wgid = (xcd < r ? xcd * (q + 1) : r * (q + 1) + (xcd - r) * q) + off; }
        const int nig = WGM * nN, gid = wgid / nig, fm = gid * WGM, gsz = (nM - fm) < WGM ? (nM - fm) : WGM;
        u.pm = fm + ((wgid % nig) % gsz); u.pn = (wgid % nig) / gsz; return true;
    }
};
template <class Epi, class Sched, bool ALIGN_EPI = false, bool SP2 = false>
__device__ __forceinline__ void gemm_phase(LAS unsigned char* lds, const Gemm g, const Sched& S, const Epi& E) {
    const int tid = fresh_tid(), wid = __builtin_amdgcn_readfirstlane(tid >> 6), lane = tid & 63, wr = wid >> 2, wc = wid & 3, fr = lane & 15, fq = lane >> 4;
    const int K = g.K, nt = K / BK;
    unsigned voffA[2], voffB[2];
#pragma unroll
    for (int i = 0; i < 2; ++i) { int R, C; stage_rc(tid * 16 + i * 8192, R, C); const int Rb = Epi::PERM ? ((R & ~31) + perm32(R & 31)) : R;
        voffA[i] = (unsigned)(R * K + C) * 2u; voffB[i] = (unsigned)(Rb * K + C) * 2u; }
    const size_t kstep = (size_t)(BK * 2);
    const size_t hstep = (size_t)HALF * K * 2;
    const size_t tstep = 2 * hstep;
    const unsigned ldsw = (unsigned)wid * 1024u;
    const int aoff = lds_byte(wr * 64 + fr, fq * 8), boff = lds_byte(wc * 32 + fr, fq * 8);
#define PG8_SA(b, h) (((b) * 2 + (h)) * HTB)
#define PG8_SB(b, h) ((4 + (b) * 2 + (h)) * HTB)
#define PG8_STAGE(bufoff, gbase, voff) do { _Pragma("unroll") for (int _i = 0; _i < 2; ++_i) \
        __builtin_amdgcn_global_load_lds((const unsigned*)((const char*)(gbase) + (voff)[_i]), (LAS unsigned*)(lds + (bufoff) + ldsw + _i * 8192), 16, 0, 0); } while (0)
#define PG8_LDA(dst, b, h) do { _Pragma("unroll") for (int m = 0; m < 4; ++m) _Pragma("unroll") for (int k = 0; k < 2; ++k) dst[m][k] = *(const LAS bf16x8*)(lds + PG8_SA(b, h) + aoff + m * 2048 + k * 1024); } while (0)
#define PG8_LDB(dst, b, h) do { _Pragma("unroll") for (int n = 0; n < 2; ++n) _Pragma("unroll") for (int k = 0; k < 2; ++k) dst[n][k] = *(const LAS bf16x8*)(lds + PG8_SB(b, h) + boff + n * 2048 + k * 1024); } while (0)
#define PG8_MMA(ai, bj, At, Bt) do { __builtin_amdgcn_s_setprio(1); _Pragma("unroll") for (int m = 0; m < 4; ++m) _Pragma("unroll") for (int n = 0; n < 2; ++n) _Pragma("unroll") for (int k = 0; k < 2; ++k) \
        acc[ai][bj][m][n] = __builtin_amdgcn_mfma_f32_16x16x32_bf16(Bt[n][k], At[m][k], acc[ai][bj][m][n], 0, 0, 0); __builtin_amdgcn_s_setprio(0); } while (0)
#define PG8_WAIT_V(n) asm volatile("s_waitcnt vmcnt(" #n ")" ::: "memory")
#define PG8_WAIT_L(n) asm volatile("s_waitcnt lgkmcnt(" #n ")" ::: "memory")
#define PG8_BAR __builtin_amdgcn_s_barrier()
#define PG8_SCHED __builtin_amdgcn_sched_barrier(0)
    Unit cur, nxt; int ui = 0;
    if (!S.next(0, cur)) return;
    f32x4 acc[2][2][4][2];
#pragma unroll
    for (int a = 0; a < 2; ++a)
#pragma unroll
        for (int b = 0; b < 2; ++b)
#pragma unroll
            for (int m = 0; m < 4; ++m)
#pragma unroll
                for (int n = 0; n < 2; ++n) acc[a][b][m][n] = (f32x4){0.f, 0.f, 0.f, 0.f};
    bf16x8 At[4][2], B0[2][2], B1[2][2];
    const char* cA = (const char*)g.A + (size_t)cur.pm * tstep; const char* cB = (const char*)g.Bt + (size_t)cur.pn * tstep;
    if constexpr (SP2) {
        PG8_STAGE(PG8_SB(0, 0), cB, voffB); PG8_STAGE(PG8_SB(0, 1), cB + hstep, voffB); PG8_STAGE(PG8_SA(0, 0), cA, voffA); PG8_STAGE(PG8_SA(0, 1), cA + hstep, voffA);
        if (wr == 1) PG8_BAR;
        PG8_WAIT_V(2); PG8_BAR;
        PG8_STAGE(PG8_SB(1, 0), cB + kstep, voffB); PG8_STAGE(PG8_SA(1, 0), cA + kstep, voffA); PG8_STAGE(PG8_SB(1, 1), cB + hstep + kstep, voffB);
        PG8_WAIT_V(6); PG8_BAR;
    } else {
        PG8_STAGE(PG8_SB(0, 0), cB, voffB); PG8_STAGE(PG8_SA(0, 0), cA, voffA); PG8_STAGE(PG8_SB(0, 1), cB + hstep, voffB); PG8_STAGE(PG8_SA(0, 1), cA + hstep, voffA);
        if (wr == 1) PG8_BAR;
        PG8_WAIT_V(4); PG8_BAR;
        PG8_STAGE(PG8_SB(1, 0), cB + kstep, voffB); PG8_STAGE(PG8_SA(1, 0), cA + kstep, voffA); PG8_STAGE(PG8_SB(1, 1), cB + hstep + kstep, voffB);
        PG8_WAIT_V(6); PG8_BAR;
    }
    for (;;) {
        const bool has_next = S.next(ui + 1, nxt);
        const char* nA = has_next ? (const char*)g.A + (size_t)nxt.pm * tstep : cA; const char* nB = has_next ? (const char*)g.Bt + (size_t)nxt.pn * tstep : cB;
        for (int t = 0; t < nt; t += 2) {
            if constexpr (Epi::MIDK) { if (t == nt / 2) E.mid(acc, cur, wr, wc, fr, fq); }
            const bool last = (t == nt - 2);
            const char* a1 = cA + (size_t)(t + 1) * kstep;
            const char* a2 = last ? nA : cA + (size_t)(t + 2) * kstep; const char* b2 = last ? nB : cB + (size_t)(t + 2) * kstep;
            const char* a3 = a2 + kstep; const char* b3 = b2 + kstep;
            if constexpr (SP2) {
            PG8_LDB(B0, 0, 0); PG8_LDB(B1, 0, 1); PG8_SCHED; PG8_LDA(At, 0, 0); PG8_STAGE(PG8_SA(1, 1), a1 + hstep, voffA);
            PG8_WAIT_V(8); PG8_WAIT_L(0); PG8_BAR; PG8_MMA(0, 0, At, B0); PG8_MMA(0, 1, At, B1); PG8_BAR; PG8_SCHED;
            PG8_LDA(At, 0, 1); PG8_STAGE(PG8_SB(0, 0), b2, voffB); PG8_STAGE(PG8_SB(0, 1), b2 + hstep, voffB); PG8_STAGE(PG8_SA(0, 0), a2, voffA);
            PG8_WAIT_V(8); PG8_WAIT_L(0); PG8_BAR; PG8_MMA(1, 0, At, B0); PG8_MMA(1, 1, At, B1); PG8_BAR; PG8_SCHED;
            PG8_LDB(B0, 1, 0); PG8_LDB(B1, 1, 1); PG8_SCHED; PG8_LDA(At, 1, 0); PG8_STAGE(PG8_SA(0, 1), a2 + hstep, voffA);
            PG8_WAIT_V(8); PG8_WAIT_L(0); PG8_BAR; PG8_MMA(0, 0, At, B0); PG8_MMA(0, 1, At, B1); PG8_BAR; PG8_SCHED;
            PG8_LDA(At, 1, 1); PG8_STAGE(PG8_SB(1, 0), b3, voffB); PG8_STAGE(PG8_SB(1, 1), b3 + hstep, voffB); PG8_STAGE(PG8_SA(1, 0), a3, voffA);
            PG8_WAIT_V(8); PG8_WAIT_L(0); PG8_BAR; PG8_MMA(1, 0, At, B0); PG8_MMA(1, 1, At, B1); PG8_BAR; PG8_SCHED;
            } else {
            PG8_LDB(B0, 0, 0); PG8_SCHED; PG8_LDA(At, 0, 0); PG8_STAGE(PG8_SA(1, 1), a1 + hstep, voffA);
            PG8_WAIT_L(8); PG8_BAR; PG8_WAIT_L(0); PG8_MMA(0, 0, At, B0); PG8_BAR; PG8_SCHED;
            PG8_LDB(B1, 0, 1); PG8_STAGE(PG8_SB(0, 0), b2, voffB);
            PG8_BAR; PG8_WAIT_L(0); PG8_MMA(0, 1, At, B1); PG8_BAR;
            PG8_LDA(At, 0, 1); PG8_STAGE(PG8_SA(0, 0), a2, voffA);
            PG8_BAR; PG8_WAIT_L(0); PG8_MMA(1, 0, At, B0); PG8_BAR; PG8_SCHED;
            PG8_STAGE(PG8_SB(0, 1), b2 + hstep, voffB);
            PG8_WAIT_V(6); PG8_BAR; PG8_MMA(1, 1, At, B1); PG8_BAR;
            PG8_LDB(B0, 1, 0); PG8_SCHED; PG8_LDA(At, 1, 0); PG8_STAGE(PG8_SA(0, 1), a2 + hstep, voffA);
            PG8_WAIT_L(8); PG8_BAR; PG8_WAIT_L(0); PG8_MMA(0, 0, At, B0); PG8_BAR; PG8_SCHED;
            PG8_LDB(B1, 1, 1); PG8_STAGE(PG8_SB(1, 0), b3, voffB);
            PG8_BAR; PG8_WAIT_L(0); PG8_MMA(0, 1, At, B1); PG8_BAR;
            PG8_LDA(At, 1, 1); PG8_STAGE(PG8_SA(1, 0), a3, voffA);
            PG8_BAR; PG8_WAIT_L(0); PG8_MMA(1, 0, At, B0); PG8_BAR; PG8_SCHED;
            PG8_STAGE(PG8_SB(1, 1), b3 + hstep, voffB);
            PG8_WAIT_V(6); PG8_BAR; PG8_MMA(1, 1, At, B1); PG8_BAR;
            }
        }
        if constexpr (ALIGN_EPI) { if (wr == 0) PG8_BAR; }
        E(acc, cur, wr, wc, fr, fq);
        if (!has_next) break;
#pragma unroll
        for (int a = 0; a < 2; ++a)
#pragma unroll
            for (int b = 0; b < 2; ++b)
#pragma unroll
                for (int m = 0; m < 4; ++m)
#pragma unroll
                    for (int n = 0; n < 2; ++n) acc[a][b][m][n] = (f32x4){0.f, 0.f, 0.f, 0.f};
        cur = nxt; cA = nA; cB = nB; ++ui;
        if constexpr (ALIGN_EPI) { if (wr == 1) PG8_BAR; }
    }
    PG8_WAIT_V(0);
    if constexpr (!ALIGN_EPI) { if (wr == 0) PG8_BAR; }
    PG8_BAR;
#undef PG8_SA
#undef PG8_SB
#undef PG8_STAGE
#undef PG8_LDA
#undef PG8_LDB
#undef PG8_MMA
#undef PG8_WAIT_V
#undef PG8_WAIT_L
#undef PG8_BAR
#undef PG8_SCHED
}
}
using pg8::Unit;
typedef f32x4 Acc[2][2][4][2];

DI u32x4 pack_row8(const f32x4& v0, const f32x4& v1) { u32x4 w; w.x = pk2(v0[0], v0[1]); w.y = pk2(v0[2], v0[3]); w.z = pk2(v1[0], v1[1]); w.w = pk2(v1[2], v1[3]); return w; }

struct EpiMod {
    static constexpr bool PERM = false, MIDK = false;
    float* mod; const float* bias;
    DI void operator()(Acc& acc, const Unit& u, int wr, int wc, int fr, int fq) const {
        { const int t_ = fresh_tid(); fr = t_ & 15; fq = (t_ >> 4) & 3; }
        if (u.pm != 0 || wr != 0) return;
#pragma unroll
        for (int m = 0; m < 3; ++m) { const int r = 16 * m + fr; if (r < NBATCH) {
#pragma unroll
            for (int bj = 0; bj < 2; ++bj)
#pragma unroll
                for (int n = 0; n < 2; ++n) { const int col = u.pn * 256 + bj * 128 + wc * 32 + n * 16 + 4 * fq;
                    *(f32x4*)(mod + (size_t)r * 6144 + col) = acc[0][bj][m][n] + *(const f32x4*)(bias + col); } } }
    }
};

struct EpiIn {
    static constexpr bool PERM = true, MIDK = false;
    bf16_t *QOB, *KA, *VA, *GA, *KB, *VB, *SGA, *SGB; float *CUM, *DEC; const float* lbl; float* out;
    DI void operator()(Acc& acc, const Unit& u, int wr, int wc, int fr, int fq) const {
        { const int t_ = fresh_tid(); fr = t_ & 15; fq = (t_ >> 4) & 3; }
        const int pn = u.pn, rt = wr * 64 + fr, row0 = u.pm * 256 + rt, cw = wc * 32 + 8 * fq, lane = fq * 16 + fr;
        if (pn >= 14) {
            const size_t o0 = (size_t)row0 * 1024 + (pn - 14) * 128 + cw;
#pragma unroll
            for (int ai = 0; ai < 2; ++ai)
#pragma unroll
                for (int m = 0; m < 4; ++m) { f32x4 r0, r1, b0, b1;
#pragma unroll
                    for (int j = 0; j < 4; ++j) { b0[j] = sigm(acc[ai][1][m][0][j]); b1[j] = sigm(acc[ai][1][m][1][j]);
                        r0[j] = sigm(acc[ai][0][m][0][j]) * __builtin_amdgcn_rcpf(b0[j]); r1[j] = sigm(acc[ai][0][m][1][j]) * __builtin_amdgcn_rcpf(b1[j]); }
                    const size_t o = o0 + (size_t)(ai * 128 + m * 16) * 1024;
                    *(u32x4*)(SGA + o) = pack_row8(r0, r1); *(u32x4*)(SGB + o) = pack_row8(b0, b1); __builtin_amdgcn_sched_barrier(0); }
            return;
        }
        const int seg = pn >> 1, col0 = (pn & 1) * 256 + cw;
        if (seg == 1) {
#pragma unroll
            for (int bj = 0; bj < 2; ++bj) {
                float lb[2][4];
#pragma unroll
                for (int n = 0; n < 2; ++n)
#pragma unroll
                    for (int j = 0; j < 4; ++j) { const int c = col0 + bj * 128 + 4 * n + j; lb[n][j] = __builtin_amdgcn_rcpf(1.f + __expf(lbl[512 + c] - lbl[c])); }
#pragma unroll
                for (int ai = 0; ai < 2; ++ai) {
                    const size_t rbase = (size_t)(u.pm * 256 + ai * 128 + wr * 64 + launder(fr)) * 512 + col0 + bj * 128;
#pragma unroll
                    for (int m = 0; m < 4; ++m) { f32x4 k0, k1;
#pragma unroll
                        for (int j = 0; j < 4; ++j) {
                            float f = lb[0][j] + (1.f - lb[0][j]) * sigm(acc[ai][bj][m][0][j]); k0[j] = 1.f - f; acc[ai][bj][m][0][j] = __logf(f);
                            f = lb[1][j] + (1.f - lb[1][j]) * sigm(acc[ai][bj][m][1][j]); k1[j] = 1.f - f; acc[ai][bj][m][1][j] = __logf(f); }
                        *(u32x4*)(KA + rbase + (size_t)m * 16 * 512) = pack_row8(k0, k1); }
                    __builtin_amdgcn_sched_barrier(0);
#pragma unroll
                    for (int n = 0; n < 2; ++n)
#pragma unroll
                        for (int j = 0; j < 4; ++j) { float carry = 0.f;
#pragma unroll
                            for (int m = 0; m < 4; ++m) { float v = acc[ai][bj][m][n][j];
                                v += __int_as_float(__builtin_amdgcn_update_dpp(0, __float_as_int(v), 0x111, 0xf, 0xf, false));
                                v += __int_as_float(__builtin_amdgcn_update_dpp(0, __float_as_int(v), 0x112, 0xf, 0xf, false));
                                v += __int_as_float(__builtin_amdgcn_update_dpp(0, __float_as_int(v), 0x114, 0xf, 0xf, false));
                                v += __int_as_float(__builtin_amdgcn_update_dpp(0, __float_as_int(v), 0x118, 0xf, 0xf, false));
                                v += carry; carry = __shfl(v, lane | 15); acc[ai][bj][m][n][j] = v; } }
                    __builtin_amdgcn_sched_barrier(0);
#pragma unroll
                    for (int m = 0; m < 4; ++m) { float* cp = CUM + rbase + (size_t)m * 16 * 512; *(f32x4*)cp = acc[ai][bj][m][0]; *(f32x4*)(cp + 4) = acc[ai][bj][m][1]; }
                    if (fr == 15) {
#pragma unroll
                        for (int n = 0; n < 2; ++n) { f32x4 e;
#pragma unroll
                            for (int j = 0; j < 4; ++j) e[j] = __expf(acc[ai][bj][3][n][j]);
                            *(f32x4*)(DEC + (size_t)(u.pm * 4 + ai * 2 + wr) * 512 + col0 + bj * 128 + 4 * n) = e; } }
                    __builtin_amdgcn_sched_barrier(0);
                }
            }
            return;
        }
        bf16_t* dst; int pitch = 512; float* o32 = nullptr;
        switch (seg) {
            case 0: dst = QOB + col0; pitch = 1024; break;
            case 2: dst = VA + col0; break;
            case 3: dst = GA + col0; break;
            case 4: dst = QOB + 512 + col0; pitch = 1024; break;
            case 5: dst = KB + col0; break;
            default: dst = VB + col0; break;
        }
        if (seg >= 5) {
            if (u.pm >= 128) o32 = out + (seg == 5 ? OFF_KS : OFF_VS) + (size_t)((u.pm - 128) * 256 + rt) * 512 + col0;
            else if ((u.pm & 63) >= 62) o32 = out + (seg == 5 ? OFF_KP : OFF_VP) + (size_t)((u.pm >> 6) * 512 + ((u.pm & 63) - 62) * 256 + rt) * 512 + col0;
        }
        const bool act = (seg == 0 || seg == 3);
#pragma unroll
        for (int ai = 0; ai < 2; ++ai)
#pragma unroll
            for (int m = 0; m < 4; ++m)
#pragma unroll
                for (int bj = 0; bj < 2; ++bj) { f32x4 v0 = acc[ai][bj][m][0], v1 = acc[ai][bj][m][1];
                    if (act) {
#pragma unroll
                        for (int j = 0; j < 4; ++j) { v0[j] = silu(v0[j]); v1[j] = silu(v1[j]); } }
                    *(u32x4*)(dst + (size_t)(row0 + ai * 128 + m * 16) * pitch + bj * 128) = pack_row8(v0, v1);
                    if (o32) { float* op = o32 + (size_t)(ai * 128 + m * 16) * 512 + bj * 128; *(f32x4*)op = v0; *(f32x4*)(op + 4) = v1; } __builtin_amdgcn_sched_barrier(0); }
    }
};

struct EpiMerge {
    static constexpr bool PERM = true, MIDK = true;
    const bf16_t *SGR, *SGB; bf16_t* Mo;
    DI void mid(Acc& acc, const Unit& u, int wr, int wc, int fr, int fq) const {
        { const int t_ = fresh_tid(); fr = t_ & 15; fq = (t_ >> 4) & 3; }
        const size_t base = (size_t)(u.pm * 256 + wr * 64 + fr) * 1024 + u.pn * 256 + wc * 32 + 8 * fq;
#pragma unroll
        for (int ai = 0; ai < 2; ++ai) { u32x4 a[4][2];
#pragma unroll
            for (int m = 0; m < 4; ++m)
#pragma unroll
                for (int bj = 0; bj < 2; ++bj) a[m][bj] = *(const u32x4*)(SGR + base + (size_t)(ai * 128 + m * 16) * 1024 + bj * 128);
#pragma unroll
            for (int m = 0; m < 4; ++m)
#pragma unroll
                for (int bj = 0; bj < 2; ++bj)
#pragma unroll
                    for (int j = 0; j < 4; ++j) { acc[ai][bj][m][j >> 1][(j & 1) * 2] *= bflo(a[m][bj][j]); acc[ai][bj][m][j >> 1][(j & 1) * 2 + 1] *= bfhi(a[m][bj][j]); }
            __builtin_amdgcn_sched_barrier(0); }
    }
    DI void operator()(Acc& acc, const Unit& u, int wr, int wc, int fr, int fq) const {
        { const int t_ = fresh_tid(); fr = t_ & 15; fq = (t_ >> 4) & 3; }
        const size_t base = (size_t)(u.pm * 256 + wr * 64 + fr) * 1024 + u.pn * 256 + wc * 32 + 8 * fq;
#pragma unroll
        for (int ai = 0; ai < 2; ++ai) { u32x4 b[4][2];
#pragma unroll
            for (int m = 0; m < 4; ++m)
#pragma unroll
                for (int bj = 0; bj < 2; ++bj) b[m][bj] = *(const u32x4*)(SGB + base + (size_t)(ai * 128 + m * 16) * 1024 + bj * 128);
#pragma unroll
            for (int m = 0; m < 4; ++m)
#pragma unroll
                for (int bj = 0; bj < 2; ++bj) { f32x4 v0 = acc[ai][bj][m][0], v1 = acc[ai][bj][m][1]; const u32x4 g = b[m][bj];
                    v0[0] *= bflo(g[0]); v0[1] *= bfhi(g[0]); v0[2] *= bflo(g[1]); v0[3] *= bfhi(g[1]);
                    v1[0] *= bflo(g[2]); v1[1] *= bfhi(g[2]); v1[2] *= bflo(g[3]); v1[3] *= bfhi(g[3]);
                    *(u32x4*)(Mo + base + (size_t)(ai * 128 + m * 16) * 1024 + bj * 128) = pack_row8(v0, v1); }
            __builtin_amdgcn_sched_barrier(0); }
    }
};

struct EpiRes {
    static constexpr bool PERM = false, MIDK = false;
    const float *xp, *xs; float* out; const float* gmod;
    DI void operator()(Acc& acc, const Unit& u, int wr, int wc, int fr, int fq) const {
        { const int t_ = fresh_tid(); fr = t_ & 15; fq = (t_ >> 4) & 3; }
        const int colb = u.pn * 256 + wc * 32 + 4 * fq;
#pragma unroll
        for (int ai = 0; ai < 2; ++ai) { const int r0 = u.pm * 256 + ai * 128 + wr * 64 + fr;
            const float* g = gmod + (size_t)batch_of(r0) * 6144 + colb; const float* xr = (r0 < TP ? xp + (size_t)r0 * D : xs + (size_t)(r0 - TP) * D) + colb; float* orow = out + (size_t)r0 * D + colb;
            f32x4 gv[2][2], xv[4][2][2];
#pragma unroll
            for (int bj = 0; bj < 2; ++bj)
#pragma unroll
                for (int n = 0; n < 2; ++n) gv[bj][n] = *(const f32x4*)(g + bj * 128 + n * 16);
#pragma unroll
            for (int m = 0; m < 4; ++m)
#pragma unroll
                for (int bj = 0; bj < 2; ++bj)
#pragma unroll
                    for (int n = 0; n < 2; ++n) xv[m][bj][n] = *(const f32x4*)(xr + (size_t)m * 16 * D + bj * 128 + n * 16);
#pragma unroll
            for (int m = 0; m < 4; ++m)
#pragma unroll
                for (int bj = 0; bj < 2; ++bj)
#pragma unroll
                    for (int n = 0; n < 2; ++n) *(f32x4*)(orow + (size_t)m * 16 * D + bj * 128 + n * 16) = xv[m][bj][n] + gv[bj][n] * acc[ai][bj][m][n];
            __builtin_amdgcn_sched_barrier(0); }
    }
};

struct EpiFfnIn {
    static constexpr bool PERM = true, MIDK = false;
    bf16_t* HID;
    DI void operator()(Acc& acc, const Unit& u, int wr, int wc, int fr, int fq) const {
        { const int t_ = fresh_tid(); fr = t_ & 15; fq = (t_ >> 4) & 3; }
        bf16_t* base = HID + (size_t)(u.pm * 256 + wr * 64 + fr) * FF + u.pn * 128 + wc * 32 + 8 * fq;
#pragma unroll
        for (int ai = 0; ai < 2; ++ai)
#pragma unroll
            for (int m = 0; m < 4; ++m) { f32x4 v0, v1;
#pragma unroll
                for (int j = 0; j < 4; ++j) { v0[j] = silu(acc[ai][0][m][0][j]) * acc[ai][1][m][0][j]; v1[j] = silu(acc[ai][0][m][1][j]) * acc[ai][1][m][1][j]; }
                *(u32x4*)(base + (size_t)(ai * 128 + m * 16) * FF) = pack_row8(v0, v1); __builtin_amdgcn_sched_barrier(0); }
    }
};

DI void transpose_item(const float* W, int N, bf16_t* WT, int pitch, int koff, int k0, int n0, int drow0, LAS float* scr, int lane) {
#pragma unroll 8
    for (int i = 0; i < 32; ++i) { const int kk = 2 * i + (lane >> 5); scr[kk * 33 + (lane & 31)] = W[(size_t)(k0 + kk) * N + n0 + (lane & 31)]; }
    asm volatile("s_waitcnt lgkmcnt(0)" ::: "memory");
    const int c = lane & 7;
#pragma unroll
    for (int j = 0; j < 4; ++j) { const int n = (lane >> 3) + 8 * j; const LAS float* s = scr + (8 * c) * 33 + n;
        u32x4 o; o.x = pk2(s[0 * 33], s[1 * 33]); o.y = pk2(s[2 * 33], s[3 * 33]); o.z = pk2(s[4 * 33], s[5 * 33]); o.w = pk2(s[6 * 33], s[7 * 33]);
        *(u32x4*)(WT + (size_t)(drow0 + n) * pitch + koff + k0 + 8 * c) = o; }
    asm volatile("s_waitcnt lgkmcnt(0)" ::: "memory");
}
DI void phase_prep(const Params& p, LAS unsigned char* lds) {
    const int tid = fresh_tid(), lane = tid & 63, wave = __builtin_amdgcn_readfirstlane(tid >> 6);
    LAS float* scr = (LAS float*)(lds + wave * 16384);
    const int gw = blockIdx.x * 8 + wave, NGW = gridDim.x * 8;
    unsigned char* ws = p.ws;
    constexpr int I_ADA = 16 * 192, I_IN = 16 * 176, I_A = 8 * 32, I_O = 16 * 32, I_FI = 16 * 176, I_FO = 44 * 32;
    constexpr int NIT = I_ADA + I_IN + 2 * I_A + I_O + I_FI + I_FO;
    for (int it = gw; it < NIT; it += NGW) {
        int r = it;
        if (r < I_ADA) { const int kb = r / 192, nb = r % 192; transpose_item(p.w_ada, 6144, (bf16_t*)(ws + WS_WADA), 1024, 0, 64 * kb, 32 * nb, 32 * nb, scr, lane); continue; } r -= I_ADA;
        if (r < I_IN) { const int kb = r / 176, nb = r % 176, n0 = 32 * nb; int dr = n0;
            if (n0 >= 3584) { const int j = n0 < 4608 ? n0 - 3584 : n0 - 4608; dr = 3584 + 256 * (j >> 7) + (j & 127) + (n0 < 4608 ? 0 : 128); }
            transpose_item(p.w_in, INC, (bf16_t*)(ws + WS_WIN), 1024, 0, 64 * kb, n0, dr, scr, lane); continue; } r -= I_IN;
        if (r < I_A) { const int kb = r / 32, nb = r % 32; transpose_item(p.w_a, 1024, (bf16_t*)(ws + WS_WAB), 1024, 0, 64 * kb, 32 * nb, 32 * nb, scr, lane); continue; } r -= I_A;
        if (r < I_A) { const int kb = r / 32, nb = r % 32; transpose_item(p.w_b, 1024, (bf16_t*)(ws + WS_WAB), 1024, 512, 64 * kb, 32 * nb, 32 * nb, scr, lane); continue; } r -= I_A;
        if (r < I_O) { const int kb = r / 32, nb = r % 32; transpose_item(p.w_out, 1024, (bf16_t*)(ws + WS_WO), 1024, 0, 64 * kb, 32 * nb, 32 * nb, scr, lane); continue; } r -= I_O;
        if (r < I_FI) { const int kb = r / 176, nb = r % 176; const int n0 = 32 * nb; const int j0 = n0 < FF ? n0 : n0 - FF;
            transpose_item(p.w_ffn_in, INC, (bf16_t*)(ws + WS_WFI), 1024, 0, 64 * kb, n0, 256 * (j0 >> 7) + (j0 & 127) + (n0 < FF ? 0 : 128), scr, lane); continue; } r -= I_FI;
        { const int kb = r / 32, nb = r % 32; transpose_item(p.w_ffn_out, 1024, (bf16_t*)(ws + WS_WFO), FF, 0, 64 * kb, 32 * nb, 32 * nb, scr, lane); }
    }
    bf16_t* SC = (bf16_t*)(ws + WS_SC);
    for (int i = blockIdx.x * 512 + tid; i < 256 * 1024 / 2; i += gridDim.x * 512) { const int row = (2 * i) >> 10, col = (2 * i) & 1023; float a = 0.f, b = 0.f;
        if (row < NBATCH) { const float* c = row < 2 ? p.c_prompt + row * D : p.c_sample + (row - 2) * D; a = silu(c[col]); b = silu(c[col + 1]); }
        ((unsigned*)SC)[i] = pk2(a, b); }
}

DI float wave_sum(float v) {
#pragma unroll
    for (int o = 1; o < 64; o <<= 1) v += __shfl_xor(v, o);
    return v;
}
DI void phase_norm_mod(const float* xp, const float* xs, const float* nw, const float* mod, int sh_off, int sc_off, bf16_t* H) {
    const int tid = fresh_tid(), lane = tid & 63, wave = __builtin_amdgcn_readfirstlane(tid >> 6);
    const int gw = blockIdx.x * 8 + wave, NGW = gridDim.x * 8;
    for (int r = gw; r < T; r += NGW) {
        const float* xr = r < TP ? xp + (size_t)r * D : xs + (size_t)(r - TP) * D; const float* mb = mod + (size_t)batch_of(r) * 6144;
        f32x4 v[4]; float s = 0.f;
#pragma unroll
        for (int j = 0; j < 4; ++j) { v[j] = *(const f32x4*)(xr + 4 * lane + 256 * j); s += (v[j][0] * v[j][0] + v[j][1] * v[j][1]) + (v[j][2] * v[j][2] + v[j][3] * v[j][3]); }
        const float rstd = __builtin_amdgcn_rsqf(wave_sum(s) * (1.f / D) + EPS);
#pragma unroll
        for (int j = 0; j < 4; ++j) { const int col = 4 * lane + 256 * j; const f32x4 w = *(const f32x4*)(nw + col), sc = *(const f32x4*)(mb + sc_off + col), sh = *(const f32x4*)(mb + sh_off + col);
            const f32x4 h = v[j] * rstd * w * (sc + 1.f) + sh; u32x2 o; o.x = pk2(h[0], h[1]); o.y = pk2(h[2], h[3]);
            *(u32x2*)(H + (size_t)r * D + col) = o; }
    }
}
DI void phase_final_norm(float* y, const float* nw) {
    const int tid = fresh_tid(), lane = tid & 63, wave = __builtin_amdgcn_readfirstlane(tid >> 6);
    const int gw = blockIdx.x * 8 + wave, NGW = gridDim.x * 8;
    for (int r = gw; r < T; r += NGW) { float* yr = y + (size_t)r * D;
        f32x4 v[4]; float s = 0.f;
#pragma unroll
        for (int j = 0; j < 4; ++j) { v[j] = *(const f32x4*)(yr + 4 * lane + 256 * j); s += (v[j][0] * v[j][0] + v[j][1] * v[j][1]) + (v[j][2] * v[j][2] + v[j][3] * v[j][3]); }
        const float rstd = __builtin_amdgcn_rsqf(wave_sum(s) * (1.f / D) + EPS);
#pragma unroll
        for (int j = 0; j < 4; ++j) { const int col = 4 * lane + 256 * j; *(f32x4*)(yr + col) = v[j] * rstd * *(const f32x4*)(nw + col); }
    }
}

DI void hgrn_u_item(const Params& p, int item, int lane) {
    const int c = item >> 5, rem = item & 31, h = rem >> 3, kt = (rem >> 1) & 3, vh = rem & 1, l31 = lane & 31, hf = lane >> 5;
    const float* CUM = (const float*)(p.ws + WS_CUM); const bf16_t* KA = (const bf16_t*)(p.ws + WS_KA); const bf16_t* VA = (const bf16_t*)(p.ws + WS_VA); bf16_t* U = (bf16_t*)(p.ws + WS_U);
    const int kcol = h * 128 + 32 * kt + l31;
    const float tot = CUM[(size_t)(c * 64 + 63) * 512 + kcol];
    bf16x8 kdf[2][2];
#pragma unroll
    for (int st = 0; st < 2; ++st) { f32x16 kd;
#pragma unroll
        for (int r = 0; r < 16; ++r) { const size_t idx = (size_t)(c * 64 + 32 * st + crow(r, hf)) * 512 + kcol; kd[r] = bf2f((short)KA[idx]) * __expf(tot - CUM[idx]); }
        kdf[st][0] = pack8(kd, 0); kdf[st][1] = pack8(kd, 1); }
    const bf16x8 id0 = ident_frag(0, l31, hf), id1 = ident_frag(1, l31, hf);
#pragma unroll
    for (int vtl = 0; vtl < 2; ++vtl) { const int vt = 2 * vh + vtl; f32x16 dacc = zero16();
#pragma unroll
        for (int st = 0; st < 2; ++st) { const bf16_t* vp = VA + (size_t)(c * 64 + 32 * st + l31) * 512 + h * 128 + 32 * vt + 8 * hf;
            f32x16 vx = zero16(); vx = MFMA32(*(const bf16x8*)vp, id0, vx); vx = MFMA32(*(const bf16x8*)(vp + 16), id1, vx);
            dacc = MFMA32(kdf[st][0], pack8(vx, 0), dacc); dacc = MFMA32(kdf[st][1], pack8(vx, 1), dacc); }
        bf16_t* up = U + ((size_t)(c * 4 + h) * 128 + 32 * vt + l31) * 128 + 32 * kt + 4 * hf;
#pragma unroll
        for (int g = 0; g < 4; ++g) { u32x2 o; o.x = pk2(dacc[4 * g], dacc[4 * g + 1]); o.y = pk2(dacc[4 * g + 2], dacc[4 * g + 3]); *(u32x2*)(up + 8 * g) = o; }
    }
}

DI void scan_prompt_item(const Params& p, int item, int lane) {
    const int bh = item >> 6, vp = item & 63, b = bh >> 2, h = bh & 3, kg = lane & 31, v0 = 2 * vp + (lane >> 5);
    const float* __restrict__ DEC = (const float*)(p.ws + WS_DEC) + (size_t)b * 256 * 512 + h * 128 + 4 * kg;
    const bf16_t* __restrict__ U = (const bf16_t*)(p.ws + WS_U) + ((size_t)(b * 256 * 4 + h) * 128 + v0) * 128 + 4 * kg;
    bf16_t* __restrict__ SST = (bf16_t*)(p.ws + WS_SST) + ((size_t)(b * 256 * 4 + h) * 128 + v0) * 128 + 4 * kg;
    f32x4 S0 = {0.f, 0.f, 0.f, 0.f};
    for (int n0 = 0; n0 < 256; n0 += 32) {
        f32x4 d[32]; u32x2 u[32];
#pragma unroll
        for (int i = 0; i < 32; ++i) { d[i] = *(const f32x4*)(DEC + (size_t)(n0 + i) * 512); u[i] = *(const u32x2*)(U + (size_t)(n0 + i) * 4 * 128 * 128); }
#pragma unroll
        for (int i = 0; i < 32; ++i) { u32x2 s; s.x = pk2(S0[0], S0[1]); s.y = pk2(S0[2], S0[3]); *(u32x2*)(SST + (size_t)(n0 + i) * 4 * 128 * 128) = s;
            S0[0] = d[i][0] * S0[0] + bflo(u[i].x); S0[1] = d[i][1] * S0[1] + bfhi(u[i].x); S0[2] = d[i][2] * S0[2] + bflo(u[i].y); S0[3] = d[i][3] * S0[3] + bfhi(u[i].y); }
    }
    float* sp = p.out + OFF_SP + ((size_t)bh * 128 + 4 * kg) * 128;
#pragma unroll
    for (int i = 0; i < 4; ++i) sp[(size_t)i * 128 + v0] = S0[i];
}
DI void scan_sample_item(const Params& p, int item, int lane) {
    const int bh = item >> 5, vq = item & 31, bs = bh >> 2, h = bh & 3, kg = lane & 31, vv = lane >> 5, c = 512 + bs;
    const float* DEC = (const float*)(p.ws + WS_DEC); const bf16_t* U = (const bf16_t*)(p.ws + WS_U); bf16_t* SST = (bf16_t*)(p.ws + WS_SST);
    const f32x4 d = *(const f32x4*)(DEC + (size_t)c * 512 + h * 128 + 4 * kg);
    const float* s0 = p.state + ((size_t)bh * 128 + 4 * kg) * 128; float* so = p.out + OFF_SS + ((size_t)bh * 128 + 4 * kg) * 128;
#pragma unroll
    for (int e = 0; e < 2; ++e) { const int v = 4 * vq + 2 * e + vv; const size_t o = ((size_t)(c * 4 + h) * 128 + v) * 128 + 4 * kg;
        const u32x2 u = *(const u32x2*)(U + o); f32x4 S;
#pragma unroll
        for (int i = 0; i < 4; ++i) S[i] = s0[(size_t)i * 128 + v];
        u32x2 s; s.x = pk2(S[0], S[1]); s.y = pk2(S[2], S[3]); *(u32x2*)(SST + o) = s;
        so[v] = d[0] * S[0] + bflo(u.x); so[128 + v] = d[1] * S[1] + bfhi(u.x); so[256 + v] = d[2] * S[2] + bflo(u.y); so[384 + v] = d[3] * S[3] + bfhi(u.y); }
}

constexpr size_t WS_CKB = 492 * MiB, WS_CVB = 5 * MiB;
DI void attn_item(const Params& p, int item, int lane, const LAS float* biasl, bf16_t* obase = nullptr, int opitch = 1024) {
    const int c = item >> 4, h = (item >> 1) & 7, qh = item & 1, l31 = lane & 31, hf = lane >> 5;
    bf16_t* qptr = (bf16_t*)(p.ws + WS_QOB) + (size_t)(c * 64 + qh * 32 + l31) * 1024 + 512 + h * 64;
    const bf16_t* KB = (const bf16_t*)(p.ws + WS_KB); const bf16_t* VB = (const bf16_t*)(p.ws + WS_VB);
    bf16x8 qf[4];
#pragma unroll
    for (int ks = 0; ks < 4; ++ks) qf[ks] = *(const bf16x8*)(qptr + 16 * ks + 8 * hf);
    const bf16x8 id0 = ident_frag(0, l31, hf), id1 = ident_frag(1, l31, hf);
    const LAS float* bl = biasl + h * 192;
    f32x16 OT0 = zero16(), OT1 = zero16(); float mrun = -1e30f, lsum = 0.f;
    int nchunk, db0; size_t own_first; const bf16_t *ck = KB, *cv = VB; int ncache = 0;
    if (c < 512) { const int n = c & 255, j0 = n < 8 ? n : 8; nchunk = j0 + 1; db0 = 64 * j0 + 32 * qh; own_first = (size_t)(c - j0) * 64; }
    else { nchunk = 9; ncache = 8; db0 = 512 + 32 * qh; own_first = (size_t)c * 64 - 512; ck = (const bf16_t*)(p.ws + WS_CKB) + (size_t)(c - 512) * 512 * 512 - own_first * 512; cv = (const bf16_t*)(p.ws + WS_CVB) + (size_t)(c - 512) * 512 * 512 - own_first * 512; }
    const size_t lo = (size_t)l31 * 512 + h * 64 + 8 * hf;
    u32x4 nk[2][4], nv[2][4];
#define ATT_LOAD(jj_) do { const size_t ro_ = (own_first + 64 * (jj_)) * 512 + lo; const bf16_t* kb_ = ((jj_) < ncache ? ck : KB) + ro_; const bf16_t* vb_ = ((jj_) < ncache ? cv : VB) + ro_; \
        _Pragma("unroll") for (int t = 0; t < 2; ++t) _Pragma("unroll") for (int ks = 0; ks < 4; ++ks) { nk[t][ks] = *(const u32x4*)(kb_ + t * 32 * 512 + 16 * ks); nv[t][ks] = *(const u32x4*)(vb_ + t * 32 * 512 + 16 * ks); } } while (0)
    ATT_LOAD(0);
    for (int jj = 0; jj < nchunk; ++jj) {
        bf16x8 kf[2][4], vf[2][4];
#pragma unroll
        for (int t = 0; t < 2; ++t)
#pragma unroll
            for (int ks = 0; ks < 4; ++ks) { kf[t][ks] = __builtin_bit_cast(bf16x8, nk[t][ks]); vf[t][ks] = __builtin_bit_cast(bf16x8, nv[t][ks]); }
        if (jj + 1 < nchunk) ATT_LOAD(jj + 1);
        f32x16 sa = zero16(), sb = zero16();
#pragma unroll
        for (int ks = 0; ks < 4; ++ks) { sa = MFMA32(kf[0][ks], qf[ks], sa); sb = MFMA32(kf[1][ks], qf[ks], sb); }
        const int dmin = db0 - 64 * jj - 63; float mt = -1e30f;
        if (dmin >= 128) { const float bc = bl[191];
#pragma unroll
            for (int r = 0; r < 16; ++r) { sa[r] = sa[r] * (0.125f * LOG2E) + bc; sb[r] = sb[r] * (0.125f * LOG2E) + bc; mt = fmaxf(mt, fmaxf(sa[r], sb[r])); }
        } else { const int dbase = db0 - 64 * jj + l31;
#pragma unroll
            for (int r = 0; r < 16; ++r) { int d0 = dbase - crow(r, hf), d1 = d0 - 32; d0 = d0 > 128 ? 128 : d0; d1 = d1 > 128 ? 128 : d1;
                sa[r] = sa[r] * (0.125f * LOG2E) + bl[d0 + 63]; sb[r] = sb[r] * (0.125f * LOG2E) + bl[d1 + 63]; mt = fmaxf(mt, fmaxf(sa[r], sb[r])); }
        }
        mt = fmaxf(mt, __shfl_xor(mt, 32));
        const float mnew = fmaxf(mrun, mt), alpha = __builtin_amdgcn_exp2f(mrun - mnew); mrun = mnew;
        float ps = 0.f;
#pragma unroll
        for (int r = 0; r < 16; ++r) { sa[r] = __builtin_amdgcn_exp2f(sa[r] - mnew); sb[r] = __builtin_amdgcn_exp2f(sb[r] - mnew); ps += sa[r] + sb[r]; }
        lsum = lsum * alpha + ps;
#pragma unroll
        for (int r = 0; r < 16; ++r) { OT0[r] *= alpha; OT1[r] *= alpha; }
        const bf16x8 pa0 = pack8(sa, 0), pa1 = pack8(sa, 1), pb0 = pack8(sb, 0), pb1 = pack8(sb, 1);
        f32x16 va0 = zero16(), va1 = zero16(), vb0 = zero16(), vb1 = zero16();
        va0 = MFMA32(vf[0][0], id0, va0); vb0 = MFMA32(vf[1][0], id0, vb0); va1 = MFMA32(vf[0][2], id0, va1); vb1 = MFMA32(vf[1][2], id0, vb1);
        va0 = MFMA32(vf[0][1], id1, va0); vb0 = MFMA32(vf[1][1], id1, vb0); va1 = MFMA32(vf[0][3], id1, va1); vb1 = MFMA32(vf[1][3], id1, vb1);
        OT0 = MFMA32(pack8(va0, 0), pa0, OT0); OT1 = MFMA32(pack8(va1, 0), pa0, OT1);
        OT0 = MFMA32(pack8(va0, 1), pa1, OT0); OT1 = MFMA32(pack8(va1, 1), pa1, OT1);
        OT0 = MFMA32(pack8(vb0, 0), pb0, OT0); OT1 = MFMA32(pack8(vb1, 0), pb0, OT1);
        OT0 = MFMA32(pack8(vb0, 1), pb1, OT0); OT1 = MFMA32(pack8(vb1, 1), pb1, OT1);
    }
#undef ATT_LOAD
    lsum += __shfl_xor(lsum, 32); const float inv = 1.f / lsum;
    if (obase) qptr = obase + (size_t)(c * 64 + qh * 32 + l31) * opitch + h * 64;
#pragma unroll
    for (int g = 0; g < 4; ++g) { u32x2 o; o.x = pk2(OT0[4 * g] * inv, OT0[4 * g + 1] * inv); o.y = pk2(OT0[4 * g + 2] * inv, OT0[4 * g + 3] * inv); *(u32x2*)(qptr + 8 * g + 4 * hf) = o;
        o.x = pk2(OT1[4 * g] * inv, OT1[4 * g + 1] * inv); o.y = pk2(OT1[4 * g + 2] * inv, OT1[4 * g + 3] * inv); *(u32x2*)(qptr + 32 + 8 * g + 4 * hf) = o; }
}

DI void hgrn_out_item(const Params& p, int item, int lane, bf16_t* obase = nullptr) {
    const int c = item >> 3, h = (item >> 1) & 3, tt = item & 1, l31 = lane & 31, hf = lane >> 5;
    const float* CUM = (const float*)(p.ws + WS_CUM); const bf16_t* KA = (const bf16_t*)(p.ws + WS_KA); const bf16_t* VA = (const bf16_t*)(p.ws + WS_VA);
    const bf16_t* GA = (const bf16_t*)(p.ws + WS_GA); const bf16_t* SST = (const bf16_t*)(p.ws + WS_SST);
    const int trow = c * 64 + 32 * tt + l31;
    bf16_t* qap = (bf16_t*)(p.ws + WS_QOB) + (size_t)trow * 1024 + h * 128;
    const float* cumt = CUM + (size_t)trow * 512 + h * 128; const float* refp = CUM + (size_t)(c * 64 + 32) * 512 + h * 128;
    bf16x8 qd1[8], qd2[8];
#pragma unroll
    for (int ks = 0; ks < 8; ++ks) { const int k0 = 16 * ks + 8 * hf; const bf16x8 q8 = *(const bf16x8*)(qap + k0);
        const f32x4 c0 = *(const f32x4*)(cumt + k0), c1 = *(const f32x4*)(cumt + k0 + 4), r0 = *(const f32x4*)(refp + k0), r1 = *(const f32x4*)(refp + k0 + 4);
        float a[8], b[8];
#pragma unroll
        for (int j = 0; j < 8; ++j) { const float q = bf2f(q8[j]), cu = j < 4 ? c0[j & 3] : c1[j & 3], rf = j < 4 ? r0[j & 3] : r1[j & 3]; a[j] = q * __expf(cu - rf); b[j] = q * __expf(cu); }
        qd1[ks] = pack8f(a); qd2[ks] = pack8f(b); }
    f32x16 OT[4];
#pragma unroll
    for (int vt = 0; vt < 4; ++vt) OT[vt] = zero16();
    const bf16_t* sp = SST + ((size_t)(c * 4 + h) * 128 + l31) * 128 + 8 * hf;
#pragma unroll
    for (int vt = 0; vt < 4; ++vt)
#pragma unroll
        for (int ks = 0; ks < 8; ++ks) OT[vt] = MFMA32(*(const bf16x8*)(sp + (size_t)vt * 32 * 128 + 16 * ks), qd2[ks], OT[vt]);
    const bf16x8 id0 = ident_frag(0, l31, hf), id1 = ident_frag(1, l31, hf);
    for (int st = 0; st <= tt; ++st) {
        const int srow = c * 64 + 32 * st + l31; const bf16_t* kap = KA + (size_t)srow * 512 + h * 128; const float* cums = CUM + (size_t)srow * 512 + h * 128;
        f32x16 X = zero16();
#pragma unroll
        for (int ks = 0; ks < 8; ++ks) { const int k0 = 16 * ks + 8 * hf; const bf16x8 k8 = *(const bf16x8*)(kap + k0);
            const f32x4 c0 = *(const f32x4*)(cums + k0), c1 = *(const f32x4*)(cums + k0 + 4), r0 = *(const f32x4*)(refp + k0), r1 = *(const f32x4*)(refp + k0 + 4);
            float a[8];
#pragma unroll
            for (int j = 0; j < 8; ++j) { const float cu = j < 4 ? c0[j & 3] : c1[j & 3], rf = j < 4 ? r0[j & 3] : r1[j & 3]; a[j] = bf2f(k8[j]) * __expf(rf - cu); }
            X = MFMA32(pack8f(a), qd1[ks], X); }
        if (st == tt) {
#pragma unroll
            for (int r = 0; r < 16; ++r) if (crow(r, hf) > l31) X[r] = 0.f; }
        const bf16x8 xf0 = pack8(X, 0), xf1 = pack8(X, 1);
        const bf16_t* vp = VA + (size_t)srow * 512 + h * 128 + 8 * hf;
#pragma unroll
        for (int vt = 0; vt < 4; ++vt) { f32x16 vx = zero16(); vx = MFMA32(*(const bf16x8*)(vp + 32 * vt), id0, vx); vx = MFMA32(*(const bf16x8*)(vp + 32 * vt + 16), id1, vx);
            OT[vt] = MFMA32(pack8(vx, 0), xf0, OT[vt]); OT[vt] = MFMA32(pack8(vx, 1), xf1, OT[vt]); }
    }
    float ss = 0.f;
#pragma unroll
    for (int vt = 0; vt < 4; ++vt)
#pragma unroll
        for (int r = 0; r < 16; ++r) ss += OT[vt][r] * OT[vt][r];
    ss += __shfl_xor(ss, 32);
    const float rstd = __builtin_amdgcn_rsqf(ss * (1.f / 128.f) + EPS);
    const bf16_t* gap = GA + (size_t)trow * 512 + h * 128; const float* onp = p.out_norm + h * 128;
    if (obase) qap = obase + (size_t)trow * 512 + h * 128;
#pragma unroll
    for (int vt = 0; vt < 4; ++vt)
#pragma unroll
        for (int g = 0; g < 4; ++g) { const int v0 = 32 * vt + 8 * g + 4 * hf; const f32x4 on = *(const f32x4*)(onp + v0); const u32x2 ga = *(const u32x2*)(gap + v0);
            u32x2 o; o.x = pk2(OT[vt][4 * g] * rstd * on[0] * bflo(ga.x), OT[vt][4 * g + 1] * rstd * on[1] * bfhi(ga.x));
            o.y = pk2(OT[vt][4 * g + 2] * rstd * on[2] * bflo(ga.y), OT[vt][4 * g + 3] * rstd * on[3] * bfhi(ga.y)); *(u32x2*)(qap + v0) = o; }
}


#define XB_TMO      128
#define XB_XCNT(j)  (256  + 64 * (j))
#define XB_XSUB(j)  (1280 + 64 * (j))
#define XB_XGEN(j)  (2304 + 64 * (j))
#define XB_TOP      3328
#define XB_TOPGEN   3392
#define XCD_BAR_WORDS 3456
#define XB_SPIN_CAP (1u << 18)
DI unsigned xb_ld(unsigned* p)              { return __hip_atomic_load(p, __ATOMIC_RELAXED, __HIP_MEMORY_SCOPE_AGENT); }
DI unsigned xb_add(unsigned* p, unsigned v) { return __hip_atomic_fetch_add(p, v, __ATOMIC_RELAXED, __HIP_MEMORY_SCOPE_AGENT); }
DI unsigned xb_xcc_id() { return (unsigned)__builtin_amdgcn_s_getreg((3 << 11) | 20) & 0xFu; }
#define XB_SPIN(cond, bar) do { unsigned _sp = 0; while (cond) { __builtin_amdgcn_s_sleep(1); \
    if ((++_sp & 255u) == 0u) { if (xb_ld(&(bar)[XB_TMO])) break; if (_sp > XB_SPIN_CAP) { atomicAdd(&(bar)[XB_TMO], 1u); break; } } } } while (0)
struct XcdBarrier { unsigned* bar; unsigned x; volatile LAS unsigned* st; };
DI XcdBarrier xcd_barrier_post(unsigned* bar, volatile LAS unsigned* st) {
    XcdBarrier b; b.bar = bar; b.x = xb_xcc_id(); b.st = st;
    if (threadIdx.x == 0) (void)xb_add(&bar[XB_XCNT(b.x)], 1u);
    return b;
}
DI void xcd_barrier_complete(unsigned* bar, unsigned x, unsigned& nloc, unsigned& nx) {
    const unsigned G = gridDim.x * gridDim.y * gridDim.z;
    unsigned sum, cnt, mine, sp = 0u;
    for (;;) {
        sum = 0u; cnt = 0u; mine = 0u;
#pragma unroll
        for (unsigned j = 0; j < 16; ++j) { const unsigned c = xb_ld(&bar[XB_XCNT(j)]); sum += c; cnt += (c > 0u) ? 1u : 0u; mine = (j == x) ? c : mine; }
        if (sum == G) break;
        __builtin_amdgcn_s_sleep(1);
        if ((++sp & 255u) == 0u) { if (xb_ld(&bar[XB_TMO])) break; if (sp > XB_SPIN_CAP) { atomicAdd(&bar[XB_TMO], 1u); break; } }
    }
    nloc = mine > 0u ? mine : 1u; nx = cnt > 0u ? cnt : 1u;
}
DI void xcd_barrier(const XcdBarrier& b) {
    asm volatile("s_waitcnt vmcnt(0)" ::: "memory");
    __syncthreads();
    if (threadIdx.x == 0) {
        unsigned* bar = b.bar;
        __builtin_amdgcn_s_waitcnt(0);
        unsigned nloc = b.st[0], nx = b.st[1];
        if (nloc == 0u) { xcd_barrier_complete(bar, b.x, nloc, nx); b.st[0] = nloc; b.st[1] = nx; }
        const unsigned old = xb_add(&bar[XB_XSUB(b.x)], 1u);
        const unsigned gen = old / nloc;
        if (old + 1u == (gen + 1u) * nloc) {
            __builtin_amdgcn_fence(__ATOMIC_RELEASE, "agent");
            asm volatile("s_waitcnt vmcnt(0)" ::: "memory");
            const unsigned og = xb_add(&bar[XB_TOP], 1u);
            const unsigned tg = og / nx;
            if (og + 1u == (tg + 1u) * nx) xb_add(&bar[XB_TOPGEN], 1u);
            else XB_SPIN(xb_ld(&bar[XB_TOPGEN]) == tg, bar);
            __builtin_amdgcn_fence(__ATOMIC_ACQUIRE, "agent");
            xb_add(&bar[XB_XGEN(b.x)], 1u);
            asm volatile("s_waitcnt vmcnt(0)" ::: "memory");
        } else {
            XB_SPIN(xb_ld(&bar[XB_XGEN(b.x)]) == gen, bar);
            __builtin_amdgcn_fence(__ATOMIC_ACQUIRE, "agent");
            asm volatile("s_waitcnt vmcnt(0)" ::: "memory");
        }
    }
    __syncthreads();
}

__global__ void __launch_bounds__(512, 2) fwd_megakernel(Params p) {
    extern __shared__ __attribute__((aligned(16))) unsigned char lds_raw[];
    LAS unsigned char* lds = (LAS unsigned char*)lds_raw;
    cg::grid_group grid = cg::this_grid();
    const int G = gridDim.x, bx = blockIdx.x;
    volatile LAS unsigned* bst = (volatile LAS unsigned*)(lds + LDS_ST_OFF);
    if (threadIdx.x < 2) bst[threadIdx.x] = 0u;
    __syncthreads();
    const XcdBarrier xbar = xcd_barrier_post((unsigned*)(p.ws + WS_BAR), bst);
#define GRID_BAR() xcd_barrier(xbar)
    unsigned char* ws = p.ws;
    float* MOD = (float*)(ws + WS_MOD); bf16_t* H = (bf16_t*)(ws + WS_H);

    phase_prep(p, lds);
    grid.sync();
    { pg8::Gemm g{(const bf16_t*)(ws + WS_SC), (const bf16_t*)(ws + WS_WADA), 256, 6144, 1024}; pg8::StaticOrder S; S.init(256, 6144, G, bx);
      EpiMod E{MOD, p.b_ada}; pg8::gemm_phase<EpiMod, pg8::StaticOrder, true, true>(lds, g, S, E); }
    GRID_BAR();
    phase_norm_mod(p.x_prompt, p.x_sample, p.norm_mix, MOD, 0, 1024, H);
#if PROBE_DUP == 1
    GRID_BAR(); phase_norm_mod(p.x_prompt, p.x_sample, p.norm_mix, MOD, 0, 1024, H);
#endif
#if PROBE_DUP == 10
    GRID_BAR(); GRID_BAR(); GRID_BAR(); GRID_BAR(); GRID_BAR(); GRID_BAR(); GRID_BAR(); GRID_BAR(); GRID_BAR(); GRID_BAR();
#endif
    GRID_BAR();
    { pg8::Gemm g{H, (const bf16_t*)(ws + WS_WIN), T, INC, 1024}; pg8::StaticOrder S; S.init(T, INC, G, bx);
      EpiIn E{(bf16_t*)(ws + WS_QOB), (bf16_t*)(ws + WS_KA), (bf16_t*)(ws + WS_VA), (bf16_t*)(ws + WS_GA), (bf16_t*)(ws + WS_KB), (bf16_t*)(ws + WS_VB),
              (bf16_t*)(p.out), (bf16_t*)(p.out) + (size_t)T * 1024, (float*)(ws + WS_CUM), (float*)(ws + WS_DEC), p.lb_logits, p.out};
      pg8::gemm_phase<EpiIn, pg8::StaticOrder, true, true>(lds, g, S, E);
#if PROBE_DUP == 2
      GRID_BAR(); pg8::gemm_phase<EpiIn, pg8::StaticOrder, true, true>(lds, g, S, E);
#endif
    }
    GRID_BAR();
    {
        const int tid = fresh_tid(), lane = tid & 63, wave = __builtin_amdgcn_readfirstlane(tid >> 6);
        LAS float* biasl = (LAS float*)lds;
        LAS unsigned* pullw = (LAS unsigned*)(lds + LDS_ST_OFF + 16);
        const bool xaw = (G & 7) == 0;
        const int att_x = bx & 7, att_ncu = xaw ? (G >> 3) : G, att_j = xaw ? (bx >> 3) : bx, att_n = xaw ? 68 * 16 : NCH * 16;
        const int A_tot = (att_n - att_j + att_ncu - 1) / att_ncu, A3 = (A_tot * 12) / 34, A4 = (A_tot * 6) / 34, A5 = A_tot - A3 - A4;
#define PULL(k_) do { int k__ = 0; if (lane == 0) k__ = (int)__hip_atomic_fetch_add(pullw, 1u, __ATOMIC_RELAXED, __HIP_MEMORY_SCOPE_WORKGROUP); k_ = __builtin_amdgcn_readfirstlane(k__); } while (0)
#define ATT_RUN(a_) do { const int idx_ = att_j + att_ncu * (a_); if (idx_ < att_n) { int it_ = idx_; if (xaw) { const int cc_ = idx_ >> 4; it_ = (cc_ < 64 ? 64 * att_x + cc_ : 512 + 4 * att_x + (cc_ - 64)) * 16 + (idx_ & 15); } \
            attn_item(p, it_, lane, biasl); } } while (0)
        for (int i = tid; i < 8 * 192; i += 512) biasl[i] = p.rel_bias[i] * LOG2E;
        if (tid == 0) *pullw = 0u;
        __syncthreads();
        { const int nU = (NCH * 32 - bx + G - 1) / G;
          for (;;) { int k; PULL(k); const int kk = k / 6;
              if (k % 6 == 5 && kk < A3) { ATT_RUN(kk); continue; }
              const int u = k - (kk < A3 ? kk : A3);
              if (u >= nU) { if (kk >= A3) break; continue; }
              hgrn_u_item(p, bx + G * u, lane); } }
        { bf16_t* CKB = (bf16_t*)(ws + WS_CKB); bf16_t* CVB = (bf16_t*)(ws + WS_CVB); constexpr int NV8 = 32 * 512 * 512 / 8;
          for (int i = bx * 512 + tid; i < 2 * NV8; i += G * 512) { const bool isv = i >= NV8; const int e = (isv ? i - NV8 : i) * 8; const float* src = (isv ? p.cache_v : p.cache_k) + e;
              const f32x4 a = *(const f32x4*)src, b = *(const f32x4*)(src + 4); *(u32x4*)((isv ? CVB : CKB) + e) = pack_row8(a, b); } }
        GRID_BAR();
        if (tid == 0) *pullw = 0u;
        __syncthreads();
        if (wave < 2) { for (int it = wave * G + bx; it < 512; it += 2 * G) scan_prompt_item(p, it, lane); }
        else { for (int it = (wave - 2) * G + bx; it < 4096; it += 6 * G) scan_sample_item(p, it, lane); }
        for (;;) { int k; PULL(k); if (k >= A4) break; ATT_RUN(A3 + k); }
        GRID_BAR();
        if (tid == 0) *pullw = 0u;
        __syncthreads();
        { const int nO = (NCH * 8 - bx + G - 1) / G;
          for (;;) { int k; PULL(k); const int kk = k / 2;
              if ((k & 1) && kk < A5) { ATT_RUN(A3 + A4 + kk); continue; }
              const int u = k - (kk < A5 ? kk : A5);
              if (u >= nO) { if (kk >= A5) break; continue; }
              hgrn_out_item(p, bx + G * u, lane); } }
#undef PULL
#undef ATT_RUN
    }
    GRID_BAR();
    { pg8::Gemm g{(const bf16_t*)(ws + WS_QOB), (const bf16_t*)(ws + WS_WAB), T, 1024, 1024}; pg8::StaticOrder S; S.init(T, 1024, G, bx);
      EpiMerge E{(const bf16_t*)(p.out), (const bf16_t*)(p.out) + (size_t)T * 1024, (bf16_t*)(ws + WS_M)};
      pg8::gemm_phase<EpiMerge, pg8::StaticOrder, true, true>(lds, g, S, E); }
    GRID_BAR();
    { pg8::Gemm g{(const bf16_t*)(ws + WS_M), (const bf16_t*)(ws + WS_WO), T, 1024, 1024}; pg8::StaticOrder S; S.init(T, 1024, G, bx);
      EpiRes E{p.x_prompt, p.x_sample, p.out, MOD + 2048}; pg8::gemm_phase<EpiRes, pg8::StaticOrder, true, true>(lds, g, S, E);
#if PROBE_DUP == 7
      GRID_BAR(); pg8::gemm_phase<EpiRes, pg8::StaticOrder, true, true>(lds, g, S, E);
#endif
    }
    GRID_BAR();
    phase_norm_mod(p.out, p.out + (size_t)TP * D, p.norm_ffn, MOD, 3072, 4096, H);
    GRID_BAR();
    { pg8::Gemm g{H, (const bf16_t*)(ws + WS_WFI), T, INC, 1024}; pg8::StaticOrder S; S.init(T, INC, G, bx);
      EpiFfnIn E{(bf16_t*)(ws + WS_HID)}; pg8::gemm_phase<EpiFfnIn, pg8::StaticOrder, true, true>(lds, g, S, E);
#if PROBE_DUP == 9
      GRID_BAR(); pg8::gemm_phase<EpiFfnIn, pg8::StaticOrder, true, true>(lds, g, S, E);
#endif
    }
    GRID_BAR();
    { pg8::Gemm g{(const bf16_t*)(ws + WS_HID), (const bf16_t*)(ws + WS_WFO), T, 1024, FF}; pg8::StaticOrder S; S.init(T, 1024, G, bx);
      EpiRes E{p.out, p.out + (size_t)TP * D, p.out, MOD + 5120}; pg8::gemm_phase<EpiRes, pg8::StaticOrder, true, true>(lds, g, S, E); }
    GRID_BAR();
    phase_final_norm(p.out, p.norm_final);
}

extern "C" void kernel_launch(void* const* d_in, const int* in_sizes, int n_in, void* d_out, int out_size, void* d_ws, size_t ws_size, hipStream_t stream) {
    static int grid = 0;
    if (grid == 0) {
        if (n_in != 21 || (size_t)out_size != OUT_TOTAL || ws_size < WS_END + 16 * MiB) { fprintf(stderr, "kernel_launch: unexpected sizes n_in %d out %d ws %zu\n", n_in, out_size, ws_size); grid = -1; return; }
        int dev = 0, cus = 0, per = 0;
        (void)hipGetDevice(&dev); (void)hipDeviceGetAttribute(&cus, hipDeviceAttributeMultiprocessorCount, dev);
        (void)hipFuncSetAttribute((const void*)fwd_megakernel, hipFuncAttributeMaxDynamicSharedMemorySize, LDS_BYTES);
        (void)hipOccupancyMaxActiveBlocksPerMultiprocessor(&per, (const void*)fwd_megakernel, 512, LDS_BYTES);
        if (per < 1) per = 1;
        grid = cus * per; fprintf(stderr, "kernel_launch: grid %d (cus %d x %d)\n", grid, cus, per);
    }
    if (grid < 0) return;
    if (hipMemsetAsync((char*)d_ws + WS_BAR, 0, BAR_BYTES, stream) != hipSuccess) { fprintf(stderr, "kernel_launch: memset failed\n"); return; }
    Params p{};
    const float** f = (const float**)&p;
    for (int i = 0; i < 21; ++i) f[i] = (const float*)d_in[i];
    p.out = (float*)d_out; p.ws = (unsigned char*)d_ws;
    void* args[] = {&p};
    hipError_t e = hipLaunchCooperativeKernel((const void*)fwd_megakernel, dim3(grid), dim3(512), args, LDS_BYTES, stream);
    if (e != hipSuccess) fprintf(stderr, "cooperative launch failed: %s (grid %d)\n", hipGetErrorString(e), grid);
}
```

```cpp
#include <hip/hip_runtime.h>
#include <hip/hip_cooperative_groups.h>
#include <cstdio>
#include <cstdint>
namespace cg = cooperative_groups;
#ifndef PROBE_DUP
#define PROBE_DUP 0
#endif

#define DI __device__ __forceinline__
#define LAS __attribute__((address_space(3)))
typedef unsigned short bf16_t;
typedef short bf16x8 __attribute__((ext_vector_type(8)));
typedef float f32x4 __attribute__((ext_vector_type(4)));
typedef float f32x2 __attribute__((ext_vector_type(2)));
typedef float f32x16 __attribute__((ext_vector_type(16)));
typedef unsigned u32x4 __attribute__((ext_vector_type(4)));
typedef unsigned u32x2 __attribute__((ext_vector_type(2)));
typedef __bf16 bf2_t __attribute__((ext_vector_type(2)));

constexpr int D = 1024, TP = 32768, TS = 2048, T = TP + TS, NCH = T / 64, NBATCH = 34;
constexpr int INC = 5632, FF = 2816;
constexpr float EPS = 1e-6f, LOG2E = 1.4426950408889634f;
constexpr size_t OFF_Y = 0, OFF_SP = (size_t)T * D, OFF_KP = OFF_SP + 131072, OFF_VP = OFF_KP + 524288, OFF_SS = OFF_VP + 524288,
                 OFF_KS = OFF_SS + 2097152, OFF_VS = OFF_KS + 1048576, OUT_TOTAL = OFF_VS + 1048576;
constexpr size_t MiB = 1u << 20;
constexpr size_t WS_MOD = 1 * MiB, WS_DEC = 2 * MiB, WS_SC = 4 * MiB, WS_WADA = 5 * MiB, WS_WIN = 17 * MiB, WS_WAB = 28 * MiB, WS_WO = 30 * MiB,
                 WS_WFI = 32 * MiB, WS_WFO = 43 * MiB, WS_H = 50 * MiB, WS_QOB = 118 * MiB, WS_KA = 186 * MiB, WS_VA = 220 * MiB, WS_GA = 254 * MiB,
                 WS_KB = 288 * MiB, WS_VB = 322 * MiB, WS_CUM = 356 * MiB, WS_SST = 424 * MiB, WS_END = 492 * MiB;
constexpr size_t WS_U = WS_H, WS_M = WS_KA, WS_HID = WS_KA, WS_X1B = WS_QOB, WS_X2B = WS_H;
constexpr size_t WS_BAR = 0, BAR_BYTES = 16384;
constexpr int LDS_BYTES = 140 * 1024, LDS_ST_OFF = 136 * 1024;

struct Params {
    const float *x_prompt, *x_sample, *c_prompt, *c_sample, *state, *cache_k, *cache_v, *w_ada, *b_ada, *norm_mix, *w_in, *lb_logits, *out_norm,
                *w_a, *rel_bias, *w_b, *w_out, *norm_ffn, *w_ffn_in, *w_ffn_out, *norm_final;
    float* out; unsigned char* ws;
};

DI int fresh_tid() { int t = threadIdx.x; asm volatile("" : "+v"(t)); return t; }
DI int launder(int v) { asm volatile("" : "+v"(v)); return v; }
DI unsigned pk2(float a, float b) { f32x2 v = {a, b}; bf2_t r = __builtin_convertvector(v, bf2_t); return __builtin_bit_cast(unsigned, r); }
DI float bflo(unsigned u) { return __uint_as_float(u << 16); }
DI float bfhi(unsigned u) { return __uint_as_float(u & 0xffff0000u); }
DI float bf2f(short s) { return __uint_as_float(((unsigned)(unsigned short)s) << 16); }
DI float sigm(float x) { return __builtin_amdgcn_rcpf(1.f + __expf(-x)); }
DI float silu(float x) { return x * sigm(x); }
DI int batch_of(int r) { return r < TP ? (r >> 14) : 2 + ((r - TP) >> 6); }
DI int crow(int reg, int h) { return (reg & 3) + 8 * (reg >> 2) + 4 * h; }
DI bf16x8 pack8(const f32x16& x, int s) {
    u32x4 p; p.x = pk2(x[8 * s], x[8 * s + 1]); p.y = pk2(x[8 * s + 2], x[8 * s + 3]); p.z = pk2(x[8 * s + 4], x[8 * s + 5]); p.w = pk2(x[8 * s + 6], x[8 * s + 7]);
    return __builtin_bit_cast(bf16x8, p);
}
DI bf16x8 pack8f(const float* v) { u32x4 p; p.x = pk2(v[0], v[1]); p.y = pk2(v[2], v[3]); p.z = pk2(v[4], v[5]); p.w = pk2(v[6], v[7]); return __builtin_bit_cast(bf16x8, p); }
DI bf16x8 ident_frag(int ks, int l31, int hf) {
    const int jj = l31 - 16 * ks - 8 * hf; bf16x8 r;
#pragma unroll
    for (int j = 0; j < 8; ++j) r[j] = (j == jj) ? (short)0x3F80 : (short)0;
    return r;
}
#define MFMA32(a, b, c) __builtin_amdgcn_mfma_f32_32x32x16_bf16((a), (b), (c), 0, 0, 0)
DI f32x16 zero16() { f32x16 z;
#pragma unroll
    for (int i = 0; i < 16; ++i) z[i] = 0.f; return z; }

namespace pg8 {
constexpr int BM = 256, BK = 64, HALF = 128, HTB = HALF * BK * 2, STAGE_BYTES = 8 * HTB, NXCD = 8, WGM = 8;
__host__ __device__ __forceinline__ int lds_byte(int r, int c) { const int st = (r >> 4) * 2 + (c >> 5), rr = r & 15, cc = c & 31, ob = rr * 64 + cc * 2; return st * 1024 + (ob ^ (((ob >> 9) & 1) << 5)); }
__host__ __device__ __forceinline__ void stage_rc(int b, int& R, int& C) { const int st = b / 1024, sb = b % 1024, swz = sb ^ (((sb >> 9) & 1) << 5); R = (st >> 1) * 16 + swz / 64; C = (st & 1) * 32 + (swz % 64) / 2; }
__host__ __device__ __forceinline__ int perm32(int rho) { const int n = rho >> 4, i = rho & 15; return 8 * (i >> 2) + 4 * n + (i & 3); }
struct Unit { int pm, pn; };
struct Gemm { const bf16_t* A; const bf16_t* Bt; int M, N, K; };
struct StaticOrder {
    int nM, nN, nwg, G, c;
    __device__ void init(int M, int N, int G_, int c_) { nM = M / BM; nN = N / BM; nwg = nM * nN; G = G_; c = c_; }
    __device__ bool next(int i, Unit& u) const {
        const long L = (long)i * G + c; if (L >= nwg) return false;
        int wgid = (int)L; { const int q = nwg / NXCD, r = nwg % NXCD, xcd = wgid % NXCD, off = wgid / NXCD; wgid = (xcd < r ? xcd * (q + 1) : r * (q + 1) + (xcd - r) * q) + off; }
        const int nig = WGM * nN, gid = wgid / nig, fm = gid * WGM, gsz = (nM - fm) < WGM ? (nM - fm) : WGM;
        u.pm = fm + ((wgid % nig) % gsz); u.pn = (wgid % nig) / gsz; return true;
    }
};
template <class Epi, class Sched, bool ALIGN_EPI = false, bool SP2 = false>
__device__ __forceinline__ void gemm_phase(LAS unsigned char* lds, const Gemm g, const Sched& S, const Epi& E) {
    const int tid = fresh_tid(), wid = __builtin_amdgcn_readfirstlane(tid >> 6), lane = tid & 63, wr = wid >> 2, wc = wid & 3, fr = lane & 15, fq = lane >> 4;
    const int K = g.K, nt = K / BK;
    unsigned voffA[2], voffB[2];
#pragma unroll
    for (int i = 0; i < 2; ++i) { int R, C; stage_rc(tid * 16 + i * 8192, R, C); const int Rb = Epi::PERM ? ((R & ~31) + perm32(R & 31)) : R;
        voffA[i] = (unsigned)(R * K + C) * 2u; voffB[i] = (unsigned)(Rb * K + C) * 2u; }
    const size_t kstep = (size_t)(BK * 2);
    const size_t hstep = (size_t)HALF * K * 2;
    const size_t tstep = 2 * hstep;
    const unsigned ldsw = (unsigned)wid * 1024u;
    const int aoff = lds_byte(wr * 64 + fr, fq * 8), boff = lds_byte(wc * 32 + fr, fq * 8);
#define PG8_SA(b, h) (((b) * 2 + (h)) * HTB)
#define PG8_SB(b, h) ((4 + (b) * 2 + (h)) * HTB)
#define PG8_STAGE(bufoff, gbase, voff) do { _Pragma("unroll") for (int _i = 0; _i < 2; ++_i) \
        __builtin_amdgcn_global_load_lds((const unsigned*)((const char*)(gbase) + (voff)[_i]), (LAS unsigned*)(lds + (bufoff) + ldsw + _i * 8192), 16, 0, 0); } while (0)
#define PG8_LDA(dst, b, h) do { _Pragma("unroll") for (int m = 0; m < 4; ++m) _Pragma("unroll") for (int k = 0; k < 2; ++k) dst[m][k] = *(const LAS bf16x8*)(lds + PG8_SA(b, h) + aoff + m * 2048 + k * 1024); } while (0)
#define PG8_LDB(dst, b, h) do { _Pragma("unroll") for (int n = 0; n < 2; ++n) _Pragma("unroll") for (int k = 0; k < 2; ++k) dst[n][k] = *(const LAS bf16x8*)(lds + PG8_SB(b, h) + boff + n * 2048 + k * 1024); } while (0)
#define PG8_MMA(ai, bj, At, Bt) do { __builtin_amdgcn_s_setprio(1); _Pragma("unroll") for (int m = 0; m < 4; ++m) _Pragma("unroll") for (int n = 0; n < 2; ++n) _Pragma("unroll") for (int k = 0; k < 2; ++k) \
        acc[ai][bj][m][n] = __builtin_amdgcn_mfma_f32_16x16x32_bf16(Bt[n][k], At[m][k], acc[ai][bj][m][n], 0, 0, 0); __builtin_amdgcn_s_setprio(0); } while (0)
#define PG8_WAIT_V(n) asm volatile("s_waitcnt vmcnt(" #n ")" ::: "memory")
#define PG8_WAIT_L(n) asm volatile("s_waitcnt lgkmcnt(" #n ")" ::: "memory")
#define PG8_BAR __builtin_amdgcn_s_barrier()
#define PG8_SCHED __builtin_amdgcn_sched_barrier(0)
    Unit cur, nxt; int ui = 0;
    if (!S.next(0, cur)) return;
    f32x4 acc[2][2][4][2];
#pragma unroll
    for (int a = 0; a < 2; ++a)
#pragma unroll
        for (int b = 0; b < 2; ++b)
#pragma unroll
            for (int m = 0; m < 4; ++m)
#pragma unroll
                for (int n = 0; n < 2; ++n) acc[a][b][m][n] = (f32x4){0.f, 0.f, 0.f, 0.f};
    bf16x8 At[4][2], B0[2][2], B1[2][2];
    const char* cA = (const char*)g.A + (size_t)cur.pm * tstep; const char* cB = (const char*)g.Bt + (size_t)cur.pn * tstep;
    if constexpr (SP2) {
        PG8_STAGE(PG8_SB(0, 0), cB, voffB); PG8_STAGE(PG8_SB(0, 1), cB + hstep, voffB); PG8_STAGE(PG8_SA(0, 0), cA, voffA); PG8_STAGE(PG8_SA(0, 1), cA + hstep, voffA);
        if (wr == 1) PG8_BAR;
        PG8_WAIT_V(2); PG8_BAR;
        PG8_STAGE(PG8_SB(1, 0), cB + kstep, voffB); PG8_STAGE(PG8_SA(1, 0), cA + kstep, voffA); PG8_STAGE(PG8_SB(1, 1), cB + hstep + kstep, voffB);
        PG8_WAIT_V(6); PG8_BAR;
    } else {
        PG8_STAGE(PG8_SB(0, 0), cB, voffB); PG8_STAGE(PG8_SA(0, 0), cA, voffA); PG8_STAGE(PG8_SB(0, 1), cB + hstep, voffB); PG8_STAGE(PG8_SA(0, 1), cA + hstep, voffA);
        if (wr == 1) PG8_BAR;
        PG8_WAIT_V(4); PG8_BAR;
        PG8_STAGE(PG8_SB(1, 0), cB + kstep, voffB); PG8_STAGE(PG8_SA(1, 0), cA + kstep, voffA); PG8_STAGE(PG8_SB(1, 1), cB + hstep + kstep, voffB);
        PG8_WAIT_V(6); PG8_BAR;
    }
    for (;;) {
        const bool has_next = S.next(ui + 1, nxt);
        const char* nA = has_next ? (const char*)g.A + (size_t)nxt.pm * tstep : cA; const char* nB = has_next ? (const char*)g.Bt + (size_t)nxt.pn * tstep : cB;
        for (int t = 0; t < nt; t += 2) {
            if constexpr (Epi::MIDK) { if (t == nt / 2) E.mid(acc, cur, wr, wc, fr, fq); }
            const bool last = (t == nt - 2);
            const char* a1 = cA + (size_t)(t + 1) * kstep;
            const char* a2 = last ? nA : cA + (size_t)(t + 2) * kstep; const char* b2 = last ? nB : cB + (size_t)(t + 2) * kstep;
            const char* a3 = a2 + kstep; const char* b3 = b2 + kstep;
            if constexpr (SP2) {
            PG8_LDB(B0, 0, 0); PG8_LDB(B1, 0, 1); PG8_SCHED; PG8_LDA(At, 0, 0); PG8_STAGE(PG8_SA(1, 1), a1 + hstep, voffA);
            PG8_WAIT_V(8); PG8_WAIT_L(0); PG8_BAR; PG8_MMA(0, 0, At, B0); PG8_MMA(0, 1, At, B1); PG8_BAR; PG8_SCHED;
            PG8_LDA(At, 0, 1); PG8_STAGE(PG8_SB(0, 0), b2, voffB); PG8_STAGE(PG8_SB(0, 1), b2 + hstep, voffB); PG8_STAGE(PG8_SA(0, 0), a2, voffA);
            PG8_WAIT_V(8); PG8_WAIT_L(0); PG8_BAR; PG8_MMA(1, 0, At, B0); PG8_MMA(1, 1, At, B1); PG8_BAR; PG8_SCHED;
            PG8_LDB(B0, 1, 0); PG8_LDB(B1, 1, 1); PG8_SCHED; PG8_LDA(At, 1, 0); PG8_STAGE(PG8_SA(0, 1), a2 + hstep, voffA);
            PG8_WAIT_V(8); PG8_WAIT_L(0); PG8_BAR; PG8_MMA(0, 0, At, B0); PG8_MMA(0, 1, At, B1); PG8_BAR; PG8_SCHED;
            PG8_LDA(At, 1, 1); PG8_STAGE(PG8_SB(1, 0), b3, voffB); PG8_STAGE(PG8_SB(1, 1), b3 + hstep, voffB); PG8_STAGE(PG8_SA(1, 0), a3, voffA);
            PG8_WAIT_V(8); PG8_WAIT_L(0); PG8_BAR; PG8_MMA(1, 0, At, B0); PG8_MMA(1, 1, At, B1); PG8_BAR; PG8_SCHED;
            } else {
            PG8_LDB(B0, 0, 0); PG8_SCHED; PG8_LDA(At, 0, 0); PG8_STAGE(PG8_SA(1, 1), a1 + hstep, voffA);
            PG8_WAIT_L(8); PG8_BAR; PG8_WAIT_L(0); PG8_MMA(0, 0, At, B0); PG8_BAR; PG8_SCHED;
            PG8_LDB(B1, 0, 1); PG8_STAGE(PG8_SB(0, 0), b2, voffB);
            PG8_BAR; PG8_WAIT_L(0); PG8_MMA(0, 1, At, B1); PG8_BAR;
            PG8_LDA(At, 0, 1); PG8_STAGE(PG8_SA(0, 0), a2, voffA);
            PG8_BAR; PG8_WAIT_L(0); PG8_MMA(1, 0, At, B0); PG8_BAR; PG8_SCHED;
            PG8_STAGE(PG8_SB(0, 1), b2 + hstep, voffB);
            PG8_WAIT_V(6); PG8_BAR; PG8_MMA(1, 1, At, B1); PG8_BAR;
            PG8_LDB(B0, 1, 0); PG8_SCHED; PG8_LDA(At, 1, 0); PG8_STAGE(PG8_SA(0, 1), a2 + hstep, voffA);
            PG8_WAIT_L(8); PG8_BAR; PG8_WAIT_L(0); PG8_MMA(0, 0, At, B0); PG8_BAR; PG8_SCHED;
            PG8_LDB(B1, 1, 1); PG8_STAGE(PG8_SB(1, 0), b3, voffB);
            PG8_BAR; PG8_WAIT_L(0); PG8_MMA(0, 1, At, B1); PG8_BAR;
            PG8_LDA(At, 1, 1); PG8_STAGE(PG8_SA(1, 0), a3, voffA);
            PG8_BAR; PG8_WAIT_L(0); PG8_MMA(1, 0, At, B0); PG8_BAR; PG8_SCHED;
            PG8_STAGE(PG8_SB(1, 1), b3 + hstep, voffB);
            PG8_WAIT_V(6); PG8_BAR; PG8_MMA(1, 1, At, B1); PG8_BAR;
            }
        }
        if constexpr (ALIGN_EPI) { if (wr == 0) PG8_BAR; }
        E(acc, cur, wr, wc, fr, fq);
        if (!has_next) break;
#pragma unroll
        for (int a = 0; a < 2; ++a)
#pragma unroll
            for (int b = 0; b < 2; ++b)
#pragma unroll
                for (int m = 0; m < 4; ++m)
#pragma unroll
                    for (int n = 0; n < 2; ++n) acc[a][b][m][n] = (f32x4){0.f, 0.f, 0.f, 0.f};
        cur = nxt; cA = nA; cB = nB; ++ui;
        if constexpr (ALIGN_EPI) { if (wr == 1) PG8_BAR; }
    }
    PG8_WAIT_V(0);
    if constexpr (!ALIGN_EPI) { if (wr == 0) PG8_BAR; }
    PG8_BAR;
#undef PG8_SA
#undef PG8_SB
#undef PG8_STAGE
#undef PG8_LDA
#undef PG8_LDB
#undef PG8_MMA
#undef PG8_WAIT_V
#undef PG8_WAIT_L
#undef PG8_BAR
#undef PG8_SCHED
}
}
using pg8::Unit;
typedef f32x4 Acc[2][2][4][2];

DI u32x4 pack_row8(const f32x4& v0, const f32x4& v1) { u32x4 w; w.x = pk2(v0[0], v0[1]); w.y = pk2(v0[2], v0[3]); w.z = pk2(v1[0], v1[1]); w.w = pk2(v1[2], v1[3]); return w; }

struct EpiMod {
    static constexpr bool PERM = false, MIDK = false;
    float* mod; const float* bias;
    DI void operator()(Acc& acc, const Unit& u, int wr, int wc, int fr, int fq) const {
        { const int t_ = fresh_tid(); fr = t_ & 15; fq = (t_ >> 4) & 3; }
        if (u.pm != 0 || wr != 0) return;
#pragma unroll
        for (int m = 0; m < 3; ++m) { const int r = 16 * m + fr; if (r < NBATCH) {
#pragma unroll
            for (int bj = 0; bj < 2; ++bj)
#pragma unroll
                for (int n = 0; n < 2; ++n) { const int col = u.pn * 256 + bj * 128 + wc * 32 + n * 16 + 4 * fq;
                    *(f32x4*)(mod + (size_t)r * 6144 + col) = acc[0][bj][m][n] + *(const f32x4*)(bias + col); } } }
    }
};

struct EpiIn {
    static constexpr bool PERM = true, MIDK = false;
    bf16_t *QOB, *KA, *VA, *GA, *KB, *VB, *SGA, *SGB; float *CUM, *DEC; const float* lbl; float* out;
    DI void operator()(Acc& acc, const Unit& u, int wr, int wc, int fr, int fq) const {
        { const int t_ = fresh_tid(); fr = t_ & 15; fq = (t_ >> 4) & 3; }
        const int pn = u.pn, rt = wr * 64 + fr, row0 = u.pm * 256 + rt, cw = wc * 32 + 8 * fq, lane = fq * 16 + fr;
        if (pn >= 14) {
            const size_t o0 = (size_t)row0 * 1024 + (pn - 14) * 128 + cw;
#pragma unroll
            for (int ai = 0; ai < 2; ++ai)
#pragma unroll
                for (int m = 0; m < 4; ++m) { f32x4 r0, r1, b0, b1;
#pragma unroll
                    for (int j = 0; j < 4; ++j) { b0[j] = sigm(acc[ai][1][m][0][j]); b1[j] = sigm(acc[ai][1][m][1][j]);
                        r0[j] = sigm(acc[ai][0][m][0][j]) * __builtin_amdgcn_rcpf(b0[j]); r1[j] = sigm(acc[ai][0][m][1][j]) * __builtin_amdgcn_rcpf(b1[j]); }
                    const size_t o = o0 + (size_t)(ai * 128 + m * 16) * 1024;
                    *(u32x4*)(SGA + o) = pack_row8(r0, r1); *(u32x4*)(SGB + o) = pack_row8(b0, b1); __builtin_amdgcn_sched_barrier(0); }
            return;
        }
        const int seg = pn >> 1, col0 = (pn & 1) * 256 + cw;
        if (seg == 1) {
#pragma unroll
            for (int bj = 0; bj < 2; ++bj) {
                float lb[2][4];
#pragma unroll
                for (int n = 0; n < 2; ++n)
#pragma unroll
                    for (int j = 0; j < 4; ++j) { const int c = col0 + bj * 128 + 4 * n + j; lb[n][j] = __builtin_amdgcn_rcpf(1.f + __expf(lbl[512 + c] - lbl[c])); }
#pragma unroll
                for (int ai = 0; ai < 2; ++ai) {
                    const size_t rbase = (size_t)(u.pm * 256 + ai * 128 + wr * 64 + launder(fr)) * 512 + col0 + bj * 128;
#pragma unroll
                    for (int m = 0; m < 4; ++m) { f32x4 k0, k1;
#pragma unroll
                        for (int j = 0; j < 4; ++j) {
                            float f = lb[0][j] + (1.f - lb[0][j]) * sigm(acc[ai][bj][m][0][j]); k0[j] = 1.f - f; acc[ai][bj][m][0][j] = __logf(f);
                            f = lb[1][j] + (1.f - lb[1][j]) * sigm(acc[ai][bj][m][1][j]); k1[j] = 1.f - f; acc[ai][bj][m][1][j] = __logf(f); }
                        *(u32x4*)(KA + rbase + (size_t)m * 16 * 512) = pack_row8(k0, k1); }
                    __builtin_amdgcn_sched_barrier(0);
#pragma unroll
                    for (int n = 0; n < 2; ++n)
#pragma unroll
                        for (int j = 0; j < 4; ++j) { float carry = 0.f;
#pragma unroll
                            for (int m = 0; m < 4; ++m) { float v = acc[ai][bj][m][n][j];
                                v += __int_as_float(__builtin_amdgcn_update_dpp(0, __float_as_int(v), 0x111, 0xf, 0xf, false));
                                v += __int_as_float(__builtin_amdgcn_update_dpp(0, __float_as_int(v), 0x112, 0xf, 0xf, false));
                                v += __int_as_float(__builtin_amdgcn_update_dpp(0, __float_as_int(v), 0x114, 0xf, 0xf, false));
                                v += __int_as_float(__builtin_amdgcn_update_dpp(0, __float_as_int(v), 0x118, 0xf, 0xf, false));
                                v += carry; carry = __shfl(v, lane | 15); acc[ai][bj][m][n][j] = v; } }
                    __builtin_amdgcn_sched_barrier(0);
#pragma unroll
                    for (int m = 0; m < 4; ++m) { float* cp = CUM + rbase + (size_t)m * 16 * 512; *(f32x4*)cp = acc[ai][bj][m][0]; *(f32x4*)(cp + 4) = acc[ai][bj][m][1]; }
                    if (fr == 15) {
#pragma unroll
                        for (int n = 0; n < 2; ++n) { f32x4 e;
#pragma unroll
                            for (int j = 0; j < 4; ++j) e[j] = __expf(acc[ai][bj][3][n][j]);
                            *(f32x4*)(DEC + (size_t)(u.pm * 4 + ai * 2 + wr) * 512 + col0 + bj * 128 + 4 * n) = e; } }
                    __builtin_amdgcn_sched_barrier(0);
                }
            }
            return;
        }
        bf16_t* dst; int pitch = 512; float* o32 = nullptr;
        switch (seg) {
            case 0: dst = QOB + col0; pitch = 1024; break;
            case 2: dst = VA + col0; break;
            case 3: dst = GA + col0; break;
            case 4: dst = QOB + 512 + col0; pitch = 1024; break;
            case 5: dst = KB + col0; break;
            default: dst = VB + col0; break;
        }
        if (seg >= 5) {
            if (u.pm >= 128) o32 = out + (seg == 5 ? OFF_KS : OFF_VS) + (size_t)((u.pm - 128) * 256 + rt) * 512 + col0;
            else if ((u.pm & 63) >= 62) o32 = out + (seg == 5 ? OFF_KP : OFF_VP) + (size_t)((u.pm >> 6) * 512 + ((u.pm & 63) - 62) * 256 + rt) * 512 + col0;
        }
        const bool act = (seg == 0 || seg == 3);
#pragma unroll
        for (int ai = 0; ai < 2; ++ai)
#pragma unroll
            for (int m = 0; m < 4; ++m)
#pragma unroll
                for (int bj = 0; bj < 2; ++bj) { f32x4 v0 = acc[ai][bj][m][0], v1 = acc[ai][bj][m][1];
                    if (act) {
#pragma unroll
                        for (int j = 0; j < 4; ++j) { v0[j] = silu(v0[j]); v1[j] = silu(v1[j]); } }
                    *(u32x4*)(dst + (size_t)(row0 + ai * 128 + m * 16) * pitch + bj * 128) = pack_row8(v0, v1);
                    if (o32) { float* op = o32 + (size_t)(ai * 128 + m * 16) * 512 + bj * 128; *(f32x4*)op = v0; *(f32x4*)(op + 4) = v1; } __builtin_amdgcn_sched_barrier(0); }
    }
};

struct EpiMerge {
    static constexpr bool PERM = true, MIDK = true;
    const bf16_t *SGR, *SGB; bf16_t* Mo;
    DI void mid(Acc& acc, const Unit& u, int wr, int wc, int fr, int fq) const {
        { const int t_ = fresh_tid(); fr = t_ & 15; fq = (t_ >> 4) & 3; }
        const size_t base = (size_t)(u.pm * 256 + wr * 64 + fr) * 1024 + u.pn * 256 + wc * 32 + 8 * fq;
#pragma unroll
        for (int ai = 0; ai < 2; ++ai) { u32x4 a[4][2];
#pragma unroll
            for (int m = 0; m < 4; ++m)
#pragma unroll
                for (int bj = 0; bj < 2; ++bj) a[m][bj] = *(const u32x4*)(SGR + base + (size_t)(ai * 128 + m * 16) * 1024 + bj * 128);
#pragma unroll
            for (int m = 0; m < 4; ++m)
#pragma unroll
                for (int bj = 0; bj < 2; ++bj)
#pragma unroll
                    for (int j = 0; j < 4; ++j) { acc[ai][bj][m][j >> 1][(j & 1) * 2] *= bflo(a[m][bj][j]); acc[ai][bj][m][j >> 1][(j & 1) * 2 + 1] *= bfhi(a[m][bj][j]); }
            __builtin_amdgcn_sched_barrier(0); }
    }
    DI void operator()(Acc& acc, const Unit& u, int wr, int wc, int fr, int fq) const {
        { const int t_ = fresh_tid(); fr = t_ & 15; fq = (t_ >> 4) & 3; }
        const size_t base = (size_t)(u.pm * 256 + wr * 64 + fr) * 1024 + u.pn * 256 + wc * 32 + 8 * fq;
#pragma unroll
        for (int ai = 0; ai < 2; ++ai) { u32x4 b[4][2];
#pragma unroll
            for (int m = 0; m < 4; ++m)
#pragma unroll
                for (int bj = 0; bj < 2; ++bj) b[m][bj] = *(const u32x4*)(SGB + base + (size_t)(ai * 128 + m * 16) * 1024 + bj * 128);
#pragma unroll
            for (int m = 0; m < 4; ++m)
#pragma unroll
                for (int bj = 0; bj < 2; ++bj) { f32x4 v0 = acc[ai][bj][m][0], v1 = acc[ai][bj][m][1]; const u32x4 g = b[m][bj];
                    v0[0] *= bflo(g[0]); v0[1] *= bfhi(g[0]); v0[2] *= bflo(g[1]); v0[3] *= bfhi(g[1]);
                    v1[0] *= bflo(g[2]); v1[1] *= bfhi(g[2]); v1[2] *= bflo(g[3]); v1[3] *= bfhi(g[3]);
                    *(u32x4*)(Mo + base + (size_t)(ai * 128 + m * 16) * 1024 + bj * 128) = pack_row8(v0, v1); }
            __builtin_amdgcn_sched_barrier(0); }
    }
};

template <bool BASE_BF16> struct EpiRes {
    static constexpr bool PERM = true, MIDK = false;
    const float *xp, *xs; const bf16_t* xb; bf16_t* xo; const float* gmod;
    DI void operator()(Acc& acc, const Unit& u, int wr, int wc, int fr, int fq) const {
        { const int t_ = fresh_tid(); fr = t_ & 15; fq = (t_ >> 4) & 3; }
        const int colb = u.pn * 256 + wc * 32 + 8 * fq;
#pragma unroll
        for (int ai = 0; ai < 2; ++ai) { const int r0 = u.pm * 256 + ai * 128 + wr * 64 + fr;
            const float* g = gmod + (size_t)batch_of(r0) * 6144 + colb;
            f32x4 gv[2][2];
#pragma unroll
            for (int bj = 0; bj < 2; ++bj) { gv[bj][0] = *(const f32x4*)(g + bj * 128); gv[bj][1] = *(const f32x4*)(g + bj * 128 + 4); }
            bf16_t* orow = xo + (size_t)r0 * D + colb;
            if constexpr (BASE_BF16) {
                const bf16_t* xr = xb + (size_t)r0 * D + colb; u32x4 xv[4][2];
#pragma unroll
                for (int m = 0; m < 4; ++m)
#pragma unroll
                    for (int bj = 0; bj < 2; ++bj) xv[m][bj] = *(const u32x4*)(xr + (size_t)m * 16 * D + bj * 128);
#pragma unroll
                for (int m = 0; m < 4; ++m)
#pragma unroll
                    for (int bj = 0; bj < 2; ++bj) { const u32x4 x = xv[m][bj]; const f32x4 a0 = acc[ai][bj][m][0] * gv[bj][0], a1 = acc[ai][bj][m][1] * gv[bj][1];
                        f32x4 v0 = {bflo(x[0]) + a0[0], bfhi(x[0]) + a0[1], bflo(x[1]) + a0[2], bfhi(x[1]) + a0[3]}, v1 = {bflo(x[2]) + a1[0], bfhi(x[2]) + a1[1], bflo(x[3]) + a1[2], bfhi(x[3]) + a1[3]};
                        *(u32x4*)(orow + (size_t)m * 16 * D + bj * 128) = pack_row8(v0, v1); }
            } else {
                const float* xr = (r0 < TP ? xp + (size_t)r0 * D : xs + (size_t)(r0 - TP) * D) + colb; f32x4 xv[4][2][2];
#pragma unroll
                for (int m = 0; m < 4; ++m)
#pragma unroll
                    for (int bj = 0; bj < 2; ++bj) { xv[m][bj][0] = *(const f32x4*)(xr + (size_t)m * 16 * D + bj * 128); xv[m][bj][1] = *(const f32x4*)(xr + (size_t)m * 16 * D + bj * 128 + 4); }
#pragma unroll
                for (int m = 0; m < 4; ++m)
#pragma unroll
                    for (int bj = 0; bj < 2; ++bj) *(u32x4*)(orow + (size_t)m * 16 * D + bj * 128) = pack_row8(xv[m][bj][0] + gv[bj][0] * acc[ai][bj][m][0], xv[m][bj][1] + gv[bj][1] * acc[ai][bj][m][1]);
            }
            __builtin_amdgcn_sched_barrier(0); }
    }
};

struct EpiFfnIn {
    static constexpr bool PERM = true, MIDK = false;
    bf16_t* HID;
    DI void operator()(Acc& acc, const Unit& u, int wr, int wc, int fr, int fq) const {
        { const int t_ = fresh_tid(); fr = t_ & 15; fq = (t_ >> 4) & 3; }
        bf16_t* base = HID + (size_t)(u.pm * 256 + wr * 64 + fr) * FF + u.pn * 128 + wc * 32 + 8 * fq;
#pragma unroll
        for (int ai = 0; ai < 2; ++ai)
#pragma unroll
            for (int m = 0; m < 4; ++m) { f32x4 v0, v1;
#pragma unroll
                for (int j = 0; j < 4; ++j) { v0[j] = silu(acc[ai][0][m][0][j]) * acc[ai][1][m][0][j]; v1[j] = silu(acc[ai][0][m][1][j]) * acc[ai][1][m][1][j]; }
                *(u32x4*)(base + (size_t)(ai * 128 + m * 16) * FF) = pack_row8(v0, v1); __builtin_amdgcn_sched_barrier(0); }
    }
};

DI void transpose_item(const float* W, int N, bf16_t* WT, int pitch, int koff, int k0, int n0, int drow0, LAS float* scr, int lane) {
#pragma unroll 8
    for (int i = 0; i < 32; ++i) { const int kk = 2 * i + (lane >> 5); scr[kk * 33 + (lane & 31)] = W[(size_t)(k0 + kk) * N + n0 + (lane & 31)]; }
    asm volatile("s_waitcnt lgkmcnt(0)" ::: "memory");
    const int c = lane & 7;
#pragma unroll
    for (int j = 0; j < 4; ++j) { const int n = (lane >> 3) + 8 * j; const LAS float* s = scr + (8 * c) * 33 + n;
        u32x4 o; o.x = pk2(s[0 * 33], s[1 * 33]); o.y = pk2(s[2 * 33], s[3 * 33]); o.z = pk2(s[4 * 33], s[5 * 33]); o.w = pk2(s[6 * 33], s[7 * 33]);
        *(u32x4*)(WT + (size_t)(drow0 + n) * pitch + koff + k0 + 8 * c) = o; }
    asm volatile("s_waitcnt lgkmcnt(0)" ::: "memory");
}
DI void phase_prep(const Params& p, LAS unsigned char* lds) {
    const int tid = fresh_tid(), lane = tid & 63, wave = __builtin_amdgcn_readfirstlane(tid >> 6);
    LAS float* scr = (LAS float*)(lds + wave * 16384);
    const int gw = blockIdx.x * 8 + wave, NGW = gridDim.x * 8;
    unsigned char* ws = p.ws;
    constexpr int I_ADA = 16 * 192, I_IN = 16 * 176, I_A = 8 * 32, I_O = 16 * 32, I_FI = 16 * 176, I_FO = 44 * 32;
    constexpr int NIT = I_ADA + I_IN + 2 * I_A + I_O + I_FI + I_FO;
    for (int it = gw; it < NIT; it += NGW) {
        int r = it;
        if (r < I_ADA) { const int kb = r / 192, nb = r % 192; transpose_item(p.w_ada, 6144, (bf16_t*)(ws + WS_WADA), 1024, 0, 64 * kb, 32 * nb, 32 * nb, scr, lane); continue; } r -= I_ADA;
        if (r < I_IN) { const int kb = r / 176, nb = r % 176, n0 = 32 * nb; int dr = n0;
            if (n0 >= 3584) { const int j = n0 < 4608 ? n0 - 3584 : n0 - 4608; dr = 3584 + 256 * (j >> 7) + (j & 127) + (n0 < 4608 ? 0 : 128); }
            transpose_item(p.w_in, INC, (bf16_t*)(ws + WS_WIN), 1024, 0, 64 * kb, n0, dr, scr, lane); continue; } r -= I_IN;
        if (r < I_A) { const int kb = r / 32, nb = r % 32; transpose_item(p.w_a, 1024, (bf16_t*)(ws + WS_WAB), 1024, 0, 64 * kb, 32 * nb, 32 * nb, scr, lane); continue; } r -= I_A;
        if (r < I_A) { const int kb = r / 32, nb = r % 32; transpose_item(p.w_b, 1024, (bf16_t*)(ws + WS_WAB), 1024, 512, 64 * kb, 32 * nb, 32 * nb, scr, lane); continue; } r -= I_A;
        if (r < I_O) { const int kb = r / 32, nb = r % 32; transpose_item(p.w_out, 1024, (bf16_t*)(ws + WS_WO), 1024, 0, 64 * kb, 32 * nb, 32 * nb, scr, lane); continue; } r -= I_O;
        if (r < I_FI) { const int kb = r / 176, nb = r % 176; const int n0 = 32 * nb; const int j0 = n0 < FF ? n0 : n0 - FF;
            transpose_item(p.w_ffn_in, INC, (bf16_t*)(ws + WS_WFI), 1024, 0, 64 * kb, n0, 256 * (j0 >> 7) + (j0 & 127) + (n0 < FF ? 0 : 128), scr, lane); continue; } r -= I_FI;
        { const int kb = r / 32, nb = r % 32; transpose_item(p.w_ffn_out, 1024, (bf16_t*)(ws + WS_WFO), FF, 0, 64 * kb, 32 * nb, 32 * nb, scr, lane); }
    }
    bf16_t* SC = (bf16_t*)(ws + WS_SC);
    for (int i = blockIdx.x * 512 + tid; i < 256 * 1024 / 2; i += gridDim.x * 512) { const int row = (2 * i) >> 10, col = (2 * i) & 1023; float a = 0.f, b = 0.f;
        if (row < NBATCH) { const float* c = row < 2 ? p.c_prompt + row * D : p.c_sample + (row - 2) * D; a = silu(c[col]); b = silu(c[col + 1]); }
        ((unsigned*)SC)[i] = pk2(a, b); }
}

DI float wave_sum(float v) {
#pragma unroll
    for (int o = 1; o < 64; o <<= 1) v += __shfl_xor(v, o);
    return v;
}
DI void phase_norm_mod(const float* xp, const float* xs, const float* nw, const float* mod, int sh_off, int sc_off, bf16_t* H) {
    const int tid = fresh_tid(), lane = tid & 63, wave = __builtin_amdgcn_readfirstlane(tid >> 6);
    const int gw = blockIdx.x * 8 + wave, NGW = gridDim.x * 8;
    for (int r = gw; r < T; r += NGW) {
        const float* xr = r < TP ? xp + (size_t)r * D : xs + (size_t)(r - TP) * D; const float* mb = mod + (size_t)batch_of(r) * 6144;
        f32x4 v[4]; float s = 0.f;
#pragma unroll
        for (int j = 0; j < 4; ++j) { v[j] = *(const f32x4*)(xr + 4 * lane + 256 * j); s += (v[j][0] * v[j][0] + v[j][1] * v[j][1]) + (v[j][2] * v[j][2] + v[j][3] * v[j][3]); }
        const float rstd = __builtin_amdgcn_rsqf(wave_sum(s) * (1.f / D) + EPS);
#pragma unroll
        for (int j = 0; j < 4; ++j) { const int col = 4 * lane + 256 * j; const f32x4 w = *(const f32x4*)(nw + col), sc = *(const f32x4*)(mb + sc_off + col), sh = *(const f32x4*)(mb + sh_off + col);
            const f32x4 h = v[j] * rstd * w * (sc + 1.f) + sh; u32x2 o; o.x = pk2(h[0], h[1]); o.y = pk2(h[2], h[3]);
            *(u32x2*)(H + (size_t)r * D + col) = o; }
    }
}
DI void phase_norm_mod_b(const bf16_t* xb, const float* nw, const float* mod, int sh_off, int sc_off, bf16_t* H) {
    const int tid = fresh_tid(), lane = tid & 63, wave = __builtin_amdgcn_readfirstlane(tid >> 6);
    const int gw = blockIdx.x * 8 + wave, NGW = gridDim.x * 8;
    for (int r = gw; r < T; r += NGW) {
        const bf16_t* xr = xb + (size_t)r * D; const float* mb = mod + (size_t)batch_of(r) * 6144;
        float v[2][8]; float s = 0.f;
#pragma unroll
        for (int j = 0; j < 2; ++j) { const u32x4 x = *(const u32x4*)(xr + 8 * lane + 512 * j);
#pragma unroll
            for (int i = 0; i < 4; ++i) { v[j][2 * i] = bflo(x[i]); v[j][2 * i + 1] = bfhi(x[i]); s += v[j][2 * i] * v[j][2 * i] + v[j][2 * i + 1] * v[j][2 * i + 1]; } }
        const float rstd = __builtin_amdgcn_rsqf(wave_sum(s) * (1.f / D) + EPS);
#pragma unroll
        for (int j = 0; j < 2; ++j) { const int col = 8 * lane + 512 * j; f32x4 h[2];
#pragma unroll
            for (int q = 0; q < 2; ++q) { const f32x4 w = *(const f32x4*)(nw + col + 4 * q), sc = *(const f32x4*)(mb + sc_off + col + 4 * q), sh = *(const f32x4*)(mb + sh_off + col + 4 * q);
                const f32x4 x = {v[j][4 * q], v[j][4 * q + 1], v[j][4 * q + 2], v[j][4 * q + 3]}; h[q] = x * rstd * w * (sc + 1.f) + sh; }
            *(u32x4*)(H + (size_t)r * D + col) = pack_row8(h[0], h[1]); }
    }
}
DI void phase_final_norm(const bf16_t* xb, float* y, const float* nw) {
    const int tid = fresh_tid(), lane = tid & 63, wave = __builtin_amdgcn_readfirstlane(tid >> 6);
    const int gw = blockIdx.x * 8 + wave, NGW = gridDim.x * 8;
    for (int r = gw; r < T; r += NGW) { const bf16_t* xr = xb + (size_t)r * D; float* yr = y + (size_t)r * D;
        float v[2][8]; float s = 0.f;
#pragma unroll
        for (int j = 0; j < 2; ++j) { const u32x4 x = *(const u32x4*)(xr + 8 * lane + 512 * j);
#pragma unroll
            for (int i = 0; i < 4; ++i) { v[j][2 * i] = bflo(x[i]); v[j][2 * i + 1] = bfhi(x[i]); s += v[j][2 * i] * v[j][2 * i] + v[j][2 * i + 1] * v[j][2 * i + 1]; } }
        const float rstd = __builtin_amdgcn_rsqf(wave_sum(s) * (1.f / D) + EPS);
#pragma unroll
        for (int j = 0; j < 2; ++j) { const int col = 8 * lane + 512 * j;
#pragma unroll
            for (int q = 0; q < 2; ++q) { const f32x4 x = {v[j][4 * q], v[j][4 * q + 1], v[j][4 * q + 2], v[j][4 * q + 3]}; *(f32x4*)(yr + col + 4 * q) = x * rstd * *(const f32x4*)(nw + col + 4 * q); } }
    }
}

DI void hgrn_u_item(const Params& p, int item, int lane) {
    const int c = item >> 5, rem = item & 31, h = rem >> 3, kt = (rem >> 1) & 3, vh = rem & 1, l31 = lane & 31, hf = lane >> 5;
    const float* CUM = (const float*)(p.ws + WS_CUM); const bf16_t* KA = (const bf16_t*)(p.ws + WS_KA); const bf16_t* VA = (const bf16_t*)(p.ws + WS_VA); bf16_t* U = (bf16_t*)(p.ws + WS_U);
    const int kcol = h * 128 + 32 * kt + l31;
    const float tot = CUM[(size_t)(c * 64 + 63) * 512 + kcol];
    bf16x8 kdf[2][2];
#pragma unroll
    for (int st = 0; st < 2; ++st) { f32x16 kd;
#pragma unroll
        for (int r = 0; r < 16; ++r) { const size_t idx = (size_t)(c * 64 + 32 * st + crow(r, hf)) * 512 + kcol; kd[r] = bf2f((short)KA[idx]) * __expf(tot - CUM[idx]); }
        kdf[st][0] = pack8(kd, 0); kdf[st][1] = pack8(kd, 1); }
    const bf16x8 id0 = ident_frag(0, l31, hf), id1 = ident_frag(1, l31, hf);
#pragma unroll
    for (int vtl = 0; vtl < 2; ++vtl) { const int vt = 2 * vh + vtl; f32x16 dacc = zero16();
#pragma unroll
        for (int st = 0; st < 2; ++st) { const bf16_t* vp = VA + (size_t)(c * 64 + 32 * st + l31) * 512 + h * 128 + 32 * vt + 8 * hf;
            f32x16 vx = zero16(); vx = MFMA32(*(const bf16x8*)vp, id0, vx); vx = MFMA32(*(const bf16x8*)(vp + 16), id1, vx);
            dacc = MFMA32(kdf[st][0], pack8(vx, 0), dacc); dacc = MFMA32(kdf[st][1], pack8(vx, 1), dacc); }
        bf16_t* up = U + ((size_t)(c * 4 + h) * 128 + 32 * vt + l31) * 128 + 32 * kt + 4 * hf;
#pragma unroll
        for (int g = 0; g < 4; ++g) { u32x2 o; o.x = pk2(dacc[4 * g], dacc[4 * g + 1]); o.y = pk2(dacc[4 * g + 2], dacc[4 * g + 3]); *(u32x2*)(up + 8 * g) = o; }
    }
}

DI void scan_prompt_item(const Params& p, int item, int lane) {
    const int bh = item >> 5, vq = item & 31, b = bh >> 2, h = bh & 3, kg = lane & 31, vv = lane >> 5;
    const float* __restrict__ DEC = (const float*)(p.ws + WS_DEC); const bf16_t* __restrict__ U = (const bf16_t*)(p.ws + WS_U); bf16_t* __restrict__ SST = (bf16_t*)(p.ws + WS_SST);
    f32x4 S0 = {0.f, 0.f, 0.f, 0.f}, S1 = {0.f, 0.f, 0.f, 0.f};
    const int v0 = 4 * vq + vv, v1 = v0 + 2;
#pragma unroll 16
    for (int n = 0; n < 256; ++n) { const int c = b * 256 + n;
        const f32x4 d = *(const f32x4*)(DEC + (size_t)c * 512 + h * 128 + 4 * kg);
        const size_t o0 = ((size_t)(c * 4 + h) * 128 + v0) * 128 + 4 * kg, o1 = ((size_t)(c * 4 + h) * 128 + v1) * 128 + 4 * kg;
        const u32x2 u0 = *(const u32x2*)(U + o0), u1 = *(const u32x2*)(U + o1);
        u32x2 s; s.x = pk2(S0[0], S0[1]); s.y = pk2(S0[2], S0[3]); *(u32x2*)(SST + o0) = s;
        s.x = pk2(S1[0], S1[1]); s.y = pk2(S1[2], S1[3]); *(u32x2*)(SST + o1) = s;
        S0[0] = d[0] * S0[0] + bflo(u0.x); S0[1] = d[1] * S0[1] + bfhi(u0.x); S0[2] = d[2] * S0[2] + bflo(u0.y); S0[3] = d[3] * S0[3] + bfhi(u0.y);
        S1[0] = d[0] * S1[0] + bflo(u1.x); S1[1] = d[1] * S1[1] + bfhi(u1.x); S1[2] = d[2] * S1[2] + bflo(u1.y); S1[3] = d[3] * S1[3] + bfhi(u1.y);
    }
    float* sp = p.out + OFF_SP + ((size_t)bh * 128 + 4 * kg) * 128;
#pragma unroll
    for (int i = 0; i < 4; ++i) { sp[(size_t)i * 128 + v0] = S0[i]; sp[(size_t)i * 128 + v1] = S1[i]; }
}
DI void scan_sample_item(const Params& p, int item, int lane) {
    const int bh = item >> 5, vq = item & 31, bs = bh >> 2, h = bh & 3, kg = lane & 31, vv = lane >> 5, c = 512 + bs;
    const float* DEC = (const float*)(p.ws + WS_DEC); const bf16_t* U = (const bf16_t*)(p.ws + WS_U); bf16_t* SST = (bf16_t*)(p.ws + WS_SST);
    const f32x4 d = *(const f32x4*)(DEC + (size_t)c * 512 + h * 128 + 4 * kg);
    const float* s0 = p.state + ((size_t)bh * 128 + 4 * kg) * 128; float* so = p.out + OFF_SS + ((size_t)bh * 128 + 4 * kg) * 128;
#pragma unroll
    for (int e = 0; e < 2; ++e) { const int v = 4 * vq + 2 * e + vv; const size_t o = ((size_t)(c * 4 + h) * 128 + v) * 128 + 4 * kg;
        const u32x2 u = *(const u32x2*)(U + o); f32x4 S;
#pragma unroll
        for (int i = 0; i < 4; ++i) S[i] = s0[(size_t)i * 128 + v];
        u32x2 s; s.x = pk2(S[0], S[1]); s.y = pk2(S[2], S[3]); *(u32x2*)(SST + o) = s;
        so[v] = d[0] * S[0] + bflo(u.x); so[128 + v] = d[1] * S[1] + bfhi(u.x); so[256 + v] = d[2] * S[2] + bflo(u.y); so[384 + v] = d[3] * S[3] + bfhi(u.y); }
}

DI void attn_item(const Params& p, int item, int lane, const LAS float* biasl, bf16_t* obase = nullptr, int opitch = 1024) {
    const int c = item >> 4, h = (item >> 1) & 7, qh = item & 1, l31 = lane & 31, hf = lane >> 5;
    bf16_t* qptr = (bf16_t*)(p.ws + WS_QOB) + (size_t)(c * 64 + qh * 32 + l31) * 1024 + 512 + h * 64;
    const bf16_t* KB = (const bf16_t*)(p.ws + WS_KB); const bf16_t* VB = (const bf16_t*)(p.ws + WS_VB);
    bf16x8 qf[4];
#pragma unroll
    for (int ks = 0; ks < 4; ++ks) qf[ks] = *(const bf16x8*)(qptr + 16 * ks + 8 * hf);
    const bf16x8 id0 = ident_frag(0, l31, hf), id1 = ident_frag(1, l31, hf);
    const LAS float* bl = biasl + h * 192;
    f32x16 OT0 = zero16(), OT1 = zero16(); float mrun = -1e30f, lsum = 0.f;
    int ntile, ncache, db0; size_t krow_first;
    if (c < 512) { const int n = c & 255, j0 = n < 8 ? n : 8; ntile = 2 * (j0 + 1); ncache = 0; db0 = 64 * j0 + 32 * qh; krow_first = (size_t)(c - j0) * 64; }
    else { ntile = 18; ncache = 16; db0 = 512 + 32 * qh; krow_first = (size_t)c * 64 - 512; }
    const int bs = c - 512;
    u32x4 nk[4], nv[4], nk2[4], nv2[4];
#define ATT_LOAD(i_) do { if ((i_) < ncache) { \
            const float* kp_ = p.cache_k + ((size_t)(bs * 512 + 32 * (i_) + l31) * 8 + h) * 64 + 8 * hf; const float* vp_ = p.cache_v + ((size_t)(bs * 512 + 32 * (i_) + l31) * 8 + h) * 64 + 8 * hf; \
            _Pragma("unroll") for (int ks = 0; ks < 4; ++ks) { nk[ks] = *(const u32x4*)(kp_ + 16 * ks); nk2[ks] = *(const u32x4*)(kp_ + 16 * ks + 4); nv[ks] = *(const u32x4*)(vp_ + 16 * ks); nv2[ks] = *(const u32x4*)(vp_ + 16 * ks + 4); } \
        } else { const size_t ro_ = (krow_first + 32 * (i_) + l31) * 512 + h * 64 + 8 * hf; \
            _Pragma("unroll") for (int ks = 0; ks < 4; ++ks) { nk[ks] = *(const u32x4*)(KB + ro_ + 16 * ks); nv[ks] = *(const u32x4*)(VB + ro_ + 16 * ks); } } } while (0)
    ATT_LOAD(0);
    for (int i = 0; i < ntile; ++i) {
        bf16x8 kf[4], vf[2][2];
        if (i < ncache) {
#pragma unroll
            for (int ks = 0; ks < 4; ++ks) { u32x4 w; const f32x4 a = __builtin_bit_cast(f32x4, nk[ks]), b = __builtin_bit_cast(f32x4, nk2[ks]), e = __builtin_bit_cast(f32x4, nv[ks]), f = __builtin_bit_cast(f32x4, nv2[ks]);
                w.x = pk2(a[0], a[1]); w.y = pk2(a[2], a[3]); w.z = pk2(b[0], b[1]); w.w = pk2(b[2], b[3]); kf[ks] = __builtin_bit_cast(bf16x8, w);
                w.x = pk2(e[0], e[1]); w.y = pk2(e[2], e[3]); w.z = pk2(f[0], f[1]); w.w = pk2(f[2], f[3]); vf[ks >> 1][ks & 1] = __builtin_bit_cast(bf16x8, w); }
        } else {
#pragma unroll
            for (int ks = 0; ks < 4; ++ks) { kf[ks] = __builtin_bit_cast(bf16x8, nk[ks]); vf[ks >> 1][ks & 1] = __builtin_bit_cast(bf16x8, nv[ks]); }
        }
        if (i + 1 < ntile) ATT_LOAD(i + 1);
        f32x16 st = zero16();
#pragma unroll
        for (int ks = 0; ks < 4; ++ks) st = MFMA32(kf[ks], qf[ks], st);
        const int dbase = db0 - 32 * i + l31; float mt = -1e30f;
        if (db0 - 32 * i - 31 >= 128) { const float bc = bl[191];
#pragma unroll
            for (int r = 0; r < 16; ++r) { const float s = st[r] * (0.125f * LOG2E) + bc; st[r] = s; mt = fmaxf(mt, s); }
        } else {
#pragma unroll
            for (int r = 0; r < 16; ++r) { int dist = dbase - crow(r, hf); dist = dist > 128 ? 128 : dist; const float s = st[r] * (0.125f * LOG2E) + bl[dist + 63]; st[r] = s; mt = fmaxf(mt, s); }
        }
        mt = fmaxf(mt, __shfl_xor(mt, 32));
        const float mnew = fmaxf(mrun, mt), alpha = __builtin_amdgcn_exp2f(mrun - mnew); mrun = mnew;
        float ps = 0.f;
#pragma unroll
        for (int r = 0; r < 16; ++r) { st[r] = __builtin_amdgcn_exp2f(st[r] - mnew); ps += st[r]; }
        lsum = lsum * alpha + ps;
#pragma unroll
        for (int r = 0; r < 16; ++r) { OT0[r] *= alpha; OT1[r] *= alpha; }
        const bf16x8 pf0 = pack8(st, 0), pf1 = pack8(st, 1);
        { f32x16 vx = zero16(); vx = MFMA32(vf[0][0], id0, vx); vx = MFMA32(vf[0][1], id1, vx); OT0 = MFMA32(pack8(vx, 0), pf0, OT0); OT0 = MFMA32(pack8(vx, 1), pf1, OT0); }
        { f32x16 vx = zero16(); vx = MFMA32(vf[1][0], id0, vx); vx = MFMA32(vf[1][1], id1, vx); OT1 = MFMA32(pack8(vx, 0), pf0, OT1); OT1 = MFMA32(pack8(vx, 1), pf1, OT1); }
    }
    lsum += __shfl_xor(lsum, 32); const float inv = 1.f / lsum;
    if (obase) qptr = obase + (size_t)(c * 64 + qh * 32 + l31) * opitch + h * 64;
#pragma unroll
    for (int g = 0; g < 4; ++g) { u32x2 o; o.x = pk2(OT0[4 * g] * inv, OT0[4 * g + 1] * inv); o.y = pk2(OT0[4 * g + 2] * inv, OT0[4 * g + 3] * inv); *(u32x2*)(qptr + 8 * g + 4 * hf) = o;
        o.x = pk2(OT1[4 * g] * inv, OT1[4 * g + 1] * inv); o.y = pk2(OT1[4 * g + 2] * inv, OT1[4 * g + 3] * inv); *(u32x2*)(qptr + 32 + 8 * g + 4 * hf) = o; }
}

DI void hgrn_out_item(const Params& p, int item, int lane, bf16_t* obase = nullptr) {
    const int c = item >> 3, h = (item >> 1) & 3, tt = item & 1, l31 = lane & 31, hf = lane >> 5;
    const float* CUM = (const float*)(p.ws + WS_CUM); const bf16_t* KA = (const bf16_t*)(p.ws + WS_KA); const bf16_t* VA = (const bf16_t*)(p.ws + WS_VA);
    const bf16_t* GA = (const bf16_t*)(p.ws + WS_GA); const bf16_t* SST = (const bf16_t*)(p.ws + WS_SST);
    const int trow = c * 64 + 32 * tt + l31;
    bf16_t* qap = (bf16_t*)(p.ws + WS_QOB) + (size_t)trow * 1024 + h * 128;
    const float* cumt = CUM + (size_t)trow * 512 + h * 128; const float* refp = CUM + (size_t)(c * 64 + 32) * 512 + h * 128;
    bf16x8 qd1[8], qd2[8];
#pragma unroll
    for (int ks = 0; ks < 8; ++ks) { const int k0 = 16 * ks + 8 * hf; const bf16x8 q8 = *(const bf16x8*)(qap + k0);
        const f32x4 c0 = *(const f32x4*)(cumt + k0), c1 = *(const f32x4*)(cumt + k0 + 4), r0 = *(const f32x4*)(refp + k0), r1 = *(const f32x4*)(refp + k0 + 4);
        float a[8], b[8];
#pragma unroll
        for (int j = 0; j < 8; ++j) { const float q = bf2f(q8[j]), cu = j < 4 ? c0[j & 3] : c1[j & 3], rf = j < 4 ? r0[j & 3] : r1[j & 3]; a[j] = q * __expf(cu - rf); b[j] = q * __expf(cu); }
        qd1[ks] = pack8f(a); qd2[ks] = pack8f(b); }
    f32x16 OT[4];
#pragma unroll
    for (int vt = 0; vt < 4; ++vt) OT[vt] = zero16();
    const bf16_t* sp = SST + ((size_t)(c * 4 + h) * 128 + l31) * 128 + 8 * hf;
#pragma unroll
    for (int vt = 0; vt < 4; ++vt)
#pragma unroll
        for (int ks = 0; ks < 8; ++ks) OT[vt] = MFMA32(*(const bf16x8*)(sp + (size_t)vt * 32 * 128 + 16 * ks), qd2[ks], OT[vt]);
    const bf16x8 id0 = ident_frag(0, l31, hf), id1 = ident_frag(1, l31, hf);
    for (int st = 0; st <= tt; ++st) {
        const int srow = c * 64 + 32 * st + l31; const bf16_t* kap = KA + (size_t)srow * 512 + h * 128; const float* cums = CUM + (size_t)srow * 512 + h * 128;
        f32x16 X = zero16();
#pragma unroll
        for (int ks = 0; ks < 8; ++ks) { const int k0 = 16 * ks + 8 * hf; const bf16x8 k8 = *(const bf16x8*)(kap + k0);
            const f32x4 c0 = *(const f32x4*)(cums + k0), c1 = *(const f32x4*)(cums + k0 + 4), r0 = *(const f32x4*)(refp + k0), r1 = *(const f32x4*)(refp + k0 + 4);
            float a[8];
#pragma unroll
            for (int j = 0; j < 8; ++j) { const float cu = j < 4 ? c0[j & 3] : c1[j & 3], rf = j < 4 ? r0[j & 3] : r1[j & 3]; a[j] = bf2f(k8[j]) * __expf(rf - cu); }
            X = MFMA32(pack8f(a), qd1[ks], X); }
        if (st == tt) {
#pragma unroll
            for (int r = 0; r < 16; ++r) if (crow(r, hf) > l31) X[r] = 0.f; }
        const bf16x8 xf0 = pack8(X, 0), xf1 = pack8(X, 1);
        const bf16_t* vp = VA + (size_t)srow * 512 + h * 128 + 8 * hf;
#pragma unroll
        for (int vt = 0; vt < 4; ++vt) { f32x16 vx = zero16(); vx = MFMA32(*(const bf16x8*)(vp + 32 * vt), id0, vx); vx = MFMA32(*(const bf16x8*)(vp + 32 * vt + 16), id1, vx);
            OT[vt] = MFMA32(pack8(vx, 0), xf0, OT[vt]); OT[vt] = MFMA32(pack8(vx, 1), xf1, OT[vt]); }
    }
    float ss = 0.f;
#pragma unroll
    for (int vt = 0; vt < 4; ++vt)
#pragma unroll
        for (int r = 0; r < 16; ++r) ss += OT[vt][r] * OT[vt][r];
    ss += __shfl_xor(ss, 32);
    const float rstd = __builtin_amdgcn_rsqf(ss * (1.f / 128.f) + EPS);
    const bf16_t* gap = GA + (size_t)trow * 512 + h * 128; const float* onp = p.out_norm + h * 128;
    if (obase) qap = obase + (size_t)trow * 512 + h * 128;
#pragma unroll
    for (int vt = 0; vt < 4; ++vt)
#pragma unroll
        for (int g = 0; g < 4; ++g) { const int v0 = 32 * vt + 8 * g + 4 * hf; const f32x4 on = *(const f32x4*)(onp + v0); const u32x2 ga = *(const u32x2*)(gap + v0);
            u32x2 o; o.x = pk2(OT[vt][4 * g] * rstd * on[0] * bflo(ga.x), OT[vt][4 * g + 1] * rstd * on[1] * bfhi(ga.x));
            o.y = pk2(OT[vt][4 * g + 2] * rstd * on[2] * bflo(ga.y), OT[vt][4 * g + 3] * rstd * on[3] * bfhi(ga.y)); *(u32x2*)(qap + v0) = o; }
}


#define XB_TMO      128
#define XB_XCNT(j)  (256  + 64 * (j))
#define XB_XSUB(j)  (1280 + 64 * (j))
#define XB_XGEN(j)  (2304 + 64 * (j))
#define XB_TOP      3328
#define XB_TOPGEN   3392
#define XCD_BAR_WORDS 3456
#define XB_SPIN_CAP (1u << 18)
DI unsigned xb_ld(unsigned* p)              { return __hip_atomic_load(p, __ATOMIC_RELAXED, __HIP_MEMORY_SCOPE_AGENT); }
DI unsigned xb_add(unsigned* p, unsigned v) { return __hip_atomic_fetch_add(p, v, __ATOMIC_RELAXED, __HIP_MEMORY_SCOPE_AGENT); }
DI unsigned xb_xcc_id() { return (unsigned)__builtin_amdgcn_s_getreg((3 << 11) | 20) & 0xFu; }
#define XB_SPIN(cond, bar) do { unsigned _sp = 0; while (cond) { __builtin_amdgcn_s_sleep(1); \
    if ((++_sp & 255u) == 0u) { if (xb_ld(&(bar)[XB_TMO])) break; if (_sp > XB_SPIN_CAP) { atomicAdd(&(bar)[XB_TMO], 1u); break; } } } } while (0)
struct XcdBarrier { unsigned* bar; unsigned x; volatile LAS unsigned* st; };
DI XcdBarrier xcd_barrier_post(unsigned* bar, volatile LAS unsigned* st) {
    XcdBarrier b; b.bar = bar; b.x = xb_xcc_id(); b.st = st;
    if (threadIdx.x == 0) (void)xb_add(&bar[XB_XCNT(b.x)], 1u);
    return b;
}
DI void xcd_barrier_complete(unsigned* bar, unsigned x, unsigned& nloc, unsigned& nx) {
    const unsigned G = gridDim.x * gridDim.y * gridDim.z;
    unsigned sum, cnt, mine, sp = 0u;
    for (;;) {
        sum = 0u; cnt = 0u; mine = 0u;
#pragma unroll
        for (unsigned j = 0; j < 16; ++j) { const unsigned c = xb_ld(&bar[XB_XCNT(j)]); sum += c; cnt += (c > 0u) ? 1u : 0u; mine = (j == x) ? c : mine; }
        if (sum == G) break;
        __builtin_amdgcn_s_sleep(1);
        if ((++sp & 255u) == 0u) { if (xb_ld(&bar[XB_TMO])) break; if (sp > XB_SPIN_CAP) { atomicAdd(&bar[XB_TMO], 1u); break; } }
    }
    nloc = mine > 0u ? mine : 1u; nx = cnt > 0u ? cnt : 1u;
}
DI void xcd_barrier(const XcdBarrier& b) {
    asm volatile("s_waitcnt vmcnt(0)" ::: "memory");
    __syncthreads();
    if (threadIdx.x == 0) {
        unsigned* bar = b.bar;
        __builtin_amdgcn_s_waitcnt(0);
        unsigned nloc = b.st[0], nx = b.st[1];
        if (nloc == 0u) { xcd_barrier_complete(bar, b.x, nloc, nx); b.st[0] = nloc; b.st[1] = nx; }
        const unsigned old = xb_add(&bar[XB_XSUB(b.x)], 1u);
        const unsigned gen = old / nloc;
        if (old + 1u == (gen + 1u) * nloc) {
            __builtin_amdgcn_fence(__ATOMIC_RELEASE, "agent");
            asm volatile("s_waitcnt vmcnt(0)" ::: "memory");
            const unsigned og = xb_add(&bar[XB_TOP], 1u);
            const unsigned tg = og / nx;
            if (og + 1u == (tg + 1u) * nx) xb_add(&bar[XB_TOPGEN], 1u);
            else XB_SPIN(xb_ld(&bar[XB_TOPGEN]) == tg, bar);
            __builtin_amdgcn_fence(__ATOMIC_ACQUIRE, "agent");
            xb_add(&bar[XB_XGEN(b.x)], 1u);
            asm volatile("s_waitcnt vmcnt(0)" ::: "memory");
        } else {
            XB_SPIN(xb_ld(&bar[XB_XGEN(b.x)]) == gen, bar);
            __builtin_amdgcn_fence(__ATOMIC_ACQUIRE, "agent");
            asm volatile("s_waitcnt vmcnt(0)" ::: "memory");
        }
    }
    __syncthreads();
}

__global__ void __launch_bounds__(512, 2) fwd_megakernel(Params p) {
    extern __shared__ __attribute__((aligned(16))) unsigned char lds_raw[];
    LAS unsigned char* lds = (LAS unsigned char*)lds_raw;
    cg::grid_group grid = cg::this_grid();
    const int G = gridDim.x, bx = blockIdx.x;
    volatile LAS unsigned* bst = (volatile LAS unsigned*)(lds + LDS_ST_OFF);
    if (threadIdx.x < 2) bst[threadIdx.x] = 0u;
    __syncthreads();
    const XcdBarrier xbar = xcd_barrier_post((unsigned*)(p.ws + WS_BAR), bst);
#define GRID_BAR() xcd_barrier(xbar)
    unsigned char* ws = p.ws;
    float* MOD = (float*)(ws + WS_MOD); bf16_t* H = (bf16_t*)(ws + WS_H);

    phase_prep(p, lds);
    grid.sync();
    { pg8::Gemm g{(const bf16_t*)(ws + WS_SC), (const bf16_t*)(ws + WS_WADA), 256, 6144, 1024}; pg8::StaticOrder S; S.init(256, 6144, G, bx);
      EpiMod E{MOD, p.b_ada}; pg8::gemm_phase<EpiMod, pg8::StaticOrder, true, true>(lds, g, S, E); }
    GRID_BAR();
    phase_norm_mod(p.x_prompt, p.x_sample, p.norm_mix, MOD, 0, 1024, H);
#if PROBE_DUP == 1
    GRID_BAR(); phase_norm_mod(p.x_prompt, p.x_sample, p.norm_mix, MOD, 0, 1024, H);
#endif
#if PROBE_DUP == 10
    GRID_BAR(); GRID_BAR(); GRID_BAR(); GRID_BAR(); GRID_BAR(); GRID_BAR(); GRID_BAR(); GRID_BAR(); GRID_BAR(); GRID_BAR();
#endif
    GRID_BAR();
    { pg8::Gemm g{H, (const bf16_t*)(ws + WS_WIN), T, INC, 1024}; pg8::StaticOrder S; S.init(T, INC, G, bx);
      EpiIn E{(bf16_t*)(ws + WS_QOB), (bf16_t*)(ws + WS_KA), (bf16_t*)(ws + WS_VA), (bf16_t*)(ws + WS_GA), (bf16_t*)(ws + WS_KB), (bf16_t*)(ws + WS_VB),
              (bf16_t*)(p.out), (bf16_t*)(p.out) + (size_t)T * 1024, (float*)(ws + WS_CUM), (float*)(ws + WS_DEC), p.lb_logits, p.out};
      pg8::gemm_phase<EpiIn, pg8::StaticOrder, true, true>(lds, g, S, E);
#if PROBE_DUP == 2
      GRID_BAR(); pg8::gemm_phase<EpiIn, pg8::StaticOrder, true, true>(lds, g, S, E);
#endif
    }
    GRID_BAR();
    { const int tid = fresh_tid(), lane = tid & 63, wave = __builtin_amdgcn_readfirstlane(tid >> 6);
      for (int it = wave * G + bx; it < NCH * 32; it += 8 * G) hgrn_u_item(p, it, lane);
#if PROBE_DUP == 3
      for (int it = wave * G + bx; it < NCH * 32; it += 8 * G) hgrn_u_item(p, it, lane);
#endif
    }
    GRID_BAR();
    {
        const int tid = fresh_tid(), lane = tid & 63, wave = __builtin_amdgcn_readfirstlane(tid >> 6);
        LAS float* biasl = (LAS float*)lds;
        for (int i = tid; i < 8 * 192; i += 512) biasl[i] = p.rel_bias[i] * LOG2E;
        __syncthreads();
#if PROBE_DUP == 4
        if (wave != 0) { const int gw = (wave - 1) * G + bx, NGW = 7 * G; for (int it = gw; it < NCH * 16; it += NGW) attn_item(p, it, lane, biasl, (bf16_t*)(ws + WS_SST), 512); }
        GRID_BAR();
#endif
#if PROBE_DUP == 41
        if (wave == 0) { for (int it = bx; it < 256; it += G) scan_prompt_item(p, it, lane); }
        GRID_BAR();
#endif
        if (wave == 0) { for (int it = bx; it < 256; it += G) scan_prompt_item(p, it, lane); }
        else {
            const int gw = (wave - 1) * G + bx, NGW = 7 * G;
            for (int it = gw; it < 4096; it += NGW) scan_sample_item(p, it, lane);
            for (int it = gw; it < NCH * 16; it += NGW) attn_item(p, it, lane, biasl);
        }
    }
    GRID_BAR();
    { const int tid = fresh_tid(), lane = tid & 63, wave = __builtin_amdgcn_readfirstlane(tid >> 6);
#if PROBE_DUP == 5
      for (int it = wave * G + bx; it < NCH * 8; it += 8 * G) hgrn_out_item(p, it, lane, (bf16_t*)(ws + WS_U));
      GRID_BAR();
#endif
      for (int it = wave * G + bx; it < NCH * 8; it += 8 * G) hgrn_out_item(p, it, lane); }
    GRID_BAR();
    { pg8::Gemm g{(const bf16_t*)(ws + WS_QOB), (const bf16_t*)(ws + WS_WAB), T, 1024, 1024}; pg8::StaticOrder S; S.init(T, 1024, G, bx);
      EpiMerge E{(const bf16_t*)(p.out), (const bf16_t*)(p.out) + (size_t)T * 1024, (bf16_t*)(ws + WS_M)};
      pg8::gemm_phase<EpiMerge, pg8::StaticOrder, true, true>(lds, g, S, E); }
    GRID_BAR();
    { pg8::Gemm g{(const bf16_t*)(ws + WS_M), (const bf16_t*)(ws + WS_WO), T, 1024, 1024}; pg8::StaticOrder S; S.init(T, 1024, G, bx);
      EpiRes<false> E{p.x_prompt, p.x_sample, nullptr, (bf16_t*)(ws + WS_X1B), MOD + 2048}; pg8::gemm_phase<EpiRes<false>, pg8::StaticOrder, true, true>(lds, g, S, E);
#if PROBE_DUP == 7
      GRID_BAR(); pg8::gemm_phase<EpiRes<false>, pg8::StaticOrder, true, true>(lds, g, S, E);
#endif
    }
    GRID_BAR();
    phase_norm_mod_b((const bf16_t*)(ws + WS_X1B), p.norm_ffn, MOD, 3072, 4096, H);
    GRID_BAR();
    { pg8::Gemm g{H, (const bf16_t*)(ws + WS_WFI), T, INC, 1024}; pg8::StaticOrder S; S.init(T, INC, G, bx);
      EpiFfnIn E{(bf16_t*)(ws + WS_HID)}; pg8::gemm_phase<EpiFfnIn, pg8::StaticOrder, true, true>(lds, g, S, E);
#if PROBE_DUP == 9
      GRID_BAR(); pg8::gemm_phase<EpiFfnIn, pg8::StaticOrder, true, true>(lds, g, S, E);
#endif
    }
    GRID_BAR();
    { pg8::Gemm g{(const bf16_t*)(ws + WS_HID), (const bf16_t*)(ws + WS_WFO), T, 1024, FF}; pg8::StaticOrder S; S.init(T, 1024, G, bx);
      EpiRes<true> E{nullptr, nullptr, (const bf16_t*)(ws + WS_X1B), (bf16_t*)(ws + WS_X2B), MOD + 5120}; pg8::gemm_phase<EpiRes<true>, pg8::StaticOrder, true, true>(lds, g, S, E); }
    GRID_BAR();
    phase_final_norm((const bf16_t*)(ws + WS_X2B), p.out, p.norm_final);
}

extern "C" void kernel_launch(void* const* d_in, const int* in_sizes, int n_in, void* d_out, int out_size, void* d_ws, size_t ws_size, hipStream_t stream) {
    static int grid = 0;
    if (grid == 0) {
        if (n_in != 21 || (size_t)out_size != OUT_TOTAL || ws_size < WS_END) { fprintf(stderr, "kernel_launch: unexpected sizes n_in %d out %d ws %zu\n", n_in, out_size, ws_size); grid = -1; return; }
        int dev = 0, cus = 0, per = 0;
        (void)hipGetDevice(&dev); (void)hipDeviceGetAttribute(&cus, hipDeviceAttributeMultiprocessorCount, dev);
        (void)hipFuncSetAttribute((const void*)fwd_megakernel, hipFuncAttributeMaxDynamicSharedMemorySize, LDS_BYTES);
        (void)hipOccupancyMaxActiveBlocksPerMultiprocessor(&per, (const void*)fwd_megakernel, 512, LDS_BYTES);
        if (per < 1) per = 1;
        grid = cus * per; fprintf(stderr, "kernel_launch: grid %d (cus %d x %d)\n", grid, cus, per);
    }
    if (grid < 0) return;
    if (hipMemsetAsync((char*)d_ws + WS_BAR, 0, BAR_BYTES, stream) != hipSuccess) { fprintf(stderr, "kernel_launch: memset failed\n"); return; }
    Params p{};
    const float** f = (const float**)&p;
    for (int i = 0; i < 21; ++i) f[i] = (const float*)d_in[i];
    p.out = (float*)d_out; p.ws = (unsigned char*)d_ws;
    void* args[] = {&p};
    hipError_t e = hipLaunchCooperativeKernel((const void*)fwd_megakernel, dim3(grid), dim3(512), args, LDS_BYTES, stream);
    if (e != hipSuccess) fprintf(stderr, "cooperative launch failed: %s (grid %d)\n", hipGetErrorString(e), grid);
}
```

```cpp
#include <hip/hip_runtime.h>
#include <hip/hip_cooperative_groups.h>
#include <cstdio>
#include <cstdint>
namespace cg = cooperative_groups;
#ifndef PROBE_DUP
#define PROBE_DUP 0
#endif

#define DI __device__ __forceinline__
#define LAS __attribute__((address_space(3)))
typedef unsigned short bf16_t;
typedef short bf16x8 __attribute__((ext_vector_type(8)));
typedef float f32x4 __attribute__((ext_vector_type(4)));
typedef float f32x2 __attribute__((ext_vector_type(2)));
typedef float f32x16 __attribute__((ext_vector_type(16)));
typedef unsigned u32x4 __attribute__((ext_vector_type(4)));
typedef unsigned u32x2 __attribute__((ext_vector_type(2)));
typedef __bf16 bf2_t __attribute__((ext_vector_type(2)));

constexpr int D = 1024, TP = 32768, TS = 2048, T = TP + TS, NCH = T / 64, NBATCH = 34;
constexpr int INC = 5632, FF = 2816;
constexpr float EPS = 1e-6f, LOG2E = 1.4426950408889634f;
constexpr size_t OFF_Y = 0, OFF_SP = (size_t)T * D, OFF_KP = OFF_SP + 131072, OFF_VP = OFF_KP + 524288, OFF_SS = OFF_VP + 524288,
                 OFF_KS = OFF_SS + 2097152, OFF_VS = OFF_KS + 1048576, OUT_TOTAL = OFF_VS + 1048576;
constexpr size_t MiB = 1u << 20;
constexpr size_t WS_MOD = 1 * MiB, WS_DEC = 2 * MiB, WS_SC = 4 * MiB, WS_WADA = 5 * MiB, WS_WIN = 17 * MiB, WS_WAB = 28 * MiB, WS_WO = 30 * MiB,
                 WS_WFI = 32 * MiB, WS_WFO = 43 * MiB, WS_H = 50 * MiB, WS_QOB = 118 * MiB, WS_KA = 186 * MiB, WS_VA = 220 * MiB, WS_GA = 254 * MiB,
                 WS_KB = 288 * MiB, WS_VB = 322 * MiB, WS_CUM = 356 * MiB, WS_SST = 424 * MiB, WS_END = 492 * MiB;
constexpr size_t WS_U = WS_H, WS_M = WS_KA, WS_HID = WS_KA, WS_X1B = WS_QOB, WS_X2B = WS_H;
constexpr size_t WS_BAR = 0, BAR_BYTES = 16384;
constexpr int LDS_BYTES = 140 * 1024, LDS_ST_OFF = 136 * 1024;

struct Params {
    const float *x_prompt, *x_sample, *c_prompt, *c_sample, *state, *cache_k, *cache_v, *w_ada, *b_ada, *norm_mix, *w_in, *lb_logits, *out_norm,
                *w_a, *rel_bias, *w_b, *w_out, *norm_ffn, *w_ffn_in, *w_ffn_out, *norm_final;
    float* out; unsigned char* ws;
};

DI int fresh_tid() { int t = threadIdx.x; asm volatile("" : "+v"(t)); return t; }
DI int launder(int v) { asm volatile("" : "+v"(v)); return v; }
DI unsigned pk2(float a, float b) { f32x2 v = {a, b}; bf2_t r = __builtin_convertvector(v, bf2_t); return __builtin_bit_cast(unsigned, r); }
DI float bflo(unsigned u) { return __uint_as_float(u << 16); }
DI float bfhi(unsigned u) { return __uint_as_float(u & 0xffff0000u); }
DI float bf2f(short s) { return __uint_as_float(((unsigned)(unsigned short)s) << 16); }
DI float sigm(float x) { return __builtin_amdgcn_rcpf(1.f + __expf(-x)); }
DI float silu(float x) { return x * sigm(x); }
DI int batch_of(int r) { return r < TP ? (r >> 14) : 2 + ((r - TP) >> 6); }
DI int crow(int reg, int h) { return (reg & 3) + 8 * (reg >> 2) + 4 * h; }
DI bf16x8 pack8(const f32x16& x, int s) {
    u32x4 p; p.x = pk2(x[8 * s], x[8 * s + 1]); p.y = pk2(x[8 * s + 2], x[8 * s + 3]); p.z = pk2(x[8 * s + 4], x[8 * s + 5]); p.w = pk2(x[8 * s + 6], x[8 * s + 7]);
    return __builtin_bit_cast(bf16x8, p);
}
DI bf16x8 pack8f(const float* v) { u32x4 p; p.x = pk2(v[0], v[1]); p.y = pk2(v[2], v[3]); p.z = pk2(v[4], v[5]); p.w = pk2(v[6], v[7]); return __builtin_bit_cast(bf16x8, p); }
DI bf16x8 ident_frag(int ks, int l31, int hf) {
    const int jj = l31 - 16 * ks - 8 * hf; bf16x8 r;
#pragma unroll
    for (int j = 0; j < 8; ++j) r[j] = (j == jj) ? (short)0x3F80 : (short)0;
    return r;
}
#define MFMA32(a, b, c) __builtin_amdgcn_mfma_f32_32x32x16_bf16((a), (b), (c), 0, 0, 0)
DI f32x16 zero16() { f32x16 z;
#pragma unroll
    for (int i = 0; i < 16; ++i) z[i] = 0.f; return z; }

namespace pg8 {
constexpr int BM = 256, BK = 64, HALF = 128, HTB = HALF * BK * 2, STAGE_BYTES = 8 * HTB, NXCD = 8, WGM = 8;
__host__ __device__ __forceinline__ int lds_byte(int r, int c) { const int st = (r >> 4) * 2 + (c >> 5), rr = r & 15, cc = c & 31, ob = rr * 64 + cc * 2; return st * 1024 + (ob ^ (((ob >> 9) & 1) << 5)); }
__host__ __device__ __forceinline__ void stage_rc(int b, int& R, int& C) { const int st = b / 1024, sb = b % 1024, swz = sb ^ (((sb >> 9) & 1) << 5); R = (st >> 1) * 16 + swz / 64; C = (st & 1) * 32 + (swz % 64) / 2; }
__host__ __device__ __forceinline__ int perm32(int rho) { const int n = rho >> 4, i = rho & 15; return 8 * (i >> 2) + 4 * n + (i & 3); }
struct Unit { int pm, pn; };
struct Gemm { const bf16_t* A; const bf16_t* Bt; int M, N, K; };
struct StaticOrder {
    int nM, nN, nwg, G, c, pm_off;
    __device__ void init(int M, int N, int G_, int c_, int pm_off_ = 0) { nM = M / BM; nN = N / BM; nwg = nM * nN; G = G_; c = c_; pm_off = pm_off_; }
    __device__ bool next(int i, Unit& u) const {
        const long L = (long)i * G + c; if (L >= nwg) return false;
        int wgid = (int)L; { const int q = nwg / NXCD, r = nwg % NXCD, xcd = wgid % NXCD, off = wgid / NXCD; wgid = (xcd < r ? xcd * (q + 1) : r * (q + 1) + (xcd - r) * q) + off; }
        const int nig = WGM * nN, gid = wgid / nig, fm = gid * WGM, gsz = (nM - fm) < WGM ? (nM - fm) : WGM;
        u.pm = pm_off + fm + ((wgid % nig) % gsz); u.pn = (wgid % nig) / gsz; return true;
    }
};
template <class Epi, class Sched, bool ALIGN_EPI = false, bool SP2 = false>
__device__ __forceinline__ void gemm_phase(LAS unsigned char* lds, const Gemm g, const Sched& S, const Epi& E) {
    const int tid = fresh_tid(), wid = __builtin_amdgcn_readfirstlane(tid >> 6), lane = tid & 63, wr = wid >> 2, wc = wid & 3, fr = lane & 15, fq = lane >> 4;
    const int K = g.K, nt = K / BK;
    unsigned voffA[2], voffB[2];
#pragma unroll
    for (int i = 0; i < 2; ++i) { int R, C; stage_rc(tid * 16 + i * 8192, R, C); const int Rb = Epi::PERM ? ((R & ~31) + perm32(R & 31)) : R;
        voffA[i] = (unsigned)(R * K + C) * 2u; voffB[i] = (unsigned)(Rb * K + C) * 2u; }
    const size_t kstep = (size_t)(BK * 2);
    const size_t hstep = (size_t)HALF * K * 2;
    const size_t tstep = 2 * hstep;
    const unsigned ldsw = (unsigned)wid * 1024u;
    const int aoff = lds_byte(wr * 64 + fr, fq * 8), boff = lds_byte(wc * 32 + fr, fq * 8);
#define PG8_SA(b, h) (((b) * 2 + (h)) * HTB)
#define PG8_SB(b, h) ((4 + (b) * 2 + (h)) * HTB)
#define PG8_STAGE(bufoff, gbase, voff) do { _Pragma("unroll") for (int _i = 0; _i < 2; ++_i) \
        __builtin_amdgcn_global_load_lds((const unsigned*)((const char*)(gbase) + (voff)[_i]), (LAS unsigned*)(lds + (bufoff) + ldsw + _i * 8192), 16, 0, 0); } while (0)
#define PG8_LDA(dst, b, h) do { _Pragma("unroll") for (int m = 0; m < 4; ++m) _Pragma("unroll") for (int k = 0; k < 2; ++k) dst[m][k] = *(const LAS bf16x8*)(lds + PG8_SA(b, h) + aoff + m * 2048 + k * 1024); } while (0)
#define PG8_LDB(dst, b, h) do { _Pragma("unroll") for (int n = 0; n < 2; ++n) _Pragma("unroll") for (int k = 0; k < 2; ++k) dst[n][k] = *(const LAS bf16x8*)(lds + PG8_SB(b, h) + boff + n * 2048 + k * 1024); } while (0)
#define PG8_MMA(ai, bj, At, Bt) do { __builtin_amdgcn_s_setprio(1); _Pragma("unroll") for (int m = 0; m < 4; ++m) _Pragma("unroll") for (int n = 0; n < 2; ++n) _Pragma("unroll") for (int k = 0; k < 2; ++k) \
        acc[ai][bj][m][n] = __builtin_amdgcn_mfma_f32_16x16x32_bf16(Bt[n][k], At[m][k], acc[ai][bj][m][n], 0, 0, 0); __builtin_amdgcn_s_setprio(0); } while (0)
#define PG8_WAIT_V(n) asm volatile("s_waitcnt vmcnt(" #n ")" ::: "memory")
#define PG8_WAIT_L(n) asm volatile("s_waitcnt lgkmcnt(" #n ")" ::: "memory")
#define PG8_BAR __builtin_amdgcn_s_barrier()
#define PG8_SCHED __builtin_amdgcn_sched_barrier(0)
    Unit cur, nxt; int ui = 0;
    if (!S.next(0, cur)) return;
    f32x4 acc[2][2][4][2];
#pragma unroll
    for (int a = 0; a < 2; ++a)
#pragma unroll
        for (int b = 0; b < 2; ++b)
#pragma unroll
            for (int m = 0; m < 4; ++m)
#pragma unroll
                for (int n = 0; n < 2; ++n) acc[a][b][m][n] = (f32x4){0.f, 0.f, 0.f, 0.f};
    bf16x8 At[4][2], B0[2][2], B1[2][2];
    const char* cA = (const char*)g.A + (size_t)cur.pm * tstep; const char* cB = (const char*)g.Bt + (size_t)cur.pn * tstep;
    if constexpr (SP2) {
        PG8_STAGE(PG8_SB(0, 0), cB, voffB); PG8_STAGE(PG8_SB(0, 1), cB + hstep, voffB); PG8_STAGE(PG8_SA(0, 0), cA, voffA); PG8_STAGE(PG8_SA(0, 1), cA + hstep, voffA);
        if (wr == 1) PG8_BAR;
        PG8_WAIT_V(2); PG8_BAR;
        PG8_STAGE(PG8_SB(1, 0), cB + kstep, voffB); PG8_STAGE(PG8_SA(1, 0), cA + kstep, voffA); PG8_STAGE(PG8_SB(1, 1), cB + hstep + kstep, voffB);
        PG8_WAIT_V(6); PG8_BAR;
    } else {
        PG8_STAGE(PG8_SB(0, 0), cB, voffB); PG8_STAGE(PG8_SA(0, 0), cA, voffA); PG8_STAGE(PG8_SB(0, 1), cB + hstep, voffB); PG8_STAGE(PG8_SA(0, 1), cA + hstep, voffA);
        if (wr == 1) PG8_BAR;
        PG8_WAIT_V(4); PG8_BAR;
        PG8_STAGE(PG8_SB(1, 0), cB + kstep, voffB); PG8_STAGE(PG8_SA(1, 0), cA + kstep, voffA); PG8_STAGE(PG8_SB(1, 1), cB + hstep + kstep, voffB);
        PG8_WAIT_V(6); PG8_BAR;
    }
    for (;;) {
        const bool has_next = S.next(ui + 1, nxt);
        const char* nA = has_next ? (const char*)g.A + (size_t)nxt.pm * tstep : cA; const char* nB = has_next ? (const char*)g.Bt + (size_t)nxt.pn * tstep : cB;
        for (int t = 0; t < nt; t += 2) {
            if constexpr (Epi::MIDK) { if (t == nt / 2) E.mid(acc, cur, wr, wc, fr, fq); }
            const bool last = (t == nt - 2);
            const char* a1 = cA + (size_t)(t + 1) * kstep;
            const char* a2 = last ? nA : cA + (size_t)(t + 2) * kstep; const char* b2 = last ? nB : cB + (size_t)(t + 2) * kstep;
            const char* a3 = a2 + kstep; const char* b3 = b2 + kstep;
            if constexpr (SP2) {
            PG8_LDB(B0, 0, 0); PG8_LDB(B1, 0, 1); PG8_SCHED; PG8_LDA(At, 0, 0); PG8_STAGE(PG8_SA(1, 1), a1 + hstep, voffA);
            PG8_WAIT_V(8); PG8_WAIT_L(0); PG8_BAR; PG8_MMA(0, 0, At, B0); PG8_MMA(0, 1, At, B1); PG8_BAR; PG8_SCHED;
            PG8_LDA(At, 0, 1); PG8_STAGE(PG8_SB(0, 0), b2, voffB); PG8_STAGE(PG8_SB(0, 1), b2 + hstep, voffB); PG8_STAGE(PG8_SA(0, 0), a2, voffA);
            PG8_WAIT_V(8); PG8_WAIT_L(0); PG8_BAR; PG8_MMA(1, 0, At, B0); PG8_MMA(1, 1, At, B1); PG8_BAR; PG8_SCHED;
            PG8_LDB(B0, 1, 0); PG8_LDB(B1, 1, 1); PG8_SCHED; PG8_LDA(At, 1, 0); PG8_STAGE(PG8_SA(0, 1), a2 + hstep, voffA);
            PG8_WAIT_V(8); PG8_WAIT_L(0); PG8_BAR; PG8_MMA(0, 0, At, B0); PG8_MMA(0, 1, At, B1); PG8_BAR; PG8_SCHED;
            PG8_LDA(At, 1, 1); PG8_STAGE(PG8_SB(1, 0), b3, voffB); PG8_STAGE(PG8_SB(1, 1), b3 + hstep, voffB); PG8_STAGE(PG8_SA(1, 0), a3, voffA);
            PG8_WAIT_V(8); PG8_WAIT_L(0); PG8_BAR; PG8_MMA(1, 0, At, B0); PG8_MMA(1, 1, At, B1); PG8_BAR; PG8_SCHED;
            } else {
            PG8_LDB(B0, 0, 0); PG8_SCHED; PG8_LDA(At, 0, 0); PG8_STAGE(PG8_SA(1, 1), a1 + hstep, voffA);
            PG8_WAIT_L(8); PG8_BAR; PG8_WAIT_L(0); PG8_MMA(0, 0, At, B0); PG8_BAR; PG8_SCHED;
            PG8_LDB(B1, 0, 1); PG8_STAGE(PG8_SB(0, 0), b2, voffB);
            PG8_BAR; PG8_WAIT_L(0); PG8_MMA(0, 1, At, B1); PG8_BAR;
            PG8_LDA(At, 0, 1); PG8_STAGE(PG8_SA(0, 0), a2, voffA);
            PG8_BAR; PG8_WAIT_L(0); PG8_MMA(1, 0, At, B0); PG8_BAR; PG8_SCHED;
            PG8_STAGE(PG8_SB(0, 1), b2 + hstep, voffB);
            PG8_WAIT_V(6); PG8_BAR; PG8_MMA(1, 1, At, B1); PG8_BAR;
            PG8_LDB(B0, 1, 0); PG8_SCHED; PG8_LDA(At, 1, 0); PG8_STAGE(PG8_SA(0, 1), a2 + hstep, voffA);
            PG8_WAIT_L(8); PG8_BAR; PG8_WAIT_L(0); PG8_MMA(0, 0, At, B0); PG8_BAR; PG8_SCHED;
            PG8_LDB(B1, 1, 1); PG8_STAGE(PG8_SB(1, 0), b3, voffB);
            PG8_BAR; PG8_WAIT_L(0); PG8_MMA(0, 1, At, B1); PG8_BAR;
            PG8_LDA(At, 1, 1); PG8_STAGE(PG8_SA(1, 0), a3, voffA);
            PG8_BAR; PG8_WAIT_L(0); PG8_MMA(1, 0, At, B0); PG8_BAR; PG8_SCHED;
            PG8_STAGE(PG8_SB(1, 1), b3 + hstep, voffB);
            PG8_WAIT_V(6); PG8_BAR; PG8_MMA(1, 1, At, B1); PG8_BAR;
            }
        }
        if constexpr (ALIGN_EPI) { if (wr == 0) PG8_BAR; }
        E(acc, cur, wr, wc, fr, fq);
        if (!has_next) break;
#pragma unroll
        for (int a = 0; a < 2; ++a)
#pragma unroll
            for (int b = 0; b < 2; ++b)
#pragma unroll
                for (int m = 0; m < 4; ++m)
#pragma unroll
                    for (int n = 0; n < 2; ++n) acc[a][b][m][n] = (f32x4){0.f, 0.f, 0.f, 0.f};
        cur = nxt; cA = nA; cB = nB; ++ui;
        if constexpr (ALIGN_EPI) { if (wr == 1) PG8_BAR; }
    }
    PG8_WAIT_V(0);
    if constexpr (!ALIGN_EPI) { if (wr == 0) PG8_BAR; }
    PG8_BAR;
#undef PG8_SA
#undef PG8_SB
#undef PG8_STAGE
#undef PG8_LDA
#undef PG8_LDB
#undef PG8_MMA
#undef PG8_WAIT_V
#undef PG8_WAIT_L
#undef PG8_BAR
#undef PG8_SCHED
}
}
using pg8::Unit;
typedef f32x4 Acc[2][2][4][2];

DI u32x4 pack_row8(const f32x4& v0, const f32x4& v1) { u32x4 w; w.x = pk2(v0[0], v0[1]); w.y = pk2(v0[2], v0[3]); w.z = pk2(v1[0], v1[1]); w.w = pk2(v1[2], v1[3]); return w; }

struct EpiMod {
    static constexpr bool PERM = false, MIDK = false;
    float* mod; const float* bias;
    DI void operator()(Acc& acc, const Unit& u, int wr, int wc, int fr, int fq) const {
        { const int t_ = fresh_tid(); fr = t_ & 15; fq = (t_ >> 4) & 3; }
        if (u.pm != 0 || wr != 0) return;
#pragma unroll
        for (int m = 0; m < 3; ++m) { const int r = 16 * m + fr; if (r < NBATCH) {
#pragma unroll
            for (int bj = 0; bj < 2; ++bj)
#pragma unroll
                for (int n = 0; n < 2; ++n) { const int col = u.pn * 256 + bj * 128 + wc * 32 + n * 16 + 4 * fq;
                    *(f32x4*)(mod + (size_t)r * 6144 + col) = acc[0][bj][m][n] + *(const f32x4*)(bias + col); } } }
    }
};

struct EpiIn {
    static constexpr bool PERM = true, MIDK = false;
    bf16_t *QOB, *KA, *VA, *GA, *KB, *VB, *SGA, *SGB; float *CUM, *DEC; const float* lbl; float* out;
    DI void operator()(Acc& acc, const Unit& u, int wr, int wc, int fr, int fq) const {
        { const int t_ = fresh_tid(); fr = t_ & 15; fq = (t_ >> 4) & 3; }
        const int pn = u.pn, rt = wr * 64 + fr, row0 = u.pm * 256 + rt, cw = wc * 32 + 8 * fq, lane = fq * 16 + fr;
        if (pn >= 14) {
            const size_t o0 = (size_t)row0 * 1024 + (pn - 14) * 128 + cw;
#pragma unroll
            for (int ai = 0; ai < 2; ++ai)
#pragma unroll
                for (int m = 0; m < 4; ++m) { f32x4 r0, r1, b0, b1;
#pragma unroll
                    for (int j = 0; j < 4; ++j) { b0[j] = fmaxf(sigm(acc[ai][1][m][0][j]), 1e-30f); b1[j] = fmaxf(sigm(acc[ai][1][m][1][j]), 1e-30f);
                        r0[j] = sigm(acc[ai][0][m][0][j]) * __builtin_amdgcn_rcpf(b0[j]); r1[j] = sigm(acc[ai][0][m][1][j]) * __builtin_amdgcn_rcpf(b1[j]); }
                    const size_t o = o0 + (size_t)(ai * 128 + m * 16) * 1024;
                    *(u32x4*)(SGA + o) = pack_row8(r0, r1); *(u32x4*)(SGB + o) = pack_row8(b0, b1); __builtin_amdgcn_sched_barrier(0); }
            return;
        }
        const int seg = pn >> 1, col0 = (pn & 1) * 256 + cw;
        if (seg == 1) {
#pragma unroll
            for (int bj = 0; bj < 2; ++bj) {
                float lb[2][4];
#pragma unroll
                for (int n = 0; n < 2; ++n)
#pragma unroll
                    for (int j = 0; j < 4; ++j) { const int c = col0 + bj * 128 + 4 * n + j; lb[n][j] = __builtin_amdgcn_rcpf(1.f + __expf(lbl[512 + c] - lbl[c])); }
#pragma unroll
                for (int ai = 0; ai < 2; ++ai) {
                    const size_t rbase = (size_t)(u.pm * 256 + ai * 128 + wr * 64 + launder(fr)) * 512 + col0 + bj * 128;
#pragma unroll
                    for (int m = 0; m < 4; ++m) { f32x4 k0, k1;
#pragma unroll
                        for (int j = 0; j < 4; ++j) {
                            float f = lb[0][j] + (1.f - lb[0][j]) * sigm(acc[ai][bj][m][0][j]); k0[j] = 1.f - f; acc[ai][bj][m][0][j] = __logf(f);
                            f = lb[1][j] + (1.f - lb[1][j]) * sigm(acc[ai][bj][m][1][j]); k1[j] = 1.f - f; acc[ai][bj][m][1][j] = __logf(f); }
                        *(u32x4*)(KA + rbase + (size_t)m * 16 * 512) = pack_row8(k0, k1); }
                    __builtin_amdgcn_sched_barrier(0);
#pragma unroll
                    for (int n = 0; n < 2; ++n)
#pragma unroll
                        for (int j = 0; j < 4; ++j) { float carry = 0.f;
#pragma unroll
                            for (int m = 0; m < 4; ++m) { float v = acc[ai][bj][m][n][j];
                                v += __int_as_float(__builtin_amdgcn_update_dpp(0, __float_as_int(v), 0x111, 0xf, 0xf, false));
                                v += __int_as_float(__builtin_amdgcn_update_dpp(0, __float_as_int(v), 0x112, 0xf, 0xf, false));
                                v += __int_as_float(__builtin_amdgcn_update_dpp(0, __float_as_int(v), 0x114, 0xf, 0xf, false));
                                v += __int_as_float(__builtin_amdgcn_update_dpp(0, __float_as_int(v), 0x118, 0xf, 0xf, false));
                                v += carry; carry = __shfl(v, lane | 15); acc[ai][bj][m][n][j] = v; } }
                    __builtin_amdgcn_sched_barrier(0);
#pragma unroll
                    for (int m = 0; m < 4; ++m) { float* cp = CUM + rbase + (size_t)m * 16 * 512; *(f32x4*)cp = acc[ai][bj][m][0]; *(f32x4*)(cp + 4) = acc[ai][bj][m][1]; }
                    if (fr == 15) {
#pragma unroll
                        for (int n = 0; n < 2; ++n) { f32x4 e;
#pragma unroll
                            for (int j = 0; j < 4; ++j) e[j] = __expf(acc[ai][bj][3][n][j]);
                            *(f32x4*)(DEC + (size_t)(u.pm * 4 + ai * 2 + wr) * 512 + col0 + bj * 128 + 4 * n) = e; } }
                    __builtin_amdgcn_sched_barrier(0);
                }
            }
            return;
        }
        bf16_t* dst; int pitch = 512; float* o32 = nullptr;
        switch (seg) {
            case 0: dst = QOB + col0; pitch = 1024; break;
            case 2: dst = VA + col0; break;
            case 3: dst = GA + col0; break;
            case 4: dst = QOB + 512 + col0; pitch = 1024; break;
            case 5: dst = KB + col0; break;
            default: dst = VB + col0; break;
        }
        if (seg >= 5) {
            if (u.pm >= 128) o32 = out + (seg == 5 ? OFF_KS : OFF_VS) + (size_t)((u.pm - 128) * 256 + rt) * 512 + col0;
            else if ((u.pm & 63) >= 62) o32 = out + (seg == 5 ? OFF_KP : OFF_VP) + (size_t)((u.pm >> 6) * 512 + ((u.pm & 63) - 62) * 256 + rt) * 512 + col0;
        }
        const bool act = (seg == 0 || seg == 3);
#pragma unroll
        for (int ai = 0; ai < 2; ++ai)
#pragma unroll
            for (int m = 0; m < 4; ++m)
#pragma unroll
                for (int bj = 0; bj < 2; ++bj) { f32x4 v0 = acc[ai][bj][m][0], v1 = acc[ai][bj][m][1];
                    if (act) {
#pragma unroll
                        for (int j = 0; j < 4; ++j) { v0[j] = silu(v0[j]); v1[j] = silu(v1[j]); } }
                    *(u32x4*)(dst + (size_t)(row0 + ai * 128 + m * 16) * pitch + bj * 128) = pack_row8(v0, v1);
                    if (o32) { float* op = o32 + (size_t)(ai * 128 + m * 16) * 512 + bj * 128; *(f32x4*)op = v0; *(f32x4*)(op + 4) = v1; } __builtin_amdgcn_sched_barrier(0); }
    }
};

struct EpiMerge {
    static constexpr bool PERM = true, MIDK = true;
    const bf16_t *SGR, *SGB; bf16_t* Mo;
    DI void mid(Acc& acc, const Unit& u, int wr, int wc, int fr, int fq) const {
        { const int t_ = fresh_tid(); fr = t_ & 15; fq = (t_ >> 4) & 3; }
        const size_t base = (size_t)(u.pm * 256 + wr * 64 + fr) * 1024 + u.pn * 256 + wc * 32 + 8 * fq;
#pragma unroll
        for (int ai = 0; ai < 2; ++ai) { u32x4 a[4][2];
#pragma unroll
            for (int m = 0; m < 4; ++m)
#pragma unroll
                for (int bj = 0; bj < 2; ++bj) a[m][bj] = *(const u32x4*)(SGR + base + (size_t)(ai * 128 + m * 16) * 1024 + bj * 128);
#pragma unroll
            for (int m = 0; m < 4; ++m)
#pragma unroll
                for (int bj = 0; bj < 2; ++bj)
#pragma unroll
                    for (int j = 0; j < 4; ++j) { acc[ai][bj][m][j >> 1][(j & 1) * 2] *= bflo(a[m][bj][j]); acc[ai][bj][m][j >> 1][(j & 1) * 2 + 1] *= bfhi(a[m][bj][j]); }
            __builtin_amdgcn_sched_barrier(0); }
    }
    DI void operator()(Acc& acc, const Unit& u, int wr, int wc, int fr, int fq) const {
        { const int t_ = fresh_tid(); fr = t_ & 15; fq = (t_ >> 4) & 3; }
        const size_t base = (size_t)(u.pm * 256 + wr * 64 + fr) * 1024 + u.pn * 256 + wc * 32 + 8 * fq;
#pragma unroll
        for (int ai = 0; ai < 2; ++ai) { u32x4 b[4][2];
#pragma unroll
            for (int m = 0; m < 4; ++m)
#pragma unroll
                for (int bj = 0; bj < 2; ++bj) b[m][bj] = *(const u32x4*)(SGB + base + (size_t)(ai * 128 + m * 16) * 1024 + bj * 128);
#pragma unroll
            for (int m = 0; m < 4; ++m)
#pragma unroll
                for (int bj = 0; bj < 2; ++bj) { f32x4 v0 = acc[ai][bj][m][0], v1 = acc[ai][bj][m][1]; const u32x4 g = b[m][bj];
                    v0[0] *= bflo(g[0]); v0[1] *= bfhi(g[0]); v0[2] *= bflo(g[1]); v0[3] *= bfhi(g[1]);
                    v1[0] *= bflo(g[2]); v1[1] *= bfhi(g[2]); v1[2] *= bflo(g[3]); v1[3] *= bfhi(g[3]);
                    *(u32x4*)(Mo + base + (size_t)(ai * 128 + m * 16) * 1024 + bj * 128) = pack_row8(v0, v1); }
            __builtin_amdgcn_sched_barrier(0); }
    }
};

template <bool BASE_BF16> struct EpiRes {
    static constexpr bool PERM = true, MIDK = false;
    const float *xp, *xs; const bf16_t* xb; bf16_t* xo; const float* gmod;
    DI void operator()(Acc& acc, const Unit& u, int wr, int wc, int fr, int fq) const {
        { const int t_ = fresh_tid(); fr = t_ & 15; fq = (t_ >> 4) & 3; }
        const int colb = u.pn * 256 + wc * 32 + 8 * fq;
#pragma unroll
        for (int ai = 0; ai < 2; ++ai) { const int r0 = u.pm * 256 + ai * 128 + wr * 64 + fr;
            const float* g = gmod + (size_t)batch_of(r0) * 6144 + colb;
            f32x4 gv[2][2];
#pragma unroll
            for (int bj = 0; bj < 2; ++bj) { gv[bj][0] = *(const f32x4*)(g + bj * 128); gv[bj][1] = *(const f32x4*)(g + bj * 128 + 4); }
            bf16_t* orow = xo + (size_t)r0 * D + colb;
            if constexpr (BASE_BF16) {
                const bf16_t* xr = xb + (size_t)r0 * D + colb; u32x4 xv[4][2];
#pragma unroll
                for (int m = 0; m < 4; ++m)
#pragma unroll
                    for (int bj = 0; bj < 2; ++bj) xv[m][bj] = *(const u32x4*)(xr + (size_t)m * 16 * D + bj * 128);
#pragma unroll
                for (int m = 0; m < 4; ++m)
#pragma unroll
                    for (int bj = 0; bj < 2; ++bj) { const u32x4 x = xv[m][bj]; const f32x4 a0 = acc[ai][bj][m][0] * gv[bj][0], a1 = acc[ai][bj][m][1] * gv[bj][1];
                        f32x4 v0 = {bflo(x[0]) + a0[0], bfhi(x[0]) + a0[1], bflo(x[1]) + a0[2], bfhi(x[1]) + a0[3]}, v1 = {bflo(x[2]) + a1[0], bfhi(x[2]) + a1[1], bflo(x[3]) + a1[2], bfhi(x[3]) + a1[3]};
                        *(u32x4*)(orow + (size_t)m * 16 * D + bj * 128) = pack_row8(v0, v1); }
            } else {
                const float* xr = (r0 < TP ? xp + (size_t)r0 * D : xs + (size_t)(r0 - TP) * D) + colb; f32x4 xv[4][2][2];
#pragma unroll
                for (int m = 0; m < 4; ++m)
#pragma unroll
                    for (int bj = 0; bj < 2; ++bj) { xv[m][bj][0] = *(const f32x4*)(xr + (size_t)m * 16 * D + bj * 128); xv[m][bj][1] = *(const f32x4*)(xr + (size_t)m * 16 * D + bj * 128 + 4); }
#pragma unroll
                for (int m = 0; m < 4; ++m)
#pragma unroll
                    for (int bj = 0; bj < 2; ++bj) *(u32x4*)(orow + (size_t)m * 16 * D + bj * 128) = pack_row8(xv[m][bj][0] + gv[bj][0] * acc[ai][bj][m][0], xv[m][bj][1] + gv[bj][1] * acc[ai][bj][m][1]);
            }
            __builtin_amdgcn_sched_barrier(0); }
    }
};

struct EpiFfnIn {
    static constexpr bool PERM = true, MIDK = false;
    bf16_t* HID;
    DI void operator()(Acc& acc, const Unit& u, int wr, int wc, int fr, int fq) const {
        { const int t_ = fresh_tid(); fr = t_ & 15; fq = (t_ >> 4) & 3; }
        bf16_t* base = HID + (size_t)(u.pm * 256 + wr * 64 + fr) * FF + u.pn * 128 + wc * 32 + 8 * fq;
#pragma unroll
        for (int ai = 0; ai < 2; ++ai)
#pragma unroll
            for (int m = 0; m < 4; ++m) { f32x4 v0, v1;
#pragma unroll
                for (int j = 0; j < 4; ++j) { v0[j] = silu(acc[ai][0][m][0][j]) * acc[ai][1][m][0][j]; v1[j] = silu(acc[ai][0][m][1][j]) * acc[ai][1][m][1][j]; }
                *(u32x4*)(base + (size_t)(ai * 128 + m * 16) * FF) = pack_row8(v0, v1); __builtin_amdgcn_sched_barrier(0); }
    }
};

DI void transpose_item(const float* W, int N, bf16_t* WT, int pitch, int koff, int k0, int n0, int drow0, LAS float* scr, int lane) {
#pragma unroll 8
    for (int i = 0; i < 32; ++i) { const int kk = 2 * i + (lane >> 5); scr[kk * 33 + (lane & 31)] = W[(size_t)(k0 + kk) * N + n0 + (lane & 31)]; }
    asm volatile("s_waitcnt lgkmcnt(0)" ::: "memory");
    const int c = lane & 7;
#pragma unroll
    for (int j = 0; j < 4; ++j) { const int n = (lane >> 3) + 8 * j; const LAS float* s = scr + (8 * c) * 33 + n;
        u32x4 o; o.x = pk2(s[0 * 33], s[1 * 33]); o.y = pk2(s[2 * 33], s[3 * 33]); o.z = pk2(s[4 * 33], s[5 * 33]); o.w = pk2(s[6 * 33], s[7 * 33]);
        *(u32x4*)(WT + (size_t)(drow0 + n) * pitch + koff + k0 + 8 * c) = o; }
    asm volatile("s_waitcnt lgkmcnt(0)" ::: "memory");
}
DI void phase_prep(const Params& p, LAS unsigned char* lds) {
    const int tid = fresh_tid(), lane = tid & 63, wave = __builtin_amdgcn_readfirstlane(tid >> 6);
    LAS float* scr = (LAS float*)(lds + wave * 16384);
    const int gw = blockIdx.x * 8 + wave, NGW = gridDim.x * 8;
    unsigned char* ws = p.ws;
    constexpr int I_ADA = 16 * 192, I_IN = 16 * 176, I_A = 8 * 32, I_O = 16 * 32, I_FI = 16 * 176, I_FO = 44 * 32;
    constexpr int NIT = I_ADA + I_IN + 2 * I_A + I_O + I_FI + I_FO;
    for (int it = gw; it < NIT; it += NGW) {
        int r = it;
        if (r < I_ADA) { const int kb = r / 192, nb = r % 192; transpose_item(p.w_ada, 6144, (bf16_t*)(ws + WS_WADA), 1024, 0, 64 * kb, 32 * nb, 32 * nb, scr, lane); continue; } r -= I_ADA;
        if (r < I_IN) { const int kb = r / 176, nb = r % 176, n0 = 32 * nb; int dr = n0;
            if (n0 >= 3584) { const int j = n0 < 4608 ? n0 - 3584 : n0 - 4608; dr = 3584 + 256 * (j >> 7) + (j & 127) + (n0 < 4608 ? 0 : 128); }
            transpose_item(p.w_in, INC, (bf16_t*)(ws + WS_WIN), 1024, 0, 64 * kb, n0, dr, scr, lane); continue; } r -= I_IN;
        if (r < I_A) { const int kb = r / 32, nb = r % 32; transpose_item(p.w_a, 1024, (bf16_t*)(ws + WS_WAB), 1024, 0, 64 * kb, 32 * nb, 32 * nb, scr, lane); continue; } r -= I_A;
        if (r < I_A) { const int kb = r / 32, nb = r % 32; transpose_item(p.w_b, 1024, (bf16_t*)(ws + WS_WAB), 1024, 512, 64 * kb, 32 * nb, 32 * nb, scr, lane); continue; } r -= I_A;
        if (r < I_O) { const int kb = r / 32, nb = r % 32; transpose_item(p.w_out, 1024, (bf16_t*)(ws + WS_WO), 1024, 0, 64 * kb, 32 * nb, 32 * nb, scr, lane); continue; } r -= I_O;
        if (r < I_FI) { const int kb = r / 176, nb = r % 176; const int n0 = 32 * nb; const int j0 = n0 < FF ? n0 : n0 - FF;
            transpose_item(p.w_ffn_in, INC, (bf16_t*)(ws + WS_WFI), 1024, 0, 64 * kb, n0, 256 * (j0 >> 7) + (j0 & 127) + (n0 < FF ? 0 : 128), scr, lane); continue; } r -= I_FI;
        { const int kb = r / 32, nb = r % 32; transpose_item(p.w_ffn_out, 1024, (bf16_t*)(ws + WS_WFO), FF, 0, 64 * kb, 32 * nb, 32 * nb, scr, lane); }
    }
    bf16_t* SC = (bf16_t*)(ws + WS_SC);
    for (int i = blockIdx.x * 512 + tid; i < 256 * 1024 / 2; i += gridDim.x * 512) { const int row = (2 * i) >> 10, col = (2 * i) & 1023; float a = 0.f, b = 0.f;
        if (row < NBATCH) { const float* c = row < 2 ? p.c_prompt + row * D : p.c_sample + (row - 2) * D; a = silu(c[col]); b = silu(c[col + 1]); }
        ((unsigned*)SC)[i] = pk2(a, b); }
}

DI float wave_sum(float v) {
#pragma unroll
    for (int o = 1; o < 64; o <<= 1) v += __shfl_xor(v, o);
    return v;
}
DI void phase_norm_mod(const float* xp, const float* xs, const float* nw, const float* mod, int sh_off, int sc_off, bf16_t* H) {
    const int tid = fresh_tid(), lane = tid & 63, wave = __builtin_amdgcn_readfirstlane(tid >> 6);
    const int gw = blockIdx.x * 8 + wave, NGW = gridDim.x * 8;
    for (int r = gw; r < T; r += NGW) {
        const float* xr = r < TP ? xp + (size_t)r * D : xs + (size_t)(r - TP) * D; const float* mb = mod + (size_t)batch_of(r) * 6144;
        f32x4 v[4]; float s = 0.f;
#pragma unroll
        for (int j = 0; j < 4; ++j) { v[j] = *(const f32x4*)(xr + 4 * lane + 256 * j); s += (v[j][0] * v[j][0] + v[j][1] * v[j][1]) + (v[j][2] * v[j][2] + v[j][3] * v[j][3]); }
        const float rstd = __builtin_amdgcn_rsqf(wave_sum(s) * (1.f / D) + EPS);
#pragma unroll
        for (int j = 0; j < 4; ++j) { const int col = 4 * lane + 256 * j; const f32x4 w = *(const f32x4*)(nw + col), sc = *(const f32x4*)(mb + sc_off + col), sh = *(const f32x4*)(mb + sh_off + col);
            const f32x4 h = v[j] * rstd * w * (sc + 1.f) + sh; u32x2 o; o.x = pk2(h[0], h[1]); o.y = pk2(h[2], h[3]);
            *(u32x2*)(H + (size_t)r * D + col) = o; }
    }
}
DI void phase_norm_mod_b(const bf16_t* xb, const float* nw, const float* mod, int sh_off, int sc_off, bf16_t* H, int r_lo = 0, int r_hi = T, int b_lo = 0) {
    const int tid = fresh_tid(), lane = tid & 63, wave = __builtin_amdgcn_readfirstlane(tid >> 6);
    const int gw = ((int)blockIdx.x - b_lo) * 8 + wave, NGW = ((int)gridDim.x - b_lo) * 8;
    for (int r = r_lo + gw; r < r_hi; r += NGW) {
        const bf16_t* xr = xb + (size_t)r * D; const float* mb = mod + (size_t)batch_of(r) * 6144;
        float v[2][8]; float s = 0.f;
#pragma unroll
        for (int j = 0; j < 2; ++j) { const u32x4 x = *(const u32x4*)(xr + 8 * lane + 512 * j);
#pragma unroll
            for (int i = 0; i < 4; ++i) { v[j][2 * i] = bflo(x[i]); v[j][2 * i + 1] = bfhi(x[i]); s += v[j][2 * i] * v[j][2 * i] + v[j][2 * i + 1] * v[j][2 * i + 1]; } }
        const float rstd = __builtin_amdgcn_rsqf(wave_sum(s) * (1.f / D) + EPS);
#pragma unroll
        for (int j = 0; j < 2; ++j) { const int col = 8 * lane + 512 * j; f32x4 h[2];
#pragma unroll
            for (int q = 0; q < 2; ++q) { const f32x4 w = *(const f32x4*)(nw + col + 4 * q), sc = *(const f32x4*)(mb + sc_off + col + 4 * q), sh = *(const f32x4*)(mb + sh_off + col + 4 * q);
                const f32x4 x = {v[j][4 * q], v[j][4 * q + 1], v[j][4 * q + 2], v[j][4 * q + 3]}; h[q] = x * rstd * w * (sc + 1.f) + sh; }
            *(u32x4*)(H + (size_t)r * D + col) = pack_row8(h[0], h[1]); }
    }
}
DI void phase_final_norm(const bf16_t* xb, float* y, const float* nw, int r_lo = 0, int r_hi = T, int b_lo = 0) {
    const int tid = fresh_tid(), lane = tid & 63, wave = __builtin_amdgcn_readfirstlane(tid >> 6);
    const int gw = ((int)blockIdx.x - b_lo) * 8 + wave, NGW = ((int)gridDim.x - b_lo) * 8;
    for (int r = r_lo + gw; r < r_hi; r += NGW) { const bf16_t* xr = xb + (size_t)r * D; float* yr = y + (size_t)r * D;
        float v[2][8]; float s = 0.f;
#pragma unroll
        for (int j = 0; j < 2; ++j) { const u32x4 x = *(const u32x4*)(xr + 8 * lane + 512 * j);
#pragma unroll
            for (int i = 0; i < 4; ++i) { v[j][2 * i] = bflo(x[i]); v[j][2 * i + 1] = bfhi(x[i]); s += v[j][2 * i] * v[j][2 * i] + v[j][2 * i + 1] * v[j][2 * i + 1]; } }
        const float rstd = __builtin_amdgcn_rsqf(wave_sum(s) * (1.f / D) + EPS);
#pragma unroll
        for (int j = 0; j < 2; ++j) { const int col = 8 * lane + 512 * j;
#pragma unroll
            for (int q = 0; q < 2; ++q) { const f32x4 x = {v[j][4 * q], v[j][4 * q + 1], v[j][4 * q + 2], v[j][4 * q + 3]}; *(f32x4*)(yr + col + 4 * q) = x * rstd * *(const f32x4*)(nw + col + 4 * q); } }
    }
}

DI void hgrn_u_item(const Params& p, int item, int lane) {
    const int c = item >> 5, rem = item & 31, h = rem >> 3, kt = (rem >> 1) & 3, vh = rem & 1, l31 = lane & 31, hf = lane >> 5;
    const float* CUM = (const float*)(p.ws + WS_CUM); const bf16_t* KA = (const bf16_t*)(p.ws + WS_KA); const bf16_t* VA = (const bf16_t*)(p.ws + WS_VA); bf16_t* U = (bf16_t*)(p.ws + WS_U);
    const int kcol = h * 128 + 32 * kt + l31;
    const float tot = CUM[(size_t)(c * 64 + 63) * 512 + kcol];
    bf16x8 kdf[2][2];
#pragma unroll
    for (int st = 0; st < 2; ++st) { f32x16 kd;
#pragma unroll
        for (int r = 0; r < 16; ++r) { const size_t idx = (size_t)(c * 64 + 32 * st + crow(r, hf)) * 512 + kcol; kd[r] = bf2f((short)KA[idx]) * __expf(tot - CUM[idx]); }
        kdf[st][0] = pack8(kd, 0); kdf[st][1] = pack8(kd, 1); }
    const bf16x8 id0 = ident_frag(0, l31, hf), id1 = ident_frag(1, l31, hf);
#pragma unroll
    for (int vtl = 0; vtl < 2; ++vtl) { const int vt = 2 * vh + vtl; f32x16 dacc = zero16();
#pragma unroll
        for (int st = 0; st < 2; ++st) { const bf16_t* vp = VA + (size_t)(c * 64 + 32 * st + l31) * 512 + h * 128 + 32 * vt + 8 * hf;
            f32x16 vx = zero16(); vx = MFMA32(*(const bf16x8*)vp, id0, vx); vx = MFMA32(*(const bf16x8*)(vp + 16), id1, vx);
            dacc = MFMA32(kdf[st][0], pack8(vx, 0), dacc); dacc = MFMA32(kdf[st][1], pack8(vx, 1), dacc); }
        bf16_t* up = U + ((size_t)(c * 4 + h) * 128 + 32 * vt + l31) * 128 + 32 * kt + 4 * hf;
#pragma unroll
        for (int g = 0; g < 4; ++g) { u32x2 o; o.x = pk2(dacc[4 * g], dacc[4 * g + 1]); o.y = pk2(dacc[4 * g + 2], dacc[4 * g + 3]); *(u32x2*)(up + 8 * g) = o; }
    }
}

DI void scan_prompt_item(const Params& p, int item, int lane) {
    const int bh = item >> 5, vq = item & 31, b = bh >> 2, h = bh & 3, kg = lane & 31, vv = lane >> 5;
    const float* __restrict__ DEC = (const float*)(p.ws + WS_DEC); const bf16_t* __restrict__ U = (const bf16_t*)(p.ws + WS_U); bf16_t* __restrict__ SST = (bf16_t*)(p.ws + WS_SST);
    f32x4 S0 = {0.f, 0.f, 0.f, 0.f}, S1 = {0.f, 0.f, 0.f, 0.f};
    const int v0 = 4 * vq + vv, v1 = v0 + 2;
#pragma unroll 16
    for (int n = 0; n < 256; ++n) { const int c = b * 256 + n;
        const f32x4 d = *(const f32x4*)(DEC + (size_t)c * 512 + h * 128 + 4 * kg);
        const size_t o0 = ((size_t)(c * 4 + h) * 128 + v0) * 128 + 4 * kg, o1 = ((size_t)(c * 4 + h) * 128 + v1) * 128 + 4 * kg;
        const u32x2 u0 = *(const u32x2*)(U + o0), u1 = *(const u32x2*)(U + o1);
        u32x2 s; s.x = pk2(S0[0], S0[1]); s.y = pk2(S0[2], S0[3]); *(u32x2*)(SST + o0) = s;
        s.x = pk2(S1[0], S1[1]); s.y = pk2(S1[2], S1[3]); *(u32x2*)(SST + o1) = s;
        S0[0] = d[0] * S0[0] + bflo(u0.x); S0[1] = d[1] * S0[1] + bfhi(u0.x); S0[2] = d[2] * S0[2] + bflo(u0.y); S0[3] = d[3] * S0[3] + bfhi(u0.y);
        S1[0] = d[0] * S1[0] + bflo(u1.x); S1[1] = d[1] * S1[1] + bfhi(u1.x); S1[2] = d[2] * S1[2] + bflo(u1.y); S1[3] = d[3] * S1[3] + bfhi(u1.y);
    }
    float* sp = p.out + OFF_SP + ((size_t)bh * 128 + 4 * kg) * 128;
#pragma unroll
    for (int i = 0; i < 4; ++i) { sp[(size_t)i * 128 + v0] = S0[i]; sp[(size_t)i * 128 + v1] = S1[i]; }
}
DI void scan_sample_item(const Params& p, int item, int lane) {
    const int bh = item >> 5, vq = item & 31, bs = bh >> 2, h = bh & 3, kg = lane & 31, vv = lane >> 5, c = 512 + bs;
    const float* DEC = (const float*)(p.ws + WS_DEC); const bf16_t* U = (const bf16_t*)(p.ws + WS_U); bf16_t* SST = (bf16_t*)(p.ws + WS_SST);
    const f32x4 d = *(const f32x4*)(DEC + (size_t)c * 512 + h * 128 + 4 * kg);
    const float* s0 = p.state + ((size_t)bh * 128 + 4 * kg) * 128; float* so = p.out + OFF_SS + ((size_t)bh * 128 + 4 * kg) * 128;
#pragma unroll
    for (int e = 0; e < 2; ++e) { const int v = 4 * vq + 2 * e + vv; const size_t o = ((size_t)(c * 4 + h) * 128 + v) * 128 + 4 * kg;
        const u32x2 u = *(const u32x2*)(U + o); f32x4 S;
#pragma unroll
        for (int i = 0; i < 4; ++i) S[i] = s0[(size_t)i * 128 + v];
        u32x2 s; s.x = pk2(S[0], S[1]); s.y = pk2(S[2], S[3]); *(u32x2*)(SST + o) = s;
        so[v] = d[0] * S[0] + bflo(u.x); so[128 + v] = d[1] * S[1] + bfhi(u.x); so[256 + v] = d[2] * S[2] + bflo(u.y); so[384 + v] = d[3] * S[3] + bfhi(u.y); }
}

DI void attn_item(const Params& p, int item, int lane, const LAS float* biasl, bf16_t* obase = nullptr, int opitch = 1024) {
    const int c = item >> 4, h = (item >> 1) & 7, qh = item & 1, l31 = lane & 31, hf = lane >> 5;
    bf16_t* qptr = (bf16_t*)(p.ws + WS_QOB) + (size_t)(c * 64 + qh * 32 + l31) * 1024 + 512 + h * 64;
    const bf16_t* KB = (const bf16_t*)(p.ws + WS_KB); const bf16_t* VB = (const bf16_t*)(p.ws + WS_VB);
    bf16x8 qf[4];
#pragma unroll
    for (int ks = 0; ks < 4; ++ks) qf[ks] = *(const bf16x8*)(qptr + 16 * ks + 8 * hf);
    const bf16x8 id0 = ident_frag(0, l31, hf), id1 = ident_frag(1, l31, hf);
    const LAS float* bl = biasl + h * 192;
    f32x16 OT0 = zero16(), OT1 = zero16(); float mrun = -1e30f, lsum = 0.f;
    int ntile, ncache, db0; size_t krow_first;
    if (c < 512) { const int n = c & 255, j0 = n < 8 ? n : 8; ntile = 2 * (j0 + 1); ncache = 0; db0 = 64 * j0 + 32 * qh; krow_first = (size_t)(c - j0) * 64; }
    else { ntile = 18; ncache = 16; db0 = 512 + 32 * qh; krow_first = (size_t)c * 64 - 512; }
    const int bs = c - 512;
    u32x4 nk[4], nv[4], nk2[4], nv2[4];
#define ATT_LOAD(i_) do { if ((i_) < ncache) { \
            const float* kp_ = p.cache_k + ((size_t)(bs * 512 + 32 * (i_) + l31) * 8 + h) * 64 + 8 * hf; const float* vp_ = p.cache_v + ((size_t)(bs * 512 + 32 * (i_) + l31) * 8 + h) * 64 + 8 * hf; \
            _Pragma("unroll") for (int ks = 0; ks < 4; ++ks) { nk[ks] = *(const u32x4*)(kp_ + 16 * ks); nk2[ks] = *(const u32x4*)(kp_ + 16 * ks + 4); nv[ks] = *(const u32x4*)(vp_ + 16 * ks); nv2[ks] = *(const u32x4*)(vp_ + 16 * ks + 4); } \
        } else { const size_t ro_ = (krow_first + 32 * (i_) + l31) * 512 + h * 64 + 8 * hf; \
            _Pragma("unroll") for (int ks = 0; ks < 4; ++ks) { nk[ks] = *(const u32x4*)(KB + ro_ + 16 * ks); nv[ks] = *(const u32x4*)(VB + ro_ + 16 * ks); } } } while (0)
    ATT_LOAD(0);
    for (int i = 0; i < ntile; ++i) {
        bf16x8 kf[4], vf[2][2];
        if (i < ncache) {
#pragma unroll
            for (int ks = 0; ks < 4; ++ks) { u32x4 w; const f32x4 a = __builtin_bit_cast(f32x4, nk[ks]), b = __builtin_bit_cast(f32x4, nk2[ks]), e = __builtin_bit_cast(f32x4, nv[ks]), f = __builtin_bit_cast(f32x4, nv2[ks]);
                w.x = pk2(a[0], a[1]); w.y = pk2(a[2], a[3]); w.z = pk2(b[0], b[1]); w.w = pk2(b[2], b[3]); kf[ks] = __builtin_bit_cast(bf16x8, w);
                w.x = pk2(e[0], e[1]); w.y = pk2(e[2], e[3]); w.z = pk2(f[0], f[1]); w.w = pk2(f[2], f[3]); vf[ks >> 1][ks & 1] = __builtin_bit_cast(bf16x8, w); }
        } else {
#pragma unroll
            for (int ks = 0; ks < 4; ++ks) { kf[ks] = __builtin_bit_cast(bf16x8, nk[ks]); vf[ks >> 1][ks & 1] = __builtin_bit_cast(bf16x8, nv[ks]); }
        }
        if (i + 1 < ntile) ATT_LOAD(i + 1);
        f32x16 st = zero16();
#pragma unroll
        for (int ks = 0; ks < 4; ++ks) st = MFMA32(kf[ks], qf[ks], st);
        const int dbase = db0 - 32 * i + l31; float mt = -1e30f;
        if (db0 - 32 * i - 31 >= 128) { const float bc = bl[191];
#pragma unroll
            for (int r = 0; r < 16; ++r) { const float s = st[r] * (0.125f * LOG2E) + bc; st[r] = s; mt = fmaxf(mt, s); }
        } else {
#pragma unroll
            for (int r = 0; r < 16; ++r) { int dist = dbase - crow(r, hf); dist = dist > 128 ? 128 : dist; const float s = st[r] * (0.125f * LOG2E) + bl[dist + 63]; st[r] = s; mt = fmaxf(mt, s); }
        }
        mt = fmaxf(mt, __shfl_xor(mt, 32));
        const float mnew = fmaxf(mrun, mt), alpha = __builtin_amdgcn_exp2f(mrun - mnew); mrun = mnew;
        float ps = 0.f;
#pragma unroll
        for (int r = 0; r < 16; ++r) { st[r] = __builtin_amdgcn_exp2f(st[r] - mnew); ps += st[r]; }
        lsum = lsum * alpha + ps;
#pragma unroll
        for (int r = 0; r < 16; ++r) { OT0[r] *= alpha; OT1[r] *= alpha; }
        const bf16x8 pf0 = pack8(st, 0), pf1 = pack8(st, 1);
        { f32x16 vx = zero16(); vx = MFMA32(vf[0][0], id0, vx); vx = MFMA32(vf[0][1], id1, vx); OT0 = MFMA32(pack8(vx, 0), pf0, OT0); OT0 = MFMA32(pack8(vx, 1), pf1, OT0); }
        { f32x16 vx = zero16(); vx = MFMA32(vf[1][0], id0, vx); vx = MFMA32(vf[1][1], id1, vx); OT1 = MFMA32(pack8(vx, 0), pf0, OT1); OT1 = MFMA32(pack8(vx, 1), pf1, OT1); }
    }
    lsum += __shfl_xor(lsum, 32); const float inv = 1.f / lsum;
    if (obase) qptr = obase + (size_t)(c * 64 + qh * 32 + l31) * opitch + h * 64;
#pragma unroll
    for (int g = 0; g < 4; ++g) { u32x2 o; o.x = pk2(OT0[4 * g] * inv, OT0[4 * g + 1] * inv); o.y = pk2(OT0[4 * g + 2] * inv, OT0[4 * g + 3] * inv); *(u32x2*)(qptr + 8 * g + 4 * hf) = o;
        o.x = pk2(OT1[4 * g] * inv, OT1[4 * g + 1] * inv); o.y = pk2(OT1[4 * g + 2] * inv, OT1[4 * g + 3] * inv); *(u32x2*)(qptr + 32 + 8 * g + 4 * hf) = o; }
}

DI void hgrn_out_item(const Params& p, int item, int lane, bf16_t* obase = nullptr) {
    const int c = item >> 3, h = (item >> 1) & 3, tt = item & 1, l31 = lane & 31, hf = lane >> 5;
    const float* CUM = (const float*)(p.ws + WS_CUM); const bf16_t* KA = (const bf16_t*)(p.ws + WS_KA); const bf16_t* VA = (const bf16_t*)(p.ws + WS_VA);
    const bf16_t* GA = (const bf16_t*)(p.ws + WS_GA); const bf16_t* SST = (const bf16_t*)(p.ws + WS_SST);
    const int trow = c * 64 + 32 * tt + l31;
    bf16_t* qap = (bf16_t*)(p.ws + WS_QOB) + (size_t)trow * 1024 + h * 128;
    const float* cumt = CUM + (size_t)trow * 512 + h * 128; const float* refp = CUM + (size_t)(c * 64 + 32) * 512 + h * 128;
    bf16x8 qd1[8], qd2[8];
#pragma unroll
    for (int ks = 0; ks < 8; ++ks) { const int k0 = 16 * ks + 8 * hf; const bf16x8 q8 = *(const bf16x8*)(qap + k0);
        const f32x4 c0 = *(const f32x4*)(cumt + k0), c1 = *(const f32x4*)(cumt + k0 + 4), r0 = *(const f32x4*)(refp + k0), r1 = *(const f32x4*)(refp + k0 + 4);
        float a[8], b[8];
#pragma unroll
        for (int j = 0; j < 8; ++j) { const float q = bf2f(q8[j]), cu = j < 4 ? c0[j & 3] : c1[j & 3], rf = j < 4 ? r0[j & 3] : r1[j & 3]; a[j] = q * __expf(cu - rf); b[j] = q * __expf(cu); }
        qd1[ks] = pack8f(a); qd2[ks] = pack8f(b); }
    f32x16 OT[4];
#pragma unroll
    for (int vt = 0; vt < 4; ++vt) OT[vt] = zero16();
    const bf16_t* sp = SST + ((size_t)(c * 4 + h) * 128 + l31) * 128 + 8 * hf;
#pragma unroll
    for (int vt = 0; vt < 4; ++vt)
#pragma unroll
        for (int ks = 0; ks < 8; ++ks) OT[vt] = MFMA32(*(const bf16x8*)(sp + (size_t)vt * 32 * 128 + 16 * ks), qd2[ks], OT[vt]);
    const bf16x8 id0 = ident_frag(0, l31, hf), id1 = ident_frag(1, l31, hf);
    for (int st = 0; st <= tt; ++st) {
        const int srow = c * 64 + 32 * st + l31; const bf16_t* kap = KA + (size_t)srow * 512 + h * 128; const float* cums = CUM + (size_t)srow * 512 + h * 128;
        f32x16 X = zero16();
#pragma unroll
        for (int ks = 0; ks < 8; ++ks) { const int k0 = 16 * ks + 8 * hf; const bf16x8 k8 = *(const bf16x8*)(kap + k0);
            const f32x4 c0 = *(const f32x4*)(cums + k0), c1 = *(const f32x4*)(cums + k0 + 4), r0 = *(const f32x4*)(refp + k0), r1 = *(const f32x4*)(refp + k0 + 4);
            float a[8];
#pragma unroll
            for (int j = 0; j < 8; ++j) { const float cu = j < 4 ? c0[j & 3] : c1[j & 3], rf = j < 4 ? r0[j & 3] : r1[j & 3]; a[j] = bf2f(k8[j]) * __expf(rf - cu); }
            X = MFMA32(pack8f(a), qd1[ks], X); }
        if (st == tt) {
#pragma unroll
            for (int r = 0; r < 16; ++r) if (crow(r, hf) > l31) X[r] = 0.f; }
        const bf16x8 xf0 = pack8(X, 0), xf1 = pack8(X, 1);
        const bf16_t* vp = VA + (size_t)srow * 512 + h * 128 + 8 * hf;
#pragma unroll
        for (int vt = 0; vt < 4; ++vt) { f32x16 vx = zero16(); vx = MFMA32(*(const bf16x8*)(vp + 32 * vt), id0, vx); vx = MFMA32(*(const bf16x8*)(vp + 32 * vt + 16), id1, vx);
            OT[vt] = MFMA32(pack8(vx, 0), xf0, OT[vt]); OT[vt] = MFMA32(pack8(vx, 1), xf1, OT[vt]); }
    }
    float ss = 0.f;
#pragma unroll
    for (int vt = 0; vt < 4; ++vt)
#pragma unroll
        for (int r = 0; r < 16; ++r) ss += OT[vt][r] * OT[vt][r];
    ss += __shfl_xor(ss, 32);
    const float rstd = __builtin_amdgcn_rsqf(ss * (1.f / 128.f) + EPS);
    const bf16_t* gap = GA + (size_t)trow * 512 + h * 128; const float* onp = p.out_norm + h * 128;
    if (obase) qap = obase + (size_t)trow * 512 + h * 128;
#pragma unroll
    for (int vt = 0; vt < 4; ++vt)
#pragma unroll
        for (int g = 0; g < 4; ++g) { const int v0 = 32 * vt + 8 * g + 4 * hf; const f32x4 on = *(const f32x4*)(onp + v0); const u32x2 ga = *(const u32x2*)(gap + v0);
            u32x2 o; o.x = pk2(OT[vt][4 * g] * rstd * on[0] * bflo(ga.x), OT[vt][4 * g + 1] * rstd * on[1] * bfhi(ga.x));
            o.y = pk2(OT[vt][4 * g + 2] * rstd * on[2] * bflo(ga.y), OT[vt][4 * g + 3] * rstd * on[3] * bfhi(ga.y)); *(u32x2*)(qap + v0) = o; }
}


#define XB_TMO      128
#define XB_XCNT(j)  (256  + 64 * (j))
#define XB_XSUB(j)  (1280 + 64 * (j))
#define XB_XGEN(j)  (2304 + 64 * (j))
#define XB_TOP      3328
#define XB_TOPGEN   3392
#define XCD_BAR_WORDS 3456
#define XB_SPIN_CAP (1u << 18)
DI unsigned xb_ld(unsigned* p)              { return __hip_atomic_load(p, __ATOMIC_RELAXED, __HIP_MEMORY_SCOPE_AGENT); }
DI unsigned xb_add(unsigned* p, unsigned v) { return __hip_atomic_fetch_add(p, v, __ATOMIC_RELAXED, __HIP_MEMORY_SCOPE_AGENT); }
DI unsigned xb_xcc_id() { return (unsigned)__builtin_amdgcn_s_getreg((3 << 11) | 20) & 0xFu; }
#define XB_SPIN(cond, bar) do { unsigned _sp = 0; while (cond) { __builtin_amdgcn_s_sleep(1); \
    if ((++_sp & 255u) == 0u) { if (xb_ld(&(bar)[XB_TMO])) break; if (_sp > XB_SPIN_CAP) { atomicAdd(&(bar)[XB_TMO], 1u); break; } } } } while (0)
struct XcdBarrier { unsigned* bar; unsigned x; volatile LAS unsigned* st; };
DI XcdBarrier xcd_barrier_post(unsigned* bar, volatile LAS unsigned* st) {
    XcdBarrier b; b.bar = bar; b.x = xb_xcc_id(); b.st = st;
    if (threadIdx.x == 0) (void)xb_add(&bar[XB_XCNT(b.x)], 1u);
    return b;
}
DI void xcd_barrier_complete(unsigned* bar, unsigned x, unsigned& nloc, unsigned& nx) {
    const unsigned G = gridDim.x * gridDim.y * gridDim.z;
    unsigned sum, cnt, mine, sp = 0u;
    for (;;) {
        sum = 0u; cnt = 0u; mine = 0u;
#pragma unroll
        for (unsigned j = 0; j < 16; ++j) { const unsigned c = xb_ld(&bar[XB_XCNT(j)]); sum += c; cnt += (c > 0u) ? 1u : 0u; mine = (j == x) ? c : mine; }
        if (sum == G) break;
        __builtin_amdgcn_s_sleep(1);
        if ((++sp & 255u) == 0u) { if (xb_ld(&bar[XB_TMO])) break; if (sp > XB_SPIN_CAP) { atomicAdd(&bar[XB_TMO], 1u); break; } }
    }
    nloc = mine > 0u ? mine : 1u; nx = cnt > 0u ? cnt : 1u;
}
DI void xcd_barrier(const XcdBarrier& b) {
    asm volatile("s_waitcnt vmcnt(0)" ::: "memory");
    __syncthreads();
    if (threadIdx.x == 0) {
        unsigned* bar = b.bar;
        __builtin_amdgcn_s_waitcnt(0);
        unsigned nloc = b.st[0], nx = b.st[1];
        if (nloc == 0u) { xcd_barrier_complete(bar, b.x, nloc, nx); b.st[0] = nloc; b.st[1] = nx; }
        const unsigned old = xb_add(&bar[XB_XSUB(b.x)], 1u);
        const unsigned gen = old / nloc;
        if (old + 1u == (gen + 1u) * nloc) {
            __builtin_amdgcn_fence(__ATOMIC_RELEASE, "agent");
            asm volatile("s_waitcnt vmcnt(0)" ::: "memory");
            const unsigned og = xb_add(&bar[XB_TOP], 1u);
            const unsigned tg = og / nx;
            if (og + 1u == (tg + 1u) * nx) xb_add(&bar[XB_TOPGEN], 1u);
            else XB_SPIN(xb_ld(&bar[XB_TOPGEN]) == tg, bar);
            __builtin_amdgcn_fence(__ATOMIC_ACQUIRE, "agent");
            xb_add(&bar[XB_XGEN(b.x)], 1u);
            asm volatile("s_waitcnt vmcnt(0)" ::: "memory");
        } else {
            XB_SPIN(xb_ld(&bar[XB_XGEN(b.x)]) == gen, bar);
            __builtin_amdgcn_fence(__ATOMIC_ACQUIRE, "agent");
            asm volatile("s_waitcnt vmcnt(0)" ::: "memory");
        }
    }
    __syncthreads();
}

__global__ void __launch_bounds__(512, 2) fwd_megakernel(Params p) {
    extern __shared__ __attribute__((aligned(16))) unsigned char lds_raw[];
    LAS unsigned char* lds = (LAS unsigned char*)lds_raw;
    cg::grid_group grid = cg::this_grid();
    const int G = gridDim.x, bx = blockIdx.x;
    volatile LAS unsigned* bst = (volatile LAS unsigned*)(lds + LDS_ST_OFF);
    if (threadIdx.x < 2) bst[threadIdx.x] = 0u;
    __syncthreads();
    const XcdBarrier xbar = xcd_barrier_post((unsigned*)(p.ws + WS_BAR), bst);
#define GRID_BAR() xcd_barrier(xbar)
    unsigned char* ws = p.ws;
    float* MOD = (float*)(ws + WS_MOD); bf16_t* H = (bf16_t*)(ws + WS_H);

    phase_prep(p, lds);
    grid.sync();
    { pg8::Gemm g{(const bf16_t*)(ws + WS_SC), (const bf16_t*)(ws + WS_WADA), 256, 6144, 1024}; pg8::StaticOrder S; S.init(256, 6144, G, bx);
      EpiMod E{MOD, p.b_ada}; pg8::gemm_phase<EpiMod, pg8::StaticOrder, true, true>(lds, g, S, E); }
    GRID_BAR();
    phase_norm_mod(p.x_prompt, p.x_sample, p.norm_mix, MOD, 0, 1024, H);
#if PROBE_DUP == 1
    GRID_BAR(); phase_norm_mod(p.x_prompt, p.x_sample, p.norm_mix, MOD, 0, 1024, H);
#endif
#if PROBE_DUP == 10
    GRID_BAR(); GRID_BAR(); GRID_BAR(); GRID_BAR(); GRID_BAR(); GRID_BAR(); GRID_BAR(); GRID_BAR(); GRID_BAR(); GRID_BAR();
#endif
    GRID_BAR();
    { pg8::Gemm g{H, (const bf16_t*)(ws + WS_WIN), T, INC, 1024}; pg8::StaticOrder S; S.init(T, INC, G, bx);
      EpiIn E{(bf16_t*)(ws + WS_QOB), (bf16_t*)(ws + WS_KA), (bf16_t*)(ws + WS_VA), (bf16_t*)(ws + WS_GA), (bf16_t*)(ws + WS_KB), (bf16_t*)(ws + WS_VB),
              (bf16_t*)(p.out), (bf16_t*)(p.out) + (size_t)T * 1024, (float*)(ws + WS_CUM), (float*)(ws + WS_DEC), p.lb_logits, p.out};
      pg8::gemm_phase<EpiIn, pg8::StaticOrder, true, true>(lds, g, S, E);
#if PROBE_DUP == 2
      GRID_BAR(); pg8::gemm_phase<EpiIn, pg8::StaticOrder, true, true>(lds, g, S, E);
#endif
    }
    GRID_BAR();
    { const int tid = fresh_tid(), lane = tid & 63, wave = __builtin_amdgcn_readfirstlane(tid >> 6);
      for (int it = wave * G + bx; it < NCH * 32; it += 8 * G) hgrn_u_item(p, it, lane);
#if PROBE_DUP == 3
      for (int it = wave * G + bx; it < NCH * 32; it += 8 * G) hgrn_u_item(p, it, lane);
#endif
    }
    GRID_BAR();
    {
        const int tid = fresh_tid(), lane = tid & 63, wave = __builtin_amdgcn_readfirstlane(tid >> 6);
        LAS float* biasl = (LAS float*)lds;
        for (int i = tid; i < 8 * 192; i += 512) biasl[i] = p.rel_bias[i] * LOG2E;
        __syncthreads();
#if PROBE_DUP == 4
        if (wave != 0) { const int gw = (wave - 1) * G + bx, NGW = 7 * G; for (int it = gw; it < NCH * 16; it += NGW) attn_item(p, it, lane, biasl, (bf16_t*)(ws + WS_SST), 512); }
        GRID_BAR();
#endif
#if PROBE_DUP == 41
        if (wave == 0) { for (int it = bx; it < 256; it += G) scan_prompt_item(p, it, lane); }
        GRID_BAR();
#endif
        if (wave == 0) { for (int it = bx; it < 256; it += G) scan_prompt_item(p, it, lane); }
        else {
            const int gw = (wave - 1) * G + bx, NGW = 7 * G;
            for (int it = gw; it < 4096; it += NGW) scan_sample_item(p, it, lane);
            for (int it = gw; it < NCH * 16; it += NGW) attn_item(p, it, lane, biasl);
        }
    }
    GRID_BAR();
    { const int tid = fresh_tid(), lane = tid & 63, wave = __builtin_amdgcn_readfirstlane(tid >> 6);
#if PROBE_DUP == 5
      for (int it = wave * G + bx; it < NCH * 8; it += 8 * G) hgrn_out_item(p, it, lane, (bf16_t*)(ws + WS_U));
      GRID_BAR();
#endif
      for (int it = wave * G + bx; it < NCH * 8; it += 8 * G) hgrn_out_item(p, it, lane); }
    GRID_BAR();
    { pg8::Gemm g{(const bf16_t*)(ws + WS_QOB), (const bf16_t*)(ws + WS_WAB), T, 1024, 1024}; pg8::StaticOrder S; S.init(T, 1024, G, bx);
      EpiMerge E{(const bf16_t*)(p.out), (const bf16_t*)(p.out) + (size_t)T * 1024, (bf16_t*)(ws + WS_M)};
      pg8::gemm_phase<EpiMerge, pg8::StaticOrder, true, true>(lds, g, S, E); }
    GRID_BAR();
    const bool split_ps = G >= 64;
    { pg8::Gemm g{(const bf16_t*)(ws + WS_M), (const bf16_t*)(ws + WS_WO), T, 1024, 1024}; EpiRes<false> E{p.x_prompt, p.x_sample, nullptr, (bf16_t*)(ws + WS_X1B), MOD + 2048};
      if (split_ps) {
        { pg8::StaticOrder S; S.init(TP, 1024, G, bx); pg8::gemm_phase<EpiRes<false>, pg8::StaticOrder, true, true>(lds, g, S, E); }
        GRID_BAR();
        if (bx < 32) { pg8::StaticOrder S; S.init(TS, 1024, 32, bx, TP / 256); pg8::gemm_phase<EpiRes<false>, pg8::StaticOrder, true, true>(lds, g, S, E); }
        else phase_norm_mod_b((const bf16_t*)(ws + WS_X1B), p.norm_ffn, MOD, 3072, 4096, H, 0, TP, 32);
        GRID_BAR();
        phase_norm_mod_b((const bf16_t*)(ws + WS_X1B), p.norm_ffn, MOD, 3072, 4096, H, TP, T, 0);
      } else {
        pg8::StaticOrder S; S.init(T, 1024, G, bx); pg8::gemm_phase<EpiRes<false>, pg8::StaticOrder, true, true>(lds, g, S, E);
        GRID_BAR();
        phase_norm_mod_b((const bf16_t*)(ws + WS_X1B), p.norm_ffn, MOD, 3072, 4096, H);
      } }
    GRID_BAR();
    { pg8::Gemm g{H, (const bf16_t*)(ws + WS_WFI), T, INC, 1024}; pg8::StaticOrder S; S.init(T, INC, G, bx);
      EpiFfnIn E{(bf16_t*)(ws + WS_HID)}; pg8::gemm_phase<EpiFfnIn, pg8::StaticOrder, true, true>(lds, g, S, E);
#if PROBE_DUP == 9
      GRID_BAR(); pg8::gemm_phase<EpiFfnIn, pg8::StaticOrder, true, true>(lds, g, S, E);
#endif
    }
    GRID_BAR();
    { pg8::Gemm g{(const bf16_t*)(ws + WS_HID), (const bf16_t*)(ws + WS_WFO), T, 1024, FF}; EpiRes<true> E{nullptr, nullptr, (const bf16_t*)(ws + WS_X1B), (bf16_t*)(ws + WS_X2B), MOD + 5120};
      if (split_ps) {
        { pg8::StaticOrder S; S.init(TP, 1024, G, bx); pg8::gemm_phase<EpiRes<true>, pg8::StaticOrder, true, true>(lds, g, S, E); }
        GRID_BAR();
        if (bx < 32) { pg8::StaticOrder S; S.init(TS, 1024, 32, bx, TP / 256); pg8::gemm_phase<EpiRes<true>, pg8::StaticOrder, true, true>(lds, g, S, E); }
        else phase_final_norm((const bf16_t*)(ws + WS_X2B), p.out, p.norm_final, 0, TP, 32);
        GRID_BAR();
        phase_final_norm((const bf16_t*)(ws + WS_X2B), p.out, p.norm_final, TP, T, 0);
      } else {
        pg8::StaticOrder S; S.init(T, 1024, G, bx); pg8::gemm_phase<EpiRes<true>, pg8::StaticOrder, true, true>(lds, g, S, E);
        GRID_BAR();
        phase_final_norm((const bf16_t*)(ws + WS_X2B), p.out, p.norm_final);
      } }
}

extern "C" void kernel_launch(void* const* d_in, const int* in_sizes, int n_in, void* d_out, int out_size, void* d_ws, size_t ws_size, hipStream_t stream) {
    static int grid = 0;
    if (grid == 0) {
        if (n_in != 21 || (size_t)out_size != OUT_TOTAL || ws_size < WS_END) { fprintf(stderr, "kernel_launch: unexpected sizes n_in %d out %d ws %zu\n", n_in, out_size, ws_size); grid = -1; return; }
        int dev = 0, cus = 0, per = 0;
        (void)hipGetDevice(&dev); (void)hipDeviceGetAttribute(&cus, hipDeviceAttributeMultiprocessorCount, dev);
        (void)hipFuncSetAttribute((const void*)fwd_megakernel, hipFuncAttributeMaxDynamicSharedMemorySize, LDS_BYTES);
        (void)hipOccupancyMaxActiveBlocksPerMultiprocessor(&per, (const void*)fwd_megakernel, 512, LDS_BYTES);
        if (per < 1) per = 1;
        grid = cus * per; fprintf(stderr, "kernel_launch: grid %d (cus %d x %d)\n", grid, cus, per);
    }
    if (grid < 0) return;
    if (hipMemsetAsync((char*)d_ws + WS_BAR, 0, BAR_BYTES, stream) != hipSuccess) { fprintf(stderr, "kernel_launch: memset failed\n"); return; }
    Params p{};
    const float** f = (const float**)&p;
    for (int i = 0; i < 21; ++i) f[i] = (const float*)d_in[i];
    p.out = (float*)d_out; p.ws = (unsigned char*)d_ws;
    void* args[] = {&p};
    hipError_t e = hipLaunchCooperativeKernel((const void*)fwd_megakernel, dim3(grid), dim3(512), args, LDS_BYTES, stream);
    if (e != hipSuccess) fprintf(stderr, "cooperative launch failed: %s (grid %d)\n", hipGetErrorString(e), grid);
}
```

```cpp
#include <hip/hip_runtime.h>
#include <hip/hip_cooperative_groups.h>
#include <cstdio>
#include <cstdint>
namespace cg = cooperative_groups;
#ifndef PROBE_DUP
#define PROBE_DUP 0
#endif

#define DI __device__ __forceinline__
#define LAS __attribute__((address_space(3)))
typedef unsigned short bf16_t;
typedef short bf16x8 __attribute__((ext_vector_type(8)));
typedef float f32x4 __attribute__((ext_vector_type(4)));
typedef float f32x2 __attribute__((ext_vector_type(2)));
typedef float f32x16 __attribute__((ext_vector_type(16)));
typedef unsigned u32x4 __attribute__((ext_vector_type(4)));
typedef unsigned u32x2 __attribute__((ext_vector_type(2)));
typedef __bf16 bf2_t __attribute__((ext_vector_type(2)));

constexpr int D = 1024, TP = 32768, TS = 2048, T = TP + TS, NCH = T / 64, NBATCH = 34;
constexpr int INC = 5632, FF = 2816;
constexpr float EPS = 1e-6f, LOG2E = 1.4426950408889634f;
constexpr size_t OFF_Y = 0, OFF_SP = (size_t)T * D, OFF_KP = OFF_SP + 131072, OFF_VP = OFF_KP + 524288, OFF_SS = OFF_VP + 524288,
                 OFF_KS = OFF_SS + 2097152, OFF_VS = OFF_KS + 1048576, OUT_TOTAL = OFF_VS + 1048576;
constexpr size_t MiB = 1u << 20;
constexpr size_t WS_MOD = 1 * MiB, WS_DEC = 2 * MiB, WS_SC = 4 * MiB, WS_WADA = 5 * MiB, WS_WIN = 17 * MiB, WS_WAB = 28 * MiB, WS_WO = 30 * MiB,
                 WS_WFI = 32 * MiB, WS_WFO = 43 * MiB, WS_H = 50 * MiB, WS_QOB = 118 * MiB, WS_KA = 186 * MiB, WS_VA = 220 * MiB, WS_GA = 254 * MiB,
                 WS_KB = 288 * MiB, WS_VB = 322 * MiB, WS_CUM = 356 * MiB, WS_SST = 424 * MiB, WS_END = 492 * MiB;
constexpr size_t WS_U = WS_H, WS_M = WS_KA, WS_HID = WS_KA, WS_X1B = WS_QOB, WS_X2B = WS_H;
constexpr size_t WS_BAR = 0, BAR_BYTES = 16384;
constexpr int LDS_BYTES = 140 * 1024, LDS_ST_OFF = 136 * 1024;

struct Params {
    const float *x_prompt, *x_sample, *c_prompt, *c_sample, *state, *cache_k, *cache_v, *w_ada, *b_ada, *norm_mix, *w_in, *lb_logits, *out_norm,
                *w_a, *rel_bias, *w_b, *w_out, *norm_ffn, *w_ffn_in, *w_ffn_out, *norm_final;
    float* out; unsigned char* ws;
};

DI int fresh_tid() { int t = threadIdx.x; asm volatile("" : "+v"(t)); return t; }
DI int launder(int v) { asm volatile("" : "+v"(v)); return v; }
DI unsigned pk2(float a, float b) { f32x2 v = {a, b}; bf2_t r = __builtin_convertvector(v, bf2_t); return __builtin_bit_cast(unsigned, r); }
DI float bflo(unsigned u) { return __uint_as_float(u << 16); }
DI float bfhi(unsigned u) { return __uint_as_float(u & 0xffff0000u); }
DI float bf2f(short s) { return __uint_as_float(((unsigned)(unsigned short)s) << 16); }
DI float sigm(float x) { return __builtin_amdgcn_rcpf(1.f + __expf(-x)); }
DI float silu(float x) { return x * sigm(x); }
DI int batch_of(int r) { return r < TP ? (r >> 14) : 2 + ((r - TP) >> 6); }
DI int crow(int reg, int h) { return (reg & 3) + 8 * (reg >> 2) + 4 * h; }
DI bf16x8 pack8(const f32x16& x, int s) {
    u32x4 p; p.x = pk2(x[8 * s], x[8 * s + 1]); p.y = pk2(x[8 * s + 2], x[8 * s + 3]); p.z = pk2(x[8 * s + 4], x[8 * s + 5]); p.w = pk2(x[8 * s + 6], x[8 * s + 7]);
    return __builtin_bit_cast(bf16x8, p);
}
DI bf16x8 pack8f(const float* v) { u32x4 p; p.x = pk2(v[0], v[1]); p.y = pk2(v[2], v[3]); p.z = pk2(v[4], v[5]); p.w = pk2(v[6], v[7]); return __builtin_bit_cast(bf16x8, p); }
DI bf16x8 ident_frag(int ks, int l31, int hf) {
    const int jj = l31 - 16 * ks - 8 * hf; bf16x8 r;
#pragma unroll
    for (int j = 0; j < 8; ++j) r[j] = (j == jj) ? (short)0x3F80 : (short)0;
    return r;
}
#define MFMA32(a, b, c) __builtin_amdgcn_mfma_f32_32x32x16_bf16((a), (b), (c), 0, 0, 0)
DI f32x16 zero16() { f32x16 z;
#pragma unroll
    for (int i = 0; i < 16; ++i) z[i] = 0.f; return z; }

namespace pg8 {
constexpr int BM = 256, BK = 64, HALF = 128, HTB = HALF * BK * 2, STAGE_BYTES = 8 * HTB, NXCD = 8, WGM = 8;
__host__ __device__ __forceinline__ int lds_byte(int r, int c) { const int st = (r >> 4) * 2 + (c >> 5), rr = r & 15, cc = c & 31, ob = rr * 64 + cc * 2; return st * 1024 + (ob ^ (((ob >> 9) & 1) << 5)); }
__host__ __device__ __forceinline__ void stage_rc(int b, int& R, int& C) { const int st = b / 1024, sb = b % 1024, swz = sb ^ (((sb >> 9) & 1) << 5); R = (st >> 1) * 16 + swz / 64; C = (st & 1) * 32 + (swz % 64) / 2; }
__host__ __device__ __forceinline__ int perm32(int rho) { const int n = rho >> 4, i = rho & 15; return 8 * (i >> 2) + 4 * n + (i & 3); }
struct Unit { int pm, pn; };
struct Gemm { const bf16_t* A; const bf16_t* Bt; int M, N, K, ld; };
struct StaticOrder {
    int nM, nN, nwg, G, c, pm_off;
    __device__ void init(int M, int N, int G_, int c_, int pm_off_ = 0) { nM = M / BM; nN = N / BM; nwg = nM * nN; G = G_; c = c_; pm_off = pm_off_; }
    __device__ bool next(int i, Unit& u) const {
        const long L = (long)i * G + c; if (L >= nwg) return false;
        int wgid = (int)L; { const int q = nwg / NXCD, r = nwg % NXCD, xcd = wgid % NXCD, off = wgid / NXCD; wgid = (xcd < r ? xcd * (q + 1) : r * (q + 1) + (xcd - r) * q) + off; }
        const int nig = WGM * nN, gid = wgid / nig, fm = gid * WGM, gsz = (nM - fm) < WGM ? (nM - fm) : WGM;
        u.pm = pm_off + fm + ((wgid % nig) % gsz); u.pn = (wgid % nig) / gsz; return true;
    }
};
template <class Epi, class Sched, bool ALIGN_EPI = false, bool SP2 = false>
__device__ __forceinline__ void gemm_phase(LAS unsigned char* lds, const Gemm g, const Sched& S, const Epi& E) {
    const int tid = fresh_tid(), wid = __builtin_amdgcn_readfirstlane(tid >> 6), lane = tid & 63, wr = wid >> 2, wc = wid & 3, fr = lane & 15, fq = lane >> 4;
    const int K = g.ld ? g.ld : g.K, nt = g.K / BK;
    unsigned voffA[2], voffB[2];
#pragma unroll
    for (int i = 0; i < 2; ++i) { int R, C; stage_rc(tid * 16 + i * 8192, R, C); const int Rb = Epi::PERM ? ((R & ~31) + perm32(R & 31)) : R;
        voffA[i] = (unsigned)(R * K + C) * 2u; voffB[i] = (unsigned)(Rb * K + C) * 2u; }
    const size_t kstep = (size_t)(BK * 2);
    const size_t hstep = (size_t)HALF * K * 2;
    const size_t tstep = 2 * hstep;
    const unsigned ldsw = (unsigned)wid * 1024u;
    const int aoff = lds_byte(wr * 64 + fr, fq * 8), boff = lds_byte(wc * 32 + fr, fq * 8);
#define PG8_SA(b, h) (((b) * 2 + (h)) * HTB)
#define PG8_SB(b, h) ((4 + (b) * 2 + (h)) * HTB)
#define PG8_STAGE(bufoff, gbase, voff) do { _Pragma("unroll") for (int _i = 0; _i < 2; ++_i) \
        __builtin_amdgcn_global_load_lds((const unsigned*)((const char*)(gbase) + (voff)[_i]), (LAS unsigned*)(lds + (bufoff) + ldsw + _i * 8192), 16, 0, 0); } while (0)
#define PG8_LDA(dst, b, h) do { _Pragma("unroll") for (int m = 0; m < 4; ++m) _Pragma("unroll") for (int k = 0; k < 2; ++k) dst[m][k] = *(const LAS bf16x8*)(lds + PG8_SA(b, h) + aoff + m * 2048 + k * 1024); } while (0)
#define PG8_LDB(dst, b, h) do { _Pragma("unroll") for (int n = 0; n < 2; ++n) _Pragma("unroll") for (int k = 0; k < 2; ++k) dst[n][k] = *(const LAS bf16x8*)(lds + PG8_SB(b, h) + boff + n * 2048 + k * 1024); } while (0)
#define PG8_MMA(ai, bj, At, Bt) do { __builtin_amdgcn_s_setprio(1); _Pragma("unroll") for (int m = 0; m < 4; ++m) _Pragma("unroll") for (int n = 0; n < 2; ++n) _Pragma("unroll") for (int k = 0; k < 2; ++k) \
        acc[ai][bj][m][n] = __builtin_amdgcn_mfma_f32_16x16x32_bf16(Bt[n][k], At[m][k], acc[ai][bj][m][n], 0, 0, 0); __builtin_amdgcn_s_setprio(0); } while (0)
#define PG8_WAIT_V(n) asm volatile("s_waitcnt vmcnt(" #n ")" ::: "memory")
#define PG8_WAIT_L(n) asm volatile("s_waitcnt lgkmcnt(" #n ")" ::: "memory")
#define PG8_BAR __builtin_amdgcn_s_barrier()
#define PG8_SCHED __builtin_amdgcn_sched_barrier(0)
    Unit cur, nxt; int ui = 0;
    if (!S.next(0, cur)) return;
    f32x4 acc[2][2][4][2];
#pragma unroll
    for (int a = 0; a < 2; ++a)
#pragma unroll
        for (int b = 0; b < 2; ++b)
#pragma unroll
            for (int m = 0; m < 4; ++m)
#pragma unroll
                for (int n = 0; n < 2; ++n) acc[a][b][m][n] = (f32x4){0.f, 0.f, 0.f, 0.f};
    bf16x8 At[4][2], B0[2][2], B1[2][2];
    const char* cA = (const char*)g.A + (size_t)cur.pm * tstep; const char* cB = (const char*)g.Bt + (size_t)cur.pn * tstep;
    if constexpr (SP2) {
        PG8_STAGE(PG8_SB(0, 0), cB, voffB); PG8_STAGE(PG8_SB(0, 1), cB + hstep, voffB); PG8_STAGE(PG8_SA(0, 0), cA, voffA); PG8_STAGE(PG8_SA(0, 1), cA + hstep, voffA);
        if (wr == 1) PG8_BAR;
        PG8_WAIT_V(2); PG8_BAR;
        PG8_STAGE(PG8_SB(1, 0), cB + kstep, voffB); PG8_STAGE(PG8_SA(1, 0), cA + kstep, voffA); PG8_STAGE(PG8_SB(1, 1), cB + hstep + kstep, voffB);
        PG8_WAIT_V(6); PG8_BAR;
    } else {
        PG8_STAGE(PG8_SB(0, 0), cB, voffB); PG8_STAGE(PG8_SA(0, 0), cA, voffA); PG8_STAGE(PG8_SB(0, 1), cB + hstep, voffB); PG8_STAGE(PG8_SA(0, 1), cA + hstep, voffA);
        if (wr == 1) PG8_BAR;
        PG8_WAIT_V(4); PG8_BAR;
        PG8_STAGE(PG8_SB(1, 0), cB + kstep, voffB); PG8_STAGE(PG8_SA(1, 0), cA + kstep, voffA); PG8_STAGE(PG8_SB(1, 1), cB + hstep + kstep, voffB);
        PG8_WAIT_V(6); PG8_BAR;
    }
    for (;;) {
        const bool has_next = S.next(ui + 1, nxt);
        const char* nA = has_next ? (const char*)g.A + (size_t)nxt.pm * tstep : cA; const char* nB = has_next ? (const char*)g.Bt + (size_t)nxt.pn * tstep : cB;
        for (int t = 0; t < nt; t += 2) {
            if constexpr (Epi::MIDK) { if (t == nt / 2) E.mid(acc, cur, wr, wc, fr, fq); }
            const bool last = (t == nt - 2);
            const char* a1 = cA + (size_t)(t + 1) * kstep;
            const char* a2 = last ? nA : cA + (size_t)(t + 2) * kstep; const char* b2 = last ? nB : cB + (size_t)(t + 2) * kstep;
            const char* a3 = a2 + kstep; const char* b3 = b2 + kstep;
            if constexpr (SP2) {
            PG8_LDB(B0, 0, 0); PG8_LDB(B1, 0, 1); PG8_SCHED; PG8_LDA(At, 0, 0); PG8_STAGE(PG8_SA(1, 1), a1 + hstep, voffA);
            PG8_WAIT_V(8); PG8_WAIT_L(0); PG8_BAR; PG8_MMA(0, 0, At, B0); PG8_MMA(0, 1, At, B1); PG8_BAR; PG8_SCHED;
            PG8_LDA(At, 0, 1); PG8_STAGE(PG8_SB(0, 0), b2, voffB); PG8_STAGE(PG8_SB(0, 1), b2 + hstep, voffB); PG8_STAGE(PG8_SA(0, 0), a2, voffA);
            PG8_WAIT_V(8); PG8_WAIT_L(0); PG8_BAR; PG8_MMA(1, 0, At, B0); PG8_MMA(1, 1, At, B1); PG8_BAR; PG8_SCHED;
            PG8_LDB(B0, 1, 0); PG8_LDB(B1, 1, 1); PG8_SCHED; PG8_LDA(At, 1, 0); PG8_STAGE(PG8_SA(0, 1), a2 + hstep, voffA);
            PG8_WAIT_V(8); PG8_WAIT_L(0); PG8_BAR; PG8_MMA(0, 0, At, B0); PG8_MMA(0, 1, At, B1); PG8_BAR; PG8_SCHED;
            PG8_LDA(At, 1, 1); PG8_STAGE(PG8_SB(1, 0), b3, voffB); PG8_STAGE(PG8_SB(1, 1), b3 + hstep, voffB); PG8_STAGE(PG8_SA(1, 0), a3, voffA);
            PG8_WAIT_V(8); PG8_WAIT_L(0); PG8_BAR; PG8_MMA(1, 0, At, B0); PG8_MMA(1, 1, At, B1); PG8_BAR; PG8_SCHED;
            } else {
            PG8_LDB(B0, 0, 0); PG8_SCHED; PG8_LDA(At, 0, 0); PG8_STAGE(PG8_SA(1, 1), a1 + hstep, voffA);
            PG8_WAIT_L(8); PG8_BAR; PG8_WAIT_L(0); PG8_MMA(0, 0, At, B0); PG8_BAR; PG8_SCHED;
            PG8_LDB(B1, 0, 1); PG8_STAGE(PG8_SB(0, 0), b2, voffB);
            PG8_BAR; PG8_WAIT_L(0); PG8_MMA(0, 1, At, B1); PG8_BAR;
            PG8_LDA(At, 0, 1); PG8_STAGE(PG8_SA(0, 0), a2, voffA);
            PG8_BAR; PG8_WAIT_L(0); PG8_MMA(1, 0, At, B0); PG8_BAR; PG8_SCHED;
            PG8_STAGE(PG8_SB(0, 1), b2 + hstep, voffB);
            PG8_WAIT_V(6); PG8_BAR; PG8_MMA(1, 1, At, B1); PG8_BAR;
            PG8_LDB(B0, 1, 0); PG8_SCHED; PG8_LDA(At, 1, 0); PG8_STAGE(PG8_SA(0, 1), a2 + hstep, voffA);
            PG8_WAIT_L(8); PG8_BAR; PG8_WAIT_L(0); PG8_MMA(0, 0, At, B0); PG8_BAR; PG8_SCHED;
            PG8_LDB(B1, 1, 1); PG8_STAGE(PG8_SB(1, 0), b3, voffB);
            PG8_BAR; PG8_WAIT_L(0); PG8_MMA(0, 1, At, B1); PG8_BAR;
            PG8_LDA(At, 1, 1); PG8_STAGE(PG8_SA(1, 0), a3, voffA);
            PG8_BAR; PG8_WAIT_L(0); PG8_MMA(1, 0, At, B0); PG8_BAR; PG8_SCHED;
            PG8_STAGE(PG8_SB(1, 1), b3 + hstep, voffB);
            PG8_WAIT_V(6); PG8_BAR; PG8_MMA(1, 1, At, B1); PG8_BAR;
            }
        }
        if constexpr (ALIGN_EPI) { if (wr == 0) PG8_BAR; }
        E(acc, cur, wr, wc, fr, fq);
        if (!has_next) break;
#pragma unroll
        for (int a = 0; a < 2; ++a)
#pragma unroll
            for (int b = 0; b < 2; ++b)
#pragma unroll
                for (int m = 0; m < 4; ++m)
#pragma unroll
                    for (int n = 0; n < 2; ++n) acc[a][b][m][n] = (f32x4){0.f, 0.f, 0.f, 0.f};
        cur = nxt; cA = nA; cB = nB; ++ui;
        if constexpr (ALIGN_EPI) { if (wr == 1) PG8_BAR; }
    }
    PG8_WAIT_V(0);
    if constexpr (!ALIGN_EPI) { if (wr == 0) PG8_BAR; }
    PG8_BAR;
#undef PG8_SA
#undef PG8_SB
#undef PG8_STAGE
#undef PG8_LDA
#undef PG8_LDB
#undef PG8_MMA
#undef PG8_WAIT_V
#undef PG8_WAIT_L
#undef PG8_BAR
#undef PG8_SCHED
}
}
using pg8::Unit;
typedef f32x4 Acc[2][2][4][2];

DI u32x4 pack_row8(const f32x4& v0, const f32x4& v1) { u32x4 w; w.x = pk2(v0[0], v0[1]); w.y = pk2(v0[2], v0[3]); w.z = pk2(v1[0], v1[1]); w.w = pk2(v1[2], v1[3]); return w; }

struct EpiMod {
    static constexpr bool PERM = false, MIDK = false;
    float* mod; const float* bias;
    DI void operator()(Acc& acc, const Unit& u, int wr, int wc, int fr, int fq) const {
        { const int t_ = fresh_tid(); fr = t_ & 15; fq = (t_ >> 4) & 3; }
        if (u.pm != 0 || wr != 0) return;
#pragma unroll
        for (int m = 0; m < 3; ++m) { const int r = 16 * m + fr; if (r < NBATCH) {
#pragma unroll
            for (int bj = 0; bj < 2; ++bj)
#pragma unroll
                for (int n = 0; n < 2; ++n) { const int col = u.pn * 256 + bj * 128 + wc * 32 + n * 16 + 4 * fq;
                    *(f32x4*)(mod + (size_t)r * 6144 + col) = acc[0][bj][m][n] + *(const f32x4*)(bias + col); } } }
    }
};

struct EpiIn {
    static constexpr bool PERM = true, MIDK = false;
    bf16_t *QOB, *KA, *VA, *GA, *KB, *VB, *SGA, *SGB; float *CUM, *DEC; const float* lbl; float* out;
    DI void operator()(Acc& acc, const Unit& u, int wr, int wc, int fr, int fq) const {
        { const int t_ = fresh_tid(); fr = t_ & 15; fq = (t_ >> 4) & 3; }
        const int pn = u.pn, rt = wr * 64 + fr, row0 = u.pm * 256 + rt, cw = wc * 32 + 8 * fq, lane = fq * 16 + fr;
        if (pn >= 14) {
            const size_t o0 = (size_t)row0 * 1024 + (pn - 14) * 128 + cw;
#pragma unroll
            for (int ai = 0; ai < 2; ++ai)
#pragma unroll
                for (int m = 0; m < 4; ++m) { f32x4 r0, r1, b0, b1;
#pragma unroll
                    for (int j = 0; j < 4; ++j) { b0[j] = fmaxf(sigm(acc[ai][1][m][0][j]), 1e-30f); b1[j] = fmaxf(sigm(acc[ai][1][m][1][j]), 1e-30f);
                        r0[j] = sigm(acc[ai][0][m][0][j]) * __builtin_amdgcn_rcpf(b0[j]); r1[j] = sigm(acc[ai][0][m][1][j]) * __builtin_amdgcn_rcpf(b1[j]); }
                    const size_t o = o0 + (size_t)(ai * 128 + m * 16) * 1024;
                    *(u32x4*)(SGA + o) = pack_row8(r0, r1); *(u32x4*)(SGB + o) = pack_row8(b0, b1); __builtin_amdgcn_sched_barrier(0); }
            return;
        }
        const int seg = pn >> 1, col0 = (pn & 1) * 256 + cw;
        if (seg == 1) {
#pragma unroll
            for (int bj = 0; bj < 2; ++bj) {
                float lb[2][4];
#pragma unroll
                for (int n = 0; n < 2; ++n)
#pragma unroll
                    for (int j = 0; j < 4; ++j) { const int c = col0 + bj * 128 + 4 * n + j; lb[n][j] = __builtin_amdgcn_rcpf(1.f + __expf(lbl[512 + c] - lbl[c])); }
#pragma unroll
                for (int ai = 0; ai < 2; ++ai) {
                    const size_t rbase = (size_t)(u.pm * 256 + ai * 128 + wr * 64 + launder(fr)) * 512 + col0 + bj * 128;
#pragma unroll
                    for (int m = 0; m < 4; ++m) { f32x4 k0, k1;
#pragma unroll
                        for (int j = 0; j < 4; ++j) {
                            float f = lb[0][j] + (1.f - lb[0][j]) * sigm(acc[ai][bj][m][0][j]); k0[j] = 1.f - f; acc[ai][bj][m][0][j] = __logf(f);
                            f = lb[1][j] + (1.f - lb[1][j]) * sigm(acc[ai][bj][m][1][j]); k1[j] = 1.f - f; acc[ai][bj][m][1][j] = __logf(f); }
                        *(u32x4*)(KA + rbase + (size_t)m * 16 * 512) = pack_row8(k0, k1); }
                    __builtin_amdgcn_sched_barrier(0);
#pragma unroll
                    for (int n = 0; n < 2; ++n)
#pragma unroll
                        for (int j = 0; j < 4; ++j) { float carry = 0.f;
#pragma unroll
                            for (int m = 0; m < 4; ++m) { float v = acc[ai][bj][m][n][j];
                                v += __int_as_float(__builtin_amdgcn_update_dpp(0, __float_as_int(v), 0x111, 0xf, 0xf, false));
                                v += __int_as_float(__builtin_amdgcn_update_dpp(0, __float_as_int(v), 0x112, 0xf, 0xf, false));
                                v += __int_as_float(__builtin_amdgcn_update_dpp(0, __float_as_int(v), 0x114, 0xf, 0xf, false));
                                v += __int_as_float(__builtin_amdgcn_update_dpp(0, __float_as_int(v), 0x118, 0xf, 0xf, false));
                                v += carry; carry = __shfl(v, lane | 15); acc[ai][bj][m][n][j] = v; } }
                    __builtin_amdgcn_sched_barrier(0);
#pragma unroll
                    for (int m = 0; m < 4; ++m) { float* cp = CUM + rbase + (size_t)m * 16 * 512; *(f32x4*)cp = acc[ai][bj][m][0]; *(f32x4*)(cp + 4) = acc[ai][bj][m][1]; }
                    if (fr == 15) {
#pragma unroll
                        for (int n = 0; n < 2; ++n) { f32x4 e;
#pragma unroll
                            for (int j = 0; j < 4; ++j) e[j] = __expf(acc[ai][bj][3][n][j]);
                            *(f32x4*)(DEC + (size_t)(u.pm * 4 + ai * 2 + wr) * 512 + col0 + bj * 128 + 4 * n) = e; } }
                    __builtin_amdgcn_sched_barrier(0);
                }
            }
            return;
        }
        bf16_t* dst; int pitch = 512; float* o32 = nullptr;
        switch (seg) {
            case 0: dst = QOB + col0; pitch = 1024; break;
            case 2: dst = VA + col0; break;
            case 3: dst = GA + col0; break;
            case 4: dst = QOB + 512 + col0; pitch = 1024; break;
            case 5: dst = KB + col0; break;
            default: dst = VB + col0; break;
        }
        if (seg >= 5) {
            if (u.pm >= 128) o32 = out + (seg == 5 ? OFF_KS : OFF_VS) + (size_t)((u.pm - 128) * 256 + rt) * 512 + col0;
            else if ((u.pm & 63) >= 62) o32 = out + (seg == 5 ? OFF_KP : OFF_VP) + (size_t)((u.pm >> 6) * 512 + ((u.pm & 63) - 62) * 256 + rt) * 512 + col0;
        }
        const bool act = (seg == 0 || seg == 3);
#pragma unroll
        for (int ai = 0; ai < 2; ++ai)
#pragma unroll
            for (int m = 0; m < 4; ++m)
#pragma unroll
                for (int bj = 0; bj < 2; ++bj) { f32x4 v0 = acc[ai][bj][m][0], v1 = acc[ai][bj][m][1];
                    if (act) {
#pragma unroll
                        for (int j = 0; j < 4; ++j) { v0[j] = silu(v0[j]); v1[j] = silu(v1[j]); } }
                    *(u32x4*)(dst + (size_t)(row0 + ai * 128 + m * 16) * pitch + bj * 128) = pack_row8(v0, v1);
                    if (o32) { float* op = o32 + (size_t)(ai * 128 + m * 16) * 512 + bj * 128; *(f32x4*)op = v0; *(f32x4*)(op + 4) = v1; } __builtin_amdgcn_sched_barrier(0); }
    }
};

struct EpiMerge {
    static constexpr bool PERM = true, MIDK = true;
    const bf16_t *SGR, *SGB; bf16_t* Mo;
    DI void mid(Acc& acc, const Unit& u, int wr, int wc, int fr, int fq) const {
        { const int t_ = fresh_tid(); fr = t_ & 15; fq = (t_ >> 4) & 3; }
        const size_t base = (size_t)(u.pm * 256 + wr * 64 + fr) * 1024 + u.pn * 256 + wc * 32 + 8 * fq;
#pragma unroll
        for (int ai = 0; ai < 2; ++ai) { u32x4 a[4][2];
#pragma unroll
            for (int m = 0; m < 4; ++m)
#pragma unroll
                for (int bj = 0; bj < 2; ++bj) a[m][bj] = *(const u32x4*)(SGR + base + (size_t)(ai * 128 + m * 16) * 1024 + bj * 128);
#pragma unroll
            for (int m = 0; m < 4; ++m)
#pragma unroll
                for (int bj = 0; bj < 2; ++bj)
#pragma unroll
                    for (int j = 0; j < 4; ++j) { acc[ai][bj][m][j >> 1][(j & 1) * 2] *= bflo(a[m][bj][j]); acc[ai][bj][m][j >> 1][(j & 1) * 2 + 1] *= bfhi(a[m][bj][j]); }
            __builtin_amdgcn_sched_barrier(0); }
    }
    DI void operator()(Acc& acc, const Unit& u, int wr, int wc, int fr, int fq) const {
        { const int t_ = fresh_tid(); fr = t_ & 15; fq = (t_ >> 4) & 3; }
        const size_t base = (size_t)(u.pm * 256 + wr * 64 + fr) * 1024 + u.pn * 256 + wc * 32 + 8 * fq;
#pragma unroll
        for (int ai = 0; ai < 2; ++ai) { u32x4 b[4][2];
#pragma unroll
            for (int m = 0; m < 4; ++m)
#pragma unroll
                for (int bj = 0; bj < 2; ++bj) b[m][bj] = *(const u32x4*)(SGB + base + (size_t)(ai * 128 + m * 16) * 1024 + bj * 128);
#pragma unroll
            for (int m = 0; m < 4; ++m)
#pragma unroll
                for (int bj = 0; bj < 2; ++bj) { f32x4 v0 = acc[ai][bj][m][0], v1 = acc[ai][bj][m][1]; const u32x4 g = b[m][bj];
                    v0[0] *= bflo(g[0]); v0[1] *= bfhi(g[0]); v0[2] *= bflo(g[1]); v0[3] *= bfhi(g[1]);
                    v1[0] *= bflo(g[2]); v1[1] *= bfhi(g[2]); v1[2] *= bflo(g[3]); v1[3] *= bfhi(g[3]);
                    *(u32x4*)(Mo + base + (size_t)(ai * 128 + m * 16) * 1024 + bj * 128) = pack_row8(v0, v1); }
            __builtin_amdgcn_sched_barrier(0); }
    }
};

template <bool BASE_BF16> struct EpiRes {
    static constexpr bool PERM = true, MIDK = false;
    const float *xp, *xs; const bf16_t* xb; bf16_t* xo; const float* gmod;
    DI void operator()(Acc& acc, const Unit& u, int wr, int wc, int fr, int fq) const {
        { const int t_ = fresh_tid(); fr = t_ & 15; fq = (t_ >> 4) & 3; }
        const int colb = u.pn * 256 + wc * 32 + 8 * fq;
#pragma unroll
        for (int ai = 0; ai < 2; ++ai) { const int r0 = u.pm * 256 + ai * 128 + wr * 64 + fr;
            const float* g = gmod + (size_t)batch_of(r0) * 6144 + colb;
            f32x4 gv[2][2];
#pragma unroll
            for (int bj = 0; bj < 2; ++bj) { gv[bj][0] = *(const f32x4*)(g + bj * 128); gv[bj][1] = *(const f32x4*)(g + bj * 128 + 4); }
            bf16_t* orow = xo + (size_t)r0 * D + colb;
            if constexpr (BASE_BF16) {
                const bf16_t* xr = xb + (size_t)r0 * D + colb; u32x4 xv[4][2];
#pragma unroll
                for (int m = 0; m < 4; ++m)
#pragma unroll
                    for (int bj = 0; bj < 2; ++bj) xv[m][bj] = *(const u32x4*)(xr + (size_t)m * 16 * D + bj * 128);
#pragma unroll
                for (int m = 0; m < 4; ++m)
#pragma unroll
                    for (int bj = 0; bj < 2; ++bj) { const u32x4 x = xv[m][bj]; const f32x4 a0 = acc[ai][bj][m][0] * gv[bj][0], a1 = acc[ai][bj][m][1] * gv[bj][1];
                        f32x4 v0 = {bflo(x[0]) + a0[0], bfhi(x[0]) + a0[1], bflo(x[1]) + a0[2], bfhi(x[1]) + a0[3]}, v1 = {bflo(x[2]) + a1[0], bfhi(x[2]) + a1[1], bflo(x[3]) + a1[2], bfhi(x[3]) + a1[3]};
                        *(u32x4*)(orow + (size_t)m * 16 * D + bj * 128) = pack_row8(v0, v1); }
            } else {
                const float* xr = (r0 < TP ? xp + (size_t)r0 * D : xs + (size_t)(r0 - TP) * D) + colb; f32x4 xv[4][2][2];
#pragma unroll
                for (int m = 0; m < 4; ++m)
#pragma unroll
                    for (int bj = 0; bj < 2; ++bj) { xv[m][bj][0] = *(const f32x4*)(xr + (size_t)m * 16 * D + bj * 128); xv[m][bj][1] = *(const f32x4*)(xr + (size_t)m * 16 * D + bj * 128 + 4); }
#pragma unroll
                for (int m = 0; m < 4; ++m)
#pragma unroll
                    for (int bj = 0; bj < 2; ++bj) *(u32x4*)(orow + (size_t)m * 16 * D + bj * 128) = pack_row8(xv[m][bj][0] + gv[bj][0] * acc[ai][bj][m][0], xv[m][bj][1] + gv[bj][1] * acc[ai][bj][m][1]);
            }
            __builtin_amdgcn_sched_barrier(0); }
    }
};

struct EpiPart {
    static constexpr bool PERM = false, MIDK = false;
    float* part; int row0;
    DI void operator()(Acc& acc, const Unit& u, int wr, int wc, int fr, int fq) const {
        { const int t_ = fresh_tid(); fr = t_ & 15; fq = (t_ >> 4) & 3; }
#pragma unroll
        for (int ai = 0; ai < 2; ++ai)
#pragma unroll
            for (int m = 0; m < 4; ++m) { float* prow = part + (size_t)(u.pm * 256 + ai * 128 + wr * 64 + m * 16 + fr - row0) * D + u.pn * 256 + wc * 32 + 4 * fq;
#pragma unroll
                for (int bj = 0; bj < 2; ++bj)
#pragma unroll
                    for (int n = 0; n < 2; ++n) *(f32x4*)(prow + bj * 128 + n * 16) = acc[ai][bj][m][n];
                __builtin_amdgcn_sched_barrier(0); }
    }
};

struct EpiFfnIn {
    static constexpr bool PERM = true, MIDK = false;
    bf16_t* HID;
    DI void operator()(Acc& acc, const Unit& u, int wr, int wc, int fr, int fq) const {
        { const int t_ = fresh_tid(); fr = t_ & 15; fq = (t_ >> 4) & 3; }
        bf16_t* base = HID + (size_t)(u.pm * 256 + wr * 64 + fr) * FF + u.pn * 128 + wc * 32 + 8 * fq;
#pragma unroll
        for (int ai = 0; ai < 2; ++ai)
#pragma unroll
            for (int m = 0; m < 4; ++m) { f32x4 v0, v1;
#pragma unroll
                for (int j = 0; j < 4; ++j) { v0[j] = silu(acc[ai][0][m][0][j]) * acc[ai][1][m][0][j]; v1[j] = silu(acc[ai][0][m][1][j]) * acc[ai][1][m][1][j]; }
                *(u32x4*)(base + (size_t)(ai * 128 + m * 16) * FF) = pack_row8(v0, v1); __builtin_amdgcn_sched_barrier(0); }
    }
};

DI void transpose_item(const float* W, int N, bf16_t* WT, int pitch, int koff, int k0, int n0, int drow0, LAS float* scr, int lane) {
#pragma unroll 8
    for (int i = 0; i < 32; ++i) { const int kk = 2 * i + (lane >> 5); scr[kk * 33 + (lane & 31)] = W[(size_t)(k0 + kk) * N + n0 + (lane & 31)]; }
    asm volatile("s_waitcnt lgkmcnt(0)" ::: "memory");
    const int c = lane & 7;
#pragma unroll
    for (int j = 0; j < 4; ++j) { const int n = (lane >> 3) + 8 * j; const LAS float* s = scr + (8 * c) * 33 + n;
        u32x4 o; o.x = pk2(s[0 * 33], s[1 * 33]); o.y = pk2(s[2 * 33], s[3 * 33]); o.z = pk2(s[4 * 33], s[5 * 33]); o.w = pk2(s[6 * 33], s[7 * 33]);
        *(u32x4*)(WT + (size_t)(drow0 + n) * pitch + koff + k0 + 8 * c) = o; }
    asm volatile("s_waitcnt lgkmcnt(0)" ::: "memory");
}
DI void phase_prep(const Params& p, LAS unsigned char* lds) {
    const int tid = fresh_tid(), lane = tid & 63, wave = __builtin_amdgcn_readfirstlane(tid >> 6);
    LAS float* scr = (LAS float*)(lds + wave * 16384);
    const int gw = blockIdx.x * 8 + wave, NGW = gridDim.x * 8;
    unsigned char* ws = p.ws;
    constexpr int I_ADA = 16 * 192, I_IN = 16 * 176, I_A = 8 * 32, I_O = 16 * 32, I_FI = 16 * 176, I_FO = 44 * 32;
    constexpr int NIT = I_ADA + I_IN + 2 * I_A + I_O + I_FI + I_FO;
    for (int it = gw; it < NIT; it += NGW) {
        int r = it;
        if (r < I_ADA) { const int kb = r / 192, nb = r % 192; transpose_item(p.w_ada, 6144, (bf16_t*)(ws + WS_WADA), 1024, 0, 64 * kb, 32 * nb, 32 * nb, scr, lane); continue; } r -= I_ADA;
        if (r < I_IN) { const int kb = r / 176, nb = r % 176, n0 = 32 * nb; int dr = n0;
            if (n0 >= 3584) { const int j = n0 < 4608 ? n0 - 3584 : n0 - 4608; dr = 3584 + 256 * (j >> 7) + (j & 127) + (n0 < 4608 ? 0 : 128); }
            transpose_item(p.w_in, INC, (bf16_t*)(ws + WS_WIN), 1024, 0, 64 * kb, n0, dr, scr, lane); continue; } r -= I_IN;
        if (r < I_A) { const int kb = r / 32, nb = r % 32; transpose_item(p.w_a, 1024, (bf16_t*)(ws + WS_WAB), 1024, 0, 64 * kb, 32 * nb, 32 * nb, scr, lane); continue; } r -= I_A;
        if (r < I_A) { const int kb = r / 32, nb = r % 32; transpose_item(p.w_b, 1024, (bf16_t*)(ws + WS_WAB), 1024, 512, 64 * kb, 32 * nb, 32 * nb, scr, lane); continue; } r -= I_A;
        if (r < I_O) { const int kb = r / 32, nb = r % 32; transpose_item(p.w_out, 1024, (bf16_t*)(ws + WS_WO), 1024, 0, 64 * kb, 32 * nb, 32 * nb, scr, lane); continue; } r -= I_O;
        if (r < I_FI) { const int kb = r / 176, nb = r % 176; const int n0 = 32 * nb; const int j0 = n0 < FF ? n0 : n0 - FF;
            transpose_item(p.w_ffn_in, INC, (bf16_t*)(ws + WS_WFI), 1024, 0, 64 * kb, n0, 256 * (j0 >> 7) + (j0 & 127) + (n0 < FF ? 0 : 128), scr, lane); continue; } r -= I_FI;
        { const int kb = r / 32, nb = r % 32; transpose_item(p.w_ffn_out, 1024, (bf16_t*)(ws + WS_WFO), FF, 0, 64 * kb, 32 * nb, 32 * nb, scr, lane); }
    }
    bf16_t* SC = (bf16_t*)(ws + WS_SC);
    for (int i = blockIdx.x * 512 + tid; i < 256 * 1024 / 2; i += gridDim.x * 512) { const int row = (2 * i) >> 10, col = (2 * i) & 1023; float a = 0.f, b = 0.f;
        if (row < NBATCH) { const float* c = row < 2 ? p.c_prompt + row * D : p.c_sample + (row - 2) * D; a = silu(c[col]); b = silu(c[col + 1]); }
        ((unsigned*)SC)[i] = pk2(a, b); }
}

DI float wave_sum(float v) {
#pragma unroll
    for (int o = 1; o < 64; o <<= 1) v += __shfl_xor(v, o);
    return v;
}
DI void phase_norm_mod(const float* xp, const float* xs, const float* nw, const float* mod, int sh_off, int sc_off, bf16_t* H) {
    const int tid = fresh_tid(), lane = tid & 63, wave = __builtin_amdgcn_readfirstlane(tid >> 6);
    const int gw = blockIdx.x * 8 + wave, NGW = gridDim.x * 8;
    for (int r = gw; r < T; r += NGW) {
        const float* xr = r < TP ? xp + (size_t)r * D : xs + (size_t)(r - TP) * D; const float* mb = mod + (size_t)batch_of(r) * 6144;
        f32x4 v[4]; float s = 0.f;
#pragma unroll
        for (int j = 0; j < 4; ++j) { v[j] = *(const f32x4*)(xr + 4 * lane + 256 * j); s += (v[j][0] * v[j][0] + v[j][1] * v[j][1]) + (v[j][2] * v[j][2] + v[j][3] * v[j][3]); }
        const float rstd = __builtin_amdgcn_rsqf(wave_sum(s) * (1.f / D) + EPS);
#pragma unroll
        for (int j = 0; j < 4; ++j) { const int col = 4 * lane + 256 * j; const f32x4 w = *(const f32x4*)(nw + col), sc = *(const f32x4*)(mb + sc_off + col), sh = *(const f32x4*)(mb + sh_off + col);
            const f32x4 h = v[j] * rstd * w * (sc + 1.f) + sh; u32x2 o; o.x = pk2(h[0], h[1]); o.y = pk2(h[2], h[3]);
            *(u32x2*)(H + (size_t)r * D + col) = o; }
    }
}
DI void phase_norm_mod_b(const bf16_t* xb, const float* nw, const float* mod, int sh_off, int sc_off, bf16_t* H, int r_lo = 0, int r_hi = T, int b_lo = 0) {
    const int tid = fresh_tid(), lane = tid & 63, wave = __builtin_amdgcn_readfirstlane(tid >> 6);
    const int gw = ((int)blockIdx.x - b_lo) * 8 + wave, NGW = ((int)gridDim.x - b_lo) * 8;
    for (int r = r_lo + gw; r < r_hi; r += NGW) {
        const bf16_t* xr = xb + (size_t)r * D; const float* mb = mod + (size_t)batch_of(r) * 6144;
        float v[2][8]; float s = 0.f;
#pragma unroll
        for (int j = 0; j < 2; ++j) { const u32x4 x = *(const u32x4*)(xr + 8 * lane + 512 * j);
#pragma unroll
            for (int i = 0; i < 4; ++i) { v[j][2 * i] = bflo(x[i]); v[j][2 * i + 1] = bfhi(x[i]); s += v[j][2 * i] * v[j][2 * i] + v[j][2 * i + 1] * v[j][2 * i + 1]; } }
        const float rstd = __builtin_amdgcn_rsqf(wave_sum(s) * (1.f / D) + EPS);
#pragma unroll
        for (int j = 0; j < 2; ++j) { const int col = 8 * lane + 512 * j; f32x4 h[2];
#pragma unroll
            for (int q = 0; q < 2; ++q) { const f32x4 w = *(const f32x4*)(nw + col + 4 * q), sc = *(const f32x4*)(mb + sc_off + col + 4 * q), sh = *(const f32x4*)(mb + sh_off + col + 4 * q);
                const f32x4 x = {v[j][4 * q], v[j][4 * q + 1], v[j][4 * q + 2], v[j][4 * q + 3]}; h[q] = x * rstd * w * (sc + 1.f) + sh; }
            *(u32x4*)(H + (size_t)r * D + col) = pack_row8(h[0], h[1]); }
    }
}
DI void phase_final_norm(const bf16_t* xb, float* y, const float* nw, int r_lo = 0, int r_hi = T, int b_lo = 0) {
    const int tid = fresh_tid(), lane = tid & 63, wave = __builtin_amdgcn_readfirstlane(tid >> 6);
    const int gw = ((int)blockIdx.x - b_lo) * 8 + wave, NGW = ((int)gridDim.x - b_lo) * 8;
    for (int r = r_lo + gw; r < r_hi; r += NGW) { const bf16_t* xr = xb + (size_t)r * D; float* yr = y + (size_t)r * D;
        float v[2][8]; float s = 0.f;
#pragma unroll
        for (int j = 0; j < 2; ++j) { const u32x4 x = *(const u32x4*)(xr + 8 * lane + 512 * j);
#pragma unroll
            for (int i = 0; i < 4; ++i) { v[j][2 * i] = bflo(x[i]); v[j][2 * i + 1] = bfhi(x[i]); s += v[j][2 * i] * v[j][2 * i] + v[j][2 * i + 1] * v[j][2 * i + 1]; } }
        const float rstd = __builtin_amdgcn_rsqf(wave_sum(s) * (1.f / D) + EPS);
#pragma unroll
        for (int j = 0; j < 2; ++j) { const int col = 8 * lane + 512 * j;
#pragma unroll
            for (int q = 0; q < 2; ++q) { const f32x4 x = {v[j][4 * q], v[j][4 * q + 1], v[j][4 * q + 2], v[j][4 * q + 3]}; *(f32x4*)(yr + col + 4 * q) = x * rstd * *(const f32x4*)(nw + col + 4 * q); } }
    }
}

DI void phase_final_norm_parts(const bf16_t* x1b, const float* part0, const float* part1, const float* g2mod, float* y, const float* nw) {
    const int tid = fresh_tid(), lane = tid & 63, wave = __builtin_amdgcn_readfirstlane(tid >> 6);
    const int gw = blockIdx.x * 8 + wave, NGW = gridDim.x * 8;
    for (int r = TP + gw; r < T; r += NGW) { const float* gb = g2mod + (size_t)batch_of(r) * 6144; const size_t po = (size_t)(r - TP) * D;
        f32x4 v[4]; float s = 0.f;
#pragma unroll
        for (int j = 0; j < 4; ++j) { const int col = 4 * lane + 256 * j; const u32x2 xb = *(const u32x2*)(x1b + (size_t)r * D + col);
            const f32x4 x = {bflo(xb.x), bfhi(xb.x), bflo(xb.y), bfhi(xb.y)};
            v[j] = x + *(const f32x4*)(gb + col) * (*(const f32x4*)(part0 + po + col) + *(const f32x4*)(part1 + po + col));
            s += (v[j][0] * v[j][0] + v[j][1] * v[j][1]) + (v[j][2] * v[j][2] + v[j][3] * v[j][3]); }
        const float rstd = __builtin_amdgcn_rsqf(wave_sum(s) * (1.f / D) + EPS);
#pragma unroll
        for (int j = 0; j < 4; ++j) { const int col = 4 * lane + 256 * j; *(f32x4*)(y + (size_t)r * D + col) = v[j] * rstd * *(const f32x4*)(nw + col); }
    }
}

DI void hgrn_u_item(const Params& p, int item, int lane) {
    const int c = item >> 5, rem = item & 31, h = rem >> 3, kt = (rem >> 1) & 3, vh = rem & 1, l31 = lane & 31, hf = lane >> 5;
    const float* CUM = (const float*)(p.ws + WS_CUM); const bf16_t* KA = (const bf16_t*)(p.ws + WS_KA); const bf16_t* VA = (const bf16_t*)(p.ws + WS_VA); bf16_t* U = (bf16_t*)(p.ws + WS_U);
    const int kcol = h * 128 + 32 * kt + l31;
    const float tot = CUM[(size_t)(c * 64 + 63) * 512 + kcol];
    bf16x8 kdf[2][2];
#pragma unroll
    for (int st = 0; st < 2; ++st) { f32x16 kd;
#pragma unroll
        for (int r = 0; r < 16; ++r) { const size_t idx = (size_t)(c * 64 + 32 * st + crow(r, hf)) * 512 + kcol; kd[r] = bf2f((short)KA[idx]) * __expf(tot - CUM[idx]); }
        kdf[st][0] = pack8(kd, 0); kdf[st][1] = pack8(kd, 1); }
    const bf16x8 id0 = ident_frag(0, l31, hf), id1 = ident_frag(1, l31, hf);
#pragma unroll
    for (int vtl = 0; vtl < 2; ++vtl) { const int vt = 2 * vh + vtl; f32x16 dacc = zero16();
#pragma unroll
        for (int st = 0; st < 2; ++st) { const bf16_t* vp = VA + (size_t)(c * 64 + 32 * st + l31) * 512 + h * 128 + 32 * vt + 8 * hf;
            f32x16 vx = zero16(); vx = MFMA32(*(const bf16x8*)vp, id0, vx); vx = MFMA32(*(const bf16x8*)(vp + 16), id1, vx);
            dacc = MFMA32(kdf[st][0], pack8(vx, 0), dacc); dacc = MFMA32(kdf[st][1], pack8(vx, 1), dacc); }
        bf16_t* up = U + ((size_t)(c * 4 + h) * 128 + 32 * vt + l31) * 128 + 32 * kt + 4 * hf;
#pragma unroll
        for (int g = 0; g < 4; ++g) { u32x2 o; o.x = pk2(dacc[4 * g], dacc[4 * g + 1]); o.y = pk2(dacc[4 * g + 2], dacc[4 * g + 3]); *(u32x2*)(up + 8 * g) = o; }
    }
}

DI void scan_prompt_item(const Params& p, int item, int lane) {
    const int bh = item >> 5, vq = item & 31, b = bh >> 2, h = bh & 3, kg = lane & 31, vv = lane >> 5;
    const float* __restrict__ DEC = (const float*)(p.ws + WS_DEC); const bf16_t* __restrict__ U = (const bf16_t*)(p.ws + WS_U); bf16_t* __restrict__ SST = (bf16_t*)(p.ws + WS_SST);
    f32x4 S0 = {0.f, 0.f, 0.f, 0.f}, S1 = {0.f, 0.f, 0.f, 0.f};
    const int v0 = 4 * vq + vv, v1 = v0 + 2;
#pragma unroll 16
    for (int n = 0; n < 256; ++n) { const int c = b * 256 + n;
        const f32x4 d = *(const f32x4*)(DEC + (size_t)c * 512 + h * 128 + 4 * kg);
        const size_t o0 = ((size_t)(c * 4 + h) * 128 + v0) * 128 + 4 * kg, o1 = ((size_t)(c * 4 + h) * 128 + v1) * 128 + 4 * kg;
        const u32x2 u0 = *(const u32x2*)(U + o0), u1 = *(const u32x2*)(U + o1);
        u32x2 s; s.x = pk2(S0[0], S0[1]); s.y = pk2(S0[2], S0[3]); *(u32x2*)(SST + o0) = s;
        s.x = pk2(S1[0], S1[1]); s.y = pk2(S1[2], S1[3]); *(u32x2*)(SST + o1) = s;
        S0[0] = d[0] * S0[0] + bflo(u0.x); S0[1] = d[1] * S0[1] + bfhi(u0.x); S0[2] = d[2] * S0[2] + bflo(u0.y); S0[3] = d[3] * S0[3] + bfhi(u0.y);
        S1[0] = d[0] * S1[0] + bflo(u1.x); S1[1] = d[1] * S1[1] + bfhi(u1.x); S1[2] = d[2] * S1[2] + bflo(u1.y); S1[3] = d[3] * S1[3] + bfhi(u1.y);
    }
    float* sp = p.out + OFF_SP + ((size_t)bh * 128 + 4 * kg) * 128;
#pragma unroll
    for (int i = 0; i < 4; ++i) { sp[(size_t)i * 128 + v0] = S0[i]; sp[(size_t)i * 128 + v1] = S1[i]; }
}
DI void scan_sample_item(const Params& p, int item, int lane) {
    const int bh = item >> 5, vq = item & 31, bs = bh >> 2, h = bh & 3, kg = lane & 31, vv = lane >> 5, c = 512 + bs;
    const float* DEC = (const float*)(p.ws + WS_DEC); const bf16_t* U = (const bf16_t*)(p.ws + WS_U); bf16_t* SST = (bf16_t*)(p.ws + WS_SST);
    const f32x4 d = *(const f32x4*)(DEC + (size_t)c * 512 + h * 128 + 4 * kg);
    const float* s0 = p.state + ((size_t)bh * 128 + 4 * kg) * 128; float* so = p.out + OFF_SS + ((size_t)bh * 128 + 4 * kg) * 128;
#pragma unroll
    for (int e = 0; e < 2; ++e) { const int v = 4 * vq + 2 * e + vv; const size_t o = ((size_t)(c * 4 + h) * 128 + v) * 128 + 4 * kg;
        const u32x2 u = *(const u32x2*)(U + o); f32x4 S;
#pragma unroll
        for (int i = 0; i < 4; ++i) S[i] = s0[(size_t)i * 128 + v];
        u32x2 s; s.x = pk2(S[0], S[1]); s.y = pk2(S[2], S[3]); *(u32x2*)(SST + o) = s;
        so[v] = d[0] * S[0] + bflo(u.x); so[128 + v] = d[1] * S[1] + bfhi(u.x); so[256 + v] = d[2] * S[2] + bflo(u.y); so[384 + v] = d[3] * S[3] + bfhi(u.y); }
}

DI void attn_item(const Params& p, int item, int lane, const LAS float* biasl, bf16_t* obase = nullptr, int opitch = 1024) {
    const int c = item >> 4, h = (item >> 1) & 7, qh = item & 1, l31 = lane & 31, hf = lane >> 5;
    bf16_t* qptr = (bf16_t*)(p.ws + WS_QOB) + (size_t)(c * 64 + qh * 32 + l31) * 1024 + 512 + h * 64;
    const bf16_t* KB = (const bf16_t*)(p.ws + WS_KB); const bf16_t* VB = (const bf16_t*)(p.ws + WS_VB);
    bf16x8 qf[4];
#pragma unroll
    for (int ks = 0; ks < 4; ++ks) qf[ks] = *(const bf16x8*)(qptr + 16 * ks + 8 * hf);
    const bf16x8 id0 = ident_frag(0, l31, hf), id1 = ident_frag(1, l31, hf);
    const LAS float* bl = biasl + h * 192;
    f32x16 OT0 = zero16(), OT1 = zero16(); float mrun = -1e30f, lsum = 0.f;
    int ntile, ncache, db0; size_t krow_first;
    if (c < 512) { const int n = c & 255, j0 = n < 8 ? n : 8; ntile = 2 * (j0 + 1); ncache = 0; db0 = 64 * j0 + 32 * qh; krow_first = (size_t)(c - j0) * 64; }
    else { ntile = 18; ncache = 16; db0 = 512 + 32 * qh; krow_first = (size_t)c * 64 - 512; }
    const int bs = c - 512;
    u32x4 nk[4], nv[4], nk2[4], nv2[4];
#define ATT_LOAD(i_) do { if ((i_) < ncache) { \
            const float* kp_ = p.cache_k + ((size_t)(bs * 512 + 32 * (i_) + l31) * 8 + h) * 64 + 8 * hf; const float* vp_ = p.cache_v + ((size_t)(bs * 512 + 32 * (i_) + l31) * 8 + h) * 64 + 8 * hf; \
            _Pragma("unroll") for (int ks = 0; ks < 4; ++ks) { nk[ks] = *(const u32x4*)(kp_ + 16 * ks); nk2[ks] = *(const u32x4*)(kp_ + 16 * ks + 4); nv[ks] = *(const u32x4*)(vp_ + 16 * ks); nv2[ks] = *(const u32x4*)(vp_ + 16 * ks + 4); } \
        } else { const size_t ro_ = (krow_first + 32 * (i_) + l31) * 512 + h * 64 + 8 * hf; \
            _Pragma("unroll") for (int ks = 0; ks < 4; ++ks) { nk[ks] = *(const u32x4*)(KB + ro_ + 16 * ks); nv[ks] = *(const u32x4*)(VB + ro_ + 16 * ks); } } } while (0)
    ATT_LOAD(0);
    for (int i = 0; i < ntile; ++i) {
        bf16x8 kf[4], vf[2][2];
        if (i < ncache) {
#pragma unroll
            for (int ks = 0; ks < 4; ++ks) { u32x4 w; const f32x4 a = __builtin_bit_cast(f32x4, nk[ks]), b = __builtin_bit_cast(f32x4, nk2[ks]), e = __builtin_bit_cast(f32x4, nv[ks]), f = __builtin_bit_cast(f32x4, nv2[ks]);
                w.x = pk2(a[0], a[1]); w.y = pk2(a[2], a[3]); w.z = pk2(b[0], b[1]); w.w = pk2(b[2], b[3]); kf[ks] = __builtin_bit_cast(bf16x8, w);
                w.x = pk2(e[0], e[1]); w.y = pk2(e[2], e[3]); w.z = pk2(f[0], f[1]); w.w = pk2(f[2], f[3]); vf[ks >> 1][ks & 1] = __builtin_bit_cast(bf16x8, w); }
        } else {
#pragma unroll
            for (int ks = 0; ks < 4; ++ks) { kf[ks] = __builtin_bit_cast(bf16x8, nk[ks]); vf[ks >> 1][ks & 1] = __builtin_bit_cast(bf16x8, nv[ks]); }
        }
        if (i + 1 < ntile) ATT_LOAD(i + 1);
        f32x16 st = zero16();
#pragma unroll
        for (int ks = 0; ks < 4; ++ks) st = MFMA32(kf[ks], qf[ks], st);
        const int dbase = db0 - 32 * i + l31; float mt = -1e30f;
        if (db0 - 32 * i - 31 >= 128) { const float bc = bl[191];
#pragma unroll
            for (int r = 0; r < 16; ++r) { const float s = st[r] * (0.125f * LOG2E) + bc; st[r] = s; mt = fmaxf(mt, s); }
        } else {
#pragma unroll
            for (int r = 0; r < 16; ++r) { int dist = dbase - crow(r, hf); dist = dist > 128 ? 128 : dist; const float s = st[r] * (0.125f * LOG2E) + bl[dist + 63]; st[r] = s; mt = fmaxf(mt, s); }
        }
        mt = fmaxf(mt, __shfl_xor(mt, 32));
        const float mnew = fmaxf(mrun, mt), alpha = __builtin_amdgcn_exp2f(mrun - mnew); mrun = mnew;
        float ps = 0.f;
#pragma unroll
        for (int r = 0; r < 16; ++r) { st[r] = __builtin_amdgcn_exp2f(st[r] - mnew); ps += st[r]; }
        lsum = lsum * alpha + ps;
#pragma unroll
        for (int r = 0; r < 16; ++r) { OT0[r] *= alpha; OT1[r] *= alpha; }
        const bf16x8 pf0 = pack8(st, 0), pf1 = pack8(st, 1);
        { f32x16 vx = zero16(); vx = MFMA32(vf[0][0], id0, vx); vx = MFMA32(vf[0][1], id1, vx); OT0 = MFMA32(pack8(vx, 0), pf0, OT0); OT0 = MFMA32(pack8(vx, 1), pf1, OT0); }
        { f32x16 vx = zero16(); vx = MFMA32(vf[1][0], id0, vx); vx = MFMA32(vf[1][1], id1, vx); OT1 = MFMA32(pack8(vx, 0), pf0, OT1); OT1 = MFMA32(pack8(vx, 1), pf1, OT1); }
    }
    lsum += __shfl_xor(lsum, 32); const float inv = 1.f / lsum;
    if (obase) qptr = obase + (size_t)(c * 64 + qh * 32 + l31) * opitch + h * 64;
#pragma unroll
    for (int g = 0; g < 4; ++g) { u32x2 o; o.x = pk2(OT0[4 * g] * inv, OT0[4 * g + 1] * inv); o.y = pk2(OT0[4 * g + 2] * inv, OT0[4 * g + 3] * inv); *(u32x2*)(qptr + 8 * g + 4 * hf) = o;
        o.x = pk2(OT1[4 * g] * inv, OT1[4 * g + 1] * inv); o.y = pk2(OT1[4 * g + 2] * inv, OT1[4 * g + 3] * inv); *(u32x2*)(qptr + 32 + 8 * g + 4 * hf) = o; }
}

DI void hgrn_out_item(const Params& p, int item, int lane, bf16_t* obase = nullptr) {
    const int c = item >> 3, h = (item >> 1) & 3, tt = item & 1, l31 = lane & 31, hf = lane >> 5;
    const float* CUM = (const float*)(p.ws + WS_CUM); const bf16_t* KA = (const bf16_t*)(p.ws + WS_KA); const bf16_t* VA = (const bf16_t*)(p.ws + WS_VA);
    const bf16_t* GA = (const bf16_t*)(p.ws + WS_GA); const bf16_t* SST = (const bf16_t*)(p.ws + WS_SST);
    const int trow = c * 64 + 32 * tt + l31;
    bf16_t* qap = (bf16_t*)(p.ws + WS_QOB) + (size_t)trow * 1024 + h * 128;
    const float* cumt = CUM + (size_t)trow * 512 + h * 128; const float* refp = CUM + (size_t)(c * 64 + 32) * 512 + h * 128;
    bf16x8 qd1[8], qd2[8];
#pragma unroll
    for (int ks = 0; ks < 8; ++ks) { const int k0 = 16 * ks + 8 * hf; const bf16x8 q8 = *(const bf16x8*)(qap + k0);
        const f32x4 c0 = *(const f32x4*)(cumt + k0), c1 = *(const f32x4*)(cumt + k0 + 4), r0 = *(const f32x4*)(refp + k0), r1 = *(const f32x4*)(refp + k0 + 4);
        float a[8], b[8];
#pragma unroll
        for (int j = 0; j < 8; ++j) { const float q = bf2f(q8[j]), cu = j < 4 ? c0[j & 3] : c1[j & 3], rf = j < 4 ? r0[j & 3] : r1[j & 3]; a[j] = q * __expf(cu - rf); b[j] = q * __expf(cu); }
        qd1[ks] = pack8f(a); qd2[ks] = pack8f(b); }
    f32x16 OT[4];
#pragma unroll
    for (int vt = 0; vt < 4; ++vt) OT[vt] = zero16();
    const bf16_t* sp = SST + ((size_t)(c * 4 + h) * 128 + l31) * 128 + 8 * hf;
#pragma unroll
    for (int vt = 0; vt < 4; ++vt)
#pragma unroll
        for (int ks = 0; ks < 8; ++ks) OT[vt] = MFMA32(*(const bf16x8*)(sp + (size_t)vt * 32 * 128 + 16 * ks), qd2[ks], OT[vt]);
    const bf16x8 id0 = ident_frag(0, l31, hf), id1 = ident_frag(1, l31, hf);
    for (int st = 0; st <= tt; ++st) {
        const int srow = c * 64 + 32 * st + l31; const bf16_t* kap = KA + (size_t)srow * 512 + h * 128; const float* cums = CUM + (size_t)srow * 512 + h * 128;
        f32x16 X = zero16();
#pragma unroll
        for (int ks = 0; ks < 8; ++ks) { const int k0 = 16 * ks + 8 * hf; const bf16x8 k8 = *(const bf16x8*)(kap + k0);
            const f32x4 c0 = *(const f32x4*)(cums + k0), c1 = *(const f32x4*)(cums + k0 + 4), r0 = *(const f32x4*)(refp + k0), r1 = *(const f32x4*)(refp + k0 + 4);
            float a[8];
#pragma unroll
            for (int j = 0; j < 8; ++j) { const float cu = j < 4 ? c0[j & 3] : c1[j & 3], rf = j < 4 ? r0[j & 3] : r1[j & 3]; a[j] = bf2f(k8[j]) * __expf(rf - cu); }
            X = MFMA32(pack8f(a), qd1[ks], X); }
        if (st == tt) {
#pragma unroll
            for (int r = 0; r < 16; ++r) if (crow(r, hf) > l31) X[r] = 0.f; }
        const bf16x8 xf0 = pack8(X, 0), xf1 = pack8(X, 1);
        const bf16_t* vp = VA + (size_t)srow * 512 + h * 128 + 8 * hf;
#pragma unroll
        for (int vt = 0; vt < 4; ++vt) { f32x16 vx = zero16(); vx = MFMA32(*(const bf16x8*)(vp + 32 * vt), id0, vx); vx = MFMA32(*(const bf16x8*)(vp + 32 * vt + 16), id1, vx);
            OT[vt] = MFMA32(pack8(vx, 0), xf0, OT[vt]); OT[vt] = MFMA32(pack8(vx, 1), xf1, OT[vt]); }
    }
    float ss = 0.f;
#pragma unroll
    for (int vt = 0; vt < 4; ++vt)
#pragma unroll
        for (int r = 0; r < 16; ++r) ss += OT[vt][r] * OT[vt][r];
    ss += __shfl_xor(ss, 32);
    const float rstd = __builtin_amdgcn_rsqf(ss * (1.f / 128.f) + EPS);
    const bf16_t* gap = GA + (size_t)trow * 512 + h * 128; const float* onp = p.out_norm + h * 128;
    if (obase) qap = obase + (size_t)trow * 512 + h * 128;
#pragma unroll
    for (int vt = 0; vt < 4; ++vt)
#pragma unroll
        for (int g = 0; g < 4; ++g) { const int v0 = 32 * vt + 8 * g + 4 * hf; const f32x4 on = *(const f32x4*)(onp + v0); const u32x2 ga = *(const u32x2*)(gap + v0);
            u32x2 o; o.x = pk2(OT[vt][4 * g] * rstd * on[0] * bflo(ga.x), OT[vt][4 * g + 1] * rstd * on[1] * bfhi(ga.x));
            o.y = pk2(OT[vt][4 * g + 2] * rstd * on[2] * bflo(ga.y), OT[vt][4 * g + 3] * rstd * on[3] * bfhi(ga.y)); *(u32x2*)(qap + v0) = o; }
}


#define XB_TMO      128
#define XB_XCNT(j)  (256  + 64 * (j))
#define XB_XSUB(j)  (1280 + 64 * (j))
#define XB_XGEN(j)  (2304 + 64 * (j))
#define XB_TOP      3328
#define XB_TOPGEN   3392
#define XCD_BAR_WORDS 3456
#define XB_SPIN_CAP (1u << 18)
DI unsigned xb_ld(unsigned* p)              { return __hip_atomic_load(p, __ATOMIC_RELAXED, __HIP_MEMORY_SCOPE_AGENT); }
DI unsigned xb_add(unsigned* p, unsigned v) { return __hip_atomic_fetch_add(p, v, __ATOMIC_RELAXED, __HIP_MEMORY_SCOPE_AGENT); }
DI unsigned xb_xcc_id() { return (unsigned)__builtin_amdgcn_s_getreg((3 << 11) | 20) & 0xFu; }
#define XB_SPIN(cond, bar) do { unsigned _sp = 0; while (cond) { __builtin_amdgcn_s_sleep(1); \
    if ((++_sp & 255u) == 0u) { if (xb_ld(&(bar)[XB_TMO])) break; if (_sp > XB_SPIN_CAP) { atomicAdd(&(bar)[XB_TMO], 1u); break; } } } } while (0)
struct XcdBarrier { unsigned* bar; unsigned x; volatile LAS unsigned* st; };
DI XcdBarrier xcd_barrier_post(unsigned* bar, volatile LAS unsigned* st) {
    XcdBarrier b; b.bar = bar; b.x = xb_xcc_id(); b.st = st;
    if (threadIdx.x == 0) (void)xb_add(&bar[XB_XCNT(b.x)], 1u);
    return b;
}
DI void xcd_barrier_complete(unsigned* bar, unsigned x, unsigned& nloc, unsigned& nx) {
    const unsigned G = gridDim.x * gridDim.y * gridDim.z;
    unsigned sum, cnt, mine, sp = 0u;
    for (;;) {
        sum = 0u; cnt = 0u; mine = 0u;
#pragma unroll
        for (unsigned j = 0; j < 16; ++j) { const unsigned c = xb_ld(&bar[XB_XCNT(j)]); sum += c; cnt += (c > 0u) ? 1u : 0u; mine = (j == x) ? c : mine; }
        if (sum == G) break;
        __builtin_amdgcn_s_sleep(1);
        if ((++sp & 255u) == 0u) { if (xb_ld(&bar[XB_TMO])) break; if (sp > XB_SPIN_CAP) { atomicAdd(&bar[XB_TMO], 1u); break; } }
    }
    nloc = mine > 0u ? mine : 1u; nx = cnt > 0u ? cnt : 1u;
}
DI void xcd_barrier(const XcdBarrier& b) {
    asm volatile("s_waitcnt vmcnt(0)" ::: "memory");
    __syncthreads();
    if (threadIdx.x == 0) {
        unsigned* bar = b.bar;
        __builtin_amdgcn_s_waitcnt(0);
        unsigned nloc = b.st[0], nx = b.st[1];
        if (nloc == 0u) { xcd_barrier_complete(bar, b.x, nloc, nx); b.st[0] = nloc; b.st[1] = nx; }
        const unsigned old = xb_add(&bar[XB_XSUB(b.x)], 1u);
        const unsigned gen = old / nloc;
        if (old + 1u == (gen + 1u) * nloc) {
            __builtin_amdgcn_fence(__ATOMIC_RELEASE, "agent");
            asm volatile("s_waitcnt vmcnt(0)" ::: "memory");
            const unsigned og = xb_add(&bar[XB_TOP], 1u);
            const unsigned tg = og / nx;
            if (og + 1u == (tg + 1u) * nx) xb_add(&bar[XB_TOPGEN], 1u);
            else XB_SPIN(xb_ld(&bar[XB_TOPGEN]) == tg, bar);
            __builtin_amdgcn_fence(__ATOMIC_ACQUIRE, "agent");
            xb_add(&bar[XB_XGEN(b.x)], 1u);
            asm volatile("s_waitcnt vmcnt(0)" ::: "memory");
        } else {
            XB_SPIN(xb_ld(&bar[XB_XGEN(b.x)]) == gen, bar);
            __builtin_amdgcn_fence(__ATOMIC_ACQUIRE, "agent");
            asm volatile("s_waitcnt vmcnt(0)" ::: "memory");
        }
    }
    __syncthreads();
}

__global__ void __launch_bounds__(512, 2) fwd_megakernel(Params p) {
    extern __shared__ __attribute__((aligned(16))) unsigned char lds_raw[];
    LAS unsigned char* lds = (LAS unsigned char*)lds_raw;
    cg::grid_group grid = cg::this_grid();
    const int G = gridDim.x, bx = blockIdx.x;
    volatile LAS unsigned* bst = (volatile LAS unsigned*)(lds + LDS_ST_OFF);
    if (threadIdx.x < 2) bst[threadIdx.x] = 0u;
    __syncthreads();
    const XcdBarrier xbar = xcd_barrier_post((unsigned*)(p.ws + WS_BAR), bst);
#define GRID_BAR() xcd_barrier(xbar)
    unsigned char* ws = p.ws;
    float* MOD = (float*)(ws + WS_MOD); bf16_t* H = (bf16_t*)(ws + WS_H);

    phase_prep(p, lds);
    grid.sync();
    { pg8::Gemm g{(const bf16_t*)(ws + WS_SC), (const bf16_t*)(ws + WS_WADA), 256, 6144, 1024}; pg8::StaticOrder S; S.init(256, 6144, G, bx);
      EpiMod E{MOD, p.b_ada}; pg8::gemm_phase<EpiMod, pg8::StaticOrder, true, true>(lds, g, S, E); }
    GRID_BAR();
    phase_norm_mod(p.x_prompt, p.x_sample, p.norm_mix, MOD, 0, 1024, H);
#if PROBE_DUP == 1
    GRID_BAR(); phase_norm_mod(p.x_prompt, p.x_sample, p.norm_mix, MOD, 0, 1024, H);
#endif
#if PROBE_DUP == 10
    GRID_BAR(); GRID_BAR(); GRID_BAR(); GRID_BAR(); GRID_BAR(); GRID_BAR(); GRID_BAR(); GRID_BAR(); GRID_BAR(); GRID_BAR();
#endif
    GRID_BAR();
    { pg8::Gemm g{H, (const bf16_t*)(ws + WS_WIN), T, INC, 1024}; pg8::StaticOrder S; S.init(T, INC, G, bx);
      EpiIn E{(bf16_t*)(ws + WS_QOB), (bf16_t*)(ws + WS_KA), (bf16_t*)(ws + WS_VA), (bf16_t*)(ws + WS_GA), (bf16_t*)(ws + WS_KB), (bf16_t*)(ws + WS_VB),
              (bf16_t*)(p.out), (bf16_t*)(p.out) + (size_t)T * 1024, (float*)(ws + WS_CUM), (float*)(ws + WS_DEC), p.lb_logits, p.out};
      pg8::gemm_phase<EpiIn, pg8::StaticOrder, true, true>(lds, g, S, E);
#if PROBE_DUP == 2
      GRID_BAR(); pg8::gemm_phase<EpiIn, pg8::StaticOrder, true, true>(lds, g, S, E);
#endif
    }
    GRID_BAR();
    { const int tid = fresh_tid(), lane = tid & 63, wave = __builtin_amdgcn_readfirstlane(tid >> 6);
      for (int it = wave * G + bx; it < NCH * 32; it += 8 * G) hgrn_u_item(p, it, lane);
#if PROBE_DUP == 3
      for (int it = wave * G + bx; it < NCH * 32; it += 8 * G) hgrn_u_item(p, it, lane);
#endif
    }
    GRID_BAR();
    {
        const int tid = fresh_tid(), lane = tid & 63, wave = __builtin_amdgcn_readfirstlane(tid >> 6);
        LAS float* biasl = (LAS float*)lds;
        for (int i = tid; i < 8 * 192; i += 512) biasl[i] = p.rel_bias[i] * LOG2E;
        __syncthreads();
#if PROBE_DUP == 4
        if (wave != 0) { const int gw = (wave - 1) * G + bx, NGW = 7 * G; for (int it = gw; it < NCH * 16; it += NGW) attn_item(p, it, lane, biasl, (bf16_t*)(ws + WS_SST), 512); }
        GRID_BAR();
#endif
#if PROBE_DUP == 41
        if (wave == 0) { for (int it = bx; it < 256; it += G) scan_prompt_item(p, it, lane); }
        GRID_BAR();
#endif
        if (wave == 0) { for (int it = bx; it < 256; it += G) scan_prompt_item(p, it, lane); }
        else {
            const int gw = (wave - 1) * G + bx, NGW = 7 * G;
            for (int it = gw; it < 4096; it += NGW) scan_sample_item(p, it, lane);
            for (int it = gw; it < NCH * 16; it += NGW) attn_item(p, it, lane, biasl);
        }
    }
    GRID_BAR();
    { const int tid = fresh_tid(), lane = tid & 63, wave = __builtin_amdgcn_readfirstlane(tid >> 6);
#if PROBE_DUP == 5
      for (int it = wave * G + bx; it < NCH * 8; it += 8 * G) hgrn_out_item(p, it, lane, (bf16_t*)(ws + WS_U));
      GRID_BAR();
#endif
      for (int it = wave * G + bx; it < NCH * 8; it += 8 * G) hgrn_out_item(p, it, lane); }
    GRID_BAR();
    { pg8::Gemm g{(const bf16_t*)(ws + WS_QOB), (const bf16_t*)(ws + WS_WAB), T, 1024, 1024}; pg8::StaticOrder S; S.init(T, 1024, G, bx);
      EpiMerge E{(const bf16_t*)(p.out), (const bf16_t*)(p.out) + (size_t)T * 1024, (bf16_t*)(ws + WS_M)};
      pg8::gemm_phase<EpiMerge, pg8::StaticOrder, true, true>(lds, g, S, E); }
    GRID_BAR();
    const bool split_ps = G >= 64;
    { pg8::Gemm g{(const bf16_t*)(ws + WS_M), (const bf16_t*)(ws + WS_WO), T, 1024, 1024}; EpiRes<false> E{p.x_prompt, p.x_sample, nullptr, (bf16_t*)(ws + WS_X1B), MOD + 2048};
      if (split_ps) {
        { pg8::StaticOrder S; S.init(TP, 1024, G, bx); pg8::gemm_phase<EpiRes<false>, pg8::StaticOrder, true, true>(lds, g, S, E); }
        GRID_BAR();
        if (bx < 32) { pg8::StaticOrder S; S.init(TS, 1024, 32, bx, TP / 256); pg8::gemm_phase<EpiRes<false>, pg8::StaticOrder, true, true>(lds, g, S, E); }
        else phase_norm_mod_b((const bf16_t*)(ws + WS_X1B), p.norm_ffn, MOD, 3072, 4096, H, 0, TP, 32);
        GRID_BAR();
        phase_norm_mod_b((const bf16_t*)(ws + WS_X1B), p.norm_ffn, MOD, 3072, 4096, H, TP, T, 0);
      } else {
        pg8::StaticOrder S; S.init(T, 1024, G, bx); pg8::gemm_phase<EpiRes<false>, pg8::StaticOrder, true, true>(lds, g, S, E);
        GRID_BAR();
        phase_norm_mod_b((const bf16_t*)(ws + WS_X1B), p.norm_ffn, MOD, 3072, 4096, H);
      } }
    GRID_BAR();
    { pg8::Gemm g{H, (const bf16_t*)(ws + WS_WFI), T, INC, 1024}; pg8::StaticOrder S; S.init(T, INC, G, bx);
      EpiFfnIn E{(bf16_t*)(ws + WS_HID)}; pg8::gemm_phase<EpiFfnIn, pg8::StaticOrder, true, true>(lds, g, S, E);
#if PROBE_DUP == 9
      GRID_BAR(); pg8::gemm_phase<EpiFfnIn, pg8::StaticOrder, true, true>(lds, g, S, E);
#endif
    }
    GRID_BAR();
    { pg8::Gemm g{(const bf16_t*)(ws + WS_HID), (const bf16_t*)(ws + WS_WFO), T, 1024, FF}; EpiRes<true> E{nullptr, nullptr, (const bf16_t*)(ws + WS_X1B), (bf16_t*)(ws + WS_X2B), MOD + 5120};
      if (split_ps) {
        { pg8::StaticOrder S; S.init(TP, 1024, G, bx); pg8::gemm_phase<EpiRes<true>, pg8::StaticOrder, true, true>(lds, g, S, E); }
        GRID_BAR();
        float* PART = (float*)(ws + WS_CUM + 20 * MiB);
        if (bx < 64) { const int ks = bx >> 5; pg8::Gemm gs{(const bf16_t*)(ws + WS_HID) + ks * (FF / 2), (const bf16_t*)(ws + WS_WFO) + ks * (FF / 2), T, 1024, FF / 2, FF};
            pg8::StaticOrder S; S.init(TS, 1024, 32, bx & 31, TP / 256); EpiPart EP{PART + (size_t)ks * TS * D, TP}; pg8::gemm_phase<EpiPart, pg8::StaticOrder, true, true>(lds, gs, S, EP); }
        else phase_final_norm((const bf16_t*)(ws + WS_X2B), p.out, p.norm_final, 0, TP, 64);
        GRID_BAR();
        phase_final_norm_parts((const bf16_t*)(ws + WS_X1B), PART, PART + (size_t)TS * D, MOD + 5120, p.out, p.norm_final);
      } else {
        pg8::StaticOrder S; S.init(T, 1024, G, bx); pg8::gemm_phase<EpiRes<true>, pg8::StaticOrder, true, true>(lds, g, S, E);
        GRID_BAR();
        phase_final_norm((const bf16_t*)(ws + WS_X2B), p.out, p.norm_final);
      } }
}

extern "C" void kernel_launch(void* const* d_in, const int* in_sizes, int n_in, void* d_out, int out_size, void* d_ws, size_t ws_size, hipStream_t stream) {
    static int grid = 0;
    if (grid == 0) {
        if (n_in != 21 || (size_t)out_size != OUT_TOTAL || ws_size < WS_END) { fprintf(stderr, "kernel_launch: unexpected sizes n_in %d out %d ws %zu\n", n_in, out_size, ws_size); grid = -1; return; }
        int dev = 0, cus = 0, per = 0;
        (void)hipGetDevice(&dev); (void)hipDeviceGetAttribute(&cus, hipDeviceAttributeMultiprocessorCount, dev);
        (void)hipFuncSetAttribute((const void*)fwd_megakernel, hipFuncAttributeMaxDynamicSharedMemorySize, LDS_BYTES);
        (void)hipOccupancyMaxActiveBlocksPerMultiprocessor(&per, (const void*)fwd_megakernel, 512, LDS_BYTES);
        if (per < 1) per = 1;
        grid = cus * per; fprintf(stderr, "kernel_launch: grid %d (cus %d x %d)\n", grid, cus, per);
    }
    if (grid < 0) return;
    if (hipMemsetAsync((char*)d_ws + WS_BAR, 0, BAR_BYTES, stream) != hipSuccess) { fprintf(stderr, "kernel_launch: memset failed\n"); return; }
    Params p{};
    const float** f = (const float**)&p;
    for (int i = 0; i < 21; ++i) f[i] = (const float*)d_in[i];
    p.out = (float*)d_out; p.ws = (unsigned char*)d_ws;
    void* args[] = {&p};
    hipError_t e = hipLaunchCooperativeKernel((const void*)fwd_megakernel, dim3(grid), dim3(512), args, LDS_BYTES, stream);
    if (e != hipSuccess) fprintf(stderr, "cooperative launch failed: %s (grid %d)\n", hipGetErrorString(e), grid);
}
```

```cpp
#include <hip/hip_runtime.h>
#include <hip/hip_cooperative_groups.h>
#include <cstdio>
#include <cstdint>
namespace cg = cooperative_groups;
#ifndef PROBE_DUP
#define PROBE_DUP 0
#endif

#define DI __device__ __forceinline__
#define LAS __attribute__((address_space(3)))
typedef unsigned short bf16_t;
typedef short bf16x8 __attribute__((ext_vector_type(8)));
typedef float f32x4 __attribute__((ext_vector_type(4)));
typedef float f32x2 __attribute__((ext_vector_type(2)));
typedef float f32x16 __attribute__((ext_vector_type(16)));
typedef unsigned u32x4 __attribute__((ext_vector_type(4)));
typedef unsigned u32x2 __attribute__((ext_vector_type(2)));
typedef __bf16 bf2_t __attribute__((ext_vector_type(2)));

constexpr int D = 1024, TP = 32768, TS = 2048, T = TP + TS, NCH = T / 64, NBATCH = 34;
constexpr int INC = 5632, FF = 2816;
constexpr float EPS = 1e-6f, LOG2E = 1.4426950408889634f;
constexpr size_t OFF_Y = 0, OFF_SP = (size_t)T * D, OFF_KP = OFF_SP + 131072, OFF_VP = OFF_KP + 524288, OFF_SS = OFF_VP + 524288,
                 OFF_KS = OFF_SS + 2097152, OFF_VS = OFF_KS + 1048576, OUT_TOTAL = OFF_VS + 1048576;
constexpr size_t MiB = 1u << 20;
constexpr size_t WS_MOD = 1 * MiB, WS_DEC = 2 * MiB, WS_SC = 4 * MiB, WS_WADA = 5 * MiB, WS_WIN = 17 * MiB, WS_WAB = 28 * MiB, WS_WO = 30 * MiB,
                 WS_WFI = 32 * MiB, WS_WFO = 43 * MiB, WS_H = 50 * MiB, WS_QOB = 118 * MiB, WS_KA = 186 * MiB, WS_VA = 220 * MiB, WS_GA = 254 * MiB,
                 WS_KB = 288 * MiB, WS_VB = 322 * MiB, WS_CUM = 356 * MiB, WS_SST = 424 * MiB, WS_END = 492 * MiB;
constexpr size_t WS_U = WS_H, WS_M = WS_KA, WS_HID = WS_KA, WS_X1B = WS_QOB, WS_X2B = WS_H;
constexpr size_t WS_BAR = 0, BAR_BYTES = 16384;
constexpr int LDS_BYTES = 140 * 1024, LDS_ST_OFF = 136 * 1024;

struct Params {
    const float *x_prompt, *x_sample, *c_prompt, *c_sample, *state, *cache_k, *cache_v, *w_ada, *b_ada, *norm_mix, *w_in, *lb_logits, *out_norm,
                *w_a, *rel_bias, *w_b, *w_out, *norm_ffn, *w_ffn_in, *w_ffn_out, *norm_final;
    float* out; unsigned char* ws;
};

DI int fresh_tid() { int t = threadIdx.x; asm volatile("" : "+v"(t)); return t; }
DI int launder(int v) { asm volatile("" : "+v"(v)); return v; }
DI unsigned pk2(float a, float b) { f32x2 v = {a, b}; bf2_t r = __builtin_convertvector(v, bf2_t); return __builtin_bit_cast(unsigned, r); }
DI float bflo(unsigned u) { return __uint_as_float(u << 16); }
DI float bfhi(unsigned u) { return __uint_as_float(u & 0xffff0000u); }
DI float bf2f(short s) { return __uint_as_float(((unsigned)(unsigned short)s) << 16); }
DI float sigm(float x) { return __builtin_amdgcn_rcpf(1.f + __expf(-x)); }
DI float silu(float x) { return x * sigm(x); }
DI int batch_of(int r) { return r < TP ? (r >> 14) : 2 + ((r - TP) >> 6); }
DI int crow(int reg, int h) { return (reg & 3) + 8 * (reg >> 2) + 4 * h; }
DI bf16x8 pack8(const f32x16& x, int s) {
    u32x4 p; p.x = pk2(x[8 * s], x[8 * s + 1]); p.y = pk2(x[8 * s + 2], x[8 * s + 3]); p.z = pk2(x[8 * s + 4], x[8 * s + 5]); p.w = pk2(x[8 * s + 6], x[8 * s + 7]);
    return __builtin_bit_cast(bf16x8, p);
}
DI bf16x8 pack8f(const float* v) { u32x4 p; p.x = pk2(v[0], v[1]); p.y = pk2(v[2], v[3]); p.z = pk2(v[4], v[5]); p.w = pk2(v[6], v[7]); return __builtin_bit_cast(bf16x8, p); }
DI bf16x8 ident_frag(int ks, int l31, int hf) {
    const int jj = l31 - 16 * ks - 8 * hf; bf16x8 r;
#pragma unroll
    for (int j = 0; j < 8; ++j) r[j] = (j == jj) ? (short)0x3F80 : (short)0;
    return r;
}
#define MFMA32(a, b, c) __builtin_amdgcn_mfma_f32_32x32x16_bf16((a), (b), (c), 0, 0, 0)
DI f32x16 zero16() { f32x16 z;
#pragma unroll
    for (int i = 0; i < 16; ++i) z[i] = 0.f; return z; }

namespace pg8 {
constexpr int BM = 256, BK = 64, HALF = 128, HTB = HALF * BK * 2, STAGE_BYTES = 8 * HTB, NXCD = 8, WGM = 8;
__host__ __device__ __forceinline__ int lds_byte(int r, int c) { const int st = (r >> 4) * 2 + (c >> 5), rr = r & 15, cc = c & 31, ob = rr * 64 + cc * 2; return st * 1024 + (ob ^ (((ob >> 9) & 1) << 5)); }
__host__ __device__ __forceinline__ void stage_rc(int b, int& R, int& C) { const int st = b / 1024, sb = b % 1024, swz = sb ^ (((sb >> 9) & 1) << 5); R = (st >> 1) * 16 + swz / 64; C = (st & 1) * 32 + (swz % 64) / 2; }
__host__ __device__ __forceinline__ int perm32(int rho) { const int n = rho >> 4, i = rho & 15; return 8 * (i >> 2) + 4 * n + (i & 3); }
struct Unit { int pm, pn; };
struct Gemm { const bf16_t* A; const bf16_t* Bt; int M, N, K, ld; };
struct StaticOrder {
    int nM, nN, nwg, G, c, pm_off;
    __device__ void init(int M, int N, int G_, int c_, int pm_off_ = 0) { nM = M / BM; nN = N / BM; nwg = nM * nN; G = G_; c = c_; pm_off = pm_off_; }
    __device__ bool next(int i, Unit& u) const {
        const long L = (long)i * G + c; if (L >= nwg) return false;
        int wgid = (int)L; { const int q = nwg / NXCD, r = nwg % NXCD, xcd = wgid % NXCD, off = wgid / NXCD; wgid = (xcd < r ? xcd * (q + 1) : r * (q + 1) + (xcd - r) * q) + off; }
        const int nig = WGM * nN, gid = wgid / nig, fm = gid * WGM, gsz = (nM - fm) < WGM ? (nM - fm) : WGM;
        u.pm = pm_off + fm + ((wgid % nig) % gsz); u.pn = (wgid % nig) / gsz; return true;
    }
};
template <class Epi, class Sched, bool ALIGN_EPI = false, bool SP2 = false>
__device__ __forceinline__ void gemm_phase(LAS unsigned char* lds, const Gemm g, const Sched& S, const Epi& E) {
    const int tid = fresh_tid(), wid = __builtin_amdgcn_readfirstlane(tid >> 6), lane = tid & 63, wr = wid >> 2, wc = wid & 3, fr = lane & 15, fq = lane >> 4;
    const int K = g.ld ? g.ld : g.K, nt = g.K / BK;
    unsigned voffA[2], voffB[2];
#pragma unroll
    for (int i = 0; i < 2; ++i) { int R, C; stage_rc(tid * 16 + i * 8192, R, C); const int Rb = Epi::PERM ? ((R & ~31) + perm32(R & 31)) : R;
        voffA[i] = (unsigned)(R * K + C) * 2u; voffB[i] = (unsigned)(Rb * K + C) * 2u; }
    const size_t kstep = (size_t)(BK * 2);
    const size_t hstep = (size_t)HALF * K * 2;
    const size_t tstep = 2 * hstep;
    const unsigned ldsw = (unsigned)wid * 1024u;
    const int aoff = lds_byte(wr * 64 + fr, fq * 8), boff = lds_byte(wc * 32 + fr, fq * 8);
#define PG8_SA(b, h) (((b) * 2 + (h)) * HTB)
#define PG8_SB(b, h) ((4 + (b) * 2 + (h)) * HTB)
#define PG8_STAGE(bufoff, gbase, voff) do { _Pragma("unroll") for (int _i = 0; _i < 2; ++_i) \
        __builtin_amdgcn_global_load_lds((const unsigned*)((const char*)(gbase) + (voff)[_i]), (LAS unsigned*)(lds + (bufoff) + ldsw + _i * 8192), 16, 0, 0); } while (0)
#define PG8_LDA(dst, b, h) do { _Pragma("unroll") for (int m = 0; m < 4; ++m) _Pragma("unroll") for (int k = 0; k < 2; ++k) dst[m][k] = *(const LAS bf16x8*)(lds + PG8_SA(b, h) + aoff + m * 2048 + k * 1024); } while (0)
#define PG8_LDB(dst, b, h) do { _Pragma("unroll") for (int n = 0; n < 2; ++n) _Pragma("unroll") for (int k = 0; k < 2; ++k) dst[n][k] = *(const LAS bf16x8*)(lds + PG8_SB(b, h) + boff + n * 2048 + k * 1024); } while (0)
#define PG8_MMA(ai, bj, At, Bt) do { __builtin_amdgcn_s_setprio(1); _Pragma("unroll") for (int m = 0; m < 4; ++m) _Pragma("unroll") for (int n = 0; n < 2; ++n) _Pragma("unroll") for (int k = 0; k < 2; ++k) \
        acc[ai][bj][m][n] = __builtin_amdgcn_mfma_f32_16x16x32_bf16(Bt[n][k], At[m][k], acc[ai][bj][m][n], 0, 0, 0); __builtin_amdgcn_s_setprio(0); } while (0)
#define PG8_WAIT_V(n) asm volatile("s_waitcnt vmcnt(" #n ")" ::: "memory")
#define PG8_WAIT_L(n) asm volatile("s_waitcnt lgkmcnt(" #n ")" ::: "memory")
#define PG8_BAR __builtin_amdgcn_s_barrier()
#define PG8_SCHED __builtin_amdgcn_sched_barrier(0)
    Unit cur, nxt; int ui = 0;
    if (!S.next(0, cur)) return;
    f32x4 acc[2][2][4][2];
#pragma unroll
    for (int a = 0; a < 2; ++a)
#pragma unroll
        for (int b = 0; b < 2; ++b)
#pragma unroll
            for (int m = 0; m < 4; ++m)
#pragma unroll
                for (int n = 0; n < 2; ++n) acc[a][b][m][n] = (f32x4){0.f, 0.f, 0.f, 0.f};
    bf16x8 At[4][2], B0[2][2], B1[2][2];
    const char* cA = (const char*)g.A + (size_t)cur.pm * tstep; const char* cB = (const char*)g.Bt + (size_t)cur.pn * tstep;
    if constexpr (SP2) {
        PG8_STAGE(PG8_SB(0, 0), cB, voffB); PG8_STAGE(PG8_SB(0, 1), cB + hstep, voffB); PG8_STAGE(PG8_SA(0, 0), cA, voffA); PG8_STAGE(PG8_SA(0, 1), cA + hstep, voffA);
        if (wr == 1) PG8_BAR;
        PG8_WAIT_V(2); PG8_BAR;
        PG8_STAGE(PG8_SB(1, 0), cB + kstep, voffB); PG8_STAGE(PG8_SA(1, 0), cA + kstep, voffA); PG8_STAGE(PG8_SB(1, 1), cB + hstep + kstep, voffB);
        PG8_WAIT_V(6); PG8_BAR;
    } else {
        PG8_STAGE(PG8_SB(0, 0), cB, voffB); PG8_STAGE(PG8_SA(0, 0), cA, voffA); PG8_STAGE(PG8_SB(0, 1), cB + hstep, voffB); PG8_STAGE(PG8_SA(0, 1), cA + hstep, voffA);
        if (wr == 1) PG8_BAR;
        PG8_WAIT_V(4); PG8_BAR;
        PG8_STAGE(PG8_SB(1, 0), cB + kstep, voffB); PG8_STAGE(PG8_SA(1, 0), cA + kstep, voffA); PG8_STAGE(PG8_SB(1, 1), cB + hstep + kstep, voffB);
        PG8_WAIT_V(6); PG8_BAR;
    }
    for (;;) {
        const bool has_next = S.next(ui + 1, nxt);
        const char* nA = has_next ? (const char*)g.A + (size_t)nxt.pm * tstep : cA; const char* nB = has_next ? (const char*)g.Bt + (size_t)nxt.pn * tstep : cB;
        for (int t = 0; t < nt; t += 2) {
            if constexpr (Epi::MIDK) { if (t == nt / 2) E.mid(acc, cur, wr, wc, fr, fq); }
            const bool last = (t == nt - 2);
            const char* a1 = cA + (size_t)(t + 1) * kstep;
            const char* a2 = last ? nA : cA + (size_t)(t + 2) * kstep; const char* b2 = last ? nB : cB + (size_t)(t + 2) * kstep;
            const char* a3 = a2 + kstep; const char* b3 = b2 + kstep;
            if constexpr (SP2) {
            PG8_LDB(B0, 0, 0); PG8_LDB(B1, 0, 1); PG8_SCHED; PG8_LDA(At, 0, 0); PG8_STAGE(PG8_SA(1, 1), a1 + hstep, voffA);
            PG8_WAIT_V(8); PG8_WAIT_L(0); PG8_BAR; PG8_MMA(0, 0, At, B0); PG8_MMA(0, 1, At, B1); PG8_BAR; PG8_SCHED;
            PG8_LDA(At, 0, 1); PG8_STAGE(PG8_SB(0, 0), b2, voffB); PG8_STAGE(PG8_SB(0, 1), b2 + hstep, voffB); PG8_STAGE(PG8_SA(0, 0), a2, voffA);
            PG8_WAIT_V(8); PG8_WAIT_L(0); PG8_BAR; PG8_MMA(1, 0, At, B0); PG8_MMA(1, 1, At, B1); PG8_BAR; PG8_SCHED;
            PG8_LDB(B0, 1, 0); PG8_LDB(B1, 1, 1); PG8_SCHED; PG8_LDA(At, 1, 0); PG8_STAGE(PG8_SA(0, 1), a2 + hstep, voffA);
            PG8_WAIT_V(8); PG8_WAIT_L(0); PG8_BAR; PG8_MMA(0, 0, At, B0); PG8_MMA(0, 1, At, B1); PG8_BAR; PG8_SCHED;
            PG8_LDA(At, 1, 1); PG8_STAGE(PG8_SB(1, 0), b3, voffB); PG8_STAGE(PG8_SB(1, 1), b3 + hstep, voffB); PG8_STAGE(PG8_SA(1, 0), a3, voffA);
            PG8_WAIT_V(8); PG8_WAIT_L(0); PG8_BAR; PG8_MMA(1, 0, At, B0); PG8_MMA(1, 1, At, B1); PG8_BAR; PG8_SCHED;
            } else {
            PG8_LDB(B0, 0, 0); PG8_SCHED; PG8_LDA(At, 0, 0); PG8_STAGE(PG8_SA(1, 1), a1 + hstep, voffA);
            PG8_WAIT_L(8); PG8_BAR; PG8_WAIT_L(0); PG8_MMA(0, 0, At, B0); PG8_BAR; PG8_SCHED;
            PG8_LDB(B1, 0, 1); PG8_STAGE(PG8_SB(0, 0), b2, voffB);
            PG8_BAR; PG8_WAIT_L(0); PG8_MMA(0, 1, At, B1); PG8_BAR;
            PG8_LDA(At, 0, 1); PG8_STAGE(PG8_SA(0, 0), a2, voffA);
            PG8_BAR; PG8_WAIT_L(0); PG8_MMA(1, 0, At, B0); PG8_BAR; PG8_SCHED;
            PG8_STAGE(PG8_SB(0, 1), b2 + hstep, voffB);
            PG8_WAIT_V(6); PG8_BAR; PG8_MMA(1, 1, At, B1); PG8_BAR;
            PG8_LDB(B0, 1, 0); PG8_SCHED; PG8_LDA(At, 1, 0); PG8_STAGE(PG8_SA(0, 1), a2 + hstep, voffA);
            PG8_WAIT_L(8); PG8_BAR; PG8_WAIT_L(0); PG8_MMA(0, 0, At, B0); PG8_BAR; PG8_SCHED;
            PG8_LDB(B1, 1, 1); PG8_STAGE(PG8_SB(1, 0), b3, voffB);
            PG8_BAR; PG8_WAIT_L(0); PG8_MMA(0, 1, At, B1); PG8_BAR;
            PG8_LDA(At, 1, 1); PG8_STAGE(PG8_SA(1, 0), a3, voffA);
            PG8_BAR; PG8_WAIT_L(0); PG8_MMA(1, 0, At, B0); PG8_BAR; PG8_SCHED;
            PG8_STAGE(PG8_SB(1, 1), b3 + hstep, voffB);
            PG8_WAIT_V(6); PG8_BAR; PG8_MMA(1, 1, At, B1); PG8_BAR;
            }
        }
        if constexpr (ALIGN_EPI) { if (wr == 0) PG8_BAR; }
        E(acc, cur, wr, wc, fr, fq);
        if (!has_next) break;
#pragma unroll
        for (int a = 0; a < 2; ++a)
#pragma unroll
            for (int b = 0; b < 2; ++b)
#pragma unroll
                for (int m = 0; m < 4; ++m)
#pragma unroll
                    for (int n = 0; n < 2; ++n) acc[a][b][m][n] = (f32x4){0.f, 0.f, 0.f, 0.f};
        cur = nxt; cA = nA; cB = nB; ++ui;
        if constexpr (ALIGN_EPI) { if (wr == 1) PG8_BAR; }
    }
    PG8_WAIT_V(0);
    if constexpr (!ALIGN_EPI) { if (wr == 0) PG8_BAR; }
    PG8_BAR;
#undef PG8_SA
#undef PG8_SB
#undef PG8_STAGE
#undef PG8_LDA
#undef PG8_LDB
#undef PG8_MMA
#undef PG8_WAIT_V
#undef PG8_WAIT_L
#undef PG8_BAR
#undef PG8_SCHED
}
}
using pg8::Unit;
typedef f32x4 Acc[2][2][4][2];

DI u32x4 pack_row8(const f32x4& v0, const f32x4& v1) { u32x4 w; w.x = pk2(v0[0], v0[1]); w.y = pk2(v0[2], v0[3]); w.z = pk2(v1[0], v1[1]); w.w = pk2(v1[2], v1[3]); return w; }

struct EpiMod {
    static constexpr bool PERM = false, MIDK = false;
    float* mod; const float* bias;
    DI void operator()(Acc& acc, const Unit& u, int wr, int wc, int fr, int fq) const {
        { const int t_ = fresh_tid(); fr = t_ & 15; fq = (t_ >> 4) & 3; }
        if (u.pm != 0 || wr != 0) return;
#pragma unroll
        for (int m = 0; m < 3; ++m) { const int r = 16 * m + fr; if (r < NBATCH) {
#pragma unroll
            for (int bj = 0; bj < 2; ++bj)
#pragma unroll
                for (int n = 0; n < 2; ++n) { const int col = u.pn * 256 + bj * 128 + wc * 32 + n * 16 + 4 * fq;
                    *(f32x4*)(mod + (size_t)r * 6144 + col) = acc[0][bj][m][n] + *(const f32x4*)(bias + col); } } }
    }
};

struct EpiIn {
    static constexpr bool PERM = true, MIDK = false;
    bf16_t *QOB, *KA, *VA, *GA, *KB, *VB, *SGA, *SGB; float *CUM, *DEC; const float* lbl; float* out;
    DI void operator()(Acc& acc, const Unit& u, int wr, int wc, int fr, int fq) const {
        { const int t_ = fresh_tid(); fr = t_ & 15; fq = (t_ >> 4) & 3; }
        const int pn = u.pn, rt = wr * 64 + fr, row0 = u.pm * 256 + rt, cw = wc * 32 + 8 * fq, lane = fq * 16 + fr;
        if (pn >= 14) {
            const size_t o0 = (size_t)row0 * 1024 + (pn - 14) * 128 + cw;
#pragma unroll
            for (int ai = 0; ai < 2; ++ai)
#pragma unroll
                for (int m = 0; m < 4; ++m) { f32x4 r0, r1, b0, b1;
#pragma unroll
                    for (int j = 0; j < 4; ++j) { b0[j] = fmaxf(sigm(acc[ai][1][m][0][j]), 1e-30f); b1[j] = fmaxf(sigm(acc[ai][1][m][1][j]), 1e-30f);
                        r0[j] = sigm(acc[ai][0][m][0][j]) * __builtin_amdgcn_rcpf(b0[j]); r1[j] = sigm(acc[ai][0][m][1][j]) * __builtin_amdgcn_rcpf(b1[j]); }
                    const size_t o = o0 + (size_t)(ai * 128 + m * 16) * 1024;
                    *(u32x4*)(SGA + o) = pack_row8(r0, r1); *(u32x4*)(SGB + o) = pack_row8(b0, b1); __builtin_amdgcn_sched_barrier(0); }
            return;
        }
        const int seg = pn >> 1, col0 = (pn & 1) * 256 + cw;
        if (seg == 1) {
#pragma unroll
            for (int bj = 0; bj < 2; ++bj) {
                float lb[2][4];
#pragma unroll
                for (int n = 0; n < 2; ++n)
#pragma unroll
                    for (int j = 0; j < 4; ++j) { const int c = col0 + bj * 128 + 4 * n + j; lb[n][j] = __builtin_amdgcn_rcpf(1.f + __expf(lbl[512 + c] - lbl[c])); }
#pragma unroll
                for (int ai = 0; ai < 2; ++ai) {
                    const size_t rbase = (size_t)(u.pm * 256 + ai * 128 + wr * 64 + launder(fr)) * 512 + col0 + bj * 128;
#pragma unroll
                    for (int m = 0; m < 4; ++m) { f32x4 k0, k1;
#pragma unroll
                        for (int j = 0; j < 4; ++j) {
                            float f = lb[0][j] + (1.f - lb[0][j]) * sigm(acc[ai][bj][m][0][j]); k0[j] = 1.f - f; acc[ai][bj][m][0][j] = __logf(f);
                            f = lb[1][j] + (1.f - lb[1][j]) * sigm(acc[ai][bj][m][1][j]); k1[j] = 1.f - f; acc[ai][bj][m][1][j] = __logf(f); }
                        *(u32x4*)(KA + rbase + (size_t)m * 16 * 512) = pack_row8(k0, k1); }
                    __builtin_amdgcn_sched_barrier(0);
#pragma unroll
                    for (int n = 0; n < 2; ++n)
#pragma unroll
                        for (int j = 0; j < 4; ++j) { float carry = 0.f;
#pragma unroll
                            for (int m = 0; m < 4; ++m) { float v = acc[ai][bj][m][n][j];
                                v += __int_as_float(__builtin_amdgcn_update_dpp(0, __float_as_int(v), 0x111, 0xf, 0xf, false));
                                v += __int_as_float(__builtin_amdgcn_update_dpp(0, __float_as_int(v), 0x112, 0xf, 0xf, false));
                                v += __int_as_float(__builtin_amdgcn_update_dpp(0, __float_as_int(v), 0x114, 0xf, 0xf, false));
                                v += __int_as_float(__builtin_amdgcn_update_dpp(0, __float_as_int(v), 0x118, 0xf, 0xf, false));
                                v += carry; carry = __shfl(v, lane | 15); acc[ai][bj][m][n][j] = v; } }
                    __builtin_amdgcn_sched_barrier(0);
#pragma unroll
                    for (int m = 0; m < 4; ++m) { float* cp = CUM + rbase + (size_t)m * 16 * 512; *(f32x4*)cp = acc[ai][bj][m][0]; *(f32x4*)(cp + 4) = acc[ai][bj][m][1]; }
                    if (fr == 15) {
#pragma unroll
                        for (int n = 0; n < 2; ++n) { f32x4 e;
#pragma unroll
                            for (int j = 0; j < 4; ++j) e[j] = __expf(acc[ai][bj][3][n][j]);
                            *(f32x4*)(DEC + (size_t)(u.pm * 4 + ai * 2 + wr) * 512 + col0 + bj * 128 + 4 * n) = e; } }
                    __builtin_amdgcn_sched_barrier(0);
                }
            }
            return;
        }
        bf16_t* dst; int pitch = 512; float* o32 = nullptr;
        switch (seg) {
            case 0: dst = QOB + col0; pitch = 1024; break;
            case 2: dst = VA + col0; break;
            case 3: dst = GA + col0; break;
            case 4: dst = QOB + 512 + col0; pitch = 1024; break;
            case 5: dst = KB + col0; break;
            default: dst = VB + col0; break;
        }
        if (seg >= 5) {
            if (u.pm >= 128) o32 = out + (seg == 5 ? OFF_KS : OFF_VS) + (size_t)((u.pm - 128) * 256 + rt) * 512 + col0;
            else if ((u.pm & 63) >= 62) o32 = out + (seg == 5 ? OFF_KP : OFF_VP) + (size_t)((u.pm >> 6) * 512 + ((u.pm & 63) - 62) * 256 + rt) * 512 + col0;
        }
        const bool act = (seg == 0 || seg == 3);
#pragma unroll
        for (int ai = 0; ai < 2; ++ai)
#pragma unroll
            for (int m = 0; m < 4; ++m)
#pragma unroll
                for (int bj = 0; bj < 2; ++bj) { f32x4 v0 = acc[ai][bj][m][0], v1 = acc[ai][bj][m][1];
                    if (act) {
#pragma unroll
                        for (int j = 0; j < 4; ++j) { v0[j] = silu(v0[j]); v1[j] = silu(v1[j]); } }
                    *(u32x4*)(dst + (size_t)(row0 + ai * 128 + m * 16) * pitch + bj * 128) = pack_row8(v0, v1);
                    if (o32) { float* op = o32 + (size_t)(ai * 128 + m * 16) * 512 + bj * 128; *(f32x4*)op = v0; *(f32x4*)(op + 4) = v1; } __builtin_amdgcn_sched_barrier(0); }
    }
};

struct EpiMerge {
    static constexpr bool PERM = true, MIDK = true;
    const bf16_t *SGR, *SGB; bf16_t* Mo;
    DI void mid(Acc& acc, const Unit& u, int wr, int wc, int fr, int fq) const {
        { const int t_ = fresh_tid(); fr = t_ & 15; fq = (t_ >> 4) & 3; }
        const size_t base = (size_t)(u.pm * 256 + wr * 64 + fr) * 1024 + u.pn * 256 + wc * 32 + 8 * fq;
#pragma unroll
        for (int ai = 0; ai < 2; ++ai) { u32x4 a[4][2];
#pragma unroll
            for (int m = 0; m < 4; ++m)
#pragma unroll
                for (int bj = 0; bj < 2; ++bj) a[m][bj] = *(const u32x4*)(SGR + base + (size_t)(ai * 128 + m * 16) * 1024 + bj * 128);
#pragma unroll
            for (int m = 0; m < 4; ++m)
#pragma unroll
                for (int bj = 0; bj < 2; ++bj)
#pragma unroll
                    for (int j = 0; j < 4; ++j) { acc[ai][bj][m][j >> 1][(j & 1) * 2] *= bflo(a[m][bj][j]); acc[ai][bj][m][j >> 1][(j & 1) * 2 + 1] *= bfhi(a[m][bj][j]); }
            __builtin_amdgcn_sched_barrier(0); }
    }
    DI void operator()(Acc& acc, const Unit& u, int wr, int wc, int fr, int fq) const {
        { const int t_ = fresh_tid(); fr = t_ & 15; fq = (t_ >> 4) & 3; }
        const size_t base = (size_t)(u.pm * 256 + wr * 64 + fr) * 1024 + u.pn * 256 + wc * 32 + 8 * fq;
#pragma unroll
        for (int ai = 0; ai < 2; ++ai) { u32x4 b[4][2];
#pragma unroll
            for (int m = 0; m < 4; ++m)
#pragma unroll
                for (int bj = 0; bj < 2; ++bj) b[m][bj] = *(const u32x4*)(SGB + base + (size_t)(ai * 128 + m * 16) * 1024 + bj * 128);
#pragma unroll
            for (int m = 0; m < 4; ++m)
#pragma unroll
                for (int bj = 0; bj < 2; ++bj) { f32x4 v0 = acc[ai][bj][m][0], v1 = acc[ai][bj][m][1]; const u32x4 g = b[m][bj];
                    v0[0] *= bflo(g[0]); v0[1] *= bfhi(g[0]); v0[2] *= bflo(g[1]); v0[3] *= bfhi(g[1]);
                    v1[0] *= bflo(g[2]); v1[1] *= bfhi(g[2]); v1[2] *= bflo(g[3]); v1[3] *= bfhi(g[3]);
                    *(u32x4*)(Mo + base + (size_t)(ai * 128 + m * 16) * 1024 + bj * 128) = pack_row8(v0, v1); }
            __builtin_amdgcn_sched_barrier(0); }
    }
};

template <bool BASE_BF16> struct EpiRes {
    static constexpr bool PERM = true, MIDK = false;
    const float *xp, *xs; const bf16_t* xb; bf16_t* xo; const float* gmod;
    DI void operator()(Acc& acc, const Unit& u, int wr, int wc, int fr, int fq) const {
        { const int t_ = fresh_tid(); fr = t_ & 15; fq = (t_ >> 4) & 3; }
        const int colb = u.pn * 256 + wc * 32 + 8 * fq;
#pragma unroll
        for (int ai = 0; ai < 2; ++ai) { const int r0 = u.pm * 256 + ai * 128 + wr * 64 + fr;
            const float* g = gmod + (size_t)batch_of(r0) * 6144 + colb;
            f32x4 gv[2][2];
#pragma unroll
            for (int bj = 0; bj < 2; ++bj) { gv[bj][0] = *(const f32x4*)(g + bj * 128); gv[bj][1] = *(const f32x4*)(g + bj * 128 + 4); }
            bf16_t* orow = xo + (size_t)r0 * D + colb;
            if constexpr (BASE_BF16) {
                const bf16_t* xr = xb + (size_t)r0 * D + colb; u32x4 xv[4][2];
#pragma unroll
                for (int m = 0; m < 4; ++m)
#pragma unroll
                    for (int bj = 0; bj < 2; ++bj) xv[m][bj] = *(const u32x4*)(xr + (size_t)m * 16 * D + bj * 128);
#pragma unroll
                for (int m = 0; m < 4; ++m)
#pragma unroll
                    for (int bj = 0; bj < 2; ++bj) { const u32x4 x = xv[m][bj]; const f32x4 a0 = acc[ai][bj][m][0] * gv[bj][0], a1 = acc[ai][bj][m][1] * gv[bj][1];
                        f32x4 v0 = {bflo(x[0]) + a0[0], bfhi(x[0]) + a0[1], bflo(x[1]) + a0[2], bfhi(x[1]) + a0[3]}, v1 = {bflo(x[2]) + a1[0], bfhi(x[2]) + a1[1], bflo(x[3]) + a1[2], bfhi(x[3]) + a1[3]};
                        *(u32x4*)(orow + (size_t)m * 16 * D + bj * 128) = pack_row8(v0, v1); }
            } else {
                const float* xr = (r0 < TP ? xp + (size_t)r0 * D : xs + (size_t)(r0 - TP) * D) + colb; f32x4 xv[4][2][2];
#pragma unroll
                for (int m = 0; m < 4; ++m)
#pragma unroll
                    for (int bj = 0; bj < 2; ++bj) { xv[m][bj][0] = *(const f32x4*)(xr + (size_t)m * 16 * D + bj * 128); xv[m][bj][1] = *(const f32x4*)(xr + (size_t)m * 16 * D + bj * 128 + 4); }
#pragma unroll
                for (int m = 0; m < 4; ++m)
#pragma unroll
                    for (int bj = 0; bj < 2; ++bj) *(u32x4*)(orow + (size_t)m * 16 * D + bj * 128) = pack_row8(xv[m][bj][0] + gv[bj][0] * acc[ai][bj][m][0], xv[m][bj][1] + gv[bj][1] * acc[ai][bj][m][1]);
            }
            __builtin_amdgcn_sched_barrier(0); }
    }
};

struct EpiPart {
    static constexpr bool PERM = false, MIDK = false;
    float* part; int row0;
    DI void operator()(Acc& acc, const Unit& u, int wr, int wc, int fr, int fq) const {
        { const int t_ = fresh_tid(); fr = t_ & 15; fq = (t_ >> 4) & 3; }
#pragma unroll
        for (int ai = 0; ai < 2; ++ai)
#pragma unroll
            for (int m = 0; m < 4; ++m) { float* prow = part + (size_t)(u.pm * 256 + ai * 128 + wr * 64 + m * 16 + fr - row0) * D + u.pn * 256 + wc * 32 + 4 * fq;
#pragma unroll
                for (int bj = 0; bj < 2; ++bj)
#pragma unroll
                    for (int n = 0; n < 2; ++n) *(f32x4*)(prow + bj * 128 + n * 16) = acc[ai][bj][m][n];
                __builtin_amdgcn_sched_barrier(0); }
    }
};

struct EpiFfnIn {
    static constexpr bool PERM = true, MIDK = false;
    bf16_t* HID;
    DI void operator()(Acc& acc, const Unit& u, int wr, int wc, int fr, int fq) const {
        { const int t_ = fresh_tid(); fr = t_ & 15; fq = (t_ >> 4) & 3; }
        bf16_t* base = HID + (size_t)(u.pm * 256 + wr * 64 + fr) * FF + u.pn * 128 + wc * 32 + 8 * fq;
#pragma unroll
        for (int ai = 0; ai < 2; ++ai)
#pragma unroll
            for (int m = 0; m < 4; ++m) { f32x4 v0, v1;
#pragma unroll
                for (int j = 0; j < 4; ++j) { v0[j] = silu(acc[ai][0][m][0][j]) * acc[ai][1][m][0][j]; v1[j] = silu(acc[ai][0][m][1][j]) * acc[ai][1][m][1][j]; }
                *(u32x4*)(base + (size_t)(ai * 128 + m * 16) * FF) = pack_row8(v0, v1); __builtin_amdgcn_sched_barrier(0); }
    }
};

DI void transpose_item(const float* W, int N, bf16_t* WT, int pitch, int koff, int k0, int n0, int drow0, LAS float* scr, int lane) {
#pragma unroll
    for (int i = 0; i < 32; ++i) { const int kk = 2 * i + (lane >> 5); scr[kk * 33 + (lane & 31)] = W[(size_t)(k0 + kk) * N + n0 + (lane & 31)]; }
    asm volatile("s_waitcnt lgkmcnt(0)" ::: "memory");
    const int c = lane & 7;
#pragma unroll
    for (int j = 0; j < 4; ++j) { const int n = (lane >> 3) + 8 * j; const LAS float* s = scr + (8 * c) * 33 + n;
        u32x4 o; o.x = pk2(s[0 * 33], s[1 * 33]); o.y = pk2(s[2 * 33], s[3 * 33]); o.z = pk2(s[4 * 33], s[5 * 33]); o.w = pk2(s[6 * 33], s[7 * 33]);
        *(u32x4*)(WT + (size_t)(drow0 + n) * pitch + koff + k0 + 8 * c) = o; }
    asm volatile("s_waitcnt lgkmcnt(0)" ::: "memory");
}
DI void phase_prep(const Params& p, LAS unsigned char* lds) {
    const int tid = fresh_tid(), lane = tid & 63, wave = __builtin_amdgcn_readfirstlane(tid >> 6);
    LAS float* scr = (LAS float*)(lds + wave * 16384);
    const int gw = blockIdx.x * 8 + wave, NGW = gridDim.x * 8;
    unsigned char* ws = p.ws;
    constexpr int I_ADA = 16 * 192, I_IN = 16 * 176, I_A = 8 * 32, I_O = 16 * 32, I_FI = 16 * 176, I_FO = 44 * 32;
    constexpr int NIT = I_ADA + I_IN + 2 * I_A + I_O + I_FI + I_FO;
    for (int it = gw; it < NIT; it += NGW) {
        int r = it;
        if (r < I_ADA) { const int kb = r / 192, nb = r % 192; transpose_item(p.w_ada, 6144, (bf16_t*)(ws + WS_WADA), 1024, 0, 64 * kb, 32 * nb, 32 * nb, scr, lane); continue; } r -= I_ADA;
        if (r < I_IN) { const int kb = r / 176, nb = r % 176, n0 = 32 * nb; int dr = n0;
            if (n0 >= 3584) { const int j = n0 < 4608 ? n0 - 3584 : n0 - 4608; dr = 3584 + 256 * (j >> 7) + (j & 127) + (n0 < 4608 ? 0 : 128); }
            transpose_item(p.w_in, INC, (bf16_t*)(ws + WS_WIN), 1024, 0, 64 * kb, n0, dr, scr, lane); continue; } r -= I_IN;
        if (r < I_A) { const int kb = r / 32, nb = r % 32; transpose_item(p.w_a, 1024, (bf16_t*)(ws + WS_WAB), 1024, 0, 64 * kb, 32 * nb, 32 * nb, scr, lane); continue; } r -= I_A;
        if (r < I_A) { const int kb = r / 32, nb = r % 32; transpose_item(p.w_b, 1024, (bf16_t*)(ws + WS_WAB), 1024, 512, 64 * kb, 32 * nb, 32 * nb, scr, lane); continue; } r -= I_A;
        if (r < I_O) { const int kb = r / 32, nb = r % 32; transpose_item(p.w_out, 1024, (bf16_t*)(ws + WS_WO), 1024, 0, 64 * kb, 32 * nb, 32 * nb, scr, lane); continue; } r -= I_O;
        if (r < I_FI) { const int kb = r / 176, nb = r % 176; const int n0 = 32 * nb; const int j0 = n0 < FF ? n0 : n0 - FF;
            transpose_item(p.w_ffn_in, INC, (bf16_t*)(ws + WS_WFI), 1024, 0, 64 * kb, n0, 256 * (j0 >> 7) + (j0 & 127) + (n0 < FF ? 0 : 128), scr, lane); continue; } r -= I_FI;
        { const int kb = r / 32, nb = r % 32; transpose_item(p.w_ffn_out, 1024, (bf16_t*)(ws + WS_WFO), FF, 0, 64 * kb, 32 * nb, 32 * nb, scr, lane); }
    }
    bf16_t* SC = (bf16_t*)(ws + WS_SC);
    for (int i = blockIdx.x * 512 + tid; i < 256 * 1024 / 2; i += gridDim.x * 512) { const int row = (2 * i) >> 10, col = (2 * i) & 1023; float a = 0.f, b = 0.f;
        if (row < NBATCH) { const float* c = row < 2 ? p.c_prompt + row * D : p.c_sample + (row - 2) * D; a = silu(c[col]); b = silu(c[col + 1]); }
        ((unsigned*)SC)[i] = pk2(a, b); }
}

DI float wave_sum(float v) {
#pragma unroll
    for (int o = 1; o < 64; o <<= 1) v += __shfl_xor(v, o);
    return v;
}
DI void phase_norm_mod(const float* xp, const float* xs, const float* nw, const float* mod, int sh_off, int sc_off, bf16_t* H) {
    const int tid = fresh_tid(), lane = tid & 63, wave = __builtin_amdgcn_readfirstlane(tid >> 6);
    const int gw = blockIdx.x * 8 + wave, NGW = gridDim.x * 8;
    for (int r = gw; r < T; r += NGW) {
        const float* xr = r < TP ? xp + (size_t)r * D : xs + (size_t)(r - TP) * D; const float* mb = mod + (size_t)batch_of(r) * 6144;
        f32x4 v[4]; float s = 0.f;
#pragma unroll
        for (int j = 0; j < 4; ++j) { v[j] = *(const f32x4*)(xr + 4 * lane + 256 * j); s += (v[j][0] * v[j][0] + v[j][1] * v[j][1]) + (v[j][2] * v[j][2] + v[j][3] * v[j][3]); }
        const float rstd = __builtin_amdgcn_rsqf(wave_sum(s) * (1.f / D) + EPS);
#pragma unroll
        for (int j = 0; j < 4; ++j) { const int col = 4 * lane + 256 * j; const f32x4 w = *(const f32x4*)(nw + col), sc = *(const f32x4*)(mb + sc_off + col), sh = *(const f32x4*)(mb + sh_off + col);
            const f32x4 h = v[j] * rstd * w * (sc + 1.f) + sh; u32x2 o; o.x = pk2(h[0], h[1]); o.y = pk2(h[2], h[3]);
            *(u32x2*)(H + (size_t)r * D + col) = o; }
    }
}
DI void phase_norm_mod_b(const bf16_t* xb, const float* nw, const float* mod, int sh_off, int sc_off, bf16_t* H, int r_lo = 0, int r_hi = T, int b_lo = 0) {
    const int tid = fresh_tid(), lane = tid & 63, wave = __builtin_amdgcn_readfirstlane(tid >> 6);
    const int gw = ((int)blockIdx.x - b_lo) * 8 + wave, NGW = ((int)gridDim.x - b_lo) * 8;
    for (int r = r_lo + gw; r < r_hi; r += NGW) {
        const bf16_t* xr = xb + (size_t)r * D; const float* mb = mod + (size_t)batch_of(r) * 6144;
        float v[2][8]; float s = 0.f;
#pragma unroll
        for (int j = 0; j < 2; ++j) { const u32x4 x = *(const u32x4*)(xr + 8 * lane + 512 * j);
#pragma unroll
            for (int i = 0; i < 4; ++i) { v[j][2 * i] = bflo(x[i]); v[j][2 * i + 1] = bfhi(x[i]); s += v[j][2 * i] * v[j][2 * i] + v[j][2 * i + 1] * v[j][2 * i + 1]; } }
        const float rstd = __builtin_amdgcn_rsqf(wave_sum(s) * (1.f / D) + EPS);
#pragma unroll
        for (int j = 0; j < 2; ++j) { const int col = 8 * lane + 512 * j; f32x4 h[2];
#pragma unroll
            for (int q = 0; q < 2; ++q) { const f32x4 w = *(const f32x4*)(nw + col + 4 * q), sc = *(const f32x4*)(mb + sc_off + col + 4 * q), sh = *(const f32x4*)(mb + sh_off + col + 4 * q);
                const f32x4 x = {v[j][4 * q], v[j][4 * q + 1], v[j][4 * q + 2], v[j][4 * q + 3]}; h[q] = x * rstd * w * (sc + 1.f) + sh; }
            *(u32x4*)(H + (size_t)r * D + col) = pack_row8(h[0], h[1]); }
    }
}
DI void phase_final_norm(const bf16_t* xb, float* y, const float* nw, int r_lo = 0, int r_hi = T, int b_lo = 0) {
    const int tid = fresh_tid(), lane = tid & 63, wave = __builtin_amdgcn_readfirstlane(tid >> 6);
    const int gw = ((int)blockIdx.x - b_lo) * 8 + wave, NGW = ((int)gridDim.x - b_lo) * 8;
    for (int r = r_lo + gw; r < r_hi; r += NGW) { const bf16_t* xr = xb + (size_t)r * D; float* yr = y + (size_t)r * D;
        float v[2][8]; float s = 0.f;
#pragma unroll
        for (int j = 0; j < 2; ++j) { const u32x4 x = *(const u32x4*)(xr + 8 * lane + 512 * j);
#pragma unroll
            for (int i = 0; i < 4; ++i) { v[j][2 * i] = bflo(x[i]); v[j][2 * i + 1] = bfhi(x[i]); s += v[j][2 * i] * v[j][2 * i] + v[j][2 * i + 1] * v[j][2 * i + 1]; } }
        const float rstd = __builtin_amdgcn_rsqf(wave_sum(s) * (1.f / D) + EPS);
#pragma unroll
        for (int j = 0; j < 2; ++j) { const int col = 8 * lane + 512 * j;
#pragma unroll
            for (int q = 0; q < 2; ++q) { const f32x4 x = {v[j][4 * q], v[j][4 * q + 1], v[j][4 * q + 2], v[j][4 * q + 3]}; *(f32x4*)(yr + col + 4 * q) = x * rstd * *(const f32x4*)(nw + col + 4 * q); } }
    }
}

DI void phase_final_norm_parts(const bf16_t* x1b, const float* part0, const float* part1, const float* g2mod, float* y, const float* nw) {
    const int tid = fresh_tid(), lane = tid & 63, wave = __builtin_amdgcn_readfirstlane(tid >> 6);
    const int gw = blockIdx.x * 8 + wave, NGW = gridDim.x * 8;
    for (int r = TP + gw; r < T; r += NGW) { const float* gb = g2mod + (size_t)batch_of(r) * 6144; const size_t po = (size_t)(r - TP) * D;
        f32x4 v[4]; float s = 0.f;
#pragma unroll
        for (int j = 0; j < 4; ++j) { const int col = 4 * lane + 256 * j; const u32x2 xb = *(const u32x2*)(x1b + (size_t)r * D + col);
            const f32x4 x = {bflo(xb.x), bfhi(xb.x), bflo(xb.y), bfhi(xb.y)};
            v[j] = x + *(const f32x4*)(gb + col) * (*(const f32x4*)(part0 + po + col) + *(const f32x4*)(part1 + po + col));
            s += (v[j][0] * v[j][0] + v[j][1] * v[j][1]) + (v[j][2] * v[j][2] + v[j][3] * v[j][3]); }
        const float rstd = __builtin_amdgcn_rsqf(wave_sum(s) * (1.f / D) + EPS);
#pragma unroll
        for (int j = 0; j < 4; ++j) { const int col = 4 * lane + 256 * j; *(f32x4*)(y + (size_t)r * D + col) = v[j] * rstd * *(const f32x4*)(nw + col); }
    }
}

DI void hgrn_u_item(const Params& p, int item, int lane) {
    const int c = item >> 5, rem = item & 31, h = rem >> 3, kt = (rem >> 1) & 3, vh = rem & 1, l31 = lane & 31, hf = lane >> 5;
    const float* CUM = (const float*)(p.ws + WS_CUM); const bf16_t* KA = (const bf16_t*)(p.ws + WS_KA); const bf16_t* VA = (const bf16_t*)(p.ws + WS_VA); bf16_t* U = (bf16_t*)(p.ws + WS_U);
    const int kcol = h * 128 + 32 * kt + l31;
    const float tot = CUM[(size_t)(c * 64 + 63) * 512 + kcol];
    bf16x8 kdf[2][2];
#pragma unroll
    for (int st = 0; st < 2; ++st) { f32x16 kd;
#pragma unroll
        for (int r = 0; r < 16; ++r) { const size_t idx = (size_t)(c * 64 + 32 * st + crow(r, hf)) * 512 + kcol; kd[r] = bf2f((short)KA[idx]) * __expf(tot - CUM[idx]); }
        kdf[st][0] = pack8(kd, 0); kdf[st][1] = pack8(kd, 1); }
    const bf16x8 id0 = ident_frag(0, l31, hf), id1 = ident_frag(1, l31, hf);
#pragma unroll
    for (int vtl = 0; vtl < 2; ++vtl) { const int vt = 2 * vh + vtl; f32x16 dacc = zero16();
#pragma unroll
        for (int st = 0; st < 2; ++st) { const bf16_t* vp = VA + (size_t)(c * 64 + 32 * st + l31) * 512 + h * 128 + 32 * vt + 8 * hf;
            f32x16 vx = zero16(); vx = MFMA32(*(const bf16x8*)vp, id0, vx); vx = MFMA32(*(const bf16x8*)(vp + 16), id1, vx);
            dacc = MFMA32(kdf[st][0], pack8(vx, 0), dacc); dacc = MFMA32(kdf[st][1], pack8(vx, 1), dacc); }
        bf16_t* up = U + ((size_t)(c * 4 + h) * 128 + 32 * vt + l31) * 128 + 32 * kt + 4 * hf;
#pragma unroll
        for (int g = 0; g < 4; ++g) { u32x2 o; o.x = pk2(dacc[4 * g], dacc[4 * g + 1]); o.y = pk2(dacc[4 * g + 2], dacc[4 * g + 3]); *(u32x2*)(up + 8 * g) = o; }
    }
}

DI void scan_prompt_item(const Params& p, int item, int lane) {
    const int bh = item >> 5, vq = item & 31, b = bh >> 2, h = bh & 3, kg = lane & 31, vv = lane >> 5;
    const float* __restrict__ DEC = (const float*)(p.ws + WS_DEC); const bf16_t* __restrict__ U = (const bf16_t*)(p.ws + WS_U); bf16_t* __restrict__ SST = (bf16_t*)(p.ws + WS_SST);
    f32x4 S0 = {0.f, 0.f, 0.f, 0.f}, S1 = {0.f, 0.f, 0.f, 0.f};
    const int v0 = 4 * vq + vv, v1 = v0 + 2;
#pragma unroll 16
    for (int n = 0; n < 256; ++n) { const int c = b * 256 + n;
        const f32x4 d = *(const f32x4*)(DEC + (size_t)c * 512 + h * 128 + 4 * kg);
        const size_t o0 = ((size_t)(c * 4 + h) * 128 + v0) * 128 + 4 * kg, o1 = ((size_t)(c * 4 + h) * 128 + v1) * 128 + 4 * kg;
        const u32x2 u0 = *(const u32x2*)(U + o0), u1 = *(const u32x2*)(U + o1);
        u32x2 s; s.x = pk2(S0[0], S0[1]); s.y = pk2(S0[2], S0[3]); *(u32x2*)(SST + o0) = s;
        s.x = pk2(S1[0], S1[1]); s.y = pk2(S1[2], S1[3]); *(u32x2*)(SST + o1) = s;
        S0[0] = d[0] * S0[0] + bflo(u0.x); S0[1] = d[1] * S0[1] + bfhi(u0.x); S0[2] = d[2] * S0[2] + bflo(u0.y); S0[3] = d[3] * S0[3] + bfhi(u0.y);
        S1[0] = d[0] * S1[0] + bflo(u1.x); S1[1] = d[1] * S1[1] + bfhi(u1.x); S1[2] = d[2] * S1[2] + bflo(u1.y); S1[3] = d[3] * S1[3] + bfhi(u1.y);
    }
    float* sp = p.out + OFF_SP + ((size_t)bh * 128 + 4 * kg) * 128;
#pragma unroll
    for (int i = 0; i < 4; ++i) { sp[(size_t)i * 128 + v0] = S0[i]; sp[(size_t)i * 128 + v1] = S1[i]; }
}
DI void scan_sample_item(const Params& p, int item, int lane) {
    const int bh = item >> 5, vq = item & 31, bs = bh >> 2, h = bh & 3, kg = lane & 31, vv = lane >> 5, c = 512 + bs;
    const float* DEC = (const float*)(p.ws + WS_DEC); const bf16_t* U = (const bf16_t*)(p.ws + WS_U); bf16_t* SST = (bf16_t*)(p.ws + WS_SST);
    const f32x4 d = *(const f32x4*)(DEC + (size_t)c * 512 + h * 128 + 4 * kg);
    const float* s0 = p.state + ((size_t)bh * 128 + 4 * kg) * 128; float* so = p.out + OFF_SS + ((size_t)bh * 128 + 4 * kg) * 128;
#pragma unroll
    for (int e = 0; e < 2; ++e) { const int v = 4 * vq + 2 * e + vv; const size_t o = ((size_t)(c * 4 + h) * 128 + v) * 128 + 4 * kg;
        const u32x2 u = *(const u32x2*)(U + o); f32x4 S;
#pragma unroll
        for (int i = 0; i < 4; ++i) S[i] = s0[(size_t)i * 128 + v];
        u32x2 s; s.x = pk2(S[0], S[1]); s.y = pk2(S[2], S[3]); *(u32x2*)(SST + o) = s;
        so[v] = d[0] * S[0] + bflo(u.x); so[128 + v] = d[1] * S[1] + bfhi(u.x); so[256 + v] = d[2] * S[2] + bflo(u.y); so[384 + v] = d[3] * S[3] + bfhi(u.y); }
}

DI void attn_item(const Params& p, int item, int lane, const LAS float* biasl, bf16_t* obase = nullptr, int opitch = 1024) {
    const int c = item >> 4, h = (item >> 1) & 7, qh = item & 1, l31 = lane & 31, hf = lane >> 5;
    bf16_t* qptr = (bf16_t*)(p.ws + WS_QOB) + (size_t)(c * 64 + qh * 32 + l31) * 1024 + 512 + h * 64;
    const bf16_t* KB = (const bf16_t*)(p.ws + WS_KB); const bf16_t* VB = (const bf16_t*)(p.ws + WS_VB);
    bf16x8 qf[4];
#pragma unroll
    for (int ks = 0; ks < 4; ++ks) qf[ks] = *(const bf16x8*)(qptr + 16 * ks + 8 * hf);
    const bf16x8 id0 = ident_frag(0, l31, hf), id1 = ident_frag(1, l31, hf);
    const LAS float* bl = biasl + h * 192;
    f32x16 OT0 = zero16(), OT1 = zero16(); float mrun = -1e30f, lsum = 0.f;
    int ntile, ncache, db0; size_t krow_first;
    if (c < 512) { const int n = c & 255, j0 = n < 8 ? n : 8; ntile = 2 * (j0 + 1); ncache = 0; db0 = 64 * j0 + 32 * qh; krow_first = (size_t)(c - j0) * 64; }
    else { ntile = 18; ncache = 16; db0 = 512 + 32 * qh; krow_first = (size_t)c * 64 - 512; }
    const int bs = c - 512;
    u32x4 nk[4], nv[4], nk2[4], nv2[4];
#define ATT_LOAD(i_) do { if ((i_) < ncache) { \
            const float* kp_ = p.cache_k + ((size_t)(bs * 512 + 32 * (i_) + l31) * 8 + h) * 64 + 8 * hf; const float* vp_ = p.cache_v + ((size_t)(bs * 512 + 32 * (i_) + l31) * 8 + h) * 64 + 8 * hf; \
            _Pragma("unroll") for (int ks = 0; ks < 4; ++ks) { nk[ks] = *(const u32x4*)(kp_ + 16 * ks); nk2[ks] = *(const u32x4*)(kp_ + 16 * ks + 4); nv[ks] = *(const u32x4*)(vp_ + 16 * ks); nv2[ks] = *(const u32x4*)(vp_ + 16 * ks + 4); } \
        } else { const size_t ro_ = (krow_first + 32 * (i_) + l31) * 512 + h * 64 + 8 * hf; \
            _Pragma("unroll") for (int ks = 0; ks < 4; ++ks) { nk[ks] = *(const u32x4*)(KB + ro_ + 16 * ks); nv[ks] = *(const u32x4*)(VB + ro_ + 16 * ks); } } } while (0)
    ATT_LOAD(0);
    for (int i = 0; i < ntile; ++i) {
        bf16x8 kf[4], vf[2][2];
        if (i < ncache) {
#pragma unroll
            for (int ks = 0; ks < 4; ++ks) { u32x4 w; const f32x4 a = __builtin_bit_cast(f32x4, nk[ks]), b = __builtin_bit_cast(f32x4, nk2[ks]), e = __builtin_bit_cast(f32x4, nv[ks]), f = __builtin_bit_cast(f32x4, nv2[ks]);
                w.x = pk2(a[0], a[1]); w.y = pk2(a[2], a[3]); w.z = pk2(b[0], b[1]); w.w = pk2(b[2], b[3]); kf[ks] = __builtin_bit_cast(bf16x8, w);
                w.x = pk2(e[0], e[1]); w.y = pk2(e[2], e[3]); w.z = pk2(f[0], f[1]); w.w = pk2(f[2], f[3]); vf[ks >> 1][ks & 1] = __builtin_bit_cast(bf16x8, w); }
        } else {
#pragma unroll
            for (int ks = 0; ks < 4; ++ks) { kf[ks] = __builtin_bit_cast(bf16x8, nk[ks]); vf[ks >> 1][ks & 1] = __builtin_bit_cast(bf16x8, nv[ks]); }
        }
        if (i + 1 < ntile) ATT_LOAD(i + 1);
        asm volatile("" ::: "memory");
        f32x16 st = zero16();
#pragma unroll
        for (int ks = 0; ks < 4; ++ks) st = MFMA32(kf[ks], qf[ks], st);
        const int dbase = db0 - 32 * i + l31; float mt = -1e30f;
        if (db0 - 32 * i - 31 >= 128) { const float bc = bl[191];
#pragma unroll
            for (int r = 0; r < 16; ++r) { const float s = st[r] * (0.125f * LOG2E) + bc; st[r] = s; mt = fmaxf(mt, s); }
        } else {
#pragma unroll
            for (int r = 0; r < 16; ++r) { int dist = dbase - crow(r, hf); dist = dist > 128 ? 128 : dist; const float s = st[r] * (0.125f * LOG2E) + bl[dist + 63]; st[r] = s; mt = fmaxf(mt, s); }
        }
        mt = fmaxf(mt, __shfl_xor(mt, 32));
        const float mnew = fmaxf(mrun, mt), alpha = __builtin_amdgcn_exp2f(mrun - mnew); mrun = mnew;
        float ps = 0.f;
#pragma unroll
        for (int r = 0; r < 16; ++r) { st[r] = __builtin_amdgcn_exp2f(st[r] - mnew); ps += st[r]; }
        lsum = lsum * alpha + ps;
#pragma unroll
        for (int r = 0; r < 16; ++r) { OT0[r] *= alpha; OT1[r] *= alpha; }
        const bf16x8 pf0 = pack8(st, 0), pf1 = pack8(st, 1);
        { f32x16 vx = zero16(); vx = MFMA32(vf[0][0], id0, vx); vx = MFMA32(vf[0][1], id1, vx); OT0 = MFMA32(pack8(vx, 0), pf0, OT0); OT0 = MFMA32(pack8(vx, 1), pf1, OT0); }
        { f32x16 vx = zero16(); vx = MFMA32(vf[1][0], id0, vx); vx = MFMA32(vf[1][1], id1, vx); OT1 = MFMA32(pack8(vx, 0), pf0, OT1); OT1 = MFMA32(pack8(vx, 1), pf1, OT1); }
    }
    lsum += __shfl_xor(lsum, 32); const float inv = 1.f / lsum;
    if (obase) qptr = obase + (size_t)(c * 64 + qh * 32 + l31) * opitch + h * 64;
#pragma unroll
    for (int g = 0; g < 4; ++g) { u32x2 o; o.x = pk2(OT0[4 * g] * inv, OT0[4 * g + 1] * inv); o.y = pk2(OT0[4 * g + 2] * inv, OT0[4 * g + 3] * inv); *(u32x2*)(qptr + 8 * g + 4 * hf) = o;
        o.x = pk2(OT1[4 * g] * inv, OT1[4 * g + 1] * inv); o.y = pk2(OT1[4 * g + 2] * inv, OT1[4 * g + 3] * inv); *(u32x2*)(qptr + 32 + 8 * g + 4 * hf) = o; }
}

DI void hgrn_out_item(const Params& p, int item, int lane, bf16_t* obase = nullptr) {
    const int c = item >> 3, h = (item >> 1) & 3, tt = item & 1, l31 = lane & 31, hf = lane >> 5;
    const float* CUM = (const float*)(p.ws + WS_CUM); const bf16_t* KA = (const bf16_t*)(p.ws + WS_KA); const bf16_t* VA = (const bf16_t*)(p.ws + WS_VA);
    const bf16_t* GA = (const bf16_t*)(p.ws + WS_GA); const bf16_t* SST = (const bf16_t*)(p.ws + WS_SST);
    const int trow = c * 64 + 32 * tt + l31;
    bf16_t* qap = (bf16_t*)(p.ws + WS_QOB) + (size_t)trow * 1024 + h * 128;
    const float* cumt = CUM + (size_t)trow * 512 + h * 128; const float* refp = CUM + (size_t)(c * 64 + 32) * 512 + h * 128;
    bf16x8 qd1[8], qd2[8];
#pragma unroll
    for (int ks = 0; ks < 8; ++ks) { const int k0 = 16 * ks + 8 * hf; const bf16x8 q8 = *(const bf16x8*)(qap + k0);
        const f32x4 c0 = *(const f32x4*)(cumt + k0), c1 = *(const f32x4*)(cumt + k0 + 4), r0 = *(const f32x4*)(refp + k0), r1 = *(const f32x4*)(refp + k0 + 4);
        float a[8], b[8];
#pragma unroll
        for (int j = 0; j < 8; ++j) { const float q = bf2f(q8[j]), cu = j < 4 ? c0[j & 3] : c1[j & 3], rf = j < 4 ? r0[j & 3] : r1[j & 3]; a[j] = q * __expf(cu - rf); b[j] = q * __expf(cu); }
        qd1[ks] = pack8f(a); qd2[ks] = pack8f(b); }
    f32x16 OT[4];
#pragma unroll
    for (int vt = 0; vt < 4; ++vt) OT[vt] = zero16();
    const bf16_t* sp = SST + ((size_t)(c * 4 + h) * 128 + l31) * 128 + 8 * hf;
#pragma unroll
    for (int vt = 0; vt < 4; ++vt)
#pragma unroll
        for (int ks = 0; ks < 8; ++ks) OT[vt] = MFMA32(*(const bf16x8*)(sp + (size_t)vt * 32 * 128 + 16 * ks), qd2[ks], OT[vt]);
    const bf16x8 id0 = ident_frag(0, l31, hf), id1 = ident_frag(1, l31, hf);
    for (int st = 0; st <= tt; ++st) {
        const int srow = c * 64 + 32 * st + l31; const bf16_t* kap = KA + (size_t)srow * 512 + h * 128; const float* cums = CUM + (size_t)srow * 512 + h * 128;
        f32x16 X = zero16();
#pragma unroll
        for (int ks = 0; ks < 8; ++ks) { const int k0 = 16 * ks + 8 * hf; const bf16x8 k8 = *(const bf16x8*)(kap + k0);
            const f32x4 c0 = *(const f32x4*)(cums + k0), c1 = *(const f32x4*)(cums + k0 + 4), r0 = *(const f32x4*)(refp + k0), r1 = *(const f32x4*)(refp + k0 + 4);
            float a[8];
#pragma unroll
            for (int j = 0; j < 8; ++j) { const float cu = j < 4 ? c0[j & 3] : c1[j & 3], rf = j < 4 ? r0[j & 3] : r1[j & 3]; a[j] = bf2f(k8[j]) * __expf(rf - cu); }
            X = MFMA32(pack8f(a), qd1[ks], X); }
        if (st == tt) {
#pragma unroll
            for (int r = 0; r < 16; ++r) if (crow(r, hf) > l31) X[r] = 0.f; }
        const bf16x8 xf0 = pack8(X, 0), xf1 = pack8(X, 1);
        const bf16_t* vp = VA + (size_t)srow * 512 + h * 128 + 8 * hf;
#pragma unroll
        for (int vt = 0; vt < 4; ++vt) { f32x16 vx = zero16(); vx = MFMA32(*(const bf16x8*)(vp + 32 * vt), id0, vx); vx = MFMA32(*(const bf16x8*)(vp + 32 * vt + 16), id1, vx);
            OT[vt] = MFMA32(pack8(vx, 0), xf0, OT[vt]); OT[vt] = MFMA32(pack8(vx, 1), xf1, OT[vt]); }
    }
    float ss = 0.f;
#pragma unroll
    for (int vt = 0; vt < 4; ++vt)
#pragma unroll
        for (int r = 0; r < 16; ++r) ss += OT[vt][r] * OT[vt][r];
    ss += __shfl_xor(ss, 32);
    const float rstd = __builtin_amdgcn_rsqf(ss * (1.f / 128.f) + EPS);
    const bf16_t* gap = GA + (size_t)trow * 512 + h * 128; const float* onp = p.out_norm + h * 128;
    if (obase) qap = obase + (size_t)trow * 512 + h * 128;
#pragma unroll
    for (int vt = 0; vt < 4; ++vt)
#pragma unroll
        for (int g = 0; g < 4; ++g) { const int v0 = 32 * vt + 8 * g + 4 * hf; const f32x4 on = *(const f32x4*)(onp + v0); const u32x2 ga = *(const u32x2*)(gap + v0);
            u32x2 o; o.x = pk2(OT[vt][4 * g] * rstd * on[0] * bflo(ga.x), OT[vt][4 * g + 1] * rstd * on[1] * bfhi(ga.x));
            o.y = pk2(OT[vt][4 * g + 2] * rstd * on[2] * bflo(ga.y), OT[vt][4 * g + 3] * rstd * on[3] * bfhi(ga.y)); *(u32x2*)(qap + v0) = o; }
}


#define XB_TMO      128
#define XB_XCNT(j)  (256  + 64 * (j))
#define XB_XSUB(j)  (1280 + 64 * (j))
#define XB_XGEN(j)  (2304 + 64 * (j))
#define XB_TOP      3328
#define XB_TOPGEN   3392
#define XCD_BAR_WORDS 3456
#define XB_SPIN_CAP (1u << 18)
DI unsigned xb_ld(unsigned* p)              { return __hip_atomic_load(p, __ATOMIC_RELAXED, __HIP_MEMORY_SCOPE_AGENT); }
DI unsigned xb_add(unsigned* p, unsigned v) { return __hip_atomic_fetch_add(p, v, __ATOMIC_RELAXED, __HIP_MEMORY_SCOPE_AGENT); }
DI unsigned xb_xcc_id() { return (unsigned)__builtin_amdgcn_s_getreg((3 << 11) | 20) & 0xFu; }
#define XB_SPIN(cond, bar) do { unsigned _sp = 0; while (cond) { __builtin_amdgcn_s_sleep(1); \
    if ((++_sp & 255u) == 0u) { if (xb_ld(&(bar)[XB_TMO])) break; if (_sp > XB_SPIN_CAP) { atomicAdd(&(bar)[XB_TMO], 1u); break; } } } } while (0)
struct XcdBarrier { unsigned* bar; unsigned x; volatile LAS unsigned* st; };
DI XcdBarrier xcd_barrier_post(unsigned* bar, volatile LAS unsigned* st) {
    XcdBarrier b; b.bar = bar; b.x = xb_xcc_id(); b.st = st;
    if (threadIdx.x == 0) (void)xb_add(&bar[XB_XCNT(b.x)], 1u);
    return b;
}
DI void xcd_barrier_complete(unsigned* bar, unsigned x, unsigned& nloc, unsigned& nx) {
    const unsigned G = gridDim.x * gridDim.y * gridDim.z;
    unsigned sum, cnt, mine, sp = 0u;
    for (;;) {
        sum = 0u; cnt = 0u; mine = 0u;
#pragma unroll
        for (unsigned j = 0; j < 16; ++j) { const unsigned c = xb_ld(&bar[XB_XCNT(j)]); sum += c; cnt += (c > 0u) ? 1u : 0u; mine = (j == x) ? c : mine; }
        if (sum == G) break;
        __builtin_amdgcn_s_sleep(1);
        if ((++sp & 255u) == 0u) { if (xb_ld(&bar[XB_TMO])) break; if (sp > XB_SPIN_CAP) { atomicAdd(&bar[XB_TMO], 1u); break; } }
    }
    nloc = mine > 0u ? mine : 1u; nx = cnt > 0u ? cnt : 1u;
}
DI void xcd_barrier(const XcdBarrier& b) {
    asm volatile("s_waitcnt vmcnt(0)" ::: "memory");
    __syncthreads();
    if (threadIdx.x == 0) {
        unsigned* bar = b.bar;
        __builtin_amdgcn_s_waitcnt(0);
        unsigned nloc = b.st[0], nx = b.st[1];
        if (nloc == 0u) { xcd_barrier_complete(bar, b.x, nloc, nx); b.st[0] = nloc; b.st[1] = nx; }
        const unsigned old = xb_add(&bar[XB_XSUB(b.x)], 1u);
        const unsigned gen = old / nloc;
        if (old + 1u == (gen + 1u) * nloc) {
            __builtin_amdgcn_fence(__ATOMIC_RELEASE, "agent");
            asm volatile("s_waitcnt vmcnt(0)" ::: "memory");
            const unsigned og = xb_add(&bar[XB_TOP], 1u);
            const unsigned tg = og / nx;
            if (og + 1u == (tg + 1u) * nx) xb_add(&bar[XB_TOPGEN], 1u);
            else XB_SPIN(xb_ld(&bar[XB_TOPGEN]) == tg, bar);
            __builtin_amdgcn_fence(__ATOMIC_ACQUIRE, "agent");
            xb_add(&bar[XB_XGEN(b.x)], 1u);
            asm volatile("s_waitcnt vmcnt(0)" ::: "memory");
        } else {
            XB_SPIN(xb_ld(&bar[XB_XGEN(b.x)]) == gen, bar);
            __builtin_amdgcn_fence(__ATOMIC_ACQUIRE, "agent");
            asm volatile("s_waitcnt vmcnt(0)" ::: "memory");
        }
    }
    __syncthreads();
}

__global__ void __launch_bounds__(512, 2) fwd_megakernel(Params p) {
    extern __shared__ __attribute__((aligned(16))) unsigned char lds_raw[];
    LAS unsigned char* lds = (LAS unsigned char*)lds_raw;
    cg::grid_group grid = cg::this_grid();
    const int G = gridDim.x, bx = blockIdx.x;
    volatile LAS unsigned* bst = (volatile LAS unsigned*)(lds + LDS_ST_OFF);
    if (threadIdx.x < 2) bst[threadIdx.x] = 0u;
    __syncthreads();
    const XcdBarrier xbar = xcd_barrier_post((unsigned*)(p.ws + WS_BAR), bst);
    if (threadIdx.x == 0) bst[2] = xb_add((unsigned*)(p.ws + WS_BAR) + 3712 + xbar.x, 1u);
#define GRID_BAR() xcd_barrier(xbar)
    unsigned char* ws = p.ws;
    float* MOD = (float*)(ws + WS_MOD); bf16_t* H = (bf16_t*)(ws + WS_H);

    phase_prep(p, lds);
    grid.sync();
    { pg8::Gemm g{(const bf16_t*)(ws + WS_SC), (const bf16_t*)(ws + WS_WADA), 256, 6144, 1024}; pg8::StaticOrder S; S.init(256, 6144, G, bx);
      EpiMod E{MOD, p.b_ada}; pg8::gemm_phase<EpiMod, pg8::StaticOrder, true, true>(lds, g, S, E); }
    GRID_BAR();
    int cv = bx;
    { unsigned* barw = (unsigned*)(p.ws + WS_BAR); bool uni = (G & 7) == 0;
#pragma unroll
      for (int j = 0; j < 16; ++j) { const unsigned c = xb_ld(&barw[XB_XCNT(j)]); uni = uni && (j < 8 ? c == (unsigned)(G >> 3) : c == 0u); }
      if (uni) cv = (int)xbar.x + 8 * (int)bst[2];
      cv = __builtin_amdgcn_readfirstlane(cv); }
    phase_norm_mod(p.x_prompt, p.x_sample, p.norm_mix, MOD, 0, 1024, H);
#if PROBE_DUP == 1
    GRID_BAR(); phase_norm_mod(p.x_prompt, p.x_sample, p.norm_mix, MOD, 0, 1024, H);
#endif
#if PROBE_DUP == 10
    GRID_BAR(); GRID_BAR(); GRID_BAR(); GRID_BAR(); GRID_BAR(); GRID_BAR(); GRID_BAR(); GRID_BAR(); GRID_BAR(); GRID_BAR();
#endif
    GRID_BAR();
    { pg8::Gemm g{H, (const bf16_t*)(ws + WS_WIN), T, INC, 1024}; pg8::StaticOrder S; S.init(T, INC, G, cv);
      EpiIn E{(bf16_t*)(ws + WS_QOB), (bf16_t*)(ws + WS_KA), (bf16_t*)(ws + WS_VA), (bf16_t*)(ws + WS_GA), (bf16_t*)(ws + WS_KB), (bf16_t*)(ws + WS_VB),
              (bf16_t*)(p.out), (bf16_t*)(p.out) + (size_t)T * 1024, (float*)(ws + WS_CUM), (float*)(ws + WS_DEC), p.lb_logits, p.out};
      pg8::gemm_phase<EpiIn, pg8::StaticOrder, true, true>(lds, g, S, E);
#if PROBE_DUP == 2
      GRID_BAR(); pg8::gemm_phase<EpiIn, pg8::StaticOrder, true, true>(lds, g, S, E);
#endif
    }
    GRID_BAR();
    { const int tid = fresh_tid(), lane = tid & 63, wave = __builtin_amdgcn_readfirstlane(tid >> 6);
      for (int it = wave * G + bx; it < NCH * 32; it += 8 * G) hgrn_u_item(p, it, lane);
#if PROBE_DUP == 3
      for (int it = wave * G + bx; it < NCH * 32; it += 8 * G) hgrn_u_item(p, it, lane);
#endif
    }
    GRID_BAR();
    {
        const int tid = fresh_tid(), lane = tid & 63, wave = __builtin_amdgcn_readfirstlane(tid >> 6);
        LAS float* biasl = (LAS float*)lds;
        for (int i = tid; i < 8 * 192; i += 512) biasl[i] = p.rel_bias[i] * LOG2E;
        __syncthreads();
#if PROBE_DUP == 4
        if (wave != 0) { const int gw = (wave - 1) * G + bx, NGW = 7 * G; for (int it = gw; it < NCH * 16; it += NGW) attn_item(p, it, lane, biasl, (bf16_t*)(ws + WS_SST), 512); }
        GRID_BAR();
#endif
#if PROBE_DUP == 41
        if (wave == 0) { for (int it = bx; it < 256; it += G) scan_prompt_item(p, it, lane); }
        GRID_BAR();
#endif
        if (wave == 0) { for (int it = bx; it < 256; it += G) scan_prompt_item(p, it, lane); }
        else {
            const int gw = (wave - 1) * G + bx, NGW = 7 * G;
            for (int it = gw; it < 4096; it += NGW) scan_sample_item(p, it, lane);
            const int x = (int)xbar.x, ncu = (int)bst[0], nxcc = (int)bst[1], j = (int)bst[2];
            if (nxcc == 8 && x < 8 && ncu > 0 && j < ncu) {
                const int nslot = 7 * ncu, slot = (wave - 1) * ncu + j;
                for (int idx = slot; idx < 68 * 16; idx += nslot) { const int cc = idx >> 4, c = cc < 4 ? 512 + 4 * x + cc : 64 * x + (cc - 4); attn_item(p, c * 16 + (idx & 15), lane, biasl); }
            } else for (int it = gw; it < NCH * 16; it += NGW) attn_item(p, it, lane, biasl);
        }
    }
    GRID_BAR();
    { const int tid = fresh_tid(), lane = tid & 63, wave = __builtin_amdgcn_readfirstlane(tid >> 6);
#if PROBE_DUP == 5
      for (int it = wave * G + bx; it < NCH * 8; it += 8 * G) hgrn_out_item(p, it, lane, (bf16_t*)(ws + WS_U));
      GRID_BAR();
#endif
      for (int it = wave * G + bx; it < NCH * 8; it += 8 * G) hgrn_out_item(p, it, lane); }
    GRID_BAR();
    { pg8::Gemm g{(const bf16_t*)(ws + WS_QOB), (const bf16_t*)(ws + WS_WAB), T, 1024, 1024}; pg8::StaticOrder S; S.init(T, 1024, G, cv);
      EpiMerge E{(const bf16_t*)(p.out), (const bf16_t*)(p.out) + (size_t)T * 1024, (bf16_t*)(ws + WS_M)};
      pg8::gemm_phase<EpiMerge, pg8::StaticOrder, true, true>(lds, g, S, E); }
    GRID_BAR();
    const bool split_ps = G >= 64;
    { pg8::Gemm g{(const bf16_t*)(ws + WS_M), (const bf16_t*)(ws + WS_WO), T, 1024, 1024}; EpiRes<false> E{p.x_prompt, p.x_sample, nullptr, (bf16_t*)(ws + WS_X1B), MOD + 2048};
      if (split_ps) {
        { pg8::StaticOrder S; S.init(TP, 1024, G, cv); pg8::gemm_phase<EpiRes<false>, pg8::StaticOrder, true, true>(lds, g, S, E); }
        GRID_BAR();
        if (bx < 32) { pg8::StaticOrder S; S.init(TS, 1024, 32, bx, TP / 256); pg8::gemm_phase<EpiRes<false>, pg8::StaticOrder, true, true>(lds, g, S, E); }
        else phase_norm_mod_b((const bf16_t*)(ws + WS_X1B), p.norm_ffn, MOD, 3072, 4096, H, 0, TP, 32);
        GRID_BAR();
        phase_norm_mod_b((const bf16_t*)(ws + WS_X1B), p.norm_ffn, MOD, 3072, 4096, H, TP, T, 0);
      } else {
        pg8::StaticOrder S; S.init(T, 1024, G, cv); pg8::gemm_phase<EpiRes<false>, pg8::StaticOrder, true, true>(lds, g, S, E);
        GRID_BAR();
        phase_norm_mod_b((const bf16_t*)(ws + WS_X1B), p.norm_ffn, MOD, 3072, 4096, H);
      } }
    GRID_BAR();
    { pg8::Gemm g{H, (const bf16_t*)(ws + WS_WFI), T, INC, 1024}; pg8::StaticOrder S; S.init(T, INC, G, cv);
      EpiFfnIn E{(bf16_t*)(ws + WS_HID)}; pg8::gemm_phase<EpiFfnIn, pg8::StaticOrder, true, true>(lds, g, S, E);
#if PROBE_DUP == 9
      GRID_BAR(); pg8::gemm_phase<EpiFfnIn, pg8::StaticOrder, true, true>(lds, g, S, E);
#endif
    }
    GRID_BAR();
    { pg8::Gemm g{(const bf16_t*)(ws + WS_HID), (const bf16_t*)(ws + WS_WFO), T, 1024, FF}; EpiRes<true> E{nullptr, nullptr, (const bf16_t*)(ws + WS_X1B), (bf16_t*)(ws + WS_X2B), MOD + 5120};
      if (split_ps) {
        { pg8::StaticOrder S; S.init(TP, 1024, G, cv); pg8::gemm_phase<EpiRes<true>, pg8::StaticOrder, true, true>(lds, g, S, E); }
        GRID_BAR();
        float* PART = (float*)(ws + WS_CUM + 20 * MiB);
        if (bx < 64) { const int ks = bx >> 5; pg8::Gemm gs{(const bf16_t*)(ws + WS_HID) + ks * (FF / 2), (const bf16_t*)(ws + WS_WFO) + ks * (FF / 2), T, 1024, FF / 2, FF};
            pg8::StaticOrder S; S.init(TS, 1024, 32, bx & 31, TP / 256); EpiPart EP{PART + (size_t)ks * TS * D, TP}; pg8::gemm_phase<EpiPart, pg8::StaticOrder, true, true>(lds, gs, S, EP); }
        else phase_final_norm((const bf16_t*)(ws + WS_X2B), p.out, p.norm_final, 0, TP, 64);
        GRID_BAR();
        phase_final_norm_parts((const bf16_t*)(ws + WS_X1B), PART, PART + (size_t)TS * D, MOD + 5120, p.out, p.norm_final);
      } else {
        pg8::StaticOrder S; S.init(T, 1024, G, cv); pg8::gemm_phase<EpiRes<true>, pg8::StaticOrder, true, true>(lds, g, S, E);
        GRID_BAR();
        phase_final_norm((const bf16_t*)(ws + WS_X2B), p.out, p.norm_final);
      } }
}

extern "C" void kernel_launch(void* const* d_in, const int* in_sizes, int n_in, void* d_out, int out_size, void* d_ws, size_t ws_size, hipStream_t stream) {
    static int grid = 0;
    if (grid == 0) {
        if (n_in != 21 || (size_t)out_size != OUT_TOTAL || ws_size < WS_END) { fprintf(stderr, "kernel_launch: unexpected sizes n_in %d out %d ws %zu\n", n_in, out_size, ws_size); grid = -1; return; }
        int dev = 0, cus = 0, per = 0;
        (void)hipGetDevice(&dev); (void)hipDeviceGetAttribute(&cus, hipDeviceAttributeMultiprocessorCount, dev);
        (void)hipFuncSetAttribute((const void*)fwd_megakernel, hipFuncAttributeMaxDynamicSharedMemorySize, LDS_BYTES);
        (void)hipOccupancyMaxActiveBlocksPerMultiprocessor(&per, (const void*)fwd_megakernel, 512, LDS_BYTES);
        if (per < 1) per = 1;
        grid = cus * per; fprintf(stderr, "kernel_launch: grid %d (cus %d x %d)\n", grid, cus, per);
    }
    if (grid < 0) return;
    if (hipMemsetAsync((char*)d_ws + WS_BAR, 0, BAR_BYTES, stream) != hipSuccess) { fprintf(stderr, "kernel_launch: memset failed\n"); return; }
    Params p{};
    const float** f = (const float**)&p;
    for (int i = 0; i < 21; ++i) f[i] = (const float*)d_in[i];
    p.out = (float*)d_out; p.ws = (unsigned char*)d_ws;
    void* args[] = {&p};
    hipError_t e = hipLaunchCooperativeKernel((const void*)fwd_megakernel, dim3(grid), dim3(512), args, LDS_BYTES, stream);
    if (e != hipSuccess) fprintf(stderr, "cooperative launch failed: %s (grid %d)\n", hipGetErrorString(e), grid);
}
```

```cpp
#include <hip/hip_runtime.h>
#include <hip/hip_cooperative_groups.h>
#include <cstdio>
#include <cstdint>
namespace cg = cooperative_groups;
#ifndef PROBE_DUP
#define PROBE_DUP 0
#endif

#define DI __device__ __forceinline__
#define LAS __attribute__((address_space(3)))
typedef unsigned short bf16_t;
typedef short bf16x8 __attribute__((ext_vector_type(8)));
typedef float f32x4 __attribute__((ext_vector_type(4)));
typedef float f32x2 __attribute__((ext_vector_type(2)));
typedef float f32x16 __attribute__((ext_vector_type(16)));
typedef unsigned u32x4 __attribute__((ext_vector_type(4)));
typedef unsigned u32x2 __attribute__((ext_vector_type(2)));
typedef __bf16 bf2_t __attribute__((ext_vector_type(2)));

constexpr int D = 1024, TP = 32768, TS = 2048, T = TP + TS, NCH = T / 64, NBATCH = 34;
constexpr int INC = 5632, FF = 2816;
constexpr float EPS = 1e-6f, LOG2E = 1.4426950408889634f;
constexpr size_t OFF_Y = 0, OFF_SP = (size_t)T * D, OFF_KP = OFF_SP + 131072, OFF_VP = OFF_KP + 524288, OFF_SS = OFF_VP + 524288,
                 OFF_KS = OFF_SS + 2097152, OFF_VS = OFF_KS + 1048576, OUT_TOTAL = OFF_VS + 1048576;
constexpr size_t MiB = 1u << 20;
constexpr size_t WS_MOD = 1 * MiB, WS_DEC = 2 * MiB, WS_SC = 4 * MiB, WS_WADA = 5 * MiB, WS_WIN = 17 * MiB, WS_WAB = 28 * MiB, WS_WO = 30 * MiB,
                 WS_WFI = 32 * MiB, WS_WFO = 43 * MiB, WS_H = 50 * MiB, WS_QOB = 118 * MiB, WS_KA = 186 * MiB, WS_VA = 220 * MiB, WS_GA = 254 * MiB,
                 WS_KB = 288 * MiB, WS_VB = 322 * MiB, WS_CUM = 356 * MiB, WS_SST = 424 * MiB, WS_END = 492 * MiB;
constexpr size_t WS_U = WS_H, WS_M = WS_KA, WS_HID = WS_KA, WS_X1B = WS_QOB, WS_X2B = WS_H;
constexpr size_t WS_BAR = 0, BAR_BYTES = 16384;
constexpr int LDS_BYTES = 140 * 1024, LDS_ST_OFF = 136 * 1024;

struct Params {
    const float *x_prompt, *x_sample, *c_prompt, *c_sample, *state, *cache_k, *cache_v, *w_ada, *b_ada, *norm_mix, *w_in, *lb_logits, *out_norm,
                *w_a, *rel_bias, *w_b, *w_out, *norm_ffn, *w_ffn_in, *w_ffn_out, *norm_final;
    float* out; unsigned char* ws;
};

DI int fresh_tid() { int t = threadIdx.x; asm volatile("" : "+v"(t)); return t; }
DI int launder(int v) { asm volatile("" : "+v"(v)); return v; }
DI unsigned pk2(float a, float b) { f32x2 v = {a, b}; bf2_t r = __builtin_convertvector(v, bf2_t); return __builtin_bit_cast(unsigned, r); }
DI float bflo(unsigned u) { return __uint_as_float(u << 16); }
DI float bfhi(unsigned u) { return __uint_as_float(u & 0xffff0000u); }
DI float bf2f(short s) { return __uint_as_float(((unsigned)(unsigned short)s) << 16); }
DI float sigm(float x) { return __builtin_amdgcn_rcpf(1.f + __expf(-x)); }
DI float silu(float x) { return x * sigm(x); }
DI int batch_of(int r) { return r < TP ? (r >> 14) : 2 + ((r - TP) >> 6); }
DI int crow(int reg, int h) { return (reg & 3) + 8 * (reg >> 2) + 4 * h; }
DI bf16x8 pack8(const f32x16& x, int s) {
    u32x4 p; p.x = pk2(x[8 * s], x[8 * s + 1]); p.y = pk2(x[8 * s + 2], x[8 * s + 3]); p.z = pk2(x[8 * s + 4], x[8 * s + 5]); p.w = pk2(x[8 * s + 6], x[8 * s + 7]);
    return __builtin_bit_cast(bf16x8, p);
}
DI bf16x8 pack8f(const float* v) { u32x4 p; p.x = pk2(v[0], v[1]); p.y = pk2(v[2], v[3]); p.z = pk2(v[4], v[5]); p.w = pk2(v[6], v[7]); return __builtin_bit_cast(bf16x8, p); }
DI bf16x8 ident_frag(int ks, int l31, int hf) {
    const int jj = l31 - 16 * ks - 8 * hf; bf16x8 r;
#pragma unroll
    for (int j = 0; j < 8; ++j) r[j] = (j == jj) ? (short)0x3F80 : (short)0;
    return r;
}
#define MFMA32(a, b, c) __builtin_amdgcn_mfma_f32_32x32x16_bf16((a), (b), (c), 0, 0, 0)
DI f32x16 zero16() { f32x16 z;
#pragma unroll
    for (int i = 0; i < 16; ++i) z[i] = 0.f; return z; }

namespace pg8 {
constexpr int BM = 256, BK = 64, HALF = 128, HTB = HALF * BK * 2, STAGE_BYTES = 8 * HTB, NXCD = 8, WGM = 8;
__host__ __device__ __forceinline__ int lds_byte(int r, int c) { const int st = (r >> 4) * 2 + (c >> 5), rr = r & 15, cc = c & 31, ob = rr * 64 + cc * 2; return st * 1024 + (ob ^ (((ob >> 9) & 1) << 5)); }
__host__ __device__ __forceinline__ void stage_rc(int b, int& R, int& C) { const int st = b / 1024, sb = b % 1024, swz = sb ^ (((sb >> 9) & 1) << 5); R = (st >> 1) * 16 + swz / 64; C = (st & 1) * 32 + (swz % 64) / 2; }
__host__ __device__ __forceinline__ int perm32(int rho) { const int n = rho >> 4, i = rho & 15; return 8 * (i >> 2) + 4 * n + (i & 3); }
struct Unit { int pm, pn; };
struct Gemm { const bf16_t* A; const bf16_t* Bt; int M, N, K, ld; };
struct StaticOrder {
    int nM, nN, nwg, G, c, pm_off;
    __device__ void init(int M, int N, int G_, int c_, int pm_off_ = 0) { nM = M / BM; nN = N / BM; nwg = nM * nN; G = G_; c = c_; pm_off = pm_off_; }
    __device__ bool next(int i, Unit& u) const {
        const long L = (long)i * G + c; if (L >= nwg) return false;
        int wgid = (int)L; { const int q = nwg / NXCD, r = nwg % NXCD, xcd = wgid % NXCD, off = wgid / NXCD; wgid = (xcd < r ? xcd * (q + 1) : r * (q + 1) + (xcd - r) * q) + off; }
        const int nig = WGM * nN, gid = wgid / nig, fm = gid * WGM, gsz = (nM - fm) < WGM ? (nM - fm) : WGM;
        u.pm = pm_off + fm + ((wgid % nig) % gsz); u.pn = (wgid % nig) / gsz; return true;
    }
};
template <class Epi, class Sched, bool ALIGN_EPI = false, bool SP2 = false>
__device__ __forceinline__ void gemm_phase(LAS unsigned char* lds, const Gemm g, const Sched& S, const Epi& E) {
    const int tid = fresh_tid(), wid = __builtin_amdgcn_readfirstlane(tid >> 6), lane = tid & 63, wr = wid >> 2, wc = wid & 3, fr = lane & 15, fq = lane >> 4;
    const int K = g.ld ? g.ld : g.K, nt = g.K / BK;
    unsigned voffA[2], voffB[2];
#pragma unroll
    for (int i = 0; i < 2; ++i) { int R, C; stage_rc(tid * 16 + i * 8192, R, C); const int Rb = Epi::PERM ? ((R & ~31) + perm32(R & 31)) : R;
        voffA[i] = (unsigned)(R * K + C) * 2u; voffB[i] = (unsigned)(Rb * K + C) * 2u; }
    const size_t kstep = (size_t)(BK * 2);
    const size_t hstep = (size_t)HALF * K * 2;
    const size_t tstep = 2 * hstep;
    const unsigned ldsw = (unsigned)wid * 1024u;
    const int aoff = lds_byte(wr * 64 + fr, fq * 8), boff = lds_byte(wc * 32 + fr, fq * 8);
#define PG8_SA(b, h) (((b) * 2 + (h)) * HTB)
#define PG8_SB(b, h) ((4 + (b) * 2 + (h)) * HTB)
#define PG8_STAGE(bufoff, gbase, voff) do { _Pragma("unroll") for (int _i = 0; _i < 2; ++_i) \
        __builtin_amdgcn_global_load_lds((const unsigned*)((const char*)(gbase) + (voff)[_i]), (LAS unsigned*)(lds + (bufoff) + ldsw + _i * 8192), 16, 0, 0); } while (0)
#define PG8_LDA(dst, b, h) do { _Pragma("unroll") for (int m = 0; m < 4; ++m) _Pragma("unroll") for (int k = 0; k < 2; ++k) dst[m][k] = *(const LAS bf16x8*)(lds + PG8_SA(b, h) + aoff + m * 2048 + k * 1024); } while (0)
#define PG8_LDB(dst, b, h) do { _Pragma("unroll") for (int n = 0; n < 2; ++n) _Pragma("unroll") for (int k = 0; k < 2; ++k) dst[n][k] = *(const LAS bf16x8*)(lds + PG8_SB(b, h) + boff + n * 2048 + k * 1024); } while (0)
#define PG8_MMA(ai, bj, At, Bt) do { __builtin_amdgcn_s_setprio(1); _Pragma("unroll") for (int m = 0; m < 4; ++m) _Pragma("unroll") for (int n = 0; n < 2; ++n) _Pragma("unroll") for (int k = 0; k < 2; ++k) \
        acc[ai][bj][m][n] = __builtin_amdgcn_mfma_f32_16x16x32_bf16(Bt[n][k], At[m][k], acc[ai][bj][m][n], 0, 0, 0); __builtin_amdgcn_s_setprio(0); } while (0)
#define PG8_WAIT_V(n) asm volatile("s_waitcnt vmcnt(" #n ")" ::: "memory")
#define PG8_WAIT_L(n) asm volatile("s_waitcnt lgkmcnt(" #n ")" ::: "memory")
#define PG8_BAR __builtin_amdgcn_s_barrier()
#define PG8_SCHED __builtin_amdgcn_sched_barrier(0)
    Unit cur, nxt; int ui = 0;
    if (!S.next(0, cur)) return;
    f32x4 acc[2][2][4][2];
#pragma unroll
    for (int a = 0; a < 2; ++a)
#pragma unroll
        for (int b = 0; b < 2; ++b)
#pragma unroll
            for (int m = 0; m < 4; ++m)
#pragma unroll
                for (int n = 0; n < 2; ++n) acc[a][b][m][n] = (f32x4){0.f, 0.f, 0.f, 0.f};
    bf16x8 At[4][2], B0[2][2], B1[2][2];
    const char* cA = (const char*)g.A + (size_t)cur.pm * tstep; const char* cB = (const char*)g.Bt + (size_t)cur.pn * tstep;
    if constexpr (SP2) {
        PG8_STAGE(PG8_SB(0, 0), cB, voffB); PG8_STAGE(PG8_SB(0, 1), cB + hstep, voffB); PG8_STAGE(PG8_SA(0, 0), cA, voffA); PG8_STAGE(PG8_SA(0, 1), cA + hstep, voffA);
        if (wr == 1) PG8_BAR;
        PG8_WAIT_V(2); PG8_BAR;
        PG8_STAGE(PG8_SB(1, 0), cB + kstep, voffB); PG8_STAGE(PG8_SA(1, 0), cA + kstep, voffA); PG8_STAGE(PG8_SB(1, 1), cB + hstep + kstep, voffB);
        PG8_WAIT_V(6); PG8_BAR;
    } else {
        PG8_STAGE(PG8_SB(0, 0), cB, voffB); PG8_STAGE(PG8_SA(0, 0), cA, voffA); PG8_STAGE(PG8_SB(0, 1), cB + hstep, voffB); PG8_STAGE(PG8_SA(0, 1), cA + hstep, voffA);
        if (wr == 1) PG8_BAR;
        PG8_WAIT_V(4); PG8_BAR;
        PG8_STAGE(PG8_SB(1, 0), cB + kstep, voffB); PG8_STAGE(PG8_SA(1, 0), cA + kstep, voffA); PG8_STAGE(PG8_SB(1, 1), cB + hstep + kstep, voffB);
        PG8_WAIT_V(6); PG8_BAR;
    }
    for (;;) {
        const bool has_next = S.next(ui + 1, nxt);
        const char* nA = has_next ? (const char*)g.A + (size_t)nxt.pm * tstep : cA; const char* nB = has_next ? (const char*)g.Bt + (size_t)nxt.pn * tstep : cB;
        for (int t = 0; t < nt; t += 2) {
            if constexpr (Epi::MIDK) { if (t == nt / 2) E.mid(acc, cur, wr, wc, fr, fq); }
            const bool last = (t == nt - 2);
            const char* a1 = cA + (size_t)(t + 1) * kstep;
            const char* a2 = last ? nA : cA + (size_t)(t + 2) * kstep; const char* b2 = last ? nB : cB + (size_t)(t + 2) * kstep;
            const char* a3 = a2 + kstep; const char* b3 = b2 + kstep;
            if constexpr (SP2) {
            PG8_LDB(B0, 0, 0); PG8_LDB(B1, 0, 1); PG8_SCHED; PG8_LDA(At, 0, 0); PG8_STAGE(PG8_SA(1, 1), a1 + hstep, voffA);
            PG8_WAIT_V(8); PG8_WAIT_L(0); PG8_BAR; PG8_MMA(0, 0, At, B0); PG8_MMA(0, 1, At, B1); PG8_BAR; PG8_SCHED;
            PG8_LDA(At, 0, 1); PG8_STAGE(PG8_SB(0, 0), b2, voffB); PG8_STAGE(PG8_SB(0, 1), b2 + hstep, voffB); PG8_STAGE(PG8_SA(0, 0), a2, voffA);
            PG8_WAIT_V(8); PG8_WAIT_L(0); PG8_BAR; PG8_MMA(1, 0, At, B0); PG8_MMA(1, 1, At, B1); PG8_BAR; PG8_SCHED;
            PG8_LDB(B0, 1, 0); PG8_LDB(B1, 1, 1); PG8_SCHED; PG8_LDA(At, 1, 0); PG8_STAGE(PG8_SA(0, 1), a2 + hstep, voffA);
            PG8_WAIT_V(8); PG8_WAIT_L(0); PG8_BAR; PG8_MMA(0, 0, At, B0); PG8_MMA(0, 1, At, B1); PG8_BAR; PG8_SCHED;
            PG8_LDA(At, 1, 1); PG8_STAGE(PG8_SB(1, 0), b3, voffB); PG8_STAGE(PG8_SB(1, 1), b3 + hstep, voffB); PG8_STAGE(PG8_SA(1, 0), a3, voffA);
            PG8_WAIT_V(8); PG8_WAIT_L(0); PG8_BAR; PG8_MMA(1, 0, At, B0); PG8_MMA(1, 1, At, B1); PG8_BAR; PG8_SCHED;
            } else {
            PG8_LDB(B0, 0, 0); PG8_SCHED; PG8_LDA(At, 0, 0); PG8_STAGE(PG8_SA(1, 1), a1 + hstep, voffA);
            PG8_WAIT_L(8); PG8_BAR; PG8_WAIT_L(0); PG8_MMA(0, 0, At, B0); PG8_BAR; PG8_SCHED;
            PG8_LDB(B1, 0, 1); PG8_STAGE(PG8_SB(0, 0), b2, voffB);
            PG8_BAR; PG8_WAIT_L(0); PG8_MMA(0, 1, At, B1); PG8_BAR;
            PG8_LDA(At, 0, 1); PG8_STAGE(PG8_SA(0, 0), a2, voffA);
            PG8_BAR; PG8_WAIT_L(0); PG8_MMA(1, 0, At, B0); PG8_BAR; PG8_SCHED;
            PG8_STAGE(PG8_SB(0, 1), b2 + hstep, voffB);
            PG8_WAIT_V(6); PG8_BAR; PG8_MMA(1, 1, At, B1); PG8_BAR;
            PG8_LDB(B0, 1, 0); PG8_SCHED; PG8_LDA(At, 1, 0); PG8_STAGE(PG8_SA(0, 1), a2 + hstep, voffA);
            PG8_WAIT_L(8); PG8_BAR; PG8_WAIT_L(0); PG8_MMA(0, 0, At, B0); PG8_BAR; PG8_SCHED;
            PG8_LDB(B1, 1, 1); PG8_STAGE(PG8_SB(1, 0), b3, voffB);
            PG8_BAR; PG8_WAIT_L(0); PG8_MMA(0, 1, At, B1); PG8_BAR;
            PG8_LDA(At, 1, 1); PG8_STAGE(PG8_SA(1, 0), a3, voffA);
            PG8_BAR; PG8_WAIT_L(0); PG8_MMA(1, 0, At, B0); PG8_BAR; PG8_SCHED;
            PG8_STAGE(PG8_SB(1, 1), b3 + hstep, voffB);
            PG8_WAIT_V(6); PG8_BAR; PG8_MMA(1, 1, At, B1); PG8_BAR;
            }
        }
        if constexpr (ALIGN_EPI) { if (wr == 0) PG8_BAR; }
        E(acc, cur, wr, wc, fr, fq);
        if (!has_next) break;
#pragma unroll
        for (int a = 0; a < 2; ++a)
#pragma unroll
            for (int b = 0; b < 2; ++b)
#pragma unroll
                for (int m = 0; m < 4; ++m)
#pragma unroll
                    for (int n = 0; n < 2; ++n) acc[a][b][m][n] = (f32x4){0.f, 0.f, 0.f, 0.f};
        cur = nxt; cA = nA; cB = nB; ++ui;
        if constexpr (ALIGN_EPI) { if (wr == 1) PG8_BAR; }
    }
    PG8_WAIT_V(0);
    if constexpr (!ALIGN_EPI) { if (wr == 0) PG8_BAR; }
    PG8_BAR;
#undef PG8_SA
#undef PG8_SB
#undef PG8_STAGE
#undef PG8_LDA
#undef PG8_LDB
#undef PG8_MMA
#undef PG8_WAIT_V
#undef PG8_WAIT_L
#undef PG8_BAR
#undef PG8_SCHED
}
}
using pg8::Unit;
typedef f32x4 Acc[2][2][4][2];

DI u32x4 pack_row8(const f32x4& v0, const f32x4& v1) { u32x4 w; w.x = pk2(v0[0], v0[1]); w.y = pk2(v0[2], v0[3]); w.z = pk2(v1[0], v1[1]); w.w = pk2(v1[2], v1[3]); return w; }

struct EpiMod {
    static constexpr bool PERM = false, MIDK = false;
    float* mod; const float* bias;
    DI void operator()(Acc& acc, const Unit& u, int wr, int wc, int fr, int fq) const {
        { const int t_ = fresh_tid(); fr = t_ & 15; fq = (t_ >> 4) & 3; }
        if (u.pm != 0 || wr != 0) return;
#pragma unroll
        for (int m = 0; m < 3; ++m) { const int r = 16 * m + fr; if (r < NBATCH) {
#pragma unroll
            for (int bj = 0; bj < 2; ++bj)
#pragma unroll
                for (int n = 0; n < 2; ++n) { const int col = u.pn * 256 + bj * 128 + wc * 32 + n * 16 + 4 * fq;
                    *(f32x4*)(mod + (size_t)r * 6144 + col) = acc[0][bj][m][n] + *(const f32x4*)(bias + col); } } }
    }
};

struct EpiIn {
    static constexpr bool PERM = true, MIDK = false;
    bf16_t *QOB, *KA, *VA, *GA, *KB, *VB, *SGA, *SGB; float *CUM, *DEC; const float* lbl; float* out;
    DI void operator()(Acc& acc, const Unit& u, int wr, int wc, int fr, int fq) const {
        { const int t_ = fresh_tid(); fr = t_ & 15; fq = (t_ >> 4) & 3; }
        const int pn = u.pn, rt = wr * 64 + fr, row0 = u.pm * 256 + rt, cw = wc * 32 + 8 * fq, lane = fq * 16 + fr;
        if (pn >= 14) {
            const size_t o0 = (size_t)row0 * 1024 + (pn - 14) * 128 + cw;
#pragma unroll
            for (int ai = 0; ai < 2; ++ai)
#pragma unroll
                for (int m = 0; m < 4; ++m) { f32x4 r0, r1, b0, b1;
#pragma unroll
                    for (int j = 0; j < 4; ++j) { b0[j] = fmaxf(sigm(acc[ai][1][m][0][j]), 1e-30f); b1[j] = fmaxf(sigm(acc[ai][1][m][1][j]), 1e-30f);
                        r0[j] = sigm(acc[ai][0][m][0][j]) * __builtin_amdgcn_rcpf(b0[j]); r1[j] = sigm(acc[ai][0][m][1][j]) * __builtin_amdgcn_rcpf(b1[j]); }
                    const size_t o = o0 + (size_t)(ai * 128 + m * 16) * 1024;
                    *(u32x4*)(SGA + o) = pack_row8(r0, r1); *(u32x4*)(SGB + o) = pack_row8(b0, b1); __builtin_amdgcn_sched_barrier(0); }
            return;
        }
        const int seg = pn >> 1, col0 = (pn & 1) * 256 + cw;
        if (seg == 1) {
#pragma unroll
            for (int bj = 0; bj < 2; ++bj) {
                float lb[2][4];
#pragma unroll
                for (int n = 0; n < 2; ++n)
#pragma unroll
                    for (int j = 0; j < 4; ++j) { const int c = col0 + bj * 128 + 4 * n + j; lb[n][j] = __builtin_amdgcn_rcpf(1.f + __expf(lbl[512 + c] - lbl[c])); }
#pragma unroll
                for (int ai = 0; ai < 2; ++ai) {
                    const size_t rbase = ((size_t)((pn & 1) * 2 + bj) * T + (u.pm * 256 + ai * 128 + wr * 64 + launder(fr))) * 128 + cw;
#pragma unroll
                    for (int m = 0; m < 4; ++m) { f32x4 k0, k1;
#pragma unroll
                        for (int j = 0; j < 4; ++j) {
                            float f = lb[0][j] + (1.f - lb[0][j]) * sigm(acc[ai][bj][m][0][j]); k0[j] = 1.f - f; acc[ai][bj][m][0][j] = __logf(f);
                            f = lb[1][j] + (1.f - lb[1][j]) * sigm(acc[ai][bj][m][1][j]); k1[j] = 1.f - f; acc[ai][bj][m][1][j] = __logf(f); }
                        *(u32x4*)(KA + rbase + (size_t)m * 16 * 128) = pack_row8(k0, k1); }
                    __builtin_amdgcn_sched_barrier(0);
#pragma unroll
                    for (int n = 0; n < 2; ++n)
#pragma unroll
                        for (int j = 0; j < 4; ++j) { float carry = 0.f;
#pragma unroll
                            for (int m = 0; m < 4; ++m) { float v = acc[ai][bj][m][n][j];
                                v += __int_as_float(__builtin_amdgcn_update_dpp(0, __float_as_int(v), 0x111, 0xf, 0xf, false));
                                v += __int_as_float(__builtin_amdgcn_update_dpp(0, __float_as_int(v), 0x112, 0xf, 0xf, false));
                                v += __int_as_float(__builtin_amdgcn_update_dpp(0, __float_as_int(v), 0x114, 0xf, 0xf, false));
                                v += __int_as_float(__builtin_amdgcn_update_dpp(0, __float_as_int(v), 0x118, 0xf, 0xf, false));
                                v += carry; carry = __shfl(v, lane | 15); acc[ai][bj][m][n][j] = v; } }
                    __builtin_amdgcn_sched_barrier(0);
#pragma unroll
                    for (int m = 0; m < 4; ++m) { float* cp = CUM + rbase + (size_t)m * 16 * 128; *(f32x4*)cp = acc[ai][bj][m][0]; *(f32x4*)(cp + 4) = acc[ai][bj][m][1]; }
                    if (fr == 15) {
#pragma unroll
                        for (int n = 0; n < 2; ++n) { f32x4 e;
#pragma unroll
                            for (int j = 0; j < 4; ++j) e[j] = __expf(acc[ai][bj][3][n][j]);
                            *(f32x4*)(DEC + (size_t)(u.pm * 4 + ai * 2 + wr) * 512 + col0 + bj * 128 + 4 * n) = e; } }
                    __builtin_amdgcn_sched_barrier(0);
                }
            }
            return;
        }
        bf16_t* dst; int pitch = 512; size_t bjoff = 128; float* o32 = nullptr;
        switch (seg) {
            case 0: dst = QOB + col0; pitch = 1024; break;
            case 2: dst = VA + (size_t)((pn & 1) * 2) * T * 128 + cw; pitch = 128; bjoff = (size_t)T * 128; break;
            case 3: dst = GA + (size_t)((pn & 1) * 2) * T * 128 + cw; pitch = 128; bjoff = (size_t)T * 128; break;
            case 4: dst = QOB + 512 + col0; pitch = 1024; break;
            default: dst = (seg == 5 ? KB : VB) + (size_t)((pn & 1) * 4 + (wc >> 1)) * T * 64 + (wc & 1) * 32 + 8 * fq; pitch = 64; bjoff = (size_t)2 * T * 64; break;
        }
        if (seg >= 5) {
            if (u.pm >= 128) o32 = out + (seg == 5 ? OFF_KS : OFF_VS) + (size_t)((u.pm - 128) * 256 + rt) * 512 + col0;
            else if ((u.pm & 63) >= 62) o32 = out + (seg == 5 ? OFF_KP : OFF_VP) + (size_t)((u.pm >> 6) * 512 + ((u.pm & 63) - 62) * 256 + rt) * 512 + col0;
        }
        const bool act = (seg == 0 || seg == 3);
#pragma unroll
        for (int ai = 0; ai < 2; ++ai)
#pragma unroll
            for (int m = 0; m < 4; ++m)
#pragma unroll
                for (int bj = 0; bj < 2; ++bj) { f32x4 v0 = acc[ai][bj][m][0], v1 = acc[ai][bj][m][1];
                    if (act) {
#pragma unroll
                        for (int j = 0; j < 4; ++j) { v0[j] = silu(v0[j]); v1[j] = silu(v1[j]); } }
                    *(u32x4*)(dst + (size_t)(row0 + ai * 128 + m * 16) * pitch + bj * bjoff) = pack_row8(v0, v1);
                    if (o32) { float* op = o32 + (size_t)(ai * 128 + m * 16) * 512 + bj * 128; *(f32x4*)op = v0; *(f32x4*)(op + 4) = v1; } __builtin_amdgcn_sched_barrier(0); }
    }
};

struct EpiMerge {
    static constexpr bool PERM = true, MIDK = true;
    const bf16_t *SGR, *SGB; bf16_t* Mo;
    DI void mid(Acc& acc, const Unit& u, int wr, int wc, int fr, int fq) const {
        { const int t_ = fresh_tid(); fr = t_ & 15; fq = (t_ >> 4) & 3; }
        const size_t base = (size_t)(u.pm * 256 + wr * 64 + fr) * 1024 + u.pn * 256 + wc * 32 + 8 * fq;
#pragma unroll
        for (int ai = 0; ai < 2; ++ai) { u32x4 a[4][2];
#pragma unroll
            for (int m = 0; m < 4; ++m)
#pragma unroll
                for (int bj = 0; bj < 2; ++bj) a[m][bj] = *(const u32x4*)(SGR + base + (size_t)(ai * 128 + m * 16) * 1024 + bj * 128);
#pragma unroll
            for (int m = 0; m < 4; ++m)
#pragma unroll
                for (int bj = 0; bj < 2; ++bj)
#pragma unroll
                    for (int j = 0; j < 4; ++j) { acc[ai][bj][m][j >> 1][(j & 1) * 2] *= bflo(a[m][bj][j]); acc[ai][bj][m][j >> 1][(j & 1) * 2 + 1] *= bfhi(a[m][bj][j]); }
            __builtin_amdgcn_sched_barrier(0); }
    }
    DI void operator()(Acc& acc, const Unit& u, int wr, int wc, int fr, int fq) const {
        { const int t_ = fresh_tid(); fr = t_ & 15; fq = (t_ >> 4) & 3; }
        const size_t base = (size_t)(u.pm * 256 + wr * 64 + fr) * 1024 + u.pn * 256 + wc * 32 + 8 * fq;
#pragma unroll
        for (int ai = 0; ai < 2; ++ai) { u32x4 b[4][2];
#pragma unroll
            for (int m = 0; m < 4; ++m)
#pragma unroll
                for (int bj = 0; bj < 2; ++bj) b[m][bj] = *(const u32x4*)(SGB + base + (size_t)(ai * 128 + m * 16) * 1024 + bj * 128);
#pragma unroll
            for (int m = 0; m < 4; ++m)
#pragma unroll
                for (int bj = 0; bj < 2; ++bj) { f32x4 v0 = acc[ai][bj][m][0], v1 = acc[ai][bj][m][1]; const u32x4 g = b[m][bj];
                    v0[0] *= bflo(g[0]); v0[1] *= bfhi(g[0]); v0[2] *= bflo(g[1]); v0[3] *= bfhi(g[1]);
                    v1[0] *= bflo(g[2]); v1[1] *= bfhi(g[2]); v1[2] *= bflo(g[3]); v1[3] *= bfhi(g[3]);
                    *(u32x4*)(Mo + base + (size_t)(ai * 128 + m * 16) * 1024 + bj * 128) = pack_row8(v0, v1); }
            __builtin_amdgcn_sched_barrier(0); }
    }
};

template <bool BASE_BF16> struct EpiRes {
    static constexpr bool PERM = true, MIDK = false;
    const float *xp, *xs; const bf16_t* xb; bf16_t* xo; const float* gmod;
    DI void operator()(Acc& acc, const Unit& u, int wr, int wc, int fr, int fq) const {
        { const int t_ = fresh_tid(); fr = t_ & 15; fq = (t_ >> 4) & 3; }
        const int colb = u.pn * 256 + wc * 32 + 8 * fq;
#pragma unroll
        for (int ai = 0; ai < 2; ++ai) { const int r0 = u.pm * 256 + ai * 128 + wr * 64 + fr;
            const float* g = gmod + (size_t)batch_of(r0) * 6144 + colb;
            f32x4 gv[2][2];
#pragma unroll
            for (int bj = 0; bj < 2; ++bj) { gv[bj][0] = *(const f32x4*)(g + bj * 128); gv[bj][1] = *(const f32x4*)(g + bj * 128 + 4); }
            bf16_t* orow = xo + (size_t)r0 * D + colb;
            if constexpr (BASE_BF16) {
                const bf16_t* xr = xb + (size_t)r0 * D + colb; u32x4 xv[4][2];
#pragma unroll
                for (int m = 0; m < 4; ++m)
#pragma unroll
                    for (int bj = 0; bj < 2; ++bj) xv[m][bj] = *(const u32x4*)(xr + (size_t)m * 16 * D + bj * 128);
#pragma unroll
                for (int m = 0; m < 4; ++m)
#pragma unroll
                    for (int bj = 0; bj < 2; ++bj) { const u32x4 x = xv[m][bj]; const f32x4 a0 = acc[ai][bj][m][0] * gv[bj][0], a1 = acc[ai][bj][m][1] * gv[bj][1];
                        f32x4 v0 = {bflo(x[0]) + a0[0], bfhi(x[0]) + a0[1], bflo(x[1]) + a0[2], bfhi(x[1]) + a0[3]}, v1 = {bflo(x[2]) + a1[0], bfhi(x[2]) + a1[1], bflo(x[3]) + a1[2], bfhi(x[3]) + a1[3]};
                        *(u32x4*)(orow + (size_t)m * 16 * D + bj * 128) = pack_row8(v0, v1); }
            } else {
                const float* xr = (r0 < TP ? xp + (size_t)r0 * D : xs + (size_t)(r0 - TP) * D) + colb; f32x4 xv[4][2][2];
#pragma unroll
                for (int m = 0; m < 4; ++m)
#pragma unroll
                    for (int bj = 0; bj < 2; ++bj) { xv[m][bj][0] = *(const f32x4*)(xr + (size_t)m * 16 * D + bj * 128); xv[m][bj][1] = *(const f32x4*)(xr + (size_t)m * 16 * D + bj * 128 + 4); }
#pragma unroll
                for (int m = 0; m < 4; ++m)
#pragma unroll
                    for (int bj = 0; bj < 2; ++bj) *(u32x4*)(orow + (size_t)m * 16 * D + bj * 128) = pack_row8(xv[m][bj][0] + gv[bj][0] * acc[ai][bj][m][0], xv[m][bj][1] + gv[bj][1] * acc[ai][bj][m][1]);
            }
            __builtin_amdgcn_sched_barrier(0); }
    }
};

struct EpiPart {
    static constexpr bool PERM = false, MIDK = false;
    float* part; int row0;
    DI void operator()(Acc& acc, const Unit& u, int wr, int wc, int fr, int fq) const {
        { const int t_ = fresh_tid(); fr = t_ & 15; fq = (t_ >> 4) & 3; }
#pragma unroll
        for (int ai = 0; ai < 2; ++ai)
#pragma unroll
            for (int m = 0; m < 4; ++m) { float* prow = part + (size_t)(u.pm * 256 + ai * 128 + wr * 64 + m * 16 + fr - row0) * D + u.pn * 256 + wc * 32 + 4 * fq;
#pragma unroll
                for (int bj = 0; bj < 2; ++bj)
#pragma unroll
                    for (int n = 0; n < 2; ++n) *(f32x4*)(prow + bj * 128 + n * 16) = acc[ai][bj][m][n];
                __builtin_amdgcn_sched_barrier(0); }
    }
};

struct EpiFfnIn {
    static constexpr bool PERM = true, MIDK = false;
    bf16_t* HID;
    DI void operator()(Acc& acc, const Unit& u, int wr, int wc, int fr, int fq) const {
        { const int t_ = fresh_tid(); fr = t_ & 15; fq = (t_ >> 4) & 3; }
        bf16_t* base = HID + (size_t)(u.pm * 256 + wr * 64 + fr) * FF + u.pn * 128 + wc * 32 + 8 * fq;
#pragma unroll
        for (int ai = 0; ai < 2; ++ai)
#pragma unroll
            for (int m = 0; m < 4; ++m) { f32x4 v0, v1;
#pragma unroll
                for (int j = 0; j < 4; ++j) { v0[j] = silu(acc[ai][0][m][0][j]) * acc[ai][1][m][0][j]; v1[j] = silu(acc[ai][0][m][1][j]) * acc[ai][1][m][1][j]; }
                *(u32x4*)(base + (size_t)(ai * 128 + m * 16) * FF) = pack_row8(v0, v1); __builtin_amdgcn_sched_barrier(0); }
    }
};

DI void transpose_item(const float* W, int N, bf16_t* WT, int pitch, int koff, int k0, int n0, int drow0, LAS float* scr, int lane) {
#pragma unroll
    for (int i = 0; i < 32; ++i) { const int kk = 2 * i + (lane >> 5); scr[kk * 33 + (lane & 31)] = W[(size_t)(k0 + kk) * N + n0 + (lane & 31)]; }
    asm volatile("s_waitcnt lgkmcnt(0)" ::: "memory");
    const int c = lane & 7;
#pragma unroll
    for (int j = 0; j < 4; ++j) { const int n = (lane >> 3) + 8 * j; const LAS float* s = scr + (8 * c) * 33 + n;
        u32x4 o; o.x = pk2(s[0 * 33], s[1 * 33]); o.y = pk2(s[2 * 33], s[3 * 33]); o.z = pk2(s[4 * 33], s[5 * 33]); o.w = pk2(s[6 * 33], s[7 * 33]);
        *(u32x4*)(WT + (size_t)(drow0 + n) * pitch + koff + k0 + 8 * c) = o; }
    asm volatile("s_waitcnt lgkmcnt(0)" ::: "memory");
}
DI void phase_prep(const Params& p, LAS unsigned char* lds) {
    const int tid = fresh_tid(), lane = tid & 63, wave = __builtin_amdgcn_readfirstlane(tid >> 6);
    LAS float* scr = (LAS float*)(lds + wave * 16384);
    const int gw = blockIdx.x * 8 + wave, NGW = gridDim.x * 8;
    unsigned char* ws = p.ws;
    constexpr int I_ADA = 16 * 192, I_IN = 16 * 176, I_A = 8 * 32, I_O = 16 * 32, I_FI = 16 * 176, I_FO = 44 * 32;
    constexpr int NIT = I_ADA + I_IN + 2 * I_A + I_O + I_FI + I_FO;
    for (int it = gw; it < NIT; it += NGW) {
        int r = it;
        if (r < I_ADA) { const int kb = r / 192, nb = r % 192; transpose_item(p.w_ada, 6144, (bf16_t*)(ws + WS_WADA), 1024, 0, 64 * kb, 32 * nb, 32 * nb, scr, lane); continue; } r -= I_ADA;
        if (r < I_IN) { const int kb = r / 176, nb = r % 176, n0 = 32 * nb; int dr = n0;
            if (n0 >= 3584) { const int j = n0 < 4608 ? n0 - 3584 : n0 - 4608; dr = 3584 + 256 * (j >> 7) + (j & 127) + (n0 < 4608 ? 0 : 128); }
            transpose_item(p.w_in, INC, (bf16_t*)(ws + WS_WIN), 1024, 0, 64 * kb, n0, dr, scr, lane); continue; } r -= I_IN;
        if (r < I_A) { const int kb = r / 32, nb = r % 32; transpose_item(p.w_a, 1024, (bf16_t*)(ws + WS_WAB), 1024, 0, 64 * kb, 32 * nb, 32 * nb, scr, lane); continue; } r -= I_A;
        if (r < I_A) { const int kb = r / 32, nb = r % 32; transpose_item(p.w_b, 1024, (bf16_t*)(ws + WS_WAB), 1024, 512, 64 * kb, 32 * nb, 32 * nb, scr, lane); continue; } r -= I_A;
        if (r < I_O) { const int kb = r / 32, nb = r % 32; transpose_item(p.w_out, 1024, (bf16_t*)(ws + WS_WO), 1024, 0, 64 * kb, 32 * nb, 32 * nb, scr, lane); continue; } r -= I_O;
        if (r < I_FI) { const int kb = r / 176, nb = r % 176; const int n0 = 32 * nb; const int j0 = n0 < FF ? n0 : n0 - FF;
            transpose_item(p.w_ffn_in, INC, (bf16_t*)(ws + WS_WFI), 1024, 0, 64 * kb, n0, 256 * (j0 >> 7) + (j0 & 127) + (n0 < FF ? 0 : 128), scr, lane); continue; } r -= I_FI;
        { const int kb = r / 32, nb = r % 32; transpose_item(p.w_ffn_out, 1024, (bf16_t*)(ws + WS_WFO), FF, 0, 64 * kb, 32 * nb, 32 * nb, scr, lane); }
    }
    bf16_t* SC = (bf16_t*)(ws + WS_SC);
    for (int i = blockIdx.x * 512 + tid; i < 256 * 1024 / 2; i += gridDim.x * 512) { const int row = (2 * i) >> 10, col = (2 * i) & 1023; float a = 0.f, b = 0.f;
        if (row < NBATCH) { const float* c = row < 2 ? p.c_prompt + row * D : p.c_sample + (row - 2) * D; a = silu(c[col]); b = silu(c[col + 1]); }
        ((unsigned*)SC)[i] = pk2(a, b); }
}

DI float wave_sum(float v) {
#pragma unroll
    for (int o = 1; o < 64; o <<= 1) v += __shfl_xor(v, o);
    return v;
}
DI void phase_norm_mod(const float* xp, const float* xs, const float* nw, const float* mod, int sh_off, int sc_off, bf16_t* H) {
    const int tid = fresh_tid(), lane = tid & 63, wave = __builtin_amdgcn_readfirstlane(tid >> 6);
    const int gw = blockIdx.x * 8 + wave, NGW = gridDim.x * 8;
    for (int r = gw; r < T; r += NGW) {
        const float* xr = r < TP ? xp + (size_t)r * D : xs + (size_t)(r - TP) * D; const float* mb = mod + (size_t)batch_of(r) * 6144;
        f32x4 v[4]; float s = 0.f;
#pragma unroll
        for (int j = 0; j < 4; ++j) { v[j] = *(const f32x4*)(xr + 4 * lane + 256 * j); s += (v[j][0] * v[j][0] + v[j][1] * v[j][1]) + (v[j][2] * v[j][2] + v[j][3] * v[j][3]); }
        const float rstd = __builtin_amdgcn_rsqf(wave_sum(s) * (1.f / D) + EPS);
#pragma unroll
        for (int j = 0; j < 4; ++j) { const int col = 4 * lane + 256 * j; const f32x4 w = *(const f32x4*)(nw + col), sc = *(const f32x4*)(mb + sc_off + col), sh = *(const f32x4*)(mb + sh_off + col);
            const f32x4 h = v[j] * rstd * w * (sc + 1.f) + sh; u32x2 o; o.x = pk2(h[0], h[1]); o.y = pk2(h[2], h[3]);
            *(u32x2*)(H + (size_t)r * D + col) = o; }
    }
}
DI void phase_norm_mod_b(const bf16_t* xb, const float* nw, const float* mod, int sh_off, int sc_off, bf16_t* H, int r_lo = 0, int r_hi = T, int b_lo = 0) {
    const int tid = fresh_tid(), lane = tid & 63, wave = __builtin_amdgcn_readfirstlane(tid >> 6);
    const int gw = ((int)blockIdx.x - b_lo) * 8 + wave, NGW = ((int)gridDim.x - b_lo) * 8;
    for (int r = r_lo + gw; r < r_hi; r += NGW) {
        const bf16_t* xr = xb + (size_t)r * D; const float* mb = mod + (size_t)batch_of(r) * 6144;
        float v[2][8]; float s = 0.f;
#pragma unroll
        for (int j = 0; j < 2; ++j) { const u32x4 x = *(const u32x4*)(xr + 8 * lane + 512 * j);
#pragma unroll
            for (int i = 0; i < 4; ++i) { v[j][2 * i] = bflo(x[i]); v[j][2 * i + 1] = bfhi(x[i]); s += v[j][2 * i] * v[j][2 * i] + v[j][2 * i + 1] * v[j][2 * i + 1]; } }
        const float rstd = __builtin_amdgcn_rsqf(wave_sum(s) * (1.f / D) + EPS);
#pragma unroll
        for (int j = 0; j < 2; ++j) { const int col = 8 * lane + 512 * j; f32x4 h[2];
#pragma unroll
            for (int q = 0; q < 2; ++q) { const f32x4 w = *(const f32x4*)(nw + col + 4 * q), sc = *(const f32x4*)(mb + sc_off + col + 4 * q), sh = *(const f32x4*)(mb + sh_off + col + 4 * q);
                const f32x4 x = {v[j][4 * q], v[j][4 * q + 1], v[j][4 * q + 2], v[j][4 * q + 3]}; h[q] = x * rstd * w * (sc + 1.f) + sh; }
            *(u32x4*)(H + (size_t)r * D + col) = pack_row8(h[0], h[1]); }
    }
}
DI void phase_final_norm(const bf16_t* xb, float* y, const float* nw, int r_lo = 0, int r_hi = T, int b_lo = 0) {
    const int tid = fresh_tid(), lane = tid & 63, wave = __builtin_amdgcn_readfirstlane(tid >> 6);
    const int gw = ((int)blockIdx.x - b_lo) * 8 + wave, NGW = ((int)gridDim.x - b_lo) * 8;
    for (int r = r_lo + gw; r < r_hi; r += NGW) { const bf16_t* xr = xb + (size_t)r * D; float* yr = y + (size_t)r * D;
        float v[2][8]; float s = 0.f;
#pragma unroll
        for (int j = 0; j < 2; ++j) { const u32x4 x = *(const u32x4*)(xr + 8 * lane + 512 * j);
#pragma unroll
            for (int i = 0; i < 4; ++i) { v[j][2 * i] = bflo(x[i]); v[j][2 * i + 1] = bfhi(x[i]); s += v[j][2 * i] * v[j][2 * i] + v[j][2 * i + 1] * v[j][2 * i + 1]; } }
        const float rstd = __builtin_amdgcn_rsqf(wave_sum(s) * (1.f / D) + EPS);
#pragma unroll
        for (int j = 0; j < 2; ++j) { const int col = 8 * lane + 512 * j;
#pragma unroll
            for (int q = 0; q < 2; ++q) { const f32x4 x = {v[j][4 * q], v[j][4 * q + 1], v[j][4 * q + 2], v[j][4 * q + 3]}; *(f32x4*)(yr + col + 4 * q) = x * rstd * *(const f32x4*)(nw + col + 4 * q); } }
    }
}

DI void phase_final_norm_parts(const bf16_t* x1b, const float* part0, const float* part1, const float* g2mod, float* y, const float* nw) {
    const int tid = fresh_tid(), lane = tid & 63, wave = __builtin_amdgcn_readfirstlane(tid >> 6);
    const int gw = blockIdx.x * 8 + wave, NGW = gridDim.x * 8;
    for (int r = TP + gw; r < T; r += NGW) { const float* gb = g2mod + (size_t)batch_of(r) * 6144; const size_t po = (size_t)(r - TP) * D;
        f32x4 v[4]; float s = 0.f;
#pragma unroll
        for (int j = 0; j < 4; ++j) { const int col = 4 * lane + 256 * j; const u32x2 xb = *(const u32x2*)(x1b + (size_t)r * D + col);
            const f32x4 x = {bflo(xb.x), bfhi(xb.x), bflo(xb.y), bfhi(xb.y)};
            v[j] = x + *(const f32x4*)(gb + col) * (*(const f32x4*)(part0 + po + col) + *(const f32x4*)(part1 + po + col));
            s += (v[j][0] * v[j][0] + v[j][1] * v[j][1]) + (v[j][2] * v[j][2] + v[j][3] * v[j][3]); }
        const float rstd = __builtin_amdgcn_rsqf(wave_sum(s) * (1.f / D) + EPS);
#pragma unroll
        for (int j = 0; j < 4; ++j) { const int col = 4 * lane + 256 * j; *(f32x4*)(y + (size_t)r * D + col) = v[j] * rstd * *(const f32x4*)(nw + col); }
    }
}

DI void hgrn_u_item(const Params& p, int item, int lane) {
    const int c = item >> 5, rem = item & 31, h = rem >> 3, kt = (rem >> 1) & 3, vh = rem & 1, l31 = lane & 31, hf = lane >> 5;
    const float* CUM = (const float*)(p.ws + WS_CUM); const bf16_t* KA = (const bf16_t*)(p.ws + WS_KA); const bf16_t* VA = (const bf16_t*)(p.ws + WS_VA); bf16_t* U = (bf16_t*)(p.ws + WS_U);
    const size_t hb = (size_t)h * T * 128; const int kcol = 32 * kt + l31;
    const float tot = CUM[hb + (size_t)(c * 64 + 63) * 128 + kcol];
    bf16x8 kdf[2][2];
#pragma unroll
    for (int st = 0; st < 2; ++st) { f32x16 kd;
#pragma unroll
        for (int r = 0; r < 16; ++r) { const size_t idx = hb + (size_t)(c * 64 + 32 * st + crow(r, hf)) * 128 + kcol; kd[r] = bf2f((short)KA[idx]) * __expf(tot - CUM[idx]); }
        kdf[st][0] = pack8(kd, 0); kdf[st][1] = pack8(kd, 1); }
    const bf16x8 id0 = ident_frag(0, l31, hf), id1 = ident_frag(1, l31, hf);
#pragma unroll
    for (int vtl = 0; vtl < 2; ++vtl) { const int vt = 2 * vh + vtl; f32x16 dacc = zero16();
#pragma unroll
        for (int st = 0; st < 2; ++st) { const bf16_t* vp = VA + hb + (size_t)(c * 64 + 32 * st + l31) * 128 + 32 * vt + 8 * hf;
            f32x16 vx = zero16(); vx = MFMA32(*(const bf16x8*)vp, id0, vx); vx = MFMA32(*(const bf16x8*)(vp + 16), id1, vx);
            dacc = MFMA32(kdf[st][0], pack8(vx, 0), dacc); dacc = MFMA32(kdf[st][1], pack8(vx, 1), dacc); }
        bf16_t* up = U + ((size_t)(c * 4 + h) * 128 + 32 * vt + l31) * 128 + 32 * kt + 4 * hf;
#pragma unroll
        for (int g = 0; g < 4; ++g) { u32x2 o; o.x = pk2(dacc[4 * g], dacc[4 * g + 1]); o.y = pk2(dacc[4 * g + 2], dacc[4 * g + 3]); *(u32x2*)(up + 8 * g) = o; }
    }
}

DI void scan_prompt_item(const Params& p, int item, int lane) {
    const int bh = item >> 5, vq = item & 31, b = bh >> 2, h = bh & 3, kg = lane & 31, vv = lane >> 5;
    const float* __restrict__ DEC = (const float*)(p.ws + WS_DEC); const bf16_t* __restrict__ U = (const bf16_t*)(p.ws + WS_U); bf16_t* __restrict__ SST = (bf16_t*)(p.ws + WS_SST);
    f32x4 S0 = {0.f, 0.f, 0.f, 0.f}, S1 = {0.f, 0.f, 0.f, 0.f};
    const int v0 = 4 * vq + vv, v1 = v0 + 2;
#pragma unroll 16
    for (int n = 0; n < 256; ++n) { const int c = b * 256 + n;
        const f32x4 d = *(const f32x4*)(DEC + (size_t)c * 512 + h * 128 + 4 * kg);
        const size_t o0 = ((size_t)(c * 4 + h) * 128 + v0) * 128 + 4 * kg, o1 = ((size_t)(c * 4 + h) * 128 + v1) * 128 + 4 * kg;
        const u32x2 u0 = *(const u32x2*)(U + o0), u1 = *(const u32x2*)(U + o1);
        u32x2 s; s.x = pk2(S0[0], S0[1]); s.y = pk2(S0[2], S0[3]); *(u32x2*)(SST + o0) = s;
        s.x = pk2(S1[0], S1[1]); s.y = pk2(S1[2], S1[3]); *(u32x2*)(SST + o1) = s;
        S0[0] = d[0] * S0[0] + bflo(u0.x); S0[1] = d[1] * S0[1] + bfhi(u0.x); S0[2] = d[2] * S0[2] + bflo(u0.y); S0[3] = d[3] * S0[3] + bfhi(u0.y);
        S1[0] = d[0] * S1[0] + bflo(u1.x); S1[1] = d[1] * S1[1] + bfhi(u1.x); S1[2] = d[2] * S1[2] + bflo(u1.y); S1[3] = d[3] * S1[3] + bfhi(u1.y);
    }
    float* sp = p.out + OFF_SP + ((size_t)bh * 128 + 4 * kg) * 128;
#pragma unroll
    for (int i = 0; i < 4; ++i) { sp[(size_t)i * 128 + v0] = S0[i]; sp[(size_t)i * 128 + v1] = S1[i]; }
}
DI void scan_sample_item(const Params& p, int item, int lane) {
    const int bh = item >> 5, vq = item & 31, bs = bh >> 2, h = bh & 3, kg = lane & 31, vv = lane >> 5, c = 512 + bs;
    const float* DEC = (const float*)(p.ws + WS_DEC); const bf16_t* U = (const bf16_t*)(p.ws + WS_U); bf16_t* SST = (bf16_t*)(p.ws + WS_SST);
    const f32x4 d = *(const f32x4*)(DEC + (size_t)c * 512 + h * 128 + 4 * kg);
    const float* s0 = p.state + ((size_t)bh * 128 + 4 * kg) * 128; float* so = p.out + OFF_SS + ((size_t)bh * 128 + 4 * kg) * 128;
#pragma unroll
    for (int e = 0; e < 2; ++e) { const int v = 4 * vq + 2 * e + vv; const size_t o = ((size_t)(c * 4 + h) * 128 + v) * 128 + 4 * kg;
        const u32x2 u = *(const u32x2*)(U + o); f32x4 S;
#pragma unroll
        for (int i = 0; i < 4; ++i) S[i] = s0[(size_t)i * 128 + v];
        u32x2 s; s.x = pk2(S[0], S[1]); s.y = pk2(S[2], S[3]); *(u32x2*)(SST + o) = s;
        so[v] = d[0] * S[0] + bflo(u.x); so[128 + v] = d[1] * S[1] + bfhi(u.x); so[256 + v] = d[2] * S[2] + bflo(u.y); so[384 + v] = d[3] * S[3] + bfhi(u.y); }
}

DI void attn_item(const Params& p, int item, int lane, const LAS float* biasl, bf16_t* obase = nullptr, int opitch = 1024) {
    const int c = item >> 4, h = (item >> 1) & 7, qh = item & 1, l31 = lane & 31, hf = lane >> 5;
    bf16_t* qptr = (bf16_t*)(p.ws + WS_QOB) + (size_t)(c * 64 + qh * 32 + l31) * 1024 + 512 + h * 64;
    const bf16_t* KB = (const bf16_t*)(p.ws + WS_KB); const bf16_t* VB = (const bf16_t*)(p.ws + WS_VB);
    bf16x8 qf[4];
#pragma unroll
    for (int ks = 0; ks < 4; ++ks) qf[ks] = *(const bf16x8*)(qptr + 16 * ks + 8 * hf);
    const bf16x8 id0 = ident_frag(0, l31, hf), id1 = ident_frag(1, l31, hf);
    const LAS float* bl = biasl + h * 192;
    f32x16 OT0 = zero16(), OT1 = zero16(); float mrun = -1e30f, lsum = 0.f;
    int ntile, ncache, db0; size_t krow_first;
    if (c < 512) { const int n = c & 255, j0 = n < 8 ? n : 8; ntile = 2 * (j0 + 1); ncache = 0; db0 = 64 * j0 + 32 * qh; krow_first = (size_t)(c - j0) * 64; }
    else { ntile = 18; ncache = 16; db0 = 512 + 32 * qh; krow_first = (size_t)c * 64 - 512; }
    const int bs = c - 512;
    u32x4 nk[4], nv[4], nk2[4], nv2[4];
#define ATT_LOAD(i_) do { if ((i_) < ncache) { \
            const float* kp_ = p.cache_k + ((size_t)(bs * 512 + 32 * (i_) + l31) * 8 + h) * 64 + 8 * hf; const float* vp_ = p.cache_v + ((size_t)(bs * 512 + 32 * (i_) + l31) * 8 + h) * 64 + 8 * hf; \
            _Pragma("unroll") for (int ks = 0; ks < 4; ++ks) { nk[ks] = *(const u32x4*)(kp_ + 16 * ks); nk2[ks] = *(const u32x4*)(kp_ + 16 * ks + 4); nv[ks] = *(const u32x4*)(vp_ + 16 * ks); nv2[ks] = *(const u32x4*)(vp_ + 16 * ks + 4); } \
        } else { const size_t ro_ = ((size_t)h * T + krow_first + 32 * (i_) + l31) * 64 + 8 * hf; \
            _Pragma("unroll") for (int ks = 0; ks < 4; ++ks) { nk[ks] = *(const u32x4*)(KB + ro_ + 16 * ks); nv[ks] = *(const u32x4*)(VB + ro_ + 16 * ks); } } } while (0)
    ATT_LOAD(0);
    for (int i = 0; i < ntile; ++i) {
        bf16x8 kf[4], vf[2][2];
        if (i < ncache) {
#pragma unroll
            for (int ks = 0; ks < 4; ++ks) { u32x4 w; const f32x4 a = __builtin_bit_cast(f32x4, nk[ks]), b = __builtin_bit_cast(f32x4, nk2[ks]), e = __builtin_bit_cast(f32x4, nv[ks]), f = __builtin_bit_cast(f32x4, nv2[ks]);
                w.x = pk2(a[0], a[1]); w.y = pk2(a[2], a[3]); w.z = pk2(b[0], b[1]); w.w = pk2(b[2], b[3]); kf[ks] = __builtin_bit_cast(bf16x8, w);
                w.x = pk2(e[0], e[1]); w.y = pk2(e[2], e[3]); w.z = pk2(f[0], f[1]); w.w = pk2(f[2], f[3]); vf[ks >> 1][ks & 1] = __builtin_bit_cast(bf16x8, w); }
        } else {
#pragma unroll
            for (int ks = 0; ks < 4; ++ks) { kf[ks] = __builtin_bit_cast(bf16x8, nk[ks]); vf[ks >> 1][ks & 1] = __builtin_bit_cast(bf16x8, nv[ks]); }
        }
        if (i + 1 < ntile) ATT_LOAD(i + 1);
        asm volatile("" ::: "memory");
        f32x16 st = zero16();
#pragma unroll
        for (int ks = 0; ks < 4; ++ks) st = MFMA32(kf[ks], qf[ks], st);
        const int dbase = db0 - 32 * i + l31; float mt = -1e30f;
        if (db0 - 32 * i - 31 >= 128) { const float bc = bl[191];
#pragma unroll
            for (int r = 0; r < 16; ++r) { const float s = st[r] * (0.125f * LOG2E) + bc; st[r] = s; mt = fmaxf(mt, s); }
        } else {
#pragma unroll
            for (int r = 0; r < 16; ++r) { int dist = dbase - crow(r, hf); dist = dist > 128 ? 128 : dist; const float s = st[r] * (0.125f * LOG2E) + bl[dist + 63]; st[r] = s; mt = fmaxf(mt, s); }
        }
        mt = fmaxf(mt, __shfl_xor(mt, 32));
        const float mnew = fmaxf(mrun, mt), alpha = __builtin_amdgcn_exp2f(mrun - mnew); mrun = mnew;
        float ps = 0.f;
#pragma unroll
        for (int r = 0; r < 16; ++r) { st[r] = __builtin_amdgcn_exp2f(st[r] - mnew); ps += st[r]; }
        lsum = lsum * alpha + ps;
#pragma unroll
        for (int r = 0; r < 16; ++r) { OT0[r] *= alpha; OT1[r] *= alpha; }
        const bf16x8 pf0 = pack8(st, 0), pf1 = pack8(st, 1);
        { f32x16 vx = zero16(); vx = MFMA32(vf[0][0], id0, vx); vx = MFMA32(vf[0][1], id1, vx); OT0 = MFMA32(pack8(vx, 0), pf0, OT0); OT0 = MFMA32(pack8(vx, 1), pf1, OT0); }
        { f32x16 vx = zero16(); vx = MFMA32(vf[1][0], id0, vx); vx = MFMA32(vf[1][1], id1, vx); OT1 = MFMA32(pack8(vx, 0), pf0, OT1); OT1 = MFMA32(pack8(vx, 1), pf1, OT1); }
    }
    lsum += __shfl_xor(lsum, 32); const float inv = 1.f / lsum;
    if (obase) qptr = obase + (size_t)(c * 64 + qh * 32 + l31) * opitch + h * 64;
#pragma unroll
    for (int g = 0; g < 4; ++g) { u32x2 o; o.x = pk2(OT0[4 * g] * inv, OT0[4 * g + 1] * inv); o.y = pk2(OT0[4 * g + 2] * inv, OT0[4 * g + 3] * inv); *(u32x2*)(qptr + 8 * g + 4 * hf) = o;
        o.x = pk2(OT1[4 * g] * inv, OT1[4 * g + 1] * inv); o.y = pk2(OT1[4 * g + 2] * inv, OT1[4 * g + 3] * inv); *(u32x2*)(qptr + 32 + 8 * g + 4 * hf) = o; }
}

DI void hgrn_out_item(const Params& p, int item, int lane, bf16_t* obase = nullptr) {
    const int c = item >> 3, h = (item >> 1) & 3, tt = item & 1, l31 = lane & 31, hf = lane >> 5;
    const float* CUM = (const float*)(p.ws + WS_CUM); const bf16_t* KA = (const bf16_t*)(p.ws + WS_KA); const bf16_t* VA = (const bf16_t*)(p.ws + WS_VA);
    const bf16_t* GA = (const bf16_t*)(p.ws + WS_GA); const bf16_t* SST = (const bf16_t*)(p.ws + WS_SST);
    const int trow = c * 64 + 32 * tt + l31;
    bf16_t* qap = (bf16_t*)(p.ws + WS_QOB) + (size_t)trow * 1024 + h * 128;
    const size_t hb = (size_t)h * T * 128;
    const float* cumt = CUM + hb + (size_t)trow * 128; const float* refp = CUM + hb + (size_t)(c * 64 + 32) * 128;
    bf16x8 qd1[8], qd2[8];
#pragma unroll
    for (int ks = 0; ks < 8; ++ks) { const int k0 = 16 * ks + 8 * hf; const bf16x8 q8 = *(const bf16x8*)(qap + k0);
        const f32x4 c0 = *(const f32x4*)(cumt + k0), c1 = *(const f32x4*)(cumt + k0 + 4), r0 = *(const f32x4*)(refp + k0), r1 = *(const f32x4*)(refp + k0 + 4);
        float a[8], b[8];
#pragma unroll
        for (int j = 0; j < 8; ++j) { const float q = bf2f(q8[j]), cu = j < 4 ? c0[j & 3] : c1[j & 3], rf = j < 4 ? r0[j & 3] : r1[j & 3]; a[j] = q * __expf(cu - rf); b[j] = q * __expf(cu); }
        qd1[ks] = pack8f(a); qd2[ks] = pack8f(b); }
    f32x16 OT[4];
#pragma unroll
    for (int vt = 0; vt < 4; ++vt) OT[vt] = zero16();
    const bf16_t* sp = SST + ((size_t)(c * 4 + h) * 128 + l31) * 128 + 8 * hf;
#pragma unroll
    for (int vt = 0; vt < 4; ++vt)
#pragma unroll
        for (int ks = 0; ks < 8; ++ks) OT[vt] = MFMA32(*(const bf16x8*)(sp + (size_t)vt * 32 * 128 + 16 * ks), qd2[ks], OT[vt]);
    const bf16x8 id0 = ident_frag(0, l31, hf), id1 = ident_frag(1, l31, hf);
    for (int st = 0; st <= tt; ++st) {
        const int srow = c * 64 + 32 * st + l31; const bf16_t* kap = KA + hb + (size_t)srow * 128; const float* cums = CUM + hb + (size_t)srow * 128;
        f32x16 X = zero16();
#pragma unroll
        for (int ks = 0; ks < 8; ++ks) { const int k0 = 16 * ks + 8 * hf; const bf16x8 k8 = *(const bf16x8*)(kap + k0);
            const f32x4 c0 = *(const f32x4*)(cums + k0), c1 = *(const f32x4*)(cums + k0 + 4), r0 = *(const f32x4*)(refp + k0), r1 = *(const f32x4*)(refp + k0 + 4);
            float a[8];
#pragma unroll
            for (int j = 0; j < 8; ++j) { const float cu = j < 4 ? c0[j & 3] : c1[j & 3], rf = j < 4 ? r0[j & 3] : r1[j & 3]; a[j] = bf2f(k8[j]) * __expf(rf - cu); }
            X = MFMA32(pack8f(a), qd1[ks], X); }
        if (st == tt) {
#pragma unroll
            for (int r = 0; r < 16; ++r) if (crow(r, hf) > l31) X[r] = 0.f; }
        const bf16x8 xf0 = pack8(X, 0), xf1 = pack8(X, 1);
        const bf16_t* vp = VA + hb + (size_t)srow * 128 + 8 * hf;
#pragma unroll
        for (int vt = 0; vt < 4; ++vt) { f32x16 vx = zero16(); vx = MFMA32(*(const bf16x8*)(vp + 32 * vt), id0, vx); vx = MFMA32(*(const bf16x8*)(vp + 32 * vt + 16), id1, vx);
            OT[vt] = MFMA32(pack8(vx, 0), xf0, OT[vt]); OT[vt] = MFMA32(pack8(vx, 1), xf1, OT[vt]); }
    }
    float ss = 0.f;
#pragma unroll
    for (int vt = 0; vt < 4; ++vt)
#pragma unroll
        for (int r = 0; r < 16; ++r) ss += OT[vt][r] * OT[vt][r];
    ss += __shfl_xor(ss, 32);
    const float rstd = __builtin_amdgcn_rsqf(ss * (1.f / 128.f) + EPS);
    const bf16_t* gap = GA + hb + (size_t)trow * 128; const float* onp = p.out_norm + h * 128;
    if (obase) qap = obase + (size_t)trow * 512 + h * 128;
#pragma unroll
    for (int vt = 0; vt < 4; ++vt)
#pragma unroll
        for (int g = 0; g < 4; ++g) { const int v0 = 32 * vt + 8 * g + 4 * hf; const f32x4 on = *(const f32x4*)(onp + v0); const u32x2 ga = *(const u32x2*)(gap + v0);
            u32x2 o; o.x = pk2(OT[vt][4 * g] * rstd * on[0] * bflo(ga.x), OT[vt][4 * g + 1] * rstd * on[1] * bfhi(ga.x));
            o.y = pk2(OT[vt][4 * g + 2] * rstd * on[2] * bflo(ga.y), OT[vt][4 * g + 3] * rstd * on[3] * bfhi(ga.y)); *(u32x2*)(qap + v0) = o; }
}


#define XB_TMO      128
#define XB_XCNT(j)  (256  + 64 * (j))
#define XB_XSUB(j)  (1280 + 64 * (j))
#define XB_XGEN(j)  (2304 + 64 * (j))
#define XB_TOP      3328
#define XB_TOPGEN   3392
#define XCD_BAR_WORDS 3456
#define XB_SPIN_CAP (1u << 18)
DI unsigned xb_ld(unsigned* p)              { return __hip_atomic_load(p, __ATOMIC_RELAXED, __HIP_MEMORY_SCOPE_AGENT); }
DI unsigned xb_add(unsigned* p, unsigned v) { return __hip_atomic_fetch_add(p, v, __ATOMIC_RELAXED, __HIP_MEMORY_SCOPE_AGENT); }
DI unsigned xb_xcc_id() { return (unsigned)__builtin_amdgcn_s_getreg((3 << 11) | 20) & 0xFu; }
#define XB_SPIN(cond, bar) do { unsigned _sp = 0; while (cond) { __builtin_amdgcn_s_sleep(1); \
    if ((++_sp & 255u) == 0u) { if (xb_ld(&(bar)[XB_TMO])) break; if (_sp > XB_SPIN_CAP) { atomicAdd(&(bar)[XB_TMO], 1u); break; } } } } while (0)
struct XcdBarrier { unsigned* bar; unsigned x; volatile LAS unsigned* st; };
DI XcdBarrier xcd_barrier_post(unsigned* bar, volatile LAS unsigned* st) {
    XcdBarrier b; b.bar = bar; b.x = xb_xcc_id(); b.st = st;
    if (threadIdx.x == 0) (void)xb_add(&bar[XB_XCNT(b.x)], 1u);
    return b;
}
DI void xcd_barrier_complete(unsigned* bar, unsigned x, unsigned& nloc, unsigned& nx) {
    const unsigned G = gridDim.x * gridDim.y * gridDim.z;
    unsigned sum, cnt, mine, sp = 0u;
    for (;;) {
        sum = 0u; cnt = 0u; mine = 0u;
#pragma unroll
        for (unsigned j = 0; j < 16; ++j) { const unsigned c = xb_ld(&bar[XB_XCNT(j)]); sum += c; cnt += (c > 0u) ? 1u : 0u; mine = (j == x) ? c : mine; }
        if (sum == G) break;
        __builtin_amdgcn_s_sleep(1);
        if ((++sp & 255u) == 0u) { if (xb_ld(&bar[XB_TMO])) break; if (sp > XB_SPIN_CAP) { atomicAdd(&bar[XB_TMO], 1u); break; } }
    }
    nloc = mine > 0u ? mine : 1u; nx = cnt > 0u ? cnt : 1u;
}
DI void xcd_barrier(const XcdBarrier& b) {
    asm volatile("s_waitcnt vmcnt(0)" ::: "memory");
    __syncthreads();
    if (threadIdx.x == 0) {
        unsigned* bar = b.bar;
        __builtin_amdgcn_s_waitcnt(0);
        unsigned nloc = b.st[0], nx = b.st[1];
        if (nloc == 0u) { xcd_barrier_complete(bar, b.x, nloc, nx); b.st[0] = nloc; b.st[1] = nx; }
        const unsigned old = xb_add(&bar[XB_XSUB(b.x)], 1u);
        const unsigned gen = old / nloc;
        if (old + 1u == (gen + 1u) * nloc) {
            __builtin_amdgcn_fence(__ATOMIC_RELEASE, "agent");
            asm volatile("s_waitcnt vmcnt(0)" ::: "memory");
            const unsigned og = xb_add(&bar[XB_TOP], 1u);
            const unsigned tg = og / nx;
            if (og + 1u == (tg + 1u) * nx) xb_add(&bar[XB_TOPGEN], 1u);
            else XB_SPIN(xb_ld(&bar[XB_TOPGEN]) == tg, bar);
            __builtin_amdgcn_fence(__ATOMIC_ACQUIRE, "agent");
            xb_add(&bar[XB_XGEN(b.x)], 1u);
            asm volatile("s_waitcnt vmcnt(0)" ::: "memory");
        } else {
            XB_SPIN(xb_ld(&bar[XB_XGEN(b.x)]) == gen, bar);
            __builtin_amdgcn_fence(__ATOMIC_ACQUIRE, "agent");
            asm volatile("s_waitcnt vmcnt(0)" ::: "memory");
        }
    }
    __syncthreads();
}

__global__ void __launch_bounds__(512, 2) fwd_megakernel(Params p) {
    extern __shared__ __attribute__((aligned(16))) unsigned char lds_raw[];
    LAS unsigned char* lds = (LAS unsigned char*)lds_raw;
    cg::grid_group grid = cg::this_grid();
    const int G = gridDim.x, bx = blockIdx.x;
    volatile LAS unsigned* bst = (volatile LAS unsigned*)(lds + LDS_ST_OFF);
    if (threadIdx.x < 2) bst[threadIdx.x] = 0u;
    __syncthreads();
    const XcdBarrier xbar = xcd_barrier_post((unsigned*)(p.ws + WS_BAR), bst);
    if (threadIdx.x == 0) bst[2] = xb_add((unsigned*)(p.ws + WS_BAR) + 3712 + xbar.x, 1u);
#define GRID_BAR() xcd_barrier(xbar)
    unsigned char* ws = p.ws;
    float* MOD = (float*)(ws + WS_MOD); bf16_t* H = (bf16_t*)(ws + WS_H);

    phase_prep(p, lds);
    grid.sync();
    { pg8::Gemm g{(const bf16_t*)(ws + WS_SC), (const bf16_t*)(ws + WS_WADA), 256, 6144, 1024}; pg8::StaticOrder S; S.init(256, 6144, G, bx);
      EpiMod E{MOD, p.b_ada}; pg8::gemm_phase<EpiMod, pg8::StaticOrder, true, true>(lds, g, S, E); }
    GRID_BAR();
    int cv = bx;
    { unsigned* barw = (unsigned*)(p.ws + WS_BAR); bool uni = (G & 7) == 0;
#pragma unroll
      for (int j = 0; j < 16; ++j) { const unsigned c = xb_ld(&barw[XB_XCNT(j)]); uni = uni && (j < 8 ? c == (unsigned)(G >> 3) : c == 0u); }
      if (uni) cv = (int)xbar.x + 8 * (int)bst[2];
      cv = __builtin_amdgcn_readfirstlane(cv); }
    phase_norm_mod(p.x_prompt, p.x_sample, p.norm_mix, MOD, 0, 1024, H);
#if PROBE_DUP == 1
    GRID_BAR(); phase_norm_mod(p.x_prompt, p.x_sample, p.norm_mix, MOD, 0, 1024, H);
#endif
#if PROBE_DUP == 10
    GRID_BAR(); GRID_BAR(); GRID_BAR(); GRID_BAR(); GRID_BAR(); GRID_BAR(); GRID_BAR(); GRID_BAR(); GRID_BAR(); GRID_BAR();
#endif
    GRID_BAR();
    { pg8::Gemm g{H, (const bf16_t*)(ws + WS_WIN), T, INC, 1024}; pg8::StaticOrder S; S.init(T, INC, G, cv);
      EpiIn E{(bf16_t*)(ws + WS_QOB), (bf16_t*)(ws + WS_KA), (bf16_t*)(ws + WS_VA), (bf16_t*)(ws + WS_GA), (bf16_t*)(ws + WS_KB), (bf16_t*)(ws + WS_VB),
              (bf16_t*)(p.out), (bf16_t*)(p.out) + (size_t)T * 1024, (float*)(ws + WS_CUM), (float*)(ws + WS_DEC), p.lb_logits, p.out};
      pg8::gemm_phase<EpiIn, pg8::StaticOrder, true, true>(lds, g, S, E);
#if PROBE_DUP == 2
      GRID_BAR(); pg8::gemm_phase<EpiIn, pg8::StaticOrder, true, true>(lds, g, S, E);
#endif
    }
    GRID_BAR();
    { const int tid = fresh_tid(), lane = tid & 63, wave = __builtin_amdgcn_readfirstlane(tid >> 6);
      for (int it = wave * G + bx; it < NCH * 32; it += 8 * G) hgrn_u_item(p, it, lane);
#if PROBE_DUP == 3
      for (int it = wave * G + bx; it < NCH * 32; it += 8 * G) hgrn_u_item(p, it, lane);
#endif
    }
    GRID_BAR();
    {
        const int tid = fresh_tid(), lane = tid & 63, wave = __builtin_amdgcn_readfirstlane(tid >> 6);
        LAS float* biasl = (LAS float*)lds;
        for (int i = tid; i < 8 * 192; i += 512) biasl[i] = p.rel_bias[i] * LOG2E;
        __syncthreads();
#if PROBE_DUP == 4
        if (wave != 0) { const int gw = (wave - 1) * G + bx, NGW = 7 * G; for (int it = gw; it < NCH * 16; it += NGW) attn_item(p, it, lane, biasl, (bf16_t*)(ws + WS_SST), 512); }
        GRID_BAR();
#endif
#if PROBE_DUP == 41
        if (wave == 0) { for (int it = bx; it < 256; it += G) scan_prompt_item(p, it, lane); }
        GRID_BAR();
#endif
        if (wave == 0) { for (int it = bx; it < 256; it += G) scan_prompt_item(p, it, lane); }
        else {
            const int gw = (wave - 1) * G + bx, NGW = 7 * G;
            for (int it = gw; it < 4096; it += NGW) scan_sample_item(p, it, lane);
            const int x = (int)xbar.x, ncu = (int)bst[0], nxcc = (int)bst[1], j = (int)bst[2];
            if (nxcc == 8 && x < 8 && ncu > 0 && j < ncu) {
                const int nslot = 7 * ncu, slot = (wave - 1) * ncu + j;
                for (int idx = slot; idx < 68 * 16; idx += nslot) { const int cc = idx >> 4, c = cc < 4 ? 512 + 4 * x + cc : 64 * x + (cc - 4); attn_item(p, c * 16 + (idx & 15), lane, biasl); }
            } else for (int it = gw; it < NCH * 16; it += NGW) attn_item(p, it, lane, biasl);
        }
    }
    GRID_BAR();
    { const int tid = fresh_tid(), lane = tid & 63, wave = __builtin_amdgcn_readfirstlane(tid >> 6);
#if PROBE_DUP == 5
      for (int it = wave * G + bx; it < NCH * 8; it += 8 * G) hgrn_out_item(p, it, lane, (bf16_t*)(ws + WS_U));
      GRID_BAR();
#endif
      for (int it = wave * G + bx; it < NCH * 8; it += 8 * G) hgrn_out_item(p, it, lane); }
    GRID_BAR();
    { pg8::Gemm g{(const bf16_t*)(ws + WS_QOB), (const bf16_t*)(ws + WS_WAB), T, 1024, 1024}; pg8::StaticOrder S; S.init(T, 1024, G, cv);
      EpiMerge E{(const bf16_t*)(p.out), (const bf16_t*)(p.out) + (size_t)T * 1024, (bf16_t*)(ws + WS_M)};
      pg8::gemm_phase<EpiMerge, pg8::StaticOrder, true, true>(lds, g, S, E); }
    GRID_BAR();
    const bool split_ps = G >= 64;
    { pg8::Gemm g{(const bf16_t*)(ws + WS_M), (const bf16_t*)(ws + WS_WO), T, 1024, 1024}; EpiRes<false> E{p.x_prompt, p.x_sample, nullptr, (bf16_t*)(ws + WS_X1B), MOD + 2048};
      if (split_ps) {
        { pg8::StaticOrder S; S.init(TP, 1024, G, cv); pg8::gemm_phase<EpiRes<false>, pg8::StaticOrder, true, true>(lds, g, S, E); }
        GRID_BAR();
        if (bx < 32) { pg8::StaticOrder S; S.init(TS, 1024, 32, bx, TP / 256); pg8::gemm_phase<EpiRes<false>, pg8::StaticOrder, true, true>(lds, g, S, E); }
        else phase_norm_mod_b((const bf16_t*)(ws + WS_X1B), p.norm_ffn, MOD, 3072, 4096, H, 0, TP, 32);
        GRID_BAR();
        phase_norm_mod_b((const bf16_t*)(ws + WS_X1B), p.norm_ffn, MOD, 3072, 4096, H, TP, T, 0);
      } else {
        pg8::StaticOrder S; S.init(T, 1024, G, cv); pg8::gemm_phase<EpiRes<false>, pg8::StaticOrder, true, true>(lds, g, S, E);
        GRID_BAR();
        phase_norm_mod_b((const bf16_t*)(ws + WS_X1B), p.norm_ffn, MOD, 3072, 4096, H);
      } }
    GRID_BAR();
    { pg8::Gemm g{H, (const bf16_t*)(ws + WS_WFI), T, INC, 1024}; pg8::StaticOrder S; S.init(T, INC, G, cv);
      EpiFfnIn E{(bf16_t*)(ws + WS_HID)}; pg8::gemm_phase<EpiFfnIn, pg8::StaticOrder, true, true>(lds, g, S, E);
#if PROBE_DUP == 9
      GRID_BAR(); pg8::gemm_phase<EpiFfnIn, pg8::StaticOrder, true, true>(lds, g, S, E);
#endif
    }
    GRID_BAR();
    { pg8::Gemm g{(const bf16_t*)(ws + WS_HID), (const bf16_t*)(ws + WS_WFO), T, 1024, FF}; EpiRes<true> E{nullptr, nullptr, (const bf16_t*)(ws + WS_X1B), (bf16_t*)(ws + WS_X2B), MOD + 5120};
      if (split_ps) {
        { pg8::StaticOrder S; S.init(TP, 1024, G, cv); pg8::gemm_phase<EpiRes<true>, pg8::StaticOrder, true, true>(lds, g, S, E); }
        GRID_BAR();
        float* PART = (float*)(ws + WS_CUM + 20 * MiB);
        if (bx < 64) { const int ks = bx >> 5; pg8::Gemm gs{(const bf16_t*)(ws + WS_HID) + ks * (FF / 2), (const bf16_t*)(ws + WS_WFO) + ks * (FF / 2), T, 1024, FF / 2, FF};
            pg8::StaticOrder S; S.init(TS, 1024, 32, bx & 31, TP / 256); EpiPart EP{PART + (size_t)ks * TS * D, TP}; pg8::gemm_phase<EpiPart, pg8::StaticOrder, true, true>(lds, gs, S, EP); }
        else phase_final_norm((const bf16_t*)(ws + WS_X2B), p.out, p.norm_final, 0, TP, 64);
        GRID_BAR();
        phase_final_norm_parts((const bf16_t*)(ws + WS_X1B), PART, PART + (size_t)TS * D, MOD + 5120, p.out, p.norm_final);
      } else {
        pg8::StaticOrder S; S.init(T, 1024, G, cv); pg8::gemm_phase<EpiRes<true>, pg8::StaticOrder, true, true>(lds, g, S, E);
        GRID_BAR();
        phase_final_norm((const bf16_t*)(ws + WS_X2B), p.out, p.norm_final);
      } }
}

extern "C" void kernel_launch(void* const* d_in, const int* in_sizes, int n_in, void* d_out, int out_size, void* d_ws, size_t ws_size, hipStream_t stream) {
    static int grid = 0;
    if (grid == 0) {
        if (n_in != 21 || (size_t)out_size != OUT_TOTAL || ws_size < WS_END) { fprintf(stderr, "kernel_launch: unexpected sizes n_in %d out %d ws %zu\n", n_in, out_size, ws_size); grid = -1; return; }
        int dev = 0, cus = 0, per = 0;
        (void)hipGetDevice(&dev); (void)hipDeviceGetAttribute(&cus, hipDeviceAttributeMultiprocessorCount, dev);
        (void)hipFuncSetAttribute((const void*)fwd_megakernel, hipFuncAttributeMaxDynamicSharedMemorySize, LDS_BYTES);
        (void)hipOccupancyMaxActiveBlocksPerMultiprocessor(&per, (const void*)fwd_megakernel, 512, LDS_BYTES);
        if (per < 1) per = 1;
        grid = cus * per; fprintf(stderr, "kernel_launch: grid %d (cus %d x %d)\n", grid, cus, per);
    }
    if (grid < 0) return;
    if (hipMemsetAsync((char*)d_ws + WS_BAR, 0, BAR_BYTES, stream) != hipSuccess) { fprintf(stderr, "kernel_launch: memset failed\n"); return; }
    Params p{};
    const float** f = (const float**)&p;
    for (int i = 0; i < 21; ++i) f[i] = (const float*)d_in[i];
    p.out = (float*)d_out; p.ws = (unsigned char*)d_ws;
    void* args[] = {&p};
    hipError_t e = hipLaunchCooperativeKernel((const void*)fwd_megakernel, dim3(grid), dim3(512), args, LDS_BYTES, stream);
    if (e != hipSuccess) fprintf(stderr, "cooperative launch failed: %s (grid %d)\n", hipGetErrorString(e), grid);
}
```

```cpp
#include <hip/hip_runtime.h>
#include <hip/hip_cooperative_groups.h>
#include <cstdio>
#include <cstdint>
namespace cg = cooperative_groups;
#ifndef PROBE_DUP
#define PROBE_DUP 0
#endif

#define DI __device__ __forceinline__
#define LAS __attribute__((address_space(3)))
typedef unsigned short bf16_t;
typedef short bf16x8 __attribute__((ext_vector_type(8)));
typedef float f32x4 __attribute__((ext_vector_type(4)));
typedef float f32x2 __attribute__((ext_vector_type(2)));
typedef float f32x16 __attribute__((ext_vector_type(16)));
typedef unsigned u32x4 __attribute__((ext_vector_type(4)));
typedef unsigned u32x2 __attribute__((ext_vector_type(2)));
typedef __bf16 bf2_t __attribute__((ext_vector_type(2)));

constexpr int D = 1024, TP = 32768, TS = 2048, T = TP + TS, NCH = T / 64, NBATCH = 34;
constexpr int INC = 5632, FF = 2816;
constexpr float EPS = 1e-6f, LOG2E = 1.4426950408889634f;
constexpr size_t OFF_Y = 0, OFF_SP = (size_t)T * D, OFF_KP = OFF_SP + 131072, OFF_VP = OFF_KP + 524288, OFF_SS = OFF_VP + 524288,
                 OFF_KS = OFF_SS + 2097152, OFF_VS = OFF_KS + 1048576, OUT_TOTAL = OFF_VS + 1048576;
constexpr size_t MiB = 1u << 20;
constexpr size_t WS_MOD = 1 * MiB, WS_DEC = 2 * MiB, WS_SC = 4 * MiB, WS_WADA = 5 * MiB, WS_WIN = 17 * MiB, WS_WAB = 28 * MiB, WS_WO = 30 * MiB,
                 WS_WFI = 32 * MiB, WS_WFO = 43 * MiB, WS_H = 50 * MiB, WS_QOB = 118 * MiB, WS_KA = 186 * MiB, WS_VA = 220 * MiB, WS_GA = 254 * MiB,
                 WS_KB = 288 * MiB, WS_VB = 322 * MiB, WS_CUM = 356 * MiB, WS_SST = 424 * MiB, WS_END = 492 * MiB;
constexpr size_t WS_U = WS_H, WS_M = WS_KA, WS_HID = WS_KA, WS_X1B = WS_QOB, WS_X2B = WS_H;
constexpr size_t WS_BAR = 0, BAR_BYTES = 16384;
constexpr int LDS_BYTES = 140 * 1024, LDS_ST_OFF = 136 * 1024;

struct Params {
    const float *x_prompt, *x_sample, *c_prompt, *c_sample, *state, *cache_k, *cache_v, *w_ada, *b_ada, *norm_mix, *w_in, *lb_logits, *out_norm,
                *w_a, *rel_bias, *w_b, *w_out, *norm_ffn, *w_ffn_in, *w_ffn_out, *norm_final;
    float* out; unsigned char* ws;
};

DI int fresh_tid() { int t = threadIdx.x; asm volatile("" : "+v"(t)); return t; }
DI int launder(int v) { asm volatile("" : "+v"(v)); return v; }
DI unsigned pk2(float a, float b) { f32x2 v = {a, b}; bf2_t r = __builtin_convertvector(v, bf2_t); return __builtin_bit_cast(unsigned, r); }
DI float bflo(unsigned u) { return __uint_as_float(u << 16); }
DI float bfhi(unsigned u) { return __uint_as_float(u & 0xffff0000u); }
DI float bf2f(short s) { return __uint_as_float(((unsigned)(unsigned short)s) << 16); }
DI float sigm(float x) { return __builtin_amdgcn_rcpf(1.f + __expf(-x)); }
DI float silu(float x) { return x * sigm(x); }
DI int batch_of(int r) { return r < TP ? (r >> 14) : 2 + ((r - TP) >> 6); }
DI int crow(int reg, int h) { return (reg & 3) + 8 * (reg >> 2) + 4 * h; }
DI bf16x8 pack8(const f32x16& x, int s) {
    u32x4 p; p.x = pk2(x[8 * s], x[8 * s + 1]); p.y = pk2(x[8 * s + 2], x[8 * s + 3]); p.z = pk2(x[8 * s + 4], x[8 * s + 5]); p.w = pk2(x[8 * s + 6], x[8 * s + 7]);
    return __builtin_bit_cast(bf16x8, p);
}
DI bf16x8 pack8f(const float* v) { u32x4 p; p.x = pk2(v[0], v[1]); p.y = pk2(v[2], v[3]); p.z = pk2(v[4], v[5]); p.w = pk2(v[6], v[7]); return __builtin_bit_cast(bf16x8, p); }
DI bf16x8 ident_frag(int ks, int l31, int hf) {
    const int jj = l31 - 16 * ks - 8 * hf; bf16x8 r;
#pragma unroll
    for (int j = 0; j < 8; ++j) r[j] = (j == jj) ? (short)0x3F80 : (short)0;
    return r;
}
#define MFMA32(a, b, c) __builtin_amdgcn_mfma_f32_32x32x16_bf16((a), (b), (c), 0, 0, 0)
DI f32x16 zero16() { f32x16 z;
#pragma unroll
    for (int i = 0; i < 16; ++i) z[i] = 0.f; return z; }

namespace pg8 {
constexpr int BM = 256, BK = 64, HALF = 128, HTB = HALF * BK * 2, STAGE_BYTES = 8 * HTB, NXCD = 8, WGM = 8;
__host__ __device__ __forceinline__ int lds_byte(int r, int c) { const int st = (r >> 4) * 2 + (c >> 5), rr = r & 15, cc = c & 31, ob = rr * 64 + cc * 2; return st * 1024 + (ob ^ (((ob >> 9) & 1) << 5)); }
__host__ __device__ __forceinline__ void stage_rc(int b, int& R, int& C) { const int st = b / 1024, sb = b % 1024, swz = sb ^ (((sb >> 9) & 1) << 5); R = (st >> 1) * 16 + swz / 64; C = (st & 1) * 32 + (swz % 64) / 2; }
__host__ __device__ __forceinline__ int perm32(int rho) { const int n = rho >> 4, i = rho & 15; return 8 * (i >> 2) + 4 * n + (i & 3); }
struct Unit { int pm, pn; };
struct Gemm { const bf16_t* A; const bf16_t* Bt; int M, N, K, ld; };
struct StaticOrder {
    int nM, nN, nwg, G, c, pm_off;
    __device__ void init(int M, int N, int G_, int c_, int pm_off_ = 0) { nM = M / BM; nN = N / BM; nwg = nM * nN; G = G_; c = c_; pm_off = pm_off_; }
    __device__ bool next(int i, Unit& u) const {
        const long L = (long)i * G + c; if (L >= nwg) return false;
        int wgid = (int)L; { const int q = nwg / NXCD, r = nwg % NXCD, xcd = wgid % NXCD, off = wgid / NXCD; wgid = (xcd < r ? xcd * (q + 1) : r * (q + 1) + (xcd - r) * q) + off; }
        const int nig = WGM * nN, gid = wgid / nig, fm = gid * WGM, gsz = (nM - fm) < WGM ? (nM - fm) : WGM;
        u.pm = pm_off + fm + ((wgid % nig) % gsz); u.pn = (wgid % nig) / gsz; return true;
    }
};
template <class Epi, class Sched, bool ALIGN_EPI = false, bool SP2 = false>
__device__ __forceinline__ void gemm_phase(LAS unsigned char* lds, const Gemm g, const Sched& S, const Epi& E) {
    const int tid = fresh_tid(), wid = __builtin_amdgcn_readfirstlane(tid >> 6), lane = tid & 63, wr = wid >> 2, wc = wid & 3, fr = lane & 15, fq = lane >> 4;
    const int K = g.ld ? g.ld : g.K, nt = g.K / BK;
    unsigned voffA[2], voffB[2];
#pragma unroll
    for (int i = 0; i < 2; ++i) { int R, C; stage_rc(tid * 16 + i * 8192, R, C); const int Rb = Epi::PERM ? ((R & ~31) + perm32(R & 31)) : R;
        voffA[i] = (unsigned)(R * K + C) * 2u; voffB[i] = (unsigned)(Rb * K + C) * 2u; }
    const size_t kstep = (size_t)(BK * 2);
    const size_t hstep = (size_t)HALF * K * 2;
    const size_t tstep = 2 * hstep;
    const unsigned ldsw = (unsigned)wid * 1024u;
    const int aoff = lds_byte(wr * 64 + fr, fq * 8), boff = lds_byte(wc * 32 + fr, fq * 8);
#define PG8_SA(b, h) (((b) * 2 + (h)) * HTB)
#define PG8_SB(b, h) ((4 + (b) * 2 + (h)) * HTB)
#define PG8_STAGE(bufoff, gbase, voff) do { _Pragma("unroll") for (int _i = 0; _i < 2; ++_i) \
        __builtin_amdgcn_global_load_lds((const unsigned*)((const char*)(gbase) + (voff)[_i]), (LAS unsigned*)(lds + (bufoff) + ldsw + _i * 8192), 16, 0, 0); } while (0)
#define PG8_LDA(dst, b, h) do { _Pragma("unroll") for (int m = 0; m < 4; ++m) _Pragma("unroll") for (int k = 0; k < 2; ++k) dst[m][k] = *(const LAS bf16x8*)(lds + PG8_SA(b, h) + aoff + m * 2048 + k * 1024); } while (0)
#define PG8_LDB(dst, b, h) do { _Pragma("unroll") for (int n = 0; n < 2; ++n) _Pragma("unroll") for (int k = 0; k < 2; ++k) dst[n][k] = *(const LAS bf16x8*)(lds + PG8_SB(b, h) + boff + n * 2048 + k * 1024); } while (0)
#define PG8_MMA(ai, bj, At, Bt) do { __builtin_amdgcn_s_setprio(1); _Pragma("unroll") for (int m = 0; m < 4; ++m) _Pragma("unroll") for (int n = 0; n < 2; ++n) _Pragma("unroll") for (int k = 0; k < 2; ++k) \
        acc[ai][bj][m][n] = __builtin_amdgcn_mfma_f32_16x16x32_bf16(Bt[n][k], At[m][k], acc[ai][bj][m][n], 0, 0, 0); __builtin_amdgcn_s_setprio(0); } while (0)
#define PG8_WAIT_V(n) asm volatile("s_waitcnt vmcnt(" #n ")" ::: "memory")
#define PG8_WAIT_L(n) asm volatile("s_waitcnt lgkmcnt(" #n ")" ::: "memory")
#define PG8_BAR __builtin_amdgcn_s_barrier()
#define PG8_SCHED __builtin_amdgcn_sched_barrier(0)
    Unit cur, nxt; int ui = 0;
    if (!S.next(0, cur)) return;
    f32x4 acc[2][2][4][2];
#pragma unroll
    for (int a = 0; a < 2; ++a)
#pragma unroll
        for (int b = 0; b < 2; ++b)
#pragma unroll
            for (int m = 0; m < 4; ++m)
#pragma unroll
                for (int n = 0; n < 2; ++n) acc[a][b][m][n] = (f32x4){0.f, 0.f, 0.f, 0.f};
    bf16x8 At[4][2], B0[2][2], B1[2][2];
    const char* cA = (const char*)g.A + (size_t)cur.pm * tstep; const char* cB = (const char*)g.Bt + (size_t)cur.pn * tstep;
    if constexpr (SP2) {
        PG8_STAGE(PG8_SB(0, 0), cB, voffB); PG8_STAGE(PG8_SB(0, 1), cB + hstep, voffB); PG8_STAGE(PG8_SA(0, 0), cA, voffA); PG8_STAGE(PG8_SA(0, 1), cA + hstep, voffA);
        if (wr == 1) PG8_BAR;
        PG8_WAIT_V(2); PG8_BAR;
        PG8_STAGE(PG8_SB(1, 0), cB + kstep, voffB); PG8_STAGE(PG8_SA(1, 0), cA + kstep, voffA); PG8_STAGE(PG8_SB(1, 1), cB + hstep + kstep, voffB);
        PG8_WAIT_V(6); PG8_BAR;
    } else {
        PG8_STAGE(PG8_SB(0, 0), cB, voffB); PG8_STAGE(PG8_SA(0, 0), cA, voffA); PG8_STAGE(PG8_SB(0, 1), cB + hstep, voffB); PG8_STAGE(PG8_SA(0, 1), cA + hstep, voffA);
        if (wr == 1) PG8_BAR;
        PG8_WAIT_V(4); PG8_BAR;
        PG8_STAGE(PG8_SB(1, 0), cB + kstep, voffB); PG8_STAGE(PG8_SA(1, 0), cA + kstep, voffA); PG8_STAGE(PG8_SB(1, 1), cB + hstep + kstep, voffB);
        PG8_WAIT_V(6); PG8_BAR;
    }
    for (;;) {
        const bool has_next = S.next(ui + 1, nxt);
        const char* nA = has_next ? (const char*)g.A + (size_t)nxt.pm * tstep : cA; const char* nB = has_next ? (const char*)g.Bt + (size_t)nxt.pn * tstep : cB;
        for (int t = 0; t < nt; t += 2) {
            if constexpr (Epi::MIDK) { if (t == nt / 2) E.mid(acc, cur, wr, wc, fr, fq); }
            const bool last = (t == nt - 2);
            const char* a1 = cA + (size_t)(t + 1) * kstep;
            const char* a2 = last ? nA : cA + (size_t)(t + 2) * kstep; const char* b2 = last ? nB : cB + (size_t)(t + 2) * kstep;
            const char* a3 = a2 + kstep; const char* b3 = b2 + kstep;
            if constexpr (SP2) {
            PG8_LDB(B0, 0, 0); PG8_LDB(B1, 0, 1); PG8_SCHED; PG8_LDA(At, 0, 0); PG8_STAGE(PG8_SA(1, 1), a1 + hstep, voffA);
            PG8_WAIT_V(8); PG8_WAIT_L(0); PG8_BAR; PG8_MMA(0, 0, At, B0); PG8_MMA(0, 1, At, B1); PG8_BAR; PG8_SCHED;
            PG8_LDA(At, 0, 1); PG8_STAGE(PG8_SB(0, 0), b2, voffB); PG8_STAGE(PG8_SB(0, 1), b2 + hstep, voffB); PG8_STAGE(PG8_SA(0, 0), a2, voffA);
            PG8_WAIT_V(8); PG8_WAIT_L(0); PG8_BAR; PG8_MMA(1, 0, At, B0); PG8_MMA(1, 1, At, B1); PG8_BAR; PG8_SCHED;
            PG8_LDB(B0, 1, 0); PG8_LDB(B1, 1, 1); PG8_SCHED; PG8_LDA(At, 1, 0); PG8_STAGE(PG8_SA(0, 1), a2 + hstep, voffA);
            PG8_WAIT_V(8); PG8_WAIT_L(0); PG8_BAR; PG8_MMA(0, 0, At, B0); PG8_MMA(0, 1, At, B1); PG8_BAR; PG8_SCHED;
            PG8_LDA(At, 1, 1); PG8_STAGE(PG8_SB(1, 0), b3, voffB); PG8_STAGE(PG8_SB(1, 1), b3 + hstep, voffB); PG8_STAGE(PG8_SA(1, 0), a3, voffA);
            PG8_WAIT_V(8); PG8_WAIT_L(0); PG8_BAR; PG8_MMA(1, 0, At, B0); PG8_MMA(1, 1, At, B1); PG8_BAR; PG8_SCHED;
            } else {
            PG8_LDB(B0, 0, 0); PG8_SCHED; PG8_LDA(At, 0, 0); PG8_STAGE(PG8_SA(1, 1), a1 + hstep, voffA);
            PG8_WAIT_L(8); PG8_BAR; PG8_WAIT_L(0); PG8_MMA(0, 0, At, B0); PG8_BAR; PG8_SCHED;
            PG8_LDB(B1, 0, 1); PG8_STAGE(PG8_SB(0, 0), b2, voffB);
            PG8_BAR; PG8_WAIT_L(0); PG8_MMA(0, 1, At, B1); PG8_BAR;
            PG8_LDA(At, 0, 1); PG8_STAGE(PG8_SA(0, 0), a2, voffA);
            PG8_BAR; PG8_WAIT_L(0); PG8_MMA(1, 0, At, B0); PG8_BAR; PG8_SCHED;
            PG8_STAGE(PG8_SB(0, 1), b2 + hstep, voffB);
            PG8_WAIT_V(6); PG8_BAR; PG8_MMA(1, 1, At, B1); PG8_BAR;
            PG8_LDB(B0, 1, 0); PG8_SCHED; PG8_LDA(At, 1, 0); PG8_STAGE(PG8_SA(0, 1), a2 + hstep, voffA);
            PG8_WAIT_L(8); PG8_BAR; PG8_WAIT_L(0); PG8_MMA(0, 0, At, B0); PG8_BAR; PG8_SCHED;
            PG8_LDB(B1, 1, 1); PG8_STAGE(PG8_SB(1, 0), b3, voffB);
            PG8_BAR; PG8_WAIT_L(0); PG8_MMA(0, 1, At, B1); PG8_BAR;
            PG8_LDA(At, 1, 1); PG8_STAGE(PG8_SA(1, 0), a3, voffA);
            PG8_BAR; PG8_WAIT_L(0); PG8_MMA(1, 0, At, B0); PG8_BAR; PG8_SCHED;
            PG8_STAGE(PG8_SB(1, 1), b3 + hstep, voffB);
            PG8_WAIT_V(6); PG8_BAR; PG8_MMA(1, 1, At, B1); PG8_BAR;
            }
        }
        if constexpr (ALIGN_EPI) { if (wr == 0) PG8_BAR; }
        E(acc, cur, wr, wc, fr, fq);
        if (!has_next) break;
#pragma unroll
        for (int a = 0; a < 2; ++a)
#pragma unroll
            for (int b = 0; b < 2; ++b)
#pragma unroll
                for (int m = 0; m < 4; ++m)
#pragma unroll
                    for (int n = 0; n < 2; ++n) acc[a][b][m][n] = (f32x4){0.f, 0.f, 0.f, 0.f};
        cur = nxt; cA = nA; cB = nB; ++ui;
        if constexpr (ALIGN_EPI) { if (wr == 1) PG8_BAR; }
    }
    PG8_WAIT_V(0);
    if constexpr (!ALIGN_EPI) { if (wr == 0) PG8_BAR; }
    PG8_BAR;
#undef PG8_SA
#undef PG8_SB
#undef PG8_STAGE
#undef PG8_LDA
#undef PG8_LDB
#undef PG8_MMA
#undef PG8_WAIT_V
#undef PG8_WAIT_L
#undef PG8_BAR
#undef PG8_SCHED
}
}
using pg8::Unit;
typedef f32x4 Acc[2][2][4][2];

DI u32x4 pack_row8(const f32x4& v0, const f32x4& v1) { u32x4 w; w.x = pk2(v0[0], v0[1]); w.y = pk2(v0[2], v0[3]); w.z = pk2(v1[0], v1[1]); w.w = pk2(v1[2], v1[3]); return w; }

struct EpiMod {
    static constexpr bool PERM = false, MIDK = false;
    float* mod; const float* bias;
    DI void operator()(Acc& acc, const Unit& u, int wr, int wc, int fr, int fq) const {
        { const int t_ = fresh_tid(); fr = t_ & 15; fq = (t_ >> 4) & 3; }
        if (u.pm != 0 || wr != 0) return;
#pragma unroll
        for (int m = 0; m < 3; ++m) { const int r = 16 * m + fr; if (r < NBATCH) {
#pragma unroll
            for (int bj = 0; bj < 2; ++bj)
#pragma unroll
                for (int n = 0; n < 2; ++n) { const int col = u.pn * 256 + bj * 128 + wc * 32 + n * 16 + 4 * fq;
                    *(f32x4*)(mod + (size_t)r * 6144 + col) = acc[0][bj][m][n] + *(const f32x4*)(bias + col); } } }
    }
};

struct EpiIn {
    static constexpr bool PERM = true, MIDK = false;
    bf16_t *QOB, *KA, *VA, *GA, *KB, *VB, *SGA, *SGB; float *CUM, *DEC; const float* lbl; float* out;
    DI void operator()(Acc& acc, const Unit& u, int wr, int wc, int fr, int fq) const {
        { const int t_ = fresh_tid(); fr = t_ & 15; fq = (t_ >> 4) & 3; }
        const int pn = u.pn, rt = wr * 64 + fr, row0 = u.pm * 256 + rt, cw = wc * 32 + 8 * fq, lane = fq * 16 + fr;
        if (pn >= 14) {
            const size_t o0 = ((size_t)(u.pm * 8 + (pn - 14)) * 8 * 512 + (size_t)(wr * 4 + wc) * 64 + lane) * 8;
#pragma unroll
            for (int ai = 0; ai < 2; ++ai)
#pragma unroll
                for (int m = 0; m < 4; ++m) { f32x4 r0, r1, b0, b1;
#pragma unroll
                    for (int j = 0; j < 4; ++j) { b0[j] = fmaxf(sigm(acc[ai][1][m][0][j]), 1e-30f); b1[j] = fmaxf(sigm(acc[ai][1][m][1][j]), 1e-30f);
                        r0[j] = sigm(acc[ai][0][m][0][j]) * __builtin_amdgcn_rcpf(b0[j]); r1[j] = sigm(acc[ai][0][m][1][j]) * __builtin_amdgcn_rcpf(b1[j]); }
                    const size_t o = o0 + (size_t)(ai * 4 + m) * 512 * 8;
                    *(u32x4*)(SGA + o) = pack_row8(r0, r1); *(u32x4*)(SGB + o) = pack_row8(b0, b1); __builtin_amdgcn_sched_barrier(0); }
            return;
        }
        const int seg = pn >> 1, col0 = (pn & 1) * 256 + cw;
        if (seg == 1) {
#pragma unroll
            for (int bj = 0; bj < 2; ++bj) {
                float lb[2][4];
#pragma unroll
                for (int n = 0; n < 2; ++n)
#pragma unroll
                    for (int j = 0; j < 4; ++j) { const int c = col0 + bj * 128 + 4 * n + j; lb[n][j] = __builtin_amdgcn_rcpf(1.f + __expf(lbl[512 + c] - lbl[c])); }
#pragma unroll
                for (int ai = 0; ai < 2; ++ai) {
                    const size_t rbase = ((size_t)((pn & 1) * 2 + bj) * T + (u.pm * 256 + ai * 128 + wr * 64 + launder(fr))) * 128 + cw;
#pragma unroll
                    for (int m = 0; m < 4; ++m) { f32x4 k0, k1;
#pragma unroll
                        for (int j = 0; j < 4; ++j) {
                            float f = lb[0][j] + (1.f - lb[0][j]) * sigm(acc[ai][bj][m][0][j]); k0[j] = 1.f - f; acc[ai][bj][m][0][j] = __logf(f);
                            f = lb[1][j] + (1.f - lb[1][j]) * sigm(acc[ai][bj][m][1][j]); k1[j] = 1.f - f; acc[ai][bj][m][1][j] = __logf(f); }
                        *(u32x4*)(KA + rbase + (size_t)m * 16 * 128) = pack_row8(k0, k1); }
                    __builtin_amdgcn_sched_barrier(0);
#pragma unroll
                    for (int n = 0; n < 2; ++n)
#pragma unroll
                        for (int j = 0; j < 4; ++j) { float carry = 0.f;
#pragma unroll
                            for (int m = 0; m < 4; ++m) { float v = acc[ai][bj][m][n][j];
                                v += __int_as_float(__builtin_amdgcn_update_dpp(0, __float_as_int(v), 0x111, 0xf, 0xf, false));
                                v += __int_as_float(__builtin_amdgcn_update_dpp(0, __float_as_int(v), 0x112, 0xf, 0xf, false));
                                v += __int_as_float(__builtin_amdgcn_update_dpp(0, __float_as_int(v), 0x114, 0xf, 0xf, false));
                                v += __int_as_float(__builtin_amdgcn_update_dpp(0, __float_as_int(v), 0x118, 0xf, 0xf, false));
                                v += carry; carry = __shfl(v, lane | 15); acc[ai][bj][m][n][j] = v; } }
                    __builtin_amdgcn_sched_barrier(0);
#pragma unroll
                    for (int m = 0; m < 4; ++m) { float* cp = CUM + rbase + (size_t)m * 16 * 128; *(f32x4*)cp = acc[ai][bj][m][0]; *(f32x4*)(cp + 4) = acc[ai][bj][m][1]; }
                    if (fr == 15) {
#pragma unroll
                        for (int n = 0; n < 2; ++n) { f32x4 e;
#pragma unroll
                            for (int j = 0; j < 4; ++j) e[j] = __expf(acc[ai][bj][3][n][j]);
                            *(f32x4*)(DEC + (size_t)(u.pm * 4 + ai * 2 + wr) * 512 + col0 + bj * 128 + 4 * n) = e; } }
                    __builtin_amdgcn_sched_barrier(0);
                }
            }
            return;
        }
        bf16_t* dst; int pitch = 512; size_t bjoff = 128; float* o32 = nullptr;
        switch (seg) {
            case 0: dst = QOB + col0; pitch = 1024; break;
            case 2: dst = VA + (size_t)((pn & 1) * 2) * T * 128 + cw; pitch = 128; bjoff = (size_t)T * 128; break;
            case 3: dst = GA + (size_t)((pn & 1) * 2) * T * 128 + cw; pitch = 128; bjoff = (size_t)T * 128; break;
            case 4: dst = QOB + 512 + col0; pitch = 1024; break;
            default: dst = (seg == 5 ? KB : VB) + (size_t)((pn & 1) * 4 + (wc >> 1)) * T * 64 + (wc & 1) * 32 + 8 * fq; pitch = 64; bjoff = (size_t)2 * T * 64; break;
        }
        if (seg >= 5) {
            if (u.pm >= 128) o32 = out + (seg == 5 ? OFF_KS : OFF_VS) + (size_t)((u.pm - 128) * 256 + rt) * 512 + col0;
            else if ((u.pm & 63) >= 62) o32 = out + (seg == 5 ? OFF_KP : OFF_VP) + (size_t)((u.pm >> 6) * 512 + ((u.pm & 63) - 62) * 256 + rt) * 512 + col0;
        }
        const bool act = (seg == 0 || seg == 3);
#pragma unroll
        for (int ai = 0; ai < 2; ++ai)
#pragma unroll
            for (int m = 0; m < 4; ++m)
#pragma unroll
                for (int bj = 0; bj < 2; ++bj) { f32x4 v0 = acc[ai][bj][m][0], v1 = acc[ai][bj][m][1];
                    if (act) {
#pragma unroll
                        for (int j = 0; j < 4; ++j) { v0[j] = silu(v0[j]); v1[j] = silu(v1[j]); } }
                    *(u32x4*)(dst + (size_t)(row0 + ai * 128 + m * 16) * pitch + bj * bjoff) = pack_row8(v0, v1);
                    if (o32) { float* op = o32 + (size_t)(ai * 128 + m * 16) * 512 + bj * 128; *(f32x4*)op = v0; *(f32x4*)(op + 4) = v1; } __builtin_amdgcn_sched_barrier(0); }
    }
};

struct EpiMerge {
    static constexpr bool PERM = true, MIDK = true;
    const bf16_t *SGR, *SGB; bf16_t* Mo;
    DI void mid(Acc& acc, const Unit& u, int wr, int wc, int fr, int fq) const {
        { const int t_ = fresh_tid(); fr = t_ & 15; fq = (t_ >> 4) & 3; }
        const size_t gb = ((size_t)(u.pm * 8 + 2 * u.pn) * 8 * 512 + (size_t)(wr * 4 + wc) * 64 + (fq * 16 + fr)) * 8;
#pragma unroll
        for (int ai = 0; ai < 2; ++ai) { u32x4 a[4][2];
#pragma unroll
            for (int m = 0; m < 4; ++m)
#pragma unroll
                for (int bj = 0; bj < 2; ++bj) a[m][bj] = *(const u32x4*)(SGR + gb + ((size_t)bj * 8 + ai * 4 + m) * 512 * 8);
#pragma unroll
            for (int m = 0; m < 4; ++m)
#pragma unroll
                for (int bj = 0; bj < 2; ++bj)
#pragma unroll
                    for (int j = 0; j < 4; ++j) { acc[ai][bj][m][j >> 1][(j & 1) * 2] *= bflo(a[m][bj][j]); acc[ai][bj][m][j >> 1][(j & 1) * 2 + 1] *= bfhi(a[m][bj][j]); }
            __builtin_amdgcn_sched_barrier(0); }
    }
    DI void operator()(Acc& acc, const Unit& u, int wr, int wc, int fr, int fq) const {
        { const int t_ = fresh_tid(); fr = t_ & 15; fq = (t_ >> 4) & 3; }
        const size_t base = (size_t)(u.pm * 256 + wr * 64 + fr) * 1024 + u.pn * 256 + wc * 32 + 8 * fq;
        const size_t gb = ((size_t)(u.pm * 8 + 2 * u.pn) * 8 * 512 + (size_t)(wr * 4 + wc) * 64 + (fq * 16 + fr)) * 8;
#pragma unroll
        for (int ai = 0; ai < 2; ++ai) { u32x4 b[4][2];
#pragma unroll
            for (int m = 0; m < 4; ++m)
#pragma unroll
                for (int bj = 0; bj < 2; ++bj) b[m][bj] = *(const u32x4*)(SGB + gb + ((size_t)bj * 8 + ai * 4 + m) * 512 * 8);
#pragma unroll
            for (int m = 0; m < 4; ++m)
#pragma unroll
                for (int bj = 0; bj < 2; ++bj) { f32x4 v0 = acc[ai][bj][m][0], v1 = acc[ai][bj][m][1]; const u32x4 g = b[m][bj];
                    v0[0] *= bflo(g[0]); v0[1] *= bfhi(g[0]); v0[2] *= bflo(g[1]); v0[3] *= bfhi(g[1]);
                    v1[0] *= bflo(g[2]); v1[1] *= bfhi(g[2]); v1[2] *= bflo(g[3]); v1[3] *= bfhi(g[3]);
                    *(u32x4*)(Mo + base + (size_t)(ai * 128 + m * 16) * 1024 + bj * 128) = pack_row8(v0, v1); }
            __builtin_amdgcn_sched_barrier(0); }
    }
};

template <bool BASE_BF16> struct EpiRes {
    static constexpr bool PERM = true, MIDK = false;
    const float *xp, *xs; const bf16_t* xb; bf16_t* xo; const float* gmod;
    DI void operator()(Acc& acc, const Unit& u, int wr, int wc, int fr, int fq) const {
        { const int t_ = fresh_tid(); fr = t_ & 15; fq = (t_ >> 4) & 3; }
        const int colb = u.pn * 256 + wc * 32 + 8 * fq;
#pragma unroll
        for (int ai = 0; ai < 2; ++ai) { const int r0 = u.pm * 256 + ai * 128 + wr * 64 + fr;
            const float* g = gmod + (size_t)batch_of(r0) * 6144 + colb;
            f32x4 gv[2][2];
#pragma unroll
            for (int bj = 0; bj < 2; ++bj) { gv[bj][0] = *(const f32x4*)(g + bj * 128); gv[bj][1] = *(const f32x4*)(g + bj * 128 + 4); }
            bf16_t* orow = xo + (size_t)r0 * D + colb;
            if constexpr (BASE_BF16) {
                const bf16_t* xr = xb + (size_t)r0 * D + colb; u32x4 xv[4][2];
#pragma unroll
                for (int m = 0; m < 4; ++m)
#pragma unroll
                    for (int bj = 0; bj < 2; ++bj) xv[m][bj] = *(const u32x4*)(xr + (size_t)m * 16 * D + bj * 128);
#pragma unroll
                for (int m = 0; m < 4; ++m)
#pragma unroll
                    for (int bj = 0; bj < 2; ++bj) { const u32x4 x = xv[m][bj]; const f32x4 a0 = acc[ai][bj][m][0] * gv[bj][0], a1 = acc[ai][bj][m][1] * gv[bj][1];
                        f32x4 v0 = {bflo(x[0]) + a0[0], bfhi(x[0]) + a0[1], bflo(x[1]) + a0[2], bfhi(x[1]) + a0[3]}, v1 = {bflo(x[2]) + a1[0], bfhi(x[2]) + a1[1], bflo(x[3]) + a1[2], bfhi(x[3]) + a1[3]};
                        *(u32x4*)(orow + (size_t)m * 16 * D + bj * 128) = pack_row8(v0, v1); }
            } else {
                const float* xr = (r0 < TP ? xp + (size_t)r0 * D : xs + (size_t)(r0 - TP) * D) + colb; f32x4 xv[4][2][2];
#pragma unroll
                for (int m = 0; m < 4; ++m)
#pragma unroll
                    for (int bj = 0; bj < 2; ++bj) { xv[m][bj][0] = *(const f32x4*)(xr + (size_t)m * 16 * D + bj * 128); xv[m][bj][1] = *(const f32x4*)(xr + (size_t)m * 16 * D + bj * 128 + 4); }
#pragma unroll
                for (int m = 0; m < 4; ++m)
#pragma unroll
                    for (int bj = 0; bj < 2; ++bj) *(u32x4*)(orow + (size_t)m * 16 * D + bj * 128) = pack_row8(xv[m][bj][0] + gv[bj][0] * acc[ai][bj][m][0], xv[m][bj][1] + gv[bj][1] * acc[ai][bj][m][1]);
            }
            __builtin_amdgcn_sched_barrier(0); }
    }
};

struct EpiPart {
    static constexpr bool PERM = false, MIDK = false;
    float* part; int row0;
    DI void operator()(Acc& acc, const Unit& u, int wr, int wc, int fr, int fq) const {
        { const int t_ = fresh_tid(); fr = t_ & 15; fq = (t_ >> 4) & 3; }
#pragma unroll
        for (int ai = 0; ai < 2; ++ai)
#pragma unroll
            for (int m = 0; m < 4; ++m) { float* prow = part + (size_t)(u.pm * 256 + ai * 128 + wr * 64 + m * 16 + fr - row0) * D + u.pn * 256 + wc * 32 + 4 * fq;
#pragma unroll
                for (int bj = 0; bj < 2; ++bj)
#pragma unroll
                    for (int n = 0; n < 2; ++n) *(f32x4*)(prow + bj * 128 + n * 16) = acc[ai][bj][m][n];
                __builtin_amdgcn_sched_barrier(0); }
    }
};

struct EpiFfnIn {
    static constexpr bool PERM = true, MIDK = false;
    bf16_t* HID;
    DI void operator()(Acc& acc, const Unit& u, int wr, int wc, int fr, int fq) const {
        { const int t_ = fresh_tid(); fr = t_ & 15; fq = (t_ >> 4) & 3; }
        bf16_t* base = HID + (size_t)(u.pm * 256 + wr * 64 + fr) * FF + u.pn * 128 + wc * 32 + 8 * fq;
#pragma unroll
        for (int ai = 0; ai < 2; ++ai)
#pragma unroll
            for (int m = 0; m < 4; ++m) { f32x4 v0, v1;
#pragma unroll
                for (int j = 0; j < 4; ++j) { v0[j] = silu(acc[ai][0][m][0][j]) * acc[ai][1][m][0][j]; v1[j] = silu(acc[ai][0][m][1][j]) * acc[ai][1][m][1][j]; }
                *(u32x4*)(base + (size_t)(ai * 128 + m * 16) * FF) = pack_row8(v0, v1); __builtin_amdgcn_sched_barrier(0); }
    }
};

DI void transpose_item(const float* W, int N, bf16_t* WT, int pitch, int koff, int k0, int n0, int drow0, LAS float* scr, int lane) {
#pragma unroll
    for (int i = 0; i < 32; ++i) { const int kk = 2 * i + (lane >> 5); scr[kk * 33 + (lane & 31)] = W[(size_t)(k0 + kk) * N + n0 + (lane & 31)]; }
    asm volatile("s_waitcnt lgkmcnt(0)" ::: "memory");
    const int c = lane & 7;
#pragma unroll
    for (int j = 0; j < 4; ++j) { const int n = (lane >> 3) + 8 * j; const LAS float* s = scr + (8 * c) * 33 + n;
        u32x4 o; o.x = pk2(s[0 * 33], s[1 * 33]); o.y = pk2(s[2 * 33], s[3 * 33]); o.z = pk2(s[4 * 33], s[5 * 33]); o.w = pk2(s[6 * 33], s[7 * 33]);
        *(u32x4*)(WT + (size_t)(drow0 + n) * pitch + koff + k0 + 8 * c) = o; }
    asm volatile("s_waitcnt lgkmcnt(0)" ::: "memory");
}
DI void phase_prep(const Params& p, LAS unsigned char* lds) {
    const int tid = fresh_tid(), lane = tid & 63, wave = __builtin_amdgcn_readfirstlane(tid >> 6);
    LAS float* scr = (LAS float*)(lds + wave * 16384);
    const int gw = blockIdx.x * 8 + wave, NGW = gridDim.x * 8;
    unsigned char* ws = p.ws;
    constexpr int I_ADA = 16 * 192, I_IN = 16 * 176, I_A = 8 * 32, I_O = 16 * 32, I_FI = 16 * 176, I_FO = 44 * 32;
    constexpr int NIT = I_ADA + I_IN + 2 * I_A + I_O + I_FI + I_FO;
    for (int it = gw; it < NIT; it += NGW) {
        int r = it;
        if (r < I_ADA) { const int kb = r / 192, nb = r % 192; transpose_item(p.w_ada, 6144, (bf16_t*)(ws + WS_WADA), 1024, 0, 64 * kb, 32 * nb, 32 * nb, scr, lane); continue; } r -= I_ADA;
        if (r < I_IN) { const int kb = r / 176, nb = r % 176, n0 = 32 * nb; int dr = n0;
            if (n0 >= 3584) { const int j = n0 < 4608 ? n0 - 3584 : n0 - 4608; dr = 3584 + 256 * (j >> 7) + (j & 127) + (n0 < 4608 ? 0 : 128); }
            transpose_item(p.w_in, INC, (bf16_t*)(ws + WS_WIN), 1024, 0, 64 * kb, n0, dr, scr, lane); continue; } r -= I_IN;
        if (r < I_A) { const int kb = r / 32, nb = r % 32; transpose_item(p.w_a, 1024, (bf16_t*)(ws + WS_WAB), 1024, 0, 64 * kb, 32 * nb, 32 * nb, scr, lane); continue; } r -= I_A;
        if (r < I_A) { const int kb = r / 32, nb = r % 32; transpose_item(p.w_b, 1024, (bf16_t*)(ws + WS_WAB), 1024, 512, 64 * kb, 32 * nb, 32 * nb, scr, lane); continue; } r -= I_A;
        if (r < I_O) { const int kb = r / 32, nb = r % 32; transpose_item(p.w_out, 1024, (bf16_t*)(ws + WS_WO), 1024, 0, 64 * kb, 32 * nb, 32 * nb, scr, lane); continue; } r -= I_O;
        if (r < I_FI) { const int kb = r / 176, nb = r % 176; const int n0 = 32 * nb; const int j0 = n0 < FF ? n0 : n0 - FF;
            transpose_item(p.w_ffn_in, INC, (bf16_t*)(ws + WS_WFI), 1024, 0, 64 * kb, n0, 256 * (j0 >> 7) + (j0 & 127) + (n0 < FF ? 0 : 128), scr, lane); continue; } r -= I_FI;
        { const int kb = r / 32, nb = r % 32; transpose_item(p.w_ffn_out, 1024, (bf16_t*)(ws + WS_WFO), FF, 0, 64 * kb, 32 * nb, 32 * nb, scr, lane); }
    }
    bf16_t* SC = (bf16_t*)(ws + WS_SC);
    for (int i = blockIdx.x * 512 + tid; i < 256 * 1024 / 2; i += gridDim.x * 512) { const int row = (2 * i) >> 10, col = (2 * i) & 1023; float a = 0.f, b = 0.f;
        if (row < NBATCH) { const float* c = row < 2 ? p.c_prompt + row * D : p.c_sample + (row - 2) * D; a = silu(c[col]); b = silu(c[col + 1]); }
        ((unsigned*)SC)[i] = pk2(a, b); }
}

DI float wave_sum(float v) {
#pragma unroll
    for (int o = 1; o < 64; o <<= 1) v += __shfl_xor(v, o);
    return v;
}
DI void phase_norm_mod(const float* xp, const float* xs, const float* nw, const float* mod, int sh_off, int sc_off, bf16_t* H) {
    const int tid = fresh_tid(), lane = tid & 63, wave = __builtin_amdgcn_readfirstlane(tid >> 6);
    const int gw = blockIdx.x * 8 + wave, NGW = gridDim.x * 8;
    for (int r = gw; r < T; r += NGW) {
        const float* xr = r < TP ? xp + (size_t)r * D : xs + (size_t)(r - TP) * D; const float* mb = mod + (size_t)batch_of(r) * 6144;
        f32x4 v[4]; float s = 0.f;
#pragma unroll
        for (int j = 0; j < 4; ++j) { v[j] = *(const f32x4*)(xr + 4 * lane + 256 * j); s += (v[j][0] * v[j][0] + v[j][1] * v[j][1]) + (v[j][2] * v[j][2] + v[j][3] * v[j][3]); }
        const float rstd = __builtin_amdgcn_rsqf(wave_sum(s) * (1.f / D) + EPS);
#pragma unroll
        for (int j = 0; j < 4; ++j) { const int col = 4 * lane + 256 * j; const f32x4 w = *(const f32x4*)(nw + col), sc = *(const f32x4*)(mb + sc_off + col), sh = *(const f32x4*)(mb + sh_off + col);
            const f32x4 h = v[j] * rstd * w * (sc + 1.f) + sh; u32x2 o; o.x = pk2(h[0], h[1]); o.y = pk2(h[2], h[3]);
            *(u32x2*)(H + (size_t)r * D + col) = o; }
    }
}
DI void phase_norm_mod_b(const bf16_t* xb, const float* nw, const float* mod, int sh_off, int sc_off, bf16_t* H, int r_lo = 0, int r_hi = T, int b_lo = 0) {
    const int tid = fresh_tid(), lane = tid & 63, wave = __builtin_amdgcn_readfirstlane(tid >> 6);
    const int gw = ((int)blockIdx.x - b_lo) * 8 + wave, NGW = ((int)gridDim.x - b_lo) * 8;
    for (int r = r_lo + gw; r < r_hi; r += NGW) {
        const bf16_t* xr = xb + (size_t)r * D; const float* mb = mod + (size_t)batch_of(r) * 6144;
        float v[2][8]; float s = 0.f;
#pragma unroll
        for (int j = 0; j < 2; ++j) { const u32x4 x = *(const u32x4*)(xr + 8 * lane + 512 * j);
#pragma unroll
            for (int i = 0; i < 4; ++i) { v[j][2 * i] = bflo(x[i]); v[j][2 * i + 1] = bfhi(x[i]); s += v[j][2 * i] * v[j][2 * i] + v[j][2 * i + 1] * v[j][2 * i + 1]; } }
        const float rstd = __builtin_amdgcn_rsqf(wave_sum(s) * (1.f / D) + EPS);
#pragma unroll
        for (int j = 0; j < 2; ++j) { const int col = 8 * lane + 512 * j; f32x4 h[2];
#pragma unroll
            for (int q = 0; q < 2; ++q) { const f32x4 w = *(const f32x4*)(nw + col + 4 * q), sc = *(const f32x4*)(mb + sc_off + col + 4 * q), sh = *(const f32x4*)(mb + sh_off + col + 4 * q);
                const f32x4 x = {v[j][4 * q], v[j][4 * q + 1], v[j][4 * q + 2], v[j][4 * q + 3]}; h[q] = x * rstd * w * (sc + 1.f) + sh; }
            *(u32x4*)(H + (size_t)r * D + col) = pack_row8(h[0], h[1]); }
    }
}
DI void phase_final_norm(const bf16_t* xb, float* y, const float* nw, int r_lo = 0, int r_hi = T, int b_lo = 0) {
    const int tid = fresh_tid(), lane = tid & 63, wave = __builtin_amdgcn_readfirstlane(tid >> 6);
    const int gw = ((int)blockIdx.x - b_lo) * 8 + wave, NGW = ((int)gridDim.x - b_lo) * 8;
    for (int r = r_lo + gw; r < r_hi; r += NGW) { const bf16_t* xr = xb + (size_t)r * D; float* yr = y + (size_t)r * D;
        float v[2][8]; float s = 0.f;
#pragma unroll
        for (int j = 0; j < 2; ++j) { const u32x4 x = *(const u32x4*)(xr + 8 * lane + 512 * j);
#pragma unroll
            for (int i = 0; i < 4; ++i) { v[j][2 * i] = bflo(x[i]); v[j][2 * i + 1] = bfhi(x[i]); s += v[j][2 * i] * v[j][2 * i] + v[j][2 * i + 1] * v[j][2 * i + 1]; } }
        const float rstd = __builtin_amdgcn_rsqf(wave_sum(s) * (1.f / D) + EPS);
#pragma unroll
        for (int j = 0; j < 2; ++j) { const int col = 8 * lane + 512 * j;
#pragma unroll
            for (int q = 0; q < 2; ++q) { const f32x4 x = {v[j][4 * q], v[j][4 * q + 1], v[j][4 * q + 2], v[j][4 * q + 3]}; *(f32x4*)(yr + col + 4 * q) = x * rstd * *(const f32x4*)(nw + col + 4 * q); } }
    }
}

DI void phase_final_norm_parts(const bf16_t* x1b, const float* part0, const float* part1, const float* g2mod, float* y, const float* nw) {
    const int tid = fresh_tid(), lane = tid & 63, wave = __builtin_amdgcn_readfirstlane(tid >> 6);
    const int gw = blockIdx.x * 8 + wave, NGW = gridDim.x * 8;
    for (int r = TP + gw; r < T; r += NGW) { const float* gb = g2mod + (size_t)batch_of(r) * 6144; const size_t po = (size_t)(r - TP) * D;
        f32x4 v[4]; float s = 0.f;
#pragma unroll
        for (int j = 0; j < 4; ++j) { const int col = 4 * lane + 256 * j; const u32x2 xb = *(const u32x2*)(x1b + (size_t)r * D + col);
            const f32x4 x = {bflo(xb.x), bfhi(xb.x), bflo(xb.y), bfhi(xb.y)};
            v[j] = x + *(const f32x4*)(gb + col) * (*(const f32x4*)(part0 + po + col) + *(const f32x4*)(part1 + po + col));
            s += (v[j][0] * v[j][0] + v[j][1] * v[j][1]) + (v[j][2] * v[j][2] + v[j][3] * v[j][3]); }
        const float rstd = __builtin_amdgcn_rsqf(wave_sum(s) * (1.f / D) + EPS);
#pragma unroll
        for (int j = 0; j < 4; ++j) { const int col = 4 * lane + 256 * j; *(f32x4*)(y + (size_t)r * D + col) = v[j] * rstd * *(const f32x4*)(nw + col); }
    }
}

DI void hgrn_u_item(const Params& p, int item, int lane) {
    const int c = item >> 5, rem = item & 31, h = rem >> 3, kt = (rem >> 1) & 3, vh = rem & 1, l31 = lane & 31, hf = lane >> 5;
    const float* CUM = (const float*)(p.ws + WS_CUM); const bf16_t* KA = (const bf16_t*)(p.ws + WS_KA); const bf16_t* VA = (const bf16_t*)(p.ws + WS_VA); bf16_t* U = (bf16_t*)(p.ws + WS_U);
    const size_t hb = (size_t)h * T * 128; const int kcol = 32 * kt + l31;
    const float tot = CUM[hb + (size_t)(c * 64 + 63) * 128 + kcol];
    bf16x8 kdf[2][2];
#pragma unroll
    for (int st = 0; st < 2; ++st) { f32x16 kd;
#pragma unroll
        for (int r = 0; r < 16; ++r) { const size_t idx = hb + (size_t)(c * 64 + 32 * st + crow(r, hf)) * 128 + kcol; kd[r] = bf2f((short)KA[idx]) * __expf(tot - CUM[idx]); }
        kdf[st][0] = pack8(kd, 0); kdf[st][1] = pack8(kd, 1); }
    const bf16x8 id0 = ident_frag(0, l31, hf), id1 = ident_frag(1, l31, hf);
#pragma unroll
    for (int vtl = 0; vtl < 2; ++vtl) { const int vt = 2 * vh + vtl; f32x16 dacc = zero16();
#pragma unroll
        for (int st = 0; st < 2; ++st) { const bf16_t* vp = VA + hb + (size_t)(c * 64 + 32 * st + l31) * 128 + 32 * vt + 8 * hf;
            f32x16 vx = zero16(); vx = MFMA32(*(const bf16x8*)vp, id0, vx); vx = MFMA32(*(const bf16x8*)(vp + 16), id1, vx);
            dacc = MFMA32(kdf[st][0], pack8(vx, 0), dacc); dacc = MFMA32(kdf[st][1], pack8(vx, 1), dacc); }
        bf16_t* up = U + ((size_t)(c * 4 + h) * 128 + 32 * vt + l31) * 128 + 32 * kt + 4 * hf;
#pragma unroll
        for (int g = 0; g < 4; ++g) { u32x2 o; o.x = pk2(dacc[4 * g], dacc[4 * g + 1]); o.y = pk2(dacc[4 * g + 2], dacc[4 * g + 3]); *(u32x2*)(up + 8 * g) = o; }
    }
}

DI void scan_prompt_item(const Params& p, int item, int lane) {
    const int bh = item >> 5, vq = item & 31, b = bh >> 2, h = bh & 3, kg = lane & 31, vv = lane >> 5;
    const float* __restrict__ DEC = (const float*)(p.ws + WS_DEC); const bf16_t* __restrict__ U = (const bf16_t*)(p.ws + WS_U); bf16_t* __restrict__ SST = (bf16_t*)(p.ws + WS_SST);
    f32x4 S0 = {0.f, 0.f, 0.f, 0.f}, S1 = {0.f, 0.f, 0.f, 0.f};
    const int v0 = 4 * vq + vv, v1 = v0 + 2;
#pragma unroll 16
    for (int n = 0; n < 256; ++n) { const int c = b * 256 + n;
        const f32x4 d = *(const f32x4*)(DEC + (size_t)c * 512 + h * 128 + 4 * kg);
        const size_t o0 = ((size_t)(c * 4 + h) * 128 + v0) * 128 + 4 * kg, o1 = ((size_t)(c * 4 + h) * 128 + v1) * 128 + 4 * kg;
        const u32x2 u0 = *(const u32x2*)(U + o0), u1 = *(const u32x2*)(U + o1);
        u32x2 s; s.x = pk2(S0[0], S0[1]); s.y = pk2(S0[2], S0[3]); *(u32x2*)(SST + o0) = s;
        s.x = pk2(S1[0], S1[1]); s.y = pk2(S1[2], S1[3]); *(u32x2*)(SST + o1) = s;
        S0[0] = d[0] * S0[0] + bflo(u0.x); S0[1] = d[1] * S0[1] + bfhi(u0.x); S0[2] = d[2] * S0[2] + bflo(u0.y); S0[3] = d[3] * S0[3] + bfhi(u0.y);
        S1[0] = d[0] * S1[0] + bflo(u1.x); S1[1] = d[1] * S1[1] + bfhi(u1.x); S1[2] = d[2] * S1[2] + bflo(u1.y); S1[3] = d[3] * S1[3] + bfhi(u1.y);
    }
    float* sp = p.out + OFF_SP + ((size_t)bh * 128 + 4 * kg) * 128;
#pragma unroll
    for (int i = 0; i < 4; ++i) { sp[(size_t)i * 128 + v0] = S0[i]; sp[(size_t)i * 128 + v1] = S1[i]; }
}
DI void scan_sample_item(const Params& p, int item, int lane) {
    const int bh = item >> 5, vq = item & 31, bs = bh >> 2, h = bh & 3, kg = lane & 31, vv = lane >> 5, c = 512 + bs;
    const float* DEC = (const float*)(p.ws + WS_DEC); const bf16_t* U = (const bf16_t*)(p.ws + WS_U); bf16_t* SST = (bf16_t*)(p.ws + WS_SST);
    const f32x4 d = *(const f32x4*)(DEC + (size_t)c * 512 + h * 128 + 4 * kg);
    const float* s0 = p.state + ((size_t)bh * 128 + 4 * kg) * 128; float* so = p.out + OFF_SS + ((size_t)bh * 128 + 4 * kg) * 128;
#pragma unroll
    for (int e = 0; e < 2; ++e) { const int v = 4 * vq + 2 * e + vv; const size_t o = ((size_t)(c * 4 + h) * 128 + v) * 128 + 4 * kg;
        const u32x2 u = *(const u32x2*)(U + o); f32x4 S;
#pragma unroll
        for (int i = 0; i < 4; ++i) S[i] = s0[(size_t)i * 128 + v];
        u32x2 s; s.x = pk2(S[0], S[1]); s.y = pk2(S[2], S[3]); *(u32x2*)(SST + o) = s;
        so[v] = d[0] * S[0] + bflo(u.x); so[128 + v] = d[1] * S[1] + bfhi(u.x); so[256 + v] = d[2] * S[2] + bflo(u.y); so[384 + v] = d[3] * S[3] + bfhi(u.y); }
}

DI void attn_item(const Params& p, int item, int lane, const LAS float* biasl, bf16_t* obase = nullptr, int opitch = 1024) {
    const int c = item >> 4, h = (item >> 1) & 7, qh = item & 1, l31 = lane & 31, hf = lane >> 5;
    bf16_t* qptr = (bf16_t*)(p.ws + WS_QOB) + (size_t)(c * 64 + qh * 32 + l31) * 1024 + 512 + h * 64;
    const bf16_t* KB = (const bf16_t*)(p.ws + WS_KB); const bf16_t* VB = (const bf16_t*)(p.ws + WS_VB);
    bf16x8 qf[4];
#pragma unroll
    for (int ks = 0; ks < 4; ++ks) qf[ks] = *(const bf16x8*)(qptr + 16 * ks + 8 * hf);
    const bf16x8 id0 = ident_frag(0, l31, hf), id1 = ident_frag(1, l31, hf);
    const LAS float* bl = biasl + h * 192;
    f32x16 OT0 = zero16(), OT1 = zero16(); float mrun = -1e30f, lsum = 0.f;
    int ntile, ncache, db0; size_t krow_first;
    if (c < 512) { const int n = c & 255, j0 = n < 8 ? n : 8; ntile = 2 * (j0 + 1); ncache = 0; db0 = 64 * j0 + 32 * qh; krow_first = (size_t)(c - j0) * 64; }
    else { ntile = 18; ncache = 16; db0 = 512 + 32 * qh; krow_first = (size_t)c * 64 - 512; }
    const int bs = c - 512;
    u32x4 nk[4], nv[4], nk2[4], nv2[4];
#define ATT_LOAD(i_) do { if ((i_) < ncache) { \
            const float* kp_ = p.cache_k + ((size_t)(bs * 512 + 32 * (i_) + l31) * 8 + h) * 64 + 8 * hf; const float* vp_ = p.cache_v + ((size_t)(bs * 512 + 32 * (i_) + l31) * 8 + h) * 64 + 8 * hf; \
            _Pragma("unroll") for (int ks = 0; ks < 4; ++ks) { nk[ks] = *(const u32x4*)(kp_ + 16 * ks); nk2[ks] = *(const u32x4*)(kp_ + 16 * ks + 4); nv[ks] = *(const u32x4*)(vp_ + 16 * ks); nv2[ks] = *(const u32x4*)(vp_ + 16 * ks + 4); } \
        } else { const size_t ro_ = ((size_t)h * T + krow_first + 32 * (i_) + l31) * 64 + 8 * hf; \
            _Pragma("unroll") for (int ks = 0; ks < 4; ++ks) { nk[ks] = *(const u32x4*)(KB + ro_ + 16 * ks); nv[ks] = *(const u32x4*)(VB + ro_ + 16 * ks); } } } while (0)
    ATT_LOAD(0);
    for (int i = 0; i < ntile; ++i) {
        bf16x8 kf[4], vf[2][2];
        if (i < ncache) {
#pragma unroll
            for (int ks = 0; ks < 4; ++ks) { u32x4 w; const f32x4 a = __builtin_bit_cast(f32x4, nk[ks]), b = __builtin_bit_cast(f32x4, nk2[ks]), e = __builtin_bit_cast(f32x4, nv[ks]), f = __builtin_bit_cast(f32x4, nv2[ks]);
                w.x = pk2(a[0], a[1]); w.y = pk2(a[2], a[3]); w.z = pk2(b[0], b[1]); w.w = pk2(b[2], b[3]); kf[ks] = __builtin_bit_cast(bf16x8, w);
                w.x = pk2(e[0], e[1]); w.y = pk2(e[2], e[3]); w.z = pk2(f[0], f[1]); w.w = pk2(f[2], f[3]); vf[ks >> 1][ks & 1] = __builtin_bit_cast(bf16x8, w); }
        } else {
#pragma unroll
            for (int ks = 0; ks < 4; ++ks) { kf[ks] = __builtin_bit_cast(bf16x8, nk[ks]); vf[ks >> 1][ks & 1] = __builtin_bit_cast(bf16x8, nv[ks]); }
        }
        if (i + 1 < ntile) ATT_LOAD(i + 1);
        asm volatile("" ::: "memory");
        f32x16 st = zero16();
#pragma unroll
        for (int ks = 0; ks < 4; ++ks) st = MFMA32(kf[ks], qf[ks], st);
        const int dbase = db0 - 32 * i + l31; float mt = -1e30f;
        if (db0 - 32 * i - 31 >= 128) { const float bc = bl[191];
#pragma unroll
            for (int r = 0; r < 16; ++r) { const float s = st[r] * (0.125f * LOG2E) + bc; st[r] = s; mt = fmaxf(mt, s); }
        } else {
#pragma unroll
            for (int r = 0; r < 16; ++r) { int dist = dbase - crow(r, hf); dist = dist > 128 ? 128 : dist; const float s = st[r] * (0.125f * LOG2E) + bl[dist + 63]; st[r] = s; mt = fmaxf(mt, s); }
        }
        mt = fmaxf(mt, __shfl_xor(mt, 32));
        const float mnew = fmaxf(mrun, mt), alpha = __builtin_amdgcn_exp2f(mrun - mnew); mrun = mnew;
        float ps = 0.f;
#pragma unroll
        for (int r = 0; r < 16; ++r) { st[r] = __builtin_amdgcn_exp2f(st[r] - mnew); ps += st[r]; }
        lsum = lsum * alpha + ps;
#pragma unroll
        for (int r = 0; r < 16; ++r) { OT0[r] *= alpha; OT1[r] *= alpha; }
        const bf16x8 pf0 = pack8(st, 0), pf1 = pack8(st, 1);
        { f32x16 vx = zero16(); vx = MFMA32(vf[0][0], id0, vx); vx = MFMA32(vf[0][1], id1, vx); OT0 = MFMA32(pack8(vx, 0), pf0, OT0); OT0 = MFMA32(pack8(vx, 1), pf1, OT0); }
        { f32x16 vx = zero16(); vx = MFMA32(vf[1][0], id0, vx); vx = MFMA32(vf[1][1], id1, vx); OT1 = MFMA32(pack8(vx, 0), pf0, OT1); OT1 = MFMA32(pack8(vx, 1), pf1, OT1); }
    }
    lsum += __shfl_xor(lsum, 32); const float inv = 1.f / lsum;
    if (obase) qptr = obase + (size_t)(c * 64 + qh * 32 + l31) * opitch + h * 64;
#pragma unroll
    for (int g = 0; g < 4; ++g) { u32x2 o; o.x = pk2(OT0[4 * g] * inv, OT0[4 * g + 1] * inv); o.y = pk2(OT0[4 * g + 2] * inv, OT0[4 * g + 3] * inv); *(u32x2*)(qptr + 8 * g + 4 * hf) = o;
        o.x = pk2(OT1[4 * g] * inv, OT1[4 * g + 1] * inv); o.y = pk2(OT1[4 * g + 2] * inv, OT1[4 * g + 3] * inv); *(u32x2*)(qptr + 32 + 8 * g + 4 * hf) = o; }
}

DI void hgrn_out_item(const Params& p, int item, int lane, bf16_t* obase = nullptr) {
    const int c = item >> 3, h = (item >> 1) & 3, tt = item & 1, l31 = lane & 31, hf = lane >> 5;
    const float* CUM = (const float*)(p.ws + WS_CUM); const bf16_t* KA = (const bf16_t*)(p.ws + WS_KA); const bf16_t* VA = (const bf16_t*)(p.ws + WS_VA);
    const bf16_t* GA = (const bf16_t*)(p.ws + WS_GA); const bf16_t* SST = (const bf16_t*)(p.ws + WS_SST);
    const int trow = c * 64 + 32 * tt + l31;
    bf16_t* qap = (bf16_t*)(p.ws + WS_QOB) + (size_t)trow * 1024 + h * 128;
    const size_t hb = (size_t)h * T * 128;
    const float* cumt = CUM + hb + (size_t)trow * 128; const float* refp = CUM + hb + (size_t)(c * 64 + 32) * 128;
    bf16x8 qd1[8], qd2[8];
#pragma unroll
    for (int ks = 0; ks < 8; ++ks) { const int k0 = 16 * ks + 8 * hf; const bf16x8 q8 = *(const bf16x8*)(qap + k0);
        const f32x4 c0 = *(const f32x4*)(cumt + k0), c1 = *(const f32x4*)(cumt + k0 + 4), r0 = *(const f32x4*)(refp + k0), r1 = *(const f32x4*)(refp + k0 + 4);
        float a[8], b[8];
#pragma unroll
        for (int j = 0; j < 8; ++j) { const float q = bf2f(q8[j]), cu = j < 4 ? c0[j & 3] : c1[j & 3], rf = j < 4 ? r0[j & 3] : r1[j & 3]; a[j] = q * __expf(cu - rf); b[j] = q * __expf(cu); }
        qd1[ks] = pack8f(a); qd2[ks] = pack8f(b); }
    f32x16 OT[4];
#pragma unroll
    for (int vt = 0; vt < 4; ++vt) OT[vt] = zero16();
    const bf16_t* sp = SST + ((size_t)(c * 4 + h) * 128 + l31) * 128 + 8 * hf;
#pragma unroll
    for (int vt = 0; vt < 4; ++vt)
#pragma unroll
        for (int ks = 0; ks < 8; ++ks) OT[vt] = MFMA32(*(const bf16x8*)(sp + (size_t)vt * 32 * 128 + 16 * ks), qd2[ks], OT[vt]);
    const bf16x8 id0 = ident_frag(0, l31, hf), id1 = ident_frag(1, l31, hf);
    for (int st = 0; st <= tt; ++st) {
        const int srow = c * 64 + 32 * st + l31; const bf16_t* kap = KA + hb + (size_t)srow * 128; const float* cums = CUM + hb + (size_t)srow * 128;
        f32x16 X = zero16();
#pragma unroll
        for (int ks = 0; ks < 8; ++ks) { const int k0 = 16 * ks + 8 * hf; const bf16x8 k8 = *(const bf16x8*)(kap + k0);
            const f32x4 c0 = *(const f32x4*)(cums + k0), c1 = *(const f32x4*)(cums + k0 + 4), r0 = *(const f32x4*)(refp + k0), r1 = *(const f32x4*)(refp + k0 + 4);
            float a[8];
#pragma unroll
            for (int j = 0; j < 8; ++j) { const float cu = j < 4 ? c0[j & 3] : c1[j & 3], rf = j < 4 ? r0[j & 3] : r1[j & 3]; a[j] = bf2f(k8[j]) * __expf(rf - cu); }
            X = MFMA32(pack8f(a), qd1[ks], X); }
        if (st == tt) {
#pragma unroll
            for (int r = 0; r < 16; ++r) if (crow(r, hf) > l31) X[r] = 0.f; }
        const bf16x8 xf0 = pack8(X, 0), xf1 = pack8(X, 1);
        const bf16_t* vp = VA + hb + (size_t)srow * 128 + 8 * hf;
#pragma unroll
        for (int vt = 0; vt < 4; ++vt) { f32x16 vx = zero16(); vx = MFMA32(*(const bf16x8*)(vp + 32 * vt), id0, vx); vx = MFMA32(*(const bf16x8*)(vp + 32 * vt + 16), id1, vx);
            OT[vt] = MFMA32(pack8(vx, 0), xf0, OT[vt]); OT[vt] = MFMA32(pack8(vx, 1), xf1, OT[vt]); }
    }
    float ss = 0.f;
#pragma unroll
    for (int vt = 0; vt < 4; ++vt)
#pragma unroll
        for (int r = 0; r < 16; ++r) ss += OT[vt][r] * OT[vt][r];
    ss += __shfl_xor(ss, 32);
    const float rstd = __builtin_amdgcn_rsqf(ss * (1.f / 128.f) + EPS);
    const bf16_t* gap = GA + hb + (size_t)trow * 128; const float* onp = p.out_norm + h * 128;
    if (obase) qap = obase + (size_t)trow * 512 + h * 128;
#pragma unroll
    for (int vt = 0; vt < 4; ++vt)
#pragma unroll
        for (int g = 0; g < 4; ++g) { const int v0 = 32 * vt + 8 * g + 4 * hf; const f32x4 on = *(const f32x4*)(onp + v0); const u32x2 ga = *(const u32x2*)(gap + v0);
            u32x2 o; o.x = pk2(OT[vt][4 * g] * rstd * on[0] * bflo(ga.x), OT[vt][4 * g + 1] * rstd * on[1] * bfhi(ga.x));
            o.y = pk2(OT[vt][4 * g + 2] * rstd * on[2] * bflo(ga.y), OT[vt][4 * g + 3] * rstd * on[3] * bfhi(ga.y)); *(u32x2*)(qap + v0) = o; }
}


#define XB_TMO      128
#define XB_XCNT(j)  (256  + 64 * (j))
#define XB_XSUB(j)  (1280 + 64 * (j))
#define XB_XGEN(j)  (2304 + 64 * (j))
#define XB_TOP      3328
#define XB_TOPGEN   3392
#define XCD_BAR_WORDS 3456
#define XB_SPIN_CAP (1u << 18)
DI unsigned xb_ld(unsigned* p)              { return __hip_atomic_load(p, __ATOMIC_RELAXED, __HIP_MEMORY_SCOPE_AGENT); }
DI unsigned xb_add(unsigned* p, unsigned v) { return __hip_atomic_fetch_add(p, v, __ATOMIC_RELAXED, __HIP_MEMORY_SCOPE_AGENT); }
DI unsigned xb_xcc_id() { return (unsigned)__builtin_amdgcn_s_getreg((3 << 11) | 20) & 0xFu; }
#define XB_SPIN(cond, bar) do { unsigned _sp = 0; while (cond) { __builtin_amdgcn_s_sleep(1); \
    if ((++_sp & 255u) == 0u) { if (xb_ld(&(bar)[XB_TMO])) break; if (_sp > XB_SPIN_CAP) { atomicAdd(&(bar)[XB_TMO], 1u); break; } } } } while (0)
struct XcdBarrier { unsigned* bar; unsigned x; volatile LAS unsigned* st; };
DI XcdBarrier xcd_barrier_post(unsigned* bar, volatile LAS unsigned* st) {
    XcdBarrier b; b.bar = bar; b.x = xb_xcc_id(); b.st = st;
    if (threadIdx.x == 0) (void)xb_add(&bar[XB_XCNT(b.x)], 1u);
    return b;
}
DI void xcd_barrier_complete(unsigned* bar, unsigned x, unsigned& nloc, unsigned& nx) {
    const unsigned G = gridDim.x * gridDim.y * gridDim.z;
    unsigned sum, cnt, mine, sp = 0u;
    for (;;) {
        sum = 0u; cnt = 0u; mine = 0u;
#pragma unroll
        for (unsigned j = 0; j < 16; ++j) { const unsigned c = xb_ld(&bar[XB_XCNT(j)]); sum += c; cnt += (c > 0u) ? 1u : 0u; mine = (j == x) ? c : mine; }
        if (sum == G) break;
        __builtin_amdgcn_s_sleep(1);
        if ((++sp & 255u) == 0u) { if (xb_ld(&bar[XB_TMO])) break; if (sp > XB_SPIN_CAP) { atomicAdd(&bar[XB_TMO], 1u); break; } }
    }
    nloc = mine > 0u ? mine : 1u; nx = cnt > 0u ? cnt : 1u;
}
DI void xcd_barrier(const XcdBarrier& b) {
    asm volatile("s_waitcnt vmcnt(0)" ::: "memory");
    __syncthreads();
    if (threadIdx.x == 0) {
        unsigned* bar = b.bar;
        __builtin_amdgcn_s_waitcnt(0);
        unsigned nloc = b.st[0], nx = b.st[1];
        if (nloc == 0u) { xcd_barrier_complete(bar, b.x, nloc, nx); b.st[0] = nloc; b.st[1] = nx; }
        const unsigned old = xb_add(&bar[XB_XSUB(b.x)], 1u);
        const unsigned gen = old / nloc;
        if (old + 1u == (gen + 1u) * nloc) {
            __builtin_amdgcn_fence(__ATOMIC_RELEASE, "agent");
            asm volatile("s_waitcnt vmcnt(0)" ::: "memory");
            const unsigned og = xb_add(&bar[XB_TOP], 1u);
            const unsigned tg = og / nx;
            if (og + 1u == (tg + 1u) * nx) xb_add(&bar[XB_TOPGEN], 1u);
            else XB_SPIN(xb_ld(&bar[XB_TOPGEN]) == tg, bar);
            __builtin_amdgcn_fence(__ATOMIC_ACQUIRE, "agent");
            xb_add(&bar[XB_XGEN(b.x)], 1u);
            asm volatile("s_waitcnt vmcnt(0)" ::: "memory");
        } else {
            XB_SPIN(xb_ld(&bar[XB_XGEN(b.x)]) == gen, bar);
            __builtin_amdgcn_fence(__ATOMIC_ACQUIRE, "agent");
            asm volatile("s_waitcnt vmcnt(0)" ::: "memory");
        }
    }
    __syncthreads();
}

__global__ void __launch_bounds__(512, 2) fwd_megakernel(Params p) {
    extern __shared__ __attribute__((aligned(16))) unsigned char lds_raw[];
    LAS unsigned char* lds = (LAS unsigned char*)lds_raw;
    cg::grid_group grid = cg::this_grid();
    const int G = gridDim.x, bx = blockIdx.x;
    volatile LAS unsigned* bst = (volatile LAS unsigned*)(lds + LDS_ST_OFF);
    if (threadIdx.x < 2) bst[threadIdx.x] = 0u;
    __syncthreads();
    const XcdBarrier xbar = xcd_barrier_post((unsigned*)(p.ws + WS_BAR), bst);
    if (threadIdx.x == 0) bst[2] = xb_add((unsigned*)(p.ws + WS_BAR) + 3712 + xbar.x, 1u);
#define GRID_BAR() xcd_barrier(xbar)
    unsigned char* ws = p.ws;
    float* MOD = (float*)(ws + WS_MOD); bf16_t* H = (bf16_t*)(ws + WS_H);

    phase_prep(p, lds);
    grid.sync();
    { pg8::Gemm g{(const bf16_t*)(ws + WS_SC), (const bf16_t*)(ws + WS_WADA), 256, 6144, 1024}; pg8::StaticOrder S; S.init(256, 6144, G, bx);
      EpiMod E{MOD, p.b_ada}; pg8::gemm_phase<EpiMod, pg8::StaticOrder, true, true>(lds, g, S, E); }
    GRID_BAR();
    int cv = bx;
    { unsigned* barw = (unsigned*)(p.ws + WS_BAR); bool uni = (G & 7) == 0;
#pragma unroll
      for (int j = 0; j < 16; ++j) { const unsigned c = xb_ld(&barw[XB_XCNT(j)]); uni = uni && (j < 8 ? c == (unsigned)(G >> 3) : c == 0u); }
      if (uni) cv = (int)xbar.x + 8 * (int)bst[2];
      cv = __builtin_amdgcn_readfirstlane(cv); }
    phase_norm_mod(p.x_prompt, p.x_sample, p.norm_mix, MOD, 0, 1024, H);
#if PROBE_DUP == 1
    GRID_BAR(); phase_norm_mod(p.x_prompt, p.x_sample, p.norm_mix, MOD, 0, 1024, H);
#endif
#if PROBE_DUP == 10
    GRID_BAR(); GRID_BAR(); GRID_BAR(); GRID_BAR(); GRID_BAR(); GRID_BAR(); GRID_BAR(); GRID_BAR(); GRID_BAR(); GRID_BAR();
#endif
    GRID_BAR();
    { pg8::Gemm g{H, (const bf16_t*)(ws + WS_WIN), T, INC, 1024}; pg8::StaticOrder S; S.init(T, INC, G, cv);
      EpiIn E{(bf16_t*)(ws + WS_QOB), (bf16_t*)(ws + WS_KA), (bf16_t*)(ws + WS_VA), (bf16_t*)(ws + WS_GA), (bf16_t*)(ws + WS_KB), (bf16_t*)(ws + WS_VB),
              (bf16_t*)(p.out), (bf16_t*)(p.out) + (size_t)T * 1024, (float*)(ws + WS_CUM), (float*)(ws + WS_DEC), p.lb_logits, p.out};
      pg8::gemm_phase<EpiIn, pg8::StaticOrder, true, true>(lds, g, S, E);
#if PROBE_DUP == 2
      GRID_BAR(); pg8::gemm_phase<EpiIn, pg8::StaticOrder, true, true>(lds, g, S, E);
#endif
    }
    GRID_BAR();
    { const int tid = fresh_tid(), lane = tid & 63, wave = __builtin_amdgcn_readfirstlane(tid >> 6);
      for (int it = wave * G + bx; it < NCH * 32; it += 8 * G) hgrn_u_item(p, it, lane);
#if PROBE_DUP == 3
      for (int it = wave * G + bx; it < NCH * 32; it += 8 * G) hgrn_u_item(p, it, lane);
#endif
    }
    GRID_BAR();
    {
        const int tid = fresh_tid(), lane = tid & 63, wave = __builtin_amdgcn_readfirstlane(tid >> 6);
        LAS float* biasl = (LAS float*)lds;
        for (int i = tid; i < 8 * 192; i += 512) biasl[i] = p.rel_bias[i] * LOG2E;
        __syncthreads();
#if PROBE_DUP == 4
        if (wave != 0) { const int gw = (wave - 1) * G + bx, NGW = 7 * G; for (int it = gw; it < NCH * 16; it += NGW) attn_item(p, it, lane, biasl, (bf16_t*)(ws + WS_SST), 512); }
        GRID_BAR();
#endif
#if PROBE_DUP == 41
        if (wave == 0) { for (int it = bx; it < 256; it += G) scan_prompt_item(p, it, lane); }
        GRID_BAR();
#endif
        if (wave == 0) { for (int it = bx; it < 256; it += G) scan_prompt_item(p, it, lane); }
        else {
            const int gw = (wave - 1) * G + bx, NGW = 7 * G;
            for (int it = gw; it < 4096; it += NGW) scan_sample_item(p, it, lane);
            const int x = (int)xbar.x, ncu = (int)bst[0], nxcc = (int)bst[1], j = (int)bst[2];
            if (nxcc == 8 && x < 8 && ncu > 0 && j < ncu) {
                const int nslot = 7 * ncu, slot = (wave - 1) * ncu + j;
                for (int idx = slot; idx < 68 * 16; idx += nslot) { const int cc = idx >> 4, c = cc < 4 ? 512 + 4 * x + cc : 64 * x + (cc - 4); attn_item(p, c * 16 + (idx & 15), lane, biasl); }
            } else for (int it = gw; it < NCH * 16; it += NGW) attn_item(p, it, lane, biasl);
        }
    }
    GRID_BAR();
    { const int tid = fresh_tid(), lane = tid & 63, wave = __builtin_amdgcn_readfirstlane(tid >> 6);
#if PROBE_DUP == 5
      for (int it = wave * G + bx; it < NCH * 8; it += 8 * G) hgrn_out_item(p, it, lane, (bf16_t*)(ws + WS_U));
      GRID_BAR();
#endif
      for (int it = wave * G + bx; it < NCH * 8; it += 8 * G) hgrn_out_item(p, it, lane); }
    GRID_BAR();
    { pg8::Gemm g{(const bf16_t*)(ws + WS_QOB), (const bf16_t*)(ws + WS_WAB), T, 1024, 1024}; pg8::StaticOrder S; S.init(T, 1024, G, cv);
      EpiMerge E{(const bf16_t*)(p.out), (const bf16_t*)(p.out) + (size_t)T * 1024, (bf16_t*)(ws + WS_M)};
      pg8::gemm_phase<EpiMerge, pg8::StaticOrder, true, true>(lds, g, S, E); }
    GRID_BAR();
    const bool split_ps = G >= 64;
    { pg8::Gemm g{(const bf16_t*)(ws + WS_M), (const bf16_t*)(ws + WS_WO), T, 1024, 1024}; EpiRes<false> E{p.x_prompt, p.x_sample, nullptr, (bf16_t*)(ws + WS_X1B), MOD + 2048};
      if (split_ps) {
        { pg8::StaticOrder S; S.init(TP, 1024, G, cv); pg8::gemm_phase<EpiRes<false>, pg8::StaticOrder, true, true>(lds, g, S, E); }
        GRID_BAR();
        if (bx < 32) { pg8::StaticOrder S; S.init(TS, 1024, 32, bx, TP / 256); pg8::gemm_phase<EpiRes<false>, pg8::StaticOrder, true, true>(lds, g, S, E); }
        else phase_norm_mod_b((const bf16_t*)(ws + WS_X1B), p.norm_ffn, MOD, 3072, 4096, H, 0, TP, 32);
        GRID_BAR();
        phase_norm_mod_b((const bf16_t*)(ws + WS_X1B), p.norm_ffn, MOD, 3072, 4096, H, TP, T, 0);
      } else {
        pg8::StaticOrder S; S.init(T, 1024, G, cv); pg8::gemm_phase<EpiRes<false>, pg8::StaticOrder, true, true>(lds, g, S, E);
        GRID_BAR();
        phase_norm_mod_b((const bf16_t*)(ws + WS_X1B), p.norm_ffn, MOD, 3072, 4096, H);
      } }
    GRID_BAR();
    { pg8::Gemm g{H, (const bf16_t*)(ws + WS_WFI), T, INC, 1024}; pg8::StaticOrder S; S.init(T, INC, G, cv);
      EpiFfnIn E{(bf16_t*)(ws + WS_HID)}; pg8::gemm_phase<EpiFfnIn, pg8::StaticOrder, true, true>(lds, g, S, E);
#if PROBE_DUP == 9
      GRID_BAR(); pg8::gemm_phase<EpiFfnIn, pg8::StaticOrder, true, true>(lds, g, S, E);
#endif
    }
    GRID_BAR();
    { pg8::Gemm g{(const bf16_t*)(ws + WS_HID), (const bf16_t*)(ws + WS_WFO), T, 1024, FF}; EpiRes<true> E{nullptr, nullptr, (const bf16_t*)(ws + WS_X1B), (bf16_t*)(ws + WS_X2B), MOD + 5120};
      if (split_ps) {
        { pg8::StaticOrder S; S.init(TP, 1024, G, cv); pg8::gemm_phase<EpiRes<true>, pg8::StaticOrder, true, true>(lds, g, S, E); }
        GRID_BAR();
        float* PART = (float*)(ws + WS_CUM + 20 * MiB);
        if (bx < 64) { const int ks = bx >> 5; pg8::Gemm gs{(const bf16_t*)(ws + WS_HID) + ks * (FF / 2), (const bf16_t*)(ws + WS_WFO) + ks * (FF / 2), T, 1024, FF / 2, FF};
            pg8::StaticOrder S; S.init(TS, 1024, 32, bx & 31, TP / 256); EpiPart EP{PART + (size_t)ks * TS * D, TP}; pg8::gemm_phase<EpiPart, pg8::StaticOrder, true, true>(lds, gs, S, EP); }
        else phase_final_norm((const bf16_t*)(ws + WS_X2B), p.out, p.norm_final, 0, TP, 64);
        GRID_BAR();
        phase_final_norm_parts((const bf16_t*)(ws + WS_X1B), PART, PART + (size_t)TS * D, MOD + 5120, p.out, p.norm_final);
      } else {
        pg8::StaticOrder S; S.init(T, 1024, G, cv); pg8::gemm_phase<EpiRes<true>, pg8::StaticOrder, true, true>(lds, g, S, E);
        GRID_BAR();
        phase_final_norm((const bf16_t*)(ws + WS_X2B), p.out, p.norm_final);
      } }
}

extern "C" void kernel_launch(void* const* d_in, const int* in_sizes, int n_in, void* d_out, int out_size, void* d_ws, size_t ws_size, hipStream_t stream) {
    static int grid = 0;
    if (grid == 0) {
        if (n_in != 21 || (size_t)out_size != OUT_TOTAL || ws_size < WS_END) { fprintf(stderr, "kernel_launch: unexpected sizes n_in %d out %d ws %zu\n", n_in, out_size, ws_size); grid = -1; return; }
        int dev = 0, cus = 0, per = 0;
        (void)hipGetDevice(&dev); (void)hipDeviceGetAttribute(&cus, hipDeviceAttributeMultiprocessorCount, dev);
        (void)hipFuncSetAttribute((const void*)fwd_megakernel, hipFuncAttributeMaxDynamicSharedMemorySize, LDS_BYTES);
        (void)hipOccupancyMaxActiveBlocksPerMultiprocessor(&per, (const void*)fwd_megakernel, 512, LDS_BYTES);
        if (per < 1) per = 1;
        grid = cus * per; fprintf(stderr, "kernel_launch: grid %d (cus %d x %d)\n", grid, cus, per);
    }
    if (grid < 0) return;
    if (hipMemsetAsync((char*)d_ws + WS_BAR, 0, BAR_BYTES, stream) != hipSuccess) { fprintf(stderr, "kernel_launch: memset failed\n"); return; }
    Params p{};
    const float** f = (const float**)&p;
    for (int i = 0; i < 21; ++i) f[i] = (const float*)d_in[i];
    p.out = (float*)d_out; p.ws = (unsigned char*)d_ws;
    void* args[] = {&p};
    hipError_t e = hipLaunchCooperativeKernel((const void*)fwd_megakernel, dim3(grid), dim3(512), args, LDS_BYTES, stream);
    if (e != hipSuccess) fprintf(stderr, "cooperative launch failed: %s (grid %d)\n", hipGetErrorString(e), grid);
}
```

```cpp
#include <hip/hip_runtime.h>
#include <hip/hip_cooperative_groups.h>
#include <cstdio>
#include <cstdint>
namespace cg = cooperative_groups;
#ifndef PROBE_DUP
#define PROBE_DUP 0
#endif

#define DI __device__ __forceinline__
#define LAS __attribute__((address_space(3)))
typedef unsigned short bf16_t;
typedef short bf16x8 __attribute__((ext_vector_type(8)));
typedef float f32x4 __attribute__((ext_vector_type(4)));
typedef float f32x2 __attribute__((ext_vector_type(2)));
typedef float f32x16 __attribute__((ext_vector_type(16)));
typedef unsigned u32x4 __attribute__((ext_vector_type(4)));
typedef unsigned u32x2 __attribute__((ext_vector_type(2)));
typedef __bf16 bf2_t __attribute__((ext_vector_type(2)));

constexpr int D = 1024, TP = 32768, TS = 2048, T = TP + TS, NCH = T / 64, NBATCH = 34;
constexpr int INC = 5632, FF = 2816;
constexpr float EPS = 1e-6f, LOG2E = 1.4426950408889634f;
constexpr size_t OFF_Y = 0, OFF_SP = (size_t)T * D, OFF_KP = OFF_SP + 131072, OFF_VP = OFF_KP + 524288, OFF_SS = OFF_VP + 524288,
                 OFF_KS = OFF_SS + 2097152, OFF_VS = OFF_KS + 1048576, OUT_TOTAL = OFF_VS + 1048576;
constexpr size_t MiB = 1u << 20;
constexpr size_t WS_MOD = 1 * MiB, WS_DEC = 2 * MiB, WS_SC = 4 * MiB, WS_WADA = 5 * MiB, WS_WIN = 17 * MiB, WS_WAB = 28 * MiB, WS_WO = 30 * MiB,
                 WS_WFI = 32 * MiB, WS_WFO = 43 * MiB, WS_H = 50 * MiB, WS_QOB = 118 * MiB, WS_KA = 186 * MiB, WS_VA = 220 * MiB, WS_GA = 254 * MiB,
                 WS_KB = 288 * MiB, WS_VB = 322 * MiB, WS_CUM = 356 * MiB, WS_SST = 424 * MiB, WS_END = 492 * MiB;
constexpr size_t WS_U = WS_H, WS_M = WS_KA, WS_HID = WS_KA, WS_X1B = WS_QOB, WS_X2B = WS_H;
constexpr size_t WS_BAR = 0, BAR_BYTES = 16384;
constexpr int LDS_BYTES = 140 * 1024, LDS_ST_OFF = 136 * 1024;

struct Params {
    const float *x_prompt, *x_sample, *c_prompt, *c_sample, *state, *cache_k, *cache_v, *w_ada, *b_ada, *norm_mix, *w_in, *lb_logits, *out_norm,
                *w_a, *rel_bias, *w_b, *w_out, *norm_ffn, *w_ffn_in, *w_ffn_out, *norm_final;
    float* out; unsigned char* ws;
};

DI int fresh_tid() { int t = threadIdx.x; asm volatile("" : "+v"(t)); return t; }
DI int launder(int v) { asm volatile("" : "+v"(v)); return v; }
DI unsigned pk2(float a, float b) { f32x2 v = {a, b}; bf2_t r = __builtin_convertvector(v, bf2_t); return __builtin_bit_cast(unsigned, r); }
DI float bflo(unsigned u) { return __uint_as_float(u << 16); }
DI float bfhi(unsigned u) { return __uint_as_float(u & 0xffff0000u); }
DI float bf2f(short s) { return __uint_as_float(((unsigned)(unsigned short)s) << 16); }
DI float sigm(float x) { return __builtin_amdgcn_rcpf(1.f + __expf(-x)); }
DI float silu(float x) { return x * sigm(x); }
DI int batch_of(int r) { return r < TP ? (r >> 14) : 2 + ((r - TP) >> 6); }
DI int crow(int reg, int h) { return (reg & 3) + 8 * (reg >> 2) + 4 * h; }
DI bf16x8 pack8(const f32x16& x, int s) {
    u32x4 p; p.x = pk2(x[8 * s], x[8 * s + 1]); p.y = pk2(x[8 * s + 2], x[8 * s + 3]); p.z = pk2(x[8 * s + 4], x[8 * s + 5]); p.w = pk2(x[8 * s + 6], x[8 * s + 7]);
    return __builtin_bit_cast(bf16x8, p);
}
DI bf16x8 pack8f(const float* v) { u32x4 p; p.x = pk2(v[0], v[1]); p.y = pk2(v[2], v[3]); p.z = pk2(v[4], v[5]); p.w = pk2(v[6], v[7]); return __builtin_bit_cast(bf16x8, p); }
DI bf16x8 ident_frag(int ks, int l31, int hf) {
    const int jj = l31 - 16 * ks - 8 * hf; bf16x8 r;
#pragma unroll
    for (int j = 0; j < 8; ++j) r[j] = (j == jj) ? (short)0x3F80 : (short)0;
    return r;
}
#define MFMA32(a, b, c) __builtin_amdgcn_mfma_f32_32x32x16_bf16((a), (b), (c), 0, 0, 0)
DI f32x16 zero16() { f32x16 z;
#pragma unroll
    for (int i = 0; i < 16; ++i) z[i] = 0.f; return z; }

namespace pg8 {
constexpr int BM = 256, BK = 64, HALF = 128, HTB = HALF * BK * 2, STAGE_BYTES = 8 * HTB, NXCD = 8, WGM = 8;
__host__ __device__ __forceinline__ int lds_byte(int r, int c) { const int st = (r >> 4) * 2 + (c >> 5), rr = r & 15, cc = c & 31, ob = rr * 64 + cc * 2; return st * 1024 + (ob ^ (((ob >> 9) & 1) << 5)); }
__host__ __device__ __forceinline__ void stage_rc(int b, int& R, int& C) { const int st = b / 1024, sb = b % 1024, swz = sb ^ (((sb >> 9) & 1) << 5); R = (st >> 1) * 16 + swz / 64; C = (st & 1) * 32 + (swz % 64) / 2; }
__host__ __device__ __forceinline__ int perm32(int rho) { const int n = rho >> 4, i = rho & 15; return 8 * (i >> 2) + 4 * n + (i & 3); }
struct Unit { int pm, pn; };
struct Gemm { const bf16_t* A; const bf16_t* Bt; int M, N, K, ld; };
struct StaticOrder {
    int nM, nN, nwg, G, c, pm_off;
    __device__ void init(int M, int N, int G_, int c_, int pm_off_ = 0) { nM = M / BM; nN = N / BM; nwg = nM * nN; G = G_; c = c_; pm_off = pm_off_; }
    __device__ bool next(int i, Unit& u) const {
        const long L = (long)i * G + c; if (L >= nwg) return false;
        int wgid = (int)L; { const int q = nwg / NXCD, r = nwg % NXCD, xcd = wgid % NXCD, off = wgid / NXCD; wgid = (xcd < r ? xcd * (q + 1) : r * (q + 1) + (xcd - r) * q) + off; }
        const int nig = WGM * nN, gid = wgid / nig, fm = gid * WGM, gsz = (nM - fm) < WGM ? (nM - fm) : WGM;
        u.pm = pm_off + fm + ((wgid % nig) % gsz); u.pn = (wgid % nig) / gsz; return true;
    }
};
template <class Epi, class Sched, bool ALIGN_EPI = false, bool SP2 = false>
__device__ __forceinline__ void gemm_phase(LAS unsigned char* lds, const Gemm g, const Sched& S, const Epi& E) {
    const int tid = fresh_tid(), wid = __builtin_amdgcn_readfirstlane(tid >> 6), lane = tid & 63, wr = wid >> 2, wc = wid & 3, fr = lane & 15, fq = lane >> 4;
    const int K = g.ld ? g.ld : g.K, nt = g.K / BK;
    unsigned voffA[2], voffB[2];
#pragma unroll
    for (int i = 0; i < 2; ++i) { int R, C; stage_rc(tid * 16 + i * 8192, R, C); const int Rb = Epi::PERM ? ((R & ~31) + perm32(R & 31)) : R;
        voffA[i] = (unsigned)(R * K + C) * 2u; voffB[i] = (unsigned)(Rb * K + C) * 2u; }
    const size_t kstep = (size_t)(BK * 2);
    const size_t hstep = (size_t)HALF * K * 2;
    const size_t tstep = 2 * hstep;
    const unsigned ldsw = (unsigned)wid * 1024u;
    const int aoff = lds_byte(wr * 64 + fr, fq * 8), boff = lds_byte(wc * 32 + fr, fq * 8);
#define PG8_SA(b, h) (((b) * 2 + (h)) * HTB)
#define PG8_SB(b, h) ((4 + (b) * 2 + (h)) * HTB)
#define PG8_STAGE(bufoff, gbase, voff) do { _Pragma("unroll") for (int _i = 0; _i < 2; ++_i) \
        __builtin_amdgcn_global_load_lds((const unsigned*)((const char*)(gbase) + (voff)[_i]), (LAS unsigned*)(lds + (bufoff) + ldsw + _i * 8192), 16, 0, 0); } while (0)
#define PG8_LDA(dst, b, h) do { _Pragma("unroll") for (int m = 0; m < 4; ++m) _Pragma("unroll") for (int k = 0; k < 2; ++k) dst[m][k] = *(const LAS bf16x8*)(lds + PG8_SA(b, h) + aoff + m * 2048 + k * 1024); } while (0)
#define PG8_LDB(dst, b, h) do { _Pragma("unroll") for (int n = 0; n < 2; ++n) _Pragma("unroll") for (int k = 0; k < 2; ++k) dst[n][k] = *(const LAS bf16x8*)(lds + PG8_SB(b, h) + boff + n * 2048 + k * 1024); } while (0)
#define PG8_MMA(ai, bj, At, Bt) do { __builtin_amdgcn_s_setprio(1); _Pragma("unroll") for (int m = 0; m < 4; ++m) _Pragma("unroll") for (int n = 0; n < 2; ++n) _Pragma("unroll") for (int k = 0; k < 2; ++k) \
        acc[ai][bj][m][n] = __builtin_amdgcn_mfma_f32_16x16x32_bf16(Bt[n][k], At[m][k], acc[ai][bj][m][n], 0, 0, 0); __builtin_amdgcn_s_setprio(0); } while (0)
#define PG8_WAIT_V(n) asm volatile("s_waitcnt vmcnt(" #n ")" ::: "memory")
#define PG8_WAIT_L(n) asm volatile("s_waitcnt lgkmcnt(" #n ")" ::: "memory")
#define PG8_BAR __builtin_amdgcn_s_barrier()
#define PG8_SCHED __builtin_amdgcn_sched_barrier(0)
    Unit cur, nxt; int ui = 0;
    if (!S.next(0, cur)) return;
    f32x4 acc[2][2][4][2];
#pragma unroll
    for (int a = 0; a < 2; ++a)
#pragma unroll
        for (int b = 0; b < 2; ++b)
#pragma unroll
            for (int m = 0; m < 4; ++m)
#pragma unroll
                for (int n = 0; n < 2; ++n) acc[a][b][m][n] = (f32x4){0.f, 0.f, 0.f, 0.f};
    bf16x8 At[4][2], B0[2][2], B1[2][2];
    const char* cA = (const char*)g.A + (size_t)cur.pm * tstep; const char* cB = (const char*)g.Bt + (size_t)cur.pn * tstep;
    if constexpr (SP2) {
        PG8_STAGE(PG8_SB(0, 0), cB, voffB); PG8_STAGE(PG8_SB(0, 1), cB + hstep, voffB); PG8_STAGE(PG8_SA(0, 0), cA, voffA); PG8_STAGE(PG8_SA(0, 1), cA + hstep, voffA);
        if (wr == 1) PG8_BAR;
        PG8_WAIT_V(2); PG8_BAR;
        PG8_STAGE(PG8_SB(1, 0), cB + kstep, voffB); PG8_STAGE(PG8_SA(1, 0), cA + kstep, voffA); PG8_STAGE(PG8_SB(1, 1), cB + hstep + kstep, voffB);
        PG8_WAIT_V(6); PG8_BAR;
    } else {
        PG8_STAGE(PG8_SB(0, 0), cB, voffB); PG8_STAGE(PG8_SA(0, 0), cA, voffA); PG8_STAGE(PG8_SB(0, 1), cB + hstep, voffB); PG8_STAGE(PG8_SA(0, 1), cA + hstep, voffA);
        if (wr == 1) PG8_BAR;
        PG8_WAIT_V(4); PG8_BAR;
        PG8_STAGE(PG8_SB(1, 0), cB + kstep, voffB); PG8_STAGE(PG8_SA(1, 0), cA + kstep, voffA); PG8_STAGE(PG8_SB(1, 1), cB + hstep + kstep, voffB);
        PG8_WAIT_V(6); PG8_BAR;
    }
    for (;;) {
        const bool has_next = S.next(ui + 1, nxt);
        const char* nA = has_next ? (const char*)g.A + (size_t)nxt.pm * tstep : cA; const char* nB = has_next ? (const char*)g.Bt + (size_t)nxt.pn * tstep : cB;
        for (int t = 0; t < nt; t += 2) {
            if constexpr (Epi::MIDK) { if (t == nt / 2) E.mid(acc, cur, wr, wc, fr, fq); }
            const bool last = (t == nt - 2);
            const char* a1 = cA + (size_t)(t + 1) * kstep;
            const char* a2 = last ? nA : cA + (size_t)(t + 2) * kstep; const char* b2 = last ? nB : cB + (size_t)(t + 2) * kstep;
            const char* a3 = a2 + kstep; const char* b3 = b2 + kstep;
            if constexpr (SP2) {
            PG8_LDB(B0, 0, 0); PG8_LDB(B1, 0, 1); PG8_SCHED; PG8_LDA(At, 0, 0); PG8_STAGE(PG8_SA(1, 1), a1 + hstep, voffA);
            PG8_WAIT_V(8); PG8_WAIT_L(0); PG8_BAR; PG8_MMA(0, 0, At, B0); PG8_MMA(0, 1, At, B1); PG8_BAR; PG8_SCHED;
            PG8_LDA(At, 0, 1); PG8_STAGE(PG8_SB(0, 0), b2, voffB); PG8_STAGE(PG8_SB(0, 1), b2 + hstep, voffB); PG8_STAGE(PG8_SA(0, 0), a2, voffA);
            PG8_WAIT_V(8); PG8_WAIT_L(0); PG8_BAR; PG8_MMA(1, 0, At, B0); PG8_MMA(1, 1, At, B1); PG8_BAR; PG8_SCHED;
            PG8_LDB(B0, 1, 0); PG8_LDB(B1, 1, 1); PG8_SCHED; PG8_LDA(At, 1, 0); PG8_STAGE(PG8_SA(0, 1), a2 + hstep, voffA);
            PG8_WAIT_V(8); PG8_WAIT_L(0); PG8_BAR; PG8_MMA(0, 0, At, B0); PG8_MMA(0, 1, At, B1); PG8_BAR; PG8_SCHED;
            PG8_LDA(At, 1, 1); PG8_STAGE(PG8_SB(1, 0), b3, voffB); PG8_STAGE(PG8_SB(1, 1), b3 + hstep, voffB); PG8_STAGE(PG8_SA(1, 0), a3, voffA);
            PG8_WAIT_V(8); PG8_WAIT_L(0); PG8_BAR; PG8_MMA(1, 0, At, B0); PG8_MMA(1, 1, At, B1); PG8_BAR; PG8_SCHED;
            } else {
            PG8_LDB(B0, 0, 0); PG8_SCHED; PG8_LDA(At, 0, 0); PG8_STAGE(PG8_SA(1, 1), a1 + hstep, voffA);
            PG8_WAIT_L(8); PG8_BAR; PG8_WAIT_L(0); PG8_MMA(0, 0, At, B0); PG8_BAR; PG8_SCHED;
            PG8_LDB(B1, 0, 1); PG8_STAGE(PG8_SB(0, 0), b2, voffB);
            PG8_BAR; PG8_WAIT_L(0); PG8_MMA(0, 1, At, B1); PG8_BAR;
            PG8_LDA(At, 0, 1); PG8_STAGE(PG8_SA(0, 0), a2, voffA);
            PG8_BAR; PG8_WAIT_L(0); PG8_MMA(1, 0, At, B0); PG8_BAR; PG8_SCHED;
            PG8_STAGE(PG8_SB(0, 1), b2 + hstep, voffB);
            PG8_WAIT_V(6); PG8_BAR; PG8_MMA(1, 1, At, B1); PG8_BAR;
            PG8_LDB(B0, 1, 0); PG8_SCHED; PG8_LDA(At, 1, 0); PG8_STAGE(PG8_SA(0, 1), a2 + hstep, voffA);
            PG8_WAIT_L(8); PG8_BAR; PG8_WAIT_L(0); PG8_MMA(0, 0, At, B0); PG8_BAR; PG8_SCHED;
            PG8_LDB(B1, 1, 1); PG8_STAGE(PG8_SB(1, 0), b3, voffB);
            PG8_BAR; PG8_WAIT_L(0); PG8_MMA(0, 1, At, B1); PG8_BAR;
            PG8_LDA(At, 1, 1); PG8_STAGE(PG8_SA(1, 0), a3, voffA);
            PG8_BAR; PG8_WAIT_L(0); PG8_MMA(1, 0, At, B0); PG8_BAR; PG8_SCHED;
            PG8_STAGE(PG8_SB(1, 1), b3 + hstep, voffB);
            PG8_WAIT_V(6); PG8_BAR; PG8_MMA(1, 1, At, B1); PG8_BAR;
            }
        }
        if constexpr (ALIGN_EPI) { if (wr == 0) PG8_BAR; }
        E(acc, cur, wr, wc, fr, fq);
        if (!has_next) break;
#pragma unroll
        for (int a = 0; a < 2; ++a)
#pragma unroll
            for (int b = 0; b < 2; ++b)
#pragma unroll
                for (int m = 0; m < 4; ++m)
#pragma unroll
                    for (int n = 0; n < 2; ++n) acc[a][b][m][n] = (f32x4){0.f, 0.f, 0.f, 0.f};
        cur = nxt; cA = nA; cB = nB; ++ui;
        if constexpr (ALIGN_EPI) { if (wr == 1) PG8_BAR; }
    }
    PG8_WAIT_V(0);
    if constexpr (!ALIGN_EPI) { if (wr == 0) PG8_BAR; }
    PG8_BAR;
#undef PG8_SA
#undef PG8_SB
#undef PG8_STAGE
#undef PG8_LDA
#undef PG8_LDB
#undef PG8_MMA
#undef PG8_WAIT_V
#undef PG8_WAIT_L
#undef PG8_BAR
#undef PG8_SCHED
}
}
using pg8::Unit;
typedef f32x4 Acc[2][2][4][2];

DI u32x4 pack_row8(const f32x4& v0, const f32x4& v1) { u32x4 w; w.x = pk2(v0[0], v0[1]); w.y = pk2(v0[2], v0[3]); w.z = pk2(v1[0], v1[1]); w.w = pk2(v1[2], v1[3]); return w; }

struct EpiMod {
    static constexpr bool PERM = false, MIDK = false;
    float* mod; const float* bias;
    DI void operator()(Acc& acc, const Unit& u, int wr, int wc, int fr, int fq) const {
        { const int t_ = fresh_tid(); fr = t_ & 15; fq = (t_ >> 4) & 3; }
        if (u.pm != 0 || wr != 0) return;
#pragma unroll
        for (int m = 0; m < 3; ++m) { const int r = 16 * m + fr; if (r < NBATCH) {
#pragma unroll
            for (int bj = 0; bj < 2; ++bj)
#pragma unroll
                for (int n = 0; n < 2; ++n) { const int col = u.pn * 256 + bj * 128 + wc * 32 + n * 16 + 4 * fq;
                    *(f32x4*)(mod + (size_t)r * 6144 + col) = acc[0][bj][m][n] + *(const f32x4*)(bias + col); } } }
    }
};

struct EpiIn {
    static constexpr bool PERM = true, MIDK = false;
    bf16_t *QOB, *KA, *VA, *GA, *KB, *VB, *SGA, *SGB; float *CUM, *DEC; const float* lbl; float* out;
    DI void operator()(Acc& acc, const Unit& u, int wr, int wc, int fr, int fq) const {
        { const int t_ = fresh_tid(); fr = t_ & 15; fq = (t_ >> 4) & 3; }
        const int pn = u.pn, rt = wr * 64 + fr, row0 = u.pm * 256 + rt, cw = wc * 32 + 8 * fq, lane = fq * 16 + fr;
        if (pn >= 14) {
            const size_t o0 = ((size_t)(u.pm * 8 + (pn - 14)) * 8 * 512 + (size_t)(wr * 4 + wc) * 64 + lane) * 8;
#pragma unroll
            for (int ai = 0; ai < 2; ++ai)
#pragma unroll
                for (int m = 0; m < 4; ++m) { f32x4 r0, r1, b0, b1;
#pragma unroll
                    for (int j = 0; j < 4; ++j) { b0[j] = fmaxf(sigm(acc[ai][1][m][0][j]), 1e-30f); b1[j] = fmaxf(sigm(acc[ai][1][m][1][j]), 1e-30f);
                        r0[j] = sigm(acc[ai][0][m][0][j]) * __builtin_amdgcn_rcpf(b0[j]); r1[j] = sigm(acc[ai][0][m][1][j]) * __builtin_amdgcn_rcpf(b1[j]); }
                    const size_t o = o0 + (size_t)(ai * 4 + m) * 512 * 8;
                    *(u32x4*)(SGA + o) = pack_row8(r0, r1); *(u32x4*)(SGB + o) = pack_row8(b0, b1); __builtin_amdgcn_sched_barrier(0); }
            return;
        }
        const int seg = pn >> 1, col0 = (pn & 1) * 256 + cw;
        if (seg == 1) {
#pragma unroll
            for (int bj = 0; bj < 2; ++bj) {
                float lb[2][4];
#pragma unroll
                for (int n = 0; n < 2; ++n)
#pragma unroll
                    for (int j = 0; j < 4; ++j) { const int c = col0 + bj * 128 + 4 * n + j; lb[n][j] = __builtin_amdgcn_rcpf(1.f + __expf(lbl[512 + c] - lbl[c])); }
#pragma unroll
                for (int ai = 0; ai < 2; ++ai) {
                    const size_t rbase = ((size_t)((pn & 1) * 2 + bj) * T + (u.pm * 256 + ai * 128 + wr * 64 + launder(fr))) * 128 + cw;
#pragma unroll
                    for (int m = 0; m < 4; ++m) { f32x4 k0, k1;
#pragma unroll
                        for (int j = 0; j < 4; ++j) {
                            float f = lb[0][j] + (1.f - lb[0][j]) * sigm(acc[ai][bj][m][0][j]); k0[j] = 1.f - f; acc[ai][bj][m][0][j] = __logf(f);
                            f = lb[1][j] + (1.f - lb[1][j]) * sigm(acc[ai][bj][m][1][j]); k1[j] = 1.f - f; acc[ai][bj][m][1][j] = __logf(f); }
                        *(u32x4*)(KA + rbase + (size_t)m * 16 * 128) = pack_row8(k0, k1); }
                    __builtin_amdgcn_sched_barrier(0);
#pragma unroll
                    for (int n = 0; n < 2; ++n)
#pragma unroll
                        for (int j = 0; j < 4; ++j) { float carry = 0.f;
#pragma unroll
                            for (int m = 0; m < 4; ++m) { float v = acc[ai][bj][m][n][j];
                                v += __int_as_float(__builtin_amdgcn_update_dpp(0, __float_as_int(v), 0x111, 0xf, 0xf, false));
                                v += __int_as_float(__builtin_amdgcn_update_dpp(0, __float_as_int(v), 0x112, 0xf, 0xf, false));
                                v += __int_as_float(__builtin_amdgcn_update_dpp(0, __float_as_int(v), 0x114, 0xf, 0xf, false));
                                v += __int_as_float(__builtin_amdgcn_update_dpp(0, __float_as_int(v), 0x118, 0xf, 0xf, false));
                                v += carry; carry = __shfl(v, lane | 15); acc[ai][bj][m][n][j] = v; } }
                    __builtin_amdgcn_sched_barrier(0);
#pragma unroll
                    for (int m = 0; m < 4; ++m) { float* cp = CUM + rbase + (size_t)m * 16 * 128; *(f32x4*)cp = acc[ai][bj][m][0]; *(f32x4*)(cp + 4) = acc[ai][bj][m][1]; }
                    if (fr == 15) {
#pragma unroll
                        for (int n = 0; n < 2; ++n) { f32x4 e;
#pragma unroll
                            for (int j = 0; j < 4; ++j) e[j] = __expf(acc[ai][bj][3][n][j]);
                            *(f32x4*)(DEC + (size_t)(u.pm * 4 + ai * 2 + wr) * 512 + col0 + bj * 128 + 4 * n) = e; } }
                    __builtin_amdgcn_sched_barrier(0);
                }
            }
            return;
        }
        bf16_t* dst; int pitch = 512; size_t bjoff = 128; float* o32 = nullptr;
        switch (seg) {
            case 0: dst = QOB + col0; pitch = 1024; break;
            case 2: dst = VA + (size_t)((pn & 1) * 2) * T * 128 + cw; pitch = 128; bjoff = (size_t)T * 128; break;
            case 3: dst = GA + (size_t)((pn & 1) * 2) * T * 128 + cw; pitch = 128; bjoff = (size_t)T * 128; break;
            case 4: dst = QOB + 512 + col0; pitch = 1024; break;
            default: dst = (seg == 5 ? KB : VB) + (size_t)((pn & 1) * 4 + (wc >> 1)) * T * 64 + (wc & 1) * 32 + 8 * fq; pitch = 64; bjoff = (size_t)2 * T * 64; break;
        }
        if (seg >= 5) {
            if (u.pm >= 128) o32 = out + (seg == 5 ? OFF_KS : OFF_VS) + (size_t)((u.pm - 128) * 256 + rt) * 512 + col0;
            else if ((u.pm & 63) >= 62) o32 = out + (seg == 5 ? OFF_KP : OFF_VP) + (size_t)((u.pm >> 6) * 512 + ((u.pm & 63) - 62) * 256 + rt) * 512 + col0;
        }
        const bool act = (seg == 0 || seg == 3);
#pragma unroll
        for (int ai = 0; ai < 2; ++ai)
#pragma unroll
            for (int m = 0; m < 4; ++m)
#pragma unroll
                for (int bj = 0; bj < 2; ++bj) { f32x4 v0 = acc[ai][bj][m][0], v1 = acc[ai][bj][m][1];
                    if (act) {
#pragma unroll
                        for (int j = 0; j < 4; ++j) { v0[j] = silu(v0[j]); v1[j] = silu(v1[j]); } }
                    *(u32x4*)(dst + (size_t)(row0 + ai * 128 + m * 16) * pitch + bj * bjoff) = pack_row8(v0, v1);
                    if (o32) { float* op = o32 + (size_t)(ai * 128 + m * 16) * 512 + bj * 128; *(f32x4*)op = v0; *(f32x4*)(op + 4) = v1; } __builtin_amdgcn_sched_barrier(0); }
    }
};

struct EpiMerge {
    static constexpr bool PERM = true, MIDK = true;
    const bf16_t *SGR, *SGB; bf16_t* Mo;
    DI void mid(Acc& acc, const Unit& u, int wr, int wc, int fr, int fq) const {
        { const int t_ = fresh_tid(); fr = t_ & 15; fq = (t_ >> 4) & 3; }
        const size_t gb = ((size_t)(u.pm * 8 + 2 * u.pn) * 8 * 512 + (size_t)(wr * 4 + wc) * 64 + (fq * 16 + fr)) * 8;
#pragma unroll
        for (int ai = 0; ai < 2; ++ai) { u32x4 a[4][2];
#pragma unroll
            for (int m = 0; m < 4; ++m)
#pragma unroll
                for (int bj = 0; bj < 2; ++bj) a[m][bj] = *(const u32x4*)(SGR + gb + ((size_t)bj * 8 + ai * 4 + m) * 512 * 8);
#pragma unroll
            for (int m = 0; m < 4; ++m)
#pragma unroll
                for (int bj = 0; bj < 2; ++bj)
#pragma unroll
                    for (int j = 0; j < 4; ++j) { acc[ai][bj][m][j >> 1][(j & 1) * 2] *= bflo(a[m][bj][j]); acc[ai][bj][m][j >> 1][(j & 1) * 2 + 1] *= bfhi(a[m][bj][j]); }
            __builtin_amdgcn_sched_barrier(0); }
    }
    DI void operator()(Acc& acc, const Unit& u, int wr, int wc, int fr, int fq) const {
        { const int t_ = fresh_tid(); fr = t_ & 15; fq = (t_ >> 4) & 3; }
        const size_t base = (size_t)(u.pm * 256 + wr * 64 + fr) * 1024 + u.pn * 256 + wc * 32 + 8 * fq;
        const size_t gb = ((size_t)(u.pm * 8 + 2 * u.pn) * 8 * 512 + (size_t)(wr * 4 + wc) * 64 + (fq * 16 + fr)) * 8;
#pragma unroll
        for (int ai = 0; ai < 2; ++ai) { u32x4 b[4][2];
#pragma unroll
            for (int m = 0; m < 4; ++m)
#pragma unroll
                for (int bj = 0; bj < 2; ++bj) b[m][bj] = *(const u32x4*)(SGB + gb + ((size_t)bj * 8 + ai * 4 + m) * 512 * 8);
#pragma unroll
            for (int m = 0; m < 4; ++m)
#pragma unroll
                for (int bj = 0; bj < 2; ++bj) { f32x4 v0 = acc[ai][bj][m][0], v1 = acc[ai][bj][m][1]; const u32x4 g = b[m][bj];
                    v0[0] *= bflo(g[0]); v0[1] *= bfhi(g[0]); v0[2] *= bflo(g[1]); v0[3] *= bfhi(g[1]);
                    v1[0] *= bflo(g[2]); v1[1] *= bfhi(g[2]); v1[2] *= bflo(g[3]); v1[3] *= bfhi(g[3]);
                    *(u32x4*)(Mo + base + (size_t)(ai * 128 + m * 16) * 1024 + bj * 128) = pack_row8(v0, v1); }
            __builtin_amdgcn_sched_barrier(0); }
    }
};

template <bool BASE_BF16> struct EpiRes {
    static constexpr bool PERM = true, MIDK = false;
    const float *xp, *xs; const bf16_t* xb; bf16_t* xo; const float* gmod;
    DI void operator()(Acc& acc, const Unit& u, int wr, int wc, int fr, int fq) const {
        { const int t_ = fresh_tid(); fr = t_ & 15; fq = (t_ >> 4) & 3; }
        const int colb = u.pn * 256 + wc * 32 + 8 * fq;
#pragma unroll
        for (int ai = 0; ai < 2; ++ai) { const int r0 = u.pm * 256 + ai * 128 + wr * 64 + fr;
            const float* g = gmod + (size_t)batch_of(r0) * 6144 + colb;
            f32x4 gv[2][2];
#pragma unroll
            for (int bj = 0; bj < 2; ++bj) { gv[bj][0] = *(const f32x4*)(g + bj * 128); gv[bj][1] = *(const f32x4*)(g + bj * 128 + 4); }
            bf16_t* orow = xo + (size_t)r0 * D + colb;
            if constexpr (BASE_BF16) {
                const bf16_t* xr = xb + (size_t)r0 * D + colb; u32x4 xv[4][2];
#pragma unroll
                for (int m = 0; m < 4; ++m)
#pragma unroll
                    for (int bj = 0; bj < 2; ++bj) xv[m][bj] = *(const u32x4*)(xr + (size_t)m * 16 * D + bj * 128);
#pragma unroll
                for (int m = 0; m < 4; ++m)
#pragma unroll
                    for (int bj = 0; bj < 2; ++bj) { const u32x4 x = xv[m][bj]; const f32x4 a0 = acc[ai][bj][m][0] * gv[bj][0], a1 = acc[ai][bj][m][1] * gv[bj][1];
                        f32x4 v0 = {bflo(x[0]) + a0[0], bfhi(x[0]) + a0[1], bflo(x[1]) + a0[2], bfhi(x[1]) + a0[3]}, v1 = {bflo(x[2]) + a1[0], bfhi(x[2]) + a1[1], bflo(x[3]) + a1[2], bfhi(x[3]) + a1[3]};
                        *(u32x4*)(orow + (size_t)m * 16 * D + bj * 128) = pack_row8(v0, v1); }
            } else {
                const float* xr = (r0 < TP ? xp + (size_t)r0 * D : xs + (size_t)(r0 - TP) * D) + colb; f32x4 xv[4][2][2];
#pragma unroll
                for (int m = 0; m < 4; ++m)
#pragma unroll
                    for (int bj = 0; bj < 2; ++bj) { xv[m][bj][0] = *(const f32x4*)(xr + (size_t)m * 16 * D + bj * 128); xv[m][bj][1] = *(const f32x4*)(xr + (size_t)m * 16 * D + bj * 128 + 4); }
#pragma unroll
                for (int m = 0; m < 4; ++m)
#pragma unroll
                    for (int bj = 0; bj < 2; ++bj) *(u32x4*)(orow + (size_t)m * 16 * D + bj * 128) = pack_row8(xv[m][bj][0] + gv[bj][0] * acc[ai][bj][m][0], xv[m][bj][1] + gv[bj][1] * acc[ai][bj][m][1]);
            }
            __builtin_amdgcn_sched_barrier(0); }
    }
};

struct EpiPart {
    static constexpr bool PERM = false, MIDK = false;
    float* part; int row0;
    DI void operator()(Acc& acc, const Unit& u, int wr, int wc, int fr, int fq) const {
        { const int t_ = fresh_tid(); fr = t_ & 15; fq = (t_ >> 4) & 3; }
#pragma unroll
        for (int ai = 0; ai < 2; ++ai)
#pragma unroll
            for (int m = 0; m < 4; ++m) { float* prow = part + (size_t)(u.pm * 256 + ai * 128 + wr * 64 + m * 16 + fr - row0) * D + u.pn * 256 + wc * 32 + 4 * fq;
#pragma unroll
                for (int bj = 0; bj < 2; ++bj)
#pragma unroll
                    for (int n = 0; n < 2; ++n) *(f32x4*)(prow + bj * 128 + n * 16) = acc[ai][bj][m][n];
                __builtin_amdgcn_sched_barrier(0); }
    }
};

struct EpiFfnIn {
    static constexpr bool PERM = true, MIDK = false;
    bf16_t* HID;
    DI void operator()(Acc& acc, const Unit& u, int wr, int wc, int fr, int fq) const {
        { const int t_ = fresh_tid(); fr = t_ & 15; fq = (t_ >> 4) & 3; }
        bf16_t* base = HID + (size_t)(u.pm * 256 + wr * 64 + fr) * FF + u.pn * 128 + wc * 32 + 8 * fq;
#pragma unroll
        for (int ai = 0; ai < 2; ++ai)
#pragma unroll
            for (int m = 0; m < 4; ++m) { f32x4 v0, v1;
#pragma unroll
                for (int j = 0; j < 4; ++j) { v0[j] = silu(acc[ai][0][m][0][j]) * acc[ai][1][m][0][j]; v1[j] = silu(acc[ai][0][m][1][j]) * acc[ai][1][m][1][j]; }
                *(u32x4*)(base + (size_t)(ai * 128 + m * 16) * FF) = pack_row8(v0, v1); __builtin_amdgcn_sched_barrier(0); }
    }
};

DI void transpose_item(const float* W, int N, bf16_t* WT, int pitch, int koff, int k0, int n0, int drow0, LAS float* scr, int lane) {
#pragma unroll
    for (int i = 0; i < 32; ++i) { const int kk = 2 * i + (lane >> 5); scr[kk * 33 + (lane & 31)] = W[(size_t)(k0 + kk) * N + n0 + (lane & 31)]; }
    asm volatile("s_waitcnt lgkmcnt(0)" ::: "memory");
    const int c = lane & 7;
#pragma unroll
    for (int j = 0; j < 4; ++j) { const int n = (lane >> 3) + 8 * j; const LAS float* s = scr + (8 * c) * 33 + n;
        u32x4 o; o.x = pk2(s[0 * 33], s[1 * 33]); o.y = pk2(s[2 * 33], s[3 * 33]); o.z = pk2(s[4 * 33], s[5 * 33]); o.w = pk2(s[6 * 33], s[7 * 33]);
        *(u32x4*)(WT + (size_t)(drow0 + n) * pitch + koff + k0 + 8 * c) = o; }
    asm volatile("s_waitcnt lgkmcnt(0)" ::: "memory");
}
DI void phase_prep(const Params& p, LAS unsigned char* lds) {
    const int tid = fresh_tid(), lane = tid & 63, wave = __builtin_amdgcn_readfirstlane(tid >> 6);
    LAS float* scr = (LAS float*)(lds + wave * 16384);
    const int gw = blockIdx.x * 8 + wave, NGW = gridDim.x * 8;
    unsigned char* ws = p.ws;
    constexpr int I_ADA = 16 * 192, I_IN = 16 * 176, I_A = 8 * 32, I_O = 16 * 32, I_FI = 16 * 176, I_FO = 44 * 32;
    constexpr int NIT = I_ADA + I_IN + 2 * I_A + I_O + I_FI + I_FO;
    for (int it = gw; it < NIT; it += NGW) {
        int r = it;
        if (r < I_ADA) { const int kb = r / 192, nb = r % 192; transpose_item(p.w_ada, 6144, (bf16_t*)(ws + WS_WADA), 1024, 0, 64 * kb, 32 * nb, 32 * nb, scr, lane); continue; } r -= I_ADA;
        if (r < I_IN) { const int kb = r / 176, nb = r % 176, n0 = 32 * nb; int dr = n0;
            if (n0 >= 3584) { const int j = n0 < 4608 ? n0 - 3584 : n0 - 4608; dr = 3584 + 256 * (j >> 7) + (j & 127) + (n0 < 4608 ? 0 : 128); }
            transpose_item(p.w_in, INC, (bf16_t*)(ws + WS_WIN), 1024, 0, 64 * kb, n0, dr, scr, lane); continue; } r -= I_IN;
        if (r < I_A) { const int kb = r / 32, nb = r % 32; transpose_item(p.w_a, 1024, (bf16_t*)(ws + WS_WAB), 1024, 0, 64 * kb, 32 * nb, 32 * nb, scr, lane); continue; } r -= I_A;
        if (r < I_A) { const int kb = r / 32, nb = r % 32; transpose_item(p.w_b, 1024, (bf16_t*)(ws + WS_WAB), 1024, 512, 64 * kb, 32 * nb, 32 * nb, scr, lane); continue; } r -= I_A;
        if (r < I_O) { const int kb = r / 32, nb = r % 32; transpose_item(p.w_out, 1024, (bf16_t*)(ws + WS_WO), 1024, 0, 64 * kb, 32 * nb, 32 * nb, scr, lane); continue; } r -= I_O;
        if (r < I_FI) { const int kb = r / 176, nb = r % 176; const int n0 = 32 * nb; const int j0 = n0 < FF ? n0 : n0 - FF;
            transpose_item(p.w_ffn_in, INC, (bf16_t*)(ws + WS_WFI), 1024, 0, 64 * kb, n0, 256 * (j0 >> 7) + (j0 & 127) + (n0 < FF ? 0 : 128), scr, lane); continue; } r -= I_FI;
        { const int kb = r / 32, nb = r % 32; transpose_item(p.w_ffn_out, 1024, (bf16_t*)(ws + WS_WFO), FF, 0, 64 * kb, 32 * nb, 32 * nb, scr, lane); }
    }
    bf16_t* SC = (bf16_t*)(ws + WS_SC);
    for (int i = blockIdx.x * 512 + tid; i < 256 * 1024 / 2; i += gridDim.x * 512) { const int row = (2 * i) >> 10, col = (2 * i) & 1023; float a = 0.f, b = 0.f;
        if (row < NBATCH) { const float* c = row < 2 ? p.c_prompt + row * D : p.c_sample + (row - 2) * D; a = silu(c[col]); b = silu(c[col + 1]); }
        ((unsigned*)SC)[i] = pk2(a, b); }
}

DI float wave_sum(float v) {
#pragma unroll
    for (int o = 1; o < 64; o <<= 1) v += __shfl_xor(v, o);
    return v;
}
DI void phase_norm_mod(const float* xp, const float* xs, const float* nw, const float* mod, int sh_off, int sc_off, bf16_t* H) {
    const int tid = fresh_tid(), lane = tid & 63, wave = __builtin_amdgcn_readfirstlane(tid >> 6);
    const int gw = blockIdx.x * 8 + wave, NGW = gridDim.x * 8;
    for (int r = gw; r < T; r += NGW) {
        const float* xr = r < TP ? xp + (size_t)r * D : xs + (size_t)(r - TP) * D; const float* mb = mod + (size_t)batch_of(r) * 6144;
        f32x4 v[4]; float s = 0.f;
#pragma unroll
        for (int j = 0; j < 4; ++j) { v[j] = *(const f32x4*)(xr + 4 * lane + 256 * j); s += (v[j][0] * v[j][0] + v[j][1] * v[j][1]) + (v[j][2] * v[j][2] + v[j][3] * v[j][3]); }
        const float rstd = __builtin_amdgcn_rsqf(wave_sum(s) * (1.f / D) + EPS);
#pragma unroll
        for (int j = 0; j < 4; ++j) { const int col = 4 * lane + 256 * j; const f32x4 w = *(const f32x4*)(nw + col), sc = *(const f32x4*)(mb + sc_off + col), sh = *(const f32x4*)(mb + sh_off + col);
            const f32x4 h = v[j] * rstd * w * (sc + 1.f) + sh; u32x2 o; o.x = pk2(h[0], h[1]); o.y = pk2(h[2], h[3]);
            *(u32x2*)(H + (size_t)r * D + col) = o; }
    }
}
DI void phase_norm_mod_b(const bf16_t* xb, const float* nw, const float* mod, int sh_off, int sc_off, bf16_t* H, int r_lo = 0, int r_hi = T, int b_lo = 0) {
    const int tid = fresh_tid(), lane = tid & 63, wave = __builtin_amdgcn_readfirstlane(tid >> 6);
    const int gw = ((int)blockIdx.x - b_lo) * 8 + wave, NGW = ((int)gridDim.x - b_lo) * 8;
    for (int r = r_lo + gw; r < r_hi; r += NGW) {
        const bf16_t* xr = xb + (size_t)r * D; const float* mb = mod + (size_t)batch_of(r) * 6144;
        float v[2][8]; float s = 0.f;
#pragma unroll
        for (int j = 0; j < 2; ++j) { const u32x4 x = *(const u32x4*)(xr + 8 * lane + 512 * j);
#pragma unroll
            for (int i = 0; i < 4; ++i) { v[j][2 * i] = bflo(x[i]); v[j][2 * i + 1] = bfhi(x[i]); s += v[j][2 * i] * v[j][2 * i] + v[j][2 * i + 1] * v[j][2 * i + 1]; } }
        const float rstd = __builtin_amdgcn_rsqf(wave_sum(s) * (1.f / D) + EPS);
#pragma unroll
        for (int j = 0; j < 2; ++j) { const int col = 8 * lane + 512 * j; f32x4 h[2];
#pragma unroll
            for (int q = 0; q < 2; ++q) { const f32x4 w = *(const f32x4*)(nw + col + 4 * q), sc = *(const f32x4*)(mb + sc_off + col + 4 * q), sh = *(const f32x4*)(mb + sh_off + col + 4 * q);
                const f32x4 x = {v[j][4 * q], v[j][4 * q + 1], v[j][4 * q + 2], v[j][4 * q + 3]}; h[q] = x * rstd * w * (sc + 1.f) + sh; }
            *(u32x4*)(H + (size_t)r * D + col) = pack_row8(h[0], h[1]); }
    }
}
DI void phase_final_norm(const bf16_t* xb, float* y, const float* nw, int r_lo = 0, int r_hi = T, int b_lo = 0) {
    const int tid = fresh_tid(), lane = tid & 63, wave = __builtin_amdgcn_readfirstlane(tid >> 6);
    const int gw = ((int)blockIdx.x - b_lo) * 8 + wave, NGW = ((int)gridDim.x - b_lo) * 8;
    for (int r = r_lo + gw; r < r_hi; r += NGW) { const bf16_t* xr = xb + (size_t)r * D; float* yr = y + (size_t)r * D;
        float v[2][8]; float s = 0.f;
#pragma unroll
        for (int j = 0; j < 2; ++j) { const u32x4 x = *(const u32x4*)(xr + 8 * lane + 512 * j);
#pragma unroll
            for (int i = 0; i < 4; ++i) { v[j][2 * i] = bflo(x[i]); v[j][2 * i + 1] = bfhi(x[i]); s += v[j][2 * i] * v[j][2 * i] + v[j][2 * i + 1] * v[j][2 * i + 1]; } }
        const float rstd = __builtin_amdgcn_rsqf(wave_sum(s) * (1.f / D) + EPS);
#pragma unroll
        for (int j = 0; j < 2; ++j) { const int col = 8 * lane + 512 * j;
#pragma unroll
            for (int q = 0; q < 2; ++q) { const f32x4 x = {v[j][4 * q], v[j][4 * q + 1], v[j][4 * q + 2], v[j][4 * q + 3]}; *(f32x4*)(yr + col + 4 * q) = x * rstd * *(const f32x4*)(nw + col + 4 * q); } }
    }
}

DI void phase_final_norm_parts(const bf16_t* x1b, const float* part0, const float* part1, const float* g2mod, float* y, const float* nw) {
    const int tid = fresh_tid(), lane = tid & 63, wave = __builtin_amdgcn_readfirstlane(tid >> 6);
    const int gw = blockIdx.x * 8 + wave, NGW = gridDim.x * 8;
    for (int r = TP + gw; r < T; r += NGW) { const float* gb = g2mod + (size_t)batch_of(r) * 6144; const size_t po = (size_t)(r - TP) * D;
        f32x4 v[4]; float s = 0.f;
#pragma unroll
        for (int j = 0; j < 4; ++j) { const int col = 4 * lane + 256 * j; const u32x2 xb = *(const u32x2*)(x1b + (size_t)r * D + col);
            const f32x4 x = {bflo(xb.x), bfhi(xb.x), bflo(xb.y), bfhi(xb.y)};
            v[j] = x + *(const f32x4*)(gb + col) * (*(const f32x4*)(part0 + po + col) + *(const f32x4*)(part1 + po + col));
            s += (v[j][0] * v[j][0] + v[j][1] * v[j][1]) + (v[j][2] * v[j][2] + v[j][3] * v[j][3]); }
        const float rstd = __builtin_amdgcn_rsqf(wave_sum(s) * (1.f / D) + EPS);
#pragma unroll
        for (int j = 0; j < 4; ++j) { const int col = 4 * lane + 256 * j; *(f32x4*)(y + (size_t)r * D + col) = v[j] * rstd * *(const f32x4*)(nw + col); }
    }
}

DI void hgrn_u_item(const Params& p, int item, int lane) {
    const int c = item >> 5, rem = item & 31, h = rem >> 3, kt = (rem >> 1) & 3, vh = rem & 1, l31 = lane & 31, hf = lane >> 5;
    const float* CUM = (const float*)(p.ws + WS_CUM); const bf16_t* KA = (const bf16_t*)(p.ws + WS_KA); const bf16_t* VA = (const bf16_t*)(p.ws + WS_VA); bf16_t* U = (bf16_t*)(p.ws + WS_U);
    const size_t hb = (size_t)h * T * 128; const int kcol = 32 * kt + l31;
    const float tot = CUM[hb + (size_t)(c * 64 + 63) * 128 + kcol];
    bf16x8 kdf[2][2];
#pragma unroll
    for (int st = 0; st < 2; ++st) { f32x16 kd;
#pragma unroll
        for (int r = 0; r < 16; ++r) { const size_t idx = hb + (size_t)(c * 64 + 32 * st + crow(r, hf)) * 128 + kcol; kd[r] = bf2f((short)KA[idx]) * __expf(tot - CUM[idx]); }
        kdf[st][0] = pack8(kd, 0); kdf[st][1] = pack8(kd, 1); }
    const bf16x8 id0 = ident_frag(0, l31, hf), id1 = ident_frag(1, l31, hf);
#pragma unroll
    for (int vtl = 0; vtl < 2; ++vtl) { const int vt = 2 * vh + vtl; f32x16 dacc = zero16();
#pragma unroll
        for (int st = 0; st < 2; ++st) { const bf16_t* vp = VA + hb + (size_t)(c * 64 + 32 * st + l31) * 128 + 32 * vt + 8 * hf;
            f32x16 vx = zero16(); vx = MFMA32(*(const bf16x8*)vp, id0, vx); vx = MFMA32(*(const bf16x8*)(vp + 16), id1, vx);
            dacc = MFMA32(kdf[st][0], pack8(vx, 0), dacc); dacc = MFMA32(kdf[st][1], pack8(vx, 1), dacc); }
        bf16_t* up = U + ((size_t)(c * 4 + h) * 128 + 32 * vt + l31) * 128 + 32 * kt + 4 * hf;
#pragma unroll
        for (int g = 0; g < 4; ++g) { u32x2 o; o.x = pk2(dacc[4 * g], dacc[4 * g + 1]); o.y = pk2(dacc[4 * g + 2], dacc[4 * g + 3]); *(u32x2*)(up + 8 * g) = o; }
    }
}

DI void scan_prompt_item(const Params& p, int item, int lane) {
    const int bh = item >> 5, vq = item & 31, b = bh >> 2, h = bh & 3, kg = lane & 31, vv = lane >> 5;
    const float* __restrict__ DEC = (const float*)(p.ws + WS_DEC); const bf16_t* __restrict__ U = (const bf16_t*)(p.ws + WS_U); bf16_t* __restrict__ SST = (bf16_t*)(p.ws + WS_SST);
    f32x4 S0 = {0.f, 0.f, 0.f, 0.f}, S1 = {0.f, 0.f, 0.f, 0.f};
    const int v0 = 4 * vq + vv, v1 = v0 + 2;
#pragma unroll 16
    for (int n = 0; n < 256; ++n) { const int c = b * 256 + n;
        const f32x4 d = *(const f32x4*)(DEC + (size_t)c * 512 + h * 128 + 4 * kg);
        const size_t o0 = ((size_t)(c * 4 + h) * 128 + v0) * 128 + 4 * kg, o1 = ((size_t)(c * 4 + h) * 128 + v1) * 128 + 4 * kg;
        const u32x2 u0 = *(const u32x2*)(U + o0), u1 = *(const u32x2*)(U + o1);
        u32x2 s; s.x = pk2(S0[0], S0[1]); s.y = pk2(S0[2], S0[3]); *(u32x2*)(SST + o0) = s;
        s.x = pk2(S1[0], S1[1]); s.y = pk2(S1[2], S1[3]); *(u32x2*)(SST + o1) = s;
        S0[0] = d[0] * S0[0] + bflo(u0.x); S0[1] = d[1] * S0[1] + bfhi(u0.x); S0[2] = d[2] * S0[2] + bflo(u0.y); S0[3] = d[3] * S0[3] + bfhi(u0.y);
        S1[0] = d[0] * S1[0] + bflo(u1.x); S1[1] = d[1] * S1[1] + bfhi(u1.x); S1[2] = d[2] * S1[2] + bflo(u1.y); S1[3] = d[3] * S1[3] + bfhi(u1.y);
    }
    float* sp = p.out + OFF_SP + ((size_t)bh * 128 + 4 * kg) * 128;
#pragma unroll
    for (int i = 0; i < 4; ++i) { sp[(size_t)i * 128 + v0] = S0[i]; sp[(size_t)i * 128 + v1] = S1[i]; }
}
DI void scan_sample_item(const Params& p, int item, int lane) {
    const int bh = item >> 5, vq = item & 31, bs = bh >> 2, h = bh & 3, kg = lane & 31, vv = lane >> 5, c = 512 + bs;
    const float* DEC = (const float*)(p.ws + WS_DEC); const bf16_t* U = (const bf16_t*)(p.ws + WS_U); bf16_t* SST = (bf16_t*)(p.ws + WS_SST);
    const f32x4 d = *(const f32x4*)(DEC + (size_t)c * 512 + h * 128 + 4 * kg);
    const float* s0 = p.state + ((size_t)bh * 128 + 4 * kg) * 128; float* so = p.out + OFF_SS + ((size_t)bh * 128 + 4 * kg) * 128;
#pragma unroll
    for (int e = 0; e < 2; ++e) { const int v = 4 * vq + 2 * e + vv; const size_t o = ((size_t)(c * 4 + h) * 128 + v) * 128 + 4 * kg;
        const u32x2 u = *(const u32x2*)(U + o); f32x4 S;
#pragma unroll
        for (int i = 0; i < 4; ++i) S[i] = s0[(size_t)i * 128 + v];
        u32x2 s; s.x = pk2(S[0], S[1]); s.y = pk2(S[2], S[3]); *(u32x2*)(SST + o) = s;
        so[v] = d[0] * S[0] + bflo(u.x); so[128 + v] = d[1] * S[1] + bfhi(u.x); so[256 + v] = d[2] * S[2] + bflo(u.y); so[384 + v] = d[3] * S[3] + bfhi(u.y); }
}

DI void attn_item(const Params& p, int item, int lane, const LAS float* biasl) {
    const int c = item >> 3, h = item & 7, l31 = lane & 31, hf = lane >> 5;
    const bf16_t* KB = (const bf16_t*)(p.ws + WS_KB); const bf16_t* VB = (const bf16_t*)(p.ws + WS_VB);
    bf16x8 qf[2][4];
    { const bf16_t* qptr = (const bf16_t*)(p.ws + WS_QOB) + (size_t)(c * 64 + l31) * 1024 + 512 + h * 64;
#pragma unroll
    for (int qq = 0; qq < 2; ++qq)
#pragma unroll
        for (int ks = 0; ks < 4; ++ks) qf[qq][ks] = *(const bf16x8*)(qptr + (size_t)qq * 32 * 1024 + 16 * ks + 8 * hf); }
    const LAS float* bl = biasl + h * 192;
    f32x16 OT[2][2]; float mrun[2], lsum[2];
#pragma unroll
    for (int qq = 0; qq < 2; ++qq) { OT[qq][0] = zero16(); OT[qq][1] = zero16(); mrun[qq] = -1e30f; lsum[qq] = 0.f; }
    int ntile, ncache, db0, krow_first;
    if (c < 512) { const int n = c & 255, j0 = n < 8 ? n : 8; ntile = 2 * (j0 + 1); ncache = 0; db0 = 64 * j0; krow_first = (c - j0) * 64; }
    else { ntile = 18; ncache = 16; db0 = 512; krow_first = c * 64 - 512; }
    const int bs = c - 512;
    u32x4 nk[4], nv[4];
#define ATT_LOAD(i_) do { if ((i_) >= ncache) { const size_t ro_ = ((size_t)h * T + (size_t)(krow_first + 32 * (i_) + l31)) * 64 + 8 * hf; \
            _Pragma("unroll") for (int ks = 0; ks < 4; ++ks) { nk[ks] = *(const u32x4*)(KB + ro_ + 16 * ks); nv[ks] = *(const u32x4*)(VB + ro_ + 16 * ks); } } } while (0)
    ATT_LOAD(0);
    for (int i = 0; i < ntile; ++i) {
        bf16x8 kf[4], vf[2][2];
        if (i < ncache) {
            const float* kp_ = p.cache_k + ((size_t)(bs * 512 + 32 * i + l31) * 8 + h) * 64 + 8 * hf; const float* vp_ = p.cache_v + ((size_t)(bs * 512 + 32 * i + l31) * 8 + h) * 64 + 8 * hf;
#pragma unroll
            for (int ks = 0; ks < 4; ++ks) { u32x4 w; const f32x4 a = *(const f32x4*)(kp_ + 16 * ks), b = *(const f32x4*)(kp_ + 16 * ks + 4), e = *(const f32x4*)(vp_ + 16 * ks), f = *(const f32x4*)(vp_ + 16 * ks + 4);
                w.x = pk2(a[0], a[1]); w.y = pk2(a[2], a[3]); w.z = pk2(b[0], b[1]); w.w = pk2(b[2], b[3]); kf[ks] = __builtin_bit_cast(bf16x8, w);
                w.x = pk2(e[0], e[1]); w.y = pk2(e[2], e[3]); w.z = pk2(f[0], f[1]); w.w = pk2(f[2], f[3]); vf[ks >> 1][ks & 1] = __builtin_bit_cast(bf16x8, w); }
        } else {
#pragma unroll
            for (int ks = 0; ks < 4; ++ks) { kf[ks] = __builtin_bit_cast(bf16x8, nk[ks]); vf[ks >> 1][ks & 1] = __builtin_bit_cast(bf16x8, nv[ks]); }
        }
        if (i + 1 < ntile) ATT_LOAD(i + 1);
        asm volatile("" ::: "memory");
        bf16x8 vxf[2][2];
        const int l31b = launder(l31); const bf16x8 id0 = ident_frag(0, l31b, hf), id1 = ident_frag(1, l31b, hf);
#pragma unroll
        for (int dt = 0; dt < 2; ++dt) { f32x16 vx = zero16(); vx = MFMA32(vf[dt][0], id0, vx); vx = MFMA32(vf[dt][1], id1, vx); vxf[dt][0] = pack8(vx, 0); vxf[dt][1] = pack8(vx, 1); }
#pragma unroll
        for (int qq = 0; qq < 2; ++qq) {
            f32x16 st = zero16();
#pragma unroll
            for (int ks = 0; ks < 4; ++ks) st = MFMA32(kf[ks], qf[qq][ks], st);
            const int dq = db0 + 32 * qq - 32 * i; float mt = -1e30f;
            if (dq - 31 >= 128) { const float bc = bl[191];
#pragma unroll
                for (int r = 0; r < 16; ++r) { const float s = st[r] * (0.125f * LOG2E) + bc; st[r] = s; mt = fmaxf(mt, s); }
            } else { const int dbase = dq + l31;
#pragma unroll
                for (int r = 0; r < 16; ++r) { int dist = dbase - crow(r, hf); dist = dist > 128 ? 128 : dist; const float s = st[r] * (0.125f * LOG2E) + bl[dist + 63]; st[r] = s; mt = fmaxf(mt, s); }
            }
            mt = fmaxf(mt, __shfl_xor(mt, 32));
            const float mnew = fmaxf(mrun[qq], mt), alpha = __builtin_amdgcn_exp2f(mrun[qq] - mnew); mrun[qq] = mnew;
            float ps = 0.f;
#pragma unroll
            for (int r = 0; r < 16; ++r) { st[r] = __builtin_amdgcn_exp2f(st[r] - mnew); ps += st[r]; }
            lsum[qq] = lsum[qq] * alpha + ps;
#pragma unroll
            for (int r = 0; r < 16; ++r) { OT[qq][0][r] *= alpha; OT[qq][1][r] *= alpha; }
            const bf16x8 pf0 = pack8(st, 0), pf1 = pack8(st, 1);
            OT[qq][0] = MFMA32(vxf[0][0], pf0, OT[qq][0]); OT[qq][0] = MFMA32(vxf[0][1], pf1, OT[qq][0]);
            OT[qq][1] = MFMA32(vxf[1][0], pf0, OT[qq][1]); OT[qq][1] = MFMA32(vxf[1][1], pf1, OT[qq][1]);
        }
    }
#undef ATT_LOAD
    bf16_t* qptr = (bf16_t*)(p.ws + WS_QOB) + (size_t)(c * 64 + launder(l31)) * 1024 + 512 + h * 64;
#pragma unroll
    for (int qq = 0; qq < 2; ++qq) { const float l = lsum[qq] + __shfl_xor(lsum[qq], 32), inv = 1.f / l; bf16_t* op = qptr + (size_t)qq * 32 * 1024;
#pragma unroll
        for (int g = 0; g < 4; ++g) { u32x2 o; o.x = pk2(OT[qq][0][4 * g] * inv, OT[qq][0][4 * g + 1] * inv); o.y = pk2(OT[qq][0][4 * g + 2] * inv, OT[qq][0][4 * g + 3] * inv); *(u32x2*)(op + 8 * g + 4 * hf) = o;
            o.x = pk2(OT[qq][1][4 * g] * inv, OT[qq][1][4 * g + 1] * inv); o.y = pk2(OT[qq][1][4 * g + 2] * inv, OT[qq][1][4 * g + 3] * inv); *(u32x2*)(op + 32 + 8 * g + 4 * hf) = o; } }
}

DI void hgrn_out_item(const Params& p, int item, int lane, bf16_t* obase = nullptr) {
    const int c = item >> 3, h = (item >> 1) & 3, tt = item & 1, l31 = lane & 31, hf = lane >> 5;
    const float* CUM = (const float*)(p.ws + WS_CUM); const bf16_t* KA = (const bf16_t*)(p.ws + WS_KA); const bf16_t* VA = (const bf16_t*)(p.ws + WS_VA);
    const bf16_t* GA = (const bf16_t*)(p.ws + WS_GA); const bf16_t* SST = (const bf16_t*)(p.ws + WS_SST);
    const int trow = c * 64 + 32 * tt + l31;
    bf16_t* qap = (bf16_t*)(p.ws + WS_QOB) + (size_t)trow * 1024 + h * 128;
    const size_t hb = (size_t)h * T * 128;
    const float* cumt = CUM + hb + (size_t)trow * 128; const float* refp = CUM + hb + (size_t)(c * 64 + 32) * 128;
    bf16x8 qd1[8], qd2[8];
#pragma unroll
    for (int ks = 0; ks < 8; ++ks) { const int k0 = 16 * ks + 8 * hf; const bf16x8 q8 = *(const bf16x8*)(qap + k0);
        const f32x4 c0 = *(const f32x4*)(cumt + k0), c1 = *(const f32x4*)(cumt + k0 + 4), r0 = *(const f32x4*)(refp + k0), r1 = *(const f32x4*)(refp + k0 + 4);
        float a[8], b[8];
#pragma unroll
        for (int j = 0; j < 8; ++j) { const float q = bf2f(q8[j]), cu = j < 4 ? c0[j & 3] : c1[j & 3], rf = j < 4 ? r0[j & 3] : r1[j & 3]; a[j] = q * __expf(cu - rf); b[j] = q * __expf(cu); }
        qd1[ks] = pack8f(a); qd2[ks] = pack8f(b); }
    f32x16 OT[4];
#pragma unroll
    for (int vt = 0; vt < 4; ++vt) OT[vt] = zero16();
    const bf16_t* sp = SST + ((size_t)(c * 4 + h) * 128 + l31) * 128 + 8 * hf;
#pragma unroll
    for (int vt = 0; vt < 4; ++vt)
#pragma unroll
        for (int ks = 0; ks < 8; ++ks) OT[vt] = MFMA32(*(const bf16x8*)(sp + (size_t)vt * 32 * 128 + 16 * ks), qd2[ks], OT[vt]);
    const bf16x8 id0 = ident_frag(0, l31, hf), id1 = ident_frag(1, l31, hf);
    for (int st = 0; st <= tt; ++st) {
        const int srow = c * 64 + 32 * st + l31; const bf16_t* kap = KA + hb + (size_t)srow * 128; const float* cums = CUM + hb + (size_t)srow * 128;
        f32x16 X = zero16();
#pragma unroll
        for (int ks = 0; ks < 8; ++ks) { const int k0 = 16 * ks + 8 * hf; const bf16x8 k8 = *(const bf16x8*)(kap + k0);
            const f32x4 c0 = *(const f32x4*)(cums + k0), c1 = *(const f32x4*)(cums + k0 + 4), r0 = *(const f32x4*)(refp + k0), r1 = *(const f32x4*)(refp + k0 + 4);
            float a[8];
#pragma unroll
            for (int j = 0; j < 8; ++j) { const float cu = j < 4 ? c0[j & 3] : c1[j & 3], rf = j < 4 ? r0[j & 3] : r1[j & 3]; a[j] = bf2f(k8[j]) * __expf(rf - cu); }
            X = MFMA32(pack8f(a), qd1[ks], X); }
        if (st == tt) {
#pragma unroll
            for (int r = 0; r < 16; ++r) if (crow(r, hf) > l31) X[r] = 0.f; }
        const bf16x8 xf0 = pack8(X, 0), xf1 = pack8(X, 1);
        const bf16_t* vp = VA + hb + (size_t)srow * 128 + 8 * hf;
#pragma unroll
        for (int vt = 0; vt < 4; ++vt) { f32x16 vx = zero16(); vx = MFMA32(*(const bf16x8*)(vp + 32 * vt), id0, vx); vx = MFMA32(*(const bf16x8*)(vp + 32 * vt + 16), id1, vx);
            OT[vt] = MFMA32(pack8(vx, 0), xf0, OT[vt]); OT[vt] = MFMA32(pack8(vx, 1), xf1, OT[vt]); }
    }
    float ss = 0.f;
#pragma unroll
    for (int vt = 0; vt < 4; ++vt)
#pragma unroll
        for (int r = 0; r < 16; ++r) ss += OT[vt][r] * OT[vt][r];
    ss += __shfl_xor(ss, 32);
    const float rstd = __builtin_amdgcn_rsqf(ss * (1.f / 128.f) + EPS);
    const bf16_t* gap = GA + hb + (size_t)trow * 128; const float* onp = p.out_norm + h * 128;
    if (obase) qap = obase + (size_t)trow * 512 + h * 128;
#pragma unroll
    for (int vt = 0; vt < 4; ++vt)
#pragma unroll
        for (int g = 0; g < 4; ++g) { const int v0 = 32 * vt + 8 * g + 4 * hf; const f32x4 on = *(const f32x4*)(onp + v0); const u32x2 ga = *(const u32x2*)(gap + v0);
            u32x2 o; o.x = pk2(OT[vt][4 * g] * rstd * on[0] * bflo(ga.x), OT[vt][4 * g + 1] * rstd * on[1] * bfhi(ga.x));
            o.y = pk2(OT[vt][4 * g + 2] * rstd * on[2] * bflo(ga.y), OT[vt][4 * g + 3] * rstd * on[3] * bfhi(ga.y)); *(u32x2*)(qap + v0) = o; }
}


#define XB_TMO      128
#define XB_XCNT(j)  (256  + 64 * (j))
#define XB_XSUB(j)  (1280 + 64 * (j))
#define XB_XGEN(j)  (2304 + 64 * (j))
#define XB_TOP      3328
#define XB_TOPGEN   3392
#define XCD_BAR_WORDS 3456
#define XB_SPIN_CAP (1u << 18)
DI unsigned xb_ld(unsigned* p)              { return __hip_atomic_load(p, __ATOMIC_RELAXED, __HIP_MEMORY_SCOPE_AGENT); }
DI unsigned xb_add(unsigned* p, unsigned v) { return __hip_atomic_fetch_add(p, v, __ATOMIC_RELAXED, __HIP_MEMORY_SCOPE_AGENT); }
DI unsigned xb_xcc_id() { return (unsigned)__builtin_amdgcn_s_getreg((3 << 11) | 20) & 0xFu; }
#define XB_SPIN(cond, bar) do { unsigned _sp = 0; while (cond) { __builtin_amdgcn_s_sleep(1); \
    if ((++_sp & 255u) == 0u) { if (xb_ld(&(bar)[XB_TMO])) break; if (_sp > XB_SPIN_CAP) { atomicAdd(&(bar)[XB_TMO], 1u); break; } } } } while (0)
struct XcdBarrier { unsigned* bar; unsigned x; volatile LAS unsigned* st; };
DI XcdBarrier xcd_barrier_post(unsigned* bar, volatile LAS unsigned* st) {
    XcdBarrier b; b.bar = bar; b.x = xb_xcc_id(); b.st = st;
    if (threadIdx.x == 0) (void)xb_add(&bar[XB_XCNT(b.x)], 1u);
    return b;
}
DI void xcd_barrier_complete(unsigned* bar, unsigned x, unsigned& nloc, unsigned& nx) {
    const unsigned G = gridDim.x * gridDim.y * gridDim.z;
    unsigned sum, cnt, mine, sp = 0u;
    for (;;) {
        sum = 0u; cnt = 0u; mine = 0u;
#pragma unroll
        for (unsigned j = 0; j < 16; ++j) { const unsigned c = xb_ld(&bar[XB_XCNT(j)]); sum += c; cnt += (c > 0u) ? 1u : 0u; mine = (j == x) ? c : mine; }
        if (sum == G) break;
        __builtin_amdgcn_s_sleep(1);
        if ((++sp & 255u) == 0u) { if (xb_ld(&bar[XB_TMO])) break; if (sp > XB_SPIN_CAP) { atomicAdd(&bar[XB_TMO], 1u); break; } }
    }
    nloc = mine > 0u ? mine : 1u; nx = cnt > 0u ? cnt : 1u;
}
DI void xcd_barrier(const XcdBarrier& b) {
    asm volatile("s_waitcnt vmcnt(0)" ::: "memory");
    __syncthreads();
    if (threadIdx.x == 0) {
        unsigned* bar = b.bar;
        __builtin_amdgcn_s_waitcnt(0);
        unsigned nloc = b.st[0], nx = b.st[1];
        if (nloc == 0u) { xcd_barrier_complete(bar, b.x, nloc, nx); b.st[0] = nloc; b.st[1] = nx; }
        const unsigned old = xb_add(&bar[XB_XSUB(b.x)], 1u);
        const unsigned gen = old / nloc;
        if (old + 1u == (gen + 1u) * nloc) {
            __builtin_amdgcn_fence(__ATOMIC_RELEASE, "agent");
            asm volatile("s_waitcnt vmcnt(0)" ::: "memory");
            const unsigned og = xb_add(&bar[XB_TOP], 1u);
            const unsigned tg = og / nx;
            if (og + 1u == (tg + 1u) * nx) xb_add(&bar[XB_TOPGEN], 1u);
            else XB_SPIN(xb_ld(&bar[XB_TOPGEN]) == tg, bar);
            __builtin_amdgcn_fence(__ATOMIC_ACQUIRE, "agent");
            xb_add(&bar[XB_XGEN(b.x)], 1u);
            asm volatile("s_waitcnt vmcnt(0)" ::: "memory");
        } else {
            XB_SPIN(xb_ld(&bar[XB_XGEN(b.x)]) == gen, bar);
            __builtin_amdgcn_fence(__ATOMIC_ACQUIRE, "agent");
            asm volatile("s_waitcnt vmcnt(0)" ::: "memory");
        }
    }
    __syncthreads();
}

__global__ void __launch_bounds__(512, 2) fwd_megakernel(Params p) {
    extern __shared__ __attribute__((aligned(16))) unsigned char lds_raw[];
    LAS unsigned char* lds = (LAS unsigned char*)lds_raw;
    cg::grid_group grid = cg::this_grid();
    const int G = gridDim.x, bx = blockIdx.x;
    volatile LAS unsigned* bst = (volatile LAS unsigned*)(lds + LDS_ST_OFF);
    if (threadIdx.x < 2) bst[threadIdx.x] = 0u;
    __syncthreads();
    const XcdBarrier xbar = xcd_barrier_post((unsigned*)(p.ws + WS_BAR), bst);
    if (threadIdx.x == 0) bst[2] = xb_add((unsigned*)(p.ws + WS_BAR) + 3712 + xbar.x, 1u);
#define GRID_BAR() xcd_barrier(xbar)
    unsigned char* ws = p.ws;
    float* MOD = (float*)(ws + WS_MOD); bf16_t* H = (bf16_t*)(ws + WS_H);

    phase_prep(p, lds);
    grid.sync();
    { pg8::Gemm g{(const bf16_t*)(ws + WS_SC), (const bf16_t*)(ws + WS_WADA), 256, 6144, 1024}; pg8::StaticOrder S; S.init(256, 6144, G, bx);
      EpiMod E{MOD, p.b_ada}; pg8::gemm_phase<EpiMod, pg8::StaticOrder, true, true>(lds, g, S, E); }
    GRID_BAR();
    int cv = bx;
    { unsigned* barw = (unsigned*)(p.ws + WS_BAR); bool uni = (G & 7) == 0;
#pragma unroll
      for (int j = 0; j < 16; ++j) { const unsigned c = xb_ld(&barw[XB_XCNT(j)]); uni = uni && (j < 8 ? c == (unsigned)(G >> 3) : c == 0u); }
      if (uni) cv = (int)xbar.x + 8 * (int)bst[2];
      cv = __builtin_amdgcn_readfirstlane(cv); }
    phase_norm_mod(p.x_prompt, p.x_sample, p.norm_mix, MOD, 0, 1024, H);
#if PROBE_DUP == 1
    GRID_BAR(); phase_norm_mod(p.x_prompt, p.x_sample, p.norm_mix, MOD, 0, 1024, H);
#endif
#if PROBE_DUP == 10
    GRID_BAR(); GRID_BAR(); GRID_BAR(); GRID_BAR(); GRID_BAR(); GRID_BAR(); GRID_BAR(); GRID_BAR(); GRID_BAR(); GRID_BAR();
#endif
    GRID_BAR();
    { pg8::Gemm g{H, (const bf16_t*)(ws + WS_WIN), T, INC, 1024}; pg8::StaticOrder S; S.init(T, INC, G, cv);
      EpiIn E{(bf16_t*)(ws + WS_QOB), (bf16_t*)(ws + WS_KA), (bf16_t*)(ws + WS_VA), (bf16_t*)(ws + WS_GA), (bf16_t*)(ws + WS_KB), (bf16_t*)(ws + WS_VB),
              (bf16_t*)(p.out), (bf16_t*)(p.out) + (size_t)T * 1024, (float*)(ws + WS_CUM), (float*)(ws + WS_DEC), p.lb_logits, p.out};
      pg8::gemm_phase<EpiIn, pg8::StaticOrder, true, true>(lds, g, S, E);
#if PROBE_DUP == 2
      GRID_BAR(); pg8::gemm_phase<EpiIn, pg8::StaticOrder, true, true>(lds, g, S, E);
#endif
    }
    GRID_BAR();
    { const int tid = fresh_tid(), lane = tid & 63, wave = __builtin_amdgcn_readfirstlane(tid >> 6);
      for (int it = wave * G + bx; it < NCH * 32; it += 8 * G) hgrn_u_item(p, it, lane);
#if PROBE_DUP == 3
      for (int it = wave * G + bx; it < NCH * 32; it += 8 * G) hgrn_u_item(p, it, lane);
#endif
    }
    GRID_BAR();
    {
        const int tid = fresh_tid(), lane = tid & 63, wave = __builtin_amdgcn_readfirstlane(tid >> 6);
        LAS float* biasl = (LAS float*)lds;
        for (int i = tid; i < 8 * 192; i += 512) biasl[i] = p.rel_bias[i] * LOG2E;
        __syncthreads();
#if PROBE_DUP == 41
        if (wave == 0) { for (int it = bx; it < 256; it += G) scan_prompt_item(p, it, lane); }
        GRID_BAR();
#endif
        if (wave == 0) { for (int it = bx; it < 256; it += G) scan_prompt_item(p, it, lane); }
        else {
            const int gw = (wave - 1) * G + bx, NGW = 7 * G;
            for (int it = gw; it < 4096; it += NGW) scan_sample_item(p, it, lane);
            const int x = (int)xbar.x, ncu = (int)bst[0], nxcc = (int)bst[1], j = (int)bst[2];
            if (nxcc == 8 && x < 8 && ncu > 0 && j < ncu) {
                const int nslot = 7 * ncu, slot = (wave - 1) * ncu + j;
                for (int idx = slot; idx < 68 * 8; idx += nslot) { const int cc = idx >> 3, c = cc < 4 ? 512 + 4 * x + cc : 64 * x + (cc - 4); attn_item(p, c * 8 + (idx & 7), lane, biasl); }
            } else for (int it = gw; it < NCH * 8; it += NGW) attn_item(p, it, lane, biasl);
        }
    }
    GRID_BAR();
    { const int tid = fresh_tid(), lane = tid & 63, wave = __builtin_amdgcn_readfirstlane(tid >> 6);
#if PROBE_DUP == 5
      for (int it = wave * G + bx; it < NCH * 8; it += 8 * G) hgrn_out_item(p, it, lane, (bf16_t*)(ws + WS_U));
      GRID_BAR();
#endif
      for (int it = wave * G + bx; it < NCH * 8; it += 8 * G) hgrn_out_item(p, it, lane); }
    GRID_BAR();
    { pg8::Gemm g{(const bf16_t*)(ws + WS_QOB), (const bf16_t*)(ws + WS_WAB), T, 1024, 1024}; pg8::StaticOrder S; S.init(T, 1024, G, cv);
      EpiMerge E{(const bf16_t*)(p.out), (const bf16_t*)(p.out) + (size_t)T * 1024, (bf16_t*)(ws + WS_M)};
      pg8::gemm_phase<EpiMerge, pg8::StaticOrder, true, true>(lds, g, S, E); }
    GRID_BAR();
    const bool split_ps = G >= 64;
    { pg8::Gemm g{(const bf16_t*)(ws + WS_M), (const bf16_t*)(ws + WS_WO), T, 1024, 1024}; EpiRes<false> E{p.x_prompt, p.x_sample, nullptr, (bf16_t*)(ws + WS_X1B), MOD + 2048};
      if (split_ps) {
        { pg8::StaticOrder S; S.init(TP, 1024, G, cv); pg8::gemm_phase<EpiRes<false>, pg8::StaticOrder, true, true>(lds, g, S, E); }
        GRID_BAR();
        if (bx < 32) { pg8::StaticOrder S; S.init(TS, 1024, 32, bx, TP / 256); pg8::gemm_phase<EpiRes<false>, pg8::StaticOrder, true, true>(lds, g, S, E); }
        else phase_norm_mod_b((const bf16_t*)(ws + WS_X1B), p.norm_ffn, MOD, 3072, 4096, H, 0, TP, 32);
        GRID_BAR();
        phase_norm_mod_b((const bf16_t*)(ws + WS_X1B), p.norm_ffn, MOD, 3072, 4096, H, TP, T, 0);
      } else {
        pg8::StaticOrder S; S.init(T, 1024, G, cv); pg8::gemm_phase<EpiRes<false>, pg8::StaticOrder, true, true>(lds, g, S, E);
        GRID_BAR();
        phase_norm_mod_b((const bf16_t*)(ws + WS_X1B), p.norm_ffn, MOD, 3072, 4096, H);
      } }
    GRID_BAR();
    { pg8::Gemm g{H, (const bf16_t*)(ws + WS_WFI), T, INC, 1024}; pg8::StaticOrder S; S.init(T, INC, G, cv);
      EpiFfnIn E{(bf16_t*)(ws + WS_HID)}; pg8::gemm_phase<EpiFfnIn, pg8::StaticOrder, true, true>(lds, g, S, E);
#if PROBE_DUP == 9
      GRID_BAR(); pg8::gemm_phase<EpiFfnIn, pg8::StaticOrder, true, true>(lds, g, S, E);
#endif
    }
    GRID_BAR();
    { pg8::Gemm g{(const bf16_t*)(ws + WS_HID), (const bf16_t*)(ws + WS_WFO), T, 1024, FF}; EpiRes<true> E{nullptr, nullptr, (const bf16_t*)(ws + WS_X1B), (bf16_t*)(ws + WS_X2B), MOD + 5120};
      if (split_ps) {
        { pg8::StaticOrder S; S.init(TP, 1024, G, cv); pg8::gemm_phase<EpiRes<true>, pg8::StaticOrder, true, true>(lds, g, S, E); }
        GRID_BAR();
        float* PART = (float*)(ws + WS_CUM + 20 * MiB);
        if (bx < 64) { const int ks = bx >> 5; pg8::Gemm gs{(const bf16_t*)(ws + WS_HID) + ks * (FF / 2), (const bf16_t*)(ws + WS_WFO) + ks * (FF / 2), T, 1024, FF / 2, FF};
            pg8::StaticOrder S; S.init(TS, 1024, 32, bx & 31, TP / 256); EpiPart EP{PART + (size_t)ks * TS * D, TP}; pg8::gemm_phase<EpiPart, pg8::StaticOrder, true, true>(lds, gs, S, EP); }
        else phase_final_norm((const bf16_t*)(ws + WS_X2B), p.out, p.norm_final, 0, TP, 64);
        GRID_BAR();
        phase_final_norm_parts((const bf16_t*)(ws + WS_X1B), PART, PART + (size_t)TS * D, MOD + 5120, p.out, p.norm_final);
      } else {
        pg8::StaticOrder S; S.init(T, 1024, G, cv); pg8::gemm_phase<EpiRes<true>, pg8::StaticOrder, true, true>(lds, g, S, E);
        GRID_BAR();
        phase_final_norm((const bf16_t*)(ws + WS_X2B), p.out, p.norm_final);
      } }
}

extern "C" void kernel_launch(void* const* d_in, const int* in_sizes, int n_in, void* d_out, int out_size, void* d_ws, size_t ws_size, hipStream_t stream) {
    static int grid = 0;
    if (grid == 0) {
        if (n_in != 21 || (size_t)out_size != OUT_TOTAL || ws_size < WS_END) { fprintf(stderr, "kernel_launch: unexpected sizes n_in %d out %d ws %zu\n", n_in, out_size, ws_size); grid = -1; return; }
        int dev = 0, cus = 0, per = 0;
        (void)hipGetDevice(&dev); (void)hipDeviceGetAttribute(&cus, hipDeviceAttributeMultiprocessorCount, dev);
        (void)hipFuncSetAttribute((const void*)fwd_megakernel, hipFuncAttributeMaxDynamicSharedMemorySize, LDS_BYTES);
        (void)hipOccupancyMaxActiveBlocksPerMultiprocessor(&per, (const void*)fwd_megakernel, 512, LDS_BYTES);
        if (per < 1) per = 1;
        grid = cus * per; fprintf(stderr, "kernel_launch: grid %d (cus %d x %d)\n", grid, cus, per);
    }
    if (grid < 0) return;
    if (hipMemsetAsync((char*)d_ws + WS_BAR, 0, BAR_BYTES, stream) != hipSuccess) { fprintf(stderr, "kernel_launch: memset failed\n"); return; }
    Params p{};
    const float** f = (const float**)&p;
    for (int i = 0; i < 21; ++i) f[i] = (const float*)d_in[i];
    p.out = (float*)d_out; p.ws = (unsigned char*)d_ws;
    void* args[] = {&p};
    hipError_t e = hipLaunchCooperativeKernel((const void*)fwd_megakernel, dim3(grid), dim3(512), args, LDS_BYTES, stream);
    if (e != hipSuccess) fprintf(stderr, "cooperative launch failed: %s (grid %d)\n", hipGetErrorString(e), grid);
}
```

```cpp
#include <hip/hip_runtime.h>
#include <hip/hip_cooperative_groups.h>
#include <cstdio>
#include <cstdint>
namespace cg = cooperative_groups;
#ifndef PROBE_DUP
#define PROBE_DUP 0
#endif

#define DI __device__ __forceinline__
#define LAS __attribute__((address_space(3)))
typedef unsigned short bf16_t;
typedef short bf16x8 __attribute__((ext_vector_type(8)));
typedef float f32x4 __attribute__((ext_vector_type(4)));
typedef float f32x2 __attribute__((ext_vector_type(2)));
typedef float f32x16 __attribute__((ext_vector_type(16)));
typedef unsigned u32x4 __attribute__((ext_vector_type(4)));
typedef unsigned u32x2 __attribute__((ext_vector_type(2)));
typedef __bf16 bf2_t __attribute__((ext_vector_type(2)));

constexpr int D = 1024, TP = 32768, TS = 2048, T = TP + TS, NCH = T / 64, NBATCH = 34;
constexpr int INC = 5632, FF = 2816;
constexpr float EPS = 1e-6f, LOG2E = 1.4426950408889634f;
constexpr size_t OFF_Y = 0, OFF_SP = (size_t)T * D, OFF_KP = OFF_SP + 131072, OFF_VP = OFF_KP + 524288, OFF_SS = OFF_VP + 524288,
                 OFF_KS = OFF_SS + 2097152, OFF_VS = OFF_KS + 1048576, OUT_TOTAL = OFF_VS + 1048576;
constexpr size_t MiB = 1u << 20;
constexpr size_t WS_MOD = 1 * MiB, WS_DEC = 2 * MiB, WS_SC = 4 * MiB, WS_WADA = 5 * MiB, WS_WIN = 17 * MiB, WS_WAB = 28 * MiB, WS_WO = 30 * MiB,
                 WS_WFI = 32 * MiB, WS_WFO = 43 * MiB, WS_H = 50 * MiB, WS_QOB = 118 * MiB, WS_KA = 186 * MiB, WS_VA = 220 * MiB, WS_GA = 254 * MiB,
                 WS_KB = 288 * MiB, WS_VB = 322 * MiB, WS_CUM = 356 * MiB, WS_SST = 424 * MiB, WS_END = 492 * MiB;
constexpr size_t WS_U = WS_H, WS_M = WS_KA, WS_HID = WS_KA, WS_X1B = WS_QOB, WS_X2B = WS_H;
constexpr size_t WS_BAR = 0, BAR_BYTES = 16384;
constexpr int LDS_BYTES = 140 * 1024, LDS_ST_OFF = 136 * 1024;

struct Params {
    const float *x_prompt, *x_sample, *c_prompt, *c_sample, *state, *cache_k, *cache_v, *w_ada, *b_ada, *norm_mix, *w_in, *lb_logits, *out_norm,
                *w_a, *rel_bias, *w_b, *w_out, *norm_ffn, *w_ffn_in, *w_ffn_out, *norm_final;
    float* out; unsigned char* ws;
};

DI int fresh_tid() { int t = threadIdx.x; asm volatile("" : "+v"(t)); return t; }
DI int launder(int v) { asm volatile("" : "+v"(v)); return v; }
DI unsigned pk2(float a, float b) { f32x2 v = {a, b}; bf2_t r = __builtin_convertvector(v, bf2_t); return __builtin_bit_cast(unsigned, r); }
DI float bflo(unsigned u) { return __uint_as_float(u << 16); }
DI float bfhi(unsigned u) { return __uint_as_float(u & 0xffff0000u); }
DI float bf2f(short s) { return __uint_as_float(((unsigned)(unsigned short)s) << 16); }
DI float sigm(float x) { return __builtin_amdgcn_rcpf(1.f + __expf(-x)); }
DI float silu(float x) { return x * sigm(x); }
DI int batch_of(int r) { return r < TP ? (r >> 14) : 2 + ((r - TP) >> 6); }
DI int crow(int reg, int h) { return (reg & 3) + 8 * (reg >> 2) + 4 * h; }
DI bf16x8 pack8(const f32x16& x, int s) {
    u32x4 p; p.x = pk2(x[8 * s], x[8 * s + 1]); p.y = pk2(x[8 * s + 2], x[8 * s + 3]); p.z = pk2(x[8 * s + 4], x[8 * s + 5]); p.w = pk2(x[8 * s + 6], x[8 * s + 7]);
    return __builtin_bit_cast(bf16x8, p);
}
DI bf16x8 pack8f(const float* v) { u32x4 p; p.x = pk2(v[0], v[1]); p.y = pk2(v[2], v[3]); p.z = pk2(v[4], v[5]); p.w = pk2(v[6], v[7]); return __builtin_bit_cast(bf16x8, p); }
DI bf16x8 ident_frag(int ks, int l31, int hf) {
    const int jj = l31 - 16 * ks - 8 * hf; bf16x8 r;
#pragma unroll
    for (int j = 0; j < 8; ++j) r[j] = (j == jj) ? (short)0x3F80 : (short)0;
    return r;
}
#define MFMA32(a, b, c) __builtin_amdgcn_mfma_f32_32x32x16_bf16((a), (b), (c), 0, 0, 0)
DI f32x16 zero16() { f32x16 z;
#pragma unroll
    for (int i = 0; i < 16; ++i) z[i] = 0.f; return z; }

namespace pg8 {
constexpr int BM = 256, BK = 64, HALF = 128, HTB = HALF * BK * 2, STAGE_BYTES = 8 * HTB, NXCD = 8, WGM = 8;
__host__ __device__ __forceinline__ int lds_byte(int r, int c) { const int st = (r >> 4) * 2 + (c >> 5), rr = r & 15, cc = c & 31, ob = rr * 64 + cc * 2; return st * 1024 + (ob ^ (((ob >> 9) & 1) << 5)); }
__host__ __device__ __forceinline__ void stage_rc(int b, int& R, int& C) { const int st = b / 1024, sb = b % 1024, swz = sb ^ (((sb >> 9) & 1) << 5); R = (st >> 1) * 16 + swz / 64; C = (st & 1) * 32 + (swz % 64) / 2; }
__host__ __device__ __forceinline__ int perm32(int rho) { const int n = rho >> 4, i = rho & 15; return 8 * (i >> 2) + 4 * n + (i & 3); }
struct Unit { int pm, pn; };
struct Gemm { const bf16_t* A; const bf16_t* Bt; int M, N, K, ld; };
struct StaticOrder {
    int nM, nN, nwg, G, c, pm_off;
    __device__ void init(int M, int N, int G_, int c_, int pm_off_ = 0) { nM = M / BM; nN = N / BM; nwg = nM * nN; G = G_; c = c_; pm_off = pm_off_; }
    __device__ bool next(int i, Unit& u) const {
        const long L = (long)i * G + c; if (L >= nwg) return false;
        int wgid = (int)L; { const int q = nwg / NXCD, r = nwg % NXCD, xcd = wgid % NXCD, off = wgid / NXCD; wgid = (xcd < r ? xcd * (q + 1) : r * (q + 1) + (xcd - r) * q) + off; }
        const int nig = WGM * nN, gid = wgid / nig, fm = gid * WGM, gsz = (nM - fm) < WGM ? (nM - fm) : WGM;
        u.pm = pm_off + fm + ((wgid % nig) % gsz); u.pn = (wgid % nig) / gsz; return true;
    }
};
template <class Epi, class Sched, bool ALIGN_EPI = false, bool SP2 = false>
__device__ __forceinline__ void gemm_phase(LAS unsigned char* lds, const Gemm g, const Sched& S, const Epi& E) {
    const int tid = fresh_tid(), wid = __builtin_amdgcn_readfirstlane(tid >> 6), lane = tid & 63, wr = wid >> 2, wc = wid & 3, fr = lane & 15, fq = lane >> 4;
    const int K = g.ld ? g.ld : g.K, nt = g.K / BK;
    unsigned voffA[2], voffB[2];
#pragma unroll
    for (int i = 0; i < 2; ++i) { int R, C; stage_rc(tid * 16 + i * 8192, R, C); const int Rb = Epi::PERM ? ((R & ~31) + perm32(R & 31)) : R;
        voffA[i] = (unsigned)(R * K + C) * 2u; voffB[i] = (unsigned)(Rb * K + C) * 2u; }
    const size_t kstep = (size_t)(BK * 2);
    const size_t hstep = (size_t)HALF * K * 2;
    const size_t tstep = 2 * hstep;
    const unsigned ldsw = (unsigned)wid * 1024u;
    const int aoff = lds_byte(wr * 64 + fr, fq * 8), boff = lds_byte(wc * 32 + fr, fq * 8);
#define PG8_SA(b, h) (((b) * 2 + (h)) * HTB)
#define PG8_SB(b, h) ((4 + (b) * 2 + (h)) * HTB)
#define PG8_STAGE(bufoff, gbase, voff) do { _Pragma("unroll") for (int _i = 0; _i < 2; ++_i) \
        __builtin_amdgcn_global_load_lds((const unsigned*)((const char*)(gbase) + (voff)[_i]), (LAS unsigned*)(lds + (bufoff) + ldsw + _i * 8192), 16, 0, 0); } while (0)
#define PG8_LDA(dst, b, h) do { _Pragma("unroll") for (int m = 0; m < 4; ++m) _Pragma("unroll") for (int k = 0; k < 2; ++k) dst[m][k] = *(const LAS bf16x8*)(lds + PG8_SA(b, h) + aoff + m * 2048 + k * 1024); } while (0)
#define PG8_LDB(dst, b, h) do { _Pragma("unroll") for (int n = 0; n < 2; ++n) _Pragma("unroll") for (int k = 0; k < 2; ++k) dst[n][k] = *(const LAS bf16x8*)(lds + PG8_SB(b, h) + boff + n * 2048 + k * 1024); } while (0)
#define PG8_MMA(ai, bj, At, Bt) do { __builtin_amdgcn_s_setprio(1); _Pragma("unroll") for (int m = 0; m < 4; ++m) _Pragma("unroll") for (int n = 0; n < 2; ++n) _Pragma("unroll") for (int k = 0; k < 2; ++k) \
        acc[ai][bj][m][n] = __builtin_amdgcn_mfma_f32_16x16x32_bf16(Bt[n][k], At[m][k], acc[ai][bj][m][n], 0, 0, 0); __builtin_amdgcn_s_setprio(0); } while (0)
#define PG8_WAIT_V(n) asm volatile("s_waitcnt vmcnt(" #n ")" ::: "memory")
#define PG8_WAIT_L(n) asm volatile("s_waitcnt lgkmcnt(" #n ")" ::: "memory")
#define PG8_BAR __builtin_amdgcn_s_barrier()
#define PG8_SCHED __builtin_amdgcn_sched_barrier(0)
    Unit cur, nxt; int ui = 0;
    if (!S.next(0, cur)) return;
    f32x4 acc[2][2][4][2];
#pragma unroll
    for (int a = 0; a < 2; ++a)
#pragma unroll
        for (int b = 0; b < 2; ++b)
#pragma unroll
            for (int m = 0; m < 4; ++m)
#pragma unroll
                for (int n = 0; n < 2; ++n) acc[a][b][m][n] = (f32x4){0.f, 0.f, 0.f, 0.f};
    bf16x8 At[4][2], B0[2][2], B1[2][2];
    const char* cA = (const char*)g.A + (size_t)cur.pm * tstep; const char* cB = (const char*)g.Bt + (size_t)cur.pn * tstep;
    if constexpr (SP2) {
        PG8_STAGE(PG8_SB(0, 0), cB, voffB); PG8_STAGE(PG8_SB(0, 1), cB + hstep, voffB); PG8_STAGE(PG8_SA(0, 0), cA, voffA); PG8_STAGE(PG8_SA(0, 1), cA + hstep, voffA);
        if (wr == 1) PG8_BAR;
        PG8_WAIT_V(2); PG8_BAR;
        PG8_STAGE(PG8_SB(1, 0), cB + kstep, voffB); PG8_STAGE(PG8_SA(1, 0), cA + kstep, voffA); PG8_STAGE(PG8_SB(1, 1), cB + hstep + kstep, voffB);
        PG8_WAIT_V(6); PG8_BAR;
    } else {
        PG8_STAGE(PG8_SB(0, 0), cB, voffB); PG8_STAGE(PG8_SA(0, 0), cA, voffA); PG8_STAGE(PG8_SB(0, 1), cB + hstep, voffB); PG8_STAGE(PG8_SA(0, 1), cA + hstep, voffA);
        if (wr == 1) PG8_BAR;
        PG8_WAIT_V(4); PG8_BAR;
        PG8_STAGE(PG8_SB(1, 0), cB + kstep, voffB); PG8_STAGE(PG8_SA(1, 0), cA + kstep, voffA); PG8_STAGE(PG8_SB(1, 1), cB + hstep + kstep, voffB);
        PG8_WAIT_V(6); PG8_BAR;
    }
    for (;;) {
        const bool has_next = S.next(ui + 1, nxt);
        const char* nA = has_next ? (const char*)g.A + (size_t)nxt.pm * tstep : cA; const char* nB = has_next ? (const char*)g.Bt + (size_t)nxt.pn * tstep : cB;
        for (int t = 0; t < nt; t += 2) {
            if constexpr (Epi::MIDK) { if (t == nt / 2) E.mid(acc, cur, wr, wc, fr, fq); }
            const bool last = (t == nt - 2);
            const char* a1 = cA + (size_t)(t + 1) * kstep;
            const char* a2 = last ? nA : cA + (size_t)(t + 2) * kstep; const char* b2 = last ? nB : cB + (size_t)(t + 2) * kstep;
            const char* a3 = a2 + kstep; const char* b3 = b2 + kstep;
            if constexpr (SP2) {
            PG8_LDB(B0, 0, 0); PG8_LDB(B1, 0, 1); PG8_SCHED; PG8_LDA(At, 0, 0); PG8_STAGE(PG8_SA(1, 1), a1 + hstep, voffA);
            PG8_WAIT_V(8); PG8_WAIT_L(0); PG8_BAR; PG8_MMA(0, 0, At, B0); PG8_MMA(0, 1, At, B1); PG8_BAR; PG8_SCHED;
            PG8_LDA(At, 0, 1); PG8_STAGE(PG8_SB(0, 0), b2, voffB); PG8_STAGE(PG8_SB(0, 1), b2 + hstep, voffB); PG8_STAGE(PG8_SA(0, 0), a2, voffA);
            PG8_WAIT_V(8); PG8_WAIT_L(0); PG8_BAR; PG8_MMA(1, 0, At, B0); PG8_MMA(1, 1, At, B1); PG8_BAR; PG8_SCHED;
            PG8_LDB(B0, 1, 0); PG8_LDB(B1, 1, 1); PG8_SCHED; PG8_LDA(At, 1, 0); PG8_STAGE(PG8_SA(0, 1), a2 + hstep, voffA);
            PG8_WAIT_V(8); PG8_WAIT_L(0); PG8_BAR; PG8_MMA(0, 0, At, B0); PG8_MMA(0, 1, At, B1); PG8_BAR; PG8_SCHED;
            PG8_LDA(At, 1, 1); PG8_STAGE(PG8_SB(1, 0), b3, voffB); PG8_STAGE(PG8_SB(1, 1), b3 + hstep, voffB); PG8_STAGE(PG8_SA(1, 0), a3, voffA);
            PG8_WAIT_V(8); PG8_WAIT_L(0); PG8_BAR; PG8_MMA(1, 0, At, B0); PG8_MMA(1, 1, At, B1); PG8_BAR; PG8_SCHED;
            } else {
            PG8_LDB(B0, 0, 0); PG8_SCHED; PG8_LDA(At, 0, 0); PG8_STAGE(PG8_SA(1, 1), a1 + hstep, voffA);
            PG8_WAIT_L(8); PG8_BAR; PG8_WAIT_L(0); PG8_MMA(0, 0, At, B0); PG8_BAR; PG8_SCHED;
            PG8_LDB(B1, 0, 1); PG8_STAGE(PG8_SB(0, 0), b2, voffB);
            PG8_BAR; PG8_WAIT_L(0); PG8_MMA(0, 1, At, B1); PG8_BAR;
            PG8_LDA(At, 0, 1); PG8_STAGE(PG8_SA(0, 0), a2, voffA);
            PG8_BAR; PG8_WAIT_L(0); PG8_MMA(1, 0, At, B0); PG8_BAR; PG8_SCHED;
            PG8_STAGE(PG8_SB(0, 1), b2 + hstep, voffB);
            PG8_WAIT_V(6); PG8_BAR; PG8_MMA(1, 1, At, B1); PG8_BAR;
            PG8_LDB(B0, 1, 0); PG8_SCHED; PG8_LDA(At, 1, 0); PG8_STAGE(PG8_SA(0, 1), a2 + hstep, voffA);
            PG8_WAIT_L(8); PG8_BAR; PG8_WAIT_L(0); PG8_MMA(0, 0, At, B0); PG8_BAR; PG8_SCHED;
            PG8_LDB(B1, 1, 1); PG8_STAGE(PG8_SB(1, 0), b3, voffB);
            PG8_BAR; PG8_WAIT_L(0); PG8_MMA(0, 1, At, B1); PG8_BAR;
            PG8_LDA(At, 1, 1); PG8_STAGE(PG8_SA(1, 0), a3, voffA);
            PG8_BAR; PG8_WAIT_L(0); PG8_MMA(1, 0, At, B0); PG8_BAR; PG8_SCHED;
            PG8_STAGE(PG8_SB(1, 1), b3 + hstep, voffB);
            PG8_WAIT_V(6); PG8_BAR; PG8_MMA(1, 1, At, B1); PG8_BAR;
            }
        }
        if constexpr (ALIGN_EPI) { if (wr == 0) PG8_BAR; }
        E(acc, cur, wr, wc, fr, fq);
        if (!has_next) break;
#pragma unroll
        for (int a = 0; a < 2; ++a)
#pragma unroll
            for (int b = 0; b < 2; ++b)
#pragma unroll
                for (int m = 0; m < 4; ++m)
#pragma unroll
                    for (int n = 0; n < 2; ++n) acc[a][b][m][n] = (f32x4){0.f, 0.f, 0.f, 0.f};
        cur = nxt; cA = nA; cB = nB; ++ui;
        if constexpr (ALIGN_EPI) { if (wr == 1) PG8_BAR; }
    }
    PG8_WAIT_V(0);
    if constexpr (!ALIGN_EPI) { if (wr == 0) PG8_BAR; }
    PG8_BAR;
#undef PG8_SA
#undef PG8_SB
#undef PG8_STAGE
#undef PG8_LDA
#undef PG8_LDB
#undef PG8_MMA
#undef PG8_WAIT_V
#undef PG8_WAIT_L
#undef PG8_BAR
#undef PG8_SCHED
}
}
using pg8::Unit;
typedef f32x4 Acc[2][2][4][2];

DI u32x4 pack_row8(const f32x4& v0, const f32x4& v1) { u32x4 w; w.x = pk2(v0[0], v0[1]); w.y = pk2(v0[2], v0[3]); w.z = pk2(v1[0], v1[1]); w.w = pk2(v1[2], v1[3]); return w; }

struct EpiMod {
    static constexpr bool PERM = false, MIDK = false;
    float* mod; const float* bias;
    DI void operator()(Acc& acc, const Unit& u, int wr, int wc, int fr, int fq) const {
        { const int t_ = fresh_tid(); fr = t_ & 15; fq = (t_ >> 4) & 3; }
        if (u.pm != 0 || wr != 0) return;
#pragma unroll
        for (int m = 0; m < 3; ++m) { const int r = 16 * m + fr; if (r < NBATCH) {
#pragma unroll
            for (int bj = 0; bj < 2; ++bj)
#pragma unroll
                for (int n = 0; n < 2; ++n) { const int col = u.pn * 256 + bj * 128 + wc * 32 + n * 16 + 4 * fq;
                    *(f32x4*)(mod + (size_t)r * 6144 + col) = acc[0][bj][m][n] + *(const f32x4*)(bias + col); } } }
    }
};

struct EpiIn {
    static constexpr bool PERM = true, MIDK = false;
    bf16_t *QOB, *KA, *VA, *GA, *KB, *VB, *SGA, *SGB; float *CUM, *DEC; const float* lbl; float* out;
    DI void operator()(Acc& acc, const Unit& u, int wr, int wc, int fr, int fq) const {
        { const int t_ = fresh_tid(); fr = t_ & 15; fq = (t_ >> 4) & 3; }
        const int pn = u.pn, rt = wr * 64 + fr, row0 = u.pm * 256 + rt, cw = wc * 32 + 8 * fq, lane = fq * 16 + fr;
        if (pn >= 14) {
            const size_t o0 = ((size_t)(u.pm * 8 + (pn - 14)) * 8 * 512 + (size_t)(wr * 4 + wc) * 64 + lane) * 8;
#pragma unroll
            for (int ai = 0; ai < 2; ++ai)
#pragma unroll
                for (int m = 0; m < 4; ++m) { f32x4 r0, r1, b0, b1;
#pragma unroll
                    for (int j = 0; j < 4; ++j) { b0[j] = fmaxf(sigm(acc[ai][1][m][0][j]), 1e-30f); b1[j] = fmaxf(sigm(acc[ai][1][m][1][j]), 1e-30f);
                        r0[j] = sigm(acc[ai][0][m][0][j]) * __builtin_amdgcn_rcpf(b0[j]); r1[j] = sigm(acc[ai][0][m][1][j]) * __builtin_amdgcn_rcpf(b1[j]); }
                    const size_t o = o0 + (size_t)(ai * 4 + m) * 512 * 8;
                    *(u32x4*)(SGA + o) = pack_row8(r0, r1); *(u32x4*)(SGB + o) = pack_row8(b0, b1); __builtin_amdgcn_sched_barrier(0); }
            return;
        }
        const int seg = pn >> 1, col0 = (pn & 1) * 256 + cw;
        if (seg == 1) {
#pragma unroll
            for (int bj = 0; bj < 2; ++bj) {
                float lb[2][4];
#pragma unroll
                for (int n = 0; n < 2; ++n)
#pragma unroll
                    for (int j = 0; j < 4; ++j) { const int c = col0 + bj * 128 + 4 * n + j; lb[n][j] = __builtin_amdgcn_rcpf(1.f + __expf(lbl[512 + c] - lbl[c])); }
#pragma unroll
                for (int ai = 0; ai < 2; ++ai) {
                    const size_t rbase = ((size_t)((pn & 1) * 2 + bj) * T + (u.pm * 256 + ai * 128 + wr * 64 + launder(fr))) * 128 + cw;
#pragma unroll
                    for (int m = 0; m < 4; ++m) { f32x4 k0, k1;
#pragma unroll
                        for (int j = 0; j < 4; ++j) {
                            float f = lb[0][j] + (1.f - lb[0][j]) * sigm(acc[ai][bj][m][0][j]); k0[j] = 1.f - f; acc[ai][bj][m][0][j] = __logf(f);
                            f = lb[1][j] + (1.f - lb[1][j]) * sigm(acc[ai][bj][m][1][j]); k1[j] = 1.f - f; acc[ai][bj][m][1][j] = __logf(f); }
                        *(u32x4*)(KA + rbase + (size_t)m * 16 * 128) = pack_row8(k0, k1); }
                    __builtin_amdgcn_sched_barrier(0);
#pragma unroll
                    for (int n = 0; n < 2; ++n)
#pragma unroll
                        for (int j = 0; j < 4; ++j) { float carry = 0.f;
#pragma unroll
                            for (int m = 0; m < 4; ++m) { float v = acc[ai][bj][m][n][j];
                                v += __int_as_float(__builtin_amdgcn_update_dpp(0, __float_as_int(v), 0x111, 0xf, 0xf, false));
                                v += __int_as_float(__builtin_amdgcn_update_dpp(0, __float_as_int(v), 0x112, 0xf, 0xf, false));
                                v += __int_as_float(__builtin_amdgcn_update_dpp(0, __float_as_int(v), 0x114, 0xf, 0xf, false));
                                v += __int_as_float(__builtin_amdgcn_update_dpp(0, __float_as_int(v), 0x118, 0xf, 0xf, false));
                                v += carry; carry = __shfl(v, lane | 15); acc[ai][bj][m][n][j] = v; } }
                    __builtin_amdgcn_sched_barrier(0);
#pragma unroll
                    for (int m = 0; m < 4; ++m) { float* cp = CUM + rbase + (size_t)m * 16 * 128; *(f32x4*)cp = acc[ai][bj][m][0]; *(f32x4*)(cp + 4) = acc[ai][bj][m][1]; }
                    if (fr == 15) {
#pragma unroll
                        for (int n = 0; n < 2; ++n) { f32x4 e;
#pragma unroll
                            for (int j = 0; j < 4; ++j) e[j] = __expf(acc[ai][bj][3][n][j]);
                            *(f32x4*)(DEC + (size_t)(u.pm * 4 + ai * 2 + wr) * 512 + col0 + bj * 128 + 4 * n) = e; } }
                    __builtin_amdgcn_sched_barrier(0);
                }
            }
            return;
        }
        bf16_t* dst; int pitch = 512; size_t bjoff = 128; float* o32 = nullptr;
        switch (seg) {
            case 0: dst = QOB + col0; pitch = 1024; break;
            case 2: dst = VA + (size_t)((pn & 1) * 2) * T * 128 + cw; pitch = 128; bjoff = (size_t)T * 128; break;
            case 3: dst = GA + (size_t)((pn & 1) * 2) * T * 128 + cw; pitch = 128; bjoff = (size_t)T * 128; break;
            case 4: dst = QOB + 512 + col0; pitch = 1024; break;
            default: dst = (seg == 5 ? KB : VB) + (size_t)((pn & 1) * 4 + (wc >> 1)) * T * 64 + (wc & 1) * 32 + 8 * fq; pitch = 64; bjoff = (size_t)2 * T * 64; break;
        }
        if (seg >= 5) {
            if (u.pm >= 128) o32 = out + (seg == 5 ? OFF_KS : OFF_VS) + (size_t)((u.pm - 128) * 256 + rt) * 512 + col0;
            else if ((u.pm & 63) >= 62) o32 = out + (seg == 5 ? OFF_KP : OFF_VP) + (size_t)((u.pm >> 6) * 512 + ((u.pm & 63) - 62) * 256 + rt) * 512 + col0;
        }
        const bool act = (seg == 0 || seg == 3);
#pragma unroll
        for (int ai = 0; ai < 2; ++ai)
#pragma unroll
            for (int m = 0; m < 4; ++m)
#pragma unroll
                for (int bj = 0; bj < 2; ++bj) { f32x4 v0 = acc[ai][bj][m][0], v1 = acc[ai][bj][m][1];
                    if (act) {
#pragma unroll
                        for (int j = 0; j < 4; ++j) { v0[j] = silu(v0[j]); v1[j] = silu(v1[j]); } }
                    *(u32x4*)(dst + (size_t)(row0 + ai * 128 + m * 16) * pitch + bj * bjoff) = pack_row8(v0, v1);
                    if (o32) { float* op = o32 + (size_t)(ai * 128 + m * 16) * 512 + bj * 128; *(f32x4*)op = v0; *(f32x4*)(op + 4) = v1; } __builtin_amdgcn_sched_barrier(0); }
    }
};

struct EpiMerge {
    static constexpr bool PERM = true, MIDK = true;
    const bf16_t *SGR, *SGB; bf16_t* Mo;
    DI void mid(Acc& acc, const Unit& u, int wr, int wc, int fr, int fq) const {
        { const int t_ = fresh_tid(); fr = t_ & 15; fq = (t_ >> 4) & 3; }
        const size_t gb = ((size_t)(u.pm * 8 + 2 * u.pn) * 8 * 512 + (size_t)(wr * 4 + wc) * 64 + (fq * 16 + fr)) * 8;
#pragma unroll
        for (int ai = 0; ai < 2; ++ai) { u32x4 a[4][2];
#pragma unroll
            for (int m = 0; m < 4; ++m)
#pragma unroll
                for (int bj = 0; bj < 2; ++bj) a[m][bj] = *(const u32x4*)(SGR + gb + ((size_t)bj * 8 + ai * 4 + m) * 512 * 8);
#pragma unroll
            for (int m = 0; m < 4; ++m)
#pragma unroll
                for (int bj = 0; bj < 2; ++bj)
#pragma unroll
                    for (int j = 0; j < 4; ++j) { acc[ai][bj][m][j >> 1][(j & 1) * 2] *= bflo(a[m][bj][j]); acc[ai][bj][m][j >> 1][(j & 1) * 2 + 1] *= bfhi(a[m][bj][j]); }
            __builtin_amdgcn_sched_barrier(0); }
    }
    DI void operator()(Acc& acc, const Unit& u, int wr, int wc, int fr, int fq) const {
        { const int t_ = fresh_tid(); fr = t_ & 15; fq = (t_ >> 4) & 3; }
        const size_t base = (size_t)(u.pm * 256 + wr * 64 + fr) * 1024 + u.pn * 256 + wc * 32 + 8 * fq;
        const size_t gb = ((size_t)(u.pm * 8 + 2 * u.pn) * 8 * 512 + (size_t)(wr * 4 + wc) * 64 + (fq * 16 + fr)) * 8;
#pragma unroll
        for (int ai = 0; ai < 2; ++ai) { u32x4 b[4][2];
#pragma unroll
            for (int m = 0; m < 4; ++m)
#pragma unroll
                for (int bj = 0; bj < 2; ++bj) b[m][bj] = *(const u32x4*)(SGB + gb + ((size_t)bj * 8 + ai * 4 + m) * 512 * 8);
#pragma unroll
            for (int m = 0; m < 4; ++m)
#pragma unroll
                for (int bj = 0; bj < 2; ++bj) { f32x4 v0 = acc[ai][bj][m][0], v1 = acc[ai][bj][m][1]; const u32x4 g = b[m][bj];
                    v0[0] *= bflo(g[0]); v0[1] *= bfhi(g[0]); v0[2] *= bflo(g[1]); v0[3] *= bfhi(g[1]);
                    v1[0] *= bflo(g[2]); v1[1] *= bfhi(g[2]); v1[2] *= bflo(g[3]); v1[3] *= bfhi(g[3]);
                    *(u32x4*)(Mo + base + (size_t)(ai * 128 + m * 16) * 1024 + bj * 128) = pack_row8(v0, v1); }
            __builtin_amdgcn_sched_barrier(0); }
    }
};

template <bool BASE_BF16> struct EpiRes {
    static constexpr bool PERM = true, MIDK = false;
    const float *xp, *xs; const bf16_t* xb; bf16_t* xo; const float* gmod;
    DI void operator()(Acc& acc, const Unit& u, int wr, int wc, int fr, int fq) const {
        { const int t_ = fresh_tid(); fr = t_ & 15; fq = (t_ >> 4) & 3; }
        const int colb = u.pn * 256 + wc * 32 + 8 * fq;
#pragma unroll
        for (int ai = 0; ai < 2; ++ai) { const int r0 = u.pm * 256 + ai * 128 + wr * 64 + fr;
            const float* g = gmod + (size_t)batch_of(r0) * 6144 + colb;
            f32x4 gv[2][2];
#pragma unroll
            for (int bj = 0; bj < 2; ++bj) { gv[bj][0] = *(const f32x4*)(g + bj * 128); gv[bj][1] = *(const f32x4*)(g + bj * 128 + 4); }
            bf16_t* orow = xo + (size_t)r0 * D + colb;
            if constexpr (BASE_BF16) {
                const bf16_t* xr = xb + (size_t)r0 * D + colb; u32x4 xv[4][2];
#pragma unroll
                for (int m = 0; m < 4; ++m)
#pragma unroll
                    for (int bj = 0; bj < 2; ++bj) xv[m][bj] = *(const u32x4*)(xr + (size_t)m * 16 * D + bj * 128);
#pragma unroll
                for (int m = 0; m < 4; ++m)
#pragma unroll
                    for (int bj = 0; bj < 2; ++bj) { const u32x4 x = xv[m][bj]; const f32x4 a0 = acc[ai][bj][m][0] * gv[bj][0], a1 = acc[ai][bj][m][1] * gv[bj][1];
                        f32x4 v0 = {bflo(x[0]) + a0[0], bfhi(x[0]) + a0[1], bflo(x[1]) + a0[2], bfhi(x[1]) + a0[3]}, v1 = {bflo(x[2]) + a1[0], bfhi(x[2]) + a1[1], bflo(x[3]) + a1[2], bfhi(x[3]) + a1[3]};
                        *(u32x4*)(orow + (size_t)m * 16 * D + bj * 128) = pack_row8(v0, v1); }
            } else {
                const float* xr = (r0 < TP ? xp + (size_t)r0 * D : xs + (size_t)(r0 - TP) * D) + colb; f32x4 xv[4][2][2];
#pragma unroll
                for (int m = 0; m < 4; ++m)
#pragma unroll
                    for (int bj = 0; bj < 2; ++bj) { xv[m][bj][0] = *(const f32x4*)(xr + (size_t)m * 16 * D + bj * 128); xv[m][bj][1] = *(const f32x4*)(xr + (size_t)m * 16 * D + bj * 128 + 4); }
#pragma unroll
                for (int m = 0; m < 4; ++m)
#pragma unroll
                    for (int bj = 0; bj < 2; ++bj) *(u32x4*)(orow + (size_t)m * 16 * D + bj * 128) = pack_row8(xv[m][bj][0] + gv[bj][0] * acc[ai][bj][m][0], xv[m][bj][1] + gv[bj][1] * acc[ai][bj][m][1]);
            }
            __builtin_amdgcn_sched_barrier(0); }
    }
};

struct EpiPart {
    static constexpr bool PERM = false, MIDK = false;
    float* part; int row0;
    DI void operator()(Acc& acc, const Unit& u, int wr, int wc, int fr, int fq) const {
        { const int t_ = fresh_tid(); fr = t_ & 15; fq = (t_ >> 4) & 3; }
#pragma unroll
        for (int ai = 0; ai < 2; ++ai)
#pragma unroll
            for (int m = 0; m < 4; ++m) { float* prow = part + (size_t)(u.pm * 256 + ai * 128 + wr * 64 + m * 16 + fr - row0) * D + u.pn * 256 + wc * 32 + 4 * fq;
#pragma unroll
                for (int bj = 0; bj < 2; ++bj)
#pragma unroll
                    for (int n = 0; n < 2; ++n) *(f32x4*)(prow + bj * 128 + n * 16) = acc[ai][bj][m][n];
                __builtin_amdgcn_sched_barrier(0); }
    }
};

struct EpiFfnIn {
    static constexpr bool PERM = true, MIDK = false;
    bf16_t* HID;
    DI void operator()(Acc& acc, const Unit& u, int wr, int wc, int fr, int fq) const {
        { const int t_ = fresh_tid(); fr = t_ & 15; fq = (t_ >> 4) & 3; }
        bf16_t* base = HID + (size_t)(u.pm * 256 + wr * 64 + fr) * FF + u.pn * 128 + wc * 32 + 8 * fq;
#pragma unroll
        for (int ai = 0; ai < 2; ++ai)
#pragma unroll
            for (int m = 0; m < 4; ++m) { f32x4 v0, v1;
#pragma unroll
                for (int j = 0; j < 4; ++j) { v0[j] = silu(acc[ai][0][m][0][j]) * acc[ai][1][m][0][j]; v1[j] = silu(acc[ai][0][m][1][j]) * acc[ai][1][m][1][j]; }
                *(u32x4*)(base + (size_t)(ai * 128 + m * 16) * FF) = pack_row8(v0, v1); __builtin_amdgcn_sched_barrier(0); }
    }
};

DI void transpose_item(const float* W, int N, bf16_t* WT, int pitch, int koff, int k0, int n0, int drow0, LAS float* scr, int lane) {
#pragma unroll
    for (int i = 0; i < 32; ++i) { const int kk = 2 * i + (lane >> 5); scr[kk * 33 + (lane & 31)] = W[(size_t)(k0 + kk) * N + n0 + (lane & 31)]; }
    asm volatile("s_waitcnt lgkmcnt(0)" ::: "memory");
    const int c = lane & 7;
#pragma unroll
    for (int j = 0; j < 4; ++j) { const int n = (lane >> 3) + 8 * j; const LAS float* s = scr + (8 * c) * 33 + n;
        u32x4 o; o.x = pk2(s[0 * 33], s[1 * 33]); o.y = pk2(s[2 * 33], s[3 * 33]); o.z = pk2(s[4 * 33], s[5 * 33]); o.w = pk2(s[6 * 33], s[7 * 33]);
        *(u32x4*)(WT + (size_t)(drow0 + n) * pitch + koff + k0 + 8 * c) = o; }
    asm volatile("s_waitcnt lgkmcnt(0)" ::: "memory");
}
DI void phase_prep(const Params& p, LAS unsigned char* lds) {
    const int tid = fresh_tid(), lane = tid & 63, wave = __builtin_amdgcn_readfirstlane(tid >> 6);
    LAS float* scr = (LAS float*)(lds + wave * 16384);
    const int gw = blockIdx.x * 8 + wave, NGW = gridDim.x * 8;
    unsigned char* ws = p.ws;
    constexpr int I_ADA = 16 * 192, I_IN = 16 * 176, I_A = 8 * 32, I_O = 16 * 32, I_FI = 16 * 176, I_FO = 44 * 32;
    constexpr int NIT = I_ADA + I_IN + 2 * I_A + I_O + I_FI + I_FO;
    for (int it = gw; it < NIT; it += NGW) {
        int r = it;
        if (r < I_ADA) { const int kb = r / 192, nb = r % 192; transpose_item(p.w_ada, 6144, (bf16_t*)(ws + WS_WADA), 1024, 0, 64 * kb, 32 * nb, 32 * nb, scr, lane); continue; } r -= I_ADA;
        if (r < I_IN) { const int kb = r / 176, nb = r % 176, n0 = 32 * nb; int dr = n0;
            if (n0 >= 3584) { const int j = n0 < 4608 ? n0 - 3584 : n0 - 4608; dr = 3584 + 256 * (j >> 7) + (j & 127) + (n0 < 4608 ? 0 : 128); }
            transpose_item(p.w_in, INC, (bf16_t*)(ws + WS_WIN), 1024, 0, 64 * kb, n0, dr, scr, lane); continue; } r -= I_IN;
        if (r < I_A) { const int kb = r / 32, nb = r % 32; transpose_item(p.w_a, 1024, (bf16_t*)(ws + WS_WAB), 1024, 0, 64 * kb, 32 * nb, 32 * nb, scr, lane); continue; } r -= I_A;
        if (r < I_A) { const int kb = r / 32, nb = r % 32; transpose_item(p.w_b, 1024, (bf16_t*)(ws + WS_WAB), 1024, 512, 64 * kb, 32 * nb, 32 * nb, scr, lane); continue; } r -= I_A;
        if (r < I_O) { const int kb = r / 32, nb = r % 32; transpose_item(p.w_out, 1024, (bf16_t*)(ws + WS_WO), 1024, 0, 64 * kb, 32 * nb, 32 * nb, scr, lane); continue; } r -= I_O;
        if (r < I_FI) { const int kb = r / 176, nb = r % 176; const int n0 = 32 * nb; const int j0 = n0 < FF ? n0 : n0 - FF;
            transpose_item(p.w_ffn_in, INC, (bf16_t*)(ws + WS_WFI), 1024, 0, 64 * kb, n0, 256 * (j0 >> 7) + (j0 & 127) + (n0 < FF ? 0 : 128), scr, lane); continue; } r -= I_FI;
        { const int kb = r / 32, nb = r % 32; transpose_item(p.w_ffn_out, 1024, (bf16_t*)(ws + WS_WFO), FF, 0, 64 * kb, 32 * nb, 32 * nb, scr, lane); }
    }
    bf16_t* SC = (bf16_t*)(ws + WS_SC);
    for (int i = blockIdx.x * 512 + tid; i < 256 * 1024 / 2; i += gridDim.x * 512) { const int row = (2 * i) >> 10, col = (2 * i) & 1023; float a = 0.f, b = 0.f;
        if (row < NBATCH) { const float* c = row < 2 ? p.c_prompt + row * D : p.c_sample + (row - 2) * D; a = silu(c[col]); b = silu(c[col + 1]); }
        ((unsigned*)SC)[i] = pk2(a, b); }
}

DI float wave_sum(float v) {
#pragma unroll
    for (int o = 1; o < 64; o <<= 1) v += __shfl_xor(v, o);
    return v;
}
DI void phase_norm_mod(const float* xp, const float* xs, const float* nw, const float* mod, int sh_off, int sc_off, bf16_t* H) {
    const int tid = fresh_tid(), lane = tid & 63, wave = __builtin_amdgcn_readfirstlane(tid >> 6);
    const int gw = blockIdx.x * 8 + wave, NGW = gridDim.x * 8;
    for (int r = gw; r < T; r += NGW) {
        const float* xr = r < TP ? xp + (size_t)r * D : xs + (size_t)(r - TP) * D; const float* mb = mod + (size_t)batch_of(r) * 6144;
        f32x4 v[4]; float s = 0.f;
#pragma unroll
        for (int j = 0; j < 4; ++j) { v[j] = *(const f32x4*)(xr + 4 * lane + 256 * j); s += (v[j][0] * v[j][0] + v[j][1] * v[j][1]) + (v[j][2] * v[j][2] + v[j][3] * v[j][3]); }
        const float rstd = __builtin_amdgcn_rsqf(wave_sum(s) * (1.f / D) + EPS);
#pragma unroll
        for (int j = 0; j < 4; ++j) { const int col = 4 * lane + 256 * j; const f32x4 w = *(const f32x4*)(nw + col), sc = *(const f32x4*)(mb + sc_off + col), sh = *(const f32x4*)(mb + sh_off + col);
            const f32x4 h = v[j] * rstd * w * (sc + 1.f) + sh; u32x2 o; o.x = pk2(h[0], h[1]); o.y = pk2(h[2], h[3]);
            *(u32x2*)(H + (size_t)r * D + col) = o; }
    }
}
DI void phase_norm_mod_b(const bf16_t* xb, const float* nw, const float* mod, int sh_off, int sc_off, bf16_t* H, int r_lo = 0, int r_hi = T, int b_lo = 0) {
    const int tid = fresh_tid(), lane = tid & 63, wave = __builtin_amdgcn_readfirstlane(tid >> 6);
    const int gw = ((int)blockIdx.x - b_lo) * 8 + wave, NGW = ((int)gridDim.x - b_lo) * 8;
    for (int r = r_lo + gw; r < r_hi; r += NGW) {
        const bf16_t* xr = xb + (size_t)r * D; const float* mb = mod + (size_t)batch_of(r) * 6144;
        float v[2][8]; float s = 0.f;
#pragma unroll
        for (int j = 0; j < 2; ++j) { const u32x4 x = *(const u32x4*)(xr + 8 * lane + 512 * j);
#pragma unroll
            for (int i = 0; i < 4; ++i) { v[j][2 * i] = bflo(x[i]); v[j][2 * i + 1] = bfhi(x[i]); s += v[j][2 * i] * v[j][2 * i] + v[j][2 * i + 1] * v[j][2 * i + 1]; } }
        const float rstd = __builtin_amdgcn_rsqf(wave_sum(s) * (1.f / D) + EPS);
#pragma unroll
        for (int j = 0; j < 2; ++j) { const int col = 8 * lane + 512 * j; f32x4 h[2];
#pragma unroll
            for (int q = 0; q < 2; ++q) { const f32x4 w = *(const f32x4*)(nw + col + 4 * q), sc = *(const f32x4*)(mb + sc_off + col + 4 * q), sh = *(const f32x4*)(mb + sh_off + col + 4 * q);
                const f32x4 x = {v[j][4 * q], v[j][4 * q + 1], v[j][4 * q + 2], v[j][4 * q + 3]}; h[q] = x * rstd * w * (sc + 1.f) + sh; }
            *(u32x4*)(H + (size_t)r * D + col) = pack_row8(h[0], h[1]); }
    }
}
DI void phase_final_norm(const bf16_t* xb, float* y, const float* nw, int r_lo = 0, int r_hi = T, int b_lo = 0) {
    const int tid = fresh_tid(), lane = tid & 63, wave = __builtin_amdgcn_readfirstlane(tid >> 6);
    const int gw = ((int)blockIdx.x - b_lo) * 8 + wave, NGW = ((int)gridDim.x - b_lo) * 8;
    for (int r = r_lo + gw; r < r_hi; r += NGW) { const bf16_t* xr = xb + (size_t)r * D; float* yr = y + (size_t)r * D;
        float v[2][8]; float s = 0.f;
#pragma unroll
        for (int j = 0; j < 2; ++j) { const u32x4 x = *(const u32x4*)(xr + 8 * lane + 512 * j);
#pragma unroll
            for (int i = 0; i < 4; ++i) { v[j][2 * i] = bflo(x[i]); v[j][2 * i + 1] = bfhi(x[i]); s += v[j][2 * i] * v[j][2 * i] + v[j][2 * i + 1] * v[j][2 * i + 1]; } }
        const float rstd = __builtin_amdgcn_rsqf(wave_sum(s) * (1.f / D) + EPS);
#pragma unroll
        for (int j = 0; j < 2; ++j) { const int col = 8 * lane + 512 * j;
#pragma unroll
            for (int q = 0; q < 2; ++q) { const f32x4 x = {v[j][4 * q], v[j][4 * q + 1], v[j][4 * q + 2], v[j][4 * q + 3]}; *(f32x4*)(yr + col + 4 * q) = x * rstd * *(const f32x4*)(nw + col + 4 * q); } }
    }
}

DI void phase_final_norm_parts(const bf16_t* x1b, const float* part0, const float* part1, const float* g2mod, float* y, const float* nw) {
    const int tid = fresh_tid(), lane = tid & 63, wave = __builtin_amdgcn_readfirstlane(tid >> 6);
    const int gw = blockIdx.x * 8 + wave, NGW = gridDim.x * 8;
    for (int r = TP + gw; r < T; r += NGW) { const float* gb = g2mod + (size_t)batch_of(r) * 6144; const size_t po = (size_t)(r - TP) * D;
        f32x4 v[4]; float s = 0.f;
#pragma unroll
        for (int j = 0; j < 4; ++j) { const int col = 4 * lane + 256 * j; const u32x2 xb = *(const u32x2*)(x1b + (size_t)r * D + col);
            const f32x4 x = {bflo(xb.x), bfhi(xb.x), bflo(xb.y), bfhi(xb.y)};
            v[j] = x + *(const f32x4*)(gb + col) * (*(const f32x4*)(part0 + po + col) + *(const f32x4*)(part1 + po + col));
            s += (v[j][0] * v[j][0] + v[j][1] * v[j][1]) + (v[j][2] * v[j][2] + v[j][3] * v[j][3]); }
        const float rstd = __builtin_amdgcn_rsqf(wave_sum(s) * (1.f / D) + EPS);
#pragma unroll
        for (int j = 0; j < 4; ++j) { const int col = 4 * lane + 256 * j; *(f32x4*)(y + (size_t)r * D + col) = v[j] * rstd * *(const f32x4*)(nw + col); }
    }
}

DI void hgrn_u_item(const Params& p, int item, int lane) {
    const int c = item >> 5, rem = item & 31, h = rem >> 3, kt = (rem >> 1) & 3, vh = rem & 1, l31 = lane & 31, hf = lane >> 5;
    const float* CUM = (const float*)(p.ws + WS_CUM); const bf16_t* KA = (const bf16_t*)(p.ws + WS_KA); const bf16_t* VA = (const bf16_t*)(p.ws + WS_VA); bf16_t* U = (bf16_t*)(p.ws + WS_U);
    const size_t hb = (size_t)h * T * 128; const int kcol = 32 * kt + l31;
    const float tot = CUM[hb + (size_t)(c * 64 + 63) * 128 + kcol];
    bf16x8 kdf[2][2];
#pragma unroll
    for (int st = 0; st < 2; ++st) { f32x16 kd;
#pragma unroll
        for (int r = 0; r < 16; ++r) { const size_t idx = hb + (size_t)(c * 64 + 32 * st + crow(r, hf)) * 128 + kcol; kd[r] = bf2f((short)KA[idx]) * __expf(tot - CUM[idx]); }
        kdf[st][0] = pack8(kd, 0); kdf[st][1] = pack8(kd, 1); }
    const bf16x8 id0 = ident_frag(0, l31, hf), id1 = ident_frag(1, l31, hf);
#pragma unroll
    for (int vtl = 0; vtl < 2; ++vtl) { const int vt = 2 * vh + vtl; f32x16 dacc = zero16();
#pragma unroll
        for (int st = 0; st < 2; ++st) { const bf16_t* vp = VA + hb + (size_t)(c * 64 + 32 * st + l31) * 128 + 32 * vt + 8 * hf;
            f32x16 vx = zero16(); vx = MFMA32(*(const bf16x8*)vp, id0, vx); vx = MFMA32(*(const bf16x8*)(vp + 16), id1, vx);
            dacc = MFMA32(kdf[st][0], pack8(vx, 0), dacc); dacc = MFMA32(kdf[st][1], pack8(vx, 1), dacc); }
        bf16_t* up = U + ((size_t)(c * 4 + h) * 128 + 32 * vt + l31) * 128 + 32 * kt + 4 * hf;
#pragma unroll
        for (int g = 0; g < 4; ++g) { u32x2 o; o.x = pk2(dacc[4 * g], dacc[4 * g + 1]); o.y = pk2(dacc[4 * g + 2], dacc[4 * g + 3]); *(u32x2*)(up + 8 * g) = o; }
    }
}

DI void scan_prompt_item(const Params& p, int item, int lane) {
    const int bh = item >> 5, vq = item & 31, b = bh >> 2, h = bh & 3, kg = lane & 31, vv = lane >> 5;
    const float* __restrict__ DEC = (const float*)(p.ws + WS_DEC); const bf16_t* __restrict__ U = (const bf16_t*)(p.ws + WS_U); bf16_t* __restrict__ SST = (bf16_t*)(p.ws + WS_SST);
    f32x4 S0 = {0.f, 0.f, 0.f, 0.f}, S1 = {0.f, 0.f, 0.f, 0.f};
    const int v0 = 4 * vq + vv, v1 = v0 + 2;
#pragma unroll 16
    for (int n = 0; n < 256; ++n) { const int c = b * 256 + n;
        const f32x4 d = *(const f32x4*)(DEC + (size_t)c * 512 + h * 128 + 4 * kg);
        const size_t o0 = ((size_t)(c * 4 + h) * 128 + v0) * 128 + 4 * kg, o1 = ((size_t)(c * 4 + h) * 128 + v1) * 128 + 4 * kg;
        const u32x2 u0 = *(const u32x2*)(U + o0), u1 = *(const u32x2*)(U + o1);
        u32x2 s; s.x = pk2(S0[0], S0[1]); s.y = pk2(S0[2], S0[3]); *(u32x2*)(SST + o0) = s;
        s.x = pk2(S1[0], S1[1]); s.y = pk2(S1[2], S1[3]); *(u32x2*)(SST + o1) = s;
        S0[0] = d[0] * S0[0] + bflo(u0.x); S0[1] = d[1] * S0[1] + bfhi(u0.x); S0[2] = d[2] * S0[2] + bflo(u0.y); S0[3] = d[3] * S0[3] + bfhi(u0.y);
        S1[0] = d[0] * S1[0] + bflo(u1.x); S1[1] = d[1] * S1[1] + bfhi(u1.x); S1[2] = d[2] * S1[2] + bflo(u1.y); S1[3] = d[3] * S1[3] + bfhi(u1.y);
    }
    float* sp = p.out + OFF_SP + ((size_t)bh * 128 + 4 * kg) * 128;
#pragma unroll
    for (int i = 0; i < 4; ++i) { sp[(size_t)i * 128 + v0] = S0[i]; sp[(size_t)i * 128 + v1] = S1[i]; }
}
DI void scan_sample_item(const Params& p, int item, int lane) {
    const int bh = item >> 5, vq = item & 31, bs = bh >> 2, h = bh & 3, kg = lane & 31, vv = lane >> 5, c = 512 + bs;
    const float* DEC = (const float*)(p.ws + WS_DEC); const bf16_t* U = (const bf16_t*)(p.ws + WS_U); bf16_t* SST = (bf16_t*)(p.ws + WS_SST);
    const f32x4 d = *(const f32x4*)(DEC + (size_t)c * 512 + h * 128 + 4 * kg);
    const float* s0 = p.state + ((size_t)bh * 128 + 4 * kg) * 128; float* so = p.out + OFF_SS + ((size_t)bh * 128 + 4 * kg) * 128;
#pragma unroll
    for (int e = 0; e < 2; ++e) { const int v = 4 * vq + 2 * e + vv; const size_t o = ((size_t)(c * 4 + h) * 128 + v) * 128 + 4 * kg;
        const u32x2 u = *(const u32x2*)(U + o); f32x4 S;
#pragma unroll
        for (int i = 0; i < 4; ++i) S[i] = s0[(size_t)i * 128 + v];
        u32x2 s; s.x = pk2(S[0], S[1]); s.y = pk2(S[2], S[3]); *(u32x2*)(SST + o) = s;
        so[v] = d[0] * S[0] + bflo(u.x); so[128 + v] = d[1] * S[1] + bfhi(u.x); so[256 + v] = d[2] * S[2] + bflo(u.y); so[384 + v] = d[3] * S[3] + bfhi(u.y); }
}

DI void attn_item(const Params& p, int item, int lane, const LAS float* biasl) {
    const int c = item >> 3, h = item & 7, l31 = lane & 31, hf = lane >> 5;
    const bf16_t* KB = (const bf16_t*)(p.ws + WS_KB); const bf16_t* VB = (const bf16_t*)(p.ws + WS_VB);
    bf16x8 qf[2][4];
    { const bf16_t* qptr = (const bf16_t*)(p.ws + WS_QOB) + (size_t)(c * 64 + l31) * 1024 + 512 + h * 64;
#pragma unroll
    for (int qq = 0; qq < 2; ++qq)
#pragma unroll
        for (int ks = 0; ks < 4; ++ks) qf[qq][ks] = *(const bf16x8*)(qptr + (size_t)qq * 32 * 1024 + 16 * ks + 8 * hf); }
    const LAS float* bl = biasl + h * 192;
    f32x16 OT[2][2]; float mrun[2], lsum[2];
#pragma unroll
    for (int qq = 0; qq < 2; ++qq) { OT[qq][0] = zero16(); OT[qq][1] = zero16(); mrun[qq] = -1e30f; lsum[qq] = 0.f; }
    int ntile, ncache, db0, krow_first;
    if (c < 512) { const int n = c & 255, j0 = n < 8 ? n : 8; ntile = 2 * (j0 + 1); ncache = 0; db0 = 64 * j0; krow_first = (c - j0) * 64; }
    else { ntile = 18; ncache = 16; db0 = 512; krow_first = c * 64 - 512; }
    const int bs = c - 512;
    u32x4 nk[4], nv[4];
#define ATT_LOAD(i_) do { if ((i_) >= ncache) { const size_t ro_ = ((size_t)h * T + (size_t)(krow_first + 32 * (i_) + l31)) * 64 + 8 * hf; \
            _Pragma("unroll") for (int ks = 0; ks < 4; ++ks) { nk[ks] = *(const u32x4*)(KB + ro_ + 16 * ks); nv[ks] = *(const u32x4*)(VB + ro_ + 16 * ks); } } } while (0)
    ATT_LOAD(0);
    for (int i = 0; i < ntile; ++i) {
        bf16x8 kf[4], vf[2][2];
        if (i < ncache) {
            const float* kp_ = p.cache_k + ((size_t)(bs * 512 + 32 * i + l31) * 8 + h) * 64 + 8 * hf; const float* vp_ = p.cache_v + ((size_t)(bs * 512 + 32 * i + l31) * 8 + h) * 64 + 8 * hf;
#pragma unroll
            for (int ks = 0; ks < 4; ++ks) { u32x4 w; const f32x4 a = *(const f32x4*)(kp_ + 16 * ks), b = *(const f32x4*)(kp_ + 16 * ks + 4), e = *(const f32x4*)(vp_ + 16 * ks), f = *(const f32x4*)(vp_ + 16 * ks + 4);
                w.x = pk2(a[0], a[1]); w.y = pk2(a[2], a[3]); w.z = pk2(b[0], b[1]); w.w = pk2(b[2], b[3]); kf[ks] = __builtin_bit_cast(bf16x8, w);
                w.x = pk2(e[0], e[1]); w.y = pk2(e[2], e[3]); w.z = pk2(f[0], f[1]); w.w = pk2(f[2], f[3]); vf[ks >> 1][ks & 1] = __builtin_bit_cast(bf16x8, w); }
        } else {
#pragma unroll
            for (int ks = 0; ks < 4; ++ks) { kf[ks] = __builtin_bit_cast(bf16x8, nk[ks]); vf[ks >> 1][ks & 1] = __builtin_bit_cast(bf16x8, nv[ks]); }
        }
        if (i + 1 < ntile) ATT_LOAD(i + 1);
        asm volatile("" ::: "memory");
        bf16x8 vxf[2][2];
        const int l31b = launder(l31); const bf16x8 id0 = ident_frag(0, l31b, hf), id1 = ident_frag(1, l31b, hf);
#pragma unroll
        for (int dt = 0; dt < 2; ++dt) { f32x16 vx = zero16(); vx = MFMA32(vf[dt][0], id0, vx); vx = MFMA32(vf[dt][1], id1, vx); vxf[dt][0] = pack8(vx, 0); vxf[dt][1] = pack8(vx, 1); }
#pragma unroll
        for (int qq = 0; qq < 2; ++qq) {
            f32x16 st = zero16();
#pragma unroll
            for (int ks = 0; ks < 4; ++ks) st = MFMA32(kf[ks], qf[qq][ks], st);
            const int dq = db0 + 32 * qq - 32 * i; float mt = -1e30f;
            if (dq - 31 >= 128) { const float bc = bl[191];
#pragma unroll
                for (int r = 0; r < 16; ++r) { const float s = st[r] * (0.125f * LOG2E) + bc; st[r] = s; mt = fmaxf(mt, s); }
            } else { const int dbase = dq + l31;
#pragma unroll
                for (int r = 0; r < 16; ++r) { int dist = dbase - crow(r, hf); dist = dist > 128 ? 128 : dist; const float s = st[r] * (0.125f * LOG2E) + bl[dist + 63]; st[r] = s; mt = fmaxf(mt, s); }
            }
            mt = fmaxf(mt, __shfl_xor(mt, 32));
            const float mnew = fmaxf(mrun[qq], mt), alpha = __builtin_amdgcn_exp2f(mrun[qq] - mnew); mrun[qq] = mnew;
            float ps = 0.f;
#pragma unroll
            for (int r = 0; r < 16; ++r) { st[r] = __builtin_amdgcn_exp2f(st[r] - mnew); ps += st[r]; }
            lsum[qq] = lsum[qq] * alpha + ps;
#pragma unroll
            for (int r = 0; r < 16; ++r) { OT[qq][0][r] *= alpha; OT[qq][1][r] *= alpha; }
            const bf16x8 pf0 = pack8(st, 0), pf1 = pack8(st, 1);
            OT[qq][0] = MFMA32(vxf[0][0], pf0, OT[qq][0]); OT[qq][0] = MFMA32(vxf[0][1], pf1, OT[qq][0]);
            OT[qq][1] = MFMA32(vxf[1][0], pf0, OT[qq][1]); OT[qq][1] = MFMA32(vxf[1][1], pf1, OT[qq][1]);
        }
    }
#undef ATT_LOAD
    bf16_t* qptr = (bf16_t*)(p.ws + WS_QOB) + (size_t)(c * 64 + launder(l31)) * 1024 + 512 + h * 64;
#pragma unroll
    for (int qq = 0; qq < 2; ++qq) { const float l = lsum[qq] + __shfl_xor(lsum[qq], 32), inv = 1.f / l; bf16_t* op = qptr + (size_t)qq * 32 * 1024;
#pragma unroll
        for (int g = 0; g < 4; ++g) { u32x2 o; o.x = pk2(OT[qq][0][4 * g] * inv, OT[qq][0][4 * g + 1] * inv); o.y = pk2(OT[qq][0][4 * g + 2] * inv, OT[qq][0][4 * g + 3] * inv); *(u32x2*)(op + 8 * g + 4 * hf) = o;
            o.x = pk2(OT[qq][1][4 * g] * inv, OT[qq][1][4 * g + 1] * inv); o.y = pk2(OT[qq][1][4 * g + 2] * inv, OT[qq][1][4 * g + 3] * inv); *(u32x2*)(op + 32 + 8 * g + 4 * hf) = o; } }
}

DI void hgrn_out_item(const Params& p, int item, int lane, bf16_t* obase = nullptr) {
    const int c = item >> 3, h = (item >> 1) & 3, tt = item & 1, l31 = lane & 31, hf = lane >> 5;
    const float* CUM = (const float*)(p.ws + WS_CUM); const bf16_t* KA = (const bf16_t*)(p.ws + WS_KA); const bf16_t* VA = (const bf16_t*)(p.ws + WS_VA);
    const bf16_t* GA = (const bf16_t*)(p.ws + WS_GA); const bf16_t* SST = (const bf16_t*)(p.ws + WS_SST);
    const int trow = c * 64 + 32 * tt + l31;
    bf16_t* qap = (bf16_t*)(p.ws + WS_QOB) + (size_t)trow * 1024 + h * 128;
    const size_t hb = (size_t)h * T * 128;
    const float* cumt = CUM + hb + (size_t)trow * 128; const float* refp = CUM + hb + (size_t)(c * 64 + 32) * 128;
    bf16x8 qd1[8], qd2[8], kdt[8];
    const bf16_t* kat = KA + hb + (size_t)trow * 128;
#pragma unroll
    for (int ks = 0; ks < 8; ++ks) { const int k0 = 16 * ks + 8 * hf; const bf16x8 q8 = *(const bf16x8*)(qap + k0), k8 = *(const bf16x8*)(kat + k0);
        const f32x4 c0 = *(const f32x4*)(cumt + k0), c1 = *(const f32x4*)(cumt + k0 + 4), r0 = *(const f32x4*)(refp + k0), r1 = *(const f32x4*)(refp + k0 + 4);
        float a[8], b[8], d[8];
#pragma unroll
        for (int j = 0; j < 8; ++j) { const float q = bf2f(q8[j]), cu = j < 4 ? c0[j & 3] : c1[j & 3], rf = j < 4 ? r0[j & 3] : r1[j & 3]; a[j] = q * __expf(cu - rf); b[j] = q * __expf(cu); d[j] = bf2f(k8[j]) * __expf(rf - cu); }
        qd1[ks] = pack8f(a); qd2[ks] = pack8f(b); kdt[ks] = pack8f(d); }
    f32x16 OT[4];
#pragma unroll
    for (int vt = 0; vt < 4; ++vt) OT[vt] = zero16();
    const bf16_t* sp = SST + ((size_t)(c * 4 + h) * 128 + l31) * 128 + 8 * hf;
#pragma unroll
    for (int vt = 0; vt < 4; ++vt) {
#pragma unroll
        for (int ks = 0; ks < 8; ++ks) OT[vt] = MFMA32(*(const bf16x8*)(sp + (size_t)vt * 32 * 128 + 16 * ks), qd2[ks], OT[vt]);
        __builtin_amdgcn_sched_barrier(0); }
    const bf16x8 id0 = ident_frag(0, l31, hf), id1 = ident_frag(1, l31, hf);
    for (int st = 0; st <= tt; ++st) {
        const int srow = c * 64 + 32 * st + l31; const bf16_t* kap = KA + hb + (size_t)srow * 128; const float* cums = CUM + hb + (size_t)srow * 128;
        f32x16 X = zero16();
        if (st == tt) {
#pragma unroll
            for (int ks = 0; ks < 8; ++ks) X = MFMA32(kdt[ks], qd1[ks], X);
        } else
#pragma unroll
        for (int ks = 0; ks < 8; ++ks) { const int k0 = 16 * ks + 8 * hf; const bf16x8 k8 = *(const bf16x8*)(kap + k0);
            const f32x4 c0 = *(const f32x4*)(cums + k0), c1 = *(const f32x4*)(cums + k0 + 4), r0 = *(const f32x4*)(refp + k0), r1 = *(const f32x4*)(refp + k0 + 4);
            float a[8];
#pragma unroll
            for (int j = 0; j < 8; ++j) { const float cu = j < 4 ? c0[j & 3] : c1[j & 3], rf = j < 4 ? r0[j & 3] : r1[j & 3]; a[j] = bf2f(k8[j]) * __expf(rf - cu); }
            X = MFMA32(pack8f(a), qd1[ks], X); }
        if (st == tt) {
#pragma unroll
            for (int r = 0; r < 16; ++r) if (crow(r, hf) > l31) X[r] = 0.f; }
        const bf16x8 xf0 = pack8(X, 0), xf1 = pack8(X, 1);
        const bf16_t* vp = VA + hb + (size_t)srow * 128 + 8 * hf;
#pragma unroll
        for (int vt = 0; vt < 4; ++vt) { f32x16 vx = zero16(); vx = MFMA32(*(const bf16x8*)(vp + 32 * vt), id0, vx); vx = MFMA32(*(const bf16x8*)(vp + 32 * vt + 16), id1, vx);
            OT[vt] = MFMA32(pack8(vx, 0), xf0, OT[vt]); OT[vt] = MFMA32(pack8(vx, 1), xf1, OT[vt]); }
    }
    float ss = 0.f;
#pragma unroll
    for (int vt = 0; vt < 4; ++vt)
#pragma unroll
        for (int r = 0; r < 16; ++r) ss += OT[vt][r] * OT[vt][r];
    ss += __shfl_xor(ss, 32);
    const float rstd = __builtin_amdgcn_rsqf(ss * (1.f / 128.f) + EPS);
    const bf16_t* gap = GA + hb + (size_t)trow * 128; const float* onp = p.out_norm + h * 128;
    if (obase) qap = obase + (size_t)trow * 512 + h * 128;
#pragma unroll
    for (int vt = 0; vt < 4; ++vt)
#pragma unroll
        for (int g = 0; g < 4; ++g) { const int v0 = 32 * vt + 8 * g + 4 * hf; const f32x4 on = *(const f32x4*)(onp + v0); const u32x2 ga = *(const u32x2*)(gap + v0);
            u32x2 o; o.x = pk2(OT[vt][4 * g] * rstd * on[0] * bflo(ga.x), OT[vt][4 * g + 1] * rstd * on[1] * bfhi(ga.x));
            o.y = pk2(OT[vt][4 * g + 2] * rstd * on[2] * bflo(ga.y), OT[vt][4 * g + 3] * rstd * on[3] * bfhi(ga.y)); *(u32x2*)(qap + v0) = o; }
}


#define XB_TMO      128
#define XB_XCNT(j)  (256  + 64 * (j))
#define XB_XSUB(j)  (1280 + 64 * (j))
#define XB_XGEN(j)  (2304 + 64 * (j))
#define XB_TOP      3328
#define XB_TOPGEN   3392
#define XCD_BAR_WORDS 3456
#define XB_SPIN_CAP (1u << 18)
DI unsigned xb_ld(unsigned* p)              { return __hip_atomic_load(p, __ATOMIC_RELAXED, __HIP_MEMORY_SCOPE_AGENT); }
DI unsigned xb_add(unsigned* p, unsigned v) { return __hip_atomic_fetch_add(p, v, __ATOMIC_RELAXED, __HIP_MEMORY_SCOPE_AGENT); }
DI unsigned xb_xcc_id() { return (unsigned)__builtin_amdgcn_s_getreg((3 << 11) | 20) & 0xFu; }
#define XB_SPIN(cond, bar) do { unsigned _sp = 0; while (cond) { __builtin_amdgcn_s_sleep(1); \
    if ((++_sp & 255u) == 0u) { if (xb_ld(&(bar)[XB_TMO])) break; if (_sp > XB_SPIN_CAP) { atomicAdd(&(bar)[XB_TMO], 1u); break; } } } } while (0)
struct XcdBarrier { unsigned* bar; unsigned x; volatile LAS unsigned* st; };
DI XcdBarrier xcd_barrier_post(unsigned* bar, volatile LAS unsigned* st) {
    XcdBarrier b; b.bar = bar; b.x = xb_xcc_id(); b.st = st;
    if (threadIdx.x == 0) (void)xb_add(&bar[XB_XCNT(b.x)], 1u);
    return b;
}
DI void xcd_barrier_complete(unsigned* bar, unsigned x, unsigned& nloc, unsigned& nx) {
    const unsigned G = gridDim.x * gridDim.y * gridDim.z;
    unsigned sum, cnt, mine, sp = 0u;
    for (;;) {
        sum = 0u; cnt = 0u; mine = 0u;
#pragma unroll
        for (unsigned j = 0; j < 16; ++j) { const unsigned c = xb_ld(&bar[XB_XCNT(j)]); sum += c; cnt += (c > 0u) ? 1u : 0u; mine = (j == x) ? c : mine; }
        if (sum == G) break;
        __builtin_amdgcn_s_sleep(1);
        if ((++sp & 255u) == 0u) { if (xb_ld(&bar[XB_TMO])) break; if (sp > XB_SPIN_CAP) { atomicAdd(&bar[XB_TMO], 1u); break; } }
    }
    nloc = mine > 0u ? mine : 1u; nx = cnt > 0u ? cnt : 1u;
}
DI void xcd_barrier(const XcdBarrier& b) {
    asm volatile("s_waitcnt vmcnt(0)" ::: "memory");
    __syncthreads();
    if (threadIdx.x == 0) {
        unsigned* bar = b.bar;
        __builtin_amdgcn_s_waitcnt(0);
        unsigned nloc = b.st[0], nx = b.st[1];
        if (nloc == 0u) { xcd_barrier_complete(bar, b.x, nloc, nx); b.st[0] = nloc; b.st[1] = nx; }
        const unsigned old = xb_add(&bar[XB_XSUB(b.x)], 1u);
        const unsigned gen = old / nloc;
        if (old + 1u == (gen + 1u) * nloc) {
            __builtin_amdgcn_fence(__ATOMIC_RELEASE, "agent");
            asm volatile("s_waitcnt vmcnt(0)" ::: "memory");
            const unsigned og = xb_add(&bar[XB_TOP], 1u);
            const unsigned tg = og / nx;
            if (og + 1u == (tg + 1u) * nx) xb_add(&bar[XB_TOPGEN], 1u);
            else XB_SPIN(xb_ld(&bar[XB_TOPGEN]) == tg, bar);
            __builtin_amdgcn_fence(__ATOMIC_ACQUIRE, "agent");
            xb_add(&bar[XB_XGEN(b.x)], 1u);
            asm volatile("s_waitcnt vmcnt(0)" ::: "memory");
        } else {
            XB_SPIN(xb_ld(&bar[XB_XGEN(b.x)]) == gen, bar);
            __builtin_amdgcn_fence(__ATOMIC_ACQUIRE, "agent");
            asm volatile("s_waitcnt vmcnt(0)" ::: "memory");
        }
    }
    __syncthreads();
}

__global__ void __launch_bounds__(512, 2) fwd_megakernel(Params p) {
    extern __shared__ __attribute__((aligned(16))) unsigned char lds_raw[];
    LAS unsigned char* lds = (LAS unsigned char*)lds_raw;
    cg::grid_group grid = cg::this_grid();
    const int G = gridDim.x, bx = blockIdx.x;
    volatile LAS unsigned* bst = (volatile LAS unsigned*)(lds + LDS_ST_OFF);
    if (threadIdx.x < 2) bst[threadIdx.x] = 0u;
    __syncthreads();
    const XcdBarrier xbar = xcd_barrier_post((unsigned*)(p.ws + WS_BAR), bst);
    if (threadIdx.x == 0) bst[2] = xb_add((unsigned*)(p.ws + WS_BAR) + 3712 + xbar.x, 1u);
#define GRID_BAR() xcd_barrier(xbar)
    unsigned char* ws = p.ws;
    float* MOD = (float*)(ws + WS_MOD); bf16_t* H = (bf16_t*)(ws + WS_H);

    phase_prep(p, lds);
    grid.sync();
    { pg8::Gemm g{(const bf16_t*)(ws + WS_SC), (const bf16_t*)(ws + WS_WADA), 256, 6144, 1024}; pg8::StaticOrder S; S.init(256, 6144, G, bx);
      EpiMod E{MOD, p.b_ada}; pg8::gemm_phase<EpiMod, pg8::StaticOrder, true, true>(lds, g, S, E); }
    GRID_BAR();
    int cv = bx;
    { unsigned* barw = (unsigned*)(p.ws + WS_BAR); bool uni = (G & 7) == 0;
#pragma unroll
      for (int j = 0; j < 16; ++j) { const unsigned c = xb_ld(&barw[XB_XCNT(j)]); uni = uni && (j < 8 ? c == (unsigned)(G >> 3) : c == 0u); }
      if (uni) cv = (int)xbar.x + 8 * (int)bst[2];
      cv = __builtin_amdgcn_readfirstlane(cv); }
    phase_norm_mod(p.x_prompt, p.x_sample, p.norm_mix, MOD, 0, 1024, H);
#if PROBE_DUP == 1
    GRID_BAR(); phase_norm_mod(p.x_prompt, p.x_sample, p.norm_mix, MOD, 0, 1024, H);
#endif
#if PROBE_DUP == 10
    GRID_BAR(); GRID_BAR(); GRID_BAR(); GRID_BAR(); GRID_BAR(); GRID_BAR(); GRID_BAR(); GRID_BAR(); GRID_BAR(); GRID_BAR();
#endif
    GRID_BAR();
    { pg8::Gemm g{H, (const bf16_t*)(ws + WS_WIN), T, INC, 1024}; pg8::StaticOrder S; S.init(T, INC, G, cv);
      EpiIn E{(bf16_t*)(ws + WS_QOB), (bf16_t*)(ws + WS_KA), (bf16_t*)(ws + WS_VA), (bf16_t*)(ws + WS_GA), (bf16_t*)(ws + WS_KB), (bf16_t*)(ws + WS_VB),
              (bf16_t*)(p.out), (bf16_t*)(p.out) + (size_t)T * 1024, (float*)(ws + WS_CUM), (float*)(ws + WS_DEC), p.lb_logits, p.out};
      pg8::gemm_phase<EpiIn, pg8::StaticOrder, true, true>(lds, g, S, E);
#if PROBE_DUP == 2
      GRID_BAR(); pg8::gemm_phase<EpiIn, pg8::StaticOrder, true, true>(lds, g, S, E);
#endif
    }
    GRID_BAR();
    { const int tid = fresh_tid(), lane = tid & 63, wave = __builtin_amdgcn_readfirstlane(tid >> 6);
      for (int it = wave * G + bx; it < NCH * 32; it += 8 * G) hgrn_u_item(p, it, lane);
#if PROBE_DUP == 3
      for (int it = wave * G + bx; it < NCH * 32; it += 8 * G) hgrn_u_item(p, it, lane);
#endif
    }
    GRID_BAR();
    {
        const int tid = fresh_tid(), lane = tid & 63, wave = __builtin_amdgcn_readfirstlane(tid >> 6);
        LAS float* biasl = (LAS float*)lds;
        for (int i = tid; i < 8 * 192; i += 512) biasl[i] = p.rel_bias[i] * LOG2E;
        __syncthreads();
#if PROBE_DUP == 41
        if (wave == 0) { for (int it = bx; it < 256; it += G) scan_prompt_item(p, it, lane); }
        GRID_BAR();
#endif
        if (wave == 0) { for (int it = bx; it < 256; it += G) scan_prompt_item(p, it, lane); }
        else {
            const int gw = (wave - 1) * G + bx, NGW = 7 * G;
            for (int it = gw; it < 4096; it += NGW) scan_sample_item(p, it, lane);
            const int x = (int)xbar.x, ncu = (int)bst[0], nxcc = (int)bst[1], j = (int)bst[2];
            if (nxcc == 8 && x < 8 && ncu > 0 && j < ncu) {
                const int nslot = 7 * ncu, slot = (wave - 1) * ncu + j;
                for (int idx = slot; idx < 68 * 8; idx += nslot) { const int cc = idx >> 3, c = cc < 4 ? 512 + 4 * x + cc : 64 * x + (cc - 4); attn_item(p, c * 8 + (idx & 7), lane, biasl); }
            } else for (int it = gw; it < NCH * 8; it += NGW) attn_item(p, it, lane, biasl);
        }
    }
    GRID_BAR();
    { const int tid = fresh_tid(), lane = tid & 63, wave = __builtin_amdgcn_readfirstlane(tid >> 6);
#if PROBE_DUP == 5
      for (int it = wave * G + bx; it < NCH * 8; it += 8 * G) hgrn_out_item(p, it, lane, (bf16_t*)(ws + WS_U));
      GRID_BAR();
#endif
      for (int it = wave * G + bx; it < NCH * 8; it += 8 * G) hgrn_out_item(p, it, lane); }
    GRID_BAR();
    { pg8::Gemm g{(const bf16_t*)(ws + WS_QOB), (const bf16_t*)(ws + WS_WAB), T, 1024, 1024}; pg8::StaticOrder S; S.init(T, 1024, G, cv);
      EpiMerge E{(const bf16_t*)(p.out), (const bf16_t*)(p.out) + (size_t)T * 1024, (bf16_t*)(ws + WS_M)};
      pg8::gemm_phase<EpiMerge, pg8::StaticOrder, true, true>(lds, g, S, E); }
    GRID_BAR();
    const bool split_ps = G >= 64;
    { pg8::Gemm g{(const bf16_t*)(ws + WS_M), (const bf16_t*)(ws + WS_WO), T, 1024, 1024}; EpiRes<false> E{p.x_prompt, p.x_sample, nullptr, (bf16_t*)(ws + WS_X1B), MOD + 2048};
      if (split_ps) {
        { pg8::StaticOrder S; S.init(TP, 1024, G, cv); pg8::gemm_phase<EpiRes<false>, pg8::StaticOrder, true, true>(lds, g, S, E); }
        GRID_BAR();
        if (bx < 32) { pg8::StaticOrder S; S.init(TS, 1024, 32, bx, TP / 256); pg8::gemm_phase<EpiRes<false>, pg8::StaticOrder, true, true>(lds, g, S, E); }
        else phase_norm_mod_b((const bf16_t*)(ws + WS_X1B), p.norm_ffn, MOD, 3072, 4096, H, 0, TP, 32);
        GRID_BAR();
        phase_norm_mod_b((const bf16_t*)(ws + WS_X1B), p.norm_ffn, MOD, 3072, 4096, H, TP, T, 0);
      } else {
        pg8::StaticOrder S; S.init(T, 1024, G, cv); pg8::gemm_phase<EpiRes<false>, pg8::StaticOrder, true, true>(lds, g, S, E);
        GRID_BAR();
        phase_norm_mod_b((const bf16_t*)(ws + WS_X1B), p.norm_ffn, MOD, 3072, 4096, H);
      } }
    GRID_BAR();
    { pg8::Gemm g{H, (const bf16_t*)(ws + WS_WFI), T, INC, 1024}; pg8::StaticOrder S; S.init(T, INC, G, cv);
      EpiFfnIn E{(bf16_t*)(ws + WS_HID)}; pg8::gemm_phase<EpiFfnIn, pg8::StaticOrder, true, true>(lds, g, S, E);
#if PROBE_DUP == 9
      GRID_BAR(); pg8::gemm_phase<EpiFfnIn, pg8::StaticOrder, true, true>(lds, g, S, E);
#endif
    }
    GRID_BAR();
    { pg8::Gemm g{(const bf16_t*)(ws + WS_HID), (const bf16_t*)(ws + WS_WFO), T, 1024, FF}; EpiRes<true> E{nullptr, nullptr, (const bf16_t*)(ws + WS_X1B), (bf16_t*)(ws + WS_X2B), MOD + 5120};
      if (split_ps) {
        { pg8::StaticOrder S; S.init(TP, 1024, G, cv); pg8::gemm_phase<EpiRes<true>, pg8::StaticOrder, true, true>(lds, g, S, E); }
        GRID_BAR();
        float* PART = (float*)(ws + WS_CUM + 20 * MiB);
        if (bx < 64) { const int ks = bx >> 5; pg8::Gemm gs{(const bf16_t*)(ws + WS_HID) + ks * (FF / 2), (const bf16_t*)(ws + WS_WFO) + ks * (FF / 2), T, 1024, FF / 2, FF};
            pg8::StaticOrder S; S.init(TS, 1024, 32, bx & 31, TP / 256); EpiPart EP{PART + (size_t)ks * TS * D, TP}; pg8::gemm_phase<EpiPart, pg8::StaticOrder, true, true>(lds, gs, S, EP); }
        else phase_final_norm((const bf16_t*)(ws + WS_X2B), p.out, p.norm_final, 0, TP, 64);
        GRID_BAR();
        phase_final_norm_parts((const bf16_t*)(ws + WS_X1B), PART, PART + (size_t)TS * D, MOD + 5120, p.out, p.norm_final);
      } else {
        pg8::StaticOrder S; S.init(T, 1024, G, cv); pg8::gemm_phase<EpiRes<true>, pg8::StaticOrder, true, true>(lds, g, S, E);
        GRID_BAR();
        phase_final_norm((const bf16_t*)(ws + WS_X2B), p.out, p.norm_final);
      } }
}

extern "C" void kernel_launch(void* const* d_in, const int* in_sizes, int n_in, void* d_out, int out_size, void* d_ws, size_t ws_size, hipStream_t stream) {
    static int grid = 0;
    if (grid == 0) {
        if (n_in != 21 || (size_t)out_size != OUT_TOTAL || ws_size < WS_END) { fprintf(stderr, "kernel_launch: unexpected sizes n_in %d out %d ws %zu\n", n_in, out_size, ws_size); grid = -1; return; }
        int dev = 0, cus = 0, per = 0;
        (void)hipGetDevice(&dev); (void)hipDeviceGetAttribute(&cus, hipDeviceAttributeMultiprocessorCount, dev);
        (void)hipFuncSetAttribute((const void*)fwd_megakernel, hipFuncAttributeMaxDynamicSharedMemorySize, LDS_BYTES);
        (void)hipOccupancyMaxActiveBlocksPerMultiprocessor(&per, (const void*)fwd_megakernel, 512, LDS_BYTES);
        if (per < 1) per = 1;
        grid = cus * per; fprintf(stderr, "kernel_launch: grid %d (cus %d x %d)\n", grid, cus, per);
    }
    if (grid < 0) return;
    if (hipMemsetAsync((char*)d_ws + WS_BAR, 0, BAR_BYTES, stream) != hipSuccess) { fprintf(stderr, "kernel_launch: memset failed\n"); return; }
    Params p{};
    const float** f = (const float**)&p;
    for (int i = 0; i < 21; ++i) f[i] = (const float*)d_in[i];
    p.out = (float*)d_out; p.ws = (unsigned char*)d_ws;
    void* args[] = {&p};
    hipError_t e = hipLaunchCooperativeKernel((const void*)fwd_megakernel, dim3(grid), dim3(512), args, LDS_BYTES, stream);
    if (e != hipSuccess) fprintf(stderr, "cooperative launch failed: %s (grid %d)\n", hipGetErrorString(e), grid);
}
```

```cpp
#include <hip/hip_runtime.h>
#include <hip/hip_cooperative_groups.h>
#include <cstdio>
#include <cstdint>
namespace cg = cooperative_groups;
#ifndef PROBE_DUP
#define PROBE_DUP 0
#endif

#define DI __device__ __forceinline__
#define LAS __attribute__((address_space(3)))
typedef unsigned short bf16_t;
typedef short bf16x8 __attribute__((ext_vector_type(8)));
typedef float f32x4 __attribute__((ext_vector_type(4)));
typedef float f32x2 __attribute__((ext_vector_type(2)));
typedef float f32x16 __attribute__((ext_vector_type(16)));
typedef unsigned u32x4 __attribute__((ext_vector_type(4)));
typedef unsigned u32x2 __attribute__((ext_vector_type(2)));
typedef __bf16 bf2_t __attribute__((ext_vector_type(2)));

constexpr int D = 1024, TP = 32768, TS = 2048, T = TP + TS, NCH = T / 64, NBATCH = 34;
constexpr int INC = 5632, FF = 2816;
constexpr float EPS = 1e-6f, LOG2E = 1.4426950408889634f;
constexpr size_t OFF_Y = 0, OFF_SP = (size_t)T * D, OFF_KP = OFF_SP + 131072, OFF_VP = OFF_KP + 524288, OFF_SS = OFF_VP + 524288,
                 OFF_KS = OFF_SS + 2097152, OFF_VS = OFF_KS + 1048576, OUT_TOTAL = OFF_VS + 1048576;
constexpr size_t MiB = 1u << 20;
constexpr size_t WS_MOD = 1 * MiB, WS_DEC = 2 * MiB, WS_SC = 4 * MiB, WS_WADA = 5 * MiB, WS_WIN = 17 * MiB, WS_WAB = 28 * MiB, WS_WO = 30 * MiB,
                 WS_WFI = 32 * MiB, WS_WFO = 43 * MiB, WS_H = 50 * MiB, WS_QOB = 118 * MiB, WS_KA = 186 * MiB, WS_VA = 220 * MiB, WS_GA = 254 * MiB,
                 WS_KB = 288 * MiB, WS_VB = 322 * MiB, WS_CUM = 356 * MiB, WS_SST = 424 * MiB, WS_END = 492 * MiB;
constexpr size_t WS_U = WS_H, WS_M = WS_KA, WS_HID = WS_KA, WS_X1B = WS_QOB, WS_X2B = WS_H;
constexpr size_t WS_BAR = 0, BAR_BYTES = 16384;
constexpr int LDS_BYTES = 140 * 1024, LDS_ST_OFF = 136 * 1024;

struct Params {
    const float *x_prompt, *x_sample, *c_prompt, *c_sample, *state, *cache_k, *cache_v, *w_ada, *b_ada, *norm_mix, *w_in, *lb_logits, *out_norm,
                *w_a, *rel_bias, *w_b, *w_out, *norm_ffn, *w_ffn_in, *w_ffn_out, *norm_final;
    float* out; unsigned char* ws;
};

DI int fresh_tid() { int t = threadIdx.x; asm volatile("" : "+v"(t)); return t; }
DI int launder(int v) { asm volatile("" : "+v"(v)); return v; }
DI unsigned pk2(float a, float b) { f32x2 v = {a, b}; bf2_t r = __builtin_convertvector(v, bf2_t); return __builtin_bit_cast(unsigned, r); }
DI float bflo(unsigned u) { return __uint_as_float(u << 16); }
DI float bfhi(unsigned u) { return __uint_as_float(u & 0xffff0000u); }
DI float bf2f(short s) { return __uint_as_float(((unsigned)(unsigned short)s) << 16); }
DI float sigm(float x) { return __builtin_amdgcn_rcpf(1.f + __expf(-x)); }
DI float silu(float x) { return x * sigm(x); }
DI int batch_of(int r) { return r < TP ? (r >> 14) : 2 + ((r - TP) >> 6); }
DI int crow(int reg, int h) { return (reg & 3) + 8 * (reg >> 2) + 4 * h; }
DI bf16x8 pack8(const f32x16& x, int s) {
    u32x4 p; p.x = pk2(x[8 * s], x[8 * s + 1]); p.y = pk2(x[8 * s + 2], x[8 * s + 3]); p.z = pk2(x[8 * s + 4], x[8 * s + 5]); p.w = pk2(x[8 * s + 6], x[8 * s + 7]);
    return __builtin_bit_cast(bf16x8, p);
}
DI bf16x8 pack8f(const float* v) { u32x4 p; p.x = pk2(v[0], v[1]); p.y = pk2(v[2], v[3]); p.z = pk2(v[4], v[5]); p.w = pk2(v[6], v[7]); return __builtin_bit_cast(bf16x8, p); }
DI bf16x8 ident_frag(int ks, int l31, int hf) {
    const int jj = l31 - 16 * ks - 8 * hf; bf16x8 r;
#pragma unroll
    for (int j = 0; j < 8; ++j) r[j] = (j == jj) ? (short)0x3F80 : (short)0;
    return r;
}
DI u32x4 widen_pair(u32x2 pg, u32x2 pg1) { const auto rx = __builtin_amdgcn_permlane32_swap(pg.x, pg1.x, false, false), ry = __builtin_amdgcn_permlane32_swap(pg.y, pg1.y, false, false); return (u32x4){rx[0], ry[0], rx[1], ry[1]}; }
DI void narrow_pair(u32x4 d, u32x2& pg, u32x2& pg1) { const auto rx = __builtin_amdgcn_permlane32_swap(d.x, d.z, false, false), ry = __builtin_amdgcn_permlane32_swap(d.y, d.w, false, false); pg = (u32x2){rx[0], ry[0]}; pg1 = (u32x2){rx[1], ry[1]}; }
#define MFMA32(a, b, c) __builtin_amdgcn_mfma_f32_32x32x16_bf16((a), (b), (c), 0, 0, 0)
DI f32x16 zero16() { f32x16 z;
#pragma unroll
    for (int i = 0; i < 16; ++i) z[i] = 0.f; return z; }

namespace pg8 {
constexpr int BM = 256, BK = 64, HALF = 128, HTB = HALF * BK * 2, STAGE_BYTES = 8 * HTB, NXCD = 8, WGM = 8;
__host__ __device__ __forceinline__ int lds_byte(int r, int c) { const int st = (r >> 4) * 2 + (c >> 5), rr = r & 15, cc = c & 31, ob = rr * 64 + cc * 2; return st * 1024 + (ob ^ (((ob >> 9) & 1) << 5)); }
__host__ __device__ __forceinline__ void stage_rc(int b, int& R, int& C) { const int st = b / 1024, sb = b % 1024, swz = sb ^ (((sb >> 9) & 1) << 5); R = (st >> 1) * 16 + swz / 64; C = (st & 1) * 32 + (swz % 64) / 2; }
__host__ __device__ __forceinline__ int perm32(int rho) { const int n = rho >> 4, i = rho & 15; return 8 * (i >> 2) + 4 * n + (i & 3); }
struct Unit { int pm, pn; };
struct Gemm { const bf16_t* A; const bf16_t* Bt; int M, N, K, ld; };
struct StaticOrder {
    int nM, nN, nwg, G, c, pm_off;
    __device__ void init(int M, int N, int G_, int c_, int pm_off_ = 0) { nM = M / BM; nN = N / BM; nwg = nM * nN; G = G_; c = c_; pm_off = pm_off_; }
    __device__ bool next(int i, Unit& u) const {
        const long L = (long)i * G + c; if (L >= nwg) return false;
        int wgid = (int)L; { const int q = nwg / NXCD, r = nwg % NXCD, xcd = wgid % NXCD, off = wgid / NXCD; wgid = (xcd < r ? xcd * (q + 1) : r * (q + 1) + (xcd - r) * q) + off; }
        const int nig = WGM * nN, gid = wgid / nig, fm = gid * WGM, gsz = (nM - fm) < WGM ? (nM - fm) : WGM;
        u.pm = pm_off + fm + ((wgid % nig) % gsz); u.pn = (wgid % nig) / gsz; return true;
    }
};
template <class Epi, class Sched, bool ALIGN_EPI = false, bool SP2 = false>
__device__ __forceinline__ void gemm_phase(LAS unsigned char* lds, const Gemm g, const Sched& S, const Epi& E) {
    const int tid = fresh_tid(), wid = __builtin_amdgcn_readfirstlane(tid >> 6), lane = tid & 63, wr = wid >> 2, wc = wid & 3, fr = lane & 15, fq = lane >> 4;
    const int K = g.ld ? g.ld : g.K, nt = g.K / BK;
    unsigned voffA[2], voffB[2];
#pragma unroll
    for (int i = 0; i < 2; ++i) { int R, C; stage_rc(tid * 16 + i * 8192, R, C); const int Rb = Epi::PERM ? ((R & ~31) + perm32(R & 31)) : R;
        voffA[i] = (unsigned)(R * K + C) * 2u; voffB[i] = (unsigned)(Rb * K + C) * 2u; }
    const size_t kstep = (size_t)(BK * 2);
    const size_t hstep = (size_t)HALF * K * 2;
    const size_t tstep = 2 * hstep;
    const unsigned ldsw = (unsigned)wid * 1024u;
    const int aoff = lds_byte(wr * 64 + fr, fq * 8), boff = lds_byte(wc * 32 + fr, fq * 8);
#define PG8_SA(b, h) (((b) * 2 + (h)) * HTB)
#define PG8_SB(b, h) ((4 + (b) * 2 + (h)) * HTB)
#define PG8_STAGE(bufoff, gbase, voff) do { _Pragma("unroll") for (int _i = 0; _i < 2; ++_i) \
        __builtin_amdgcn_global_load_lds((const unsigned*)((const char*)(gbase) + (voff)[_i]), (LAS unsigned*)(lds + (bufoff) + ldsw + _i * 8192), 16, 0, 0); } while (0)
#define PG8_LDA(dst, b, h) do { _Pragma("unroll") for (int m = 0; m < 4; ++m) _Pragma("unroll") for (int k = 0; k < 2; ++k) dst[m][k] = *(const LAS bf16x8*)(lds + PG8_SA(b, h) + aoff + m * 2048 + k * 1024); } while (0)
#define PG8_LDB(dst, b, h) do { _Pragma("unroll") for (int n = 0; n < 2; ++n) _Pragma("unroll") for (int k = 0; k < 2; ++k) dst[n][k] = *(const LAS bf16x8*)(lds + PG8_SB(b, h) + boff + n * 2048 + k * 1024); } while (0)
#define PG8_MMA(ai, bj, At, Bt) do { __builtin_amdgcn_s_setprio(1); _Pragma("unroll") for (int m = 0; m < 4; ++m) _Pragma("unroll") for (int n = 0; n < 2; ++n) _Pragma("unroll") for (int k = 0; k < 2; ++k) \
        acc[ai][bj][m][n] = __builtin_amdgcn_mfma_f32_16x16x32_bf16(Bt[n][k], At[m][k], acc[ai][bj][m][n], 0, 0, 0); __builtin_amdgcn_s_setprio(0); } while (0)
#define PG8_WAIT_V(n) asm volatile("s_waitcnt vmcnt(" #n ")" ::: "memory")
#define PG8_WAIT_L(n) asm volatile("s_waitcnt lgkmcnt(" #n ")" ::: "memory")
#define PG8_BAR __builtin_amdgcn_s_barrier()
#define PG8_SCHED __builtin_amdgcn_sched_barrier(0)
    Unit cur, nxt; int ui = 0;
    if (!S.next(0, cur)) return;
    f32x4 acc[2][2][4][2];
#pragma unroll
    for (int a = 0; a < 2; ++a)
#pragma unroll
        for (int b = 0; b < 2; ++b)
#pragma unroll
            for (int m = 0; m < 4; ++m)
#pragma unroll
                for (int n = 0; n < 2; ++n) acc[a][b][m][n] = (f32x4){0.f, 0.f, 0.f, 0.f};
    bf16x8 At[4][2], B0[2][2], B1[2][2];
    const char* cA = (const char*)g.A + (size_t)cur.pm * tstep; const char* cB = (const char*)g.Bt + (size_t)cur.pn * tstep;
    if constexpr (SP2) {
        PG8_STAGE(PG8_SB(0, 0), cB, voffB); PG8_STAGE(PG8_SB(0, 1), cB + hstep, voffB); PG8_STAGE(PG8_SA(0, 0), cA, voffA); PG8_STAGE(PG8_SA(0, 1), cA + hstep, voffA);
        if (wr == 1) PG8_BAR;
        PG8_WAIT_V(2); PG8_BAR;
        PG8_STAGE(PG8_SB(1, 0), cB + kstep, voffB); PG8_STAGE(PG8_SA(1, 0), cA + kstep, voffA); PG8_STAGE(PG8_SB(1, 1), cB + hstep + kstep, voffB);
        PG8_WAIT_V(6); PG8_BAR;
    } else {
        PG8_STAGE(PG8_SB(0, 0), cB, voffB); PG8_STAGE(PG8_SA(0, 0), cA, voffA); PG8_STAGE(PG8_SB(0, 1), cB + hstep, voffB); PG8_STAGE(PG8_SA(0, 1), cA + hstep, voffA);
        if (wr == 1) PG8_BAR;
        PG8_WAIT_V(4); PG8_BAR;
        PG8_STAGE(PG8_SB(1, 0), cB + kstep, voffB); PG8_STAGE(PG8_SA(1, 0), cA + kstep, voffA); PG8_STAGE(PG8_SB(1, 1), cB + hstep + kstep, voffB);
        PG8_WAIT_V(6); PG8_BAR;
    }
    for (;;) {
        const bool has_next = S.next(ui + 1, nxt);
        const char* nA = has_next ? (const char*)g.A + (size_t)nxt.pm * tstep : cA; const char* nB = has_next ? (const char*)g.Bt + (size_t)nxt.pn * tstep : cB;
        for (int t = 0; t < nt; t += 2) {
            if constexpr (Epi::MIDK) { if (t == nt / 2) E.mid(acc, cur, wr, wc, fr, fq); }
            const bool last = (t == nt - 2);
            const char* a1 = cA + (size_t)(t + 1) * kstep;
            const char* a2 = last ? nA : cA + (size_t)(t + 2) * kstep; const char* b2 = last ? nB : cB + (size_t)(t + 2) * kstep;
            const char* a3 = a2 + kstep; const char* b3 = b2 + kstep;
            if constexpr (SP2) {
            PG8_LDB(B0, 0, 0); PG8_LDB(B1, 0, 1); PG8_SCHED; PG8_LDA(At, 0, 0); PG8_STAGE(PG8_SA(1, 1), a1 + hstep, voffA);
            PG8_WAIT_V(8); PG8_WAIT_L(0); PG8_BAR; PG8_MMA(0, 0, At, B0); PG8_MMA(0, 1, At, B1); PG8_BAR; PG8_SCHED;
            PG8_LDA(At, 0, 1); PG8_STAGE(PG8_SB(0, 0), b2, voffB); PG8_STAGE(PG8_SB(0, 1), b2 + hstep, voffB); PG8_STAGE(PG8_SA(0, 0), a2, voffA);
            PG8_WAIT_V(8); PG8_WAIT_L(0); PG8_BAR; PG8_MMA(1, 0, At, B0); PG8_MMA(1, 1, At, B1); PG8_BAR; PG8_SCHED;
            PG8_LDB(B0, 1, 0); PG8_LDB(B1, 1, 1); PG8_SCHED; PG8_LDA(At, 1, 0); PG8_STAGE(PG8_SA(0, 1), a2 + hstep, voffA);
            PG8_WAIT_V(8); PG8_WAIT_L(0); PG8_BAR; PG8_MMA(0, 0, At, B0); PG8_MMA(0, 1, At, B1); PG8_BAR; PG8_SCHED;
            PG8_LDA(At, 1, 1); PG8_STAGE(PG8_SB(1, 0), b3, voffB); PG8_STAGE(PG8_SB(1, 1), b3 + hstep, voffB); PG8_STAGE(PG8_SA(1, 0), a3, voffA);
            PG8_WAIT_V(8); PG8_WAIT_L(0); PG8_BAR; PG8_MMA(1, 0, At, B0); PG8_MMA(1, 1, At, B1); PG8_BAR; PG8_SCHED;
            } else {
            PG8_LDB(B0, 0, 0); PG8_SCHED; PG8_LDA(At, 0, 0); PG8_STAGE(PG8_SA(1, 1), a1 + hstep, voffA);
            PG8_WAIT_L(8); PG8_BAR; PG8_WAIT_L(0); PG8_MMA(0, 0, At, B0); PG8_BAR; PG8_SCHED;
            PG8_LDB(B1, 0, 1); PG8_STAGE(PG8_SB(0, 0), b2, voffB);
            PG8_BAR; PG8_WAIT_L(0); PG8_MMA(0, 1, At, B1); PG8_BAR;
            PG8_LDA(At, 0, 1); PG8_STAGE(PG8_SA(0, 0), a2, voffA);
            PG8_BAR; PG8_WAIT_L(0); PG8_MMA(1, 0, At, B0); PG8_BAR; PG8_SCHED;
            PG8_STAGE(PG8_SB(0, 1), b2 + hstep, voffB);
            PG8_WAIT_V(6); PG8_BAR; PG8_MMA(1, 1, At, B1); PG8_BAR;
            PG8_LDB(B0, 1, 0); PG8_SCHED; PG8_LDA(At, 1, 0); PG8_STAGE(PG8_SA(0, 1), a2 + hstep, voffA);
            PG8_WAIT_L(8); PG8_BAR; PG8_WAIT_L(0); PG8_MMA(0, 0, At, B0); PG8_BAR; PG8_SCHED;
            PG8_LDB(B1, 1, 1); PG8_STAGE(PG8_SB(1, 0), b3, voffB);
            PG8_BAR; PG8_WAIT_L(0); PG8_MMA(0, 1, At, B1); PG8_BAR;
            PG8_LDA(At, 1, 1); PG8_STAGE(PG8_SA(1, 0), a3, voffA);
            PG8_BAR; PG8_WAIT_L(0); PG8_MMA(1, 0, At, B0); PG8_BAR; PG8_SCHED;
            PG8_STAGE(PG8_SB(1, 1), b3 + hstep, voffB);
            PG8_WAIT_V(6); PG8_BAR; PG8_MMA(1, 1, At, B1); PG8_BAR;
            }
        }
        if constexpr (ALIGN_EPI) { if (wr == 0) PG8_BAR; }
        E(acc, cur, wr, wc, fr, fq);
        if (!has_next) break;
#pragma unroll
        for (int a = 0; a < 2; ++a)
#pragma unroll
            for (int b = 0; b < 2; ++b)
#pragma unroll
                for (int m = 0; m < 4; ++m)
#pragma unroll
                    for (int n = 0; n < 2; ++n) acc[a][b][m][n] = (f32x4){0.f, 0.f, 0.f, 0.f};
        cur = nxt; cA = nA; cB = nB; ++ui;
        if constexpr (ALIGN_EPI) { if (wr == 1) PG8_BAR; }
    }
    PG8_WAIT_V(0);
    if constexpr (!ALIGN_EPI) { if (wr == 0) PG8_BAR; }
    PG8_BAR;
#undef PG8_SA
#undef PG8_SB
#undef PG8_STAGE
#undef PG8_LDA
#undef PG8_LDB
#undef PG8_MMA
#undef PG8_WAIT_V
#undef PG8_WAIT_L
#undef PG8_BAR
#undef PG8_SCHED
}
}
using pg8::Unit;
typedef f32x4 Acc[2][2][4][2];

DI u32x4 pack_row8(const f32x4& v0, const f32x4& v1) { u32x4 w; w.x = pk2(v0[0], v0[1]); w.y = pk2(v0[2], v0[3]); w.z = pk2(v1[0], v1[1]); w.w = pk2(v1[2], v1[3]); return w; }

struct EpiMod {
    static constexpr bool PERM = false, MIDK = false;
    float* mod; const float* bias;
    DI void operator()(Acc& acc, const Unit& u, int wr, int wc, int fr, int fq) const {
        { const int t_ = fresh_tid(); fr = t_ & 15; fq = (t_ >> 4) & 3; }
        if (u.pm != 0 || wr != 0) return;
#pragma unroll
        for (int m = 0; m < 3; ++m) { const int r = 16 * m + fr; if (r < NBATCH) {
#pragma unroll
            for (int bj = 0; bj < 2; ++bj)
#pragma unroll
                for (int n = 0; n < 2; ++n) { const int col = u.pn * 256 + bj * 128 + wc * 32 + n * 16 + 4 * fq;
                    *(f32x4*)(mod + (size_t)r * 6144 + col) = acc[0][bj][m][n] + *(const f32x4*)(bias + col); } } }
    }
};

struct EpiIn {
    static constexpr bool PERM = true, MIDK = false;
    bf16_t *QOB, *KA, *VA, *GA, *KB, *VB, *SGA, *SGB; float *CUM, *DEC; const float* lbl; float* out;
    DI void operator()(Acc& acc, const Unit& u, int wr, int wc, int fr, int fq) const {
        { const int t_ = fresh_tid(); fr = t_ & 15; fq = (t_ >> 4) & 3; }
        const int pn = u.pn, rt = wr * 64 + fr, row0 = u.pm * 256 + rt, cw = wc * 32 + 8 * fq, lane = fq * 16 + fr;
        if (pn >= 14) {
            const size_t o0 = ((size_t)(u.pm * 8 + (pn - 14)) * 8 * 512 + (size_t)(wr * 4 + wc) * 64 + lane) * 8;
#pragma unroll
            for (int ai = 0; ai < 2; ++ai)
#pragma unroll
                for (int m = 0; m < 4; ++m) { f32x4 r0, r1, b0, b1;
#pragma unroll
                    for (int j = 0; j < 4; ++j) { b0[j] = fmaxf(sigm(acc[ai][1][m][0][j]), 1e-30f); b1[j] = fmaxf(sigm(acc[ai][1][m][1][j]), 1e-30f);
                        r0[j] = sigm(acc[ai][0][m][0][j]) * __builtin_amdgcn_rcpf(b0[j]); r1[j] = sigm(acc[ai][0][m][1][j]) * __builtin_amdgcn_rcpf(b1[j]); }
                    const size_t o = o0 + (size_t)(ai * 4 + m) * 512 * 8;
                    *(u32x4*)(SGA + o) = pack_row8(r0, r1); *(u32x4*)(SGB + o) = pack_row8(b0, b1); __builtin_amdgcn_sched_barrier(0); }
            return;
        }
        const int seg = pn >> 1, col0 = (pn & 1) * 256 + cw;
        if (seg == 1) {
#pragma unroll
            for (int bj = 0; bj < 2; ++bj) {
                float lb[2][4];
#pragma unroll
                for (int n = 0; n < 2; ++n)
#pragma unroll
                    for (int j = 0; j < 4; ++j) { const int c = col0 + bj * 128 + 4 * n + j; lb[n][j] = __builtin_amdgcn_rcpf(1.f + __expf(lbl[512 + c] - lbl[c])); }
#pragma unroll
                for (int ai = 0; ai < 2; ++ai) {
                    const size_t rbase = ((size_t)((pn & 1) * 2 + bj) * T + (u.pm * 256 + ai * 128 + wr * 64 + launder(fr))) * 128 + cw;
#pragma unroll
                    for (int m = 0; m < 4; ++m) { f32x4 k0, k1;
#pragma unroll
                        for (int j = 0; j < 4; ++j) {
                            float f = lb[0][j] + (1.f - lb[0][j]) * sigm(acc[ai][bj][m][0][j]); k0[j] = 1.f - f; acc[ai][bj][m][0][j] = __logf(f);
                            f = lb[1][j] + (1.f - lb[1][j]) * sigm(acc[ai][bj][m][1][j]); k1[j] = 1.f - f; acc[ai][bj][m][1][j] = __logf(f); }
                        *(u32x4*)(KA + rbase + (size_t)m * 16 * 128) = pack_row8(k0, k1); }
                    __builtin_amdgcn_sched_barrier(0);
#pragma unroll
                    for (int n = 0; n < 2; ++n)
#pragma unroll
                        for (int j = 0; j < 4; ++j) { float carry = 0.f;
#pragma unroll
                            for (int m = 0; m < 4; ++m) { float v = acc[ai][bj][m][n][j];
                                v += __int_as_float(__builtin_amdgcn_update_dpp(0, __float_as_int(v), 0x111, 0xf, 0xf, false));
                                v += __int_as_float(__builtin_amdgcn_update_dpp(0, __float_as_int(v), 0x112, 0xf, 0xf, false));
                                v += __int_as_float(__builtin_amdgcn_update_dpp(0, __float_as_int(v), 0x114, 0xf, 0xf, false));
                                v += __int_as_float(__builtin_amdgcn_update_dpp(0, __float_as_int(v), 0x118, 0xf, 0xf, false));
                                v += carry; carry = __shfl(v, lane | 15); acc[ai][bj][m][n][j] = v; } }
                    __builtin_amdgcn_sched_barrier(0);
#pragma unroll
                    for (int m = 0; m < 4; ++m) { float* cp = CUM + rbase + (size_t)m * 16 * 128; *(f32x4*)cp = acc[ai][bj][m][0]; *(f32x4*)(cp + 4) = acc[ai][bj][m][1]; }
                    if (fr == 15) {
#pragma unroll
                        for (int n = 0; n < 2; ++n) { f32x4 e;
#pragma unroll
                            for (int j = 0; j < 4; ++j) e[j] = __expf(acc[ai][bj][3][n][j]);
                            *(f32x4*)(DEC + (size_t)(u.pm * 4 + ai * 2 + wr) * 512 + col0 + bj * 128 + 4 * n) = e; } }
                    __builtin_amdgcn_sched_barrier(0);
                }
            }
            return;
        }
        bf16_t* dst; int pitch = 512; size_t bjoff = 128; float* o32 = nullptr;
        switch (seg) {
            case 0: dst = QOB + col0; pitch = 1024; break;
            case 2: dst = VA + (size_t)((pn & 1) * 2) * T * 128 + cw; pitch = 128; bjoff = (size_t)T * 128; break;
            case 3: dst = GA + (size_t)((pn & 1) * 2) * T * 128 + cw; pitch = 128; bjoff = (size_t)T * 128; break;
            case 4: dst = QOB + 512 + col0; pitch = 1024; break;
            default: dst = (seg == 5 ? KB : VB) + (size_t)((pn & 1) * 4 + (wc >> 1)) * T * 64 + (wc & 1) * 32 + 8 * fq; pitch = 64; bjoff = (size_t)2 * T * 64; break;
        }
        if (seg >= 5) {
            if (u.pm >= 128) o32 = out + (seg == 5 ? OFF_KS : OFF_VS) + (size_t)((u.pm - 128) * 256 + rt) * 512 + col0;
            else if ((u.pm & 63) >= 62) o32 = out + (seg == 5 ? OFF_KP : OFF_VP) + (size_t)((u.pm >> 6) * 512 + ((u.pm & 63) - 62) * 256 + rt) * 512 + col0;
        }
        const bool act = (seg == 0 || seg == 3);
#pragma unroll
        for (int ai = 0; ai < 2; ++ai)
#pragma unroll
            for (int m = 0; m < 4; ++m)
#pragma unroll
                for (int bj = 0; bj < 2; ++bj) { f32x4 v0 = acc[ai][bj][m][0], v1 = acc[ai][bj][m][1];
                    if (act) {
#pragma unroll
                        for (int j = 0; j < 4; ++j) { v0[j] = silu(v0[j]); v1[j] = silu(v1[j]); } }
                    *(u32x4*)(dst + (size_t)(row0 + ai * 128 + m * 16) * pitch + bj * bjoff) = pack_row8(v0, v1);
                    if (o32) { float* op = o32 + (size_t)(ai * 128 + m * 16) * 512 + bj * 128; *(f32x4*)op = v0; *(f32x4*)(op + 4) = v1; } __builtin_amdgcn_sched_barrier(0); }
    }
};

struct EpiMerge {
    static constexpr bool PERM = true, MIDK = true;
    const bf16_t *SGR, *SGB; bf16_t* Mo;
    DI void mid(Acc& acc, const Unit& u, int wr, int wc, int fr, int fq) const {
        { const int t_ = fresh_tid(); fr = t_ & 15; fq = (t_ >> 4) & 3; }
        const size_t gb = ((size_t)(u.pm * 8 + 2 * u.pn) * 8 * 512 + (size_t)(wr * 4 + wc) * 64 + (fq * 16 + fr)) * 8;
#pragma unroll
        for (int ai = 0; ai < 2; ++ai) { u32x4 a[4][2];
#pragma unroll
            for (int m = 0; m < 4; ++m)
#pragma unroll
                for (int bj = 0; bj < 2; ++bj) a[m][bj] = *(const u32x4*)(SGR + gb + ((size_t)bj * 8 + ai * 4 + m) * 512 * 8);
#pragma unroll
            for (int m = 0; m < 4; ++m)
#pragma unroll
                for (int bj = 0; bj < 2; ++bj)
#pragma unroll
                    for (int j = 0; j < 4; ++j) { acc[ai][bj][m][j >> 1][(j & 1) * 2] *= bflo(a[m][bj][j]); acc[ai][bj][m][j >> 1][(j & 1) * 2 + 1] *= bfhi(a[m][bj][j]); }
            __builtin_amdgcn_sched_barrier(0); }
    }
    DI void operator()(Acc& acc, const Unit& u, int wr, int wc, int fr, int fq) const {
        { const int t_ = fresh_tid(); fr = t_ & 15; fq = (t_ >> 4) & 3; }
        const size_t base = (size_t)(u.pm * 256 + wr * 64 + fr) * 1024 + u.pn * 256 + wc * 32 + 8 * fq;
        const size_t gb = ((size_t)(u.pm * 8 + 2 * u.pn) * 8 * 512 + (size_t)(wr * 4 + wc) * 64 + (fq * 16 + fr)) * 8;
#pragma unroll
        for (int ai = 0; ai < 2; ++ai) { u32x4 b[4][2];
#pragma unroll
            for (int m = 0; m < 4; ++m)
#pragma unroll
                for (int bj = 0; bj < 2; ++bj) b[m][bj] = *(const u32x4*)(SGB + gb + ((size_t)bj * 8 + ai * 4 + m) * 512 * 8);
#pragma unroll
            for (int m = 0; m < 4; ++m)
#pragma unroll
                for (int bj = 0; bj < 2; ++bj) { f32x4 v0 = acc[ai][bj][m][0], v1 = acc[ai][bj][m][1]; const u32x4 g = b[m][bj];
                    v0[0] *= bflo(g[0]); v0[1] *= bfhi(g[0]); v0[2] *= bflo(g[1]); v0[3] *= bfhi(g[1]);
                    v1[0] *= bflo(g[2]); v1[1] *= bfhi(g[2]); v1[2] *= bflo(g[3]); v1[3] *= bfhi(g[3]);
                    *(u32x4*)(Mo + base + (size_t)(ai * 128 + m * 16) * 1024 + bj * 128) = pack_row8(v0, v1); }
            __builtin_amdgcn_sched_barrier(0); }
    }
};

template <bool BASE_BF16> struct EpiRes {
    static constexpr bool PERM = true, MIDK = false;
    const float *xp, *xs; const bf16_t* xb; bf16_t* xo; const float* gmod;
    DI void operator()(Acc& acc, const Unit& u, int wr, int wc, int fr, int fq) const {
        { const int t_ = fresh_tid(); fr = t_ & 15; fq = (t_ >> 4) & 3; }
        const int colb = u.pn * 256 + wc * 32 + 8 * fq;
#pragma unroll
        for (int ai = 0; ai < 2; ++ai) { const int r0 = u.pm * 256 + ai * 128 + wr * 64 + fr;
            const float* g = gmod + (size_t)batch_of(r0) * 6144 + colb;
            f32x4 gv[2][2];
#pragma unroll
            for (int bj = 0; bj < 2; ++bj) { gv[bj][0] = *(const f32x4*)(g + bj * 128); gv[bj][1] = *(const f32x4*)(g + bj * 128 + 4); }
            bf16_t* orow = xo + (size_t)r0 * D + colb;
            if constexpr (BASE_BF16) {
                const bf16_t* xr = xb + (size_t)r0 * D + colb; u32x4 xv[4][2];
#pragma unroll
                for (int m = 0; m < 4; ++m)
#pragma unroll
                    for (int bj = 0; bj < 2; ++bj) xv[m][bj] = *(const u32x4*)(xr + (size_t)m * 16 * D + bj * 128);
#pragma unroll
                for (int m = 0; m < 4; ++m)
#pragma unroll
                    for (int bj = 0; bj < 2; ++bj) { const u32x4 x = xv[m][bj]; const f32x4 a0 = acc[ai][bj][m][0] * gv[bj][0], a1 = acc[ai][bj][m][1] * gv[bj][1];
                        f32x4 v0 = {bflo(x[0]) + a0[0], bfhi(x[0]) + a0[1], bflo(x[1]) + a0[2], bfhi(x[1]) + a0[3]}, v1 = {bflo(x[2]) + a1[0], bfhi(x[2]) + a1[1], bflo(x[3]) + a1[2], bfhi(x[3]) + a1[3]};
                        *(u32x4*)(orow + (size_t)m * 16 * D + bj * 128) = pack_row8(v0, v1); }
            } else {
                const float* xr = (r0 < TP ? xp + (size_t)r0 * D : xs + (size_t)(r0 - TP) * D) + colb; f32x4 xv[4][2][2];
#pragma unroll
                for (int m = 0; m < 4; ++m)
#pragma unroll
                    for (int bj = 0; bj < 2; ++bj) { xv[m][bj][0] = *(const f32x4*)(xr + (size_t)m * 16 * D + bj * 128); xv[m][bj][1] = *(const f32x4*)(xr + (size_t)m * 16 * D + bj * 128 + 4); }
#pragma unroll
                for (int m = 0; m < 4; ++m)
#pragma unroll
                    for (int bj = 0; bj < 2; ++bj) *(u32x4*)(orow + (size_t)m * 16 * D + bj * 128) = pack_row8(xv[m][bj][0] + gv[bj][0] * acc[ai][bj][m][0], xv[m][bj][1] + gv[bj][1] * acc[ai][bj][m][1]);
            }
            __builtin_amdgcn_sched_barrier(0); }
    }
};

struct EpiPart {
    static constexpr bool PERM = false, MIDK = false;
    float* part; int row0;
    DI void operator()(Acc& acc, const Unit& u, int wr, int wc, int fr, int fq) const {
        { const int t_ = fresh_tid(); fr = t_ & 15; fq = (t_ >> 4) & 3; }
#pragma unroll
        for (int ai = 0; ai < 2; ++ai)
#pragma unroll
            for (int m = 0; m < 4; ++m) { float* prow = part + (size_t)(u.pm * 256 + ai * 128 + wr * 64 + m * 16 + fr - row0) * D + u.pn * 256 + wc * 32 + 4 * fq;
#pragma unroll
                for (int bj = 0; bj < 2; ++bj)
#pragma unroll
                    for (int n = 0; n < 2; ++n) *(f32x4*)(prow + bj * 128 + n * 16) = acc[ai][bj][m][n];
                __builtin_amdgcn_sched_barrier(0); }
    }
};

struct EpiFfnIn {
    static constexpr bool PERM = true, MIDK = false;
    bf16_t* HID;
    DI void operator()(Acc& acc, const Unit& u, int wr, int wc, int fr, int fq) const {
        { const int t_ = fresh_tid(); fr = t_ & 15; fq = (t_ >> 4) & 3; }
        bf16_t* base = HID + (size_t)(u.pm * 256 + wr * 64 + fr) * FF + u.pn * 128 + wc * 32 + 8 * fq;
#pragma unroll
        for (int ai = 0; ai < 2; ++ai)
#pragma unroll
            for (int m = 0; m < 4; ++m) { f32x4 v0, v1;
#pragma unroll
                for (int j = 0; j < 4; ++j) { v0[j] = silu(acc[ai][0][m][0][j]) * acc[ai][1][m][0][j]; v1[j] = silu(acc[ai][0][m][1][j]) * acc[ai][1][m][1][j]; }
                *(u32x4*)(base + (size_t)(ai * 128 + m * 16) * FF) = pack_row8(v0, v1); __builtin_amdgcn_sched_barrier(0); }
    }
};

DI void transpose_item(const float* W, int N, bf16_t* WT, int pitch, int koff, int k0, int n0, int drow0, LAS float* scr, int lane) {
#pragma unroll
    for (int i = 0; i < 32; ++i) { const int kk = 2 * i + (lane >> 5); scr[kk * 33 + (lane & 31)] = W[(size_t)(k0 + kk) * N + n0 + (lane & 31)]; }
    asm volatile("s_waitcnt lgkmcnt(0)" ::: "memory");
    const int c = lane & 7;
#pragma unroll
    for (int j = 0; j < 4; ++j) { const int n = (lane >> 3) + 8 * j; const LAS float* s = scr + (8 * c) * 33 + n;
        u32x4 o; o.x = pk2(s[0 * 33], s[1 * 33]); o.y = pk2(s[2 * 33], s[3 * 33]); o.z = pk2(s[4 * 33], s[5 * 33]); o.w = pk2(s[6 * 33], s[7 * 33]);
        *(u32x4*)(WT + (size_t)(drow0 + n) * pitch + koff + k0 + 8 * c) = o; }
    asm volatile("s_waitcnt lgkmcnt(0)" ::: "memory");
}
DI void phase_prep(const Params& p, LAS unsigned char* lds) {
    const int tid = fresh_tid(), lane = tid & 63, wave = __builtin_amdgcn_readfirstlane(tid >> 6);
    LAS float* scr = (LAS float*)(lds + wave * 16384);
    const int gw = blockIdx.x * 8 + wave, NGW = gridDim.x * 8;
    unsigned char* ws = p.ws;
    constexpr int I_ADA = 16 * 192, I_IN = 16 * 176, I_A = 8 * 32, I_O = 16 * 32, I_FI = 16 * 176, I_FO = 44 * 32;
    constexpr int NIT = I_ADA + I_IN + 2 * I_A + I_O + I_FI + I_FO;
    for (int it = gw; it < NIT; it += NGW) {
        int r = it;
        if (r < I_ADA) { const int kb = r / 192, nb = r % 192; transpose_item(p.w_ada, 6144, (bf16_t*)(ws + WS_WADA), 1024, 0, 64 * kb, 32 * nb, 32 * nb, scr, lane); continue; } r -= I_ADA;
        if (r < I_IN) { const int kb = r / 176, nb = r % 176, n0 = 32 * nb; int dr = n0;
            if (n0 >= 3584) { const int j = n0 < 4608 ? n0 - 3584 : n0 - 4608; dr = 3584 + 256 * (j >> 7) + (j & 127) + (n0 < 4608 ? 0 : 128); }
            transpose_item(p.w_in, INC, (bf16_t*)(ws + WS_WIN), 1024, 0, 64 * kb, n0, dr, scr, lane); continue; } r -= I_IN;
        if (r < I_A) { const int kb = r / 32, nb = r % 32; transpose_item(p.w_a, 1024, (bf16_t*)(ws + WS_WAB), 1024, 0, 64 * kb, 32 * nb, 32 * nb, scr, lane); continue; } r -= I_A;
        if (r < I_A) { const int kb = r / 32, nb = r % 32; transpose_item(p.w_b, 1024, (bf16_t*)(ws + WS_WAB), 1024, 512, 64 * kb, 32 * nb, 32 * nb, scr, lane); continue; } r -= I_A;
        if (r < I_O) { const int kb = r / 32, nb = r % 32; transpose_item(p.w_out, 1024, (bf16_t*)(ws + WS_WO), 1024, 0, 64 * kb, 32 * nb, 32 * nb, scr, lane); continue; } r -= I_O;
        if (r < I_FI) { const int kb = r / 176, nb = r % 176; const int n0 = 32 * nb; const int j0 = n0 < FF ? n0 : n0 - FF;
            transpose_item(p.w_ffn_in, INC, (bf16_t*)(ws + WS_WFI), 1024, 0, 64 * kb, n0, 256 * (j0 >> 7) + (j0 & 127) + (n0 < FF ? 0 : 128), scr, lane); continue; } r -= I_FI;
        { const int kb = r / 32, nb = r % 32; transpose_item(p.w_ffn_out, 1024, (bf16_t*)(ws + WS_WFO), FF, 0, 64 * kb, 32 * nb, 32 * nb, scr, lane); }
    }
    bf16_t* SC = (bf16_t*)(ws + WS_SC);
    for (int i = blockIdx.x * 512 + tid; i < 256 * 1024 / 2; i += gridDim.x * 512) { const int row = (2 * i) >> 10, col = (2 * i) & 1023; float a = 0.f, b = 0.f;
        if (row < NBATCH) { const float* c = row < 2 ? p.c_prompt + row * D : p.c_sample + (row - 2) * D; a = silu(c[col]); b = silu(c[col + 1]); }
        ((unsigned*)SC)[i] = pk2(a, b); }
}

DI float wave_sum(float v) {
#pragma unroll
    for (int o = 1; o < 64; o <<= 1) v += __shfl_xor(v, o);
    return v;
}
DI void phase_norm_mod(const float* xp, const float* xs, const float* nw, const float* mod, int sh_off, int sc_off, bf16_t* H) {
    const int tid = fresh_tid(), lane = tid & 63, wave = __builtin_amdgcn_readfirstlane(tid >> 6);
    const int gw = blockIdx.x * 8 + wave, NGW = gridDim.x * 8;
    for (int r = gw; r < T; r += NGW) {
        const float* xr = r < TP ? xp + (size_t)r * D : xs + (size_t)(r - TP) * D; const float* mb = mod + (size_t)batch_of(r) * 6144;
        f32x4 v[4]; float s = 0.f;
#pragma unroll
        for (int j = 0; j < 4; ++j) { v[j] = *(const f32x4*)(xr + 4 * lane + 256 * j); s += (v[j][0] * v[j][0] + v[j][1] * v[j][1]) + (v[j][2] * v[j][2] + v[j][3] * v[j][3]); }
        const float rstd = __builtin_amdgcn_rsqf(wave_sum(s) * (1.f / D) + EPS);
#pragma unroll
        for (int j = 0; j < 4; ++j) { const int col = 4 * lane + 256 * j; const f32x4 w = *(const f32x4*)(nw + col), sc = *(const f32x4*)(mb + sc_off + col), sh = *(const f32x4*)(mb + sh_off + col);
            const f32x4 h = v[j] * rstd * w * (sc + 1.f) + sh; u32x2 o; o.x = pk2(h[0], h[1]); o.y = pk2(h[2], h[3]);
            *(u32x2*)(H + (size_t)r * D + col) = o; }
    }
}
DI void phase_norm_mod_b(const bf16_t* xb, const float* nw, const float* mod, int sh_off, int sc_off, bf16_t* H, int r_lo = 0, int r_hi = T, int b_lo = 0) {
    const int tid = fresh_tid(), lane = tid & 63, wave = __builtin_amdgcn_readfirstlane(tid >> 6);
    const int gw = ((int)blockIdx.x - b_lo) * 8 + wave, NGW = ((int)gridDim.x - b_lo) * 8;
    for (int r = r_lo + gw; r < r_hi; r += NGW) {
        const bf16_t* xr = xb + (size_t)r * D; const float* mb = mod + (size_t)batch_of(r) * 6144;
        float v[2][8]; float s = 0.f;
#pragma unroll
        for (int j = 0; j < 2; ++j) { const u32x4 x = *(const u32x4*)(xr + 8 * lane + 512 * j);
#pragma unroll
            for (int i = 0; i < 4; ++i) { v[j][2 * i] = bflo(x[i]); v[j][2 * i + 1] = bfhi(x[i]); s += v[j][2 * i] * v[j][2 * i] + v[j][2 * i + 1] * v[j][2 * i + 1]; } }
        const float rstd = __builtin_amdgcn_rsqf(wave_sum(s) * (1.f / D) + EPS);
#pragma unroll
        for (int j = 0; j < 2; ++j) { const int col = 8 * lane + 512 * j; f32x4 h[2];
#pragma unroll
            for (int q = 0; q < 2; ++q) { const f32x4 w = *(const f32x4*)(nw + col + 4 * q), sc = *(const f32x4*)(mb + sc_off + col + 4 * q), sh = *(const f32x4*)(mb + sh_off + col + 4 * q);
                const f32x4 x = {v[j][4 * q], v[j][4 * q + 1], v[j][4 * q + 2], v[j][4 * q + 3]}; h[q] = x * rstd * w * (sc + 1.f) + sh; }
            *(u32x4*)(H + (size_t)r * D + col) = pack_row8(h[0], h[1]); }
    }
}
DI void phase_final_norm(const bf16_t* xb, float* y, const float* nw, int r_lo = 0, int r_hi = T, int b_lo = 0) {
    const int tid = fresh_tid(), lane = tid & 63, wave = __builtin_amdgcn_readfirstlane(tid >> 6);
    const int gw = ((int)blockIdx.x - b_lo) * 8 + wave, NGW = ((int)gridDim.x - b_lo) * 8;
    for (int r = r_lo + gw; r < r_hi; r += NGW) { const bf16_t* xr = xb + (size_t)r * D; float* yr = y + (size_t)r * D;
        float v[2][8]; float s = 0.f;
#pragma unroll
        for (int j = 0; j < 2; ++j) { const u32x4 x = *(const u32x4*)(xr + 8 * lane + 512 * j);
#pragma unroll
            for (int i = 0; i < 4; ++i) { v[j][2 * i] = bflo(x[i]); v[j][2 * i + 1] = bfhi(x[i]); s += v[j][2 * i] * v[j][2 * i] + v[j][2 * i + 1] * v[j][2 * i + 1]; } }
        const float rstd = __builtin_amdgcn_rsqf(wave_sum(s) * (1.f / D) + EPS);
#pragma unroll
        for (int j = 0; j < 2; ++j) { const int col = 8 * lane + 512 * j;
#pragma unroll
            for (int q = 0; q < 2; ++q) { const f32x4 x = {v[j][4 * q], v[j][4 * q + 1], v[j][4 * q + 2], v[j][4 * q + 3]}; *(f32x4*)(yr + col + 4 * q) = x * rstd * *(const f32x4*)(nw + col + 4 * q); } }
    }
}

DI void phase_final_norm_parts(const bf16_t* x1b, const float* part0, const float* part1, const float* g2mod, float* y, const float* nw) {
    const int tid = fresh_tid(), lane = tid & 63, wave = __builtin_amdgcn_readfirstlane(tid >> 6);
    const int gw = blockIdx.x * 8 + wave, NGW = gridDim.x * 8;
    for (int r = TP + gw; r < T; r += NGW) { const float* gb = g2mod + (size_t)batch_of(r) * 6144; const size_t po = (size_t)(r - TP) * D;
        f32x4 v[4]; float s = 0.f;
#pragma unroll
        for (int j = 0; j < 4; ++j) { const int col = 4 * lane + 256 * j; const u32x2 xb = *(const u32x2*)(x1b + (size_t)r * D + col);
            const f32x4 x = {bflo(xb.x), bfhi(xb.x), bflo(xb.y), bfhi(xb.y)};
            v[j] = x + *(const f32x4*)(gb + col) * (*(const f32x4*)(part0 + po + col) + *(const f32x4*)(part1 + po + col));
            s += (v[j][0] * v[j][0] + v[j][1] * v[j][1]) + (v[j][2] * v[j][2] + v[j][3] * v[j][3]); }
        const float rstd = __builtin_amdgcn_rsqf(wave_sum(s) * (1.f / D) + EPS);
#pragma unroll
        for (int j = 0; j < 4; ++j) { const int col = 4 * lane + 256 * j; *(f32x4*)(y + (size_t)r * D + col) = v[j] * rstd * *(const f32x4*)(nw + col); }
    }
}

DI void hgrn_u_item(const Params& p, int item, int lane) {
    const int c = item >> 5, rem = item & 31, h = rem >> 3, kt = (rem >> 1) & 3, vh = rem & 1, l31 = lane & 31, hf = lane >> 5;
    const float* CUM = (const float*)(p.ws + WS_CUM); const bf16_t* KA = (const bf16_t*)(p.ws + WS_KA); const bf16_t* VA = (const bf16_t*)(p.ws + WS_VA); bf16_t* U = (bf16_t*)(p.ws + WS_U);
    const size_t hb = (size_t)h * T * 128; const int kcol = 32 * kt + l31;
    const float tot = CUM[hb + (size_t)(c * 64 + 63) * 128 + kcol];
    bf16x8 kdf[2][2];
#pragma unroll
    for (int st = 0; st < 2; ++st) { f32x16 kd;
#pragma unroll
        for (int r = 0; r < 16; ++r) { const size_t idx = hb + (size_t)(c * 64 + 32 * st + crow(r, hf)) * 128 + kcol; kd[r] = bf2f((short)KA[idx]) * __expf(tot - CUM[idx]); }
        kdf[st][0] = pack8(kd, 0); kdf[st][1] = pack8(kd, 1); }
    const bf16x8 id0 = ident_frag(0, l31, hf), id1 = ident_frag(1, l31, hf);
#pragma unroll
    for (int vtl = 0; vtl < 2; ++vtl) { const int vt = 2 * vh + vtl; f32x16 dacc = zero16();
#pragma unroll
        for (int st = 0; st < 2; ++st) { const bf16_t* vp = VA + hb + (size_t)(c * 64 + 32 * st + l31) * 128 + 32 * vt + 8 * hf;
            f32x16 vx = zero16(); vx = MFMA32(*(const bf16x8*)vp, id0, vx); vx = MFMA32(*(const bf16x8*)(vp + 16), id1, vx);
            dacc = MFMA32(kdf[st][0], pack8(vx, 0), dacc); dacc = MFMA32(kdf[st][1], pack8(vx, 1), dacc); }
        bf16_t* up = U + ((size_t)(c * 4 + h) * 128 + 32 * vt + l31) * 128 + 32 * kt + 8 * hf;
#pragma unroll
        for (int g = 0; g < 4; g += 2) { u32x2 o0, o1; o0.x = pk2(dacc[4 * g], dacc[4 * g + 1]); o0.y = pk2(dacc[4 * g + 2], dacc[4 * g + 3]); o1.x = pk2(dacc[4 * g + 4], dacc[4 * g + 5]); o1.y = pk2(dacc[4 * g + 6], dacc[4 * g + 7]);
            *(u32x4*)(up + 8 * g) = widen_pair(o0, o1); }
    }
}

DI void scan_prompt_item(const Params& p, int item, int lane) {
    const int bh = item >> 5, vq = item & 31, b = bh >> 2, h = bh & 3, kg = lane & 31, vv = lane >> 5;
    const float* __restrict__ DEC = (const float*)(p.ws + WS_DEC); const bf16_t* __restrict__ U = (const bf16_t*)(p.ws + WS_U); bf16_t* __restrict__ SST = (bf16_t*)(p.ws + WS_SST);
    f32x4 S0 = {0.f, 0.f, 0.f, 0.f}, S1 = {0.f, 0.f, 0.f, 0.f};
    const int v0 = 4 * vq + vv, v1 = v0 + 2;
#pragma unroll 16
    for (int n = 0; n < 256; ++n) { const int c = b * 256 + n;
        const f32x4 d = *(const f32x4*)(DEC + (size_t)c * 512 + h * 128 + 4 * kg);
        const size_t o0 = ((size_t)(c * 4 + h) * 128 + v0) * 128 + 4 * kg, o1 = ((size_t)(c * 4 + h) * 128 + v1) * 128 + 4 * kg;
        const u32x2 u0 = *(const u32x2*)(U + o0), u1 = *(const u32x2*)(U + o1);
        u32x2 s; s.x = pk2(S0[0], S0[1]); s.y = pk2(S0[2], S0[3]); *(u32x2*)(SST + o0) = s;
        s.x = pk2(S1[0], S1[1]); s.y = pk2(S1[2], S1[3]); *(u32x2*)(SST + o1) = s;
        S0[0] = d[0] * S0[0] + bflo(u0.x); S0[1] = d[1] * S0[1] + bfhi(u0.x); S0[2] = d[2] * S0[2] + bflo(u0.y); S0[3] = d[3] * S0[3] + bfhi(u0.y);
        S1[0] = d[0] * S1[0] + bflo(u1.x); S1[1] = d[1] * S1[1] + bfhi(u1.x); S1[2] = d[2] * S1[2] + bflo(u1.y); S1[3] = d[3] * S1[3] + bfhi(u1.y);
    }
    float* sp = p.out + OFF_SP + ((size_t)bh * 128 + 4 * kg) * 128;
#pragma unroll
    for (int i = 0; i < 4; ++i) { sp[(size_t)i * 128 + v0] = S0[i]; sp[(size_t)i * 128 + v1] = S1[i]; }
}
DI void scan_sample_item(const Params& p, int item, int lane) {
    const int bh = item >> 5, vq = item & 31, bs = bh >> 2, h = bh & 3, kg = lane & 31, vv = lane >> 5, c = 512 + bs;
    const float* DEC = (const float*)(p.ws + WS_DEC); const bf16_t* U = (const bf16_t*)(p.ws + WS_U); bf16_t* SST = (bf16_t*)(p.ws + WS_SST);
    const f32x4 d = *(const f32x4*)(DEC + (size_t)c * 512 + h * 128 + 4 * kg);
    const float* s0 = p.state + ((size_t)bh * 128 + 4 * kg) * 128; float* so = p.out + OFF_SS + ((size_t)bh * 128 + 4 * kg) * 128;
#pragma unroll
    for (int e = 0; e < 2; ++e) { const int v = 4 * vq + 2 * e + vv; const size_t o = ((size_t)(c * 4 + h) * 128 + v) * 128 + 4 * kg;
        const u32x2 u = *(const u32x2*)(U + o); f32x4 S;
#pragma unroll
        for (int i = 0; i < 4; ++i) S[i] = s0[(size_t)i * 128 + v];
        u32x2 s; s.x = pk2(S[0], S[1]); s.y = pk2(S[2], S[3]); *(u32x2*)(SST + o) = s;
        so[v] = d[0] * S[0] + bflo(u.x); so[128 + v] = d[1] * S[1] + bfhi(u.x); so[256 + v] = d[2] * S[2] + bflo(u.y); so[384 + v] = d[3] * S[3] + bfhi(u.y); }
}

DI void attn_item(const Params& p, int item, int lane, const LAS float* biasl) {
    const int c = item >> 3, h = item & 7, l31 = lane & 31, hf = lane >> 5;
    const bf16_t* KB = (const bf16_t*)(p.ws + WS_KB); const bf16_t* VB = (const bf16_t*)(p.ws + WS_VB);
    bf16x8 qf[2][4];
    { const bf16_t* qptr = (const bf16_t*)(p.ws + WS_QOB) + (size_t)(c * 64 + l31) * 1024 + 512 + h * 64;
#pragma unroll
    for (int qq = 0; qq < 2; ++qq)
#pragma unroll
        for (int ks = 0; ks < 4; ++ks) qf[qq][ks] = *(const bf16x8*)(qptr + (size_t)qq * 32 * 1024 + 16 * ks + 8 * hf); }
    const LAS float* bl = biasl + h * 192;
    f32x16 OT[2][2]; float mrun[2], lsum[2];
#pragma unroll
    for (int qq = 0; qq < 2; ++qq) { OT[qq][0] = zero16(); OT[qq][1] = zero16(); mrun[qq] = -1e30f; lsum[qq] = 0.f; }
    int ntile, ncache, db0, krow_first;
    if (c < 512) { const int n = c & 255, j0 = n < 8 ? n : 8; ntile = 2 * (j0 + 1); ncache = 0; db0 = 64 * j0; krow_first = (c - j0) * 64; }
    else { ntile = 18; ncache = 16; db0 = 512; krow_first = c * 64 - 512; }
    const int bs = c - 512;
    u32x4 nk[4], nv[4];
#define ATT_LOAD(i_) do { if ((i_) >= ncache) { const size_t ro_ = ((size_t)h * T + (size_t)(krow_first + 32 * (i_) + l31)) * 64 + 8 * hf; \
            _Pragma("unroll") for (int ks = 0; ks < 4; ++ks) { nk[ks] = *(const u32x4*)(KB + ro_ + 16 * ks); nv[ks] = *(const u32x4*)(VB + ro_ + 16 * ks); } } } while (0)
    ATT_LOAD(0);
    for (int i = 0; i < ntile; ++i) {
        bf16x8 kf[4], vf[2][2];
        if (i < ncache) {
            const float* kp_ = p.cache_k + ((size_t)(bs * 512 + 32 * i + l31) * 8 + h) * 64 + 8 * hf; const float* vp_ = p.cache_v + ((size_t)(bs * 512 + 32 * i + l31) * 8 + h) * 64 + 8 * hf;
#pragma unroll
            for (int ks = 0; ks < 4; ++ks) { u32x4 w; const f32x4 a = *(const f32x4*)(kp_ + 16 * ks), b = *(const f32x4*)(kp_ + 16 * ks + 4), e = *(const f32x4*)(vp_ + 16 * ks), f = *(const f32x4*)(vp_ + 16 * ks + 4);
                w.x = pk2(a[0], a[1]); w.y = pk2(a[2], a[3]); w.z = pk2(b[0], b[1]); w.w = pk2(b[2], b[3]); kf[ks] = __builtin_bit_cast(bf16x8, w);
                w.x = pk2(e[0], e[1]); w.y = pk2(e[2], e[3]); w.z = pk2(f[0], f[1]); w.w = pk2(f[2], f[3]); vf[ks >> 1][ks & 1] = __builtin_bit_cast(bf16x8, w); }
        } else {
#pragma unroll
            for (int ks = 0; ks < 4; ++ks) { kf[ks] = __builtin_bit_cast(bf16x8, nk[ks]); vf[ks >> 1][ks & 1] = __builtin_bit_cast(bf16x8, nv[ks]); }
        }
        if (i + 1 < ntile) ATT_LOAD(i + 1);
        asm volatile("" ::: "memory");
        bf16x8 vxf[2][2];
        const int l31b = launder(l31); const bf16x8 id0 = ident_frag(0, l31b, hf), id1 = ident_frag(1, l31b, hf);
#pragma unroll
        for (int dt = 0; dt < 2; ++dt) { f32x16 vx = zero16(); vx = MFMA32(vf[dt][0], id0, vx); vx = MFMA32(vf[dt][1], id1, vx); vxf[dt][0] = pack8(vx, 0); vxf[dt][1] = pack8(vx, 1); }
#pragma unroll
        for (int qq = 0; qq < 2; ++qq) {
            f32x16 st = zero16();
#pragma unroll
            for (int ks = 0; ks < 4; ++ks) st = MFMA32(kf[ks], qf[qq][ks], st);
            const int dq = db0 + 32 * qq - 32 * i; float mt = -1e30f;
            if (dq - 31 >= 128) { const float bc = bl[191];
#pragma unroll
                for (int r = 0; r < 16; ++r) { const float s = st[r] * (0.125f * LOG2E) + bc; st[r] = s; mt = fmaxf(mt, s); }
            } else { const int dbase = dq + l31;
#pragma unroll
                for (int r = 0; r < 16; ++r) { int dist = dbase - crow(r, hf); dist = dist > 128 ? 128 : dist; const float s = st[r] * (0.125f * LOG2E) + bl[dist + 63]; st[r] = s; mt = fmaxf(mt, s); }
            }
            mt = fmaxf(mt, __shfl_xor(mt, 32));
            const float mnew = fmaxf(mrun[qq], mt), alpha = __builtin_amdgcn_exp2f(mrun[qq] - mnew); mrun[qq] = mnew;
            float ps = 0.f;
#pragma unroll
            for (int r = 0; r < 16; ++r) { st[r] = __builtin_amdgcn_exp2f(st[r] - mnew); ps += st[r]; }
            lsum[qq] = lsum[qq] * alpha + ps;
#pragma unroll
            for (int r = 0; r < 16; ++r) { OT[qq][0][r] *= alpha; OT[qq][1][r] *= alpha; }
            const bf16x8 pf0 = pack8(st, 0), pf1 = pack8(st, 1);
            OT[qq][0] = MFMA32(vxf[0][0], pf0, OT[qq][0]); OT[qq][0] = MFMA32(vxf[0][1], pf1, OT[qq][0]);
            OT[qq][1] = MFMA32(vxf[1][0], pf0, OT[qq][1]); OT[qq][1] = MFMA32(vxf[1][1], pf1, OT[qq][1]);
        }
    }
#undef ATT_LOAD
    bf16_t* qptr = (bf16_t*)(p.ws + WS_QOB) + (size_t)(c * 64 + launder(l31)) * 1024 + 512 + h * 64;
#pragma unroll
    for (int qq = 0; qq < 2; ++qq) { const float l = lsum[qq] + __shfl_xor(lsum[qq], 32), inv = 1.f / l; bf16_t* op = qptr + (size_t)qq * 32 * 1024;
#pragma unroll
        for (int dt = 0; dt < 2; ++dt)
#pragma unroll
            for (int g = 0; g < 4; g += 2) { u32x2 o0, o1; o0.x = pk2(OT[qq][dt][4 * g] * inv, OT[qq][dt][4 * g + 1] * inv); o0.y = pk2(OT[qq][dt][4 * g + 2] * inv, OT[qq][dt][4 * g + 3] * inv);
                o1.x = pk2(OT[qq][dt][4 * g + 4] * inv, OT[qq][dt][4 * g + 5] * inv); o1.y = pk2(OT[qq][dt][4 * g + 6] * inv, OT[qq][dt][4 * g + 7] * inv);
                *(u32x4*)(op + 32 * dt + 8 * (g + hf)) = widen_pair(o0, o1); } }
}

DI void hgrn_out_item(const Params& p, int item, int lane, bf16_t* obase = nullptr) {
    const int c = item >> 3, h = (item >> 1) & 3, tt = item & 1, l31 = lane & 31, hf = lane >> 5;
    const float* CUM = (const float*)(p.ws + WS_CUM); const bf16_t* KA = (const bf16_t*)(p.ws + WS_KA); const bf16_t* VA = (const bf16_t*)(p.ws + WS_VA);
    const bf16_t* GA = (const bf16_t*)(p.ws + WS_GA); const bf16_t* SST = (const bf16_t*)(p.ws + WS_SST);
    const int trow = c * 64 + 32 * tt + l31;
    bf16_t* qap = (bf16_t*)(p.ws + WS_QOB) + (size_t)trow * 1024 + h * 128;
    const size_t hb = (size_t)h * T * 128;
    const float* cumt = CUM + hb + (size_t)trow * 128; const float* refp = CUM + hb + (size_t)(c * 64 + 32) * 128;
    bf16x8 qd1[8], qd2[8], kdt[8];
    const bf16_t* kat = KA + hb + (size_t)trow * 128;
#pragma unroll
    for (int ks = 0; ks < 8; ++ks) { const int k0 = 16 * ks + 8 * hf; const bf16x8 q8 = *(const bf16x8*)(qap + k0), k8 = *(const bf16x8*)(kat + k0);
        const f32x4 c0 = *(const f32x4*)(cumt + k0), c1 = *(const f32x4*)(cumt + k0 + 4), r0 = *(const f32x4*)(refp + k0), r1 = *(const f32x4*)(refp + k0 + 4);
        float a[8], b[8], d[8];
#pragma unroll
        for (int j = 0; j < 8; ++j) { const float q = bf2f(q8[j]), cu = j < 4 ? c0[j & 3] : c1[j & 3], rf = j < 4 ? r0[j & 3] : r1[j & 3]; a[j] = q * __expf(cu - rf); b[j] = q * __expf(cu); d[j] = bf2f(k8[j]) * __expf(rf - cu); }
        qd1[ks] = pack8f(a); qd2[ks] = pack8f(b); kdt[ks] = pack8f(d); }
    f32x16 OT[4];
#pragma unroll
    for (int vt = 0; vt < 4; ++vt) OT[vt] = zero16();
    const bf16_t* sp = SST + ((size_t)(c * 4 + h) * 128 + l31) * 128 + 8 * hf;
#pragma unroll
    for (int vt = 0; vt < 4; ++vt) {
#pragma unroll
        for (int ks = 0; ks < 8; ++ks) OT[vt] = MFMA32(*(const bf16x8*)(sp + (size_t)vt * 32 * 128 + 16 * ks), qd2[ks], OT[vt]);
        __builtin_amdgcn_sched_barrier(0); }
    const bf16x8 id0 = ident_frag(0, l31, hf), id1 = ident_frag(1, l31, hf);
    for (int st = 0; st <= tt; ++st) {
        const int srow = c * 64 + 32 * st + l31; const bf16_t* kap = KA + hb + (size_t)srow * 128; const float* cums = CUM + hb + (size_t)srow * 128;
        f32x16 X = zero16();
        if (st == tt) {
#pragma unroll
            for (int ks = 0; ks < 8; ++ks) X = MFMA32(kdt[ks], qd1[ks], X);
        } else
#pragma unroll
        for (int ks = 0; ks < 8; ++ks) { const int k0 = 16 * ks + 8 * hf; const bf16x8 k8 = *(const bf16x8*)(kap + k0);
            const f32x4 c0 = *(const f32x4*)(cums + k0), c1 = *(const f32x4*)(cums + k0 + 4), r0 = *(const f32x4*)(refp + k0), r1 = *(const f32x4*)(refp + k0 + 4);
            float a[8];
#pragma unroll
            for (int j = 0; j < 8; ++j) { const float cu = j < 4 ? c0[j & 3] : c1[j & 3], rf = j < 4 ? r0[j & 3] : r1[j & 3]; a[j] = bf2f(k8[j]) * __expf(rf - cu); }
            X = MFMA32(pack8f(a), qd1[ks], X); }
        if (st == tt) {
#pragma unroll
            for (int r = 0; r < 16; ++r) if (crow(r, hf) > l31) X[r] = 0.f; }
        const bf16x8 xf0 = pack8(X, 0), xf1 = pack8(X, 1);
        const bf16_t* vp = VA + hb + (size_t)srow * 128 + 8 * hf;
#pragma unroll
        for (int vt = 0; vt < 4; ++vt) { f32x16 vx = zero16(); vx = MFMA32(*(const bf16x8*)(vp + 32 * vt), id0, vx); vx = MFMA32(*(const bf16x8*)(vp + 32 * vt + 16), id1, vx);
            OT[vt] = MFMA32(pack8(vx, 0), xf0, OT[vt]); OT[vt] = MFMA32(pack8(vx, 1), xf1, OT[vt]); }
    }
    float ss = 0.f;
#pragma unroll
    for (int vt = 0; vt < 4; ++vt)
#pragma unroll
        for (int r = 0; r < 16; ++r) ss += OT[vt][r] * OT[vt][r];
    ss += __shfl_xor(ss, 32);
    const float rstd = __builtin_amdgcn_rsqf(ss * (1.f / 128.f) + EPS);
    const bf16_t* gap = GA + hb + (size_t)trow * 128; const float* onp = p.out_norm + h * 128;
    if (obase) qap = obase + (size_t)trow * 512 + h * 128;
#pragma unroll
    for (int vt = 0; vt < 4; ++vt)
#pragma unroll
        for (int g = 0; g < 4; g += 2) { u32x2 ga0, ga1; narrow_pair(*(const u32x4*)(gap + 32 * vt + 8 * (g + hf)), ga0, ga1);
            u32x2 o0, o1;
            { const int v0 = 32 * vt + 8 * g + 4 * hf; const f32x4 on = *(const f32x4*)(onp + v0);
              o0.x = pk2(OT[vt][4 * g] * rstd * on[0] * bflo(ga0.x), OT[vt][4 * g + 1] * rstd * on[1] * bfhi(ga0.x)); o0.y = pk2(OT[vt][4 * g + 2] * rstd * on[2] * bflo(ga0.y), OT[vt][4 * g + 3] * rstd * on[3] * bfhi(ga0.y)); }
            { const int v0 = 32 * vt + 8 * (g + 1) + 4 * hf; const f32x4 on = *(const f32x4*)(onp + v0);
              o1.x = pk2(OT[vt][4 * g + 4] * rstd * on[0] * bflo(ga1.x), OT[vt][4 * g + 5] * rstd * on[1] * bfhi(ga1.x)); o1.y = pk2(OT[vt][4 * g + 6] * rstd * on[2] * bflo(ga1.y), OT[vt][4 * g + 7] * rstd * on[3] * bfhi(ga1.y)); }
            *(u32x4*)(qap + 32 * vt + 8 * (g + hf)) = widen_pair(o0, o1); }
}


#define XB_TMO      128
#define XB_XCNT(j)  (256  + 64 * (j))
#define XB_XSUB(j)  (1280 + 64 * (j))
#define XB_XGEN(j)  (2304 + 64 * (j))
#define XB_TOP      3328
#define XB_TOPGEN   3392
#define XCD_BAR_WORDS 3456
#define XB_SPIN_CAP (1u << 18)
DI unsigned xb_ld(unsigned* p)              { return __hip_atomic_load(p, __ATOMIC_RELAXED, __HIP_MEMORY_SCOPE_AGENT); }
DI unsigned xb_add(unsigned* p, unsigned v) { return __hip_atomic_fetch_add(p, v, __ATOMIC_RELAXED, __HIP_MEMORY_SCOPE_AGENT); }
DI unsigned xb_xcc_id() { return (unsigned)__builtin_amdgcn_s_getreg((3 << 11) | 20) & 0xFu; }
#define XB_SPIN(cond, bar) do { unsigned _sp = 0; while (cond) { __builtin_amdgcn_s_sleep(1); \
    if ((++_sp & 255u) == 0u) { if (xb_ld(&(bar)[XB_TMO])) break; if (_sp > XB_SPIN_CAP) { atomicAdd(&(bar)[XB_TMO], 1u); break; } } } } while (0)
struct XcdBarrier { unsigned* bar; unsigned x; volatile LAS unsigned* st; };
DI XcdBarrier xcd_barrier_post(unsigned* bar, volatile LAS unsigned* st) {
    XcdBarrier b; b.bar = bar; b.x = xb_xcc_id(); b.st = st;
    if (threadIdx.x == 0) (void)xb_add(&bar[XB_XCNT(b.x)], 1u);
    return b;
}
DI void xcd_barrier_complete(unsigned* bar, unsigned x, unsigned& nloc, unsigned& nx) {
    const unsigned G = gridDim.x * gridDim.y * gridDim.z;
    unsigned sum, cnt, mine, sp = 0u;
    for (;;) {
        sum = 0u; cnt = 0u; mine = 0u;
#pragma unroll
        for (unsigned j = 0; j < 16; ++j) { const unsigned c = xb_ld(&bar[XB_XCNT(j)]); sum += c; cnt += (c > 0u) ? 1u : 0u; mine = (j == x) ? c : mine; }
        if (sum == G) break;
        __builtin_amdgcn_s_sleep(1);
        if ((++sp & 255u) == 0u) { if (xb_ld(&bar[XB_TMO])) break; if (sp > XB_SPIN_CAP) { atomicAdd(&bar[XB_TMO], 1u); break; } }
    }
    nloc = mine > 0u ? mine : 1u; nx = cnt > 0u ? cnt : 1u;
}
DI void xcd_barrier(const XcdBarrier& b) {
    asm volatile("s_waitcnt vmcnt(0)" ::: "memory");
    __syncthreads();
    if (threadIdx.x == 0) {
        unsigned* bar = b.bar;
        __builtin_amdgcn_s_waitcnt(0);
        unsigned nloc = b.st[0], nx = b.st[1];
        if (nloc == 0u) { xcd_barrier_complete(bar, b.x, nloc, nx); b.st[0] = nloc; b.st[1] = nx; }
        const unsigned old = xb_add(&bar[XB_XSUB(b.x)], 1u);
        const unsigned gen = old / nloc;
        if (old + 1u == (gen + 1u) * nloc) {
            __builtin_amdgcn_fence(__ATOMIC_RELEASE, "agent");
            asm volatile("s_waitcnt vmcnt(0)" ::: "memory");
            const unsigned og = xb_add(&bar[XB_TOP], 1u);
            const unsigned tg = og / nx;
            if (og + 1u == (tg + 1u) * nx) xb_add(&bar[XB_TOPGEN], 1u);
            else XB_SPIN(xb_ld(&bar[XB_TOPGEN]) == tg, bar);
            __builtin_amdgcn_fence(__ATOMIC_ACQUIRE, "agent");
            xb_add(&bar[XB_XGEN(b.x)], 1u);
            asm volatile("s_waitcnt vmcnt(0)" ::: "memory");
        } else {
            XB_SPIN(xb_ld(&bar[XB_XGEN(b.x)]) == gen, bar);
            __builtin_amdgcn_fence(__ATOMIC_ACQUIRE, "agent");
            asm volatile("s_waitcnt vmcnt(0)" ::: "memory");
        }
    }
    __syncthreads();
}

__global__ void __launch_bounds__(512, 2) fwd_megakernel(Params p) {
    extern __shared__ __attribute__((aligned(16))) unsigned char lds_raw[];
    LAS unsigned char* lds = (LAS unsigned char*)lds_raw;
    cg::grid_group grid = cg::this_grid();
    const int G = gridDim.x, bx = blockIdx.x;
    volatile LAS unsigned* bst = (volatile LAS unsigned*)(lds + LDS_ST_OFF);
    if (threadIdx.x < 2) bst[threadIdx.x] = 0u;
    __syncthreads();
    const XcdBarrier xbar = xcd_barrier_post((unsigned*)(p.ws + WS_BAR), bst);
    if (threadIdx.x == 0) bst[2] = xb_add((unsigned*)(p.ws + WS_BAR) + 3712 + xbar.x, 1u);
#define GRID_BAR() xcd_barrier(xbar)
    unsigned char* ws = p.ws;
    float* MOD = (float*)(ws + WS_MOD); bf16_t* H = (bf16_t*)(ws + WS_H);

    phase_prep(p, lds);
    grid.sync();
    { pg8::Gemm g{(const bf16_t*)(ws + WS_SC), (const bf16_t*)(ws + WS_WADA), 256, 6144, 1024}; pg8::StaticOrder S; S.init(256, 6144, G, bx);
      EpiMod E{MOD, p.b_ada}; pg8::gemm_phase<EpiMod, pg8::StaticOrder, true, true>(lds, g, S, E); }
    GRID_BAR();
    int cv = bx;
    { unsigned* barw = (unsigned*)(p.ws + WS_BAR); bool uni = (G & 7) == 0;
#pragma unroll
      for (int j = 0; j < 16; ++j) { const unsigned c = xb_ld(&barw[XB_XCNT(j)]); uni = uni && (j < 8 ? c == (unsigned)(G >> 3) : c == 0u); }
      if (uni) cv = (int)xbar.x + 8 * (int)bst[2];
      cv = __builtin_amdgcn_readfirstlane(cv); }
    phase_norm_mod(p.x_prompt, p.x_sample, p.norm_mix, MOD, 0, 1024, H);
#if PROBE_DUP == 1
    GRID_BAR(); phase_norm_mod(p.x_prompt, p.x_sample, p.norm_mix, MOD, 0, 1024, H);
#endif
#if PROBE_DUP == 10
    GRID_BAR(); GRID_BAR(); GRID_BAR(); GRID_BAR(); GRID_BAR(); GRID_BAR(); GRID_BAR(); GRID_BAR(); GRID_BAR(); GRID_BAR();
#endif
    GRID_BAR();
    { pg8::Gemm g{H, (const bf16_t*)(ws + WS_WIN), T, INC, 1024}; pg8::StaticOrder S; S.init(T, INC, G, cv);
      EpiIn E{(bf16_t*)(ws + WS_QOB), (bf16_t*)(ws + WS_KA), (bf16_t*)(ws + WS_VA), (bf16_t*)(ws + WS_GA), (bf16_t*)(ws + WS_KB), (bf16_t*)(ws + WS_VB),
              (bf16_t*)(p.out), (bf16_t*)(p.out) + (size_t)T * 1024, (float*)(ws + WS_CUM), (float*)(ws + WS_DEC), p.lb_logits, p.out};
      pg8::gemm_phase<EpiIn, pg8::StaticOrder, true, true>(lds, g, S, E);
#if PROBE_DUP == 2
      GRID_BAR(); pg8::gemm_phase<EpiIn, pg8::StaticOrder, true, true>(lds, g, S, E);
#endif
    }
    GRID_BAR();
    { const int tid = fresh_tid(), lane = tid & 63, wave = __builtin_amdgcn_readfirstlane(tid >> 6);
      for (int it = wave * G + bx; it < NCH * 32; it += 8 * G) hgrn_u_item(p, it, lane);
#if PROBE_DUP == 3
      for (int it = wave * G + bx; it < NCH * 32; it += 8 * G) hgrn_u_item(p, it, lane);
#endif
    }
    GRID_BAR();
    {
        const int tid = fresh_tid(), lane = tid & 63, wave = __builtin_amdgcn_readfirstlane(tid >> 6);
        LAS float* biasl = (LAS float*)lds;
        for (int i = tid; i < 8 * 192; i += 512) biasl[i] = p.rel_bias[i] * LOG2E;
        __syncthreads();
#if PROBE_DUP == 41
        if (wave == 0) { for (int it = bx; it < 256; it += G) scan_prompt_item(p, it, lane); }
        GRID_BAR();
#endif
        if (wave == 0) { for (int it = bx; it < 256; it += G) scan_prompt_item(p, it, lane); }
        else {
            const int gw = (wave - 1) * G + bx, NGW = 7 * G;
            for (int it = gw; it < 4096; it += NGW) scan_sample_item(p, it, lane);
            const int x = (int)xbar.x, ncu = (int)bst[0], nxcc = (int)bst[1], j = (int)bst[2];
            if (nxcc == 8 && x < 8 && ncu > 0 && j < ncu) {
                const int nslot = 7 * ncu, slot = (wave - 1) * ncu + j;
                for (int idx = slot; idx < 68 * 8; idx += nslot) { const int cc = idx >> 3, c = cc < 4 ? 512 + 4 * x + cc : 64 * x + (cc - 4); attn_item(p, c * 8 + (idx & 7), lane, biasl); }
            } else for (int it = gw; it < NCH * 8; it += NGW) attn_item(p, it, lane, biasl);
        }
    }
    GRID_BAR();
    { const int tid = fresh_tid(), lane = tid & 63, wave = __builtin_amdgcn_readfirstlane(tid >> 6);
#if PROBE_DUP == 5
      for (int it = wave * G + bx; it < NCH * 8; it += 8 * G) hgrn_out_item(p, it, lane, (bf16_t*)(ws + WS_U));
      GRID_BAR();
#endif
      for (int it = wave * G + bx; it < NCH * 8; it += 8 * G) hgrn_out_item(p, it, lane); }
    GRID_BAR();
    { pg8::Gemm g{(const bf16_t*)(ws + WS_QOB), (const bf16_t*)(ws + WS_WAB), T, 1024, 1024}; pg8::StaticOrder S; S.init(T, 1024, G, cv);
      EpiMerge E{(const bf16_t*)(p.out), (const bf16_t*)(p.out) + (size_t)T * 1024, (bf16_t*)(ws + WS_M)};
      pg8::gemm_phase<EpiMerge, pg8::StaticOrder, true, true>(lds, g, S, E); }
    GRID_BAR();
    const bool split_ps = G >= 64;
    { pg8::Gemm g{(const bf16_t*)(ws + WS_M), (const bf16_t*)(ws + WS_WO), T, 1024, 1024}; EpiRes<false> E{p.x_prompt, p.x_sample, nullptr, (bf16_t*)(ws + WS_X1B), MOD + 2048};
      if (split_ps) {
        { pg8::StaticOrder S; S.init(TP, 1024, G, cv); pg8::gemm_phase<EpiRes<false>, pg8::StaticOrder, true, true>(lds, g, S, E); }
        GRID_BAR();
        if (bx < 32) { pg8::StaticOrder S; S.init(TS, 1024, 32, bx, TP / 256); pg8::gemm_phase<EpiRes<false>, pg8::StaticOrder, true, true>(lds, g, S, E); }
        else phase_norm_mod_b((const bf16_t*)(ws + WS_X1B), p.norm_ffn, MOD, 3072, 4096, H, 0, TP, 32);
        GRID_BAR();
        phase_norm_mod_b((const bf16_t*)(ws + WS_X1B), p.norm_ffn, MOD, 3072, 4096, H, TP, T, 0);
      } else {
        pg8::StaticOrder S; S.init(T, 1024, G, cv); pg8::gemm_phase<EpiRes<false>, pg8::StaticOrder, true, true>(lds, g, S, E);
        GRID_BAR();
        phase_norm_mod_b((const bf16_t*)(ws + WS_X1B), p.norm_ffn, MOD, 3072, 4096, H);
      } }
    GRID_BAR();
    { pg8::Gemm g{H, (const bf16_t*)(ws + WS_WFI), T, INC, 1024}; pg8::StaticOrder S; S.init(T, INC, G, cv);
      EpiFfnIn E{(bf16_t*)(ws + WS_HID)}; pg8::gemm_phase<EpiFfnIn, pg8::StaticOrder, true, true>(lds, g, S, E);
#if PROBE_DUP == 9
      GRID_BAR(); pg8::gemm_phase<EpiFfnIn, pg8::StaticOrder, true, true>(lds, g, S, E);
#endif
    }
    GRID_BAR();
    { pg8::Gemm g{(const bf16_t*)(ws + WS_HID), (const bf16_t*)(ws + WS_WFO), T, 1024, FF}; EpiRes<true> E{nullptr, nullptr, (const bf16_t*)(ws + WS_X1B), (bf16_t*)(ws + WS_X2B), MOD + 5120};
      if (split_ps) {
        { pg8::StaticOrder S; S.init(TP, 1024, G, cv); pg8::gemm_phase<EpiRes<true>, pg8::StaticOrder, true, true>(lds, g, S, E); }
        GRID_BAR();
        float* PART = (float*)(ws + WS_CUM + 20 * MiB);
        if (bx < 64) { const int ks = bx >> 5; pg8::Gemm gs{(const bf16_t*)(ws + WS_HID) + ks * (FF / 2), (const bf16_t*)(ws + WS_WFO) + ks * (FF / 2), T, 1024, FF / 2, FF};
            pg8::StaticOrder S; S.init(TS, 1024, 32, bx & 31, TP / 256); EpiPart EP{PART + (size_t)ks * TS * D, TP}; pg8::gemm_phase<EpiPart, pg8::StaticOrder, true, true>(lds, gs, S, EP); }
        else phase_final_norm((const bf16_t*)(ws + WS_X2B), p.out, p.norm_final, 0, TP, 64);
        GRID_BAR();
        phase_final_norm_parts((const bf16_t*)(ws + WS_X1B), PART, PART + (size_t)TS * D, MOD + 5120, p.out, p.norm_final);
      } else {
        pg8::StaticOrder S; S.init(T, 1024, G, cv); pg8::gemm_phase<EpiRes<true>, pg8::StaticOrder, true, true>(lds, g, S, E);
        GRID_BAR();
        phase_final_norm((const bf16_t*)(ws + WS_X2B), p.out, p.norm_final);
      } }
}

extern "C" void kernel_launch(void* const* d_in, const int* in_sizes, int n_in, void* d_out, int out_size, void* d_ws, size_t ws_size, hipStream_t stream) {
    static int grid = 0;
    if (grid == 0) {
        if (n_in != 21 || (size_t)out_size != OUT_TOTAL || ws_size < WS_END) { fprintf(stderr, "kernel_launch: unexpected sizes n_in %d out %d ws %zu\n", n_in, out_size, ws_size); grid = -1; return; }
        int dev = 0, cus = 0, per = 0;
        (void)hipGetDevice(&dev); (void)hipDeviceGetAttribute(&cus, hipDeviceAttributeMultiprocessorCount, dev);
        (void)hipFuncSetAttribute((const void*)fwd_megakernel, hipFuncAttributeMaxDynamicSharedMemorySize, LDS_BYTES);
        (void)hipOccupancyMaxActiveBlocksPerMultiprocessor(&per, (const void*)fwd_megakernel, 512, LDS_BYTES);
        if (per < 1) per = 1;
        grid = cus * per; fprintf(stderr, "kernel_launch: grid %d (cus %d x %d)\n", grid, cus, per);
    }
    if (grid < 0) return;
    if (hipMemsetAsync((char*)d_ws + WS_BAR, 0, BAR_BYTES, stream) != hipSuccess) { fprintf(stderr, "kernel_launch: memset failed\n"); return; }
    Params p{};
    const float** f = (const float**)&p;
    for (int i = 0; i < 21; ++i) f[i] = (const float*)d_in[i];
    p.out = (float*)d_out; p.ws = (unsigned char*)d_ws;
    void* args[] = {&p};
    hipError_t e = hipLaunchCooperativeKernel((const void*)fwd_megakernel, dim3(grid), dim3(512), args, LDS_BYTES, stream);
    if (e != hipSuccess) fprintf(stderr, "cooperative launch failed: %s (grid %d)\n", hipGetErrorString(e), grid);
}
```

```cpp
#include <hip/hip_runtime.h>
#include <hip/hip_cooperative_groups.h>
#include <cstdio>
#include <cstdint>
namespace cg = cooperative_groups;
#ifndef PROBE_DUP
#define PROBE_DUP 0
#endif

#define DI __device__ __forceinline__
#define LAS __attribute__((address_space(3)))
typedef unsigned short bf16_t;
typedef short bf16x8 __attribute__((ext_vector_type(8)));
typedef float f32x4 __attribute__((ext_vector_type(4)));
typedef float f32x2 __attribute__((ext_vector_type(2)));
typedef float f32x16 __attribute__((ext_vector_type(16)));
typedef unsigned u32x4 __attribute__((ext_vector_type(4)));
typedef unsigned u32x2 __attribute__((ext_vector_type(2)));
typedef __bf16 bf2_t __attribute__((ext_vector_type(2)));

constexpr int D = 1024, TP = 32768, TS = 2048, T = TP + TS, NCH = T / 64, NBATCH = 34;
constexpr int INC = 5632, FF = 2816;
constexpr float EPS = 1e-6f, LOG2E = 1.4426950408889634f;
constexpr size_t OFF_Y = 0, OFF_SP = (size_t)T * D, OFF_KP = OFF_SP + 131072, OFF_VP = OFF_KP + 524288, OFF_SS = OFF_VP + 524288,
                 OFF_KS = OFF_SS + 2097152, OFF_VS = OFF_KS + 1048576, OUT_TOTAL = OFF_VS + 1048576;
constexpr size_t MiB = 1u << 20;
constexpr size_t WS_MOD = 1 * MiB, WS_DEC = 2 * MiB, WS_SC = 4 * MiB, WS_WADA = 5 * MiB, WS_WIN = 17 * MiB, WS_WAB = 28 * MiB, WS_WO = 30 * MiB,
                 WS_WFI = 32 * MiB, WS_WFO = 43 * MiB, WS_H = 50 * MiB, WS_QOB = 118 * MiB, WS_KA = 186 * MiB, WS_VA = 220 * MiB, WS_GA = 254 * MiB,
                 WS_KB = 288 * MiB, WS_VB = 322 * MiB, WS_CUM = 356 * MiB, WS_SST = 424 * MiB, WS_END = 492 * MiB;
constexpr size_t WS_U = WS_H, WS_M = WS_KA, WS_HID = WS_KA, WS_X1B = WS_QOB, WS_X2B = WS_H;
constexpr size_t WS_BAR = 0, BAR_BYTES = 16384;
constexpr int LDS_BYTES = 140 * 1024, LDS_ST_OFF = 136 * 1024;

struct Params {
    const float *x_prompt, *x_sample, *c_prompt, *c_sample, *state, *cache_k, *cache_v, *w_ada, *b_ada, *norm_mix, *w_in, *lb_logits, *out_norm,
                *w_a, *rel_bias, *w_b, *w_out, *norm_ffn, *w_ffn_in, *w_ffn_out, *norm_final;
    float* out; unsigned char* ws;
};

DI int fresh_tid() { int t = threadIdx.x; asm volatile("" : "+v"(t)); return t; }
DI int launder(int v) { asm volatile("" : "+v"(v)); return v; }
DI unsigned pk2(float a, float b) { f32x2 v = {a, b}; bf2_t r = __builtin_convertvector(v, bf2_t); return __builtin_bit_cast(unsigned, r); }
DI float bflo(unsigned u) { return __uint_as_float(u << 16); }
DI float bfhi(unsigned u) { return __uint_as_float(u & 0xffff0000u); }
DI float bf2f(short s) { return __uint_as_float(((unsigned)(unsigned short)s) << 16); }
DI float sigm(float x) { return __builtin_amdgcn_rcpf(1.f + __expf(-x)); }
DI float silu(float x) { return x * sigm(x); }
DI int batch_of(int r) { return r < TP ? (r >> 14) : 2 + ((r - TP) >> 6); }
DI int crow(int reg, int h) { return (reg & 3) + 8 * (reg >> 2) + 4 * h; }
DI bf16x8 pack8(const f32x16& x, int s) {
    u32x4 p; p.x = pk2(x[8 * s], x[8 * s + 1]); p.y = pk2(x[8 * s + 2], x[8 * s + 3]); p.z = pk2(x[8 * s + 4], x[8 * s + 5]); p.w = pk2(x[8 * s + 6], x[8 * s + 7]);
    return __builtin_bit_cast(bf16x8, p);
}
DI bf16x8 pack8f(const float* v) { u32x4 p; p.x = pk2(v[0], v[1]); p.y = pk2(v[2], v[3]); p.z = pk2(v[4], v[5]); p.w = pk2(v[6], v[7]); return __builtin_bit_cast(bf16x8, p); }
DI bf16x8 ident_frag(int ks, int l31, int hf) {
    const int jj = l31 - 16 * ks - 8 * hf; bf16x8 r;
#pragma unroll
    for (int j = 0; j < 8; ++j) r[j] = (j == jj) ? (short)0x3F80 : (short)0;
    return r;
}
DI u32x4 widen_pair(u32x2 pg, u32x2 pg1) { const auto rx = __builtin_amdgcn_permlane32_swap(pg.x, pg1.x, false, false), ry = __builtin_amdgcn_permlane32_swap(pg.y, pg1.y, false, false); return (u32x4){rx[0], ry[0], rx[1], ry[1]}; }
DI void narrow_pair(u32x4 d, u32x2& pg, u32x2& pg1) { const auto rx = __builtin_amdgcn_permlane32_swap(d.x, d.z, false, false), ry = __builtin_amdgcn_permlane32_swap(d.y, d.w, false, false); pg = (u32x2){rx[0], ry[0]}; pg1 = (u32x2){rx[1], ry[1]}; }
#define MFMA32(a, b, c) __builtin_amdgcn_mfma_f32_32x32x16_bf16((a), (b), (c), 0, 0, 0)
DI f32x16 zero16() { f32x16 z;
#pragma unroll
    for (int i = 0; i < 16; ++i) z[i] = 0.f; return z; }

namespace pg8 {
constexpr int BM = 256, BK = 64, HALF = 128, HTB = HALF * BK * 2, STAGE_BYTES = 8 * HTB, NXCD = 8, WGM = 8;
__host__ __device__ __forceinline__ int lds_byte(int r, int c) { const int st = (r >> 4) * 2 + (c >> 5), rr = r & 15, cc = c & 31, ob = rr * 64 + cc * 2; return st * 1024 + (ob ^ (((ob >> 9) & 1) << 5)); }
__host__ __device__ __forceinline__ void stage_rc(int b, int& R, int& C) { const int st = b / 1024, sb = b % 1024, swz = sb ^ (((sb >> 9) & 1) << 5); R = (st >> 1) * 16 + swz / 64; C = (st & 1) * 32 + (swz % 64) / 2; }
__host__ __device__ __forceinline__ int perm32(int rho) { const int n = rho >> 4, i = rho & 15; return 8 * (i >> 2) + 4 * n + (i & 3); }
struct Unit { int pm, pn; };
struct Gemm { const bf16_t* A; const bf16_t* Bt; int M, N, K, ld; };
struct StaticOrder {
    int nM, nN, nwg, G, c, pm_off;
    __device__ void init(int M, int N, int G_, int c_, int pm_off_ = 0) { nM = M / BM; nN = N / BM; nwg = nM * nN; G = G_; c = c_; pm_off = pm_off_; }
    __device__ bool next(int i, Unit& u) const {
        const long L = (long)i * G + c; if (L >= nwg) return false;
        int wgid = (int)L; { const int q = nwg / NXCD, r = nwg % NXCD, xcd = wgid % NXCD, off = wgid / NXCD; wgid = (xcd < r ? xcd * (q + 1) : r * (q + 1) + (xcd - r) * q) + off; }
        const int nig = WGM * nN, gid = wgid / nig, fm = gid * WGM, gsz = (nM - fm) < WGM ? (nM - fm) : WGM;
        u.pm = pm_off + fm + ((wgid % nig) % gsz); u.pn = (wgid % nig) / gsz; return true;
    }
};
template <class Epi, class Sched, bool ALIGN_EPI = false, bool SP2 = false>
__device__ __forceinline__ void gemm_phase(LAS unsigned char* lds, const Gemm g, const Sched& S, const Epi& E) {
    const int tid = fresh_tid(), wid = __builtin_amdgcn_readfirstlane(tid >> 6), lane = tid & 63, wr = wid >> 2, wc = wid & 3, fr = lane & 15, fq = lane >> 4;
    const int K = g.ld ? g.ld : g.K, nt = g.K / BK;
    unsigned voffA[2], voffB[2];
#pragma unroll
    for (int i = 0; i < 2; ++i) { int R, C; stage_rc(tid * 16 + i * 8192, R, C); const int Rb = Epi::PERM ? ((R & ~31) + perm32(R & 31)) : R;
        voffA[i] = (unsigned)(R * K + C) * 2u; voffB[i] = (unsigned)(Rb * K + C) * 2u; }
    const size_t kstep = (size_t)(BK * 2);
    const size_t hstep = (size_t)HALF * K * 2;
    const size_t tstep = 2 * hstep;
    const unsigned ldsw = (unsigned)wid * 1024u;
    const int aoff = lds_byte(wr * 64 + fr, fq * 8), boff = lds_byte(wc * 32 + fr, fq * 8);
#define PG8_SA(b, h) (((b) * 2 + (h)) * HTB)
#define PG8_SB(b, h) ((4 + (b) * 2 + (h)) * HTB)
#define PG8_STAGE(bufoff, gbase, voff) do { _Pragma("unroll") for (int _i = 0; _i < 2; ++_i) \
        __builtin_amdgcn_global_load_lds((const unsigned*)((const char*)(gbase) + (voff)[_i]), (LAS unsigned*)(lds + (bufoff) + ldsw + _i * 8192), 16, 0, 0); } while (0)
#define PG8_LDA(dst, b, h) do { _Pragma("unroll") for (int m = 0; m < 4; ++m) _Pragma("unroll") for (int k = 0; k < 2; ++k) dst[m][k] = *(const LAS bf16x8*)(lds + PG8_SA(b, h) + aoff + m * 2048 + k * 1024); } while (0)
#define PG8_LDB(dst, b, h) do { _Pragma("unroll") for (int n = 0; n < 2; ++n) _Pragma("unroll") for (int k = 0; k < 2; ++k) dst[n][k] = *(const LAS bf16x8*)(lds + PG8_SB(b, h) + boff + n * 2048 + k * 1024); } while (0)
#define PG8_MMA(ai, bj, At, Bt) do { __builtin_amdgcn_s_setprio(1); _Pragma("unroll") for (int m = 0; m < 4; ++m) _Pragma("unroll") for (int n = 0; n < 2; ++n) _Pragma("unroll") for (int k = 0; k < 2; ++k) \
        acc[ai][bj][m][n] = __builtin_amdgcn_mfma_f32_16x16x32_bf16(Bt[n][k], At[m][k], acc[ai][bj][m][n], 0, 0, 0); __builtin_amdgcn_s_setprio(0); } while (0)
#define PG8_WAIT_V(n) asm volatile("s_waitcnt vmcnt(" #n ")" ::: "memory")
#define PG8_WAIT_L(n) asm volatile("s_waitcnt lgkmcnt(" #n ")" ::: "memory")
#define PG8_BAR __builtin_amdgcn_s_barrier()
#define PG8_SCHED __builtin_amdgcn_sched_barrier(0)
    Unit cur, nxt; int ui = 0;
    if (!S.next(0, cur)) return;
    f32x4 acc[2][2][4][2];
#pragma unroll
    for (int a = 0; a < 2; ++a)
#pragma unroll
        for (int b = 0; b < 2; ++b)
#pragma unroll
            for (int m = 0; m < 4; ++m)
#pragma unroll
                for (int n = 0; n < 2; ++n) acc[a][b][m][n] = (f32x4){0.f, 0.f, 0.f, 0.f};
    bf16x8 At[4][2], B0[2][2], B1[2][2];
    const char* cA = (const char*)g.A + (size_t)cur.pm * tstep; const char* cB = (const char*)g.Bt + (size_t)cur.pn * tstep;
    if constexpr (SP2) {
        PG8_STAGE(PG8_SB(0, 0), cB, voffB); PG8_STAGE(PG8_SB(0, 1), cB + hstep, voffB); PG8_STAGE(PG8_SA(0, 0), cA, voffA); PG8_STAGE(PG8_SA(0, 1), cA + hstep, voffA);
        if (wr == 1) PG8_BAR;
        PG8_WAIT_V(2); PG8_BAR;
        PG8_STAGE(PG8_SB(1, 0), cB + kstep, voffB); PG8_STAGE(PG8_SA(1, 0), cA + kstep, voffA); PG8_STAGE(PG8_SB(1, 1), cB + hstep + kstep, voffB);
        PG8_WAIT_V(6); PG8_BAR;
    } else {
        PG8_STAGE(PG8_SB(0, 0), cB, voffB); PG8_STAGE(PG8_SA(0, 0), cA, voffA); PG8_STAGE(PG8_SB(0, 1), cB + hstep, voffB); PG8_STAGE(PG8_SA(0, 1), cA + hstep, voffA);
        if (wr == 1) PG8_BAR;
        PG8_WAIT_V(4); PG8_BAR;
        PG8_STAGE(PG8_SB(1, 0), cB + kstep, voffB); PG8_STAGE(PG8_SA(1, 0), cA + kstep, voffA); PG8_STAGE(PG8_SB(1, 1), cB + hstep + kstep, voffB);
        PG8_WAIT_V(6); PG8_BAR;
    }
    for (;;) {
        const bool has_next = S.next(ui + 1, nxt);
        const char* nA = has_next ? (const char*)g.A + (size_t)nxt.pm * tstep : cA; const char* nB = has_next ? (const char*)g.Bt + (size_t)nxt.pn * tstep : cB;
        for (int t = 0; t < nt; t += 2) {
            if constexpr (Epi::MIDK) { if (t == nt / 2) E.mid(acc, cur, wr, wc, fr, fq); }
            const bool last = (t == nt - 2);
            const char* a1 = cA + (size_t)(t + 1) * kstep;
            const char* a2 = last ? nA : cA + (size_t)(t + 2) * kstep; const char* b2 = last ? nB : cB + (size_t)(t + 2) * kstep;
            const char* a3 = a2 + kstep; const char* b3 = b2 + kstep;
            if constexpr (SP2) {
            PG8_LDB(B0, 0, 0); PG8_LDB(B1, 0, 1); PG8_SCHED; PG8_LDA(At, 0, 0); PG8_STAGE(PG8_SA(1, 1), a1 + hstep, voffA);
            PG8_WAIT_V(8); PG8_WAIT_L(0); PG8_BAR; PG8_MMA(0, 0, At, B0); PG8_MMA(0, 1, At, B1); PG8_BAR; PG8_SCHED;
            PG8_LDA(At, 0, 1); PG8_STAGE(PG8_SB(0, 0), b2, voffB); PG8_STAGE(PG8_SB(0, 1), b2 + hstep, voffB); PG8_STAGE(PG8_SA(0, 0), a2, voffA);
            PG8_WAIT_V(8); PG8_WAIT_L(0); PG8_BAR; PG8_MMA(1, 0, At, B0); PG8_MMA(1, 1, At, B1); PG8_BAR; PG8_SCHED;
            PG8_LDB(B0, 1, 0); PG8_LDB(B1, 1, 1); PG8_SCHED; PG8_LDA(At, 1, 0); PG8_STAGE(PG8_SA(0, 1), a2 + hstep, voffA);
            PG8_WAIT_V(8); PG8_WAIT_L(0); PG8_BAR; PG8_MMA(0, 0, At, B0); PG8_MMA(0, 1, At, B1); PG8_BAR; PG8_SCHED;
            PG8_LDA(At, 1, 1); PG8_STAGE(PG8_SB(1, 0), b3, voffB); PG8_STAGE(PG8_SB(1, 1), b3 + hstep, voffB); PG8_STAGE(PG8_SA(1, 0), a3, voffA);
            PG8_WAIT_V(8); PG8_WAIT_L(0); PG8_BAR; PG8_MMA(1, 0, At, B0); PG8_MMA(1, 1, At, B1); PG8_BAR; PG8_SCHED;
            } else {
            PG8_LDB(B0, 0, 0); PG8_SCHED; PG8_LDA(At, 0, 0); PG8_STAGE(PG8_SA(1, 1), a1 + hstep, voffA);
            PG8_WAIT_L(8); PG8_BAR; PG8_WAIT_L(0); PG8_MMA(0, 0, At, B0); PG8_BAR; PG8_SCHED;
            PG8_LDB(B1, 0, 1); PG8_STAGE(PG8_SB(0, 0), b2, voffB);
            PG8_BAR; PG8_WAIT_L(0); PG8_MMA(0, 1, At, B1); PG8_BAR;
            PG8_LDA(At, 0, 1); PG8_STAGE(PG8_SA(0, 0), a2, voffA);
            PG8_BAR; PG8_WAIT_L(0); PG8_MMA(1, 0, At, B0); PG8_BAR; PG8_SCHED;
            PG8_STAGE(PG8_SB(0, 1), b2 + hstep, voffB);
            PG8_WAIT_V(6); PG8_BAR; PG8_MMA(1, 1, At, B1); PG8_BAR;
            PG8_LDB(B0, 1, 0); PG8_SCHED; PG8_LDA(At, 1, 0); PG8_STAGE(PG8_SA(0, 1), a2 + hstep, voffA);
            PG8_WAIT_L(8); PG8_BAR; PG8_WAIT_L(0); PG8_MMA(0, 0, At, B0); PG8_BAR; PG8_SCHED;
            PG8_LDB(B1, 1, 1); PG8_STAGE(PG8_SB(1, 0), b3, voffB);
            PG8_BAR; PG8_WAIT_L(0); PG8_MMA(0, 1, At, B1); PG8_BAR;
            PG8_LDA(At, 1, 1); PG8_STAGE(PG8_SA(1, 0), a3, voffA);
            PG8_BAR; PG8_WAIT_L(0); PG8_MMA(1, 0, At, B0); PG8_BAR; PG8_SCHED;
            PG8_STAGE(PG8_SB(1, 1), b3 + hstep, voffB);
            PG8_WAIT_V(6); PG8_BAR; PG8_MMA(1, 1, At, B1); PG8_BAR;
            }
        }
        if constexpr (ALIGN_EPI) { if (wr == 0) PG8_BAR; }
        E(acc, cur, wr, wc, fr, fq);
        if (!has_next) break;
#pragma unroll
        for (int a = 0; a < 2; ++a)
#pragma unroll
            for (int b = 0; b < 2; ++b)
#pragma unroll
                for (int m = 0; m < 4; ++m)
#pragma unroll
                    for (int n = 0; n < 2; ++n) acc[a][b][m][n] = (f32x4){0.f, 0.f, 0.f, 0.f};
        cur = nxt; cA = nA; cB = nB; ++ui;
        if constexpr (ALIGN_EPI) { if (wr == 1) PG8_BAR; }
    }
    PG8_WAIT_V(0);
    if constexpr (!ALIGN_EPI) { if (wr == 0) PG8_BAR; }
    PG8_BAR;
#undef PG8_SA
#undef PG8_SB
#undef PG8_STAGE
#undef PG8_LDA
#undef PG8_LDB
#undef PG8_MMA
#undef PG8_WAIT_V
#undef PG8_WAIT_L
#undef PG8_BAR
#undef PG8_SCHED
}
}
using pg8::Unit;
typedef f32x4 Acc[2][2][4][2];

DI u32x4 pack_row8(const f32x4& v0, const f32x4& v1) { u32x4 w; w.x = pk2(v0[0], v0[1]); w.y = pk2(v0[2], v0[3]); w.z = pk2(v1[0], v1[1]); w.w = pk2(v1[2], v1[3]); return w; }

struct EpiMod {
    static constexpr bool PERM = false, MIDK = false;
    float* mod; const float* bias;
    DI void operator()(Acc& acc, const Unit& u, int wr, int wc, int fr, int fq) const {
        { const int t_ = fresh_tid(); fr = t_ & 15; fq = (t_ >> 4) & 3; }
        if (u.pm != 0 || wr != 0) return;
#pragma unroll
        for (int m = 0; m < 3; ++m) { const int r = 16 * m + fr; if (r < NBATCH) {
#pragma unroll
            for (int bj = 0; bj < 2; ++bj)
#pragma unroll
                for (int n = 0; n < 2; ++n) { const int col = u.pn * 256 + bj * 128 + wc * 32 + n * 16 + 4 * fq;
                    *(f32x4*)(mod + (size_t)r * 6144 + col) = acc[0][bj][m][n] + *(const f32x4*)(bias + col); } } }
    }
};

struct EpiIn {
    static constexpr bool PERM = true, MIDK = false;
    bf16_t *QOB, *KA, *VA, *GA, *KB, *VB, *SGA, *SGB; float *CUM, *DEC; const float* lbl; float* out;
    DI void operator()(Acc& acc, const Unit& u, int wr, int wc, int fr, int fq) const {
        { const int t_ = fresh_tid(); fr = t_ & 15; fq = (t_ >> 4) & 3; }
        const int pn = u.pn, rt = wr * 64 + fr, row0 = u.pm * 256 + rt, cw = wc * 32 + 8 * fq, lane = fq * 16 + fr;
        if (pn >= 14) {
            const size_t o0 = ((size_t)(u.pm * 8 + (pn - 14)) * 8 * 512 + (size_t)(wr * 4 + wc) * 64 + lane) * 8;
#pragma unroll
            for (int ai = 0; ai < 2; ++ai)
#pragma unroll
                for (int m = 0; m < 4; ++m) { f32x4 r0, r1, b0, b1;
#pragma unroll
                    for (int j = 0; j < 4; ++j) { b0[j] = fmaxf(sigm(acc[ai][1][m][0][j]), 1e-30f); b1[j] = fmaxf(sigm(acc[ai][1][m][1][j]), 1e-30f);
                        r0[j] = sigm(acc[ai][0][m][0][j]) * __builtin_amdgcn_rcpf(b0[j]); r1[j] = sigm(acc[ai][0][m][1][j]) * __builtin_amdgcn_rcpf(b1[j]); }
                    const size_t o = o0 + (size_t)(ai * 4 + m) * 512 * 8;
                    *(u32x4*)(SGA + o) = pack_row8(r0, r1); *(u32x4*)(SGB + o) = pack_row8(b0, b1); __builtin_amdgcn_sched_barrier(0); }
            return;
        }
        const int seg = pn >> 1, col0 = (pn & 1) * 256 + cw;
        if (seg == 1) {
#pragma unroll
            for (int bj = 0; bj < 2; ++bj) {
                float lb[2][4];
#pragma unroll
                for (int n = 0; n < 2; ++n)
#pragma unroll
                    for (int j = 0; j < 4; ++j) { const int c = col0 + bj * 128 + 4 * n + j; lb[n][j] = __builtin_amdgcn_rcpf(1.f + __expf(lbl[512 + c] - lbl[c])); }
#pragma unroll
                for (int ai = 0; ai < 2; ++ai) {
                    const size_t rbase = ((size_t)((pn & 1) * 2 + bj) * T + (u.pm * 256 + ai * 128 + wr * 64 + launder(fr))) * 128 + cw;
#pragma unroll
                    for (int m = 0; m < 4; ++m) { f32x4 k0, k1;
#pragma unroll
                        for (int j = 0; j < 4; ++j) {
                            float f = lb[0][j] + (1.f - lb[0][j]) * sigm(acc[ai][bj][m][0][j]); k0[j] = 1.f - f; acc[ai][bj][m][0][j] = __logf(f);
                            f = lb[1][j] + (1.f - lb[1][j]) * sigm(acc[ai][bj][m][1][j]); k1[j] = 1.f - f; acc[ai][bj][m][1][j] = __logf(f); }
                        *(u32x4*)(KA + rbase + (size_t)m * 16 * 128) = pack_row8(k0, k1); }
                    __builtin_amdgcn_sched_barrier(0);
#pragma unroll
                    for (int n = 0; n < 2; ++n)
#pragma unroll
                        for (int j = 0; j < 4; ++j) { float carry = 0.f;
#pragma unroll
                            for (int m = 0; m < 4; ++m) { float v = acc[ai][bj][m][n][j];
                                v += __int_as_float(__builtin_amdgcn_update_dpp(0, __float_as_int(v), 0x111, 0xf, 0xf, false));
                                v += __int_as_float(__builtin_amdgcn_update_dpp(0, __float_as_int(v), 0x112, 0xf, 0xf, false));
                                v += __int_as_float(__builtin_amdgcn_update_dpp(0, __float_as_int(v), 0x114, 0xf, 0xf, false));
                                v += __int_as_float(__builtin_amdgcn_update_dpp(0, __float_as_int(v), 0x118, 0xf, 0xf, false));
                                v += carry; carry = __shfl(v, lane | 15); acc[ai][bj][m][n][j] = v; } }
                    __builtin_amdgcn_sched_barrier(0);
#pragma unroll
                    for (int m = 0; m < 4; ++m) { float* cp = CUM + rbase + (size_t)m * 16 * 128; *(f32x4*)cp = acc[ai][bj][m][0]; *(f32x4*)(cp + 4) = acc[ai][bj][m][1]; }
                    if (fr == 15) {
#pragma unroll
                        for (int n = 0; n < 2; ++n) { f32x4 e;
#pragma unroll
                            for (int j = 0; j < 4; ++j) e[j] = __expf(acc[ai][bj][3][n][j]);
                            *(f32x4*)(DEC + (size_t)(u.pm * 4 + ai * 2 + wr) * 512 + col0 + bj * 128 + 4 * n) = e; } }
                    __builtin_amdgcn_sched_barrier(0);
                }
            }
            return;
        }
        bf16_t* dst; int pitch = 512; size_t bjoff = 128; float* o32 = nullptr;
        switch (seg) {
            case 0: dst = QOB + col0; pitch = 1024; break;
            case 2: dst = VA + (size_t)((pn & 1) * 2) * T * 128 + cw; pitch = 128; bjoff = (size_t)T * 128; break;
            case 3: dst = GA + (size_t)((pn & 1) * 2) * T * 128 + cw; pitch = 128; bjoff = (size_t)T * 128; break;
            case 4: dst = QOB + 512 + col0; pitch = 1024; break;
            default: dst = (seg == 5 ? KB : VB) + (size_t)((pn & 1) * 4 + (wc >> 1)) * T * 64 + (wc & 1) * 32 + 8 * fq; pitch = 64; bjoff = (size_t)2 * T * 64; break;
        }
        if (seg >= 5) {
            if (u.pm >= 128) o32 = out + (seg == 5 ? OFF_KS : OFF_VS) + (size_t)((u.pm - 128) * 256 + rt) * 512 + col0;
            else if ((u.pm & 63) >= 62) o32 = out + (seg == 5 ? OFF_KP : OFF_VP) + (size_t)((u.pm >> 6) * 512 + ((u.pm & 63) - 62) * 256 + rt) * 512 + col0;
        }
        const bool act = (seg == 0 || seg == 3);
#pragma unroll
        for (int ai = 0; ai < 2; ++ai)
#pragma unroll
            for (int m = 0; m < 4; ++m)
#pragma unroll
                for (int bj = 0; bj < 2; ++bj) { f32x4 v0 = acc[ai][bj][m][0], v1 = acc[ai][bj][m][1];
                    if (act) {
#pragma unroll
                        for (int j = 0; j < 4; ++j) { v0[j] = silu(v0[j]); v1[j] = silu(v1[j]); } }
                    *(u32x4*)(dst + (size_t)(row0 + ai * 128 + m * 16) * pitch + bj * bjoff) = pack_row8(v0, v1);
                    if (o32) { float* op = o32 + (size_t)(ai * 128 + m * 16) * 512 + bj * 128; *(f32x4*)op = v0; *(f32x4*)(op + 4) = v1; } __builtin_amdgcn_sched_barrier(0); }
    }
};

struct EpiMerge {
    static constexpr bool PERM = true, MIDK = true;
    const bf16_t *SGR, *SGB; bf16_t* Mo;
    DI void mid(Acc& acc, const Unit& u, int wr, int wc, int fr, int fq) const {
        { const int t_ = fresh_tid(); fr = t_ & 15; fq = (t_ >> 4) & 3; }
        const size_t gb = ((size_t)(u.pm * 8 + 2 * u.pn) * 8 * 512 + (size_t)(wr * 4 + wc) * 64 + (fq * 16 + fr)) * 8;
#pragma unroll
        for (int ai = 0; ai < 2; ++ai) { u32x4 a[4][2];
#pragma unroll
            for (int m = 0; m < 4; ++m)
#pragma unroll
                for (int bj = 0; bj < 2; ++bj) a[m][bj] = *(const u32x4*)(SGR + gb + ((size_t)bj * 8 + ai * 4 + m) * 512 * 8);
#pragma unroll
            for (int m = 0; m < 4; ++m)
#pragma unroll
                for (int bj = 0; bj < 2; ++bj)
#pragma unroll
                    for (int j = 0; j < 4; ++j) { acc[ai][bj][m][j >> 1][(j & 1) * 2] *= bflo(a[m][bj][j]); acc[ai][bj][m][j >> 1][(j & 1) * 2 + 1] *= bfhi(a[m][bj][j]); }
            __builtin_amdgcn_sched_barrier(0); }
    }
    DI void operator()(Acc& acc, const Unit& u, int wr, int wc, int fr, int fq) const {
        { const int t_ = fresh_tid(); fr = t_ & 15; fq = (t_ >> 4) & 3; }
        const size_t base = (size_t)(u.pm * 256 + wr * 64 + fr) * 1024 + u.pn * 256 + wc * 32 + 8 * fq;
        const size_t gb = ((size_t)(u.pm * 8 + 2 * u.pn) * 8 * 512 + (size_t)(wr * 4 + wc) * 64 + (fq * 16 + fr)) * 8;
#pragma unroll
        for (int ai = 0; ai < 2; ++ai) { u32x4 b[4][2];
#pragma unroll
            for (int m = 0; m < 4; ++m)
#pragma unroll
                for (int bj = 0; bj < 2; ++bj) b[m][bj] = *(const u32x4*)(SGB + gb + ((size_t)bj * 8 + ai * 4 + m) * 512 * 8);
#pragma unroll
            for (int m = 0; m < 4; ++m)
#pragma unroll
                for (int bj = 0; bj < 2; ++bj) { f32x4 v0 = acc[ai][bj][m][0], v1 = acc[ai][bj][m][1]; const u32x4 g = b[m][bj];
                    v0[0] *= bflo(g[0]); v0[1] *= bfhi(g[0]); v0[2] *= bflo(g[1]); v0[3] *= bfhi(g[1]);
                    v1[0] *= bflo(g[2]); v1[1] *= bfhi(g[2]); v1[2] *= bflo(g[3]); v1[3] *= bfhi(g[3]);
                    *(u32x4*)(Mo + base + (size_t)(ai * 128 + m * 16) * 1024 + bj * 128) = pack_row8(v0, v1); }
            __builtin_amdgcn_sched_barrier(0); }
    }
};

template <bool BASE_BF16> struct EpiRes {
    static constexpr bool PERM = true, MIDK = false;
    const float *xp, *xs; const bf16_t* xb; bf16_t* xo; const float* gmod;
    DI void operator()(Acc& acc, const Unit& u, int wr, int wc, int fr, int fq) const {
        { const int t_ = fresh_tid(); fr = t_ & 15; fq = (t_ >> 4) & 3; }
        const int colb = u.pn * 256 + wc * 32 + 8 * fq;
#pragma unroll
        for (int ai = 0; ai < 2; ++ai) { const int r0 = u.pm * 256 + ai * 128 + wr * 64 + fr;
            const float* g = gmod + (size_t)batch_of(r0) * 6144 + colb;
            f32x4 gv[2][2];
#pragma unroll
            for (int bj = 0; bj < 2; ++bj) { gv[bj][0] = *(const f32x4*)(g + bj * 128); gv[bj][1] = *(const f32x4*)(g + bj * 128 + 4); }
            bf16_t* orow = xo + (size_t)r0 * D + colb;
            if constexpr (BASE_BF16) {
                const bf16_t* xr = xb + (size_t)r0 * D + colb; u32x4 xv[4][2];
#pragma unroll
                for (int m = 0; m < 4; ++m)
#pragma unroll
                    for (int bj = 0; bj < 2; ++bj) xv[m][bj] = *(const u32x4*)(xr + (size_t)m * 16 * D + bj * 128);
#pragma unroll
                for (int m = 0; m < 4; ++m)
#pragma unroll
                    for (int bj = 0; bj < 2; ++bj) { const u32x4 x = xv[m][bj]; const f32x4 a0 = acc[ai][bj][m][0] * gv[bj][0], a1 = acc[ai][bj][m][1] * gv[bj][1];
                        f32x4 v0 = {bflo(x[0]) + a0[0], bfhi(x[0]) + a0[1], bflo(x[1]) + a0[2], bfhi(x[1]) + a0[3]}, v1 = {bflo(x[2]) + a1[0], bfhi(x[2]) + a1[1], bflo(x[3]) + a1[2], bfhi(x[3]) + a1[3]};
                        *(u32x4*)(orow + (size_t)m * 16 * D + bj * 128) = pack_row8(v0, v1); }
            } else {
                const float* xr = (r0 < TP ? xp + (size_t)r0 * D : xs + (size_t)(r0 - TP) * D) + colb; f32x4 xv[4][2][2];
#pragma unroll
                for (int m = 0; m < 4; ++m)
#pragma unroll
                    for (int bj = 0; bj < 2; ++bj) { xv[m][bj][0] = *(const f32x4*)(xr + (size_t)m * 16 * D + bj * 128); xv[m][bj][1] = *(const f32x4*)(xr + (size_t)m * 16 * D + bj * 128 + 4); }
#pragma unroll
                for (int m = 0; m < 4; ++m)
#pragma unroll
                    for (int bj = 0; bj < 2; ++bj) *(u32x4*)(orow + (size_t)m * 16 * D + bj * 128) = pack_row8(xv[m][bj][0] + gv[bj][0] * acc[ai][bj][m][0], xv[m][bj][1] + gv[bj][1] * acc[ai][bj][m][1]);
            }
            __builtin_amdgcn_sched_barrier(0); }
    }
};

struct EpiPart {
    static constexpr bool PERM = false, MIDK = false;
    float* part; int row0;
    DI void operator()(Acc& acc, const Unit& u, int wr, int wc, int fr, int fq) const {
        { const int t_ = fresh_tid(); fr = t_ & 15; fq = (t_ >> 4) & 3; }
#pragma unroll
        for (int ai = 0; ai < 2; ++ai)
#pragma unroll
            for (int m = 0; m < 4; ++m) { float* prow = part + (size_t)(u.pm * 256 + ai * 128 + wr * 64 + m * 16 + fr - row0) * D + u.pn * 256 + wc * 32 + 4 * fq;
#pragma unroll
                for (int bj = 0; bj < 2; ++bj)
#pragma unroll
                    for (int n = 0; n < 2; ++n) *(f32x4*)(prow + bj * 128 + n * 16) = acc[ai][bj][m][n];
                __builtin_amdgcn_sched_barrier(0); }
    }
};

struct EpiFfnIn {
    static constexpr bool PERM = true, MIDK = false;
    bf16_t* HID;
    DI void operator()(Acc& acc, const Unit& u, int wr, int wc, int fr, int fq) const {
        { const int t_ = fresh_tid(); fr = t_ & 15; fq = (t_ >> 4) & 3; }
        bf16_t* base = HID + (size_t)(u.pm * 256 + wr * 64 + fr) * FF + u.pn * 128 + wc * 32 + 8 * fq;
#pragma unroll
        for (int ai = 0; ai < 2; ++ai)
#pragma unroll
            for (int m = 0; m < 4; ++m) { f32x4 v0, v1;
#pragma unroll
                for (int j = 0; j < 4; ++j) { v0[j] = silu(acc[ai][0][m][0][j]) * acc[ai][1][m][0][j]; v1[j] = silu(acc[ai][0][m][1][j]) * acc[ai][1][m][1][j]; }
                *(u32x4*)(base + (size_t)(ai * 128 + m * 16) * FF) = pack_row8(v0, v1); __builtin_amdgcn_sched_barrier(0); }
    }
};

DI void transpose_item(const float* W, int N, bf16_t* WT, int pitch, int koff, int k0, int n0, int drow0, LAS float* scr, int lane) {
#pragma unroll
    for (int i = 0; i < 32; ++i) { const int kk = 2 * i + (lane >> 5); scr[kk * 33 + (lane & 31)] = W[(size_t)(k0 + kk) * N + n0 + (lane & 31)]; }
    asm volatile("s_waitcnt lgkmcnt(0)" ::: "memory");
    const int c = lane & 7;
#pragma unroll
    for (int j = 0; j < 4; ++j) { const int n = (lane >> 3) + 8 * j; const LAS float* s = scr + (8 * c) * 33 + n;
        u32x4 o; o.x = pk2(s[0 * 33], s[1 * 33]); o.y = pk2(s[2 * 33], s[3 * 33]); o.z = pk2(s[4 * 33], s[5 * 33]); o.w = pk2(s[6 * 33], s[7 * 33]);
        *(u32x4*)(WT + (size_t)(drow0 + n) * pitch + koff + k0 + 8 * c) = o; }
    asm volatile("s_waitcnt lgkmcnt(0)" ::: "memory");
}
DI void phase_prep(const Params& p, LAS unsigned char* lds) {
    const int tid = fresh_tid(), lane = tid & 63, wave = __builtin_amdgcn_readfirstlane(tid >> 6);
    LAS float* scr = (LAS float*)(lds + wave * 16384);
    const int gw = blockIdx.x * 8 + wave, NGW = gridDim.x * 8;
    unsigned char* ws = p.ws;
    constexpr int I_ADA = 16 * 192, I_IN = 16 * 176, I_A = 8 * 32, I_O = 16 * 32, I_FI = 16 * 176, I_FO = 44 * 32;
    constexpr int NIT = I_ADA + I_IN + 2 * I_A + I_O + I_FI + I_FO;
    for (int it = gw; it < NIT; it += NGW) {
        int r = it;
        if (r < I_ADA) { const int kb = r / 192, nb = r % 192; transpose_item(p.w_ada, 6144, (bf16_t*)(ws + WS_WADA), 1024, 0, 64 * kb, 32 * nb, 32 * nb, scr, lane); continue; } r -= I_ADA;
        if (r < I_IN) { const int kb = r / 176, nb = r % 176, n0 = 32 * nb; int dr = n0;
            if (n0 >= 3584) { const int j = n0 < 4608 ? n0 - 3584 : n0 - 4608; dr = 3584 + 256 * (j >> 7) + (j & 127) + (n0 < 4608 ? 0 : 128); }
            transpose_item(p.w_in, INC, (bf16_t*)(ws + WS_WIN), 1024, 0, 64 * kb, n0, dr, scr, lane); continue; } r -= I_IN;
        if (r < I_A) { const int kb = r / 32, nb = r % 32; transpose_item(p.w_a, 1024, (bf16_t*)(ws + WS_WAB), 1024, 0, 64 * kb, 32 * nb, 32 * nb, scr, lane); continue; } r -= I_A;
        if (r < I_A) { const int kb = r / 32, nb = r % 32; transpose_item(p.w_b, 1024, (bf16_t*)(ws + WS_WAB), 1024, 512, 64 * kb, 32 * nb, 32 * nb, scr, lane); continue; } r -= I_A;
        if (r < I_O) { const int kb = r / 32, nb = r % 32; transpose_item(p.w_out, 1024, (bf16_t*)(ws + WS_WO), 1024, 0, 64 * kb, 32 * nb, 32 * nb, scr, lane); continue; } r -= I_O;
        if (r < I_FI) { const int kb = r / 176, nb = r % 176; const int n0 = 32 * nb; const int j0 = n0 < FF ? n0 : n0 - FF;
            transpose_item(p.w_ffn_in, INC, (bf16_t*)(ws + WS_WFI), 1024, 0, 64 * kb, n0, 256 * (j0 >> 7) + (j0 & 127) + (n0 < FF ? 0 : 128), scr, lane); continue; } r -= I_FI;
        { const int kb = r / 32, nb = r % 32; transpose_item(p.w_ffn_out, 1024, (bf16_t*)(ws + WS_WFO), FF, 0, 64 * kb, 32 * nb, 32 * nb, scr, lane); }
    }
    bf16_t* SC = (bf16_t*)(ws + WS_SC);
    for (int i = blockIdx.x * 512 + tid; i < 256 * 1024 / 2; i += gridDim.x * 512) { const int row = (2 * i) >> 10, col = (2 * i) & 1023; float a = 0.f, b = 0.f;
        if (row < NBATCH) { const float* c = row < 2 ? p.c_prompt + row * D : p.c_sample + (row - 2) * D; a = silu(c[col]); b = silu(c[col + 1]); }
        ((unsigned*)SC)[i] = pk2(a, b); }
}

DI float wave_sum(float v) {
#pragma unroll
    for (int o = 1; o < 64; o <<= 1) v += __shfl_xor(v, o);
    return v;
}
DI void phase_norm_mod(const float* xp, const float* xs, const float* nw, const float* mod, int sh_off, int sc_off, bf16_t* H) {
    const int tid = fresh_tid(), lane = tid & 63, wave = __builtin_amdgcn_readfirstlane(tid >> 6);
    const int gw = blockIdx.x * 8 + wave, NGW = gridDim.x * 8;
    for (int r = gw; r < T; r += NGW) {
        const float* xr = r < TP ? xp + (size_t)r * D : xs + (size_t)(r - TP) * D; const float* mb = mod + (size_t)batch_of(r) * 6144;
        f32x4 v[4]; float s = 0.f;
#pragma unroll
        for (int j = 0; j < 4; ++j) { v[j] = *(const f32x4*)(xr + 4 * lane + 256 * j); s += (v[j][0] * v[j][0] + v[j][1] * v[j][1]) + (v[j][2] * v[j][2] + v[j][3] * v[j][3]); }
        const float rstd = __builtin_amdgcn_rsqf(wave_sum(s) * (1.f / D) + EPS);
#pragma unroll
        for (int j = 0; j < 4; ++j) { const int col = 4 * lane + 256 * j; const f32x4 w = *(const f32x4*)(nw + col), sc = *(const f32x4*)(mb + sc_off + col), sh = *(const f32x4*)(mb + sh_off + col);
            const f32x4 h = v[j] * rstd * w * (sc + 1.f) + sh; u32x2 o; o.x = pk2(h[0], h[1]); o.y = pk2(h[2], h[3]);
            *(u32x2*)(H + (size_t)r * D + col) = o; }
    }
}
DI void phase_norm_mod_b(const bf16_t* xb, const float* nw, const float* mod, int sh_off, int sc_off, bf16_t* H, int r_lo = 0, int r_hi = T, int b_lo = 0) {
    const int tid = fresh_tid(), lane = tid & 63, wave = __builtin_amdgcn_readfirstlane(tid >> 6);
    const int gw = ((int)blockIdx.x - b_lo) * 8 + wave, NGW = ((int)gridDim.x - b_lo) * 8;
    for (int r = r_lo + gw; r < r_hi; r += NGW) {
        const bf16_t* xr = xb + (size_t)r * D; const float* mb = mod + (size_t)batch_of(r) * 6144;
        float v[2][8]; float s = 0.f;
#pragma unroll
        for (int j = 0; j < 2; ++j) { const u32x4 x = *(const u32x4*)(xr + 8 * lane + 512 * j);
#pragma unroll
            for (int i = 0; i < 4; ++i) { v[j][2 * i] = bflo(x[i]); v[j][2 * i + 1] = bfhi(x[i]); s += v[j][2 * i] * v[j][2 * i] + v[j][2 * i + 1] * v[j][2 * i + 1]; } }
        const float rstd = __builtin_amdgcn_rsqf(wave_sum(s) * (1.f / D) + EPS);
#pragma unroll
        for (int j = 0; j < 2; ++j) { const int col = 8 * lane + 512 * j; f32x4 h[2];
#pragma unroll
            for (int q = 0; q < 2; ++q) { const f32x4 w = *(const f32x4*)(nw + col + 4 * q), sc = *(const f32x4*)(mb + sc_off + col + 4 * q), sh = *(const f32x4*)(mb + sh_off + col + 4 * q);
                const f32x4 x = {v[j][4 * q], v[j][4 * q + 1], v[j][4 * q + 2], v[j][4 * q + 3]}; h[q] = x * rstd * w * (sc + 1.f) + sh; }
            *(u32x4*)(H + (size_t)r * D + col) = pack_row8(h[0], h[1]); }
    }
}
DI void phase_final_norm(const bf16_t* xb, float* y, const float* nw, int r_lo = 0, int r_hi = T, int b_lo = 0) {
    const int tid = fresh_tid(), lane = tid & 63, wave = __builtin_amdgcn_readfirstlane(tid >> 6);
    const int gw = ((int)blockIdx.x - b_lo) * 8 + wave, NGW = ((int)gridDim.x - b_lo) * 8;
    for (int r = r_lo + gw; r < r_hi; r += NGW) { const bf16_t* xr = xb + (size_t)r * D; float* yr = y + (size_t)r * D;
        float v[2][8]; float s = 0.f;
#pragma unroll
        for (int j = 0; j < 2; ++j) { const u32x4 x = *(const u32x4*)(xr + 8 * lane + 512 * j);
#pragma unroll
            for (int i = 0; i < 4; ++i) { v[j][2 * i] = bflo(x[i]); v[j][2 * i + 1] = bfhi(x[i]); s += v[j][2 * i] * v[j][2 * i] + v[j][2 * i + 1] * v[j][2 * i + 1]; } }
        const float rstd = __builtin_amdgcn_rsqf(wave_sum(s) * (1.f / D) + EPS);
#pragma unroll
        for (int j = 0; j < 2; ++j) { const int col = 8 * lane + 512 * j;
#pragma unroll
            for (int q = 0; q < 2; ++q) { const f32x4 x = {v[j][4 * q], v[j][4 * q + 1], v[j][4 * q + 2], v[j][4 * q + 3]}; *(f32x4*)(yr + col + 4 * q) = x * rstd * *(const f32x4*)(nw + col + 4 * q); } }
    }
}

DI void phase_final_norm_parts(const bf16_t* x1b, const float* part0, const float* part1, const float* g2mod, float* y, const float* nw) {
    const int tid = fresh_tid(), lane = tid & 63, wave = __builtin_amdgcn_readfirstlane(tid >> 6);
    const int gw = blockIdx.x * 8 + wave, NGW = gridDim.x * 8;
    for (int r = TP + gw; r < T; r += NGW) { const float* gb = g2mod + (size_t)batch_of(r) * 6144; const size_t po = (size_t)(r - TP) * D;
        f32x4 v[4]; float s = 0.f;
#pragma unroll
        for (int j = 0; j < 4; ++j) { const int col = 4 * lane + 256 * j; const u32x2 xb = *(const u32x2*)(x1b + (size_t)r * D + col);
            const f32x4 x = {bflo(xb.x), bfhi(xb.x), bflo(xb.y), bfhi(xb.y)};
            v[j] = x + *(const f32x4*)(gb + col) * (*(const f32x4*)(part0 + po + col) + *(const f32x4*)(part1 + po + col));
            s += (v[j][0] * v[j][0] + v[j][1] * v[j][1]) + (v[j][2] * v[j][2] + v[j][3] * v[j][3]); }
        const float rstd = __builtin_amdgcn_rsqf(wave_sum(s) * (1.f / D) + EPS);
#pragma unroll
        for (int j = 0; j < 4; ++j) { const int col = 4 * lane + 256 * j; *(f32x4*)(y + (size_t)r * D + col) = v[j] * rstd * *(const f32x4*)(nw + col); }
    }
}

DI void hgrn_u_item(const Params& p, int item, int lane) {
    const int c = item >> 4, rem = item & 15, h = rem >> 2, kt = rem & 3, l31 = lane & 31, hf = lane >> 5;
    const float* CUM = (const float*)(p.ws + WS_CUM); const bf16_t* KA = (const bf16_t*)(p.ws + WS_KA); const bf16_t* VA = (const bf16_t*)(p.ws + WS_VA); bf16_t* U = (bf16_t*)(p.ws + WS_U);
    const size_t hb = (size_t)h * T * 128; const int kcol = 32 * kt + l31;
    const float tot = CUM[hb + (size_t)(c * 64 + 63) * 128 + kcol];
    bf16x8 kdf[2][2];
#pragma unroll
    for (int st = 0; st < 2; ++st) { f32x16 kd;
#pragma unroll
        for (int r = 0; r < 16; ++r) { const size_t idx = hb + (size_t)(c * 64 + 32 * st + crow(r, hf)) * 128 + kcol; kd[r] = bf2f((short)KA[idx]) * __expf(tot - CUM[idx]); }
        kdf[st][0] = pack8(kd, 0); kdf[st][1] = pack8(kd, 1); }
    const bf16x8 id0 = ident_frag(0, l31, hf), id1 = ident_frag(1, l31, hf);
#pragma unroll
    for (int vt = 0; vt < 4; ++vt) { f32x16 dacc = zero16();
#pragma unroll
        for (int st = 0; st < 2; ++st) { const bf16_t* vp = VA + hb + (size_t)(c * 64 + 32 * st + l31) * 128 + 32 * vt + 8 * hf;
            f32x16 vx = zero16(); vx = MFMA32(*(const bf16x8*)vp, id0, vx); vx = MFMA32(*(const bf16x8*)(vp + 16), id1, vx);
            dacc = MFMA32(kdf[st][0], pack8(vx, 0), dacc); dacc = MFMA32(kdf[st][1], pack8(vx, 1), dacc); }
        bf16_t* up = U + ((size_t)(c * 4 + h) * 128 + 32 * vt + l31) * 128 + 32 * kt + 8 * hf;
#pragma unroll
        for (int g = 0; g < 4; g += 2) { u32x2 o0, o1; o0.x = pk2(dacc[4 * g], dacc[4 * g + 1]); o0.y = pk2(dacc[4 * g + 2], dacc[4 * g + 3]); o1.x = pk2(dacc[4 * g + 4], dacc[4 * g + 5]); o1.y = pk2(dacc[4 * g + 6], dacc[4 * g + 7]);
            *(u32x4*)(up + 8 * g) = widen_pair(o0, o1); }
    }
}

DI void scan_prompt_item(const Params& p, int item, int lane) {
    const int bh = item >> 5, vq = item & 31, b = bh >> 2, h = bh & 3, kg = lane & 31, vv = lane >> 5;
    const float* __restrict__ DEC = (const float*)(p.ws + WS_DEC); const bf16_t* __restrict__ U = (const bf16_t*)(p.ws + WS_U); bf16_t* __restrict__ SST = (bf16_t*)(p.ws + WS_SST);
    f32x4 S0 = {0.f, 0.f, 0.f, 0.f}, S1 = {0.f, 0.f, 0.f, 0.f};
    const int v0 = 4 * vq + vv, v1 = v0 + 2;
#pragma unroll 16
    for (int n = 0; n < 256; ++n) { const int c = b * 256 + n;
        const f32x4 d = *(const f32x4*)(DEC + (size_t)c * 512 + h * 128 + 4 * kg);
        const size_t o0 = ((size_t)(c * 4 + h) * 128 + v0) * 128 + 4 * kg, o1 = ((size_t)(c * 4 + h) * 128 + v1) * 128 + 4 * kg;
        const u32x2 u0 = *(const u32x2*)(U + o0), u1 = *(const u32x2*)(U + o1);
        u32x2 s; s.x = pk2(S0[0], S0[1]); s.y = pk2(S0[2], S0[3]); *(u32x2*)(SST + o0) = s;
        s.x = pk2(S1[0], S1[1]); s.y = pk2(S1[2], S1[3]); *(u32x2*)(SST + o1) = s;
        S0[0] = d[0] * S0[0] + bflo(u0.x); S0[1] = d[1] * S0[1] + bfhi(u0.x); S0[2] = d[2] * S0[2] + bflo(u0.y); S0[3] = d[3] * S0[3] + bfhi(u0.y);
        S1[0] = d[0] * S1[0] + bflo(u1.x); S1[1] = d[1] * S1[1] + bfhi(u1.x); S1[2] = d[2] * S1[2] + bflo(u1.y); S1[3] = d[3] * S1[3] + bfhi(u1.y);
    }
    float* sp = p.out + OFF_SP + ((size_t)bh * 128 + 4 * kg) * 128;
#pragma unroll
    for (int i = 0; i < 4; ++i) { sp[(size_t)i * 128 + v0] = S0[i]; sp[(size_t)i * 128 + v1] = S1[i]; }
}
DI void scan_sample_item(const Params& p, int item, int lane) {
    const int bh = item >> 5, vq = item & 31, bs = bh >> 2, h = bh & 3, kg = lane & 31, vv = lane >> 5, c = 512 + bs;
    const float* DEC = (const float*)(p.ws + WS_DEC); const bf16_t* U = (const bf16_t*)(p.ws + WS_U); bf16_t* SST = (bf16_t*)(p.ws + WS_SST);
    const f32x4 d = *(const f32x4*)(DEC + (size_t)c * 512 + h * 128 + 4 * kg);
    const float* s0 = p.state + ((size_t)bh * 128 + 4 * kg) * 128; float* so = p.out + OFF_SS + ((size_t)bh * 128 + 4 * kg) * 128;
#pragma unroll
    for (int e = 0; e < 2; ++e) { const int v = 4 * vq + 2 * e + vv; const size_t o = ((size_t)(c * 4 + h) * 128 + v) * 128 + 4 * kg;
        const u32x2 u = *(const u32x2*)(U + o); f32x4 S;
#pragma unroll
        for (int i = 0; i < 4; ++i) S[i] = s0[(size_t)i * 128 + v];
        u32x2 s; s.x = pk2(S[0], S[1]); s.y = pk2(S[2], S[3]); *(u32x2*)(SST + o) = s;
        so[v] = d[0] * S[0] + bflo(u.x); so[128 + v] = d[1] * S[1] + bfhi(u.x); so[256 + v] = d[2] * S[2] + bflo(u.y); so[384 + v] = d[3] * S[3] + bfhi(u.y); }
}

DI void attn_item(const Params& p, int item, int lane, const LAS float* biasl) {
    const int c = item >> 3, h = item & 7, l31 = lane & 31, hf = lane >> 5;
    const bf16_t* KB = (const bf16_t*)(p.ws + WS_KB); const bf16_t* VB = (const bf16_t*)(p.ws + WS_VB);
    bf16x8 qf[2][4];
    { const bf16_t* qptr = (const bf16_t*)(p.ws + WS_QOB) + (size_t)(c * 64 + l31) * 1024 + 512 + h * 64;
#pragma unroll
    for (int qq = 0; qq < 2; ++qq)
#pragma unroll
        for (int ks = 0; ks < 4; ++ks) qf[qq][ks] = *(const bf16x8*)(qptr + (size_t)qq * 32 * 1024 + 16 * ks + 8 * hf); }
    const LAS float* bl = biasl + h * 192;
    f32x16 OT[2][2]; float mrun[2], lsum[2];
#pragma unroll
    for (int qq = 0; qq < 2; ++qq) { OT[qq][0] = zero16(); OT[qq][1] = zero16(); mrun[qq] = -1e30f; lsum[qq] = 0.f; }
    int ntile, ncache, db0, krow_first;
    if (c < 512) { const int n = c & 255, j0 = n < 8 ? n : 8; ntile = 2 * (j0 + 1); ncache = 0; db0 = 64 * j0; krow_first = (c - j0) * 64; }
    else { ntile = 18; ncache = 16; db0 = 512; krow_first = c * 64 - 512; }
    const int bs = c - 512;
    u32x4 nk[4], nv[4];
#define ATT_LOAD(i_) do { if ((i_) >= ncache) { const size_t ro_ = ((size_t)h * T + (size_t)(krow_first + 32 * (i_) + l31)) * 64 + 8 * hf; \
            _Pragma("unroll") for (int ks = 0; ks < 4; ++ks) { nk[ks] = *(const u32x4*)(KB + ro_ + 16 * ks); nv[ks] = *(const u32x4*)(VB + ro_ + 16 * ks); } } } while (0)
    ATT_LOAD(0);
    for (int i = 0; i < ntile; ++i) {
        bf16x8 kf[4], vf[2][2];
        if (i < ncache) {
            const float* kp_ = p.cache_k + ((size_t)(bs * 512 + 32 * i + l31) * 8 + h) * 64 + 8 * hf; const float* vp_ = p.cache_v + ((size_t)(bs * 512 + 32 * i + l31) * 8 + h) * 64 + 8 * hf;
#pragma unroll
            for (int ks = 0; ks < 4; ++ks) { u32x4 w; const f32x4 a = *(const f32x4*)(kp_ + 16 * ks), b = *(const f32x4*)(kp_ + 16 * ks + 4), e = *(const f32x4*)(vp_ + 16 * ks), f = *(const f32x4*)(vp_ + 16 * ks + 4);
                w.x = pk2(a[0], a[1]); w.y = pk2(a[2], a[3]); w.z = pk2(b[0], b[1]); w.w = pk2(b[2], b[3]); kf[ks] = __builtin_bit_cast(bf16x8, w);
                w.x = pk2(e[0], e[1]); w.y = pk2(e[2], e[3]); w.z = pk2(f[0], f[1]); w.w = pk2(f[2], f[3]); vf[ks >> 1][ks & 1] = __builtin_bit_cast(bf16x8, w); }
        } else {
#pragma unroll
            for (int ks = 0; ks < 4; ++ks) { kf[ks] = __builtin_bit_cast(bf16x8, nk[ks]); vf[ks >> 1][ks & 1] = __builtin_bit_cast(bf16x8, nv[ks]); }
        }
        if (i + 1 < ntile) ATT_LOAD(i + 1);
        asm volatile("" ::: "memory");
        bf16x8 vxf[2][2];
        const int l31b = launder(l31); const bf16x8 id0 = ident_frag(0, l31b, hf), id1 = ident_frag(1, l31b, hf);
#pragma unroll
        for (int dt = 0; dt < 2; ++dt) { f32x16 vx = zero16(); vx = MFMA32(vf[dt][0], id0, vx); vx = MFMA32(vf[dt][1], id1, vx); vxf[dt][0] = pack8(vx, 0); vxf[dt][1] = pack8(vx, 1); }
#pragma unroll
        for (int qq = 0; qq < 2; ++qq) {
            f32x16 st = zero16();
#pragma unroll
            for (int ks = 0; ks < 4; ++ks) st = MFMA32(kf[ks], qf[qq][ks], st);
            const int dq = db0 + 32 * qq - 32 * i; float mt = -1e30f;
            if (dq - 31 >= 128) { const float bc = bl[191];
#pragma unroll
                for (int r = 0; r < 16; ++r) { const float s = st[r] * (0.125f * LOG2E) + bc; st[r] = s; mt = fmaxf(mt, s); }
            } else { const int dbase = dq + l31;
#pragma unroll
                for (int r = 0; r < 16; ++r) { int dist = dbase - crow(r, hf); dist = dist > 128 ? 128 : dist; const float s = st[r] * (0.125f * LOG2E) + bl[dist + 63]; st[r] = s; mt = fmaxf(mt, s); }
            }
            mt = fmaxf(mt, __shfl_xor(mt, 32));
            const float mnew = fmaxf(mrun[qq], mt), alpha = __builtin_amdgcn_exp2f(mrun[qq] - mnew); mrun[qq] = mnew;
            float ps = 0.f;
#pragma unroll
            for (int r = 0; r < 16; ++r) { st[r] = __builtin_amdgcn_exp2f(st[r] - mnew); ps += st[r]; }
            lsum[qq] = lsum[qq] * alpha + ps;
#pragma unroll
            for (int r = 0; r < 16; ++r) { OT[qq][0][r] *= alpha; OT[qq][1][r] *= alpha; }
            const bf16x8 pf0 = pack8(st, 0), pf1 = pack8(st, 1);
            OT[qq][0] = MFMA32(vxf[0][0], pf0, OT[qq][0]); OT[qq][0] = MFMA32(vxf[0][1], pf1, OT[qq][0]);
            OT[qq][1] = MFMA32(vxf[1][0], pf0, OT[qq][1]); OT[qq][1] = MFMA32(vxf[1][1], pf1, OT[qq][1]);
        }
    }
#undef ATT_LOAD
    bf16_t* qptr = (bf16_t*)(p.ws + WS_QOB) + (size_t)(c * 64 + launder(l31)) * 1024 + 512 + h * 64;
#pragma unroll
    for (int qq = 0; qq < 2; ++qq) { const float l = lsum[qq] + __shfl_xor(lsum[qq], 32), inv = 1.f / l; bf16_t* op = qptr + (size_t)qq * 32 * 1024;
#pragma unroll
        for (int dt = 0; dt < 2; ++dt)
#pragma unroll
            for (int g = 0; g < 4; g += 2) { u32x2 o0, o1; o0.x = pk2(OT[qq][dt][4 * g] * inv, OT[qq][dt][4 * g + 1] * inv); o0.y = pk2(OT[qq][dt][4 * g + 2] * inv, OT[qq][dt][4 * g + 3] * inv);
                o1.x = pk2(OT[qq][dt][4 * g + 4] * inv, OT[qq][dt][4 * g + 5] * inv); o1.y = pk2(OT[qq][dt][4 * g + 6] * inv, OT[qq][dt][4 * g + 7] * inv);
                *(u32x4*)(op + 32 * dt + 8 * (g + hf)) = widen_pair(o0, o1); } }
}

DI void hgrn_out_item(const Params& p, int item, int lane, bf16_t* obase = nullptr) {
    const int c = item >> 3, h = (item >> 1) & 3, tt = item & 1, l31 = lane & 31, hf = lane >> 5;
    const float* CUM = (const float*)(p.ws + WS_CUM); const bf16_t* KA = (const bf16_t*)(p.ws + WS_KA); const bf16_t* VA = (const bf16_t*)(p.ws + WS_VA);
    const bf16_t* GA = (const bf16_t*)(p.ws + WS_GA); const bf16_t* SST = (const bf16_t*)(p.ws + WS_SST);
    const int trow = c * 64 + 32 * tt + l31;
    bf16_t* qap = (bf16_t*)(p.ws + WS_QOB) + (size_t)trow * 1024 + h * 128;
    const size_t hb = (size_t)h * T * 128;
    const float* cumt = CUM + hb + (size_t)trow * 128; const float* refp = CUM + hb + (size_t)(c * 64 + 32) * 128;
    bf16x8 qd1[8], qd2[8], kdt[8];
    const bf16_t* kat = KA + hb + (size_t)trow * 128;
#pragma unroll
    for (int ks = 0; ks < 8; ++ks) { const int k0 = 16 * ks + 8 * hf; const bf16x8 q8 = *(const bf16x8*)(qap + k0), k8 = *(const bf16x8*)(kat + k0);
        const f32x4 c0 = *(const f32x4*)(cumt + k0), c1 = *(const f32x4*)(cumt + k0 + 4), r0 = *(const f32x4*)(refp + k0), r1 = *(const f32x4*)(refp + k0 + 4);
        float a[8], b[8], d[8];
#pragma unroll
        for (int j = 0; j < 8; ++j) { const float q = bf2f(q8[j]), cu = j < 4 ? c0[j & 3] : c1[j & 3], rf = j < 4 ? r0[j & 3] : r1[j & 3]; a[j] = q * __expf(cu - rf); b[j] = q * __expf(cu); d[j] = bf2f(k8[j]) * __expf(rf - cu); }
        qd1[ks] = pack8f(a); qd2[ks] = pack8f(b); kdt[ks] = pack8f(d); }
    f32x16 OT[4];
#pragma unroll
    for (int vt = 0; vt < 4; ++vt) OT[vt] = zero16();
    const bf16_t* sp = SST + ((size_t)(c * 4 + h) * 128 + l31) * 128 + 8 * hf;
#pragma unroll
    for (int vt = 0; vt < 4; ++vt) {
#pragma unroll
        for (int ks = 0; ks < 8; ++ks) OT[vt] = MFMA32(*(const bf16x8*)(sp + (size_t)vt * 32 * 128 + 16 * ks), qd2[ks], OT[vt]);
        __builtin_amdgcn_sched_barrier(0); }
    const bf16x8 id0 = ident_frag(0, l31, hf), id1 = ident_frag(1, l31, hf);
    for (int st = 0; st <= tt; ++st) {
        const int srow = c * 64 + 32 * st + l31; const bf16_t* kap = KA + hb + (size_t)srow * 128; const float* cums = CUM + hb + (size_t)srow * 128;
        f32x16 X = zero16();
        if (st == tt) {
#pragma unroll
            for (int ks = 0; ks < 8; ++ks) X = MFMA32(kdt[ks], qd1[ks], X);
        } else
#pragma unroll
        for (int ks = 0; ks < 8; ++ks) { const int k0 = 16 * ks + 8 * hf; const bf16x8 k8 = *(const bf16x8*)(kap + k0);
            const f32x4 c0 = *(const f32x4*)(cums + k0), c1 = *(const f32x4*)(cums + k0 + 4), r0 = *(const f32x4*)(refp + k0), r1 = *(const f32x4*)(refp + k0 + 4);
            float a[8];
#pragma unroll
            for (int j = 0; j < 8; ++j) { const float cu = j < 4 ? c0[j & 3] : c1[j & 3], rf = j < 4 ? r0[j & 3] : r1[j & 3]; a[j] = bf2f(k8[j]) * __expf(rf - cu); }
            X = MFMA32(pack8f(a), qd1[ks], X); }
        if (st == tt) {
#pragma unroll
            for (int r = 0; r < 16; ++r) if (crow(r, hf) > l31) X[r] = 0.f; }
        const bf16x8 xf0 = pack8(X, 0), xf1 = pack8(X, 1);
        const bf16_t* vp = VA + hb + (size_t)srow * 128 + 8 * hf;
#pragma unroll
        for (int vt = 0; vt < 4; ++vt) { f32x16 vx = zero16(); vx = MFMA32(*(const bf16x8*)(vp + 32 * vt), id0, vx); vx = MFMA32(*(const bf16x8*)(vp + 32 * vt + 16), id1, vx);
            OT[vt] = MFMA32(pack8(vx, 0), xf0, OT[vt]); OT[vt] = MFMA32(pack8(vx, 1), xf1, OT[vt]); }
    }
    float ss = 0.f;
#pragma unroll
    for (int vt = 0; vt < 4; ++vt)
#pragma unroll
        for (int r = 0; r < 16; ++r) ss += OT[vt][r] * OT[vt][r];
    ss += __shfl_xor(ss, 32);
    const float rstd = __builtin_amdgcn_rsqf(ss * (1.f / 128.f) + EPS);
    const bf16_t* gap = GA + hb + (size_t)trow * 128; const float* onp = p.out_norm + h * 128;
    if (obase) qap = obase + (size_t)trow * 512 + h * 128;
#pragma unroll
    for (int vt = 0; vt < 4; ++vt)
#pragma unroll
        for (int g = 0; g < 4; g += 2) { u32x2 ga0, ga1; narrow_pair(*(const u32x4*)(gap + 32 * vt + 8 * (g + hf)), ga0, ga1);
            u32x2 o0, o1;
            { const int v0 = 32 * vt + 8 * g + 4 * hf; const f32x4 on = *(const f32x4*)(onp + v0);
              o0.x = pk2(OT[vt][4 * g] * rstd * on[0] * bflo(ga0.x), OT[vt][4 * g + 1] * rstd * on[1] * bfhi(ga0.x)); o0.y = pk2(OT[vt][4 * g + 2] * rstd * on[2] * bflo(ga0.y), OT[vt][4 * g + 3] * rstd * on[3] * bfhi(ga0.y)); }
            { const int v0 = 32 * vt + 8 * (g + 1) + 4 * hf; const f32x4 on = *(const f32x4*)(onp + v0);
              o1.x = pk2(OT[vt][4 * g + 4] * rstd * on[0] * bflo(ga1.x), OT[vt][4 * g + 5] * rstd * on[1] * bfhi(ga1.x)); o1.y = pk2(OT[vt][4 * g + 6] * rstd * on[2] * bflo(ga1.y), OT[vt][4 * g + 7] * rstd * on[3] * bfhi(ga1.y)); }
            *(u32x4*)(qap + 32 * vt + 8 * (g + hf)) = widen_pair(o0, o1); }
}


#define XB_TMO      128
#define XB_XCNT(j)  (256  + 64 * (j))
#define XB_XSUB(j)  (1280 + 64 * (j))
#define XB_XGEN(j)  (2304 + 64 * (j))
#define XB_TOP      3328
#define XB_TOPGEN   3392
#define XCD_BAR_WORDS 3456
#define XB_SPIN_CAP (1u << 18)
DI unsigned xb_ld(unsigned* p)              { return __hip_atomic_load(p, __ATOMIC_RELAXED, __HIP_MEMORY_SCOPE_AGENT); }
DI unsigned xb_add(unsigned* p, unsigned v) { return __hip_atomic_fetch_add(p, v, __ATOMIC_RELAXED, __HIP_MEMORY_SCOPE_AGENT); }
DI unsigned xb_xcc_id() { return (unsigned)__builtin_amdgcn_s_getreg((3 << 11) | 20) & 0xFu; }
#define XB_SPIN(cond, bar) do { unsigned _sp = 0; while (cond) { __builtin_amdgcn_s_sleep(1); \
    if ((++_sp & 255u) == 0u) { if (xb_ld(&(bar)[XB_TMO])) break; if (_sp > XB_SPIN_CAP) { atomicAdd(&(bar)[XB_TMO], 1u); break; } } } } while (0)
struct XcdBarrier { unsigned* bar; unsigned x; volatile LAS unsigned* st; };
DI XcdBarrier xcd_barrier_post(unsigned* bar, volatile LAS unsigned* st) {
    XcdBarrier b; b.bar = bar; b.x = xb_xcc_id(); b.st = st;
    if (threadIdx.x == 0) (void)xb_add(&bar[XB_XCNT(b.x)], 1u);
    return b;
}
DI void xcd_barrier_complete(unsigned* bar, unsigned x, unsigned& nloc, unsigned& nx) {
    const unsigned G = gridDim.x * gridDim.y * gridDim.z;
    unsigned sum, cnt, mine, sp = 0u;
    for (;;) {
        sum = 0u; cnt = 0u; mine = 0u;
#pragma unroll
        for (unsigned j = 0; j < 16; ++j) { const unsigned c = xb_ld(&bar[XB_XCNT(j)]); sum += c; cnt += (c > 0u) ? 1u : 0u; mine = (j == x) ? c : mine; }
        if (sum == G) break;
        __builtin_amdgcn_s_sleep(1);
        if ((++sp & 255u) == 0u) { if (xb_ld(&bar[XB_TMO])) break; if (sp > XB_SPIN_CAP) { atomicAdd(&bar[XB_TMO], 1u); break; } }
    }
    nloc = mine > 0u ? mine : 1u; nx = cnt > 0u ? cnt : 1u;
}
DI void xcd_barrier(const XcdBarrier& b) {
    asm volatile("s_waitcnt vmcnt(0)" ::: "memory");
    __syncthreads();
    if (threadIdx.x == 0) {
        unsigned* bar = b.bar;
        __builtin_amdgcn_s_waitcnt(0);
        unsigned nloc = b.st[0], nx = b.st[1];
        if (nloc == 0u) { xcd_barrier_complete(bar, b.x, nloc, nx); b.st[0] = nloc; b.st[1] = nx; }
        const unsigned old = xb_add(&bar[XB_XSUB(b.x)], 1u);
        const unsigned gen = old / nloc;
        if (old + 1u == (gen + 1u) * nloc) {
            __builtin_amdgcn_fence(__ATOMIC_RELEASE, "agent");
            asm volatile("s_waitcnt vmcnt(0)" ::: "memory");
            const unsigned og = xb_add(&bar[XB_TOP], 1u);
            const unsigned tg = og / nx;
            if (og + 1u == (tg + 1u) * nx) xb_add(&bar[XB_TOPGEN], 1u);
            else XB_SPIN(xb_ld(&bar[XB_TOPGEN]) == tg, bar);
            __builtin_amdgcn_fence(__ATOMIC_ACQUIRE, "agent");
            xb_add(&bar[XB_XGEN(b.x)], 1u);
            asm volatile("s_waitcnt vmcnt(0)" ::: "memory");
        } else {
            XB_SPIN(xb_ld(&bar[XB_XGEN(b.x)]) == gen, bar);
            __builtin_amdgcn_fence(__ATOMIC_ACQUIRE, "agent");
            asm volatile("s_waitcnt vmcnt(0)" ::: "memory");
        }
    }
    __syncthreads();
}

__global__ void __launch_bounds__(512, 2) fwd_megakernel(Params p) {
    extern __shared__ __attribute__((aligned(16))) unsigned char lds_raw[];
    LAS unsigned char* lds = (LAS unsigned char*)lds_raw;
    cg::grid_group grid = cg::this_grid();
    const int G = gridDim.x, bx = blockIdx.x;
    volatile LAS unsigned* bst = (volatile LAS unsigned*)(lds + LDS_ST_OFF);
    if (threadIdx.x < 2) bst[threadIdx.x] = 0u;
    __syncthreads();
    const XcdBarrier xbar = xcd_barrier_post((unsigned*)(p.ws + WS_BAR), bst);
    if (threadIdx.x == 0) bst[2] = xb_add((unsigned*)(p.ws + WS_BAR) + 3712 + xbar.x, 1u);
#define GRID_BAR() xcd_barrier(xbar)
    unsigned char* ws = p.ws;
    float* MOD = (float*)(ws + WS_MOD); bf16_t* H = (bf16_t*)(ws + WS_H);

    phase_prep(p, lds);
    grid.sync();
    { pg8::Gemm g{(const bf16_t*)(ws + WS_SC), (const bf16_t*)(ws + WS_WADA), 256, 6144, 1024}; pg8::StaticOrder S; S.init(256, 6144, G, bx);
      EpiMod E{MOD, p.b_ada}; pg8::gemm_phase<EpiMod, pg8::StaticOrder, true, true>(lds, g, S, E); }
    GRID_BAR();
    int cv = bx;
    { unsigned* barw = (unsigned*)(p.ws + WS_BAR); bool uni = (G & 7) == 0;
#pragma unroll
      for (int j = 0; j < 16; ++j) { const unsigned c = xb_ld(&barw[XB_XCNT(j)]); uni = uni && (j < 8 ? c == (unsigned)(G >> 3) : c == 0u); }
      if (uni) cv = (int)xbar.x + 8 * (int)bst[2];
      cv = __builtin_amdgcn_readfirstlane(cv); }
    phase_norm_mod(p.x_prompt, p.x_sample, p.norm_mix, MOD, 0, 1024, H);
#if PROBE_DUP == 1
    GRID_BAR(); phase_norm_mod(p.x_prompt, p.x_sample, p.norm_mix, MOD, 0, 1024, H);
#endif
#if PROBE_DUP == 10
    GRID_BAR(); GRID_BAR(); GRID_BAR(); GRID_BAR(); GRID_BAR(); GRID_BAR(); GRID_BAR(); GRID_BAR(); GRID_BAR(); GRID_BAR();
#endif
    GRID_BAR();
    { pg8::Gemm g{H, (const bf16_t*)(ws + WS_WIN), T, INC, 1024}; pg8::StaticOrder S; S.init(T, INC, G, cv);
      EpiIn E{(bf16_t*)(ws + WS_QOB), (bf16_t*)(ws + WS_KA), (bf16_t*)(ws + WS_VA), (bf16_t*)(ws + WS_GA), (bf16_t*)(ws + WS_KB), (bf16_t*)(ws + WS_VB),
              (bf16_t*)(p.out), (bf16_t*)(p.out) + (size_t)T * 1024, (float*)(ws + WS_CUM), (float*)(ws + WS_DEC), p.lb_logits, p.out};
      pg8::gemm_phase<EpiIn, pg8::StaticOrder, true, true>(lds, g, S, E);
#if PROBE_DUP == 2
      GRID_BAR(); pg8::gemm_phase<EpiIn, pg8::StaticOrder, true, true>(lds, g, S, E);
#endif
    }
    GRID_BAR();
    { const int tid = fresh_tid(), lane = tid & 63, wave = __builtin_amdgcn_readfirstlane(tid >> 6);
      for (int it = wave * G + bx; it < NCH * 16; it += 8 * G) hgrn_u_item(p, it, lane);
#if PROBE_DUP == 3
      for (int it = wave * G + bx; it < NCH * 16; it += 8 * G) hgrn_u_item(p, it, lane);
#endif
    }
    GRID_BAR();
    {
        const int tid = fresh_tid(), lane = tid & 63, wave = __builtin_amdgcn_readfirstlane(tid >> 6);
        LAS float* biasl = (LAS float*)lds;
        for (int i = tid; i < 8 * 192; i += 512) biasl[i] = p.rel_bias[i] * LOG2E;
        __syncthreads();
#if PROBE_DUP == 41
        if (wave == 0) { for (int it = bx; it < 256; it += G) scan_prompt_item(p, it, lane); }
        GRID_BAR();
#endif
        if (wave == 0) { for (int it = bx; it < 256; it += G) scan_prompt_item(p, it, lane); }
        else {
            const int gw = (wave - 1) * G + bx, NGW = 7 * G;
            for (int it = gw; it < 4096; it += NGW) scan_sample_item(p, it, lane);
            const int x = (int)xbar.x, ncu = (int)bst[0], nxcc = (int)bst[1], j = (int)bst[2];
            if (nxcc == 8 && x < 8 && ncu > 0 && j < ncu) {
                const int nslot = 7 * ncu, slot = (wave - 1) * ncu + j;
                for (int idx = slot; idx < 68 * 8; idx += nslot) { const int cc = idx >> 3, c = cc < 4 ? 512 + 4 * x + cc : 64 * x + (cc - 4); attn_item(p, c * 8 + (idx & 7), lane, biasl); }
            } else for (int it = gw; it < NCH * 8; it += NGW) attn_item(p, it, lane, biasl);
        }
    }
    GRID_BAR();
    { const int tid = fresh_tid(), lane = tid & 63, wave = __builtin_amdgcn_readfirstlane(tid >> 6);
#if PROBE_DUP == 5
      for (int it = wave * G + bx; it < NCH * 8; it += 8 * G) hgrn_out_item(p, it, lane, (bf16_t*)(ws + WS_U));
      GRID_BAR();
#endif
      for (int it = wave * G + bx; it < NCH * 8; it += 8 * G) hgrn_out_item(p, it, lane); }
    GRID_BAR();
    { pg8::Gemm g{(const bf16_t*)(ws + WS_QOB), (const bf16_t*)(ws + WS_WAB), T, 1024, 1024}; pg8::StaticOrder S; S.init(T, 1024, G, cv);
      EpiMerge E{(const bf16_t*)(p.out), (const bf16_t*)(p.out) + (size_t)T * 1024, (bf16_t*)(ws + WS_M)};
      pg8::gemm_phase<EpiMerge, pg8::StaticOrder, true, true>(lds, g, S, E); }
    GRID_BAR();
    const bool split_ps = G >= 64;
    { pg8::Gemm g{(const bf16_t*)(ws + WS_M), (const bf16_t*)(ws + WS_WO), T, 1024, 1024}; EpiRes<false> E{p.x_prompt, p.x_sample, nullptr, (bf16_t*)(ws + WS_X1B), MOD + 2048};
      if (split_ps) {
        { pg8::StaticOrder S; S.init(TP, 1024, G, cv); pg8::gemm_phase<EpiRes<false>, pg8::StaticOrder, true, true>(lds, g, S, E); }
        GRID_BAR();
        if (bx < 32) { pg8::StaticOrder S; S.init(TS, 1024, 32, bx, TP / 256); pg8::gemm_phase<EpiRes<false>, pg8::StaticOrder, true, true>(lds, g, S, E); }
        else phase_norm_mod_b((const bf16_t*)(ws + WS_X1B), p.norm_ffn, MOD, 3072, 4096, H, 0, TP, 32);
        GRID_BAR();
        phase_norm_mod_b((const bf16_t*)(ws + WS_X1B), p.norm_ffn, MOD, 3072, 4096, H, TP, T, 0);
      } else {
        pg8::StaticOrder S; S.init(T, 1024, G, cv); pg8::gemm_phase<EpiRes<false>, pg8::StaticOrder, true, true>(lds, g, S, E);
        GRID_BAR();
        phase_norm_mod_b((const bf16_t*)(ws + WS_X1B), p.norm_ffn, MOD, 3072, 4096, H);
      } }
    GRID_BAR();
    { pg8::Gemm g{H, (const bf16_t*)(ws + WS_WFI), T, INC, 1024}; pg8::StaticOrder S; S.init(T, INC, G, cv);
      EpiFfnIn E{(bf16_t*)(ws + WS_HID)}; pg8::gemm_phase<EpiFfnIn, pg8::StaticOrder, true, true>(lds, g, S, E);
#if PROBE_DUP == 9
      GRID_BAR(); pg8::gemm_phase<EpiFfnIn, pg8::StaticOrder, true, true>(lds, g, S, E);
#endif
    }
    GRID_BAR();
    { pg8::Gemm g{(const bf16_t*)(ws + WS_HID), (const bf16_t*)(ws + WS_WFO), T, 1024, FF}; EpiRes<true> E{nullptr, nullptr, (const bf16_t*)(ws + WS_X1B), (bf16_t*)(ws + WS_X2B), MOD + 5120};
      if (split_ps) {
        { pg8::StaticOrder S; S.init(TP, 1024, G, cv); pg8::gemm_phase<EpiRes<true>, pg8::StaticOrder, true, true>(lds, g, S, E); }
        GRID_BAR();
        float* PART = (float*)(ws + WS_CUM + 20 * MiB);
        if (bx < 64) { const int ks = bx >> 5; pg8::Gemm gs{(const bf16_t*)(ws + WS_HID) + ks * (FF / 2), (const bf16_t*)(ws + WS_WFO) + ks * (FF / 2), T, 1024, FF / 2, FF};
            pg8::StaticOrder S; S.init(TS, 1024, 32, bx & 31, TP / 256); EpiPart EP{PART + (size_t)ks * TS * D, TP}; pg8::gemm_phase<EpiPart, pg8::StaticOrder, true, true>(lds, gs, S, EP); }
        else phase_final_norm((const bf16_t*)(ws + WS_X2B), p.out, p.norm_final, 0, TP, 64);
        GRID_BAR();
        phase_final_norm_parts((const bf16_t*)(ws + WS_X1B), PART, PART + (size_t)TS * D, MOD + 5120, p.out, p.norm_final);
      } else {
        pg8::StaticOrder S; S.init(T, 1024, G, cv); pg8::gemm_phase<EpiRes<true>, pg8::StaticOrder, true, true>(lds, g, S, E);
        GRID_BAR();
        phase_final_norm((const bf16_t*)(ws + WS_X2B), p.out, p.norm_final);
      } }
}

extern "C" void kernel_launch(void* const* d_in, const int* in_sizes, int n_in, void* d_out, int out_size, void* d_ws, size_t ws_size, hipStream_t stream) {
    static int grid = 0;
    if (grid == 0) {
        if (n_in != 21 || (size_t)out_size != OUT_TOTAL || ws_size < WS_END) { fprintf(stderr, "kernel_launch: unexpected sizes n_in %d out %d ws %zu\n", n_in, out_size, ws_size); grid = -1; return; }
        int dev = 0, cus = 0, per = 0;
        (void)hipGetDevice(&dev); (void)hipDeviceGetAttribute(&cus, hipDeviceAttributeMultiprocessorCount, dev);
        (void)hipFuncSetAttribute((const void*)fwd_megakernel, hipFuncAttributeMaxDynamicSharedMemorySize, LDS_BYTES);
        (void)hipOccupancyMaxActiveBlocksPerMultiprocessor(&per, (const void*)fwd_megakernel, 512, LDS_BYTES);
        if (per < 1) per = 1;
        grid = cus * per; fprintf(stderr, "kernel_launch: grid %d (cus %d x %d)\n", grid, cus, per);
    }
    if (grid < 0) return;
    if (hipMemsetAsync((char*)d_ws + WS_BAR, 0, BAR_BYTES, stream) != hipSuccess) { fprintf(stderr, "kernel_launch: memset failed\n"); return; }
    Params p{};
    const float** f = (const float**)&p;
    for (int i = 0; i < 21; ++i) f[i] = (const float*)d_in[i];
    p.out = (float*)d_out; p.ws = (unsigned char*)d_ws;
    void* args[] = {&p};
    hipError_t e = hipLaunchCooperativeKernel((const void*)fwd_megakernel, dim3(grid), dim3(512), args, LDS_BYTES, stream);
    if (e != hipSuccess) fprintf(stderr, "cooperative launch failed: %s (grid %d)\n", hipGetErrorString(e), grid);
}
```

```cpp
#include <hip/hip_runtime.h>
#include <hip/hip_cooperative_groups.h>
#include <cstdio>
#include <cstdint>
namespace cg = cooperative_groups;
#ifndef PROBE_DUP
#define PROBE_DUP 0
#endif

#define DI __device__ __forceinline__
#define LAS __attribute__((address_space(3)))
typedef unsigned short bf16_t;
typedef short bf16x8 __attribute__((ext_vector_type(8)));
typedef float f32x4 __attribute__((ext_vector_type(4)));
typedef float f32x2 __attribute__((ext_vector_type(2)));
typedef float f32x16 __attribute__((ext_vector_type(16)));
typedef unsigned u32x4 __attribute__((ext_vector_type(4)));
typedef unsigned u32x2 __attribute__((ext_vector_type(2)));
typedef __bf16 bf2_t __attribute__((ext_vector_type(2)));

constexpr int D = 1024, TP = 32768, TS = 2048, T = TP + TS, NCH = T / 64, NBATCH = 34;
constexpr int INC = 5632, FF = 2816;
constexpr float EPS = 1e-6f, LOG2E = 1.4426950408889634f;
constexpr size_t OFF_Y = 0, OFF_SP = (size_t)T * D, OFF_KP = OFF_SP + 131072, OFF_VP = OFF_KP + 524288, OFF_SS = OFF_VP + 524288,
                 OFF_KS = OFF_SS + 2097152, OFF_VS = OFF_KS + 1048576, OUT_TOTAL = OFF_VS + 1048576;
constexpr size_t MiB = 1u << 20;
constexpr size_t WS_MOD = 1 * MiB, WS_DEC = 2 * MiB, WS_SC = 4 * MiB, WS_WADA = 5 * MiB, WS_WIN = 17 * MiB, WS_WAB = 28 * MiB, WS_WO = 30 * MiB,
                 WS_WFI = 32 * MiB, WS_WFO = 43 * MiB, WS_H = 50 * MiB, WS_QOB = 118 * MiB, WS_KA = 186 * MiB, WS_VA = 220 * MiB, WS_GA = 254 * MiB,
                 WS_KB = 288 * MiB, WS_VB = 322 * MiB, WS_CUM = 356 * MiB, WS_SST = 424 * MiB, WS_END = 492 * MiB;
constexpr size_t WS_U = WS_H, WS_M = WS_KA, WS_HID = WS_KA, WS_X1B = WS_QOB, WS_X2B = WS_H;
constexpr size_t WS_BAR = 0, BAR_BYTES = 16384;
constexpr int LDS_BYTES = 140 * 1024, LDS_ST_OFF = 136 * 1024;

struct Params {
    const float *x_prompt, *x_sample, *c_prompt, *c_sample, *state, *cache_k, *cache_v, *w_ada, *b_ada, *norm_mix, *w_in, *lb_logits, *out_norm,
                *w_a, *rel_bias, *w_b, *w_out, *norm_ffn, *w_ffn_in, *w_ffn_out, *norm_final;
    float* out; unsigned char* ws;
};

DI int fresh_tid() { int t = threadIdx.x; asm volatile("" : "+v"(t)); return t; }
DI int launder(int v) { asm volatile("" : "+v"(v)); return v; }
DI unsigned pk2(float a, float b) { f32x2 v = {a, b}; bf2_t r = __builtin_convertvector(v, bf2_t); return __builtin_bit_cast(unsigned, r); }
DI float bflo(unsigned u) { return __uint_as_float(u << 16); }
DI float bfhi(unsigned u) { return __uint_as_float(u & 0xffff0000u); }
DI float bf2f(short s) { return __uint_as_float(((unsigned)(unsigned short)s) << 16); }
DI float sigm(float x) { return __builtin_amdgcn_rcpf(1.f + __expf(-x)); }
DI float silu(float x) { return x * sigm(x); }
DI int batch_of(int r) { return r < TP ? (r >> 14) : 2 + ((r - TP) >> 6); }
DI int crow(int reg, int h) { return (reg & 3) + 8 * (reg >> 2) + 4 * h; }
DI bf16x8 pack8(const f32x16& x, int s) {
    u32x4 p; p.x = pk2(x[8 * s], x[8 * s + 1]); p.y = pk2(x[8 * s + 2], x[8 * s + 3]); p.z = pk2(x[8 * s + 4], x[8 * s + 5]); p.w = pk2(x[8 * s + 6], x[8 * s + 7]);
    return __builtin_bit_cast(bf16x8, p);
}
DI bf16x8 pack8f(const float* v) { u32x4 p; p.x = pk2(v[0], v[1]); p.y = pk2(v[2], v[3]); p.z = pk2(v[4], v[5]); p.w = pk2(v[6], v[7]); return __builtin_bit_cast(bf16x8, p); }
DI bf16x8 ident_frag(int ks, int l31, int hf) {
    const int jj = l31 - 16 * ks - 8 * hf; bf16x8 r;
#pragma unroll
    for (int j = 0; j < 8; ++j) r[j] = (j == jj) ? (short)0x3F80 : (short)0;
    return r;
}
DI u32x4 widen_pair(u32x2 pg, u32x2 pg1) { const auto rx = __builtin_amdgcn_permlane32_swap(pg.x, pg1.x, false, false), ry = __builtin_amdgcn_permlane32_swap(pg.y, pg1.y, false, false); return (u32x4){rx[0], ry[0], rx[1], ry[1]}; }
DI void narrow_pair(u32x4 d, u32x2& pg, u32x2& pg1) { const auto rx = __builtin_amdgcn_permlane32_swap(d.x, d.z, false, false), ry = __builtin_amdgcn_permlane32_swap(d.y, d.w, false, false); pg = (u32x2){rx[0], ry[0]}; pg1 = (u32x2){rx[1], ry[1]}; }
#define MFMA32(a, b, c) __builtin_amdgcn_mfma_f32_32x32x16_bf16((a), (b), (c), 0, 0, 0)
DI f32x16 zero16() { f32x16 z;
#pragma unroll
    for (int i = 0; i < 16; ++i) z[i] = 0.f; return z; }

namespace pg8 {
constexpr int BM = 256, BK = 64, HALF = 128, HTB = HALF * BK * 2, STAGE_BYTES = 8 * HTB, NXCD = 8, WGM = 8;
__host__ __device__ __forceinline__ int lds_byte(int r, int c) { const int st = (r >> 4) * 2 + (c >> 5), rr = r & 15, cc = c & 31, ob = rr * 64 + cc * 2; return st * 1024 + (ob ^ (((ob >> 9) & 1) << 5)); }
__host__ __device__ __forceinline__ void stage_rc(int b, int& R, int& C) { const int st = b / 1024, sb = b % 1024, swz = sb ^ (((sb >> 9) & 1) << 5); R = (st >> 1) * 16 + swz / 64; C = (st & 1) * 32 + (swz % 64) / 2; }
__host__ __device__ __forceinline__ int perm32(int rho) { const int n = rho >> 4, i = rho & 15; return 8 * (i >> 2) + 4 * n + (i & 3); }
struct Unit { int pm, pn; };
struct Gemm { const bf16_t* A; const bf16_t* Bt; int M, N, K, ld; };
struct StaticOrder {
    int nM, nN, nwg, G, c, pm_off;
    __device__ void init(int M, int N, int G_, int c_, int pm_off_ = 0) { nM = M / BM; nN = N / BM; nwg = nM * nN; G = G_; c = c_; pm_off = pm_off_; }
    __device__ bool next(int i, Unit& u) const {
        const long L = (long)i * G + c; if (L >= nwg) return false;
        int wgid = (int)L; { const int q = nwg / NXCD, r = nwg % NXCD, xcd = wgid % NXCD, off = wgid / NXCD; wgid = (xcd < r ? xcd * (q + 1) : r * (q + 1) + (xcd - r) * q) + off; }
        const int nig = WGM * nN, gid = wgid / nig, fm = gid * WGM, gsz = (nM - fm) < WGM ? (nM - fm) : WGM;
        u.pm = pm_off + fm + ((wgid % nig) % gsz); u.pn = (wgid % nig) / gsz; return true;
    }
};
template <class Epi, class Sched, bool ALIGN_EPI = false, bool SP2 = false>
__device__ __forceinline__ void gemm_phase(LAS unsigned char* lds, const Gemm g, const Sched& S, const Epi& E) {
    const int tid = fresh_tid(), wid = __builtin_amdgcn_readfirstlane(tid >> 6), lane = tid & 63, wr = wid >> 2, wc = wid & 3, fr = lane & 15, fq = lane >> 4;
    const int K = g.ld ? g.ld : g.K, nt = g.K / BK;
    unsigned voffA[2], voffB[2];
#pragma unroll
    for (int i = 0; i < 2; ++i) { int R, C; stage_rc(tid * 16 + i * 8192, R, C); const int Rb = Epi::PERM ? ((R & ~31) + perm32(R & 31)) : R;
        voffA[i] = (unsigned)(R * K + C) * 2u; voffB[i] = (unsigned)(Rb * K + C) * 2u; }
    const size_t kstep = (size_t)(BK * 2);
    const size_t hstep = (size_t)HALF * K * 2;
    const size_t tstep = 2 * hstep;
    const unsigned ldsw = (unsigned)wid * 1024u;
    const int aoff = lds_byte(wr * 64 + fr, fq * 8), boff = lds_byte(wc * 32 + fr, fq * 8);
#define PG8_SA(b, h) (((b) * 2 + (h)) * HTB)
#define PG8_SB(b, h) ((4 + (b) * 2 + (h)) * HTB)
#define PG8_STAGE(bufoff, gbase, voff) do { _Pragma("unroll") for (int _i = 0; _i < 2; ++_i) \
        __builtin_amdgcn_global_load_lds((const unsigned*)((const char*)(gbase) + (voff)[_i]), (LAS unsigned*)(lds + (bufoff) + ldsw + _i * 8192), 16, 0, 0); } while (0)
#define PG8_LDA(dst, b, h) do { _Pragma("unroll") for (int m = 0; m < 4; ++m) _Pragma("unroll") for (int k = 0; k < 2; ++k) dst[m][k] = *(const LAS bf16x8*)(lds + PG8_SA(b, h) + aoff + m * 2048 + k * 1024); } while (0)
#define PG8_LDB(dst, b, h) do { _Pragma("unroll") for (int n = 0; n < 2; ++n) _Pragma("unroll") for (int k = 0; k < 2; ++k) dst[n][k] = *(const LAS bf16x8*)(lds + PG8_SB(b, h) + boff + n * 2048 + k * 1024); } while (0)
#define PG8_MMA(ai, bj, At, Bt) do { __builtin_amdgcn_s_setprio(1); _Pragma("unroll") for (int m = 0; m < 4; ++m) _Pragma("unroll") for (int n = 0; n < 2; ++n) _Pragma("unroll") for (int k = 0; k < 2; ++k) \
        acc[ai][bj][m][n] = __builtin_amdgcn_mfma_f32_16x16x32_bf16(Bt[n][k], At[m][k], acc[ai][bj][m][n], 0, 0, 0); __builtin_amdgcn_s_setprio(0); } while (0)
#define PG8_WAIT_V(n) asm volatile("s_waitcnt vmcnt(" #n ")" ::: "memory")
#define PG8_WAIT_L(n) asm volatile("s_waitcnt lgkmcnt(" #n ")" ::: "memory")
#define PG8_BAR __builtin_amdgcn_s_barrier()
#define PG8_SCHED __builtin_amdgcn_sched_barrier(0)
    Unit cur, nxt; int ui = 0;
    if (!S.next(0, cur)) return;
    f32x4 acc[2][2][4][2];
#pragma unroll
    for (int a = 0; a < 2; ++a)
#pragma unroll
        for (int b = 0; b < 2; ++b)
#pragma unroll
            for (int m = 0; m < 4; ++m)
#pragma unroll
                for (int n = 0; n < 2; ++n) acc[a][b][m][n] = (f32x4){0.f, 0.f, 0.f, 0.f};
    bf16x8 At[4][2], B0[2][2], B1[2][2];
    const char* cA = (const char*)g.A + (size_t)cur.pm * tstep; const char* cB = (const char*)g.Bt + (size_t)cur.pn * tstep;
    if constexpr (SP2) {
        PG8_STAGE(PG8_SB(0, 0), cB, voffB); PG8_STAGE(PG8_SB(0, 1), cB + hstep, voffB); PG8_STAGE(PG8_SA(0, 0), cA, voffA); PG8_STAGE(PG8_SA(0, 1), cA + hstep, voffA);
        if (wr == 1) PG8_BAR;
        PG8_WAIT_V(2); PG8_BAR;
        PG8_STAGE(PG8_SB(1, 0), cB + kstep, voffB); PG8_STAGE(PG8_SA(1, 0), cA + kstep, voffA); PG8_STAGE(PG8_SB(1, 1), cB + hstep + kstep, voffB);
        PG8_WAIT_V(6); PG8_BAR;
    } else {
        PG8_STAGE(PG8_SB(0, 0), cB, voffB); PG8_STAGE(PG8_SA(0, 0), cA, voffA); PG8_STAGE(PG8_SB(0, 1), cB + hstep, voffB); PG8_STAGE(PG8_SA(0, 1), cA + hstep, voffA);
        if (wr == 1) PG8_BAR;
        PG8_WAIT_V(4); PG8_BAR;
        PG8_STAGE(PG8_SB(1, 0), cB + kstep, voffB); PG8_STAGE(PG8_SA(1, 0), cA + kstep, voffA); PG8_STAGE(PG8_SB(1, 1), cB + hstep + kstep, voffB);
        PG8_WAIT_V(6); PG8_BAR;
    }
    for (;;) {
        const bool has_next = S.next(ui + 1, nxt);
        const char* nA = has_next ? (const char*)g.A + (size_t)nxt.pm * tstep : cA; const char* nB = has_next ? (const char*)g.Bt + (size_t)nxt.pn * tstep : cB;
        for (int t = 0; t < nt; t += 2) {
            if constexpr (Epi::MIDK) { if (t == nt / 2) E.mid(acc, cur, wr, wc, fr, fq); }
            const bool last = (t == nt - 2);
            const char* a1 = cA + (size_t)(t + 1) * kstep;
            const char* a2 = last ? nA : cA + (size_t)(t + 2) * kstep; const char* b2 = last ? nB : cB + (size_t)(t + 2) * kstep;
            const char* a3 = a2 + kstep; const char* b3 = b2 + kstep;
            if constexpr (SP2) {
            PG8_LDB(B0, 0, 0); PG8_LDB(B1, 0, 1); PG8_SCHED; PG8_LDA(At, 0, 0); PG8_STAGE(PG8_SA(1, 1), a1 + hstep, voffA);
            PG8_WAIT_V(8); PG8_WAIT_L(0); PG8_BAR; PG8_MMA(0, 0, At, B0); PG8_MMA(0, 1, At, B1); PG8_BAR; PG8_SCHED;
            PG8_LDA(At, 0, 1); PG8_STAGE(PG8_SB(0, 0), b2, voffB); PG8_STAGE(PG8_SB(0, 1), b2 + hstep, voffB); PG8_STAGE(PG8_SA(0, 0), a2, voffA);
            PG8_WAIT_V(8); PG8_WAIT_L(0); PG8_BAR; PG8_MMA(1, 0, At, B0); PG8_MMA(1, 1, At, B1); PG8_BAR; PG8_SCHED;
            PG8_LDB(B0, 1, 0); PG8_LDB(B1, 1, 1); PG8_SCHED; PG8_LDA(At, 1, 0); PG8_STAGE(PG8_SA(0, 1), a2 + hstep, voffA);
            PG8_WAIT_V(8); PG8_WAIT_L(0); PG8_BAR; PG8_MMA(0, 0, At, B0); PG8_MMA(0, 1, At, B1); PG8_BAR; PG8_SCHED;
            PG8_LDA(At, 1, 1); PG8_STAGE(PG8_SB(1, 0), b3, voffB); PG8_STAGE(PG8_SB(1, 1), b3 + hstep, voffB); PG8_STAGE(PG8_SA(1, 0), a3, voffA);
            PG8_WAIT_V(8); PG8_WAIT_L(0); PG8_BAR; PG8_MMA(1, 0, At, B0); PG8_MMA(1, 1, At, B1); PG8_BAR; PG8_SCHED;
            } else {
            PG8_LDB(B0, 0, 0); PG8_SCHED; PG8_LDA(At, 0, 0); PG8_STAGE(PG8_SA(1, 1), a1 + hstep, voffA);
            PG8_WAIT_L(8); PG8_BAR; PG8_WAIT_L(0); PG8_MMA(0, 0, At, B0); PG8_BAR; PG8_SCHED;
            PG8_LDB(B1, 0, 1); PG8_STAGE(PG8_SB(0, 0), b2, voffB);
            PG8_BAR; PG8_WAIT_L(0); PG8_MMA(0, 1, At, B1); PG8_BAR;
            PG8_LDA(At, 0, 1); PG8_STAGE(PG8_SA(0, 0), a2, voffA);
            PG8_BAR; PG8_WAIT_L(0); PG8_MMA(1, 0, At, B0); PG8_BAR; PG8_SCHED;
            PG8_STAGE(PG8_SB(0, 1), b2 + hstep, voffB);
            PG8_WAIT_V(6); PG8_BAR; PG8_MMA(1, 1, At, B1); PG8_BAR;
            PG8_LDB(B0, 1, 0); PG8_SCHED; PG8_LDA(At, 1, 0); PG8_STAGE(PG8_SA(0, 1), a2 + hstep, voffA);
            PG8_WAIT_L(8); PG8_BAR; PG8_WAIT_L(0); PG8_MMA(0, 0, At, B0); PG8_BAR; PG8_SCHED;
            PG8_LDB(B1, 1, 1); PG8_STAGE(PG8_SB(1, 0), b3, voffB);
            PG8_BAR; PG8_WAIT_L(0); PG8_MMA(0, 1, At, B1); PG8_BAR;
            PG8_LDA(At, 1, 1); PG8_STAGE(PG8_SA(1, 0), a3, voffA);
            PG8_BAR; PG8_WAIT_L(0); PG8_MMA(1, 0, At, B0); PG8_BAR; PG8_SCHED;
            PG8_STAGE(PG8_SB(1, 1), b3 + hstep, voffB);
            PG8_WAIT_V(6); PG8_BAR; PG8_MMA(1, 1, At, B1); PG8_BAR;
            }
        }
        if constexpr (ALIGN_EPI) { if (wr == 0) PG8_BAR; }
        E(acc, cur, wr, wc, fr, fq);
        if (!has_next) break;
#pragma unroll
        for (int a = 0; a < 2; ++a)
#pragma unroll
            for (int b = 0; b < 2; ++b)
#pragma unroll
                for (int m = 0; m < 4; ++m)
#pragma unroll
                    for (int n = 0; n < 2; ++n) acc[a][b][m][n] = (f32x4){0.f, 0.f, 0.f, 0.f};
        cur = nxt; cA = nA; cB = nB; ++ui;
        if constexpr (ALIGN_EPI) { if (wr == 1) PG8_BAR; }
    }
    PG8_WAIT_V(0);
    if constexpr (!ALIGN_EPI) { if (wr == 0) PG8_BAR; }
    PG8_BAR;
#undef PG8_SA
#undef PG8_SB
#undef PG8_STAGE
#undef PG8_LDA
#undef PG8_LDB
#undef PG8_MMA
#undef PG8_WAIT_V
#undef PG8_WAIT_L
#undef PG8_BAR
#undef PG8_SCHED
}
}
using pg8::Unit;
typedef f32x4 Acc[2][2][4][2];

DI u32x4 pack_row8(const f32x4& v0, const f32x4& v1) { u32x4 w; w.x = pk2(v0[0], v0[1]); w.y = pk2(v0[2], v0[3]); w.z = pk2(v1[0], v1[1]); w.w = pk2(v1[2], v1[3]); return w; }

struct EpiMod {
    static constexpr bool PERM = false, MIDK = false;
    float* mod; const float* bias;
    DI void operator()(Acc& acc, const Unit& u, int wr, int wc, int fr, int fq) const {
        { const int t_ = fresh_tid(); fr = t_ & 15; fq = (t_ >> 4) & 3; }
        if (u.pm != 0 || wr != 0) return;
#pragma unroll
        for (int m = 0; m < 3; ++m) { const int r = 16 * m + fr; if (r < NBATCH) {
#pragma unroll
            for (int bj = 0; bj < 2; ++bj)
#pragma unroll
                for (int n = 0; n < 2; ++n) { const int col = u.pn * 256 + bj * 128 + wc * 32 + n * 16 + 4 * fq;
                    *(f32x4*)(mod + (size_t)r * 6144 + col) = acc[0][bj][m][n] + *(const f32x4*)(bias + col); } } }
    }
};

struct EpiIn {
    static constexpr bool PERM = true, MIDK = false;
    bf16_t *QOB, *KA, *VA, *GA, *KB, *VB, *SGA, *SGB; float *CUM, *DEC; const float* lbl; float* out;
    DI void operator()(Acc& acc, const Unit& u, int wr, int wc, int fr, int fq) const {
        { const int t_ = fresh_tid(); fr = t_ & 15; fq = (t_ >> 4) & 3; }
        const int pn = u.pn, rt = wr * 64 + fr, row0 = u.pm * 256 + rt, cw = wc * 32 + 8 * fq, lane = fq * 16 + fr;
        if (pn >= 14) {
            const size_t o0 = ((size_t)(u.pm * 8 + (pn - 14)) * 8 * 512 + (size_t)(wr * 4 + wc) * 64 + lane) * 8;
#pragma unroll
            for (int ai = 0; ai < 2; ++ai)
#pragma unroll
                for (int m = 0; m < 4; ++m) { f32x4 r0, r1, b0, b1;
#pragma unroll
                    for (int j = 0; j < 4; ++j) { b0[j] = fmaxf(sigm(acc[ai][1][m][0][j]), 1e-30f); b1[j] = fmaxf(sigm(acc[ai][1][m][1][j]), 1e-30f);
                        r0[j] = sigm(acc[ai][0][m][0][j]) * __builtin_amdgcn_rcpf(b0[j]); r1[j] = sigm(acc[ai][0][m][1][j]) * __builtin_amdgcn_rcpf(b1[j]); }
                    const size_t o = o0 + (size_t)(ai * 4 + m) * 512 * 8;
                    *(u32x4*)(SGA + o) = pack_row8(r0, r1); *(u32x4*)(SGB + o) = pack_row8(b0, b1); __builtin_amdgcn_sched_barrier(0); }
            return;
        }
        const int seg = pn >> 1, col0 = (pn & 1) * 256 + cw;
        if (seg == 1) {
#pragma unroll
            for (int bj = 0; bj < 2; ++bj) {
                float lb[2][4];
#pragma unroll
                for (int n = 0; n < 2; ++n)
#pragma unroll
                    for (int j = 0; j < 4; ++j) { const int c = col0 + bj * 128 + 4 * n + j; lb[n][j] = __builtin_amdgcn_rcpf(1.f + __expf(lbl[512 + c] - lbl[c])); }
#pragma unroll
                for (int ai = 0; ai < 2; ++ai) {
                    const size_t rbase = ((size_t)((pn & 1) * 2 + bj) * T + (u.pm * 256 + ai * 128 + wr * 64 + launder(fr))) * 128 + cw;
#pragma unroll
                    for (int m = 0; m < 4; ++m) { f32x4 k0, k1;
#pragma unroll
                        for (int j = 0; j < 4; ++j) {
                            float f = lb[0][j] + (1.f - lb[0][j]) * sigm(acc[ai][bj][m][0][j]); k0[j] = 1.f - f; acc[ai][bj][m][0][j] = __logf(f);
                            f = lb[1][j] + (1.f - lb[1][j]) * sigm(acc[ai][bj][m][1][j]); k1[j] = 1.f - f; acc[ai][bj][m][1][j] = __logf(f); }
                        *(u32x4*)(KA + rbase + (size_t)m * 16 * 128) = pack_row8(k0, k1); }
                    __builtin_amdgcn_sched_barrier(0);
#pragma unroll
                    for (int n = 0; n < 2; ++n)
#pragma unroll
                        for (int j = 0; j < 4; ++j) { float carry = 0.f;
#pragma unroll
                            for (int m = 0; m < 4; ++m) { float v = acc[ai][bj][m][n][j];
                                v += __int_as_float(__builtin_amdgcn_update_dpp(0, __float_as_int(v), 0x111, 0xf, 0xf, false));
                                v += __int_as_float(__builtin_amdgcn_update_dpp(0, __float_as_int(v), 0x112, 0xf, 0xf, false));
                                v += __int_as_float(__builtin_amdgcn_update_dpp(0, __float_as_int(v), 0x114, 0xf, 0xf, false));
                                v += __int_as_float(__builtin_amdgcn_update_dpp(0, __float_as_int(v), 0x118, 0xf, 0xf, false));
                                v += carry; carry = __shfl(v, lane | 15); acc[ai][bj][m][n][j] = v; } }
                    __builtin_amdgcn_sched_barrier(0);
#pragma unroll
                    for (int m = 0; m < 4; ++m) { float* cp = CUM + rbase + (size_t)m * 16 * 128; *(f32x4*)cp = acc[ai][bj][m][0]; *(f32x4*)(cp + 4) = acc[ai][bj][m][1]; }
                    if (fr == 15) {
#pragma unroll
                        for (int n = 0; n < 2; ++n) { f32x4 e;
#pragma unroll
                            for (int j = 0; j < 4; ++j) e[j] = __expf(acc[ai][bj][3][n][j]);
                            *(f32x4*)(DEC + (size_t)(u.pm * 4 + ai * 2 + wr) * 512 + col0 + bj * 128 + 4 * n) = e; } }
                    __builtin_amdgcn_sched_barrier(0);
                }
            }
            return;
        }
        bf16_t* dst; int pitch = 512; size_t bjoff = 128; float* o32 = nullptr;
        switch (seg) {
            case 0: dst = QOB + col0; pitch = 1024; break;
            case 2: dst = VA + (size_t)((pn & 1) * 2) * T * 128 + cw; pitch = 128; bjoff = (size_t)T * 128; break;
            case 3: dst = GA + (size_t)((pn & 1) * 2) * T * 128 + cw; pitch = 128; bjoff = (size_t)T * 128; break;
            case 4: dst = QOB + 512 + col0; pitch = 1024; break;
            default: dst = (seg == 5 ? KB : VB) + (size_t)((pn & 1) * 4 + (wc >> 1)) * T * 64 + (wc & 1) * 32 + 8 * fq; pitch = 64; bjoff = (size_t)2 * T * 64; break;
        }
        if (seg >= 5) {
            if (u.pm >= 128) o32 = out + (seg == 5 ? OFF_KS : OFF_VS) + (size_t)((u.pm - 128) * 256 + rt) * 512 + col0;
            else if ((u.pm & 63) >= 62) o32 = out + (seg == 5 ? OFF_KP : OFF_VP) + (size_t)((u.pm >> 6) * 512 + ((u.pm & 63) - 62) * 256 + rt) * 512 + col0;
        }
        const bool act = (seg == 0 || seg == 3);
#pragma unroll
        for (int ai = 0; ai < 2; ++ai)
#pragma unroll
            for (int m = 0; m < 4; ++m)
#pragma unroll
                for (int bj = 0; bj < 2; ++bj) { f32x4 v0 = acc[ai][bj][m][0], v1 = acc[ai][bj][m][1];
                    if (act) {
#pragma unroll
                        for (int j = 0; j < 4; ++j) { v0[j] = silu(v0[j]); v1[j] = silu(v1[j]); } }
                    *(u32x4*)(dst + (size_t)(row0 + ai * 128 + m * 16) * pitch + bj * bjoff) = pack_row8(v0, v1);
                    if (o32) { float* op = o32 + (size_t)(ai * 128 + m * 16) * 512 + bj * 128; *(f32x4*)op = v0; *(f32x4*)(op + 4) = v1; } __builtin_amdgcn_sched_barrier(0); }
    }
};

struct EpiMerge {
    static constexpr bool PERM = true, MIDK = true;
    const bf16_t *SGR, *SGB; bf16_t* Mo;
    DI void mid(Acc& acc, const Unit& u, int wr, int wc, int fr, int fq) const {
        { const int t_ = fresh_tid(); fr = t_ & 15; fq = (t_ >> 4) & 3; }
        const size_t gb = ((size_t)(u.pm * 8 + 2 * u.pn) * 8 * 512 + (size_t)(wr * 4 + wc) * 64 + (fq * 16 + fr)) * 8;
#pragma unroll
        for (int ai = 0; ai < 2; ++ai) { u32x4 a[4][2];
#pragma unroll
            for (int m = 0; m < 4; ++m)
#pragma unroll
                for (int bj = 0; bj < 2; ++bj) a[m][bj] = *(const u32x4*)(SGR + gb + ((size_t)bj * 8 + ai * 4 + m) * 512 * 8);
#pragma unroll
            for (int m = 0; m < 4; ++m)
#pragma unroll
                for (int bj = 0; bj < 2; ++bj)
#pragma unroll
                    for (int j = 0; j < 4; ++j) { acc[ai][bj][m][j >> 1][(j & 1) * 2] *= bflo(a[m][bj][j]); acc[ai][bj][m][j >> 1][(j & 1) * 2 + 1] *= bfhi(a[m][bj][j]); }
            __builtin_amdgcn_sched_barrier(0); }
    }
    DI void operator()(Acc& acc, const Unit& u, int wr, int wc, int fr, int fq) const {
        { const int t_ = fresh_tid(); fr = t_ & 15; fq = (t_ >> 4) & 3; }
        const size_t base = (size_t)(u.pm * 256 + wr * 64 + fr) * 1024 + u.pn * 256 + wc * 32 + 8 * fq;
        const size_t gb = ((size_t)(u.pm * 8 + 2 * u.pn) * 8 * 512 + (size_t)(wr * 4 + wc) * 64 + (fq * 16 + fr)) * 8;
#pragma unroll
        for (int ai = 0; ai < 2; ++ai) { u32x4 b[4][2];
#pragma unroll
            for (int m = 0; m < 4; ++m)
#pragma unroll
                for (int bj = 0; bj < 2; ++bj) b[m][bj] = *(const u32x4*)(SGB + gb + ((size_t)bj * 8 + ai * 4 + m) * 512 * 8);
#pragma unroll
            for (int m = 0; m < 4; ++m)
#pragma unroll
                for (int bj = 0; bj < 2; ++bj) { f32x4 v0 = acc[ai][bj][m][0], v1 = acc[ai][bj][m][1]; const u32x4 g = b[m][bj];
                    v0[0] *= bflo(g[0]); v0[1] *= bfhi(g[0]); v0[2] *= bflo(g[1]); v0[3] *= bfhi(g[1]);
                    v1[0] *= bflo(g[2]); v1[1] *= bfhi(g[2]); v1[2] *= bflo(g[3]); v1[3] *= bfhi(g[3]);
                    *(u32x4*)(Mo + base + (size_t)(ai * 128 + m * 16) * 1024 + bj * 128) = pack_row8(v0, v1); }
            __builtin_amdgcn_sched_barrier(0); }
    }
};

template <bool BASE_BF16> struct EpiRes {
    static constexpr bool PERM = true, MIDK = false;
    const float *xp, *xs; const bf16_t* xb; bf16_t* xo; const float* gmod;
    DI void operator()(Acc& acc, const Unit& u, int wr, int wc, int fr, int fq) const {
        { const int t_ = fresh_tid(); fr = t_ & 15; fq = (t_ >> 4) & 3; }
        const int colb = u.pn * 256 + wc * 32 + 8 * fq;
#pragma unroll
        for (int ai = 0; ai < 2; ++ai) { const int r0 = u.pm * 256 + ai * 128 + wr * 64 + fr;
            const float* g = gmod + (size_t)batch_of(r0) * 6144 + colb;
            f32x4 gv[2][2];
#pragma unroll
            for (int bj = 0; bj < 2; ++bj) { gv[bj][0] = *(const f32x4*)(g + bj * 128); gv[bj][1] = *(const f32x4*)(g + bj * 128 + 4); }
            bf16_t* orow = xo + (size_t)r0 * D + colb;
            if constexpr (BASE_BF16) {
                const bf16_t* xr = xb + (size_t)r0 * D + colb; u32x4 xv[4][2];
#pragma unroll
                for (int m = 0; m < 4; ++m)
#pragma unroll
                    for (int bj = 0; bj < 2; ++bj) xv[m][bj] = *(const u32x4*)(xr + (size_t)m * 16 * D + bj * 128);
#pragma unroll
                for (int m = 0; m < 4; ++m)
#pragma unroll
                    for (int bj = 0; bj < 2; ++bj) { const u32x4 x = xv[m][bj]; const f32x4 a0 = acc[ai][bj][m][0] * gv[bj][0], a1 = acc[ai][bj][m][1] * gv[bj][1];
                        f32x4 v0 = {bflo(x[0]) + a0[0], bfhi(x[0]) + a0[1], bflo(x[1]) + a0[2], bfhi(x[1]) + a0[3]}, v1 = {bflo(x[2]) + a1[0], bfhi(x[2]) + a1[1], bflo(x[3]) + a1[2], bfhi(x[3]) + a1[3]};
                        *(u32x4*)(orow + (size_t)m * 16 * D + bj * 128) = pack_row8(v0, v1); }
            } else {
                const float* xr = (r0 < TP ? xp + (size_t)r0 * D : xs + (size_t)(r0 - TP) * D) + colb; f32x4 xv[4][2][2];
#pragma unroll
                for (int m = 0; m < 4; ++m)
#pragma unroll
                    for (int bj = 0; bj < 2; ++bj) { xv[m][bj][0] = *(const f32x4*)(xr + (size_t)m * 16 * D + bj * 128); xv[m][bj][1] = *(const f32x4*)(xr + (size_t)m * 16 * D + bj * 128 + 4); }
#pragma unroll
                for (int m = 0; m < 4; ++m)
#pragma unroll
                    for (int bj = 0; bj < 2; ++bj) *(u32x4*)(orow + (size_t)m * 16 * D + bj * 128) = pack_row8(xv[m][bj][0] + gv[bj][0] * acc[ai][bj][m][0], xv[m][bj][1] + gv[bj][1] * acc[ai][bj][m][1]);
            }
            __builtin_amdgcn_sched_barrier(0); }
    }
};

struct EpiPart {
    static constexpr bool PERM = false, MIDK = false;
    float* part; int row0;
    DI void operator()(Acc& acc, const Unit& u, int wr, int wc, int fr, int fq) const {
        { const int t_ = fresh_tid(); fr = t_ & 15; fq = (t_ >> 4) & 3; }
#pragma unroll
        for (int ai = 0; ai < 2; ++ai)
#pragma unroll
            for (int m = 0; m < 4; ++m) { float* prow = part + (size_t)(u.pm * 256 + ai * 128 + wr * 64 + m * 16 + fr - row0) * D + u.pn * 256 + wc * 32 + 4 * fq;
#pragma unroll
                for (int bj = 0; bj < 2; ++bj)
#pragma unroll
                    for (int n = 0; n < 2; ++n) *(f32x4*)(prow + bj * 128 + n * 16) = acc[ai][bj][m][n];
                __builtin_amdgcn_sched_barrier(0); }
    }
};

struct EpiFfnIn {
    static constexpr bool PERM = true, MIDK = false;
    bf16_t* HID;
    DI void operator()(Acc& acc, const Unit& u, int wr, int wc, int fr, int fq) const {
        { const int t_ = fresh_tid(); fr = t_ & 15; fq = (t_ >> 4) & 3; }
        bf16_t* base = HID + (size_t)(u.pm * 256 + wr * 64 + fr) * FF + u.pn * 128 + wc * 32 + 8 * fq;
#pragma unroll
        for (int ai = 0; ai < 2; ++ai)
#pragma unroll
            for (int m = 0; m < 4; ++m) { f32x4 v0, v1;
#pragma unroll
                for (int j = 0; j < 4; ++j) { v0[j] = silu(acc[ai][0][m][0][j]) * acc[ai][1][m][0][j]; v1[j] = silu(acc[ai][0][m][1][j]) * acc[ai][1][m][1][j]; }
                *(u32x4*)(base + (size_t)(ai * 128 + m * 16) * FF) = pack_row8(v0, v1); __builtin_amdgcn_sched_barrier(0); }
    }
};

DI void transpose_item(const float* W, int N, bf16_t* WT, int pitch, int koff, int k0, int n0, int drow0, LAS float* scr, int lane) {
#pragma unroll
    for (int i = 0; i < 8; ++i) { const int kk = 8 * i + (lane >> 3), n4 = 4 * (lane & 7); const f32x4 w = *(const f32x4*)(W + (size_t)(k0 + kk) * N + n0 + n4);
        scr[kk * 33 + n4] = w[0]; scr[kk * 33 + n4 + 1] = w[1]; scr[kk * 33 + n4 + 2] = w[2]; scr[kk * 33 + n4 + 3] = w[3]; }
    asm volatile("s_waitcnt lgkmcnt(0)" ::: "memory");
    const int c = lane & 7;
#pragma unroll
    for (int j = 0; j < 4; ++j) { const int n = (lane >> 3) + 8 * j; const LAS float* s = scr + (8 * c) * 33 + n;
        u32x4 o; o.x = pk2(s[0 * 33], s[1 * 33]); o.y = pk2(s[2 * 33], s[3 * 33]); o.z = pk2(s[4 * 33], s[5 * 33]); o.w = pk2(s[6 * 33], s[7 * 33]);
        *(u32x4*)(WT + (size_t)(drow0 + n) * pitch + koff + k0 + 8 * c) = o; }
    asm volatile("s_waitcnt lgkmcnt(0)" ::: "memory");
}
DI void phase_prep(const Params& p, LAS unsigned char* lds) {
    const int tid = fresh_tid(), lane = tid & 63, wave = __builtin_amdgcn_readfirstlane(tid >> 6);
    LAS float* scr = (LAS float*)(lds + wave * 16384);
    const int gw = blockIdx.x * 8 + wave, NGW = gridDim.x * 8;
    unsigned char* ws = p.ws;
    constexpr int I_ADA = 16 * 192, I_IN = 16 * 176, I_A = 8 * 32, I_O = 16 * 32, I_FI = 16 * 176, I_FO = 44 * 32;
    constexpr int NIT = I_ADA + I_IN + 2 * I_A + I_O + I_FI + I_FO;
    for (int it = gw; it < NIT; it += NGW) {
        int r = it;
        if (r < I_ADA) { const int kb = r / 192, nb = r % 192; transpose_item(p.w_ada, 6144, (bf16_t*)(ws + WS_WADA), 1024, 0, 64 * kb, 32 * nb, 32 * nb, scr, lane); continue; } r -= I_ADA;
        if (r < I_IN) { const int kb = r / 176, nb = r % 176, n0 = 32 * nb; int dr = n0;
            if (n0 >= 3584) { const int j = n0 < 4608 ? n0 - 3584 : n0 - 4608; dr = 3584 + 256 * (j >> 7) + (j & 127) + (n0 < 4608 ? 0 : 128); }
            transpose_item(p.w_in, INC, (bf16_t*)(ws + WS_WIN), 1024, 0, 64 * kb, n0, dr, scr, lane); continue; } r -= I_IN;
        if (r < I_A) { const int kb = r / 32, nb = r % 32; transpose_item(p.w_a, 1024, (bf16_t*)(ws + WS_WAB), 1024, 0, 64 * kb, 32 * nb, 32 * nb, scr, lane); continue; } r -= I_A;
        if (r < I_A) { const int kb = r / 32, nb = r % 32; transpose_item(p.w_b, 1024, (bf16_t*)(ws + WS_WAB), 1024, 512, 64 * kb, 32 * nb, 32 * nb, scr, lane); continue; } r -= I_A;
        if (r < I_O) { const int kb = r / 32, nb = r % 32; transpose_item(p.w_out, 1024, (bf16_t*)(ws + WS_WO), 1024, 0, 64 * kb, 32 * nb, 32 * nb, scr, lane); continue; } r -= I_O;
        if (r < I_FI) { const int kb = r / 176, nb = r % 176; const int n0 = 32 * nb; const int j0 = n0 < FF ? n0 : n0 - FF;
            transpose_item(p.w_ffn_in, INC, (bf16_t*)(ws + WS_WFI), 1024, 0, 64 * kb, n0, 256 * (j0 >> 7) + (j0 & 127) + (n0 < FF ? 0 : 128), scr, lane); continue; } r -= I_FI;
        { const int kb = r / 32, nb = r % 32; transpose_item(p.w_ffn_out, 1024, (bf16_t*)(ws + WS_WFO), FF, 0, 64 * kb, 32 * nb, 32 * nb, scr, lane); }
    }
    bf16_t* SC = (bf16_t*)(ws + WS_SC);
    for (int i = blockIdx.x * 512 + tid; i < 256 * 1024 / 2; i += gridDim.x * 512) { const int row = (2 * i) >> 10, col = (2 * i) & 1023; float a = 0.f, b = 0.f;
        if (row < NBATCH) { const float* c = row < 2 ? p.c_prompt + row * D : p.c_sample + (row - 2) * D; a = silu(c[col]); b = silu(c[col + 1]); }
        ((unsigned*)SC)[i] = pk2(a, b); }
}

DI float wave_sum(float v) {
#pragma unroll
    for (int o = 1; o < 64; o <<= 1) v += __shfl_xor(v, o);
    return v;
}
DI void phase_norm_mod(const float* xp, const float* xs, const float* nw, const float* mod, int sh_off, int sc_off, bf16_t* H) {
    const int tid = fresh_tid(), lane = tid & 63, wave = __builtin_amdgcn_readfirstlane(tid >> 6);
    const int gw = blockIdx.x * 8 + wave, NGW = gridDim.x * 8;
    for (int r = gw; r < T; r += NGW) {
        const float* xr = r < TP ? xp + (size_t)r * D : xs + (size_t)(r - TP) * D; const float* mb = mod + (size_t)batch_of(r) * 6144;
        f32x4 v[4]; float s = 0.f;
#pragma unroll
        for (int j = 0; j < 4; ++j) { v[j] = *(const f32x4*)(xr + 4 * lane + 256 * j); s += (v[j][0] * v[j][0] + v[j][1] * v[j][1]) + (v[j][2] * v[j][2] + v[j][3] * v[j][3]); }
        const float rstd = __builtin_amdgcn_rsqf(wave_sum(s) * (1.f / D) + EPS);
#pragma unroll
        for (int j = 0; j < 4; ++j) { const int col = 4 * lane + 256 * j; const f32x4 w = *(const f32x4*)(nw + col), sc = *(const f32x4*)(mb + sc_off + col), sh = *(const f32x4*)(mb + sh_off + col);
            const f32x4 h = v[j] * rstd * w * (sc + 1.f) + sh; u32x2 o; o.x = pk2(h[0], h[1]); o.y = pk2(h[2], h[3]);
            *(u32x2*)(H + (size_t)r * D + col) = o; }
    }
}
DI void phase_norm_mod_b(const bf16_t* xb, const float* nw, const float* mod, int sh_off, int sc_off, bf16_t* H, int r_lo = 0, int r_hi = T, int b_lo = 0) {
    const int tid = fresh_tid(), lane = tid & 63, wave = __builtin_amdgcn_readfirstlane(tid >> 6);
    const int gw = ((int)blockIdx.x - b_lo) * 8 + wave, NGW = ((int)gridDim.x - b_lo) * 8;
    for (int r = r_lo + gw; r < r_hi; r += NGW) {
        const bf16_t* xr = xb + (size_t)r * D; const float* mb = mod + (size_t)batch_of(r) * 6144;
        float v[2][8]; float s = 0.f;
#pragma unroll
        for (int j = 0; j < 2; ++j) { const u32x4 x = *(const u32x4*)(xr + 8 * lane + 512 * j);
#pragma unroll
            for (int i = 0; i < 4; ++i) { v[j][2 * i] = bflo(x[i]); v[j][2 * i + 1] = bfhi(x[i]); s += v[j][2 * i] * v[j][2 * i] + v[j][2 * i + 1] * v[j][2 * i + 1]; } }
        const float rstd = __builtin_amdgcn_rsqf(wave_sum(s) * (1.f / D) + EPS);
#pragma unroll
        for (int j = 0; j < 2; ++j) { const int col = 8 * lane + 512 * j; f32x4 h[2];
#pragma unroll
            for (int q = 0; q < 2; ++q) { const f32x4 w = *(const f32x4*)(nw + col + 4 * q), sc = *(const f32x4*)(mb + sc_off + col + 4 * q), sh = *(const f32x4*)(mb + sh_off + col + 4 * q);
                const f32x4 x = {v[j][4 * q], v[j][4 * q + 1], v[j][4 * q + 2], v[j][4 * q + 3]}; h[q] = x * rstd * w * (sc + 1.f) + sh; }
            *(u32x4*)(H + (size_t)r * D + col) = pack_row8(h[0], h[1]); }
    }
}
DI void phase_final_norm(const bf16_t* xb, float* y, const float* nw, int r_lo = 0, int r_hi = T, int b_lo = 0) {
    const int tid = fresh_tid(), lane = tid & 63, wave = __builtin_amdgcn_readfirstlane(tid >> 6);
    const int gw = ((int)blockIdx.x - b_lo) * 8 + wave, NGW = ((int)gridDim.x - b_lo) * 8;
    for (int r = r_lo + gw; r < r_hi; r += NGW) { const bf16_t* xr = xb + (size_t)r * D; float* yr = y + (size_t)r * D;
        float v[2][8]; float s = 0.f;
#pragma unroll
        for (int j = 0; j < 2; ++j) { const u32x4 x = *(const u32x4*)(xr + 8 * lane + 512 * j);
#pragma unroll
            for (int i = 0; i < 4; ++i) { v[j][2 * i] = bflo(x[i]); v[j][2 * i + 1] = bfhi(x[i]); s += v[j][2 * i] * v[j][2 * i] + v[j][2 * i + 1] * v[j][2 * i + 1]; } }
        const float rstd = __builtin_amdgcn_rsqf(wave_sum(s) * (1.f / D) + EPS);
#pragma unroll
        for (int j = 0; j < 2; ++j) { const int col = 8 * lane + 512 * j;
#pragma unroll
            for (int q = 0; q < 2; ++q) { const f32x4 x = {v[j][4 * q], v[j][4 * q + 1], v[j][4 * q + 2], v[j][4 * q + 3]}; *(f32x4*)(yr + col + 4 * q) = x * rstd * *(const f32x4*)(nw + col + 4 * q); } }
    }
}

DI void phase_final_norm_parts(const bf16_t* x1b, const float* part0, const float* part1, const float* g2mod, float* y, const float* nw) {
    const int tid = fresh_tid(), lane = tid & 63, wave = __builtin_amdgcn_readfirstlane(tid >> 6);
    const int gw = blockIdx.x * 8 + wave, NGW = gridDim.x * 8;
    for (int r = TP + gw; r < T; r += NGW) { const float* gb = g2mod + (size_t)batch_of(r) * 6144; const size_t po = (size_t)(r - TP) * D;
        f32x4 v[4]; float s = 0.f;
#pragma unroll
        for (int j = 0; j < 4; ++j) { const int col = 4 * lane + 256 * j; const u32x2 xb = *(const u32x2*)(x1b + (size_t)r * D + col);
            const f32x4 x = {bflo(xb.x), bfhi(xb.x), bflo(xb.y), bfhi(xb.y)};
            v[j] = x + *(const f32x4*)(gb + col) * (*(const f32x4*)(part0 + po + col) + *(const f32x4*)(part1 + po + col));
            s += (v[j][0] * v[j][0] + v[j][1] * v[j][1]) + (v[j][2] * v[j][2] + v[j][3] * v[j][3]); }
        const float rstd = __builtin_amdgcn_rsqf(wave_sum(s) * (1.f / D) + EPS);
#pragma unroll
        for (int j = 0; j < 4; ++j) { const int col = 4 * lane + 256 * j; *(f32x4*)(y + (size_t)r * D + col) = v[j] * rstd * *(const f32x4*)(nw + col); }
    }
}

DI void hgrn_u_item(const Params& p, int item, int lane) {
    const int c = item >> 4, rem = item & 15, h = rem >> 2, kt = rem & 3, l31 = lane & 31, hf = lane >> 5;
    const float* CUM = (const float*)(p.ws + WS_CUM); const bf16_t* KA = (const bf16_t*)(p.ws + WS_KA); const bf16_t* VA = (const bf16_t*)(p.ws + WS_VA); bf16_t* U = (bf16_t*)(p.ws + WS_U);
    const size_t hb = (size_t)h * T * 128; const int kcol = 32 * kt + l31;
    const float tot = CUM[hb + (size_t)(c * 64 + 63) * 128 + kcol];
    bf16x8 kdf[2][2];
#pragma unroll
    for (int st = 0; st < 2; ++st) { f32x16 kd;
#pragma unroll
        for (int r = 0; r < 16; ++r) { const size_t idx = hb + (size_t)(c * 64 + 32 * st + crow(r, hf)) * 128 + kcol; kd[r] = bf2f((short)KA[idx]) * __expf(tot - CUM[idx]); }
        kdf[st][0] = pack8(kd, 0); kdf[st][1] = pack8(kd, 1); }
    const bf16x8 id0 = ident_frag(0, l31, hf), id1 = ident_frag(1, l31, hf);
#pragma unroll
    for (int vt = 0; vt < 4; ++vt) { f32x16 dacc = zero16();
#pragma unroll
        for (int st = 0; st < 2; ++st) { const bf16_t* vp = VA + hb + (size_t)(c * 64 + 32 * st + l31) * 128 + 32 * vt + 8 * hf;
            f32x16 vx = zero16(); vx = MFMA32(*(const bf16x8*)vp, id0, vx); vx = MFMA32(*(const bf16x8*)(vp + 16), id1, vx);
            dacc = MFMA32(kdf[st][0], pack8(vx, 0), dacc); dacc = MFMA32(kdf[st][1], pack8(vx, 1), dacc); }
        bf16_t* up = U + ((size_t)(c * 4 + h) * 128 + 32 * vt + l31) * 128 + 32 * kt + 8 * hf;
#pragma unroll
        for (int g = 0; g < 4; g += 2) { u32x2 o0, o1; o0.x = pk2(dacc[4 * g], dacc[4 * g + 1]); o0.y = pk2(dacc[4 * g + 2], dacc[4 * g + 3]); o1.x = pk2(dacc[4 * g + 4], dacc[4 * g + 5]); o1.y = pk2(dacc[4 * g + 6], dacc[4 * g + 7]);
            *(u32x4*)(up + 8 * g) = widen_pair(o0, o1); }
    }
}

DI void scan_prompt_item(const Params& p, int item, int lane) {
    const int bh = item >> 5, vq = item & 31, b = bh >> 2, h = bh & 3, kg = lane & 31, vv = lane >> 5;
    const float* __restrict__ DEC = (const float*)(p.ws + WS_DEC); const bf16_t* __restrict__ U = (const bf16_t*)(p.ws + WS_U); bf16_t* __restrict__ SST = (bf16_t*)(p.ws + WS_SST);
    f32x4 S0 = {0.f, 0.f, 0.f, 0.f}, S1 = {0.f, 0.f, 0.f, 0.f};
    const int v0 = 4 * vq + vv, v1 = v0 + 2;
#pragma unroll 16
    for (int n = 0; n < 256; ++n) { const int c = b * 256 + n;
        const f32x4 d = *(const f32x4*)(DEC + (size_t)c * 512 + h * 128 + 4 * kg);
        const size_t o0 = ((size_t)(c * 4 + h) * 128 + v0) * 128 + 4 * kg, o1 = ((size_t)(c * 4 + h) * 128 + v1) * 128 + 4 * kg;
        const u32x2 u0 = *(const u32x2*)(U + o0), u1 = *(const u32x2*)(U + o1);
        u32x2 s; s.x = pk2(S0[0], S0[1]); s.y = pk2(S0[2], S0[3]); *(u32x2*)(SST + o0) = s;
        s.x = pk2(S1[0], S1[1]); s.y = pk2(S1[2], S1[3]); *(u32x2*)(SST + o1) = s;
        S0[0] = d[0] * S0[0] + bflo(u0.x); S0[1] = d[1] * S0[1] + bfhi(u0.x); S0[2] = d[2] * S0[2] + bflo(u0.y); S0[3] = d[3] * S0[3] + bfhi(u0.y);
        S1[0] = d[0] * S1[0] + bflo(u1.x); S1[1] = d[1] * S1[1] + bfhi(u1.x); S1[2] = d[2] * S1[2] + bflo(u1.y); S1[3] = d[3] * S1[3] + bfhi(u1.y);
    }
    float* sp = p.out + OFF_SP + ((size_t)bh * 128 + 4 * kg) * 128;
#pragma unroll
    for (int i = 0; i < 4; ++i) { sp[(size_t)i * 128 + v0] = S0[i]; sp[(size_t)i * 128 + v1] = S1[i]; }
}
DI void scan_sample_item(const Params& p, int item, int lane) {
    const int bh = item >> 5, vq = item & 31, bs = bh >> 2, h = bh & 3, kg = lane & 31, vv = lane >> 5, c = 512 + bs;
    const float* DEC = (const float*)(p.ws + WS_DEC); const bf16_t* U = (const bf16_t*)(p.ws + WS_U); bf16_t* SST = (bf16_t*)(p.ws + WS_SST);
    const f32x4 d = *(const f32x4*)(DEC + (size_t)c * 512 + h * 128 + 4 * kg);
    const float* s0 = p.state + ((size_t)bh * 128 + 4 * kg) * 128; float* so = p.out + OFF_SS + ((size_t)bh * 128 + 4 * kg) * 128;
#pragma unroll
    for (int e = 0; e < 2; ++e) { const int v = 4 * vq + 2 * e + vv; const size_t o = ((size_t)(c * 4 + h) * 128 + v) * 128 + 4 * kg;
        const u32x2 u = *(const u32x2*)(U + o); f32x4 S;
#pragma unroll
        for (int i = 0; i < 4; ++i) S[i] = s0[(size_t)i * 128 + v];
        u32x2 s; s.x = pk2(S[0], S[1]); s.y = pk2(S[2], S[3]); *(u32x2*)(SST + o) = s;
        so[v] = d[0] * S[0] + bflo(u.x); so[128 + v] = d[1] * S[1] + bfhi(u.x); so[256 + v] = d[2] * S[2] + bflo(u.y); so[384 + v] = d[3] * S[3] + bfhi(u.y); }
}

DI void attn_item(const Params& p, int item, int lane, const LAS float* biasl) {
    const int c = item >> 3, h = item & 7, l31 = lane & 31, hf = lane >> 5;
    const bf16_t* KB = (const bf16_t*)(p.ws + WS_KB); const bf16_t* VB = (const bf16_t*)(p.ws + WS_VB);
    bf16x8 qf[2][4];
    { const bf16_t* qptr = (const bf16_t*)(p.ws + WS_QOB) + (size_t)(c * 64 + l31) * 1024 + 512 + h * 64;
#pragma unroll
    for (int qq = 0; qq < 2; ++qq)
#pragma unroll
        for (int ks = 0; ks < 4; ++ks) qf[qq][ks] = *(const bf16x8*)(qptr + (size_t)qq * 32 * 1024 + 16 * ks + 8 * hf); }
    const LAS float* bl = biasl + h * 192;
    f32x16 OT[2][2]; float mrun[2], lsum[2];
#pragma unroll
    for (int qq = 0; qq < 2; ++qq) { OT[qq][0] = zero16(); OT[qq][1] = zero16(); mrun[qq] = -1e30f; lsum[qq] = 0.f; }
    int ntile, ncache, db0, krow_first;
    if (c < 512) { const int n = c & 255, j0 = n < 8 ? n : 8; ntile = 2 * (j0 + 1); ncache = 0; db0 = 64 * j0; krow_first = (c - j0) * 64; }
    else { ntile = 18; ncache = 16; db0 = 512; krow_first = c * 64 - 512; }
    const int bs = c - 512;
    u32x4 nk[4], nv[4];
#define ATT_LOAD(i_) do { if ((i_) >= ncache) { const size_t ro_ = ((size_t)h * T + (size_t)(krow_first + 32 * (i_) + l31)) * 64 + 8 * hf; \
            _Pragma("unroll") for (int ks = 0; ks < 4; ++ks) { nk[ks] = *(const u32x4*)(KB + ro_ + 16 * ks); nv[ks] = *(const u32x4*)(VB + ro_ + 16 * ks); } } } while (0)
    ATT_LOAD(0);
    for (int i = 0; i < ntile; ++i) {
        bf16x8 kf[4], vf[2][2];
        if (i < ncache) {
            const float* kp_ = p.cache_k + ((size_t)(bs * 512 + 32 * i + l31) * 8 + h) * 64 + 8 * hf; const float* vp_ = p.cache_v + ((size_t)(bs * 512 + 32 * i + l31) * 8 + h) * 64 + 8 * hf;
#pragma unroll
            for (int ks = 0; ks < 4; ++ks) { u32x4 w; const f32x4 a = *(const f32x4*)(kp_ + 16 * ks), b = *(const f32x4*)(kp_ + 16 * ks + 4), e = *(const f32x4*)(vp_ + 16 * ks), f = *(const f32x4*)(vp_ + 16 * ks + 4);
                w.x = pk2(a[0], a[1]); w.y = pk2(a[2], a[3]); w.z = pk2(b[0], b[1]); w.w = pk2(b[2], b[3]); kf[ks] = __builtin_bit_cast(bf16x8, w);
                w.x = pk2(e[0], e[1]); w.y = pk2(e[2], e[3]); w.z = pk2(f[0], f[1]); w.w = pk2(f[2], f[3]); vf[ks >> 1][ks & 1] = __builtin_bit_cast(bf16x8, w); }
        } else {
#pragma unroll
            for (int ks = 0; ks < 4; ++ks) { kf[ks] = __builtin_bit_cast(bf16x8, nk[ks]); vf[ks >> 1][ks & 1] = __builtin_bit_cast(bf16x8, nv[ks]); }
        }
        if (i + 1 < ntile) ATT_LOAD(i + 1);
        asm volatile("" ::: "memory");
        bf16x8 vxf[2][2];
        const int l31b = launder(l31); const bf16x8 id0 = ident_frag(0, l31b, hf), id1 = ident_frag(1, l31b, hf);
#pragma unroll
        for (int dt = 0; dt < 2; ++dt) { f32x16 vx = zero16(); vx = MFMA32(vf[dt][0], id0, vx); vx = MFMA32(vf[dt][1], id1, vx); vxf[dt][0] = pack8(vx, 0); vxf[dt][1] = pack8(vx, 1); }
#pragma unroll
        for (int qq = 0; qq < 2; ++qq) {
            f32x16 st = zero16();
#pragma unroll
            for (int ks = 0; ks < 4; ++ks) st = MFMA32(kf[ks], qf[qq][ks], st);
            const int dq = db0 + 32 * qq - 32 * i; float mt = -1e30f;
            if (dq - 31 >= 128) { const float bc = bl[191];
#pragma unroll
                for (int r = 0; r < 16; ++r) { const float s = st[r] * (0.125f * LOG2E) + bc; st[r] = s; mt = fmaxf(mt, s); }
            } else { const int dbase = dq + l31;
#pragma unroll
                for (int r = 0; r < 16; ++r) { int dist = dbase - crow(r, hf); dist = dist > 128 ? 128 : dist; const float s = st[r] * (0.125f * LOG2E) + bl[dist + 63]; st[r] = s; mt = fmaxf(mt, s); }
            }
            mt = fmaxf(mt, __shfl_xor(mt, 32));
            const float mnew = fmaxf(mrun[qq], mt), alpha = __builtin_amdgcn_exp2f(mrun[qq] - mnew); mrun[qq] = mnew;
            float ps = 0.f;
#pragma unroll
            for (int r = 0; r < 16; ++r) { st[r] = __builtin_amdgcn_exp2f(st[r] - mnew); ps += st[r]; }
            lsum[qq] = lsum[qq] * alpha + ps;
#pragma unroll
            for (int r = 0; r < 16; ++r) { OT[qq][0][r] *= alpha; OT[qq][1][r] *= alpha; }
            const bf16x8 pf0 = pack8(st, 0), pf1 = pack8(st, 1);
            OT[qq][0] = MFMA32(vxf[0][0], pf0, OT[qq][0]); OT[qq][0] = MFMA32(vxf[0][1], pf1, OT[qq][0]);
            OT[qq][1] = MFMA32(vxf[1][0], pf0, OT[qq][1]); OT[qq][1] = MFMA32(vxf[1][1], pf1, OT[qq][1]);
        }
    }
#undef ATT_LOAD
    bf16_t* qptr = (bf16_t*)(p.ws + WS_QOB) + (size_t)(c * 64 + launder(l31)) * 1024 + 512 + h * 64;
#pragma unroll
    for (int qq = 0; qq < 2; ++qq) { const float l = lsum[qq] + __shfl_xor(lsum[qq], 32), inv = 1.f / l; bf16_t* op = qptr + (size_t)qq * 32 * 1024;
#pragma unroll
        for (int dt = 0; dt < 2; ++dt)
#pragma unroll
            for (int g = 0; g < 4; g += 2) { u32x2 o0, o1; o0.x = pk2(OT[qq][dt][4 * g] * inv, OT[qq][dt][4 * g + 1] * inv); o0.y = pk2(OT[qq][dt][4 * g + 2] * inv, OT[qq][dt][4 * g + 3] * inv);
                o1.x = pk2(OT[qq][dt][4 * g + 4] * inv, OT[qq][dt][4 * g + 5] * inv); o1.y = pk2(OT[qq][dt][4 * g + 6] * inv, OT[qq][dt][4 * g + 7] * inv);
                *(u32x4*)(op + 32 * dt + 8 * (g + hf)) = widen_pair(o0, o1); } }
}

DI void hgrn_out_item(const Params& p, int item, int lane, bf16_t* obase = nullptr) {
    const int c = item >> 3, h = (item >> 1) & 3, tt = item & 1, l31 = lane & 31, hf = lane >> 5;
    const float* CUM = (const float*)(p.ws + WS_CUM); const bf16_t* KA = (const bf16_t*)(p.ws + WS_KA); const bf16_t* VA = (const bf16_t*)(p.ws + WS_VA);
    const bf16_t* GA = (const bf16_t*)(p.ws + WS_GA); const bf16_t* SST = (const bf16_t*)(p.ws + WS_SST);
    const int trow = c * 64 + 32 * tt + l31;
    bf16_t* qap = (bf16_t*)(p.ws + WS_QOB) + (size_t)trow * 1024 + h * 128;
    const size_t hb = (size_t)h * T * 128;
    const float* cumt = CUM + hb + (size_t)trow * 128; const float* refp = CUM + hb + (size_t)(c * 64 + 32) * 128;
    bf16x8 qd1[8], qd2[8], kdt[8];
    const bf16_t* kat = KA + hb + (size_t)trow * 128;
#pragma unroll
    for (int ks = 0; ks < 8; ++ks) { const int k0 = 16 * ks + 8 * hf; const bf16x8 q8 = *(const bf16x8*)(qap + k0), k8 = *(const bf16x8*)(kat + k0);
        const f32x4 c0 = *(const f32x4*)(cumt + k0), c1 = *(const f32x4*)(cumt + k0 + 4), r0 = *(const f32x4*)(refp + k0), r1 = *(const f32x4*)(refp + k0 + 4);
        float a[8], b[8], d[8];
#pragma unroll
        for (int j = 0; j < 8; ++j) { const float q = bf2f(q8[j]), cu = j < 4 ? c0[j & 3] : c1[j & 3], rf = j < 4 ? r0[j & 3] : r1[j & 3]; a[j] = q * __expf(cu - rf); b[j] = q * __expf(cu); d[j] = bf2f(k8[j]) * __expf(rf - cu); }
        qd1[ks] = pack8f(a); qd2[ks] = pack8f(b); kdt[ks] = pack8f(d); }
    f32x16 OT[4];
#pragma unroll
    for (int vt = 0; vt < 4; ++vt) OT[vt] = zero16();
    const bf16_t* sp = SST + ((size_t)(c * 4 + h) * 128 + l31) * 128 + 8 * hf;
#pragma unroll
    for (int vt = 0; vt < 4; ++vt) {
#pragma unroll
        for (int ks = 0; ks < 8; ++ks) OT[vt] = MFMA32(*(const bf16x8*)(sp + (size_t)vt * 32 * 128 + 16 * ks), qd2[ks], OT[vt]);
        __builtin_amdgcn_sched_barrier(0); }
    const bf16x8 id0 = ident_frag(0, l31, hf), id1 = ident_frag(1, l31, hf);
    for (int st = 0; st <= tt; ++st) {
        const int srow = c * 64 + 32 * st + l31; const bf16_t* kap = KA + hb + (size_t)srow * 128; const float* cums = CUM + hb + (size_t)srow * 128;
        f32x16 X = zero16();
        if (st == tt) {
#pragma unroll
            for (int ks = 0; ks < 8; ++ks) X = MFMA32(kdt[ks], qd1[ks], X);
        } else
#pragma unroll
        for (int ks = 0; ks < 8; ++ks) { const int k0 = 16 * ks + 8 * hf; const bf16x8 k8 = *(const bf16x8*)(kap + k0);
            const f32x4 c0 = *(const f32x4*)(cums + k0), c1 = *(const f32x4*)(cums + k0 + 4), r0 = *(const f32x4*)(refp + k0), r1 = *(const f32x4*)(refp + k0 + 4);
            float a[8];
#pragma unroll
            for (int j = 0; j < 8; ++j) { const float cu = j < 4 ? c0[j & 3] : c1[j & 3], rf = j < 4 ? r0[j & 3] : r1[j & 3]; a[j] = bf2f(k8[j]) * __expf(rf - cu); }
            X = MFMA32(pack8f(a), qd1[ks], X); }
        if (st == tt) {
#pragma unroll
            for (int r = 0; r < 16; ++r) if (crow(r, hf) > l31) X[r] = 0.f; }
        const bf16x8 xf0 = pack8(X, 0), xf1 = pack8(X, 1);
        const bf16_t* vp = VA + hb + (size_t)srow * 128 + 8 * hf;
#pragma unroll
        for (int vt = 0; vt < 4; ++vt) { f32x16 vx = zero16(); vx = MFMA32(*(const bf16x8*)(vp + 32 * vt), id0, vx); vx = MFMA32(*(const bf16x8*)(vp + 32 * vt + 16), id1, vx);
            OT[vt] = MFMA32(pack8(vx, 0), xf0, OT[vt]); OT[vt] = MFMA32(pack8(vx, 1), xf1, OT[vt]); }
    }
    float ss = 0.f;
#pragma unroll
    for (int vt = 0; vt < 4; ++vt)
#pragma unroll
        for (int r = 0; r < 16; ++r) ss += OT[vt][r] * OT[vt][r];
    ss += __shfl_xor(ss, 32);
    const float rstd = __builtin_amdgcn_rsqf(ss * (1.f / 128.f) + EPS);
    const bf16_t* gap = GA + hb + (size_t)trow * 128; const float* onp = p.out_norm + h * 128;
    if (obase) qap = obase + (size_t)trow * 512 + h * 128;
#pragma unroll
    for (int vt = 0; vt < 4; ++vt)
#pragma unroll
        for (int g = 0; g < 4; g += 2) { u32x2 ga0, ga1; narrow_pair(*(const u32x4*)(gap + 32 * vt + 8 * (g + hf)), ga0, ga1);
            u32x2 o0, o1;
            { const int v0 = 32 * vt + 8 * g + 4 * hf; const f32x4 on = *(const f32x4*)(onp + v0);
              o0.x = pk2(OT[vt][4 * g] * rstd * on[0] * bflo(ga0.x), OT[vt][4 * g + 1] * rstd * on[1] * bfhi(ga0.x)); o0.y = pk2(OT[vt][4 * g + 2] * rstd * on[2] * bflo(ga0.y), OT[vt][4 * g + 3] * rstd * on[3] * bfhi(ga0.y)); }
            { const int v0 = 32 * vt + 8 * (g + 1) + 4 * hf; const f32x4 on = *(const f32x4*)(onp + v0);
              o1.x = pk2(OT[vt][4 * g + 4] * rstd * on[0] * bflo(ga1.x), OT[vt][4 * g + 5] * rstd * on[1] * bfhi(ga1.x)); o1.y = pk2(OT[vt][4 * g + 6] * rstd * on[2] * bflo(ga1.y), OT[vt][4 * g + 7] * rstd * on[3] * bfhi(ga1.y)); }
            *(u32x4*)(qap + 32 * vt + 8 * (g + hf)) = widen_pair(o0, o1); }
}


#define XB_TMO      128
#define XB_XCNT(j)  (256  + 64 * (j))
#define XB_XSUB(j)  (1280 + 64 * (j))
#define XB_XGEN(j)  (2304 + 64 * (j))
#define XB_TOP      3328
#define XB_TOPGEN   3392
#define XCD_BAR_WORDS 3456
#define XB_SPIN_CAP (1u << 18)
DI unsigned xb_ld(unsigned* p)              { return __hip_atomic_load(p, __ATOMIC_RELAXED, __HIP_MEMORY_SCOPE_AGENT); }
DI unsigned xb_add(unsigned* p, unsigned v) { return __hip_atomic_fetch_add(p, v, __ATOMIC_RELAXED, __HIP_MEMORY_SCOPE_AGENT); }
DI unsigned xb_xcc_id() { return (unsigned)__builtin_amdgcn_s_getreg((3 << 11) | 20) & 0xFu; }
#define XB_SPIN(cond, bar) do { unsigned _sp = 0; while (cond) { __builtin_amdgcn_s_sleep(1); \
    if ((++_sp & 255u) == 0u) { if (xb_ld(&(bar)[XB_TMO])) break; if (_sp > XB_SPIN_CAP) { atomicAdd(&(bar)[XB_TMO], 1u); break; } } } } while (0)
struct XcdBarrier { unsigned* bar; unsigned x; volatile LAS unsigned* st; };
DI XcdBarrier xcd_barrier_post(unsigned* bar, volatile LAS unsigned* st) {
    XcdBarrier b; b.bar = bar; b.x = xb_xcc_id(); b.st = st;
    if (threadIdx.x == 0) (void)xb_add(&bar[XB_XCNT(b.x)], 1u);
    return b;
}
DI void xcd_barrier_complete(unsigned* bar, unsigned x, unsigned& nloc, unsigned& nx) {
    const unsigned G = gridDim.x * gridDim.y * gridDim.z;
    unsigned sum, cnt, mine, sp = 0u;
    for (;;) {
        sum = 0u; cnt = 0u; mine = 0u;
#pragma unroll
        for (unsigned j = 0; j < 16; ++j) { const unsigned c = xb_ld(&bar[XB_XCNT(j)]); sum += c; cnt += (c > 0u) ? 1u : 0u; mine = (j == x) ? c : mine; }
        if (sum == G) break;
        __builtin_amdgcn_s_sleep(1);
        if ((++sp & 255u) == 0u) { if (xb_ld(&bar[XB_TMO])) break; if (sp > XB_SPIN_CAP) { atomicAdd(&bar[XB_TMO], 1u); break; } }
    }
    nloc = mine > 0u ? mine : 1u; nx = cnt > 0u ? cnt : 1u;
}
DI void xcd_barrier(const XcdBarrier& b) {
    asm volatile("s_waitcnt vmcnt(0)" ::: "memory");
    __syncthreads();
    if (threadIdx.x == 0) {
        unsigned* bar = b.bar;
        __builtin_amdgcn_s_waitcnt(0);
        unsigned nloc = b.st[0], nx = b.st[1];
        if (nloc == 0u) { xcd_barrier_complete(bar, b.x, nloc, nx); b.st[0] = nloc; b.st[1] = nx; }
        const unsigned old = xb_add(&bar[XB_XSUB(b.x)], 1u);
        const unsigned gen = old / nloc;
        if (old + 1u == (gen + 1u) * nloc) {
            __builtin_amdgcn_fence(__ATOMIC_RELEASE, "agent");
            asm volatile("s_waitcnt vmcnt(0)" ::: "memory");
            const unsigned og = xb_add(&bar[XB_TOP], 1u);
            const unsigned tg = og / nx;
            if (og + 1u == (tg + 1u) * nx) xb_add(&bar[XB_TOPGEN], 1u);
            else XB_SPIN(xb_ld(&bar[XB_TOPGEN]) == tg, bar);
            __builtin_amdgcn_fence(__ATOMIC_ACQUIRE, "agent");
            xb_add(&bar[XB_XGEN(b.x)], 1u);
            asm volatile("s_waitcnt vmcnt(0)" ::: "memory");
        } else {
            XB_SPIN(xb_ld(&bar[XB_XGEN(b.x)]) == gen, bar);
            __builtin_amdgcn_fence(__ATOMIC_ACQUIRE, "agent");
            asm volatile("s_waitcnt vmcnt(0)" ::: "memory");
        }
    }
    __syncthreads();
}

__global__ void __launch_bounds__(512, 2) fwd_megakernel(Params p) {
    extern __shared__ __attribute__((aligned(16))) unsigned char lds_raw[];
    LAS unsigned char* lds = (LAS unsigned char*)lds_raw;
    cg::grid_group grid = cg::this_grid();
    const int G = gridDim.x, bx = blockIdx.x;
    volatile LAS unsigned* bst = (volatile LAS unsigned*)(lds + LDS_ST_OFF);
    if (threadIdx.x < 2) bst[threadIdx.x] = 0u;
    __syncthreads();
    const XcdBarrier xbar = xcd_barrier_post((unsigned*)(p.ws + WS_BAR), bst);
    if (threadIdx.x == 0) bst[2] = xb_add((unsigned*)(p.ws + WS_BAR) + 3712 + xbar.x, 1u);
#define GRID_BAR() xcd_barrier(xbar)
    unsigned char* ws = p.ws;
    float* MOD = (float*)(ws + WS_MOD); bf16_t* H = (bf16_t*)(ws + WS_H);

    phase_prep(p, lds);
    grid.sync();
    { pg8::Gemm g{(const bf16_t*)(ws + WS_SC), (const bf16_t*)(ws + WS_WADA), 256, 6144, 1024}; pg8::StaticOrder S; S.init(256, 6144, G, bx);
      EpiMod E{MOD, p.b_ada}; pg8::gemm_phase<EpiMod, pg8::StaticOrder, true, true>(lds, g, S, E); }
    GRID_BAR();
    int cv = bx;
    { unsigned* barw = (unsigned*)(p.ws + WS_BAR); bool uni = (G & 7) == 0;
#pragma unroll
      for (int j = 0; j < 16; ++j) { const unsigned c = xb_ld(&barw[XB_XCNT(j)]); uni = uni && (j < 8 ? c == (unsigned)(G >> 3) : c == 0u); }
      if (uni) cv = (int)xbar.x + 8 * (int)bst[2];
      cv = __builtin_amdgcn_readfirstlane(cv); }
    phase_norm_mod(p.x_prompt, p.x_sample, p.norm_mix, MOD, 0, 1024, H);
#if PROBE_DUP == 1
    GRID_BAR(); phase_norm_mod(p.x_prompt, p.x_sample, p.norm_mix, MOD, 0, 1024, H);
#endif
#if PROBE_DUP == 10
    GRID_BAR(); GRID_BAR(); GRID_BAR(); GRID_BAR(); GRID_BAR(); GRID_BAR(); GRID_BAR(); GRID_BAR(); GRID_BAR(); GRID_BAR();
#endif
    GRID_BAR();
    { pg8::Gemm g{H, (const bf16_t*)(ws + WS_WIN), T, INC, 1024}; pg8::StaticOrder S; S.init(T, INC, G, cv);
      EpiIn E{(bf16_t*)(ws + WS_QOB), (bf16_t*)(ws + WS_KA), (bf16_t*)(ws + WS_VA), (bf16_t*)(ws + WS_GA), (bf16_t*)(ws + WS_KB), (bf16_t*)(ws + WS_VB),
              (bf16_t*)(p.out), (bf16_t*)(p.out) + (size_t)T * 1024, (float*)(ws + WS_CUM), (float*)(ws + WS_DEC), p.lb_logits, p.out};
      pg8::gemm_phase<EpiIn, pg8::StaticOrder, true, true>(lds, g, S, E);
#if PROBE_DUP == 2
      GRID_BAR(); pg8::gemm_phase<EpiIn, pg8::StaticOrder, true, true>(lds, g, S, E);
#endif
    }
    GRID_BAR();
    { const int tid = fresh_tid(), lane = tid & 63, wave = __builtin_amdgcn_readfirstlane(tid >> 6);
      for (int it = wave * G + bx; it < NCH * 16; it += 8 * G) hgrn_u_item(p, it, lane);
#if PROBE_DUP == 3
      for (int it = wave * G + bx; it < NCH * 16; it += 8 * G) hgrn_u_item(p, it, lane);
#endif
    }
    GRID_BAR();
    {
        const int tid = fresh_tid(), lane = tid & 63, wave = __builtin_amdgcn_readfirstlane(tid >> 6);
        LAS float* biasl = (LAS float*)lds;
        for (int i = tid; i < 8 * 192; i += 512) biasl[i] = p.rel_bias[i] * LOG2E;
        __syncthreads();
#if PROBE_DUP == 41
        if (wave == 0) { for (int it = bx; it < 256; it += G) scan_prompt_item(p, it, lane); }
        GRID_BAR();
#endif
        if (wave == 0) { for (int it = bx; it < 256; it += G) scan_prompt_item(p, it, lane); }
        else {
            const int gw = (wave - 1) * G + bx, NGW = 7 * G;
            for (int it = gw; it < 4096; it += NGW) scan_sample_item(p, it, lane);
            const int x = (int)xbar.x, ncu = (int)bst[0], nxcc = (int)bst[1], j = (int)bst[2];
            if (nxcc == 8 && x < 8 && ncu > 0 && j < ncu) {
                const int nslot = 7 * ncu, slot = (wave - 1) * ncu + j;
                for (int idx = slot; idx < 68 * 8; idx += nslot) { const int cc = idx >> 3, c = cc < 4 ? 512 + 4 * x + cc : 64 * x + (cc - 4); attn_item(p, c * 8 + (idx & 7), lane, biasl); }
            } else for (int it = gw; it < NCH * 8; it += NGW) attn_item(p, it, lane, biasl);
        }
    }
    GRID_BAR();
    { const int tid = fresh_tid(), lane = tid & 63, wave = __builtin_amdgcn_readfirstlane(tid >> 6);
#if PROBE_DUP == 5
      for (int it = wave * G + bx; it < NCH * 8; it += 8 * G) hgrn_out_item(p, it, lane, (bf16_t*)(ws + WS_U));
      GRID_BAR();
#endif
      for (int it = wave * G + bx; it < NCH * 8; it += 8 * G) hgrn_out_item(p, it, lane); }
    GRID_BAR();
    { pg8::Gemm g{(const bf16_t*)(ws + WS_QOB), (const bf16_t*)(ws + WS_WAB), T, 1024, 1024}; pg8::StaticOrder S; S.init(T, 1024, G, cv);
      EpiMerge E{(const bf16_t*)(p.out), (const bf16_t*)(p.out) + (size_t)T * 1024, (bf16_t*)(ws + WS_M)};
      pg8::gemm_phase<EpiMerge, pg8::StaticOrder, true, true>(lds, g, S, E); }
    GRID_BAR();
    const bool split_ps = G >= 64;
    { pg8::Gemm g{(const bf16_t*)(ws + WS_M), (const bf16_t*)(ws + WS_WO), T, 1024, 1024}; EpiRes<false> E{p.x_prompt, p.x_sample, nullptr, (bf16_t*)(ws + WS_X1B), MOD + 2048};
      if (split_ps) {
        { pg8::StaticOrder S; S.init(TP, 1024, G, cv); pg8::gemm_phase<EpiRes<false>, pg8::StaticOrder, true, true>(lds, g, S, E); }
        GRID_BAR();
        if (bx < 32) { pg8::StaticOrder S; S.init(TS, 1024, 32, bx, TP / 256); pg8::gemm_phase<EpiRes<false>, pg8::StaticOrder, true, true>(lds, g, S, E); }
        else phase_norm_mod_b((const bf16_t*)(ws + WS_X1B), p.norm_ffn, MOD, 3072, 4096, H, 0, TP, 32);
        GRID_BAR();
        phase_norm_mod_b((const bf16_t*)(ws + WS_X1B), p.norm_ffn, MOD, 3072, 4096, H, TP, T, 0);
      } else {
        pg8::StaticOrder S; S.init(T, 1024, G, cv); pg8::gemm_phase<EpiRes<false>, pg8::StaticOrder, true, true>(lds, g, S, E);
        GRID_BAR();
        phase_norm_mod_b((const bf16_t*)(ws + WS_X1B), p.norm_ffn, MOD, 3072, 4096, H);
      } }
    GRID_BAR();
    { pg8::Gemm g{H, (const bf16_t*)(ws + WS_WFI), T, INC, 1024}; pg8::StaticOrder S; S.init(T, INC, G, cv);
      EpiFfnIn E{(bf16_t*)(ws + WS_HID)}; pg8::gemm_phase<EpiFfnIn, pg8::StaticOrder, true, true>(lds, g, S, E);
#if PROBE_DUP == 9
      GRID_BAR(); pg8::gemm_phase<EpiFfnIn, pg8::StaticOrder, true, true>(lds, g, S, E);
#endif
    }
    GRID_BAR();
    { pg8::Gemm g{(const bf16_t*)(ws + WS_HID), (const bf16_t*)(ws + WS_WFO), T, 1024, FF}; EpiRes<true> E{nullptr, nullptr, (const bf16_t*)(ws + WS_X1B), (bf16_t*)(ws + WS_X2B), MOD + 5120};
      if (split_ps) {
        { pg8::StaticOrder S; S.init(TP, 1024, G, cv); pg8::gemm_phase<EpiRes<true>, pg8::StaticOrder, true, true>(lds, g, S, E); }
        GRID_BAR();
        float* PART = (float*)(ws + WS_CUM + 20 * MiB);
        if (bx < 64) { const int ks = bx >> 5; pg8::Gemm gs{(const bf16_t*)(ws + WS_HID) + ks * (FF / 2), (const bf16_t*)(ws + WS_WFO) + ks * (FF / 2), T, 1024, FF / 2, FF};
            pg8::StaticOrder S; S.init(TS, 1024, 32, bx & 31, TP / 256); EpiPart EP{PART + (size_t)ks * TS * D, TP}; pg8::gemm_phase<EpiPart, pg8::StaticOrder, true, true>(lds, gs, S, EP); }
        else phase_final_norm((const bf16_t*)(ws + WS_X2B), p.out, p.norm_final, 0, TP, 64);
        GRID_BAR();
        phase_final_norm_parts((const bf16_t*)(ws + WS_X1B), PART, PART + (size_t)TS * D, MOD + 5120, p.out, p.norm_final);
      } else {
        pg8::StaticOrder S; S.init(T, 1024, G, cv); pg8::gemm_phase<EpiRes<true>, pg8::StaticOrder, true, true>(lds, g, S, E);
        GRID_BAR();
        phase_final_norm((const bf16_t*)(ws + WS_X2B), p.out, p.norm_final);
      } }
}

extern "C" void kernel_launch(void* const* d_in, const int* in_sizes, int n_in, void* d_out, int out_size, void* d_ws, size_t ws_size, hipStream_t stream) {
    static int grid = 0;
    if (grid == 0) {
        if (n_in != 21 || (size_t)out_size != OUT_TOTAL || ws_size < WS_END) { fprintf(stderr, "kernel_launch: unexpected sizes n_in %d out %d ws %zu\n", n_in, out_size, ws_size); grid = -1; return; }
        int dev = 0, cus = 0, per = 0;
        (void)hipGetDevice(&dev); (void)hipDeviceGetAttribute(&cus, hipDeviceAttributeMultiprocessorCount, dev);
        (void)hipFuncSetAttribute((const void*)fwd_megakernel, hipFuncAttributeMaxDynamicSharedMemorySize, LDS_BYTES);
        (void)hipOccupancyMaxActiveBlocksPerMultiprocessor(&per, (const void*)fwd_megakernel, 512, LDS_BYTES);
        if (per < 1) per = 1;
        grid = cus * per; fprintf(stderr, "kernel_launch: grid %d (cus %d x %d)\n", grid, cus, per);
    }
    if (grid < 0) return;
    if (hipMemsetAsync((char*)d_ws + WS_BAR, 0, BAR_BYTES, stream) != hipSuccess) { fprintf(stderr, "kernel_launch: memset failed\n"); return; }
    Params p{};
    const float** f = (const float**)&p;
    for (int i = 0; i < 21; ++i) f[i] = (const float*)d_in[i];
    p.out = (float*)d_out; p.ws = (unsigned char*)d_ws;
    void* args[] = {&p};
    hipError_t e = hipLaunchCooperativeKernel((const void*)fwd_megakernel, dim3(grid), dim3(512), args, LDS_BYTES, stream);
    if (e != hipSuccess) fprintf(stderr, "cooperative launch failed: %s (grid %d)\n", hipGetErrorString(e), grid);
}
```

```cpp
#include <hip/hip_runtime.h>
#include <hip/hip_cooperative_groups.h>
#include <cstdio>
#include <cstdint>
namespace cg = cooperative_groups;
#ifndef PROBE_DUP
#define PROBE_DUP 0
#endif

#define DI __device__ __forceinline__
#define LAS __attribute__((address_space(3)))
typedef unsigned short bf16_t;
typedef short bf16x8 __attribute__((ext_vector_type(8)));
typedef float f32x4 __attribute__((ext_vector_type(4)));
typedef float f32x2 __attribute__((ext_vector_type(2)));
typedef float f32x16 __attribute__((ext_vector_type(16)));
typedef unsigned u32x4 __attribute__((ext_vector_type(4)));
typedef unsigned u32x2 __attribute__((ext_vector_type(2)));
typedef __bf16 bf2_t __attribute__((ext_vector_type(2)));

constexpr int D = 1024, TP = 32768, TS = 2048, T = TP + TS, NCH = T / 64, NBATCH = 34;
constexpr int INC = 5632, FF = 2816;
constexpr float EPS = 1e-6f, LOG2E = 1.4426950408889634f;
constexpr size_t OFF_Y = 0, OFF_SP = (size_t)T * D, OFF_KP = OFF_SP + 131072, OFF_VP = OFF_KP + 524288, OFF_SS = OFF_VP + 524288,
                 OFF_KS = OFF_SS + 2097152, OFF_VS = OFF_KS + 1048576, OUT_TOTAL = OFF_VS + 1048576;
constexpr size_t MiB = 1u << 20;
constexpr size_t WS_MOD = 1 * MiB, WS_DEC = 2 * MiB, WS_SC = 4 * MiB, WS_WADA = 5 * MiB, WS_WIN = 17 * MiB, WS_WAB = 28 * MiB, WS_WO = 30 * MiB,
                 WS_WFI = 32 * MiB, WS_WFO = 43 * MiB, WS_H = 50 * MiB, WS_QOB = 118 * MiB, WS_KA = 186 * MiB, WS_VA = 220 * MiB, WS_GA = 254 * MiB,
                 WS_KB = 288 * MiB, WS_VB = 322 * MiB, WS_CUM = 356 * MiB, WS_SST = 424 * MiB, WS_END = 492 * MiB;
constexpr size_t WS_U = WS_H, WS_M = WS_KA, WS_HID = WS_KA, WS_X1B = WS_QOB, WS_X2B = WS_H;
constexpr size_t WS_BAR = 0, BAR_BYTES = 16384;
constexpr int LDS_BYTES = 140 * 1024, LDS_ST_OFF = 136 * 1024;

struct Params {
    const float *x_prompt, *x_sample, *c_prompt, *c_sample, *state, *cache_k, *cache_v, *w_ada, *b_ada, *norm_mix, *w_in, *lb_logits, *out_norm,
                *w_a, *rel_bias, *w_b, *w_out, *norm_ffn, *w_ffn_in, *w_ffn_out, *norm_final;
    float* out; unsigned char* ws;
};

DI int fresh_tid() { int t = threadIdx.x; asm volatile("" : "+v"(t)); return t; }
DI int launder(int v) { asm volatile("" : "+v"(v)); return v; }
DI unsigned pk2(float a, float b) { f32x2 v = {a, b}; bf2_t r = __builtin_convertvector(v, bf2_t); return __builtin_bit_cast(unsigned, r); }
DI float bflo(unsigned u) { return __uint_as_float(u << 16); }
DI float bfhi(unsigned u) { return __uint_as_float(u & 0xffff0000u); }
DI float bf2f(short s) { return __uint_as_float(((unsigned)(unsigned short)s) << 16); }
DI float sigm(float x) { return __builtin_amdgcn_rcpf(1.f + __expf(-x)); }
DI float silu(float x) { return x * sigm(x); }
DI int batch_of(int r) { return r < TP ? (r >> 14) : 2 + ((r - TP) >> 6); }
DI int crow(int reg, int h) { return (reg & 3) + 8 * (reg >> 2) + 4 * h; }
DI bf16x8 pack8(const f32x16& x, int s) {
    u32x4 p; p.x = pk2(x[8 * s], x[8 * s + 1]); p.y = pk2(x[8 * s + 2], x[8 * s + 3]); p.z = pk2(x[8 * s + 4], x[8 * s + 5]); p.w = pk2(x[8 * s + 6], x[8 * s + 7]);
    return __builtin_bit_cast(bf16x8, p);
}
DI bf16x8 pack8f(const float* v) { u32x4 p; p.x = pk2(v[0], v[1]); p.y = pk2(v[2], v[3]); p.z = pk2(v[4], v[5]); p.w = pk2(v[6], v[7]); return __builtin_bit_cast(bf16x8, p); }
DI bf16x8 ident_frag(int ks, int l31, int hf) {
    const int jj = l31 - 16 * ks - 8 * hf; bf16x8 r;
#pragma unroll
    for (int j = 0; j < 8; ++j) r[j] = (j == jj) ? (short)0x3F80 : (short)0;
    return r;
}
DI u32x4 widen_pair(u32x2 pg, u32x2 pg1) { const auto rx = __builtin_amdgcn_permlane32_swap(pg.x, pg1.x, false, false), ry = __builtin_amdgcn_permlane32_swap(pg.y, pg1.y, false, false); return (u32x4){rx[0], ry[0], rx[1], ry[1]}; }
DI void narrow_pair(u32x4 d, u32x2& pg, u32x2& pg1) { const auto rx = __builtin_amdgcn_permlane32_swap(d.x, d.z, false, false), ry = __builtin_amdgcn_permlane32_swap(d.y, d.w, false, false); pg = (u32x2){rx[0], ry[0]}; pg1 = (u32x2){rx[1], ry[1]}; }
#define MFMA32(a, b, c) __builtin_amdgcn_mfma_f32_32x32x16_bf16((a), (b), (c), 0, 0, 0)
DI f32x16 zero16() { f32x16 z;
#pragma unroll
    for (int i = 0; i < 16; ++i) z[i] = 0.f; return z; }

namespace pg8 {
constexpr int BM = 256, BK = 64, HALF = 128, HTB = HALF * BK * 2, STAGE_BYTES = 8 * HTB, NXCD = 8, WGM = 8;
__host__ __device__ __forceinline__ int lds_byte(int r, int c) { const int st = (r >> 4) * 2 + (c >> 5), rr = r & 15, cc = c & 31, ob = rr * 64 + cc * 2; return st * 1024 + (ob ^ (((ob >> 9) & 1) << 5)); }
__host__ __device__ __forceinline__ void stage_rc(int b, int& R, int& C) { const int st = b / 1024, sb = b % 1024, swz = sb ^ (((sb >> 9) & 1) << 5); R = (st >> 1) * 16 + swz / 64; C = (st & 1) * 32 + (swz % 64) / 2; }
__host__ __device__ __forceinline__ int perm32(int rho) { const int n = rho >> 4, i = rho & 15; return 8 * (i >> 2) + 4 * n + (i & 3); }
struct Unit { int pm, pn; };
struct Gemm { const bf16_t* A; const bf16_t* Bt; int M, N, K, ld; };
struct StaticOrder {
    int nM, nN, nwg, G, c, pm_off;
    __device__ void init(int M, int N, int G_, int c_, int pm_off_ = 0) { nM = M / BM; nN = N / BM; nwg = nM * nN; G = G_; c = c_; pm_off = pm_off_; }
    __device__ bool next(int i, Unit& u) const {
        const long L = (long)i * G + c; if (L >= nwg) return false;
        int wgid = (int)L; { const int q = nwg / NXCD, r = nwg % NXCD, xcd = wgid % NXCD, off = wgid / NXCD; wgid = (xcd < r ? xcd * (q + 1) : r * (q + 1) + (xcd - r) * q) + off; }
        const int nig = WGM * nN, gid = wgid / nig, fm = gid * WGM, gsz = (nM - fm) < WGM ? (nM - fm) : WGM;
        u.pm = pm_off + fm + ((wgid % nig) % gsz); u.pn = (wgid % nig) / gsz; return true;
    }
};
template <class Epi, class Sched, bool ALIGN_EPI = false, bool SP2 = false>
__device__ __forceinline__ void gemm_phase(LAS unsigned char* lds, const Gemm g, const Sched& S, const Epi& E) {
    const int tid = fresh_tid(), wid = __builtin_amdgcn_readfirstlane(tid >> 6), lane = tid & 63, wr = wid >> 2, wc = wid & 3, fr = lane & 15, fq = lane >> 4;
    const int K = g.ld ? g.ld : g.K, nt = g.K / BK;
    unsigned voffA[2], voffB[2];
#pragma unroll
    for (int i = 0; i < 2; ++i) { int R, C; stage_rc(tid * 16 + i * 8192, R, C); const int Rb = Epi::PERM ? ((R & ~31) + perm32(R & 31)) : R;
        voffA[i] = (unsigned)(R * K + C) * 2u; voffB[i] = (unsigned)(Rb * K + C) * 2u; }
    const size_t kstep = (size_t)(BK * 2);
    const size_t hstep = (size_t)HALF * K * 2;
    const size_t tstep = 2 * hstep;
    const unsigned ldsw = (unsigned)wid * 1024u;
    const int aoff = lds_byte(wr * 64 + fr, fq * 8), boff = lds_byte(wc * 32 + fr, fq * 8);
#define PG8_SA(b, h) (((b) * 2 + (h)) * HTB)
#define PG8_SB(b, h) ((4 + (b) * 2 + (h)) * HTB)
#define PG8_STAGE(bufoff, gbase, voff) do { _Pragma("unroll") for (int _i = 0; _i < 2; ++_i) \
        __builtin_amdgcn_global_load_lds((const unsigned*)((const char*)(gbase) + (voff)[_i]), (LAS unsigned*)(lds + (bufoff) + ldsw + _i * 8192), 16, 0, 0); } while (0)
#define PG8_LDA(dst, b, h) do { _Pragma("unroll") for (int m = 0; m < 4; ++m) _Pragma("unroll") for (int k = 0; k < 2; ++k) dst[m][k] = *(const LAS bf16x8*)(lds + PG8_SA(b, h) + aoff + m * 2048 + k * 1024); } while (0)
#define PG8_LDB(dst, b, h) do { _Pragma("unroll") for (int n = 0; n < 2; ++n) _Pragma("unroll") for (int k = 0; k < 2; ++k) dst[n][k] = *(const LAS bf16x8*)(lds + PG8_SB(b, h) + boff + n * 2048 + k * 1024); } while (0)
#define PG8_MMA(ai, bj, At, Bt) do { __builtin_amdgcn_s_setprio(1); _Pragma("unroll") for (int m = 0; m < 4; ++m) _Pragma("unroll") for (int n = 0; n < 2; ++n) _Pragma("unroll") for (int k = 0; k < 2; ++k) \
        acc[ai][bj][m][n] = __builtin_amdgcn_mfma_f32_16x16x32_bf16(Bt[n][k], At[m][k], acc[ai][bj][m][n], 0, 0, 0); __builtin_amdgcn_s_setprio(0); } while (0)
#define PG8_WAIT_V(n) asm volatile("s_waitcnt vmcnt(" #n ")" ::: "memory")
#define PG8_WAIT_L(n) asm volatile("s_waitcnt lgkmcnt(" #n ")" ::: "memory")
#define PG8_BAR __builtin_amdgcn_s_barrier()
#define PG8_SCHED __builtin_amdgcn_sched_barrier(0)
    Unit cur, nxt; int ui = 0;
    if (!S.next(0, cur)) return;
    f32x4 acc[2][2][4][2];
#pragma unroll
    for (int a = 0; a < 2; ++a)
#pragma unroll
        for (int b = 0; b < 2; ++b)
#pragma unroll
            for (int m = 0; m < 4; ++m)
#pragma unroll
                for (int n = 0; n < 2; ++n) acc[a][b][m][n] = (f32x4){0.f, 0.f, 0.f, 0.f};
    bf16x8 At[4][2], B0[2][2], B1[2][2];
    const char* cA = (const char*)g.A + (size_t)cur.pm * tstep; const char* cB = (const char*)g.Bt + (size_t)cur.pn * tstep;
    if constexpr (SP2) {
        PG8_STAGE(PG8_SB(0, 0), cB, voffB); PG8_STAGE(PG8_SB(0, 1), cB + hstep, voffB); PG8_STAGE(PG8_SA(0, 0), cA, voffA); PG8_STAGE(PG8_SA(0, 1), cA + hstep, voffA);
        if (wr == 1) PG8_BAR;
        PG8_WAIT_V(2); PG8_BAR;
        PG8_STAGE(PG8_SB(1, 0), cB + kstep, voffB); PG8_STAGE(PG8_SA(1, 0), cA + kstep, voffA); PG8_STAGE(PG8_SB(1, 1), cB + hstep + kstep, voffB);
        PG8_WAIT_V(6); PG8_BAR;
    } else {
        PG8_STAGE(PG8_SB(0, 0), cB, voffB); PG8_STAGE(PG8_SA(0, 0), cA, voffA); PG8_STAGE(PG8_SB(0, 1), cB + hstep, voffB); PG8_STAGE(PG8_SA(0, 1), cA + hstep, voffA);
        if (wr == 1) PG8_BAR;
        PG8_WAIT_V(4); PG8_BAR;
        PG8_STAGE(PG8_SB(1, 0), cB + kstep, voffB); PG8_STAGE(PG8_SA(1, 0), cA + kstep, voffA); PG8_STAGE(PG8_SB(1, 1), cB + hstep + kstep, voffB);
        PG8_WAIT_V(6); PG8_BAR;
    }
    for (;;) {
        const bool has_next = S.next(ui + 1, nxt);
        const char* nA = has_next ? (const char*)g.A + (size_t)nxt.pm * tstep : cA; const char* nB = has_next ? (const char*)g.Bt + (size_t)nxt.pn * tstep : cB;
        for (int t = 0; t < nt; t += 2) {
            if constexpr (Epi::MIDK) { if (t == nt / 2) E.mid(acc, cur, wr, wc, fr, fq); }
            const bool last = (t == nt - 2);
            const char* a1 = cA + (size_t)(t + 1) * kstep;
            const char* a2 = last ? nA : cA + (size_t)(t + 2) * kstep; const char* b2 = last ? nB : cB + (size_t)(t + 2) * kstep;
            const char* a3 = a2 + kstep; const char* b3 = b2 + kstep;
            if constexpr (SP2) {
            PG8_LDB(B0, 0, 0); PG8_LDB(B1, 0, 1); PG8_SCHED; PG8_LDA(At, 0, 0); PG8_STAGE(PG8_SA(1, 1), a1 + hstep, voffA);
            PG8_WAIT_V(8); PG8_WAIT_L(0); PG8_BAR; PG8_MMA(0, 0, At, B0); PG8_MMA(0, 1, At, B1); PG8_BAR; PG8_SCHED;
            PG8_LDA(At, 0, 1); PG8_STAGE(PG8_SB(0, 0), b2, voffB); PG8_STAGE(PG8_SB(0, 1), b2 + hstep, voffB); PG8_STAGE(PG8_SA(0, 0), a2, voffA);
            PG8_WAIT_V(8); PG8_WAIT_L(0); PG8_BAR; PG8_MMA(1, 0, At, B0); PG8_MMA(1, 1, At, B1); PG8_BAR; PG8_SCHED;
            PG8_LDB(B0, 1, 0); PG8_LDB(B1, 1, 1); PG8_SCHED; PG8_LDA(At, 1, 0); PG8_STAGE(PG8_SA(0, 1), a2 + hstep, voffA);
            PG8_WAIT_V(8); PG8_WAIT_L(0); PG8_BAR; PG8_MMA(0, 0, At, B0); PG8_MMA(0, 1, At, B1); PG8_BAR; PG8_SCHED;
            PG8_LDA(At, 1, 1); PG8_STAGE(PG8_SB(1, 0), b3, voffB); PG8_STAGE(PG8_SB(1, 1), b3 + hstep, voffB); PG8_STAGE(PG8_SA(1, 0), a3, voffA);
            PG8_WAIT_V(8); PG8_WAIT_L(0); PG8_BAR; PG8_MMA(1, 0, At, B0); PG8_MMA(1, 1, At, B1); PG8_BAR; PG8_SCHED;
            } else {
            PG8_LDB(B0, 0, 0); PG8_SCHED; PG8_LDA(At, 0, 0); PG8_STAGE(PG8_SA(1, 1), a1 + hstep, voffA);
            PG8_WAIT_L(8); PG8_BAR; PG8_WAIT_L(0); PG8_MMA(0, 0, At, B0); PG8_BAR; PG8_SCHED;
            PG8_LDB(B1, 0, 1); PG8_STAGE(PG8_SB(0, 0), b2, voffB);
            PG8_BAR; PG8_WAIT_L(0); PG8_MMA(0, 1, At, B1); PG8_BAR;
            PG8_LDA(At, 0, 1); PG8_STAGE(PG8_SA(0, 0), a2, voffA);
            PG8_BAR; PG8_WAIT_L(0); PG8_MMA(1, 0, At, B0); PG8_BAR; PG8_SCHED;
            PG8_STAGE(PG8_SB(0, 1), b2 + hstep, voffB);
            PG8_WAIT_V(6); PG8_BAR; PG8_MMA(1, 1, At, B1); PG8_BAR;
            PG8_LDB(B0, 1, 0); PG8_SCHED; PG8_LDA(At, 1, 0); PG8_STAGE(PG8_SA(0, 1), a2 + hstep, voffA);
            PG8_WAIT_L(8); PG8_BAR; PG8_WAIT_L(0); PG8_MMA(0, 0, At, B0); PG8_BAR; PG8_SCHED;
            PG8_LDB(B1, 1, 1); PG8_STAGE(PG8_SB(1, 0), b3, voffB);
            PG8_BAR; PG8_WAIT_L(0); PG8_MMA(0, 1, At, B1); PG8_BAR;
            PG8_LDA(At, 1, 1); PG8_STAGE(PG8_SA(1, 0), a3, voffA);
            PG8_BAR; PG8_WAIT_L(0); PG8_MMA(1, 0, At, B0); PG8_BAR; PG8_SCHED;
            PG8_STAGE(PG8_SB(1, 1), b3 + hstep, voffB);
            PG8_WAIT_V(6); PG8_BAR; PG8_MMA(1, 1, At, B1); PG8_BAR;
            }
        }
        if constexpr (ALIGN_EPI) { if (wr == 0) PG8_BAR; }
        E(acc, cur, wr, wc, fr, fq);
        if (!has_next) break;
#pragma unroll
        for (int a = 0; a < 2; ++a)
#pragma unroll
            for (int b = 0; b < 2; ++b)
#pragma unroll
                for (int m = 0; m < 4; ++m)
#pragma unroll
                    for (int n = 0; n < 2; ++n) acc[a][b][m][n] = (f32x4){0.f, 0.f, 0.f, 0.f};
        cur = nxt; cA = nA; cB = nB; ++ui;
        if constexpr (ALIGN_EPI) { if (wr == 1) PG8_BAR; }
    }
    PG8_WAIT_V(0);
    if constexpr (!ALIGN_EPI) { if (wr == 0) PG8_BAR; }
    PG8_BAR;
#undef PG8_SA
#undef PG8_SB
#undef PG8_STAGE
#undef PG8_LDA
#undef PG8_LDB
#undef PG8_MMA
#undef PG8_WAIT_V
#undef PG8_WAIT_L
#undef PG8_BAR
#undef PG8_SCHED
}
}
using pg8::Unit;
typedef f32x4 Acc[2][2][4][2];

DI u32x4 pack_row8(const f32x4& v0, const f32x4& v1) { u32x4 w; w.x = pk2(v0[0], v0[1]); w.y = pk2(v0[2], v0[3]); w.z = pk2(v1[0], v1[1]); w.w = pk2(v1[2], v1[3]); return w; }

struct EpiMod {
    static constexpr bool PERM = false, MIDK = false;
    float* mod; const float* bias;
    DI void operator()(Acc& acc, const Unit& u, int wr, int wc, int fr, int fq) const {
        { const int t_ = fresh_tid(); fr = t_ & 15; fq = (t_ >> 4) & 3; }
        if (u.pm != 0 || wr != 0) return;
#pragma unroll
        for (int m = 0; m < 3; ++m) { const int r = 16 * m + fr; if (r < NBATCH) {
#pragma unroll
            for (int bj = 0; bj < 2; ++bj)
#pragma unroll
                for (int n = 0; n < 2; ++n) { const int col = u.pn * 256 + bj * 128 + wc * 32 + n * 16 + 4 * fq;
                    *(f32x4*)(mod + (size_t)r * 6144 + col) = acc[0][bj][m][n] + *(const f32x4*)(bias + col); } } }
    }
};

struct EpiIn {
    static constexpr bool PERM = true, MIDK = false;
    bf16_t *QOB, *KA, *VA, *GA, *KB, *VB, *SGA, *SGB; float *CUM, *DEC; const float* lbl; float* out;
    DI void operator()(Acc& acc, const Unit& u, int wr, int wc, int fr, int fq) const {
        { const int t_ = fresh_tid(); fr = t_ & 15; fq = (t_ >> 4) & 3; }
        const int pn = u.pn, rt = wr * 64 + fr, row0 = u.pm * 256 + rt, cw = wc * 32 + 8 * fq, lane = fq * 16 + fr;
        if (pn >= 14) {
            const size_t o0 = ((size_t)(u.pm * 8 + (pn - 14)) * 8 * 512 + (size_t)(wr * 4 + wc) * 64 + lane) * 8;
#pragma unroll
            for (int ai = 0; ai < 2; ++ai)
#pragma unroll
                for (int m = 0; m < 4; ++m) { f32x4 r0, r1, b0, b1;
#pragma unroll
                    for (int j = 0; j < 4; ++j) { b0[j] = fmaxf(sigm(acc[ai][1][m][0][j]), 1e-30f); b1[j] = fmaxf(sigm(acc[ai][1][m][1][j]), 1e-30f);
                        r0[j] = sigm(acc[ai][0][m][0][j]) * __builtin_amdgcn_rcpf(b0[j]); r1[j] = sigm(acc[ai][0][m][1][j]) * __builtin_amdgcn_rcpf(b1[j]); }
                    const size_t o = o0 + (size_t)(ai * 4 + m) * 512 * 8;
                    *(u32x4*)(SGA + o) = pack_row8(r0, r1); *(u32x4*)(SGB + o) = pack_row8(b0, b1); __builtin_amdgcn_sched_barrier(0); }
            return;
        }
        const int seg = pn >> 1, col0 = (pn & 1) * 256 + cw;
        if (seg == 1) {
#pragma unroll
            for (int bj = 0; bj < 2; ++bj) {
                float lb[2][4];
#pragma unroll
                for (int n = 0; n < 2; ++n)
#pragma unroll
                    for (int j = 0; j < 4; ++j) { const int c = col0 + bj * 128 + 4 * n + j; lb[n][j] = __builtin_amdgcn_rcpf(1.f + __expf(lbl[512 + c] - lbl[c])); }
#pragma unroll
                for (int ai = 0; ai < 2; ++ai) {
                    const size_t rbase = ((size_t)((pn & 1) * 2 + bj) * T + (u.pm * 256 + ai * 128 + wr * 64 + launder(fr))) * 128 + cw;
#pragma unroll
                    for (int m = 0; m < 4; ++m) { f32x4 k0, k1;
#pragma unroll
                        for (int j = 0; j < 4; ++j) {
                            float f = lb[0][j] + (1.f - lb[0][j]) * sigm(acc[ai][bj][m][0][j]); k0[j] = 1.f - f; acc[ai][bj][m][0][j] = __logf(f);
                            f = lb[1][j] + (1.f - lb[1][j]) * sigm(acc[ai][bj][m][1][j]); k1[j] = 1.f - f; acc[ai][bj][m][1][j] = __logf(f); }
                        *(u32x4*)(KA + rbase + (size_t)m * 16 * 128) = pack_row8(k0, k1); }
                    __builtin_amdgcn_sched_barrier(0);
#pragma unroll
                    for (int n = 0; n < 2; ++n)
#pragma unroll
                        for (int j = 0; j < 4; ++j) { float carry = 0.f;
#pragma unroll
                            for (int m = 0; m < 4; ++m) { float v = acc[ai][bj][m][n][j];
                                v += __int_as_float(__builtin_amdgcn_update_dpp(0, __float_as_int(v), 0x111, 0xf, 0xf, false));
                                v += __int_as_float(__builtin_amdgcn_update_dpp(0, __float_as_int(v), 0x112, 0xf, 0xf, false));
                                v += __int_as_float(__builtin_amdgcn_update_dpp(0, __float_as_int(v), 0x114, 0xf, 0xf, false));
                                v += __int_as_float(__builtin_amdgcn_update_dpp(0, __float_as_int(v), 0x118, 0xf, 0xf, false));
                                v += carry; carry = __shfl(v, lane | 15); acc[ai][bj][m][n][j] = v; } }
                    __builtin_amdgcn_sched_barrier(0);
#pragma unroll
                    for (int m = 0; m < 4; ++m) { float* cp = CUM + rbase + (size_t)m * 16 * 128; *(f32x4*)cp = acc[ai][bj][m][0]; *(f32x4*)(cp + 4) = acc[ai][bj][m][1]; }
                    if (fr == 15) {
#pragma unroll
                        for (int n = 0; n < 2; ++n) { f32x4 e;
#pragma unroll
                            for (int j = 0; j < 4; ++j) e[j] = __expf(acc[ai][bj][3][n][j]);
                            *(f32x4*)(DEC + (size_t)(u.pm * 4 + ai * 2 + wr) * 512 + col0 + bj * 128 + 4 * n) = e; } }
                    __builtin_amdgcn_sched_barrier(0);
                }
            }
            return;
        }
        bf16_t* dst; int pitch = 512; size_t bjoff = 128; float* o32 = nullptr;
        switch (seg) {
            case 0: dst = QOB + col0; pitch = 1024; break;
            case 2: dst = VA + (size_t)((pn & 1) * 2) * T * 128 + cw; pitch = 128; bjoff = (size_t)T * 128; break;
            case 3: dst = GA + (size_t)((pn & 1) * 2) * T * 128 + cw; pitch = 128; bjoff = (size_t)T * 128; break;
            case 4: dst = QOB + 512 + col0; pitch = 1024; break;
            default: dst = (seg == 5 ? KB : VB) + (size_t)((pn & 1) * 4 + (wc >> 1)) * (T / 32) * 2048 + ((wc & 1) * 4 + fq) * 256; bjoff = (size_t)2 * (T / 32) * 2048; break;
        }
        if (seg >= 5) {
            if (u.pm >= 128) o32 = out + (seg == 5 ? OFF_KS : OFF_VS) + (size_t)((u.pm - 128) * 256 + rt) * 512 + col0;
            else if ((u.pm & 63) >= 62) o32 = out + (seg == 5 ? OFF_KP : OFF_VP) + (size_t)((u.pm >> 6) * 512 + ((u.pm & 63) - 62) * 256 + rt) * 512 + col0;
        }
        const bool act = (seg == 0 || seg == 3);
#pragma unroll
        for (int ai = 0; ai < 2; ++ai)
#pragma unroll
            for (int m = 0; m < 4; ++m)
#pragma unroll
                for (int bj = 0; bj < 2; ++bj) { f32x4 v0 = acc[ai][bj][m][0], v1 = acc[ai][bj][m][1];
                    if (act) {
#pragma unroll
                        for (int j = 0; j < 4; ++j) { v0[j] = silu(v0[j]); v1[j] = silu(v1[j]); } }
                    const size_t ro = seg >= 5 ? (size_t)(u.pm * 8 + 2 * wr + 4 * ai + (m >> 1)) * 2048 + ((m & 1) * 16 + fr) * 8 : (size_t)(row0 + ai * 128 + m * 16) * pitch;
                    *(u32x4*)(dst + ro + bj * bjoff) = pack_row8(v0, v1);
                    if (o32) { float* op = o32 + (size_t)(ai * 128 + m * 16) * 512 + bj * 128; *(f32x4*)op = v0; *(f32x4*)(op + 4) = v1; } __builtin_amdgcn_sched_barrier(0); }
    }
};

struct EpiMerge {
    static constexpr bool PERM = true, MIDK = true;
    const bf16_t *SGR, *SGB; bf16_t* Mo;
    DI void mid(Acc& acc, const Unit& u, int wr, int wc, int fr, int fq) const {
        { const int t_ = fresh_tid(); fr = t_ & 15; fq = (t_ >> 4) & 3; }
        const size_t gb = ((size_t)(u.pm * 8 + 2 * u.pn) * 8 * 512 + (size_t)(wr * 4 + wc) * 64 + (fq * 16 + fr)) * 8;
#pragma unroll
        for (int ai = 0; ai < 2; ++ai) { u32x4 a[4][2];
#pragma unroll
            for (int m = 0; m < 4; ++m)
#pragma unroll
                for (int bj = 0; bj < 2; ++bj) a[m][bj] = *(const u32x4*)(SGR + gb + ((size_t)bj * 8 + ai * 4 + m) * 512 * 8);
#pragma unroll
            for (int m = 0; m < 4; ++m)
#pragma unroll
                for (int bj = 0; bj < 2; ++bj)
#pragma unroll
                    for (int j = 0; j < 4; ++j) { acc[ai][bj][m][j >> 1][(j & 1) * 2] *= bflo(a[m][bj][j]); acc[ai][bj][m][j >> 1][(j & 1) * 2 + 1] *= bfhi(a[m][bj][j]); }
            __builtin_amdgcn_sched_barrier(0); }
    }
    DI void operator()(Acc& acc, const Unit& u, int wr, int wc, int fr, int fq) const {
        { const int t_ = fresh_tid(); fr = t_ & 15; fq = (t_ >> 4) & 3; }
        const size_t base = (size_t)(u.pm * 256 + wr * 64 + fr) * 1024 + u.pn * 256 + wc * 32 + 8 * fq;
        const size_t gb = ((size_t)(u.pm * 8 + 2 * u.pn) * 8 * 512 + (size_t)(wr * 4 + wc) * 64 + (fq * 16 + fr)) * 8;
#pragma unroll
        for (int ai = 0; ai < 2; ++ai) { u32x4 b[4][2];
#pragma unroll
            for (int m = 0; m < 4; ++m)
#pragma unroll
                for (int bj = 0; bj < 2; ++bj) b[m][bj] = *(const u32x4*)(SGB + gb + ((size_t)bj * 8 + ai * 4 + m) * 512 * 8);
#pragma unroll
            for (int m = 0; m < 4; ++m)
#pragma unroll
                for (int bj = 0; bj < 2; ++bj) { f32x4 v0 = acc[ai][bj][m][0], v1 = acc[ai][bj][m][1]; const u32x4 g = b[m][bj];
                    v0[0] *= bflo(g[0]); v0[1] *= bfhi(g[0]); v0[2] *= bflo(g[1]); v0[3] *= bfhi(g[1]);
                    v1[0] *= bflo(g[2]); v1[1] *= bfhi(g[2]); v1[2] *= bflo(g[3]); v1[3] *= bfhi(g[3]);
                    *(u32x4*)(Mo + base + (size_t)(ai * 128 + m * 16) * 1024 + bj * 128) = pack_row8(v0, v1); }
            __builtin_amdgcn_sched_barrier(0); }
    }
};

template <bool BASE_BF16> struct EpiRes {
    static constexpr bool PERM = true, MIDK = false;
    const float *xp, *xs; const bf16_t* xb; bf16_t* xo; const float* gmod;
    DI void operator()(Acc& acc, const Unit& u, int wr, int wc, int fr, int fq) const {
        { const int t_ = fresh_tid(); fr = t_ & 15; fq = (t_ >> 4) & 3; }
        const int colb = u.pn * 256 + wc * 32 + 8 * fq;
#pragma unroll
        for (int ai = 0; ai < 2; ++ai) { const int r0 = u.pm * 256 + ai * 128 + wr * 64 + fr;
            const float* g = gmod + (size_t)batch_of(r0) * 6144 + colb;
            f32x4 gv[2][2];
#pragma unroll
            for (int bj = 0; bj < 2; ++bj) { gv[bj][0] = *(const f32x4*)(g + bj * 128); gv[bj][1] = *(const f32x4*)(g + bj * 128 + 4); }
            bf16_t* orow = xo + (size_t)r0 * D + colb;
            if constexpr (BASE_BF16) {
                const bf16_t* xr = xb + (size_t)r0 * D + colb; u32x4 xv[4][2];
#pragma unroll
                for (int m = 0; m < 4; ++m)
#pragma unroll
                    for (int bj = 0; bj < 2; ++bj) xv[m][bj] = *(const u32x4*)(xr + (size_t)m * 16 * D + bj * 128);
#pragma unroll
                for (int m = 0; m < 4; ++m)
#pragma unroll
                    for (int bj = 0; bj < 2; ++bj) { const u32x4 x = xv[m][bj]; const f32x4 a0 = acc[ai][bj][m][0] * gv[bj][0], a1 = acc[ai][bj][m][1] * gv[bj][1];
                        f32x4 v0 = {bflo(x[0]) + a0[0], bfhi(x[0]) + a0[1], bflo(x[1]) + a0[2], bfhi(x[1]) + a0[3]}, v1 = {bflo(x[2]) + a1[0], bfhi(x[2]) + a1[1], bflo(x[3]) + a1[2], bfhi(x[3]) + a1[3]};
                        *(u32x4*)(orow + (size_t)m * 16 * D + bj * 128) = pack_row8(v0, v1); }
            } else {
                const float* xr = (r0 < TP ? xp + (size_t)r0 * D : xs + (size_t)(r0 - TP) * D) + colb; f32x4 xv[4][2][2];
#pragma unroll
                for (int m = 0; m < 4; ++m)
#pragma unroll
                    for (int bj = 0; bj < 2; ++bj) { xv[m][bj][0] = *(const f32x4*)(xr + (size_t)m * 16 * D + bj * 128); xv[m][bj][1] = *(const f32x4*)(xr + (size_t)m * 16 * D + bj * 128 + 4); }
#pragma unroll
                for (int m = 0; m < 4; ++m)
#pragma unroll
                    for (int bj = 0; bj < 2; ++bj) *(u32x4*)(orow + (size_t)m * 16 * D + bj * 128) = pack_row8(xv[m][bj][0] + gv[bj][0] * acc[ai][bj][m][0], xv[m][bj][1] + gv[bj][1] * acc[ai][bj][m][1]);
            }
            __builtin_amdgcn_sched_barrier(0); }
    }
};

struct EpiPart {
    static constexpr bool PERM = false, MIDK = false;
    float* part; int row0;
    DI void operator()(Acc& acc, const Unit& u, int wr, int wc, int fr, int fq) const {
        { const int t_ = fresh_tid(); fr = t_ & 15; fq = (t_ >> 4) & 3; }
#pragma unroll
        for (int ai = 0; ai < 2; ++ai)
#pragma unroll
            for (int m = 0; m < 4; ++m) { float* prow = part + (size_t)(u.pm * 256 + ai * 128 + wr * 64 + m * 16 + fr - row0) * D + u.pn * 256 + wc * 32 + 4 * fq;
#pragma unroll
                for (int bj = 0; bj < 2; ++bj)
#pragma unroll
                    for (int n = 0; n < 2; ++n) *(f32x4*)(prow + bj * 128 + n * 16) = acc[ai][bj][m][n];
                __builtin_amdgcn_sched_barrier(0); }
    }
};

struct EpiFfnIn {
    static constexpr bool PERM = true, MIDK = false;
    bf16_t* HID;
    DI void operator()(Acc& acc, const Unit& u, int wr, int wc, int fr, int fq) const {
        { const int t_ = fresh_tid(); fr = t_ & 15; fq = (t_ >> 4) & 3; }
        bf16_t* base = HID + (size_t)(u.pm * 256 + wr * 64 + fr) * FF + u.pn * 128 + wc * 32 + 8 * fq;
#pragma unroll
        for (int ai = 0; ai < 2; ++ai)
#pragma unroll
            for (int m = 0; m < 4; ++m) { f32x4 v0, v1;
#pragma unroll
                for (int j = 0; j < 4; ++j) { v0[j] = silu(acc[ai][0][m][0][j]) * acc[ai][1][m][0][j]; v1[j] = silu(acc[ai][0][m][1][j]) * acc[ai][1][m][1][j]; }
                *(u32x4*)(base + (size_t)(ai * 128 + m * 16) * FF) = pack_row8(v0, v1); __builtin_amdgcn_sched_barrier(0); }
    }
};

DI void transpose_item(const float* W, int N, bf16_t* WT, int pitch, int koff, int k0, int n0, int drow0, LAS float* scr, int lane) {
#pragma unroll
    for (int i = 0; i < 8; ++i) { const int kk = 8 * i + (lane >> 3), n4 = 4 * (lane & 7); const f32x4 w = *(const f32x4*)(W + (size_t)(k0 + kk) * N + n0 + n4);
        scr[kk * 33 + n4] = w[0]; scr[kk * 33 + n4 + 1] = w[1]; scr[kk * 33 + n4 + 2] = w[2]; scr[kk * 33 + n4 + 3] = w[3]; }
    asm volatile("s_waitcnt lgkmcnt(0)" ::: "memory");
    const int c = lane & 7;
#pragma unroll
    for (int j = 0; j < 4; ++j) { const int n = (lane >> 3) + 8 * j; const LAS float* s = scr + (8 * c) * 33 + n;
        u32x4 o; o.x = pk2(s[0 * 33], s[1 * 33]); o.y = pk2(s[2 * 33], s[3 * 33]); o.z = pk2(s[4 * 33], s[5 * 33]); o.w = pk2(s[6 * 33], s[7 * 33]);
        *(u32x4*)(WT + (size_t)(drow0 + n) * pitch + koff + k0 + 8 * c) = o; }
    asm volatile("s_waitcnt lgkmcnt(0)" ::: "memory");
}
DI void phase_prep(const Params& p, LAS unsigned char* lds) {
    const int tid = fresh_tid(), lane = tid & 63, wave = __builtin_amdgcn_readfirstlane(tid >> 6);
    LAS float* scr = (LAS float*)(lds + wave * 16384);
    const int gw = blockIdx.x * 8 + wave, NGW = gridDim.x * 8;
    unsigned char* ws = p.ws;
    constexpr int I_ADA = 16 * 192, I_IN = 16 * 176, I_A = 8 * 32, I_O = 16 * 32, I_FI = 16 * 176, I_FO = 44 * 32;
    constexpr int NIT = I_ADA + I_IN + 2 * I_A + I_O + I_FI + I_FO;
    for (int it = gw; it < NIT; it += NGW) {
        int r = it;
        if (r < I_ADA) { const int kb = r / 192, nb = r % 192; transpose_item(p.w_ada, 6144, (bf16_t*)(ws + WS_WADA), 1024, 0, 64 * kb, 32 * nb, 32 * nb, scr, lane); continue; } r -= I_ADA;
        if (r < I_IN) { const int kb = r / 176, nb = r % 176, n0 = 32 * nb; int dr = n0;
            if (n0 >= 3584) { const int j = n0 < 4608 ? n0 - 3584 : n0 - 4608; dr = 3584 + 256 * (j >> 7) + (j & 127) + (n0 < 4608 ? 0 : 128); }
            transpose_item(p.w_in, INC, (bf16_t*)(ws + WS_WIN), 1024, 0, 64 * kb, n0, dr, scr, lane); continue; } r -= I_IN;
        if (r < I_A) { const int kb = r / 32, nb = r % 32; transpose_item(p.w_a, 1024, (bf16_t*)(ws + WS_WAB), 1024, 0, 64 * kb, 32 * nb, 32 * nb, scr, lane); continue; } r -= I_A;
        if (r < I_A) { const int kb = r / 32, nb = r % 32; transpose_item(p.w_b, 1024, (bf16_t*)(ws + WS_WAB), 1024, 512, 64 * kb, 32 * nb, 32 * nb, scr, lane); continue; } r -= I_A;
        if (r < I_O) { const int kb = r / 32, nb = r % 32; transpose_item(p.w_out, 1024, (bf16_t*)(ws + WS_WO), 1024, 0, 64 * kb, 32 * nb, 32 * nb, scr, lane); continue; } r -= I_O;
        if (r < I_FI) { const int kb = r / 176, nb = r % 176; const int n0 = 32 * nb; const int j0 = n0 < FF ? n0 : n0 - FF;
            transpose_item(p.w_ffn_in, INC, (bf16_t*)(ws + WS_WFI), 1024, 0, 64 * kb, n0, 256 * (j0 >> 7) + (j0 & 127) + (n0 < FF ? 0 : 128), scr, lane); continue; } r -= I_FI;
        { const int kb = r / 32, nb = r % 32; transpose_item(p.w_ffn_out, 1024, (bf16_t*)(ws + WS_WFO), FF, 0, 64 * kb, 32 * nb, 32 * nb, scr, lane); }
    }
    bf16_t* SC = (bf16_t*)(ws + WS_SC);
    for (int i = blockIdx.x * 512 + tid; i < 256 * 1024 / 2; i += gridDim.x * 512) { const int row = (2 * i) >> 10, col = (2 * i) & 1023; float a = 0.f, b = 0.f;
        if (row < NBATCH) { const float* c = row < 2 ? p.c_prompt + row * D : p.c_sample + (row - 2) * D; a = silu(c[col]); b = silu(c[col + 1]); }
        ((unsigned*)SC)[i] = pk2(a, b); }
}

DI float wave_sum(float v) {
#pragma unroll
    for (int o = 1; o < 64; o <<= 1) v += __shfl_xor(v, o);
    return v;
}
DI void phase_norm_mod(const float* xp, const float* xs, const float* nw, const float* mod, int sh_off, int sc_off, bf16_t* H) {
    const int tid = fresh_tid(), lane = tid & 63, wave = __builtin_amdgcn_readfirstlane(tid >> 6);
    const int gw = blockIdx.x * 8 + wave, NGW = gridDim.x * 8;
    for (int r = gw; r < T; r += NGW) {
        const float* xr = r < TP ? xp + (size_t)r * D : xs + (size_t)(r - TP) * D; const float* mb = mod + (size_t)batch_of(r) * 6144;
        f32x4 v[4]; float s = 0.f;
#pragma unroll
        for (int j = 0; j < 4; ++j) { v[j] = *(const f32x4*)(xr + 4 * lane + 256 * j); s += (v[j][0] * v[j][0] + v[j][1] * v[j][1]) + (v[j][2] * v[j][2] + v[j][3] * v[j][3]); }
        const float rstd = __builtin_amdgcn_rsqf(wave_sum(s) * (1.f / D) + EPS);
#pragma unroll
        for (int j = 0; j < 4; ++j) { const int col = 4 * lane + 256 * j; const f32x4 w = *(const f32x4*)(nw + col), sc = *(const f32x4*)(mb + sc_off + col), sh = *(const f32x4*)(mb + sh_off + col);
            const f32x4 h = v[j] * rstd * w * (sc + 1.f) + sh; u32x2 o; o.x = pk2(h[0], h[1]); o.y = pk2(h[2], h[3]);
            *(u32x2*)(H + (size_t)r * D + col) = o; }
    }
}
DI void phase_norm_mod_b(const bf16_t* xb, const float* nw, const float* mod, int sh_off, int sc_off, bf16_t* H, int r_lo = 0, int r_hi = T, int b_lo = 0) {
    const int tid = fresh_tid(), lane = tid & 63, wave = __builtin_amdgcn_readfirstlane(tid >> 6);
    const int gw = ((int)blockIdx.x - b_lo) * 8 + wave, NGW = ((int)gridDim.x - b_lo) * 8;
    for (int r = r_lo + gw; r < r_hi; r += NGW) {
        const bf16_t* xr = xb + (size_t)r * D; const float* mb = mod + (size_t)batch_of(r) * 6144;
        float v[2][8]; float s = 0.f;
#pragma unroll
        for (int j = 0; j < 2; ++j) { const u32x4 x = *(const u32x4*)(xr + 8 * lane + 512 * j);
#pragma unroll
            for (int i = 0; i < 4; ++i) { v[j][2 * i] = bflo(x[i]); v[j][2 * i + 1] = bfhi(x[i]); s += v[j][2 * i] * v[j][2 * i] + v[j][2 * i + 1] * v[j][2 * i + 1]; } }
        const float rstd = __builtin_amdgcn_rsqf(wave_sum(s) * (1.f / D) + EPS);
#pragma unroll
        for (int j = 0; j < 2; ++j) { const int col = 8 * lane + 512 * j; f32x4 h[2];
#pragma unroll
            for (int q = 0; q < 2; ++q) { const f32x4 w = *(const f32x4*)(nw + col + 4 * q), sc = *(const f32x4*)(mb + sc_off + col + 4 * q), sh = *(const f32x4*)(mb + sh_off + col + 4 * q);
                const f32x4 x = {v[j][4 * q], v[j][4 * q + 1], v[j][4 * q + 2], v[j][4 * q + 3]}; h[q] = x * rstd * w * (sc + 1.f) + sh; }
            *(u32x4*)(H + (size_t)r * D + col) = pack_row8(h[0], h[1]); }
    }
}
DI void phase_final_norm(const bf16_t* xb, float* y, const float* nw, int r_lo = 0, int r_hi = T, int b_lo = 0) {
    const int tid = fresh_tid(), lane = tid & 63, wave = __builtin_amdgcn_readfirstlane(tid >> 6);
    const int gw = ((int)blockIdx.x - b_lo) * 8 + wave, NGW = ((int)gridDim.x - b_lo) * 8;
    for (int r = r_lo + gw; r < r_hi; r += NGW) { const bf16_t* xr = xb + (size_t)r * D; float* yr = y + (size_t)r * D;
        float v[2][8]; float s = 0.f;
#pragma unroll
        for (int j = 0; j < 2; ++j) { const u32x4 x = *(const u32x4*)(xr + 8 * lane + 512 * j);
#pragma unroll
            for (int i = 0; i < 4; ++i) { v[j][2 * i] = bflo(x[i]); v[j][2 * i + 1] = bfhi(x[i]); s += v[j][2 * i] * v[j][2 * i] + v[j][2 * i + 1] * v[j][2 * i + 1]; } }
        const float rstd = __builtin_amdgcn_rsqf(wave_sum(s) * (1.f / D) + EPS);
#pragma unroll
        for (int j = 0; j < 2; ++j) { const int col = 8 * lane + 512 * j;
#pragma unroll
            for (int q = 0; q < 2; ++q) { const f32x4 x = {v[j][4 * q], v[j][4 * q + 1], v[j][4 * q + 2], v[j][4 * q + 3]}; *(f32x4*)(yr + col + 4 * q) = x * rstd * *(const f32x4*)(nw + col + 4 * q); } }
    }
}

DI void phase_final_norm_parts(const bf16_t* x1b, const float* part0, const float* part1, const float* g2mod, float* y, const float* nw) {
    const int tid = fresh_tid(), lane = tid & 63, wave = __builtin_amdgcn_readfirstlane(tid >> 6);
    const int gw = blockIdx.x * 8 + wave, NGW = gridDim.x * 8;
    for (int r = TP + gw; r < T; r += NGW) { const float* gb = g2mod + (size_t)batch_of(r) * 6144; const size_t po = (size_t)(r - TP) * D;
        f32x4 v[4]; float s = 0.f;
#pragma unroll
        for (int j = 0; j < 4; ++j) { const int col = 4 * lane + 256 * j; const u32x2 xb = *(const u32x2*)(x1b + (size_t)r * D + col);
            const f32x4 x = {bflo(xb.x), bfhi(xb.x), bflo(xb.y), bfhi(xb.y)};
            v[j] = x + *(const f32x4*)(gb + col) * (*(const f32x4*)(part0 + po + col) + *(const f32x4*)(part1 + po + col));
            s += (v[j][0] * v[j][0] + v[j][1] * v[j][1]) + (v[j][2] * v[j][2] + v[j][3] * v[j][3]); }
        const float rstd = __builtin_amdgcn_rsqf(wave_sum(s) * (1.f / D) + EPS);
#pragma unroll
        for (int j = 0; j < 4; ++j) { const int col = 4 * lane + 256 * j; *(f32x4*)(y + (size_t)r * D + col) = v[j] * rstd * *(const f32x4*)(nw + col); }
    }
}

DI void hgrn_u_item(const Params& p, int item, int lane) {
    const int c = item >> 4, rem = item & 15, h = rem >> 2, kt = rem & 3, l31 = lane & 31, hf = lane >> 5;
    const float* CUM = (const float*)(p.ws + WS_CUM); const bf16_t* KA = (const bf16_t*)(p.ws + WS_KA); const bf16_t* VA = (const bf16_t*)(p.ws + WS_VA); bf16_t* U = (bf16_t*)(p.ws + WS_U);
    const size_t hb = (size_t)h * T * 128; const int kcol = 32 * kt + l31;
    const float tot = CUM[hb + (size_t)(c * 64 + 63) * 128 + kcol];
    bf16x8 kdf[2][2];
#pragma unroll
    for (int st = 0; st < 2; ++st) { f32x16 kd;
#pragma unroll
        for (int r = 0; r < 16; ++r) { const size_t idx = hb + (size_t)(c * 64 + 32 * st + crow(r, hf)) * 128 + kcol; kd[r] = bf2f((short)KA[idx]) * __expf(tot - CUM[idx]); }
        kdf[st][0] = pack8(kd, 0); kdf[st][1] = pack8(kd, 1); }
    const bf16x8 id0 = ident_frag(0, l31, hf), id1 = ident_frag(1, l31, hf);
#pragma unroll
    for (int vt = 0; vt < 4; ++vt) { f32x16 dacc = zero16();
#pragma unroll
        for (int st = 0; st < 2; ++st) { const bf16_t* vp = VA + hb + (size_t)(c * 64 + 32 * st + l31) * 128 + 32 * vt + 8 * hf;
            f32x16 vx = zero16(); vx = MFMA32(*(const bf16x8*)vp, id0, vx); vx = MFMA32(*(const bf16x8*)(vp + 16), id1, vx);
            dacc = MFMA32(kdf[st][0], pack8(vx, 0), dacc); dacc = MFMA32(kdf[st][1], pack8(vx, 1), dacc); }
        bf16_t* up = U + ((size_t)(c * 4 + h) * 128 + 32 * vt + l31) * 128 + 32 * kt + 8 * hf;
#pragma unroll
        for (int g = 0; g < 4; g += 2) { u32x2 o0, o1; o0.x = pk2(dacc[4 * g], dacc[4 * g + 1]); o0.y = pk2(dacc[4 * g + 2], dacc[4 * g + 3]); o1.x = pk2(dacc[4 * g + 4], dacc[4 * g + 5]); o1.y = pk2(dacc[4 * g + 6], dacc[4 * g + 7]);
            *(u32x4*)(up + 8 * g) = widen_pair(o0, o1); }
    }
}

DI void scan_prompt_item(const Params& p, int item, int lane) {
    const int bh = item >> 5, vq = item & 31, b = bh >> 2, h = bh & 3, kg = lane & 31, vv = lane >> 5;
    const float* __restrict__ DEC = (const float*)(p.ws + WS_DEC); const bf16_t* __restrict__ U = (const bf16_t*)(p.ws + WS_U); bf16_t* __restrict__ SST = (bf16_t*)(p.ws + WS_SST);
    f32x4 S0 = {0.f, 0.f, 0.f, 0.f}, S1 = {0.f, 0.f, 0.f, 0.f};
    const int v0 = 4 * vq + vv, v1 = v0 + 2;
#pragma unroll 16
    for (int n = 0; n < 256; ++n) { const int c = b * 256 + n;
        const f32x4 d = *(const f32x4*)(DEC + (size_t)c * 512 + h * 128 + 4 * kg);
        const size_t o0 = ((size_t)(c * 4 + h) * 128 + v0) * 128 + 4 * kg, o1 = ((size_t)(c * 4 + h) * 128 + v1) * 128 + 4 * kg;
        const u32x2 u0 = *(const u32x2*)(U + o0), u1 = *(const u32x2*)(U + o1);
        u32x2 s; s.x = pk2(S0[0], S0[1]); s.y = pk2(S0[2], S0[3]); *(u32x2*)(SST + o0) = s;
        s.x = pk2(S1[0], S1[1]); s.y = pk2(S1[2], S1[3]); *(u32x2*)(SST + o1) = s;
        S0[0] = d[0] * S0[0] + bflo(u0.x); S0[1] = d[1] * S0[1] + bfhi(u0.x); S0[2] = d[2] * S0[2] + bflo(u0.y); S0[3] = d[3] * S0[3] + bfhi(u0.y);
        S1[0] = d[0] * S1[0] + bflo(u1.x); S1[1] = d[1] * S1[1] + bfhi(u1.x); S1[2] = d[2] * S1[2] + bflo(u1.y); S1[3] = d[3] * S1[3] + bfhi(u1.y);
    }
    float* sp = p.out + OFF_SP + ((size_t)bh * 128 + 4 * kg) * 128;
#pragma unroll
    for (int i = 0; i < 4; ++i) { sp[(size_t)i * 128 + v0] = S0[i]; sp[(size_t)i * 128 + v1] = S1[i]; }
}
DI void scan_sample_item(const Params& p, int item, int lane) {
    const int bh = item >> 5, vq = item & 31, bs = bh >> 2, h = bh & 3, kg = lane & 31, vv = lane >> 5, c = 512 + bs;
    const float* DEC = (const float*)(p.ws + WS_DEC); const bf16_t* U = (const bf16_t*)(p.ws + WS_U); bf16_t* SST = (bf16_t*)(p.ws + WS_SST);
    const f32x4 d = *(const f32x4*)(DEC + (size_t)c * 512 + h * 128 + 4 * kg);
    const float* s0 = p.state + ((size_t)bh * 128 + 4 * kg) * 128; float* so = p.out + OFF_SS + ((size_t)bh * 128 + 4 * kg) * 128;
#pragma unroll
    for (int e = 0; e < 2; ++e) { const int v = 4 * vq + 2 * e + vv; const size_t o = ((size_t)(c * 4 + h) * 128 + v) * 128 + 4 * kg;
        const u32x2 u = *(const u32x2*)(U + o); f32x4 S;
#pragma unroll
        for (int i = 0; i < 4; ++i) S[i] = s0[(size_t)i * 128 + v];
        u32x2 s; s.x = pk2(S[0], S[1]); s.y = pk2(S[2], S[3]); *(u32x2*)(SST + o) = s;
        so[v] = d[0] * S[0] + bflo(u.x); so[128 + v] = d[1] * S[1] + bfhi(u.x); so[256 + v] = d[2] * S[2] + bflo(u.y); so[384 + v] = d[3] * S[3] + bfhi(u.y); }
}

DI void attn_item(const Params& p, int item, int lane, const LAS float* biasl) {
    const int c = item >> 3, h = item & 7, l31 = lane & 31, hf = lane >> 5;
    const bf16_t* KB = (const bf16_t*)(p.ws + WS_KB); const bf16_t* VB = (const bf16_t*)(p.ws + WS_VB);
    bf16x8 qf[2][4];
    { const bf16_t* qptr = (const bf16_t*)(p.ws + WS_QOB) + (size_t)(c * 64 + l31) * 1024 + 512 + h * 64;
#pragma unroll
    for (int qq = 0; qq < 2; ++qq)
#pragma unroll
        for (int ks = 0; ks < 4; ++ks) qf[qq][ks] = *(const bf16x8*)(qptr + (size_t)qq * 32 * 1024 + 16 * ks + 8 * hf); }
    const LAS float* bl = biasl + h * 192;
    f32x16 OT[2][2]; float mrun[2], lsum[2];
#pragma unroll
    for (int qq = 0; qq < 2; ++qq) { OT[qq][0] = zero16(); OT[qq][1] = zero16(); mrun[qq] = -1e30f; lsum[qq] = 0.f; }
    int ntile, ncache, db0, krow_first;
    if (c < 512) { const int n = c & 255, j0 = n < 8 ? n : 8; ntile = 2 * (j0 + 1); ncache = 0; db0 = 64 * j0; krow_first = (c - j0) * 64; }
    else { ntile = 18; ncache = 16; db0 = 512; krow_first = c * 64 - 512; }
    const int bs = c - 512;
    u32x4 nk[4], nv[4];
#define ATT_LOAD(i_) do { if ((i_) >= ncache) { const size_t ro_ = (((size_t)h * (T / 32) + (size_t)((krow_first >> 5) + (i_))) * 8 + hf) * 256 + l31 * 8;     \
            _Pragma("unroll") for (int ks = 0; ks < 4; ++ks) { nk[ks] = *(const u32x4*)(KB + ro_ + 512 * ks); nv[ks] = *(const u32x4*)(VB + ro_ + 512 * ks); } } } while (0)
    ATT_LOAD(0);
    for (int i = 0; i < ntile; ++i) {
        bf16x8 kf[4], vf[2][2];
        if (i < ncache) {
            const float* kp_ = p.cache_k + ((size_t)(bs * 512 + 32 * i + l31) * 8 + h) * 64 + 8 * hf; const float* vp_ = p.cache_v + ((size_t)(bs * 512 + 32 * i + l31) * 8 + h) * 64 + 8 * hf;
#pragma unroll
            for (int ks = 0; ks < 4; ++ks) { u32x4 w; const f32x4 a = *(const f32x4*)(kp_ + 16 * ks), b = *(const f32x4*)(kp_ + 16 * ks + 4), e = *(const f32x4*)(vp_ + 16 * ks), f = *(const f32x4*)(vp_ + 16 * ks + 4);
                w.x = pk2(a[0], a[1]); w.y = pk2(a[2], a[3]); w.z = pk2(b[0], b[1]); w.w = pk2(b[2], b[3]); kf[ks] = __builtin_bit_cast(bf16x8, w);
                w.x = pk2(e[0], e[1]); w.y = pk2(e[2], e[3]); w.z = pk2(f[0], f[1]); w.w = pk2(f[2], f[3]); vf[ks >> 1][ks & 1] = __builtin_bit_cast(bf16x8, w); }
        } else {
#pragma unroll
            for (int ks = 0; ks < 4; ++ks) { kf[ks] = __builtin_bit_cast(bf16x8, nk[ks]); vf[ks >> 1][ks & 1] = __builtin_bit_cast(bf16x8, nv[ks]); }
        }
        if (i + 1 < ntile) ATT_LOAD(i + 1);
        asm volatile("" ::: "memory");
        bf16x8 vxf[2][2];
        const int l31b = launder(l31); const bf16x8 id0 = ident_frag(0, l31b, hf), id1 = ident_frag(1, l31b, hf);
#pragma unroll
        for (int dt = 0; dt < 2; ++dt) { f32x16 vx = zero16(); vx = MFMA32(vf[dt][0], id0, vx); vx = MFMA32(vf[dt][1], id1, vx); vxf[dt][0] = pack8(vx, 0); vxf[dt][1] = pack8(vx, 1); }
#pragma unroll
        for (int qq = 0; qq < 2; ++qq) {
            f32x16 st = zero16();
#pragma unroll
            for (int ks = 0; ks < 4; ++ks) st = MFMA32(kf[ks], qf[qq][ks], st);
            const int dq = db0 + 32 * qq - 32 * i; float mt = -1e30f;
            if (dq - 31 >= 128) { const float bc = bl[191];
#pragma unroll
                for (int r = 0; r < 16; ++r) { const float s = st[r] * (0.125f * LOG2E) + bc; st[r] = s; mt = fmaxf(mt, s); }
            } else { const int dbase = dq + l31;
#pragma unroll
                for (int r = 0; r < 16; ++r) { int dist = dbase - crow(r, hf); dist = dist > 128 ? 128 : dist; const float s = st[r] * (0.125f * LOG2E) + bl[dist + 63]; st[r] = s; mt = fmaxf(mt, s); }
            }
            mt = fmaxf(mt, __shfl_xor(mt, 32));
            const float mnew = fmaxf(mrun[qq], mt), alpha = __builtin_amdgcn_exp2f(mrun[qq] - mnew); mrun[qq] = mnew;
            float ps = 0.f;
#pragma unroll
            for (int r = 0; r < 16; ++r) { st[r] = __builtin_amdgcn_exp2f(st[r] - mnew); ps += st[r]; }
            lsum[qq] = lsum[qq] * alpha + ps;
#pragma unroll
            for (int r = 0; r < 16; ++r) { OT[qq][0][r] *= alpha; OT[qq][1][r] *= alpha; }
            const bf16x8 pf0 = pack8(st, 0), pf1 = pack8(st, 1);
            OT[qq][0] = MFMA32(vxf[0][0], pf0, OT[qq][0]); OT[qq][0] = MFMA32(vxf[0][1], pf1, OT[qq][0]);
            OT[qq][1] = MFMA32(vxf[1][0], pf0, OT[qq][1]); OT[qq][1] = MFMA32(vxf[1][1], pf1, OT[qq][1]);
        }
    }
#undef ATT_LOAD
    bf16_t* qptr = (bf16_t*)(p.ws + WS_QOB) + (size_t)(c * 64 + launder(l31)) * 1024 + 512 + h * 64;
#pragma unroll
    for (int qq = 0; qq < 2; ++qq) { const float l = lsum[qq] + __shfl_xor(lsum[qq], 32), inv = 1.f / l; bf16_t* op = qptr + (size_t)qq * 32 * 1024;
#pragma unroll
        for (int dt = 0; dt < 2; ++dt)
#pragma unroll
            for (int g = 0; g < 4; g += 2) { u32x2 o0, o1; o0.x = pk2(OT[qq][dt][4 * g] * inv, OT[qq][dt][4 * g + 1] * inv); o0.y = pk2(OT[qq][dt][4 * g + 2] * inv, OT[qq][dt][4 * g + 3] * inv);
                o1.x = pk2(OT[qq][dt][4 * g + 4] * inv, OT[qq][dt][4 * g + 5] * inv); o1.y = pk2(OT[qq][dt][4 * g + 6] * inv, OT[qq][dt][4 * g + 7] * inv);
                *(u32x4*)(op + 32 * dt + 8 * (g + hf)) = widen_pair(o0, o1); } }
}

DI void hgrn_out_item(const Params& p, int item, int lane, bf16_t* obase = nullptr) {
    const int c = item >> 3, h = (item >> 1) & 3, tt = item & 1, l31 = lane & 31, hf = lane >> 5;
    const float* CUM = (const float*)(p.ws + WS_CUM); const bf16_t* KA = (const bf16_t*)(p.ws + WS_KA); const bf16_t* VA = (const bf16_t*)(p.ws + WS_VA);
    const bf16_t* GA = (const bf16_t*)(p.ws + WS_GA); const bf16_t* SST = (const bf16_t*)(p.ws + WS_SST);
    const int trow = c * 64 + 32 * tt + l31;
    bf16_t* qap = (bf16_t*)(p.ws + WS_QOB) + (size_t)trow * 1024 + h * 128;
    const size_t hb = (size_t)h * T * 128;
    const float* cumt = CUM + hb + (size_t)trow * 128; const float* refp = CUM + hb + (size_t)(c * 64 + 32) * 128;
    bf16x8 qd1[8], qd2[8], kdt[8];
    const bf16_t* kat = KA + hb + (size_t)trow * 128;
#pragma unroll
    for (int ks = 0; ks < 8; ++ks) { const int k0 = 16 * ks + 8 * hf; const bf16x8 q8 = *(const bf16x8*)(qap + k0), k8 = *(const bf16x8*)(kat + k0);
        const f32x4 c0 = *(const f32x4*)(cumt + k0), c1 = *(const f32x4*)(cumt + k0 + 4), r0 = *(const f32x4*)(refp + k0), r1 = *(const f32x4*)(refp + k0 + 4);
        float a[8], b[8], d[8];
#pragma unroll
        for (int j = 0; j < 8; ++j) { const float q = bf2f(q8[j]), cu = j < 4 ? c0[j & 3] : c1[j & 3], rf = j < 4 ? r0[j & 3] : r1[j & 3]; a[j] = q * __expf(cu - rf); b[j] = q * __expf(cu); d[j] = bf2f(k8[j]) * __expf(rf - cu); }
        qd1[ks] = pack8f(a); qd2[ks] = pack8f(b); kdt[ks] = pack8f(d); }
    f32x16 OT[4];
#pragma unroll
    for (int vt = 0; vt < 4; ++vt) OT[vt] = zero16();
    const bf16_t* sp = SST + ((size_t)(c * 4 + h) * 128 + l31) * 128 + 8 * hf;
#pragma unroll
    for (int vt = 0; vt < 4; ++vt) {
#pragma unroll
        for (int ks = 0; ks < 8; ++ks) OT[vt] = MFMA32(*(const bf16x8*)(sp + (size_t)vt * 32 * 128 + 16 * ks), qd2[ks], OT[vt]);
        __builtin_amdgcn_sched_barrier(0); }
    const bf16x8 id0 = ident_frag(0, l31, hf), id1 = ident_frag(1, l31, hf);
    for (int st = 0; st <= tt; ++st) {
        const int srow = c * 64 + 32 * st + l31; const bf16_t* kap = KA + hb + (size_t)srow * 128; const float* cums = CUM + hb + (size_t)srow * 128;
        f32x16 X = zero16();
        if (st == tt) {
#pragma unroll
            for (int ks = 0; ks < 8; ++ks) X = MFMA32(kdt[ks], qd1[ks], X);
        } else
#pragma unroll
        for (int ks = 0; ks < 8; ++ks) { const int k0 = 16 * ks + 8 * hf; const bf16x8 k8 = *(const bf16x8*)(kap + k0);
            const f32x4 c0 = *(const f32x4*)(cums + k0), c1 = *(const f32x4*)(cums + k0 + 4), r0 = *(const f32x4*)(refp + k0), r1 = *(const f32x4*)(refp + k0 + 4);
            float a[8];
#pragma unroll
            for (int j = 0; j < 8; ++j) { const float cu = j < 4 ? c0[j & 3] : c1[j & 3], rf = j < 4 ? r0[j & 3] : r1[j & 3]; a[j] = bf2f(k8[j]) * __expf(rf - cu); }
            X = MFMA32(pack8f(a), qd1[ks], X); }
        if (st == tt) {
#pragma unroll
            for (int r = 0; r < 16; ++r) if (crow(r, hf) > l31) X[r] = 0.f; }
        const bf16x8 xf0 = pack8(X, 0), xf1 = pack8(X, 1);
        const bf16_t* vp = VA + hb + (size_t)srow * 128 + 8 * hf;
#pragma unroll
        for (int vt = 0; vt < 4; ++vt) { f32x16 vx = zero16(); vx = MFMA32(*(const bf16x8*)(vp + 32 * vt), id0, vx); vx = MFMA32(*(const bf16x8*)(vp + 32 * vt + 16), id1, vx);
            OT[vt] = MFMA32(pack8(vx, 0), xf0, OT[vt]); OT[vt] = MFMA32(pack8(vx, 1), xf1, OT[vt]); }
    }
    float ss = 0.f;
#pragma unroll
    for (int vt = 0; vt < 4; ++vt)
#pragma unroll
        for (int r = 0; r < 16; ++r) ss += OT[vt][r] * OT[vt][r];
    ss += __shfl_xor(ss, 32);
    const float rstd = __builtin_amdgcn_rsqf(ss * (1.f / 128.f) + EPS);
    const bf16_t* gap = GA + hb + (size_t)trow * 128; const float* onp = p.out_norm + h * 128;
    if (obase) qap = obase + (size_t)trow * 512 + h * 128;
#pragma unroll
    for (int vt = 0; vt < 4; ++vt)
#pragma unroll
        for (int g = 0; g < 4; g += 2) { u32x2 ga0, ga1; narrow_pair(*(const u32x4*)(gap + 32 * vt + 8 * (g + hf)), ga0, ga1);
            u32x2 o0, o1;
            { const int v0 = 32 * vt + 8 * g + 4 * hf; const f32x4 on = *(const f32x4*)(onp + v0);
              o0.x = pk2(OT[vt][4 * g] * rstd * on[0] * bflo(ga0.x), OT[vt][4 * g + 1] * rstd * on[1] * bfhi(ga0.x)); o0.y = pk2(OT[vt][4 * g + 2] * rstd * on[2] * bflo(ga0.y), OT[vt][4 * g + 3] * rstd * on[3] * bfhi(ga0.y)); }
            { const int v0 = 32 * vt + 8 * (g + 1) + 4 * hf; const f32x4 on = *(const f32x4*)(onp + v0);
              o1.x = pk2(OT[vt][4 * g + 4] * rstd * on[0] * bflo(ga1.x), OT[vt][4 * g + 5] * rstd * on[1] * bfhi(ga1.x)); o1.y = pk2(OT[vt][4 * g + 6] * rstd * on[2] * bflo(ga1.y), OT[vt][4 * g + 7] * rstd * on[3] * bfhi(ga1.y)); }
            *(u32x4*)(qap + 32 * vt + 8 * (g + hf)) = widen_pair(o0, o1); }
}


#define XB_TMO      128
#define XB_XCNT(j)  (256  + 64 * (j))
#define XB_XSUB(j)  (1280 + 64 * (j))
#define XB_XGEN(j)  (2304 + 64 * (j))
#define XB_TOP      3328
#define XB_TOPGEN   3392
#define XCD_BAR_WORDS 3456
#define XB_SPIN_CAP (1u << 18)
DI unsigned xb_ld(unsigned* p)              { return __hip_atomic_load(p, __ATOMIC_RELAXED, __HIP_MEMORY_SCOPE_AGENT); }
DI unsigned xb_add(unsigned* p, unsigned v) { return __hip_atomic_fetch_add(p, v, __ATOMIC_RELAXED, __HIP_MEMORY_SCOPE_AGENT); }
DI unsigned xb_xcc_id() { return (unsigned)__builtin_amdgcn_s_getreg((3 << 11) | 20) & 0xFu; }
#define XB_SPIN(cond, bar) do { unsigned _sp = 0; while (cond) { __builtin_amdgcn_s_sleep(1); \
    if ((++_sp & 255u) == 0u) { if (xb_ld(&(bar)[XB_TMO])) break; if (_sp > XB_SPIN_CAP) { atomicAdd(&(bar)[XB_TMO], 1u); break; } } } } while (0)
struct XcdBarrier { unsigned* bar; unsigned x; volatile LAS unsigned* st; };
DI XcdBarrier xcd_barrier_post(unsigned* bar, volatile LAS unsigned* st) {
    XcdBarrier b; b.bar = bar; b.x = xb_xcc_id(); b.st = st;
    if (threadIdx.x == 0) (void)xb_add(&bar[XB_XCNT(b.x)], 1u);
    return b;
}
DI void xcd_barrier_complete(unsigned* bar, unsigned x, unsigned& nloc, unsigned& nx) {
    const unsigned G = gridDim.x * gridDim.y * gridDim.z;
    unsigned sum, cnt, mine, sp = 0u;
    for (;;) {
        sum = 0u; cnt = 0u; mine = 0u;
#pragma unroll
        for (unsigned j = 0; j < 16; ++j) { const unsigned c = xb_ld(&bar[XB_XCNT(j)]); sum += c; cnt += (c > 0u) ? 1u : 0u; mine = (j == x) ? c : mine; }
        if (sum == G) break;
        __builtin_amdgcn_s_sleep(1);
        if ((++sp & 255u) == 0u) { if (xb_ld(&bar[XB_TMO])) break; if (sp > XB_SPIN_CAP) { atomicAdd(&bar[XB_TMO], 1u); break; } }
    }
    nloc = mine > 0u ? mine : 1u; nx = cnt > 0u ? cnt : 1u;
}
DI void xcd_barrier(const XcdBarrier& b) {
    asm volatile("s_waitcnt vmcnt(0)" ::: "memory");
    __syncthreads();
    if (threadIdx.x == 0) {
        unsigned* bar = b.bar;
        __builtin_amdgcn_s_waitcnt(0);
        unsigned nloc = b.st[0], nx = b.st[1];
        if (nloc == 0u) { xcd_barrier_complete(bar, b.x, nloc, nx); b.st[0] = nloc; b.st[1] = nx; }
        const unsigned old = xb_add(&bar[XB_XSUB(b.x)], 1u);
        const unsigned gen = old / nloc;
        if (old + 1u == (gen + 1u) * nloc) {
            __builtin_amdgcn_fence(__ATOMIC_RELEASE, "agent");
            asm volatile("s_waitcnt vmcnt(0)" ::: "memory");
            const unsigned og = xb_add(&bar[XB_TOP], 1u);
            const unsigned tg = og / nx;
            if (og + 1u == (tg + 1u) * nx) xb_add(&bar[XB_TOPGEN], 1u);
            else XB_SPIN(xb_ld(&bar[XB_TOPGEN]) == tg, bar);
            __builtin_amdgcn_fence(__ATOMIC_ACQUIRE, "agent");
            xb_add(&bar[XB_XGEN(b.x)], 1u);
            asm volatile("s_waitcnt vmcnt(0)" ::: "memory");
        } else {
            XB_SPIN(xb_ld(&bar[XB_XGEN(b.x)]) == gen, bar);
            __builtin_amdgcn_fence(__ATOMIC_ACQUIRE, "agent");
            asm volatile("s_waitcnt vmcnt(0)" ::: "memory");
        }
    }
    __syncthreads();
}

__global__ void __launch_bounds__(512, 2) fwd_megakernel(Params p) {
    extern __shared__ __attribute__((aligned(16))) unsigned char lds_raw[];
    LAS unsigned char* lds = (LAS unsigned char*)lds_raw;
    cg::grid_group grid = cg::this_grid();
    const int G = gridDim.x, bx = blockIdx.x;
    volatile LAS unsigned* bst = (volatile LAS unsigned*)(lds + LDS_ST_OFF);
    if (threadIdx.x < 2) bst[threadIdx.x] = 0u;
    __syncthreads();
    const XcdBarrier xbar = xcd_barrier_post((unsigned*)(p.ws + WS_BAR), bst);
    if (threadIdx.x == 0) bst[2] = xb_add((unsigned*)(p.ws + WS_BAR) + 3712 + xbar.x, 1u);
#define GRID_BAR() xcd_barrier(xbar)
    unsigned char* ws = p.ws;
    float* MOD = (float*)(ws + WS_MOD); bf16_t* H = (bf16_t*)(ws + WS_H);

    phase_prep(p, lds);
    grid.sync();
    { pg8::Gemm g{(const bf16_t*)(ws + WS_SC), (const bf16_t*)(ws + WS_WADA), 256, 6144, 1024}; pg8::StaticOrder S; S.init(256, 6144, G, bx);
      EpiMod E{MOD, p.b_ada}; pg8::gemm_phase<EpiMod, pg8::StaticOrder, true, true>(lds, g, S, E); }
    GRID_BAR();
    int cv = bx;
    { unsigned* barw = (unsigned*)(p.ws + WS_BAR); bool uni = (G & 7) == 0;
#pragma unroll
      for (int j = 0; j < 16; ++j) { const unsigned c = xb_ld(&barw[XB_XCNT(j)]); uni = uni && (j < 8 ? c == (unsigned)(G >> 3) : c == 0u); }
      if (uni) cv = (int)xbar.x + 8 * (int)bst[2];
      cv = __builtin_amdgcn_readfirstlane(cv); }
    phase_norm_mod(p.x_prompt, p.x_sample, p.norm_mix, MOD, 0, 1024, H);
#if PROBE_DUP == 1
    GRID_BAR(); phase_norm_mod(p.x_prompt, p.x_sample, p.norm_mix, MOD, 0, 1024, H);
#endif
#if PROBE_DUP == 10
    GRID_BAR(); GRID_BAR(); GRID_BAR(); GRID_BAR(); GRID_BAR(); GRID_BAR(); GRID_BAR(); GRID_BAR(); GRID_BAR(); GRID_BAR();
#endif
    GRID_BAR();
    { pg8::Gemm g{H, (const bf16_t*)(ws + WS_WIN), T, INC, 1024}; pg8::StaticOrder S; S.init(T, INC, G, cv);
      EpiIn E{(bf16_t*)(ws + WS_QOB), (bf16_t*)(ws + WS_KA), (bf16_t*)(ws + WS_VA), (bf16_t*)(ws + WS_GA), (bf16_t*)(ws + WS_KB), (bf16_t*)(ws + WS_VB),
              (bf16_t*)(p.out), (bf16_t*)(p.out) + (size_t)T * 1024, (float*)(ws + WS_CUM), (float*)(ws + WS_DEC), p.lb_logits, p.out};
      pg8::gemm_phase<EpiIn, pg8::StaticOrder, true, true>(lds, g, S, E);
#if PROBE_DUP == 2
      GRID_BAR(); pg8::gemm_phase<EpiIn, pg8::StaticOrder, true, true>(lds, g, S, E);
#endif
    }
    GRID_BAR();
    { const int tid = fresh_tid(), lane = tid & 63, wave = __builtin_amdgcn_readfirstlane(tid >> 6);
      for (int it = wave * G + bx; it < NCH * 16; it += 8 * G) hgrn_u_item(p, it, lane);
#if PROBE_DUP == 3
      for (int it = wave * G + bx; it < NCH * 16; it += 8 * G) hgrn_u_item(p, it, lane);
#endif
    }
    GRID_BAR();
    {
        const int tid = fresh_tid(), lane = tid & 63, wave = __builtin_amdgcn_readfirstlane(tid >> 6);
        LAS float* biasl = (LAS float*)lds;
        for (int i = tid; i < 8 * 192; i += 512) biasl[i] = p.rel_bias[i] * LOG2E;
        __syncthreads();
#if PROBE_DUP == 41
        if (wave == 0) { for (int it = bx; it < 256; it += G) scan_prompt_item(p, it, lane); }
        GRID_BAR();
#endif
        if (wave == 0) { for (int it = bx; it < 256; it += G) scan_prompt_item(p, it, lane); }
        else {
            const int gw = (wave - 1) * G + bx, NGW = 7 * G;
            for (int it = gw; it < 4096; it += NGW) scan_sample_item(p, it, lane);
            const int x = __builtin_amdgcn_readfirstlane((int)xbar.x), ncu = __builtin_amdgcn_readfirstlane((int)bst[0]), nxcc = __builtin_amdgcn_readfirstlane((int)bst[1]), j = __builtin_amdgcn_readfirstlane((int)bst[2]);
            if (nxcc == 8 && x < 8 && ncu > 0 && j < ncu) {
                const int nslot = 7 * ncu, slot = (wave - 1) * ncu + j;
                for (int idx = slot; idx < 68 * 8; idx += nslot) { const int cc = idx >> 3, c = cc < 4 ? 512 + 4 * x + cc : 64 * x + (cc - 4); attn_item(p, c * 8 + (idx & 7), lane, biasl); }
            } else for (int it = gw; it < NCH * 8; it += NGW) attn_item(p, it, lane, biasl);
        }
    }
    GRID_BAR();
    { const int tid = fresh_tid(), lane = tid & 63, wave = __builtin_amdgcn_readfirstlane(tid >> 6);
#if PROBE_DUP == 5
      for (int it = wave * G + bx; it < NCH * 8; it += 8 * G) hgrn_out_item(p, it, lane, (bf16_t*)(ws + WS_U));
      GRID_BAR();
#endif
      for (int it = wave * G + bx; it < NCH * 8; it += 8 * G) hgrn_out_item(p, it, lane); }
    GRID_BAR();
    { pg8::Gemm g{(const bf16_t*)(ws + WS_QOB), (const bf16_t*)(ws + WS_WAB), T, 1024, 1024}; pg8::StaticOrder S; S.init(T, 1024, G, cv);
      EpiMerge E{(const bf16_t*)(p.out), (const bf16_t*)(p.out) + (size_t)T * 1024, (bf16_t*)(ws + WS_M)};
      pg8::gemm_phase<EpiMerge, pg8::StaticOrder, true, true>(lds, g, S, E); }
    GRID_BAR();
    const bool split_ps = G >= 64;
    { pg8::Gemm g{(const bf16_t*)(ws + WS_M), (const bf16_t*)(ws + WS_WO), T, 1024, 1024}; EpiRes<false> E{p.x_prompt, p.x_sample, nullptr, (bf16_t*)(ws + WS_X1B), MOD + 2048};
      if (split_ps) {
        { pg8::StaticOrder S; S.init(TP, 1024, G, cv); pg8::gemm_phase<EpiRes<false>, pg8::StaticOrder, true, true>(lds, g, S, E); }
        GRID_BAR();
        if (bx < 32) { pg8::StaticOrder S; S.init(TS, 1024, 32, bx, TP / 256); pg8::gemm_phase<EpiRes<false>, pg8::StaticOrder, true, true>(lds, g, S, E); }
        else phase_norm_mod_b((const bf16_t*)(ws + WS_X1B), p.norm_ffn, MOD, 3072, 4096, H, 0, TP, 32);
        GRID_BAR();
        phase_norm_mod_b((const bf16_t*)(ws + WS_X1B), p.norm_ffn, MOD, 3072, 4096, H, TP, T, 0);
      } else {
        pg8::StaticOrder S; S.init(T, 1024, G, cv); pg8::gemm_phase<EpiRes<false>, pg8::StaticOrder, true, true>(lds, g, S, E);
        GRID_BAR();
        phase_norm_mod_b((const bf16_t*)(ws + WS_X1B), p.norm_ffn, MOD, 3072, 4096, H);
      } }
    GRID_BAR();
    { pg8::Gemm g{H, (const bf16_t*)(ws + WS_WFI), T, INC, 1024}; pg8::StaticOrder S; S.init(T, INC, G, cv);
      EpiFfnIn E{(bf16_t*)(ws + WS_HID)}; pg8::gemm_phase<EpiFfnIn, pg8::StaticOrder, true, true>(lds, g, S, E);
#if PROBE_DUP == 9
      GRID_BAR(); pg8::gemm_phase<EpiFfnIn, pg8::StaticOrder, true, true>(lds, g, S, E);
#endif
    }
    GRID_BAR();
    { pg8::Gemm g{(const bf16_t*)(ws + WS_HID), (const bf16_t*)(ws + WS_WFO), T, 1024, FF}; EpiRes<true> E{nullptr, nullptr, (const bf16_t*)(ws + WS_X1B), (bf16_t*)(ws + WS_X2B), MOD + 5120};
      if (split_ps) {
        { pg8::StaticOrder S; S.init(TP, 1024, G, cv); pg8::gemm_phase<EpiRes<true>, pg8::StaticOrder, true, true>(lds, g, S, E); }
        GRID_BAR();
        float* PART = (float*)(ws + WS_CUM + 20 * MiB);
        if (bx < 64) { const int ks = bx >> 5; pg8::Gemm gs{(const bf16_t*)(ws + WS_HID) + ks * (FF / 2), (const bf16_t*)(ws + WS_WFO) + ks * (FF / 2), T, 1024, FF / 2, FF};
            pg8::StaticOrder S; S.init(TS, 1024, 32, bx & 31, TP / 256); EpiPart EP{PART + (size_t)ks * TS * D, TP}; pg8::gemm_phase<EpiPart, pg8::StaticOrder, true, true>(lds, gs, S, EP); }
        else phase_final_norm((const bf16_t*)(ws + WS_X2B), p.out, p.norm_final, 0, TP, 64);
        GRID_BAR();
        phase_final_norm_parts((const bf16_t*)(ws + WS_X1B), PART, PART + (size_t)TS * D, MOD + 5120, p.out, p.norm_final);
      } else {
        pg8::StaticOrder S; S.init(T, 1024, G, cv); pg8::gemm_phase<EpiRes<true>, pg8::StaticOrder, true, true>(lds, g, S, E);
        GRID_BAR();
        phase_final_norm((const bf16_t*)(ws + WS_X2B), p.out, p.norm_final);
      } }
}

extern "C" void kernel_launch(void* const* d_in, const int* in_sizes, int n_in, void* d_out, int out_size, void* d_ws, size_t ws_size, hipStream_t stream) {
    static int grid = 0;
    if (grid == 0) {
        if (n_in != 21 || (size_t)out_size != OUT_TOTAL || ws_size < WS_END) { fprintf(stderr, "kernel_launch: unexpected sizes n_in %d out %d ws %zu\n", n_in, out_size, ws_size); grid = -1; return; }
        int dev = 0, cus = 0, per = 0;
        (void)hipGetDevice(&dev); (void)hipDeviceGetAttribute(&cus, hipDeviceAttributeMultiprocessorCount, dev);
        (void)hipFuncSetAttribute((const void*)fwd_megakernel, hipFuncAttributeMaxDynamicSharedMemorySize, LDS_BYTES);
        (void)hipOccupancyMaxActiveBlocksPerMultiprocessor(&per, (const void*)fwd_megakernel, 512, LDS_BYTES);
        if (per < 1) per = 1;
        grid = cus * per; fprintf(stderr, "kernel_launch: grid %d (cus %d x %d)\n", grid, cus, per);
    }
    if (grid < 0) return;
    if (hipMemsetAsync((char*)d_ws + WS_BAR, 0, BAR_BYTES, stream) != hipSuccess) { fprintf(stderr, "kernel_launch: memset failed\n"); return; }
    Params p{};
    const float** f = (const float**)&p;
    for (int i = 0; i < 21; ++i) f[i] = (const float*)d_in[i];
    p.out = (float*)d_out; p.ws = (unsigned char*)d_ws;
    void* args[] = {&p};
    hipError_t e = hipLaunchCooperativeKernel((const void*)fwd_megakernel, dim3(grid), dim3(512), args, LDS_BYTES, stream);
    if (e != hipSuccess) fprintf(stderr, "cooperative launch failed: %s (grid %d)\n", hipGetErrorString(e), grid);
}
```

```cpp
#include <hip/hip_runtime.h>
#include <hip/hip_cooperative_groups.h>
#include <cstdio>
#include <cstdint>
namespace cg = cooperative_groups;
#ifndef PROBE_DUP
#define PROBE_DUP 0
#endif

#define DI __device__ __forceinline__
#define LAS __attribute__((address_space(3)))
typedef unsigned short bf16_t;
typedef short bf16x8 __attribute__((ext_vector_type(8)));
typedef float f32x4 __attribute__((ext_vector_type(4)));
typedef float f32x2 __attribute__((ext_vector_type(2)));
typedef float f32x16 __attribute__((ext_vector_type(16)));
typedef unsigned u32x4 __attribute__((ext_vector_type(4)));
typedef unsigned u32x2 __attribute__((ext_vector_type(2)));
typedef __bf16 bf2_t __attribute__((ext_vector_type(2)));

constexpr int D = 1024, TP = 32768, TS = 2048, T = TP + TS, NCH = T / 64, NBATCH = 34;
constexpr int INC = 5632, FF = 2816;
constexpr float EPS = 1e-6f, LOG2E = 1.4426950408889634f;
constexpr size_t OFF_Y = 0, OFF_SP = (size_t)T * D, OFF_KP = OFF_SP + 131072, OFF_VP = OFF_KP + 524288, OFF_SS = OFF_VP + 524288,
                 OFF_KS = OFF_SS + 2097152, OFF_VS = OFF_KS + 1048576, OUT_TOTAL = OFF_VS + 1048576;
constexpr size_t MiB = 1u << 20;
constexpr size_t WS_MOD = 1 * MiB, WS_DEC = 2 * MiB, WS_SC = 4 * MiB, WS_WADA = 5 * MiB, WS_WIN = 17 * MiB, WS_WAB = 28 * MiB, WS_WO = 30 * MiB,
                 WS_WFI = 32 * MiB, WS_WFO = 43 * MiB, WS_H = 50 * MiB, WS_QOB = 118 * MiB, WS_KA = 186 * MiB, WS_VA = 220 * MiB, WS_GA = 254 * MiB,
                 WS_KB = 288 * MiB, WS_VB = 322 * MiB, WS_CUM = 356 * MiB, WS_SST = 424 * MiB, WS_END = 492 * MiB;
constexpr size_t WS_U = WS_H, WS_M = WS_KA, WS_HID = WS_KA, WS_X1B = WS_QOB, WS_X2B = WS_H;
constexpr size_t WS_BAR = 0, BAR_BYTES = 16384;
constexpr int LDS_BYTES = 140 * 1024, LDS_ST_OFF = 136 * 1024;

struct Params {
    const float *x_prompt, *x_sample, *c_prompt, *c_sample, *state, *cache_k, *cache_v, *w_ada, *b_ada, *norm_mix, *w_in, *lb_logits, *out_norm,
                *w_a, *rel_bias, *w_b, *w_out, *norm_ffn, *w_ffn_in, *w_ffn_out, *norm_final;
    float* out; unsigned char* ws;
};

DI int fresh_tid() { int t = threadIdx.x; asm volatile("" : "+v"(t)); return t; }
DI int launder(int v) { asm volatile("" : "+v"(v)); return v; }
DI unsigned pk2(float a, float b) { f32x2 v = {a, b}; bf2_t r = __builtin_convertvector(v, bf2_t); return __builtin_bit_cast(unsigned, r); }
DI float bflo(unsigned u) { return __uint_as_float(u << 16); }
DI float bfhi(unsigned u) { return __uint_as_float(u & 0xffff0000u); }
DI float bf2f(short s) { return __uint_as_float(((unsigned)(unsigned short)s) << 16); }
DI float sigm(float x) { return __builtin_amdgcn_rcpf(1.f + __expf(-x)); }
DI float silu(float x) { return x * sigm(x); }
DI int batch_of(int r) { return r < TP ? (r >> 14) : 2 + ((r - TP) >> 6); }
DI int crow(int reg, int h) { return (reg & 3) + 8 * (reg >> 2) + 4 * h; }
DI bf16x8 pack8(const f32x16& x, int s) {
    u32x4 p; p.x = pk2(x[8 * s], x[8 * s + 1]); p.y = pk2(x[8 * s + 2], x[8 * s + 3]); p.z = pk2(x[8 * s + 4], x[8 * s + 5]); p.w = pk2(x[8 * s + 6], x[8 * s + 7]);
    return __builtin_bit_cast(bf16x8, p);
}
DI bf16x8 pack8f(const float* v) { u32x4 p; p.x = pk2(v[0], v[1]); p.y = pk2(v[2], v[3]); p.z = pk2(v[4], v[5]); p.w = pk2(v[6], v[7]); return __builtin_bit_cast(bf16x8, p); }
DI bf16x8 ident_frag(int ks, int l31, int hf) {
    const int jj = l31 - 16 * ks - 8 * hf; bf16x8 r;
#pragma unroll
    for (int j = 0; j < 8; ++j) r[j] = (j == jj) ? (short)0x3F80 : (short)0;
    return r;
}
DI u32x4 widen_pair(u32x2 pg, u32x2 pg1) { const auto rx = __builtin_amdgcn_permlane32_swap(pg.x, pg1.x, false, false), ry = __builtin_amdgcn_permlane32_swap(pg.y, pg1.y, false, false); return (u32x4){rx[0], ry[0], rx[1], ry[1]}; }
DI void narrow_pair(u32x4 d, u32x2& pg, u32x2& pg1) { const auto rx = __builtin_amdgcn_permlane32_swap(d.x, d.z, false, false), ry = __builtin_amdgcn_permlane32_swap(d.y, d.w, false, false); pg = (u32x2){rx[0], ry[0]}; pg1 = (u32x2){rx[1], ry[1]}; }
#define MFMA32(a, b, c) __builtin_amdgcn_mfma_f32_32x32x16_bf16((a), (b), (c), 0, 0, 0)
DI f32x16 zero16() { f32x16 z;
#pragma unroll
    for (int i = 0; i < 16; ++i) z[i] = 0.f; return z; }

namespace pg8 {
constexpr int BM = 256, BK = 64, HALF = 128, HTB = HALF * BK * 2, STAGE_BYTES = 8 * HTB, NXCD = 8, WGM = 8;
__host__ __device__ __forceinline__ int lds_byte(int r, int c) { const int st = (r >> 4) * 2 + (c >> 5), rr = r & 15, cc = c & 31, ob = rr * 64 + cc * 2; return st * 1024 + (ob ^ (((ob >> 9) & 1) << 5)); }
__host__ __device__ __forceinline__ void stage_rc(int b, int& R, int& C) { const int st = b / 1024, sb = b % 1024, swz = sb ^ (((sb >> 9) & 1) << 5); R = (st >> 1) * 16 + swz / 64; C = (st & 1) * 32 + (swz % 64) / 2; }
__host__ __device__ __forceinline__ int perm32(int rho) { const int n = rho >> 4, i = rho & 15; return 8 * (i >> 2) + 4 * n + (i & 3); }
struct Unit { int pm, pn; };
struct Gemm { const bf16_t* A; const bf16_t* Bt; int M, N, K, ld; };
struct StaticOrder {
    int nM, nN, nwg, G, c, pm_off;
    __device__ void init(int M, int N, int G_, int c_, int pm_off_ = 0) { nM = M / BM; nN = N / BM; nwg = nM * nN; G = G_; c = c_; pm_off = pm_off_; }
    __device__ bool next(int i, Unit& u) const {
        const long L = (long)i * G + c; if (L >= nwg) return false;
        int wgid = (int)L; { const int q = nwg / NXCD, r = nwg % NXCD, xcd = wgid % NXCD, off = wgid / NXCD; wgid = (xcd < r ? xcd * (q + 1) : r * (q + 1) + (xcd - r) * q) + off; }
        const int nig = WGM * nN, gid = wgid / nig, fm = gid * WGM, gsz = (nM - fm) < WGM ? (nM - fm) : WGM;
        u.pm = pm_off + fm + ((wgid % nig) % gsz); u.pn = (wgid % nig) / gsz; return true;
    }
};
template <class Epi, class Sched, bool ALIGN_EPI = false, bool SP2 = false>
__device__ __forceinline__ void gemm_phase(LAS unsigned char* lds, const Gemm g, const Sched& S, const Epi& E) {
    const int tid = fresh_tid(), wid = __builtin_amdgcn_readfirstlane(tid >> 6), lane = tid & 63, wr = wid >> 2, wc = wid & 3, fr = lane & 15, fq = lane >> 4;
    const int K = g.ld ? g.ld : g.K, nt = g.K / BK;
    unsigned voffA[2], voffB[2];
#pragma unroll
    for (int i = 0; i < 2; ++i) { int R, C; stage_rc(tid * 16 + i * 8192, R, C); const int Rb = Epi::PERM ? ((R & ~31) + perm32(R & 31)) : R;
        voffA[i] = (unsigned)(R * K + C) * 2u; voffB[i] = (unsigned)(Rb * K + C) * 2u; }
    const size_t kstep = (size_t)(BK * 2);
    const size_t hstep = (size_t)HALF * K * 2;
    const size_t tstep = 2 * hstep;
    const unsigned ldsw = (unsigned)wid * 1024u;
    const int aoff = lds_byte(wr * 64 + fr, fq * 8), boff = lds_byte(wc * 32 + fr, fq * 8);
#define PG8_SA(b, h) (((b) * 2 + (h)) * HTB)
#define PG8_SB(b, h) ((4 + (b) * 2 + (h)) * HTB)
#define PG8_STAGE(bufoff, gbase, voff) do { _Pragma("unroll") for (int _i = 0; _i < 2; ++_i) \
        __builtin_amdgcn_global_load_lds((const unsigned*)((const char*)(gbase) + (voff)[_i]), (LAS unsigned*)(lds + (bufoff) + ldsw + _i * 8192), 16, 0, 0); } while (0)
#define PG8_LDA(dst, b, h) do { _Pragma("unroll") for (int m = 0; m < 4; ++m) _Pragma("unroll") for (int k = 0; k < 2; ++k) dst[m][k] = *(const LAS bf16x8*)(lds + PG8_SA(b, h) + aoff + m * 2048 + k * 1024); } while (0)
#define PG8_LDB(dst, b, h) do { _Pragma("unroll") for (int n = 0; n < 2; ++n) _Pragma("unroll") for (int k = 0; k < 2; ++k) dst[n][k] = *(const LAS bf16x8*)(lds + PG8_SB(b, h) + boff + n * 2048 + k * 1024); } while (0)
#define PG8_MMA(ai, bj, At, Bt) do { __builtin_amdgcn_s_setprio(1); _Pragma("unroll") for (int m = 0; m < 4; ++m) _Pragma("unroll") for (int n = 0; n < 2; ++n) _Pragma("unroll") for (int k = 0; k < 2; ++k) \
        acc[ai][bj][m][n] = __builtin_amdgcn_mfma_f32_16x16x32_bf16(Bt[n][k], At[m][k], acc[ai][bj][m][n], 0, 0, 0); __builtin_amdgcn_s_setprio(0); } while (0)
#define PG8_WAIT_V(n) asm volatile("s_waitcnt vmcnt(" #n ")" ::: "memory")
#define PG8_WAIT_L(n) asm volatile("s_waitcnt lgkmcnt(" #n ")" ::: "memory")
#define PG8_BAR __builtin_amdgcn_s_barrier()
#define PG8_SCHED __builtin_amdgcn_sched_barrier(0)
    Unit cur, nxt; int ui = 0;
    if (!S.next(0, cur)) return;
    f32x4 acc[2][2][4][2];
#pragma unroll
    for (int a = 0; a < 2; ++a)
#pragma unroll
        for (int b = 0; b < 2; ++b)
#pragma unroll
            for (int m = 0; m < 4; ++m)
#pragma unroll
                for (int n = 0; n < 2; ++n) acc[a][b][m][n] = (f32x4){0.f, 0.f, 0.f, 0.f};
    bf16x8 At[4][2], B0[2][2], B1[2][2];
    const char* cA = (const char*)g.A + (size_t)cur.pm * tstep; const char* cB = (const char*)g.Bt + (size_t)cur.pn * tstep;
    if constexpr (SP2) {
        PG8_STAGE(PG8_SB(0, 0), cB, voffB); PG8_STAGE(PG8_SB(0, 1), cB + hstep, voffB); PG8_STAGE(PG8_SA(0, 0), cA, voffA); PG8_STAGE(PG8_SA(0, 1), cA + hstep, voffA);
        if (wr == 1) PG8_BAR;
        PG8_WAIT_V(2); PG8_BAR;
        PG8_STAGE(PG8_SB(1, 0), cB + kstep, voffB); PG8_STAGE(PG8_SA(1, 0), cA + kstep, voffA); PG8_STAGE(PG8_SB(1, 1), cB + hstep + kstep, voffB);
        PG8_WAIT_V(6); PG8_BAR;
    } else {
        PG8_STAGE(PG8_SB(0, 0), cB, voffB); PG8_STAGE(PG8_SA(0, 0), cA, voffA); PG8_STAGE(PG8_SB(0, 1), cB + hstep, voffB); PG8_STAGE(PG8_SA(0, 1), cA + hstep, voffA);
        if (wr == 1) PG8_BAR;
        PG8_WAIT_V(4); PG8_BAR;
        PG8_STAGE(PG8_SB(1, 0), cB + kstep, voffB); PG8_STAGE(PG8_SA(1, 0), cA + kstep, voffA); PG8_STAGE(PG8_SB(1, 1), cB + hstep + kstep, voffB);
        PG8_WAIT_V(6); PG8_BAR;
    }
    for (;;) {
        const bool has_next = S.next(ui + 1, nxt);
        const char* nA = has_next ? (const char*)g.A + (size_t)nxt.pm * tstep : cA; const char* nB = has_next ? (const char*)g.Bt + (size_t)nxt.pn * tstep : cB;
        for (int t = 0; t < nt; t += 2) {
            if constexpr (Epi::MIDK) { if (t == nt / 2) E.mid(acc, cur, wr, wc, fr, fq); }
            const bool last = (t == nt - 2);
            const char* a1 = cA + (size_t)(t + 1) * kstep;
            const char* a2 = last ? nA : cA + (size_t)(t + 2) * kstep; const char* b2 = last ? nB : cB + (size_t)(t + 2) * kstep;
            const char* a3 = a2 + kstep; const char* b3 = b2 + kstep;
            if constexpr (SP2) {
            PG8_LDB(B0, 0, 0); PG8_LDB(B1, 0, 1); PG8_SCHED; PG8_LDA(At, 0, 0); PG8_STAGE(PG8_SA(1, 1), a1 + hstep, voffA);
            PG8_WAIT_V(8); PG8_WAIT_L(0); PG8_BAR; PG8_MMA(0, 0, At, B0); PG8_MMA(0, 1, At, B1); PG8_BAR; PG8_SCHED;
            PG8_LDA(At, 0, 1); PG8_STAGE(PG8_SB(0, 0), b2, voffB); PG8_STAGE(PG8_SB(0, 1), b2 + hstep, voffB); PG8_STAGE(PG8_SA(0, 0), a2, voffA);
            PG8_WAIT_V(8); PG8_WAIT_L(0); PG8_BAR; PG8_MMA(1, 0, At, B0); PG8_MMA(1, 1, At, B1); PG8_BAR; PG8_SCHED;
            PG8_LDB(B0, 1, 0); PG8_LDB(B1, 1, 1); PG8_SCHED; PG8_LDA(At, 1, 0); PG8_STAGE(PG8_SA(0, 1), a2 + hstep, voffA);
            PG8_WAIT_V(8); PG8_WAIT_L(0); PG8_BAR; PG8_MMA(0, 0, At, B0); PG8_MMA(0, 1, At, B1); PG8_BAR; PG8_SCHED;
            PG8_LDA(At, 1, 1); PG8_STAGE(PG8_SB(1, 0), b3, voffB); PG8_STAGE(PG8_SB(1, 1), b3 + hstep, voffB); PG8_STAGE(PG8_SA(1, 0), a3, voffA);
            PG8_WAIT_V(8); PG8_WAIT_L(0); PG8_BAR; PG8_MMA(1, 0, At, B0); PG8_MMA(1, 1, At, B1); PG8_BAR; PG8_SCHED;
            } else {
            PG8_LDB(B0, 0, 0); PG8_SCHED; PG8_LDA(At, 0, 0); PG8_STAGE(PG8_SA(1, 1), a1 + hstep, voffA);
            PG8_WAIT_L(8); PG8_BAR; PG8_WAIT_L(0); PG8_MMA(0, 0, At, B0); PG8_BAR; PG8_SCHED;
            PG8_LDB(B1, 0, 1); PG8_STAGE(PG8_SB(0, 0), b2, voffB);
            PG8_BAR; PG8_WAIT_L(0); PG8_MMA(0, 1, At, B1); PG8_BAR;
            PG8_LDA(At, 0, 1); PG8_STAGE(PG8_SA(0, 0), a2, voffA);
            PG8_BAR; PG8_WAIT_L(0); PG8_MMA(1, 0, At, B0); PG8_BAR; PG8_SCHED;
            PG8_STAGE(PG8_SB(0, 1), b2 + hstep, voffB);
            PG8_WAIT_V(6); PG8_BAR; PG8_MMA(1, 1, At, B1); PG8_BAR;
            PG8_LDB(B0, 1, 0); PG8_SCHED; PG8_LDA(At, 1, 0); PG8_STAGE(PG8_SA(0, 1), a2 + hstep, voffA);
            PG8_WAIT_L(8); PG8_BAR; PG8_WAIT_L(0); PG8_MMA(0, 0, At, B0); PG8_BAR; PG8_SCHED;
            PG8_LDB(B1, 1, 1); PG8_STAGE(PG8_SB(1, 0), b3, voffB);
            PG8_BAR; PG8_WAIT_L(0); PG8_MMA(0, 1, At, B1); PG8_BAR;
            PG8_LDA(At, 1, 1); PG8_STAGE(PG8_SA(1, 0), a3, voffA);
            PG8_BAR; PG8_WAIT_L(0); PG8_MMA(1, 0, At, B0); PG8_BAR; PG8_SCHED;
            PG8_STAGE(PG8_SB(1, 1), b3 + hstep, voffB);
            PG8_WAIT_V(6); PG8_BAR; PG8_MMA(1, 1, At, B1); PG8_BAR;
            }
        }
        if constexpr (ALIGN_EPI) { if (wr == 0) PG8_BAR; }
        E(acc, cur, wr, wc, fr, fq);
        if (!has_next) break;
#pragma unroll
        for (int a = 0; a < 2; ++a)
#pragma unroll
            for (int b = 0; b < 2; ++b)
#pragma unroll
                for (int m = 0; m < 4; ++m)
#pragma unroll
                    for (int n = 0; n < 2; ++n) acc[a][b][m][n] = (f32x4){0.f, 0.f, 0.f, 0.f};
        cur = nxt; cA = nA; cB = nB; ++ui;
        if constexpr (ALIGN_EPI) { if (wr == 1) PG8_BAR; }
    }
    PG8_WAIT_V(0);
    if constexpr (!ALIGN_EPI) { if (wr == 0) PG8_BAR; }
    PG8_BAR;
#undef PG8_SA
#undef PG8_SB
#undef PG8_STAGE
#undef PG8_LDA
#undef PG8_LDB
#undef PG8_MMA
#undef PG8_WAIT_V
#undef PG8_WAIT_L
#undef PG8_BAR
#undef PG8_SCHED
}
}
using pg8::Unit;
typedef f32x4 Acc[2][2][4][2];

DI u32x4 pack_row8(const f32x4& v0, const f32x4& v1) { u32x4 w; w.x = pk2(v0[0], v0[1]); w.y = pk2(v0[2], v0[3]); w.z = pk2(v1[0], v1[1]); w.w = pk2(v1[2], v1[3]); return w; }

struct EpiMod {
    static constexpr bool PERM = false, MIDK = false;
    float* mod; const float* bias;
    DI void operator()(Acc& acc, const Unit& u, int wr, int wc, int fr, int fq) const {
        { const int t_ = fresh_tid(); fr = t_ & 15; fq = (t_ >> 4) & 3; }
        if (u.pm != 0 || wr != 0) return;
#pragma unroll
        for (int m = 0; m < 3; ++m) { const int r = 16 * m + fr; if (r < NBATCH) {
#pragma unroll
            for (int bj = 0; bj < 2; ++bj)
#pragma unroll
                for (int n = 0; n < 2; ++n) { const int col = u.pn * 256 + bj * 128 + wc * 32 + n * 16 + 4 * fq;
                    *(f32x4*)(mod + (size_t)r * 6144 + col) = acc[0][bj][m][n] + *(const f32x4*)(bias + col); } } }
    }
};

struct EpiIn {
    static constexpr bool PERM = true, MIDK = false;
    bf16_t *QOB, *KA, *VA, *GA, *KB, *VB, *SGA, *SGB; float *CUM, *DEC; const float* lbl; float* out;
    DI void operator()(Acc& acc, const Unit& u, int wr, int wc, int fr, int fq) const {
        { const int t_ = fresh_tid(); fr = t_ & 15; fq = (t_ >> 4) & 3; }
        const int pn = u.pn, rt = wr * 64 + fr, row0 = u.pm * 256 + rt, cw = wc * 32 + 8 * fq, lane = fq * 16 + fr;
        if (pn >= 14) {
            const size_t o0 = ((size_t)(u.pm * 8 + (pn - 14)) * 8 * 512 + (size_t)(wr * 4 + wc) * 64 + lane) * 8;
#pragma unroll
            for (int ai = 0; ai < 2; ++ai)
#pragma unroll
                for (int m = 0; m < 4; ++m) { f32x4 r0, r1, b0, b1;
#pragma unroll
                    for (int j = 0; j < 4; ++j) { b0[j] = fmaxf(sigm(acc[ai][1][m][0][j]), 1e-30f); b1[j] = fmaxf(sigm(acc[ai][1][m][1][j]), 1e-30f);
                        r0[j] = sigm(acc[ai][0][m][0][j]) * __builtin_amdgcn_rcpf(b0[j]); r1[j] = sigm(acc[ai][0][m][1][j]) * __builtin_amdgcn_rcpf(b1[j]); }
                    const size_t o = o0 + (size_t)(ai * 4 + m) * 512 * 8;
                    *(u32x4*)(SGA + o) = pack_row8(r0, r1); *(u32x4*)(SGB + o) = pack_row8(b0, b1); __builtin_amdgcn_sched_barrier(0); }
            return;
        }
        const int seg = pn >> 1, col0 = (pn & 1) * 256 + cw;
        if (seg == 1) {
#pragma unroll
            for (int bj = 0; bj < 2; ++bj) {
                float lb[2][4];
#pragma unroll
                for (int n = 0; n < 2; ++n)
#pragma unroll
                    for (int j = 0; j < 4; ++j) { const int c = col0 + bj * 128 + 4 * n + j; lb[n][j] = __builtin_amdgcn_rcpf(1.f + __expf(lbl[512 + c] - lbl[c])); }
#pragma unroll
                for (int ai = 0; ai < 2; ++ai) {
                    const size_t rbase = ((size_t)((pn & 1) * 2 + bj) * T + (u.pm * 256 + ai * 128 + wr * 64 + launder(fr))) * 128 + cw;
#pragma unroll
                    for (int m = 0; m < 4; ++m) { f32x4 k0, k1;
#pragma unroll
                        for (int j = 0; j < 4; ++j) {
                            float f = lb[0][j] + (1.f - lb[0][j]) * sigm(acc[ai][bj][m][0][j]); k0[j] = 1.f - f; acc[ai][bj][m][0][j] = __logf(f);
                            f = lb[1][j] + (1.f - lb[1][j]) * sigm(acc[ai][bj][m][1][j]); k1[j] = 1.f - f; acc[ai][bj][m][1][j] = __logf(f); }
                        *(u32x4*)(KA + rbase + (size_t)m * 16 * 128) = pack_row8(k0, k1); }
                    __builtin_amdgcn_sched_barrier(0);
#pragma unroll
                    for (int n = 0; n < 2; ++n)
#pragma unroll
                        for (int j = 0; j < 4; ++j) { float carry = 0.f;
#pragma unroll
                            for (int m = 0; m < 4; ++m) { float v = acc[ai][bj][m][n][j];
                                v += __int_as_float(__builtin_amdgcn_update_dpp(0, __float_as_int(v), 0x111, 0xf, 0xf, false));
                                v += __int_as_float(__builtin_amdgcn_update_dpp(0, __float_as_int(v), 0x112, 0xf, 0xf, false));
                                v += __int_as_float(__builtin_amdgcn_update_dpp(0, __float_as_int(v), 0x114, 0xf, 0xf, false));
                                v += __int_as_float(__builtin_amdgcn_update_dpp(0, __float_as_int(v), 0x118, 0xf, 0xf, false));
                                v += carry; carry = __shfl(v, lane | 15); acc[ai][bj][m][n][j] = v; } }
                    __builtin_amdgcn_sched_barrier(0);
#pragma unroll
                    for (int m = 0; m < 4; ++m) { float* cp = CUM + rbase + (size_t)m * 16 * 128; *(f32x4*)cp = acc[ai][bj][m][0]; *(f32x4*)(cp + 4) = acc[ai][bj][m][1]; }
                    if (fr == 15) {
#pragma unroll
                        for (int n = 0; n < 2; ++n) { f32x4 e;
#pragma unroll
                            for (int j = 0; j < 4; ++j) e[j] = __expf(acc[ai][bj][3][n][j]);
                            *(f32x4*)(DEC + (size_t)(u.pm * 4 + ai * 2 + wr) * 512 + col0 + bj * 128 + 4 * n) = e; } }
                    __builtin_amdgcn_sched_barrier(0);
                }
            }
            return;
        }
        bf16_t* dst; int pitch = 512; size_t bjoff = 128; float* o32 = nullptr;
        switch (seg) {
            case 0: dst = QOB + col0; pitch = 1024; break;
            case 2: dst = VA + (size_t)((pn & 1) * 2) * T * 128 + cw; pitch = 128; bjoff = (size_t)T * 128; break;
            case 3: dst = GA + (size_t)((pn & 1) * 2) * T * 128 + cw; pitch = 128; bjoff = (size_t)T * 128; break;
            case 4: dst = QOB + 512 + col0; pitch = 1024; break;
            default: dst = (seg == 5 ? KB : VB) + (size_t)((pn & 1) * 4 + (wc >> 1)) * (T / 32) * 2048 + ((wc & 1) * 4 + fq) * 256; bjoff = (size_t)2 * (T / 32) * 2048; break;
        }
        if (seg >= 5) {
            if (u.pm >= 128) o32 = out + (seg == 5 ? OFF_KS : OFF_VS) + (size_t)((u.pm - 128) * 256 + rt) * 512 + col0;
            else if ((u.pm & 63) >= 62) o32 = out + (seg == 5 ? OFF_KP : OFF_VP) + (size_t)((u.pm >> 6) * 512 + ((u.pm & 63) - 62) * 256 + rt) * 512 + col0;
        }
        const bool act = (seg == 0 || seg == 3);
#pragma unroll
        for (int ai = 0; ai < 2; ++ai)
#pragma unroll
            for (int m = 0; m < 4; ++m)
#pragma unroll
                for (int bj = 0; bj < 2; ++bj) { f32x4 v0 = acc[ai][bj][m][0], v1 = acc[ai][bj][m][1];
                    if (act) {
#pragma unroll
                        for (int j = 0; j < 4; ++j) { v0[j] = silu(v0[j]); v1[j] = silu(v1[j]); } }
                    const size_t ro = seg >= 5 ? (size_t)(u.pm * 8 + 2 * wr + 4 * ai + (m >> 1)) * 2048 + ((m & 1) * 16 + fr) * 8 : (size_t)(row0 + ai * 128 + m * 16) * pitch;
                    *(u32x4*)(dst + ro + bj * bjoff) = pack_row8(v0, v1);
                    if (o32) { float* op = o32 + (size_t)(ai * 128 + m * 16) * 512 + bj * 128; *(f32x4*)op = v0; *(f32x4*)(op + 4) = v1; } __builtin_amdgcn_sched_barrier(0); }
    }
};

struct EpiMerge {
    static constexpr bool PERM = true, MIDK = true;
    const bf16_t *SGR, *SGB; bf16_t* Mo;
    DI void mid(Acc& acc, const Unit& u, int wr, int wc, int fr, int fq) const {
        { const int t_ = fresh_tid(); fr = t_ & 15; fq = (t_ >> 4) & 3; }
        const size_t gb = ((size_t)(u.pm * 8 + 2 * u.pn) * 8 * 512 + (size_t)(wr * 4 + wc) * 64 + (fq * 16 + fr)) * 8;
#pragma unroll
        for (int ai = 0; ai < 2; ++ai) { u32x4 a[4][2];
#pragma unroll
            for (int m = 0; m < 4; ++m)
#pragma unroll
                for (int bj = 0; bj < 2; ++bj) a[m][bj] = *(const u32x4*)(SGR + gb + ((size_t)bj * 8 + ai * 4 + m) * 512 * 8);
#pragma unroll
            for (int m = 0; m < 4; ++m)
#pragma unroll
                for (int bj = 0; bj < 2; ++bj)
#pragma unroll
                    for (int j = 0; j < 4; ++j) { acc[ai][bj][m][j >> 1][(j & 1) * 2] *= bflo(a[m][bj][j]); acc[ai][bj][m][j >> 1][(j & 1) * 2 + 1] *= bfhi(a[m][bj][j]); }
            __builtin_amdgcn_sched_barrier(0); }
    }
    DI void operator()(Acc& acc, const Unit& u, int wr, int wc, int fr, int fq) const {
        { const int t_ = fresh_tid(); fr = t_ & 15; fq = (t_ >> 4) & 3; }
        const size_t base = (size_t)(u.pm * 256 + wr * 64 + fr) * 1024 + u.pn * 256 + wc * 32 + 8 * fq;
        const size_t gb = ((size_t)(u.pm * 8 + 2 * u.pn) * 8 * 512 + (size_t)(wr * 4 + wc) * 64 + (fq * 16 + fr)) * 8;
#pragma unroll
        for (int ai = 0; ai < 2; ++ai) { u32x4 b[4][2];
#pragma unroll
            for (int m = 0; m < 4; ++m)
#pragma unroll
                for (int bj = 0; bj < 2; ++bj) b[m][bj] = *(const u32x4*)(SGB + gb + ((size_t)bj * 8 + ai * 4 + m) * 512 * 8);
#pragma unroll
            for (int m = 0; m < 4; ++m)
#pragma unroll
                for (int bj = 0; bj < 2; ++bj) { f32x4 v0 = acc[ai][bj][m][0], v1 = acc[ai][bj][m][1]; const u32x4 g = b[m][bj];
                    v0[0] *= bflo(g[0]); v0[1] *= bfhi(g[0]); v0[2] *= bflo(g[1]); v0[3] *= bfhi(g[1]);
                    v1[0] *= bflo(g[2]); v1[1] *= bfhi(g[2]); v1[2] *= bflo(g[3]); v1[3] *= bfhi(g[3]);
                    *(u32x4*)(Mo + base + (size_t)(ai * 128 + m * 16) * 1024 + bj * 128) = pack_row8(v0, v1); }
            __builtin_amdgcn_sched_barrier(0); }
    }
};

template <bool BASE_BF16> struct EpiRes {
    static constexpr bool PERM = true, MIDK = false;
    const float *xp, *xs; const bf16_t* xb; bf16_t* xo; const float* gmod;
    DI void operator()(Acc& acc, const Unit& u, int wr, int wc, int fr, int fq) const {
        { const int t_ = fresh_tid(); fr = t_ & 15; fq = (t_ >> 4) & 3; }
        const int colb = u.pn * 256 + wc * 32 + 8 * fq;
#pragma unroll
        for (int ai = 0; ai < 2; ++ai) { const int r0 = u.pm * 256 + ai * 128 + wr * 64 + fr;
            const float* g = gmod + (size_t)batch_of(r0) * 6144 + colb;
            f32x4 gv[2][2];
#pragma unroll
            for (int bj = 0; bj < 2; ++bj) { gv[bj][0] = *(const f32x4*)(g + bj * 128); gv[bj][1] = *(const f32x4*)(g + bj * 128 + 4); }
            bf16_t* orow = xo + (size_t)r0 * D + colb;
            if constexpr (BASE_BF16) {
                const bf16_t* xr = xb + (size_t)r0 * D + colb; u32x4 xv[4][2];
#pragma unroll
                for (int m = 0; m < 4; ++m)
#pragma unroll
                    for (int bj = 0; bj < 2; ++bj) xv[m][bj] = *(const u32x4*)(xr + (size_t)m * 16 * D + bj * 128);
#pragma unroll
                for (int m = 0; m < 4; ++m)
#pragma unroll
                    for (int bj = 0; bj < 2; ++bj) { const u32x4 x = xv[m][bj]; const f32x4 a0 = acc[ai][bj][m][0] * gv[bj][0], a1 = acc[ai][bj][m][1] * gv[bj][1];
                        f32x4 v0 = {bflo(x[0]) + a0[0], bfhi(x[0]) + a0[1], bflo(x[1]) + a0[2], bfhi(x[1]) + a0[3]}, v1 = {bflo(x[2]) + a1[0], bfhi(x[2]) + a1[1], bflo(x[3]) + a1[2], bfhi(x[3]) + a1[3]};
                        *(u32x4*)(orow + (size_t)m * 16 * D + bj * 128) = pack_row8(v0, v1); }
            } else {
                const float* xr = (r0 < TP ? xp + (size_t)r0 * D : xs + (size_t)(r0 - TP) * D) + colb; f32x4 xv[4][2][2];
#pragma unroll
                for (int m = 0; m < 4; ++m)
#pragma unroll
                    for (int bj = 0; bj < 2; ++bj) { xv[m][bj][0] = *(const f32x4*)(xr + (size_t)m * 16 * D + bj * 128); xv[m][bj][1] = *(const f32x4*)(xr + (size_t)m * 16 * D + bj * 128 + 4); }
#pragma unroll
                for (int m = 0; m < 4; ++m)
#pragma unroll
                    for (int bj = 0; bj < 2; ++bj) *(u32x4*)(orow + (size_t)m * 16 * D + bj * 128) = pack_row8(xv[m][bj][0] + gv[bj][0] * acc[ai][bj][m][0], xv[m][bj][1] + gv[bj][1] * acc[ai][bj][m][1]);
            }
            __builtin_amdgcn_sched_barrier(0); }
    }
};

struct EpiPart {
    static constexpr bool PERM = false, MIDK = false;
    float* part; int row0;
    DI void operator()(Acc& acc, const Unit& u, int wr, int wc, int fr, int fq) const {
        { const int t_ = fresh_tid(); fr = t_ & 15; fq = (t_ >> 4) & 3; }
#pragma unroll
        for (int ai = 0; ai < 2; ++ai)
#pragma unroll
            for (int m = 0; m < 4; ++m) { float* prow = part + (size_t)(u.pm * 256 + ai * 128 + wr * 64 + m * 16 + fr - row0) * D + u.pn * 256 + wc * 32 + 4 * fq;
#pragma unroll
                for (int bj = 0; bj < 2; ++bj)
#pragma unroll
                    for (int n = 0; n < 2; ++n) *(f32x4*)(prow + bj * 128 + n * 16) = acc[ai][bj][m][n];
                __builtin_amdgcn_sched_barrier(0); }
    }
};

struct EpiFfnIn {
    static constexpr bool PERM = true, MIDK = false;
    bf16_t* HID;
    DI void operator()(Acc& acc, const Unit& u, int wr, int wc, int fr, int fq) const {
        { const int t_ = fresh_tid(); fr = t_ & 15; fq = (t_ >> 4) & 3; }
        bf16_t* base = HID + (size_t)(u.pm * 256 + wr * 64 + fr) * FF + u.pn * 128 + wc * 32 + 8 * fq;
#pragma unroll
        for (int ai = 0; ai < 2; ++ai)
#pragma unroll
            for (int m = 0; m < 4; ++m) { f32x4 v0, v1;
#pragma unroll
                for (int j = 0; j < 4; ++j) { v0[j] = silu(acc[ai][0][m][0][j]) * acc[ai][1][m][0][j]; v1[j] = silu(acc[ai][0][m][1][j]) * acc[ai][1][m][1][j]; }
                *(u32x4*)(base + (size_t)(ai * 128 + m * 16) * FF) = pack_row8(v0, v1); __builtin_amdgcn_sched_barrier(0); }
    }
};

DI void transpose_item(const float* W, int N, bf16_t* WT, int pitch, int koff, int k0, int n0, int drow0, LAS float* scr, int lane) {
#pragma unroll
    for (int i = 0; i < 8; ++i) { const int kk = 8 * i + (lane >> 3), n4 = 4 * (lane & 7); const f32x4 w = *(const f32x4*)(W + (size_t)(k0 + kk) * N + n0 + n4);
        scr[kk * 33 + n4] = w[0]; scr[kk * 33 + n4 + 1] = w[1]; scr[kk * 33 + n4 + 2] = w[2]; scr[kk * 33 + n4 + 3] = w[3]; }
    asm volatile("s_waitcnt lgkmcnt(0)" ::: "memory");
    const int c = lane & 7;
#pragma unroll
    for (int j = 0; j < 4; ++j) { const int n = (lane >> 3) + 8 * j; const LAS float* s = scr + (8 * c) * 33 + n;
        u32x4 o; o.x = pk2(s[0 * 33], s[1 * 33]); o.y = pk2(s[2 * 33], s[3 * 33]); o.z = pk2(s[4 * 33], s[5 * 33]); o.w = pk2(s[6 * 33], s[7 * 33]);
        *(u32x4*)(WT + (size_t)(drow0 + n) * pitch + koff + k0 + 8 * c) = o; }
    asm volatile("s_waitcnt lgkmcnt(0)" ::: "memory");
}
DI void phase_prep(const Params& p, LAS unsigned char* lds) {
    const int tid = fresh_tid(), lane = tid & 63, wave = __builtin_amdgcn_readfirstlane(tid >> 6);
    LAS float* scr = (LAS float*)(lds + wave * 16384);
    const int gw = blockIdx.x * 8 + wave, NGW = gridDim.x * 8;
    unsigned char* ws = p.ws;
    constexpr int I_ADA = 16 * 192, I_IN = 16 * 176, I_A = 8 * 32, I_O = 16 * 32, I_FI = 16 * 176, I_FO = 44 * 32;
    constexpr int NIT = I_ADA + I_IN + 2 * I_A + I_O + I_FI + I_FO;
    for (int it = gw; it < NIT; it += NGW) {
        int r = it;
        if (r < I_ADA) { const int kb = r / 192, nb = r % 192; transpose_item(p.w_ada, 6144, (bf16_t*)(ws + WS_WADA), 1024, 0, 64 * kb, 32 * nb, 32 * nb, scr, lane); continue; } r -= I_ADA;
        if (r < I_IN) { const int kb = r / 176, nb = r % 176, n0 = 32 * nb; int dr = n0;
            if (n0 >= 3584) { const int j = n0 < 4608 ? n0 - 3584 : n0 - 4608; dr = 3584 + 256 * (j >> 7) + (j & 127) + (n0 < 4608 ? 0 : 128); }
            transpose_item(p.w_in, INC, (bf16_t*)(ws + WS_WIN), 1024, 0, 64 * kb, n0, dr, scr, lane); continue; } r -= I_IN;
        if (r < I_A) { const int kb = r / 32, nb = r % 32; transpose_item(p.w_a, 1024, (bf16_t*)(ws + WS_WAB), 1024, 0, 64 * kb, 32 * nb, 32 * nb, scr, lane); continue; } r -= I_A;
        if (r < I_A) { const int kb = r / 32, nb = r % 32; transpose_item(p.w_b, 1024, (bf16_t*)(ws + WS_WAB), 1024, 512, 64 * kb, 32 * nb, 32 * nb, scr, lane); continue; } r -= I_A;
        if (r < I_O) { const int kb = r / 32, nb = r % 32; transpose_item(p.w_out, 1024, (bf16_t*)(ws + WS_WO), 1024, 0, 64 * kb, 32 * nb, 32 * nb, scr, lane); continue; } r -= I_O;
        if (r < I_FI) { const int kb = r / 176, nb = r % 176; const int n0 = 32 * nb; const int j0 = n0 < FF ? n0 : n0 - FF;
            transpose_item(p.w_ffn_in, INC, (bf16_t*)(ws + WS_WFI), 1024, 0, 64 * kb, n0, 256 * (j0 >> 7) + (j0 & 127) + (n0 < FF ? 0 : 128), scr, lane); continue; } r -= I_FI;
        { const int kb = r / 32, nb = r % 32; transpose_item(p.w_ffn_out, 1024, (bf16_t*)(ws + WS_WFO), FF, 0, 64 * kb, 32 * nb, 32 * nb, scr, lane); }
    }
    bf16_t* SC = (bf16_t*)(ws + WS_SC);
    for (int i = blockIdx.x * 512 + tid; i < 256 * 1024 / 2; i += gridDim.x * 512) { const int row = (2 * i) >> 10, col = (2 * i) & 1023; float a = 0.f, b = 0.f;
        if (row < NBATCH) { const float* c = row < 2 ? p.c_prompt + row * D : p.c_sample + (row - 2) * D; a = silu(c[col]); b = silu(c[col + 1]); }
        ((unsigned*)SC)[i] = pk2(a, b); }
}

DI float wave_sum(float v) {
#pragma unroll
    for (int o = 1; o < 64; o <<= 1) v += __shfl_xor(v, o);
    return v;
}
DI void phase_norm_mod(const float* xp, const float* xs, const float* nw, const float* mod, int sh_off, int sc_off, bf16_t* H) {
    const int tid = fresh_tid(), lane = tid & 63, wave = __builtin_amdgcn_readfirstlane(tid >> 6);
    const int gw = blockIdx.x * 8 + wave, NGW = gridDim.x * 8;
    for (int r = gw; r < T; r += NGW) {
        const float* xr = r < TP ? xp + (size_t)r * D : xs + (size_t)(r - TP) * D; const float* mb = mod + (size_t)batch_of(r) * 6144;
        f32x4 v[4]; float s = 0.f;
#pragma unroll
        for (int j = 0; j < 4; ++j) { v[j] = *(const f32x4*)(xr + 4 * lane + 256 * j); s += (v[j][0] * v[j][0] + v[j][1] * v[j][1]) + (v[j][2] * v[j][2] + v[j][3] * v[j][3]); }
        const float rstd = __builtin_amdgcn_rsqf(wave_sum(s) * (1.f / D) + EPS);
#pragma unroll
        for (int j = 0; j < 4; ++j) { const int col = 4 * lane + 256 * j; const f32x4 w = *(const f32x4*)(nw + col), sc = *(const f32x4*)(mb + sc_off + col), sh = *(const f32x4*)(mb + sh_off + col);
            const f32x4 h = v[j] * rstd * w * (sc + 1.f) + sh; u32x2 o; o.x = pk2(h[0], h[1]); o.y = pk2(h[2], h[3]);
            *(u32x2*)(H + (size_t)r * D + col) = o; }
    }
}
DI void phase_norm_mod_b(const bf16_t* xb, const float* nw, const float* mod, int sh_off, int sc_off, bf16_t* H, int r_lo = 0, int r_hi = T, int b_lo = 0) {
    const int tid = fresh_tid(), lane = tid & 63, wave = __builtin_amdgcn_readfirstlane(tid >> 6);
    const int gw = ((int)blockIdx.x - b_lo) * 8 + wave, NGW = ((int)gridDim.x - b_lo) * 8;
    for (int r = r_lo + gw; r < r_hi; r += NGW) {
        const bf16_t* xr = xb + (size_t)r * D; const float* mb = mod + (size_t)batch_of(r) * 6144;
        float v[2][8]; float s = 0.f;
#pragma unroll
        for (int j = 0; j < 2; ++j) { const u32x4 x = *(const u32x4*)(xr + 8 * lane + 512 * j);
#pragma unroll
            for (int i = 0; i < 4; ++i) { v[j][2 * i] = bflo(x[i]); v[j][2 * i + 1] = bfhi(x[i]); s += v[j][2 * i] * v[j][2 * i] + v[j][2 * i + 1] * v[j][2 * i + 1]; } }
        const float rstd = __builtin_amdgcn_rsqf(wave_sum(s) * (1.f / D) + EPS);
#pragma unroll
        for (int j = 0; j < 2; ++j) { const int col = 8 * lane + 512 * j; f32x4 h[2];
#pragma unroll
            for (int q = 0; q < 2; ++q) { const f32x4 w = *(const f32x4*)(nw + col + 4 * q), sc = *(const f32x4*)(mb + sc_off + col + 4 * q), sh = *(const f32x4*)(mb + sh_off + col + 4 * q);
                const f32x4 x = {v[j][4 * q], v[j][4 * q + 1], v[j][4 * q + 2], v[j][4 * q + 3]}; h[q] = x * rstd * w * (sc + 1.f) + sh; }
            *(u32x4*)(H + (size_t)r * D + col) = pack_row8(h[0], h[1]); }
    }
}
DI void phase_final_norm(const bf16_t* xb, float* y, const float* nw, int r_lo = 0, int r_hi = T, int b_lo = 0) {
    const int tid = fresh_tid(), lane = tid & 63, wave = __builtin_amdgcn_readfirstlane(tid >> 6);
    const int gw = ((int)blockIdx.x - b_lo) * 8 + wave, NGW = ((int)gridDim.x - b_lo) * 8;
    for (int r = r_lo + gw; r < r_hi; r += NGW) { const bf16_t* xr = xb + (size_t)r * D; float* yr = y + (size_t)r * D;
        float v[2][8]; float s = 0.f;
#pragma unroll
        for (int j = 0; j < 2; ++j) { const u32x4 x = *(const u32x4*)(xr + 8 * lane + 512 * j);
#pragma unroll
            for (int i = 0; i < 4; ++i) { v[j][2 * i] = bflo(x[i]); v[j][2 * i + 1] = bfhi(x[i]); s += v[j][2 * i] * v[j][2 * i] + v[j][2 * i + 1] * v[j][2 * i + 1]; } }
        const float rstd = __builtin_amdgcn_rsqf(wave_sum(s) * (1.f / D) + EPS);
#pragma unroll
        for (int j = 0; j < 2; ++j) { const int col = 8 * lane + 512 * j;
#pragma unroll
            for (int q = 0; q < 2; ++q) { const f32x4 x = {v[j][4 * q], v[j][4 * q + 1], v[j][4 * q + 2], v[j][4 * q + 3]}; *(f32x4*)(yr + col + 4 * q) = x * rstd * *(const f32x4*)(nw + col + 4 * q); } }
    }
}

DI void phase_final_norm_parts(const bf16_t* x1b, const float* part0, const float* part1, const float* g2mod, float* y, const float* nw) {
    const int tid = fresh_tid(), lane = tid & 63, wave = __builtin_amdgcn_readfirstlane(tid >> 6);
    const int gw = blockIdx.x * 8 + wave, NGW = gridDim.x * 8;
    for (int r = TP + gw; r < T; r += NGW) { const float* gb = g2mod + (size_t)batch_of(r) * 6144; const size_t po = (size_t)(r - TP) * D;
        f32x4 v[4]; float s = 0.f;
#pragma unroll
        for (int j = 0; j < 4; ++j) { const int col = 4 * lane + 256 * j; const u32x2 xb = *(const u32x2*)(x1b + (size_t)r * D + col);
            const f32x4 x = {bflo(xb.x), bfhi(xb.x), bflo(xb.y), bfhi(xb.y)};
            v[j] = x + *(const f32x4*)(gb + col) * (*(const f32x4*)(part0 + po + col) + *(const f32x4*)(part1 + po + col));
            s += (v[j][0] * v[j][0] + v[j][1] * v[j][1]) + (v[j][2] * v[j][2] + v[j][3] * v[j][3]); }
        const float rstd = __builtin_amdgcn_rsqf(wave_sum(s) * (1.f / D) + EPS);
#pragma unroll
        for (int j = 0; j < 4; ++j) { const int col = 4 * lane + 256 * j; *(f32x4*)(y + (size_t)r * D + col) = v[j] * rstd * *(const f32x4*)(nw + col); }
    }
}

DI void hgrn_u_item(const Params& p, int item, int lane) {
    const int c = item >> 4, rem = item & 15, h = rem >> 2, kt = rem & 3, l31 = lane & 31, hf = lane >> 5;
    const float* CUM = (const float*)(p.ws + WS_CUM); const bf16_t* KA = (const bf16_t*)(p.ws + WS_KA); const bf16_t* VA = (const bf16_t*)(p.ws + WS_VA); bf16_t* U = (bf16_t*)(p.ws + WS_U);
    const size_t hb = (size_t)h * T * 128; const int kcol = 32 * kt + l31;
    const float tot = CUM[hb + (size_t)(c * 64 + 63) * 128 + kcol];
    bf16x8 kdf[2][2];
#pragma unroll
    for (int st = 0; st < 2; ++st) { f32x16 kd;
#pragma unroll
        for (int r = 0; r < 16; ++r) { const size_t idx = hb + (size_t)(c * 64 + 32 * st + crow(r, hf)) * 128 + kcol; kd[r] = bf2f((short)KA[idx]) * __expf(tot - CUM[idx]); }
        kdf[st][0] = pack8(kd, 0); kdf[st][1] = pack8(kd, 1); }
    const bf16x8 id0 = ident_frag(0, l31, hf), id1 = ident_frag(1, l31, hf);
#pragma unroll
    for (int vt = 0; vt < 4; ++vt) { f32x16 dacc = zero16();
#pragma unroll
        for (int st = 0; st < 2; ++st) { const bf16_t* vp = VA + hb + (size_t)(c * 64 + 32 * st + l31) * 128 + 32 * vt + 8 * hf;
            f32x16 vx = zero16(); vx = MFMA32(*(const bf16x8*)vp, id0, vx); vx = MFMA32(*(const bf16x8*)(vp + 16), id1, vx);
            dacc = MFMA32(kdf[st][0], pack8(vx, 0), dacc); dacc = MFMA32(kdf[st][1], pack8(vx, 1), dacc); }
        bf16_t* up = U + ((size_t)(c * 4 + h) * 128 + 32 * vt + l31) * 128 + 32 * kt + 8 * hf;
#pragma unroll
        for (int g = 0; g < 4; g += 2) { u32x2 o0, o1; o0.x = pk2(dacc[4 * g], dacc[4 * g + 1]); o0.y = pk2(dacc[4 * g + 2], dacc[4 * g + 3]); o1.x = pk2(dacc[4 * g + 4], dacc[4 * g + 5]); o1.y = pk2(dacc[4 * g + 6], dacc[4 * g + 7]);
            *(u32x4*)(up + 8 * g) = widen_pair(o0, o1); }
    }
}

DI void scan_prompt_item(const Params& p, int item, int lane) {
    const int bh = item >> 6, vp = item & 63, b = bh >> 2, h = bh & 3, kg = lane & 31, v0 = 2 * vp + (lane >> 5);
    const float* __restrict__ DEC = (const float*)(p.ws + WS_DEC) + (size_t)b * 256 * 512 + h * 128 + 4 * kg;
    const bf16_t* __restrict__ U = (const bf16_t*)(p.ws + WS_U) + ((size_t)(b * 256 * 4 + h) * 128 + v0) * 128 + 4 * kg;
    bf16_t* __restrict__ SST = (bf16_t*)(p.ws + WS_SST) + ((size_t)(b * 256 * 4 + h) * 128 + v0) * 128 + 4 * kg;
    f32x4 S0 = {0.f, 0.f, 0.f, 0.f};
    for (int n0 = 0; n0 < 256; n0 += 32) {
        f32x4 d[32]; u32x2 u[32];
#pragma unroll
        for (int i = 0; i < 32; ++i) { d[i] = *(const f32x4*)(DEC + (size_t)(n0 + i) * 512); u[i] = *(const u32x2*)(U + (size_t)(n0 + i) * 4 * 128 * 128); }
#pragma unroll
        for (int i = 0; i < 32; ++i) { u32x2 s; s.x = pk2(S0[0], S0[1]); s.y = pk2(S0[2], S0[3]); *(u32x2*)(SST + (size_t)(n0 + i) * 4 * 128 * 128) = s;
            S0[0] = d[i][0] * S0[0] + bflo(u[i].x); S0[1] = d[i][1] * S0[1] + bfhi(u[i].x); S0[2] = d[i][2] * S0[2] + bflo(u[i].y); S0[3] = d[i][3] * S0[3] + bfhi(u[i].y); }
    }
    float* sp = p.out + OFF_SP + ((size_t)bh * 128 + 4 * kg) * 128;
#pragma unroll
    for (int i = 0; i < 4; ++i) sp[(size_t)i * 128 + v0] = S0[i];
}
DI void scan_sample_item(const Params& p, int item, int lane) {
    const int bh = item >> 5, vq = item & 31, bs = bh >> 2, h = bh & 3, kg = lane & 31, vv = lane >> 5, c = 512 + bs;
    const float* DEC = (const float*)(p.ws + WS_DEC); const bf16_t* U = (const bf16_t*)(p.ws + WS_U); bf16_t* SST = (bf16_t*)(p.ws + WS_SST);
    const f32x4 d = *(const f32x4*)(DEC + (size_t)c * 512 + h * 128 + 4 * kg);
    const float* s0 = p.state + ((size_t)bh * 128 + 4 * kg) * 128; float* so = p.out + OFF_SS + ((size_t)bh * 128 + 4 * kg) * 128;
#pragma unroll
    for (int e = 0; e < 2; ++e) { const int v = 4 * vq + 2 * e + vv; const size_t o = ((size_t)(c * 4 + h) * 128 + v) * 128 + 4 * kg;
        const u32x2 u = *(const u32x2*)(U + o); f32x4 S;
#pragma unroll
        for (int i = 0; i < 4; ++i) S[i] = s0[(size_t)i * 128 + v];
        u32x2 s; s.x = pk2(S[0], S[1]); s.y = pk2(S[2], S[3]); *(u32x2*)(SST + o) = s;
        so[v] = d[0] * S[0] + bflo(u.x); so[128 + v] = d[1] * S[1] + bfhi(u.x); so[256 + v] = d[2] * S[2] + bflo(u.y); so[384 + v] = d[3] * S[3] + bfhi(u.y); }
}

DI void attn_item(const Params& p, int item, int lane, const LAS float* biasl) {
    const int c = item >> 3, h = item & 7, l31 = lane & 31, hf = lane >> 5;
    const bf16_t* KB = (const bf16_t*)(p.ws + WS_KB); const bf16_t* VB = (const bf16_t*)(p.ws + WS_VB);
    bf16x8 qf[2][4];
    { const bf16_t* qptr = (const bf16_t*)(p.ws + WS_QOB) + (size_t)(c * 64 + l31) * 1024 + 512 + h * 64;
#pragma unroll
    for (int qq = 0; qq < 2; ++qq)
#pragma unroll
        for (int ks = 0; ks < 4; ++ks) qf[qq][ks] = *(const bf16x8*)(qptr + (size_t)qq * 32 * 1024 + 16 * ks + 8 * hf); }
    const LAS float* bl = biasl + h * 192;
    f32x16 OT[2][2]; float mrun[2], lsum[2];
#pragma unroll
    for (int qq = 0; qq < 2; ++qq) { OT[qq][0] = zero16(); OT[qq][1] = zero16(); mrun[qq] = -1e30f; lsum[qq] = 0.f; }
    int ntile, ncache, db0, krow_first;
    if (c < 512) { const int n = c & 255, j0 = n < 8 ? n : 8; ntile = 2 * (j0 + 1); ncache = 0; db0 = 64 * j0; krow_first = (c - j0) * 64; }
    else { ntile = 18; ncache = 16; db0 = 512; krow_first = c * 64 - 512; }
    const int bs = c - 512;
    u32x4 nk[4], nv[4];
#define ATT_LOAD(i_) do { if ((i_) >= ncache) { const size_t ro_ = (((size_t)h * (T / 32) + (size_t)((krow_first >> 5) + (i_))) * 8 + hf) * 256 + l31 * 8;     \
            _Pragma("unroll") for (int ks = 0; ks < 4; ++ks) { nk[ks] = *(const u32x4*)(KB + ro_ + 512 * ks); nv[ks] = *(const u32x4*)(VB + ro_ + 512 * ks); } } } while (0)
    ATT_LOAD(0);
    for (int i = 0; i < ntile; ++i) {
        bf16x8 kf[4], vf[2][2];
        if (i < ncache) {
            const float* kp_ = p.cache_k + ((size_t)(bs * 512 + 32 * i + l31) * 8 + h) * 64 + 8 * hf; const float* vp_ = p.cache_v + ((size_t)(bs * 512 + 32 * i + l31) * 8 + h) * 64 + 8 * hf;
#pragma unroll
            for (int ks = 0; ks < 4; ++ks) { u32x4 w; const f32x4 a = *(const f32x4*)(kp_ + 16 * ks), b = *(const f32x4*)(kp_ + 16 * ks + 4), e = *(const f32x4*)(vp_ + 16 * ks), f = *(const f32x4*)(vp_ + 16 * ks + 4);
                w.x = pk2(a[0], a[1]); w.y = pk2(a[2], a[3]); w.z = pk2(b[0], b[1]); w.w = pk2(b[2], b[3]); kf[ks] = __builtin_bit_cast(bf16x8, w);
                w.x = pk2(e[0], e[1]); w.y = pk2(e[2], e[3]); w.z = pk2(f[0], f[1]); w.w = pk2(f[2], f[3]); vf[ks >> 1][ks & 1] = __builtin_bit_cast(bf16x8, w); }
        } else {
#pragma unroll
            for (int ks = 0; ks < 4; ++ks) { kf[ks] = __builtin_bit_cast(bf16x8, nk[ks]); vf[ks >> 1][ks & 1] = __builtin_bit_cast(bf16x8, nv[ks]); }
        }
        if (i + 1 < ntile) ATT_LOAD(i + 1);
        asm volatile("" ::: "memory");
        bf16x8 vxf[2][2];
        const int l31b = launder(l31); const bf16x8 id0 = ident_frag(0, l31b, hf), id1 = ident_frag(1, l31b, hf);
#pragma unroll
        for (int dt = 0; dt < 2; ++dt) { f32x16 vx = zero16(); vx = MFMA32(vf[dt][0], id0, vx); vx = MFMA32(vf[dt][1], id1, vx); vxf[dt][0] = pack8(vx, 0); vxf[dt][1] = pack8(vx, 1); }
#pragma unroll
        for (int qq = 0; qq < 2; ++qq) {
            f32x16 st = zero16();
#pragma unroll
            for (int ks = 0; ks < 4; ++ks) st = MFMA32(kf[ks], qf[qq][ks], st);
            const int dq = db0 + 32 * qq - 32 * i; float mt = -1e30f;
            if (dq - 31 >= 128) { const float bc = bl[191];
#pragma unroll
                for (int r = 0; r < 16; ++r) { const float s = st[r] * (0.125f * LOG2E) + bc; st[r] = s; mt = fmaxf(mt, s); }
            } else { const int dbase = dq + l31;
#pragma unroll
                for (int r = 0; r < 16; ++r) { int dist = dbase - crow(r, hf); dist = dist > 128 ? 128 : dist; const float s = st[r] * (0.125f * LOG2E) + bl[dist + 63]; st[r] = s; mt = fmaxf(mt, s); }
            }
            mt = fmaxf(mt, __shfl_xor(mt, 32));
            const float mnew = fmaxf(mrun[qq], mt), alpha = __builtin_amdgcn_exp2f(mrun[qq] - mnew); mrun[qq] = mnew;
            float ps = 0.f;
#pragma unroll
            for (int r = 0; r < 16; ++r) { st[r] = __builtin_amdgcn_exp2f(st[r] - mnew); ps += st[r]; }
            lsum[qq] = lsum[qq] * alpha + ps;
#pragma unroll
            for (int r = 0; r < 16; ++r) { OT[qq][0][r] *= alpha; OT[qq][1][r] *= alpha; }
            const bf16x8 pf0 = pack8(st, 0), pf1 = pack8(st, 1);
            OT[qq][0] = MFMA32(vxf[0][0], pf0, OT[qq][0]); OT[qq][0] = MFMA32(vxf[0][1], pf1, OT[qq][0]);
            OT[qq][1] = MFMA32(vxf[1][0], pf0, OT[qq][1]); OT[qq][1] = MFMA32(vxf[1][1], pf1, OT[qq][1]);
        }
    }
#undef ATT_LOAD
    bf16_t* qptr = (bf16_t*)(p.ws + WS_QOB) + (size_t)(c * 64 + launder(l31)) * 1024 + 512 + h * 64;
#pragma unroll
    for (int qq = 0; qq < 2; ++qq) { const float l = lsum[qq] + __shfl_xor(lsum[qq], 32), inv = 1.f / l; bf16_t* op = qptr + (size_t)qq * 32 * 1024;
#pragma unroll
        for (int dt = 0; dt < 2; ++dt)
#pragma unroll
            for (int g = 0; g < 4; g += 2) { u32x2 o0, o1; o0.x = pk2(OT[qq][dt][4 * g] * inv, OT[qq][dt][4 * g + 1] * inv); o0.y = pk2(OT[qq][dt][4 * g + 2] * inv, OT[qq][dt][4 * g + 3] * inv);
                o1.x = pk2(OT[qq][dt][4 * g + 4] * inv, OT[qq][dt][4 * g + 5] * inv); o1.y = pk2(OT[qq][dt][4 * g + 6] * inv, OT[qq][dt][4 * g + 7] * inv);
                *(u32x4*)(op + 32 * dt + 8 * (g + hf)) = widen_pair(o0, o1); } }
}

DI void hgrn_out_item(const Params& p, int item, int lane, bf16_t* obase = nullptr) {
    const int c = item >> 3, h = (item >> 1) & 3, tt = item & 1, l31 = lane & 31, hf = lane >> 5;
    const float* CUM = (const float*)(p.ws + WS_CUM); const bf16_t* KA = (const bf16_t*)(p.ws + WS_KA); const bf16_t* VA = (const bf16_t*)(p.ws + WS_VA);
    const bf16_t* GA = (const bf16_t*)(p.ws + WS_GA); const bf16_t* SST = (const bf16_t*)(p.ws + WS_SST);
    const int trow = c * 64 + 32 * tt + l31;
    bf16_t* qap = (bf16_t*)(p.ws + WS_QOB) + (size_t)trow * 1024 + h * 128;
    const size_t hb = (size_t)h * T * 128;
    const float* cumt = CUM + hb + (size_t)trow * 128; const float* refp = CUM + hb + (size_t)(c * 64 + 32) * 128;
    bf16x8 qd1[8], qd2[8], kdt[8];
    const bf16_t* kat = KA + hb + (size_t)trow * 128;
#pragma unroll
    for (int ks = 0; ks < 8; ++ks) { const int k0 = 16 * ks + 8 * hf; const bf16x8 q8 = *(const bf16x8*)(qap + k0), k8 = *(const bf16x8*)(kat + k0);
        const f32x4 c0 = *(const f32x4*)(cumt + k0), c1 = *(const f32x4*)(cumt + k0 + 4), r0 = *(const f32x4*)(refp + k0), r1 = *(const f32x4*)(refp + k0 + 4);
        float a[8], b[8], d[8];
#pragma unroll
        for (int j = 0; j < 8; ++j) { const float q = bf2f(q8[j]), cu = j < 4 ? c0[j & 3] : c1[j & 3], rf = j < 4 ? r0[j & 3] : r1[j & 3]; a[j] = q * __expf(cu - rf); b[j] = q * __expf(cu); d[j] = bf2f(k8[j]) * __expf(rf - cu); }
        qd1[ks] = pack8f(a); qd2[ks] = pack8f(b); kdt[ks] = pack8f(d); }
    f32x16 OT[4];
#pragma unroll
    for (int vt = 0; vt < 4; ++vt) OT[vt] = zero16();
    const bf16_t* sp = SST + ((size_t)(c * 4 + h) * 128 + l31) * 128 + 8 * hf;
#pragma unroll
    for (int vt = 0; vt < 4; ++vt) {
#pragma unroll
        for (int ks = 0; ks < 8; ++ks) OT[vt] = MFMA32(*(const bf16x8*)(sp + (size_t)vt * 32 * 128 + 16 * ks), qd2[ks], OT[vt]);
        __builtin_amdgcn_sched_barrier(0); }
    const bf16x8 id0 = ident_frag(0, l31, hf), id1 = ident_frag(1, l31, hf);
    for (int st = 0; st <= tt; ++st) {
        const int srow = c * 64 + 32 * st + l31; const bf16_t* kap = KA + hb + (size_t)srow * 128; const float* cums = CUM + hb + (size_t)srow * 128;
        f32x16 X = zero16();
        if (st == tt) {
#pragma unroll
            for (int ks = 0; ks < 8; ++ks) X = MFMA32(kdt[ks], qd1[ks], X);
        } else
#pragma unroll
        for (int ks = 0; ks < 8; ++ks) { const int k0 = 16 * ks + 8 * hf; const bf16x8 k8 = *(const bf16x8*)(kap + k0);
            const f32x4 c0 = *(const f32x4*)(cums + k0), c1 = *(const f32x4*)(cums + k0 + 4), r0 = *(const f32x4*)(refp + k0), r1 = *(const f32x4*)(refp + k0 + 4);
            float a[8];
#pragma unroll
            for (int j = 0; j < 8; ++j) { const float cu = j < 4 ? c0[j & 3] : c1[j & 3], rf = j < 4 ? r0[j & 3] : r1[j & 3]; a[j] = bf2f(k8[j]) * __expf(rf - cu); }
            X = MFMA32(pack8f(a), qd1[ks], X); }
        if (st == tt) {
#pragma unroll
            for (int r = 0; r < 16; ++r) if (crow(r, hf) > l31) X[r] = 0.f; }
        const bf16x8 xf0 = pack8(X, 0), xf1 = pack8(X, 1);
        const bf16_t* vp = VA + hb + (size_t)srow * 128 + 8 * hf;
#pragma unroll
        for (int vt = 0; vt < 4; ++vt) { f32x16 vx = zero16(); vx = MFMA32(*(const bf16x8*)(vp + 32 * vt), id0, vx); vx = MFMA32(*(const bf16x8*)(vp + 32 * vt + 16), id1, vx);
            OT[vt] = MFMA32(pack8(vx, 0), xf0, OT[vt]); OT[vt] = MFMA32(pack8(vx, 1), xf1, OT[vt]); }
    }
    float ss = 0.f;
#pragma unroll
    for (int vt = 0; vt < 4; ++vt)
#pragma unroll
        for (int r = 0; r < 16; ++r) ss += OT[vt][r] * OT[vt][r];
    ss += __shfl_xor(ss, 32);
    const float rstd = __builtin_amdgcn_rsqf(ss * (1.f / 128.f) + EPS);
    const bf16_t* gap = GA + hb + (size_t)trow * 128; const float* onp = p.out_norm + h * 128;
    if (obase) qap = obase + (size_t)trow * 512 + h * 128;
#pragma unroll
    for (int vt = 0; vt < 4; ++vt)
#pragma unroll
        for (int g = 0; g < 4; g += 2) { u32x2 ga0, ga1; narrow_pair(*(const u32x4*)(gap + 32 * vt + 8 * (g + hf)), ga0, ga1);
            u32x2 o0, o1;
            { const int v0 = 32 * vt + 8 * g + 4 * hf; const f32x4 on = *(const f32x4*)(onp + v0);
              o0.x = pk2(OT[vt][4 * g] * rstd * on[0] * bflo(ga0.x), OT[vt][4 * g + 1] * rstd * on[1] * bfhi(ga0.x)); o0.y = pk2(OT[vt][4 * g + 2] * rstd * on[2] * bflo(ga0.y), OT[vt][4 * g + 3] * rstd * on[3] * bfhi(ga0.y)); }
            { const int v0 = 32 * vt + 8 * (g + 1) + 4 * hf; const f32x4 on = *(const f32x4*)(onp + v0);
              o1.x = pk2(OT[vt][4 * g + 4] * rstd * on[0] * bflo(ga1.x), OT[vt][4 * g + 5] * rstd * on[1] * bfhi(ga1.x)); o1.y = pk2(OT[vt][4 * g + 6] * rstd * on[2] * bflo(ga1.y), OT[vt][4 * g + 7] * rstd * on[3] * bfhi(ga1.y)); }
            *(u32x4*)(qap + 32 * vt + 8 * (g + hf)) = widen_pair(o0, o1); }
}


#define XB_TMO      128
#define XB_XCNT(j)  (256  + 64 * (j))
#define XB_XSUB(j)  (1280 + 64 * (j))
#define XB_XGEN(j)  (2304 + 64 * (j))
#define XB_TOP      3328
#define XB_TOPGEN   3392
#define XCD_BAR_WORDS 3456
#define XB_SPIN_CAP (1u << 18)
DI unsigned xb_ld(unsigned* p)              { return __hip_atomic_load(p, __ATOMIC_RELAXED, __HIP_MEMORY_SCOPE_AGENT); }
DI unsigned xb_add(unsigned* p, unsigned v) { return __hip_atomic_fetch_add(p, v, __ATOMIC_RELAXED, __HIP_MEMORY_SCOPE_AGENT); }
DI unsigned xb_xcc_id() { return (unsigned)__builtin_amdgcn_s_getreg((3 << 11) | 20) & 0xFu; }
#define XB_SPIN(cond, bar) do { unsigned _sp = 0; while (cond) { __builtin_amdgcn_s_sleep(1); \
    if ((++_sp & 255u) == 0u) { if (xb_ld(&(bar)[XB_TMO])) break; if (_sp > XB_SPIN_CAP) { atomicAdd(&(bar)[XB_TMO], 1u); break; } } } } while (0)
struct XcdBarrier { unsigned* bar; unsigned x; volatile LAS unsigned* st; };
DI XcdBarrier xcd_barrier_post(unsigned* bar, volatile LAS unsigned* st) {
    XcdBarrier b; b.bar = bar; b.x = xb_xcc_id(); b.st = st;
    if (threadIdx.x == 0) (void)xb_add(&bar[XB_XCNT(b.x)], 1u);
    return b;
}
DI void xcd_barrier_complete(unsigned* bar, unsigned x, unsigned& nloc, unsigned& nx) {
    const unsigned G = gridDim.x * gridDim.y * gridDim.z;
    unsigned sum, cnt, mine, sp = 0u;
    for (;;) {
        sum = 0u; cnt = 0u; mine = 0u;
#pragma unroll
        for (unsigned j = 0; j < 16; ++j) { const unsigned c = xb_ld(&bar[XB_XCNT(j)]); sum += c; cnt += (c > 0u) ? 1u : 0u; mine = (j == x) ? c : mine; }
        if (sum == G) break;
        __builtin_amdgcn_s_sleep(1);
        if ((++sp & 255u) == 0u) { if (xb_ld(&bar[XB_TMO])) break; if (sp > XB_SPIN_CAP) { atomicAdd(&bar[XB_TMO], 1u); break; } }
    }
    nloc = mine > 0u ? mine : 1u; nx = cnt > 0u ? cnt : 1u;
}
DI void xcd_barrier(const XcdBarrier& b) {
    asm volatile("s_waitcnt vmcnt(0)" ::: "memory");
    __syncthreads();
    if (threadIdx.x == 0) {
        unsigned* bar = b.bar;
        __builtin_amdgcn_s_waitcnt(0);
        unsigned nloc = b.st[0], nx = b.st[1];
        if (nloc == 0u) { xcd_barrier_complete(bar, b.x, nloc, nx); b.st[0] = nloc; b.st[1] = nx; }
        const unsigned old = xb_add(&bar[XB_XSUB(b.x)], 1u);
        const unsigned gen = old / nloc;
        if (old + 1u == (gen + 1u) * nloc) {
            __builtin_amdgcn_fence(__ATOMIC_RELEASE, "agent");
            asm volatile("s_waitcnt vmcnt(0)" ::: "memory");
            const unsigned og = xb_add(&bar[XB_TOP], 1u);
            const unsigned tg = og / nx;
            if (og + 1u == (tg + 1u) * nx) xb_add(&bar[XB_TOPGEN], 1u);
            else XB_SPIN(xb_ld(&bar[XB_TOPGEN]) == tg, bar);
            __builtin_amdgcn_fence(__ATOMIC_ACQUIRE, "agent");
            xb_add(&bar[XB_XGEN(b.x)], 1u);
            asm volatile("s_waitcnt vmcnt(0)" ::: "memory");
        } else {
            XB_SPIN(xb_ld(&bar[XB_XGEN(b.x)]) == gen, bar);
            __builtin_amdgcn_fence(__ATOMIC_ACQUIRE, "agent");
            asm volatile("s_waitcnt vmcnt(0)" ::: "memory");
        }
    }
    __syncthreads();
}

__global__ void __launch_bounds__(512, 2) fwd_megakernel(Params p) {
    extern __shared__ __attribute__((aligned(16))) unsigned char lds_raw[];
    LAS unsigned char* lds = (LAS unsigned char*)lds_raw;
    cg::grid_group grid = cg::this_grid();
    const int G = gridDim.x, bx = blockIdx.x;
    volatile LAS unsigned* bst = (volatile LAS unsigned*)(lds + LDS_ST_OFF);
    if (threadIdx.x < 2) bst[threadIdx.x] = 0u;
    __syncthreads();
    const XcdBarrier xbar = xcd_barrier_post((unsigned*)(p.ws + WS_BAR), bst);
    if (threadIdx.x == 0) bst[2] = xb_add((unsigned*)(p.ws + WS_BAR) + 3712 + xbar.x, 1u);
#define GRID_BAR() xcd_barrier(xbar)
    unsigned char* ws = p.ws;
    float* MOD = (float*)(ws + WS_MOD); bf16_t* H = (bf16_t*)(ws + WS_H);

    phase_prep(p, lds);
    grid.sync();
    { pg8::Gemm g{(const bf16_t*)(ws + WS_SC), (const bf16_t*)(ws + WS_WADA), 256, 6144, 1024}; pg8::StaticOrder S; S.init(256, 6144, G, bx);
      EpiMod E{MOD, p.b_ada}; pg8::gemm_phase<EpiMod, pg8::StaticOrder, true, true>(lds, g, S, E); }
    GRID_BAR();
    int cv = bx;
    { unsigned* barw = (unsigned*)(p.ws + WS_BAR); bool uni = (G & 7) == 0;
#pragma unroll
      for (int j = 0; j < 16; ++j) { const unsigned c = xb_ld(&barw[XB_XCNT(j)]); uni = uni && (j < 8 ? c == (unsigned)(G >> 3) : c == 0u); }
      if (uni) cv = (int)xbar.x + 8 * (int)bst[2];
      cv = __builtin_amdgcn_readfirstlane(cv); }
    phase_norm_mod(p.x_prompt, p.x_sample, p.norm_mix, MOD, 0, 1024, H);
#if PROBE_DUP == 1
    GRID_BAR(); phase_norm_mod(p.x_prompt, p.x_sample, p.norm_mix, MOD, 0, 1024, H);
#endif
#if PROBE_DUP == 10
    GRID_BAR(); GRID_BAR(); GRID_BAR(); GRID_BAR(); GRID_BAR(); GRID_BAR(); GRID_BAR(); GRID_BAR(); GRID_BAR(); GRID_BAR();
#endif
    GRID_BAR();
    { pg8::Gemm g{H, (const bf16_t*)(ws + WS_WIN), T, INC, 1024}; pg8::StaticOrder S; S.init(T, INC, G, cv);
      EpiIn E{(bf16_t*)(ws + WS_QOB), (bf16_t*)(ws + WS_KA), (bf16_t*)(ws + WS_VA), (bf16_t*)(ws + WS_GA), (bf16_t*)(ws + WS_KB), (bf16_t*)(ws + WS_VB),
              (bf16_t*)(p.out), (bf16_t*)(p.out) + (size_t)T * 1024, (float*)(ws + WS_CUM), (float*)(ws + WS_DEC), p.lb_logits, p.out};
      pg8::gemm_phase<EpiIn, pg8::StaticOrder, true, true>(lds, g, S, E);
#if PROBE_DUP == 2
      GRID_BAR(); pg8::gemm_phase<EpiIn, pg8::StaticOrder, true, true>(lds, g, S, E);
#endif
    }
    GRID_BAR();
    { const int tid = fresh_tid(), lane = tid & 63, wave = __builtin_amdgcn_readfirstlane(tid >> 6);
      for (int it = wave * G + bx; it < NCH * 16; it += 8 * G) hgrn_u_item(p, it, lane);
#if PROBE_DUP == 3
      for (int it = wave * G + bx; it < NCH * 16; it += 8 * G) hgrn_u_item(p, it, lane);
#endif
    }
    GRID_BAR();
    {
        const int tid = fresh_tid(), lane = tid & 63, wave = __builtin_amdgcn_readfirstlane(tid >> 6);
        LAS float* biasl = (LAS float*)lds;
        for (int i = tid; i < 8 * 192; i += 512) biasl[i] = p.rel_bias[i] * LOG2E;
        __syncthreads();
#if PROBE_DUP == 41
        if (wave == 0) { for (int it = bx; it < 512; it += G) scan_prompt_item(p, it, lane); }
        GRID_BAR();
#endif
        if (wave == 0) { for (int it = bx; it < 512; it += G) scan_prompt_item(p, it, lane); }
        else {
            const int gw = (wave - 1) * G + bx, NGW = 7 * G;
            for (int it = gw; it < 4096; it += NGW) scan_sample_item(p, it, lane);
            const int x = __builtin_amdgcn_readfirstlane((int)xbar.x), ncu = __builtin_amdgcn_readfirstlane((int)bst[0]), nxcc = __builtin_amdgcn_readfirstlane((int)bst[1]), j = __builtin_amdgcn_readfirstlane((int)bst[2]);
            if (nxcc == 8 && x < 8 && ncu > 0 && j < ncu) {
                const int nslot = 7 * ncu, slot = (wave - 1) * ncu + j;
                for (int idx = slot; idx < 68 * 8; idx += nslot) { const int cc = idx >> 3, c = cc < 4 ? 512 + 4 * x + cc : 64 * x + (cc - 4); attn_item(p, c * 8 + (idx & 7), lane, biasl); }
            } else for (int it = gw; it < NCH * 8; it += NGW) attn_item(p, it, lane, biasl);
        }
    }
    GRID_BAR();
    { const int tid = fresh_tid(), lane = tid & 63, wave = __builtin_amdgcn_readfirstlane(tid >> 6);
#if PROBE_DUP == 5
      for (int it = wave * G + bx; it < NCH * 8; it += 8 * G) hgrn_out_item(p, it, lane, (bf16_t*)(ws + WS_U));
      GRID_BAR();
#endif
      for (int it = wave * G + bx; it < NCH * 8; it += 8 * G) hgrn_out_item(p, it, lane); }
    GRID_BAR();
    { pg8::Gemm g{(const bf16_t*)(ws + WS_QOB), (const bf16_t*)(ws + WS_WAB), T, 1024, 1024}; pg8::StaticOrder S; S.init(T, 1024, G, cv);
      EpiMerge E{(const bf16_t*)(p.out), (const bf16_t*)(p.out) + (size_t)T * 1024, (bf16_t*)(ws + WS_M)};
      pg8::gemm_phase<EpiMerge, pg8::StaticOrder, true, true>(lds, g, S, E); }
    GRID_BAR();
    const bool split_ps = G >= 64;
    { pg8::Gemm g{(const bf16_t*)(ws + WS_M), (const bf16_t*)(ws + WS_WO), T, 1024, 1024}; EpiRes<false> E{p.x_prompt, p.x_sample, nullptr, (bf16_t*)(ws + WS_X1B), MOD + 2048};
      if (split_ps) {
        { pg8::StaticOrder S; S.init(TP, 1024, G, cv); pg8::gemm_phase<EpiRes<false>, pg8::StaticOrder, true, true>(lds, g, S, E); }
        GRID_BAR();
        if (bx < 32) { pg8::StaticOrder S; S.init(TS, 1024, 32, bx, TP / 256); pg8::gemm_phase<EpiRes<false>, pg8::StaticOrder, true, true>(lds, g, S, E); }
        else phase_norm_mod_b((const bf16_t*)(ws + WS_X1B), p.norm_ffn, MOD, 3072, 4096, H, 0, TP, 32);
        GRID_BAR();
        phase_norm_mod_b((const bf16_t*)(ws + WS_X1B), p.norm_ffn, MOD, 3072, 4096, H, TP, T, 0);
      } else {
        pg8::StaticOrder S; S.init(T, 1024, G, cv); pg8::gemm_phase<EpiRes<false>, pg8::StaticOrder, true, true>(lds, g, S, E);
        GRID_BAR();
        phase_norm_mod_b((const bf16_t*)(ws + WS_X1B), p.norm_ffn, MOD, 3072, 4096, H);
      } }
    GRID_BAR();
    { pg8::Gemm g{H, (const bf16_t*)(ws + WS_WFI), T, INC, 1024}; pg8::StaticOrder S; S.init(T, INC, G, cv);
      EpiFfnIn E{(bf16_t*)(ws + WS_HID)}; pg8::gemm_phase<EpiFfnIn, pg8::StaticOrder, true, true>(lds, g, S, E);
#if PROBE_DUP == 9
      GRID_BAR(); pg8::gemm_phase<EpiFfnIn, pg8::StaticOrder, true, true>(lds, g, S, E);
#endif
    }
    GRID_BAR();
    { pg8::Gemm g{(const bf16_t*)(ws + WS_HID), (const bf16_t*)(ws + WS_WFO), T, 1024, FF}; EpiRes<true> E{nullptr, nullptr, (const bf16_t*)(ws + WS_X1B), (bf16_t*)(ws + WS_X2B), MOD + 5120};
      if (split_ps) {
        { pg8::StaticOrder S; S.init(TP, 1024, G, cv); pg8::gemm_phase<EpiRes<true>, pg8::StaticOrder, true, true>(lds, g, S, E); }
        GRID_BAR();
        float* PART = (float*)(ws + WS_CUM + 20 * MiB);
        if (bx < 64) { const int ks = bx >> 5; pg8::Gemm gs{(const bf16_t*)(ws + WS_HID) + ks * (FF / 2), (const bf16_t*)(ws + WS_WFO) + ks * (FF / 2), T, 1024, FF / 2, FF};
            pg8::StaticOrder S; S.init(TS, 1024, 32, bx & 31, TP / 256); EpiPart EP{PART + (size_t)ks * TS * D, TP}; pg8::gemm_phase<EpiPart, pg8::StaticOrder, true, true>(lds, gs, S, EP); }
        else phase_final_norm((const bf16_t*)(ws + WS_X2B), p.out, p.norm_final, 0, TP, 64);
        GRID_BAR();
        phase_final_norm_parts((const bf16_t*)(ws + WS_X1B), PART, PART + (size_t)TS * D, MOD + 5120, p.out, p.norm_final);
      } else {
        pg8::StaticOrder S; S.init(T, 1024, G, cv); pg8::gemm_phase<EpiRes<true>, pg8::StaticOrder, true, true>(lds, g, S, E);
        GRID_BAR();
        phase_final_norm((const bf16_t*)(ws + WS_X2B), p.out, p.norm_final);
      } }
}

extern "C" void kernel_launch(void* const* d_in, const int* in_sizes, int n_in, void* d_out, int out_size, void* d_ws, size_t ws_size, hipStream_t stream) {
    static int grid = 0;
    if (grid == 0) {
        if (n_in != 21 || (size_t)out_size != OUT_TOTAL || ws_size < WS_END) { fprintf(stderr, "kernel_launch: unexpected sizes n_in %d out %d ws %zu\n", n_in, out_size, ws_size); grid = -1; return; }
        int dev = 0, cus = 0, per = 0;
        (void)hipGetDevice(&dev); (void)hipDeviceGetAttribute(&cus, hipDeviceAttributeMultiprocessorCount, dev);
        (void)hipFuncSetAttribute((const void*)fwd_megakernel, hipFuncAttributeMaxDynamicSharedMemorySize, LDS_BYTES);
        (void)hipOccupancyMaxActiveBlocksPerMultiprocessor(&per, (const void*)fwd_megakernel, 512, LDS_BYTES);
        if (per < 1) per = 1;
        grid = cus * per; fprintf(stderr, "kernel_launch: grid %d (cus %d x %d)\n", grid, cus, per);
    }
    if (grid < 0) return;
    if (hipMemsetAsync((char*)d_ws + WS_BAR, 0, BAR_BYTES, stream) != hipSuccess) { fprintf(stderr, "kernel_launch: memset failed\n"); return; }
    Params p{};
    const float** f = (const float**)&p;
    for (int i = 0; i < 21; ++i) f[i] = (const float*)d_in[i];
    p.out = (float*)d_out; p.ws = (unsigned char*)d_ws;
    void* args[] = {&p};
    hipError_t e = hipLaunchCooperativeKernel((const void*)fwd_megakernel, dim3(grid), dim3(512), args, LDS_BYTES, stream);
    if (e != hipSuccess) fprintf(stderr, "cooperative launch failed: %s (grid %d)\n", hipGetErrorString(e), grid);
}
```

```cpp
#include <hip/hip_runtime.h>
#include <hip/hip_cooperative_groups.h>
#include <cstdio>
#include <cstdint>
namespace cg = cooperative_groups;
#ifndef PROBE_DUP
#define PROBE_DUP 0
#endif

#define DI __device__ __forceinline__
#define LAS __attribute__((address_space(3)))
typedef unsigned short bf16_t;
typedef short bf16x8 __attribute__((ext_vector_type(8)));
typedef float f32x4 __attribute__((ext_vector_type(4)));
typedef float f32x2 __attribute__((ext_vector_type(2)));
typedef float f32x16 __attribute__((ext_vector_type(16)));
typedef unsigned u32x4 __attribute__((ext_vector_type(4)));
typedef unsigned u32x2 __attribute__((ext_vector_type(2)));
typedef __bf16 bf2_t __attribute__((ext_vector_type(2)));

constexpr int D = 1024, TP = 32768, TS = 2048, T = TP + TS, NCH = T / 64, NBATCH = 34;
constexpr int INC = 5632, FF = 2816;
constexpr float EPS = 1e-6f, LOG2E = 1.4426950408889634f;
constexpr size_t OFF_Y = 0, OFF_SP = (size_t)T * D, OFF_KP = OFF_SP + 131072, OFF_VP = OFF_KP + 524288, OFF_SS = OFF_VP + 524288,
                 OFF_KS = OFF_SS + 2097152, OFF_VS = OFF_KS + 1048576, OUT_TOTAL = OFF_VS + 1048576;
constexpr size_t MiB = 1u << 20;
constexpr size_t WS_MOD = 1 * MiB, WS_DEC = 2 * MiB, WS_SC = 4 * MiB, WS_WADA = 5 * MiB, WS_WIN = 17 * MiB, WS_WAB = 28 * MiB, WS_WO = 30 * MiB,
                 WS_WFI = 32 * MiB, WS_WFO = 43 * MiB, WS_H = 50 * MiB, WS_QOB = 118 * MiB, WS_KA = 186 * MiB, WS_VA = 220 * MiB, WS_GA = 254 * MiB,
                 WS_KB = 288 * MiB, WS_VB = 322 * MiB, WS_CUM = 356 * MiB, WS_SST = 424 * MiB, WS_END = 492 * MiB;
constexpr size_t WS_U = WS_H, WS_M = WS_KA, WS_HID = WS_KA, WS_X1B = WS_QOB, WS_X2B = WS_H;
constexpr size_t WS_BAR = 0, BAR_BYTES = 16384;
constexpr int LDS_BYTES = 140 * 1024, LDS_ST_OFF = 136 * 1024;

struct Params {
    const float *x_prompt, *x_sample, *c_prompt, *c_sample, *state, *cache_k, *cache_v, *w_ada, *b_ada, *norm_mix, *w_in, *lb_logits, *out_norm,
                *w_a, *rel_bias, *w_b, *w_out, *norm_ffn, *w_ffn_in, *w_ffn_out, *norm_final;
    float* out; unsigned char* ws;
};

DI int fresh_tid() { int t = threadIdx.x; asm volatile("" : "+v"(t)); return t; }
DI int launder(int v) { asm volatile("" : "+v"(v)); return v; }
DI unsigned pk2(float a, float b) { f32x2 v = {a, b}; bf2_t r = __builtin_convertvector(v, bf2_t); return __builtin_bit_cast(unsigned, r); }
DI float bflo(unsigned u) { return __uint_as_float(u << 16); }
DI float bfhi(unsigned u) { return __uint_as_float(u & 0xffff0000u); }
DI float bf2f(short s) { return __uint_as_float(((unsigned)(unsigned short)s) << 16); }
DI float sigm(float x) { return __builtin_amdgcn_rcpf(1.f + __expf(-x)); }
DI float silu(float x) { return x * sigm(x); }
DI int batch_of(int r) { return r < TP ? (r >> 14) : 2 + ((r - TP) >> 6); }
DI int crow(int reg, int h) { return (reg & 3) + 8 * (reg >> 2) + 4 * h; }
DI bf16x8 pack8(const f32x16& x, int s) {
    u32x4 p; p.x = pk2(x[8 * s], x[8 * s + 1]); p.y = pk2(x[8 * s + 2], x[8 * s + 3]); p.z = pk2(x[8 * s + 4], x[8 * s + 5]); p.w = pk2(x[8 * s + 6], x[8 * s + 7]);
    return __builtin_bit_cast(bf16x8, p);
}
DI bf16x8 pack8f(const float* v) { u32x4 p; p.x = pk2(v[0], v[1]); p.y = pk2(v[2], v[3]); p.z = pk2(v[4], v[5]); p.w = pk2(v[6], v[7]); return __builtin_bit_cast(bf16x8, p); }
DI bf16x8 ident_frag(int ks, int l31, int hf) {
    const int jj = l31 - 16 * ks - 8 * hf; bf16x8 r;
#pragma unroll
    for (int j = 0; j < 8; ++j) r[j] = (j == jj) ? (short)0x3F80 : (short)0;
    return r;
}
DI u32x4 widen_pair(u32x2 pg, u32x2 pg1) { const auto rx = __builtin_amdgcn_permlane32_swap(pg.x, pg1.x, false, false), ry = __builtin_amdgcn_permlane32_swap(pg.y, pg1.y, false, false); return (u32x4){rx[0], ry[0], rx[1], ry[1]}; }
DI void narrow_pair(u32x4 d, u32x2& pg, u32x2& pg1) { const auto rx = __builtin_amdgcn_permlane32_swap(d.x, d.z, false, false), ry = __builtin_amdgcn_permlane32_swap(d.y, d.w, false, false); pg = (u32x2){rx[0], ry[0]}; pg1 = (u32x2){rx[1], ry[1]}; }
#define MFMA32(a, b, c) __builtin_amdgcn_mfma_f32_32x32x16_bf16((a), (b), (c), 0, 0, 0)
DI f32x16 zero16() { f32x16 z;
#pragma unroll
    for (int i = 0; i < 16; ++i) z[i] = 0.f; return z; }

namespace pg8 {
constexpr int BM = 256, BK = 64, HALF = 128, HTB = HALF * BK * 2, STAGE_BYTES = 8 * HTB, NXCD = 8, WGM = 8;
__host__ __device__ __forceinline__ int lds_byte(int r, int c) { const int st = (r >> 4) * 2 + (c >> 5), rr = r & 15, cc = c & 31, ob = rr * 64 + cc * 2; return st * 1024 + (ob ^ (((ob >> 9) & 1) << 5)); }
__host__ __device__ __forceinline__ void stage_rc(int b, int& R, int& C) { const int st = b / 1024, sb = b % 1024, swz = sb ^ (((sb >> 9) & 1) << 5); R = (st >> 1) * 16 + swz / 64; C = (st & 1) * 32 + (swz % 64) / 2; }
__host__ __device__ __forceinline__ int perm32(int rho) { const int n = rho >> 4, i = rho & 15; return 8 * (i >> 2) + 4 * n + (i & 3); }
struct Unit { int pm, pn; };
struct Gemm { const bf16_t* A; const bf16_t* Bt; int M, N, K, ld; };
struct StaticOrder {
    int nM, nN, nwg, G, c, pm_off;
    __device__ void init(int M, int N, int G_, int c_, int pm_off_ = 0) { nM = M / BM; nN = N / BM; nwg = nM * nN; G = G_; c = c_; pm_off = pm_off_; }
    __device__ bool next(int i, Unit& u) const {
        const long L = (long)i * G + c; if (L >= nwg) return false;
        int wgid = (int)L; { const int q = nwg / NXCD, r = nwg % NXCD, xcd = wgid % NXCD, off = wgid / NXCD; wgid = (xcd < r ? xcd * (q + 1) : r * (q + 1) + (xcd - r) * q) + off; }
        const int nig = WGM * nN, gid = wgid / nig, fm = gid * WGM, gsz = (nM - fm) < WGM ? (nM - fm) : WGM;
        u.pm = pm_off + fm + ((wgid % nig) % gsz); u.pn = (wgid % nig) / gsz; return true;
    }
};
template <class Epi, class Sched, bool ALIGN_EPI = false, bool SP2 = false>
__device__ __forceinline__ void gemm_phase(LAS unsigned char* lds, const Gemm g, const Sched& S, const Epi& E) {
    const int tid = fresh_tid(), wid = __builtin_amdgcn_readfirstlane(tid >> 6), lane = tid & 63, wr = wid >> 2, wc = wid & 3, fr = lane & 15, fq = lane >> 4;
    const int K = g.ld ? g.ld : g.K, nt = g.K / BK;
    unsigned voffA[2], voffB[2];
#pragma unroll
    for (int i = 0; i < 2; ++i) { int R, C; stage_rc(tid * 16 + i * 8192, R, C); const int Rb = Epi::PERM ? ((R & ~31) + perm32(R & 31)) : R;
        voffA[i] = (unsigned)(R * K + C) * 2u; voffB[i] = (unsigned)(Rb * K + C) * 2u; }
    const size_t kstep = (size_t)(BK * 2);
    const size_t hstep = (size_t)HALF * K * 2;
    const size_t tstep = 2 * hstep;
    const unsigned ldsw = (unsigned)wid * 1024u;
    const int aoff = lds_byte(wr * 64 + fr, fq * 8), boff = lds_byte(wc * 32 + fr, fq * 8);
#define PG8_SA(b, h) (((b) * 2 + (h)) * HTB)
#define PG8_SB(b, h) ((4 + (b) * 2 + (h)) * HTB)
#define PG8_STAGE(bufoff, gbase, voff) do { _Pragma("unroll") for (int _i = 0; _i < 2; ++_i) \
        __builtin_amdgcn_global_load_lds((const unsigned*)((const char*)(gbase) + (voff)[_i]), (LAS unsigned*)(lds + (bufoff) + ldsw + _i * 8192), 16, 0, 0); } while (0)
#define PG8_LDA(dst, b, h) do { _Pragma("unroll") for (int m = 0; m < 4; ++m) _Pragma("unroll") for (int k = 0; k < 2; ++k) dst[m][k] = *(const LAS bf16x8*)(lds + PG8_SA(b, h) + aoff + m * 2048 + k * 1024); } while (0)
#define PG8_LDB(dst, b, h) do { _Pragma("unroll") for (int n = 0; n < 2; ++n) _Pragma("unroll") for (int k = 0; k < 2; ++k) dst[n][k] = *(const LAS bf16x8*)(lds + PG8_SB(b, h) + boff + n * 2048 + k * 1024); } while (0)
#define PG8_MMA(ai, bj, At, Bt) do { __builtin_amdgcn_s_setprio(1); _Pragma("unroll") for (int m = 0; m < 4; ++m) _Pragma("unroll") for (int n = 0; n < 2; ++n) _Pragma("unroll") for (int k = 0; k < 2; ++k) \
        acc[ai][bj][m][n] = __builtin_amdgcn_mfma_f32_16x16x32_bf16(Bt[n][k], At[m][k], acc[ai][bj][m][n], 0, 0, 0); __builtin_amdgcn_s_setprio(0); } while (0)
#define PG8_WAIT_V(n) asm volatile("s_waitcnt vmcnt(" #n ")" ::: "memory")
#define PG8_WAIT_L(n) asm volatile("s_waitcnt lgkmcnt(" #n ")" ::: "memory")
#define PG8_BAR __builtin_amdgcn_s_barrier()
#define PG8_SCHED __builtin_amdgcn_sched_barrier(0)
    Unit cur, nxt; int ui = 0;
    if (!S.next(0, cur)) return;
    f32x4 acc[2][2][4][2];
#pragma unroll
    for (int a = 0; a < 2; ++a)
#pragma unroll
        for (int b = 0; b < 2; ++b)
#pragma unroll
            for (int m = 0; m < 4; ++m)
#pragma unroll
                for (int n = 0; n < 2; ++n) acc[a][b][m][n] = (f32x4){0.f, 0.f, 0.f, 0.f};
    bf16x8 At[4][2], B0[2][2], B1[2][2];
    const char* cA = (const char*)g.A + (size_t)cur.pm * tstep; const char* cB = (const char*)g.Bt + (size_t)cur.pn * tstep;
    if constexpr (SP2) {
        PG8_STAGE(PG8_SB(0, 0), cB, voffB); PG8_STAGE(PG8_SB(0, 1), cB + hstep, voffB); PG8_STAGE(PG8_SA(0, 0), cA, voffA); PG8_STAGE(PG8_SA(0, 1), cA + hstep, voffA);
        if (wr == 1) PG8_BAR;
        PG8_WAIT_V(2); PG8_BAR;
        PG8_STAGE(PG8_SB(1, 0), cB + kstep, voffB); PG8_STAGE(PG8_SA(1, 0), cA + kstep, voffA); PG8_STAGE(PG8_SB(1, 1), cB + hstep + kstep, voffB);
        PG8_WAIT_V(6); PG8_BAR;
    } else {
        PG8_STAGE(PG8_SB(0, 0), cB, voffB); PG8_STAGE(PG8_SA(0, 0), cA, voffA); PG8_STAGE(PG8_SB(0, 1), cB + hstep, voffB); PG8_STAGE(PG8_SA(0, 1), cA + hstep, voffA);
        if (wr == 1) PG8_BAR;
        PG8_WAIT_V(4); PG8_BAR;
        PG8_STAGE(PG8_SB(1, 0), cB + kstep, voffB); PG8_STAGE(PG8_SA(1, 0), cA + kstep, voffA); PG8_STAGE(PG8_SB(1, 1), cB + hstep + kstep, voffB);
        PG8_WAIT_V(6); PG8_BAR;
    }
    for (;;) {
        const bool has_next = S.next(ui + 1, nxt);
        const char* nA = has_next ? (const char*)g.A + (size_t)nxt.pm * tstep : cA; const char* nB = has_next ? (const char*)g.Bt + (size_t)nxt.pn * tstep : cB;
        for (int t = 0; t < nt; t += 2) {
            if constexpr (Epi::MIDK) { if (t == nt / 2) E.mid(acc, cur, wr, wc, fr, fq); }
            const bool last = (t == nt - 2);
            const char* a1 = cA + (size_t)(t + 1) * kstep;
            const char* a2 = last ? nA : cA + (size_t)(t + 2) * kstep; const char* b2 = last ? nB : cB + (size_t)(t + 2) * kstep;
            const char* a3 = a2 + kstep; const char* b3 = b2 + kstep;
            if constexpr (SP2) {
            PG8_LDB(B0, 0, 0); PG8_LDB(B1, 0, 1); PG8_SCHED; PG8_LDA(At, 0, 0); PG8_STAGE(PG8_SA(1, 1), a1 + hstep, voffA);
            PG8_WAIT_V(8); PG8_WAIT_L(0); PG8_BAR; PG8_MMA(0, 0, At, B0); PG8_MMA(0, 1, At, B1); PG8_BAR; PG8_SCHED;
            PG8_LDA(At, 0, 1); PG8_STAGE(PG8_SB(0, 0), b2, voffB); PG8_STAGE(PG8_SB(0, 1), b2 + hstep, voffB); PG8_STAGE(PG8_SA(0, 0), a2, voffA);
            PG8_WAIT_V(8); PG8_WAIT_L(0); PG8_BAR; PG8_MMA(1, 0, At, B0); PG8_MMA(1, 1, At, B1); PG8_BAR; PG8_SCHED;
            PG8_LDB(B0, 1, 0); PG8_LDB(B1, 1, 1); PG8_SCHED; PG8_LDA(At, 1, 0); PG8_STAGE(PG8_SA(0, 1), a2 + hstep, voffA);
            PG8_WAIT_V(8); PG8_WAIT_L(0); PG8_BAR; PG8_MMA(0, 0, At, B0); PG8_MMA(0, 1, At, B1); PG8_BAR; PG8_SCHED;
            PG8_LDA(At, 1, 1); PG8_STAGE(PG8_SB(1, 0), b3, voffB); PG8_STAGE(PG8_SB(1, 1), b3 + hstep, voffB); PG8_STAGE(PG8_SA(1, 0), a3, voffA);
            PG8_WAIT_V(8); PG8_WAIT_L(0); PG8_BAR; PG8_MMA(1, 0, At, B0); PG8_MMA(1, 1, At, B1); PG8_BAR; PG8_SCHED;
            } else {
            PG8_LDB(B0, 0, 0); PG8_SCHED; PG8_LDA(At, 0, 0); PG8_STAGE(PG8_SA(1, 1), a1 + hstep, voffA);
            PG8_WAIT_L(8); PG8_BAR; PG8_WAIT_L(0); PG8_MMA(0, 0, At, B0); PG8_BAR; PG8_SCHED;
            PG8_LDB(B1, 0, 1); PG8_STAGE(PG8_SB(0, 0), b2, voffB);
            PG8_BAR; PG8_WAIT_L(0); PG8_MMA(0, 1, At, B1); PG8_BAR;
            PG8_LDA(At, 0, 1); PG8_STAGE(PG8_SA(0, 0), a2, voffA);
            PG8_BAR; PG8_WAIT_L(0); PG8_MMA(1, 0, At, B0); PG8_BAR; PG8_SCHED;
            PG8_STAGE(PG8_SB(0, 1), b2 + hstep, voffB);
            PG8_WAIT_V(6); PG8_BAR; PG8_MMA(1, 1, At, B1); PG8_BAR;
            PG8_LDB(B0, 1, 0); PG8_SCHED; PG8_LDA(At, 1, 0); PG8_STAGE(PG8_SA(0, 1), a2 + hstep, voffA);
            PG8_WAIT_L(8); PG8_BAR; PG8_WAIT_L(0); PG8_MMA(0, 0, At, B0); PG8_BAR; PG8_SCHED;
            PG8_LDB(B1, 1, 1); PG8_STAGE(PG8_SB(1, 0), b3, voffB);
            PG8_BAR; PG8_WAIT_L(0); PG8_MMA(0, 1, At, B1); PG8_BAR;
            PG8_LDA(At, 1, 1); PG8_STAGE(PG8_SA(1, 0), a3, voffA);
            PG8_BAR; PG8_WAIT_L(0); PG8_MMA(1, 0, At, B0); PG8_BAR; PG8_SCHED;
            PG8_STAGE(PG8_SB(1, 1), b3 + hstep, voffB);
            PG8_WAIT_V(6); PG8_BAR; PG8_MMA(1, 1, At, B1); PG8_BAR;
            }
        }
        if constexpr (ALIGN_EPI) { if (wr == 0) PG8_BAR; }
        E(acc, cur, wr, wc, fr, fq);
        if (!has_next) break;
#pragma unroll
        for (int a = 0; a < 2; ++a)
#pragma unroll
            for (int b = 0; b < 2; ++b)
#pragma unroll
                for (int m = 0; m < 4; ++m)
#pragma unroll
                    for (int n = 0; n < 2; ++n) acc[a][b][m][n] = (f32x4){0.f, 0.f, 0.f, 0.f};
        cur = nxt; cA = nA; cB = nB; ++ui;
        if constexpr (ALIGN_EPI) { if (wr == 1) PG8_BAR; }
    }
    PG8_WAIT_V(0);
    if constexpr (!ALIGN_EPI) { if (wr == 0) PG8_BAR; }
    PG8_BAR;
#undef PG8_SA
#undef PG8_SB
#undef PG8_STAGE
#undef PG8_LDA
#undef PG8_LDB
#undef PG8_MMA
#undef PG8_WAIT_V
#undef PG8_WAIT_L
#undef PG8_BAR
#undef PG8_SCHED
}
}
using pg8::Unit;
typedef f32x4 Acc[2][2][4][2];

DI u32x4 pack_row8(const f32x4& v0, const f32x4& v1) { u32x4 w; w.x = pk2(v0[0], v0[1]); w.y = pk2(v0[2], v0[3]); w.z = pk2(v1[0], v1[1]); w.w = pk2(v1[2], v1[3]); return w; }

struct EpiMod {
    static constexpr bool PERM = false, MIDK = false;
    float* mod; const float* bias;
    DI void operator()(Acc& acc, const Unit& u, int wr, int wc, int fr, int fq) const {
        { const int t_ = fresh_tid(); fr = t_ & 15; fq = (t_ >> 4) & 3; }
        if (u.pm != 0 || wr != 0) return;
#pragma unroll
        for (int m = 0; m < 3; ++m) { const int r = 16 * m + fr; if (r < NBATCH) {
#pragma unroll
            for (int bj = 0; bj < 2; ++bj)
#pragma unroll
                for (int n = 0; n < 2; ++n) { const int col = u.pn * 256 + bj * 128 + wc * 32 + n * 16 + 4 * fq;
                    *(f32x4*)(mod + (size_t)r * 6144 + col) = acc[0][bj][m][n] + *(const f32x4*)(bias + col); } } }
    }
};

struct EpiIn {
    static constexpr bool PERM = true, MIDK = false;
    bf16_t *QOB, *KA, *VA, *GA, *KB, *VB, *SGA, *SGB; float *CUM, *DEC; const float* lbl; float* out;
    DI void operator()(Acc& acc, const Unit& u, int wr, int wc, int fr, int fq) const {
        { const int t_ = fresh_tid(); fr = t_ & 15; fq = (t_ >> 4) & 3; }
        const int pn = u.pn, rt = wr * 64 + fr, row0 = u.pm * 256 + rt, cw = wc * 32 + 8 * fq, lane = fq * 16 + fr;
        if (pn >= 14) {
            const size_t o0 = ((size_t)(u.pm * 8 + (pn - 14)) * 8 * 512 + (size_t)(wr * 4 + wc) * 64 + lane) * 8;
#pragma unroll
            for (int ai = 0; ai < 2; ++ai)
#pragma unroll
                for (int m = 0; m < 4; ++m) { f32x4 r0, r1, b0, b1;
#pragma unroll
                    for (int j = 0; j < 4; ++j) { b0[j] = fmaxf(sigm(acc[ai][1][m][0][j]), 1e-30f); b1[j] = fmaxf(sigm(acc[ai][1][m][1][j]), 1e-30f);
                        r0[j] = sigm(acc[ai][0][m][0][j]) * __builtin_amdgcn_rcpf(b0[j]); r1[j] = sigm(acc[ai][0][m][1][j]) * __builtin_amdgcn_rcpf(b1[j]); }
                    const size_t o = o0 + (size_t)(ai * 4 + m) * 512 * 8;
                    *(u32x4*)(SGA + o) = pack_row8(r0, r1); *(u32x4*)(SGB + o) = pack_row8(b0, b1); __builtin_amdgcn_sched_barrier(0); }
            return;
        }
        const int seg = pn >> 1, col0 = (pn & 1) * 256 + cw;
        if (seg == 1) {
#pragma unroll
            for (int bj = 0; bj < 2; ++bj) {
                float lb[2][4];
#pragma unroll
                for (int n = 0; n < 2; ++n)
#pragma unroll
                    for (int j = 0; j < 4; ++j) { const int c = col0 + bj * 128 + 4 * n + j; lb[n][j] = __builtin_amdgcn_rcpf(1.f + __expf(lbl[512 + c] - lbl[c])); }
#pragma unroll
                for (int ai = 0; ai < 2; ++ai) {
                    const size_t rbase = ((size_t)((pn & 1) * 2 + bj) * T + (u.pm * 256 + ai * 128 + wr * 64 + launder(fr))) * 128 + cw;
#pragma unroll
                    for (int m = 0; m < 4; ++m) { f32x4 k0, k1;
#pragma unroll
                        for (int j = 0; j < 4; ++j) {
                            float f = lb[0][j] + (1.f - lb[0][j]) * sigm(acc[ai][bj][m][0][j]); k0[j] = 1.f - f; acc[ai][bj][m][0][j] = __logf(f);
                            f = lb[1][j] + (1.f - lb[1][j]) * sigm(acc[ai][bj][m][1][j]); k1[j] = 1.f - f; acc[ai][bj][m][1][j] = __logf(f); }
                        *(u32x4*)(KA + rbase + (size_t)m * 16 * 128) = pack_row8(k0, k1); }
                    __builtin_amdgcn_sched_barrier(0);
#pragma unroll
                    for (int n = 0; n < 2; ++n)
#pragma unroll
                        for (int j = 0; j < 4; ++j) { float carry = 0.f;
#pragma unroll
                            for (int m = 0; m < 4; ++m) { float v = acc[ai][bj][m][n][j];
                                v += __int_as_float(__builtin_amdgcn_update_dpp(0, __float_as_int(v), 0x111, 0xf, 0xf, false));
                                v += __int_as_float(__builtin_amdgcn_update_dpp(0, __float_as_int(v), 0x112, 0xf, 0xf, false));
                                v += __int_as_float(__builtin_amdgcn_update_dpp(0, __float_as_int(v), 0x114, 0xf, 0xf, false));
                                v += __int_as_float(__builtin_amdgcn_update_dpp(0, __float_as_int(v), 0x118, 0xf, 0xf, false));
                                v += carry; carry = __shfl(v, lane | 15); acc[ai][bj][m][n][j] = v; } }
                    __builtin_amdgcn_sched_barrier(0);
#pragma unroll
                    for (int m = 0; m < 4; ++m) { float* cp = CUM + rbase + (size_t)m * 16 * 128; *(f32x4*)cp = acc[ai][bj][m][0]; *(f32x4*)(cp + 4) = acc[ai][bj][m][1]; }
                    if (fr == 15) {
#pragma unroll
                        for (int n = 0; n < 2; ++n) { f32x4 e;
#pragma unroll
                            for (int j = 0; j < 4; ++j) e[j] = __expf(acc[ai][bj][3][n][j]);
                            *(f32x4*)(DEC + (size_t)(u.pm * 4 + ai * 2 + wr) * 512 + col0 + bj * 128 + 4 * n) = e; } }
                    __builtin_amdgcn_sched_barrier(0);
                }
            }
            return;
        }
        bf16_t* dst; int pitch = 512; size_t bjoff = 128; float* o32 = nullptr;
        switch (seg) {
            case 0: dst = QOB + col0; pitch = 1024; break;
            case 2: dst = VA + (size_t)((pn & 1) * 2) * T * 128 + (cw >> 3) * 256; bjoff = (size_t)T * 128; break;
            case 3: dst = GA + (size_t)((pn & 1) * 2) * T * 128 + cw; pitch = 128; bjoff = (size_t)T * 128; break;
            case 4: dst = QOB + 512 + col0; pitch = 1024; break;
            default: dst = (seg == 5 ? KB : VB) + (size_t)((pn & 1) * 4 + (wc >> 1)) * (T / 32) * 2048 + ((wc & 1) * 4 + fq) * 256; bjoff = (size_t)2 * (T / 32) * 2048; break;
        }
        if (seg >= 5) {
            if (u.pm >= 128) o32 = out + (seg == 5 ? OFF_KS : OFF_VS) + (size_t)((u.pm - 128) * 256 + rt) * 512 + col0;
            else if ((u.pm & 63) >= 62) o32 = out + (seg == 5 ? OFF_KP : OFF_VP) + (size_t)((u.pm >> 6) * 512 + ((u.pm & 63) - 62) * 256 + rt) * 512 + col0;
        }
        const bool act = (seg == 0 || seg == 3);
#pragma unroll
        for (int ai = 0; ai < 2; ++ai)
#pragma unroll
            for (int m = 0; m < 4; ++m)
#pragma unroll
                for (int bj = 0; bj < 2; ++bj) { f32x4 v0 = acc[ai][bj][m][0], v1 = acc[ai][bj][m][1];
                    if (act) {
#pragma unroll
                        for (int j = 0; j < 4; ++j) { v0[j] = silu(v0[j]); v1[j] = silu(v1[j]); } }
                    const size_t ro = seg >= 5 ? (size_t)(u.pm * 8 + 2 * wr + 4 * ai + (m >> 1)) * 2048 + ((m & 1) * 16 + fr) * 8 : seg == 2 ? (size_t)(u.pm * 8 + 2 * wr + 4 * ai + (m >> 1)) * 4096 + ((m & 1) * 16 + fr) * 8 : (size_t)(row0 + ai * 128 + m * 16) * pitch;
                    *(u32x4*)(dst + ro + bj * bjoff) = pack_row8(v0, v1);
                    if (o32) { float* op = o32 + (size_t)(ai * 128 + m * 16) * 512 + bj * 128; *(f32x4*)op = v0; *(f32x4*)(op + 4) = v1; } __builtin_amdgcn_sched_barrier(0); }
    }
};

struct EpiMerge {
    static constexpr bool PERM = true, MIDK = true;
    const bf16_t *SGR, *SGB; bf16_t* Mo;
    DI void mid(Acc& acc, const Unit& u, int wr, int wc, int fr, int fq) const {
        { const int t_ = fresh_tid(); fr = t_ & 15; fq = (t_ >> 4) & 3; }
        const size_t gb = ((size_t)(u.pm * 8 + 2 * u.pn) * 8 * 512 + (size_t)(wr * 4 + wc) * 64 + (fq * 16 + fr)) * 8;
#pragma unroll
        for (int ai = 0; ai < 2; ++ai) { u32x4 a[4][2];
#pragma unroll
            for (int m = 0; m < 4; ++m)
#pragma unroll
                for (int bj = 0; bj < 2; ++bj) a[m][bj] = *(const u32x4*)(SGR + gb + ((size_t)bj * 8 + ai * 4 + m) * 512 * 8);
#pragma unroll
            for (int m = 0; m < 4; ++m)
#pragma unroll
                for (int bj = 0; bj < 2; ++bj)
#pragma unroll
                    for (int j = 0; j < 4; ++j) { acc[ai][bj][m][j >> 1][(j & 1) * 2] *= bflo(a[m][bj][j]); acc[ai][bj][m][j >> 1][(j & 1) * 2 + 1] *= bfhi(a[m][bj][j]); }
            __builtin_amdgcn_sched_barrier(0); }
    }
    DI void operator()(Acc& acc, const Unit& u, int wr, int wc, int fr, int fq) const {
        { const int t_ = fresh_tid(); fr = t_ & 15; fq = (t_ >> 4) & 3; }
        const size_t base = (size_t)(u.pm * 256 + wr * 64 + fr) * 1024 + u.pn * 256 + wc * 32 + 8 * fq;
        const size_t gb = ((size_t)(u.pm * 8 + 2 * u.pn) * 8 * 512 + (size_t)(wr * 4 + wc) * 64 + (fq * 16 + fr)) * 8;
#pragma unroll
        for (int ai = 0; ai < 2; ++ai) { u32x4 b[4][2];
#pragma unroll
            for (int m = 0; m < 4; ++m)
#pragma unroll
                for (int bj = 0; bj < 2; ++bj) b[m][bj] = *(const u32x4*)(SGB + gb + ((size_t)bj * 8 + ai * 4 + m) * 512 * 8);
#pragma unroll
            for (int m = 0; m < 4; ++m)
#pragma unroll
                for (int bj = 0; bj < 2; ++bj) { f32x4 v0 = acc[ai][bj][m][0], v1 = acc[ai][bj][m][1]; const u32x4 g = b[m][bj];
                    v0[0] *= bflo(g[0]); v0[1] *= bfhi(g[0]); v0[2] *= bflo(g[1]); v0[3] *= bfhi(g[1]);
                    v1[0] *= bflo(g[2]); v1[1] *= bfhi(g[2]); v1[2] *= bflo(g[3]); v1[3] *= bfhi(g[3]);
                    *(u32x4*)(Mo + base + (size_t)(ai * 128 + m * 16) * 1024 + bj * 128) = pack_row8(v0, v1); }
            __builtin_amdgcn_sched_barrier(0); }
    }
};

template <bool BASE_BF16> struct EpiRes {
    static constexpr bool PERM = true, MIDK = false;
    const float *xp, *xs; const bf16_t* xb; bf16_t* xo; const float* gmod;
    DI void operator()(Acc& acc, const Unit& u, int wr, int wc, int fr, int fq) const {
        { const int t_ = fresh_tid(); fr = t_ & 15; fq = (t_ >> 4) & 3; }
        const int colb = u.pn * 256 + wc * 32 + 8 * fq;
#pragma unroll
        for (int ai = 0; ai < 2; ++ai) { const int r0 = u.pm * 256 + ai * 128 + wr * 64 + fr;
            const float* g = gmod + (size_t)batch_of(r0) * 6144 + colb;
            f32x4 gv[2][2];
#pragma unroll
            for (int bj = 0; bj < 2; ++bj) { gv[bj][0] = *(const f32x4*)(g + bj * 128); gv[bj][1] = *(const f32x4*)(g + bj * 128 + 4); }
            bf16_t* orow = xo + (size_t)r0 * D + colb;
            if constexpr (BASE_BF16) {
                const bf16_t* xr = xb + (size_t)r0 * D + colb; u32x4 xv[4][2];
#pragma unroll
                for (int m = 0; m < 4; ++m)
#pragma unroll
                    for (int bj = 0; bj < 2; ++bj) xv[m][bj] = *(const u32x4*)(xr + (size_t)m * 16 * D + bj * 128);
#pragma unroll
                for (int m = 0; m < 4; ++m)
#pragma unroll
                    for (int bj = 0; bj < 2; ++bj) { const u32x4 x = xv[m][bj]; const f32x4 a0 = acc[ai][bj][m][0] * gv[bj][0], a1 = acc[ai][bj][m][1] * gv[bj][1];
                        f32x4 v0 = {bflo(x[0]) + a0[0], bfhi(x[0]) + a0[1], bflo(x[1]) + a0[2], bfhi(x[1]) + a0[3]}, v1 = {bflo(x[2]) + a1[0], bfhi(x[2]) + a1[1], bflo(x[3]) + a1[2], bfhi(x[3]) + a1[3]};
                        *(u32x4*)(orow + (size_t)m * 16 * D + bj * 128) = pack_row8(v0, v1); }
            } else {
                const float* xr = (r0 < TP ? xp + (size_t)r0 * D : xs + (size_t)(r0 - TP) * D) + colb; f32x4 xv[4][2][2];
#pragma unroll
                for (int m = 0; m < 4; ++m)
#pragma unroll
                    for (int bj = 0; bj < 2; ++bj) { xv[m][bj][0] = *(const f32x4*)(xr + (size_t)m * 16 * D + bj * 128); xv[m][bj][1] = *(const f32x4*)(xr + (size_t)m * 16 * D + bj * 128 + 4); }
#pragma unroll
                for (int m = 0; m < 4; ++m)
#pragma unroll
                    for (int bj = 0; bj < 2; ++bj) *(u32x4*)(orow + (size_t)m * 16 * D + bj * 128) = pack_row8(xv[m][bj][0] + gv[bj][0] * acc[ai][bj][m][0], xv[m][bj][1] + gv[bj][1] * acc[ai][bj][m][1]);
            }
            __builtin_amdgcn_sched_barrier(0); }
    }
};

struct EpiPart {
    static constexpr bool PERM = false, MIDK = false;
    float* part; int row0;
    DI void operator()(Acc& acc, const Unit& u, int wr, int wc, int fr, int fq) const {
        { const int t_ = fresh_tid(); fr = t_ & 15; fq = (t_ >> 4) & 3; }
#pragma unroll
        for (int ai = 0; ai < 2; ++ai)
#pragma unroll
            for (int m = 0; m < 4; ++m) { float* prow = part + (size_t)(u.pm * 256 + ai * 128 + wr * 64 + m * 16 + fr - row0) * D + u.pn * 256 + wc * 32 + 4 * fq;
#pragma unroll
                for (int bj = 0; bj < 2; ++bj)
#pragma unroll
                    for (int n = 0; n < 2; ++n) *(f32x4*)(prow + bj * 128 + n * 16) = acc[ai][bj][m][n];
                __builtin_amdgcn_sched_barrier(0); }
    }
};

struct EpiFfnIn {
    static constexpr bool PERM = true, MIDK = false;
    bf16_t* HID;
    DI void operator()(Acc& acc, const Unit& u, int wr, int wc, int fr, int fq) const {
        { const int t_ = fresh_tid(); fr = t_ & 15; fq = (t_ >> 4) & 3; }
        bf16_t* base = HID + (size_t)(u.pm * 256 + wr * 64 + fr) * FF + u.pn * 128 + wc * 32 + 8 * fq;
#pragma unroll
        for (int ai = 0; ai < 2; ++ai)
#pragma unroll
            for (int m = 0; m < 4; ++m) { f32x4 v0, v1;
#pragma unroll
                for (int j = 0; j < 4; ++j) { v0[j] = silu(acc[ai][0][m][0][j]) * acc[ai][1][m][0][j]; v1[j] = silu(acc[ai][0][m][1][j]) * acc[ai][1][m][1][j]; }
                *(u32x4*)(base + (size_t)(ai * 128 + m * 16) * FF) = pack_row8(v0, v1); __builtin_amdgcn_sched_barrier(0); }
    }
};

DI void transpose_item(const float* W, int N, bf16_t* WT, int pitch, int koff, int k0, int n0, int drow0, LAS float* scr, int lane) {
#pragma unroll
    for (int i = 0; i < 8; ++i) { const int kk = 8 * i + (lane >> 3), n4 = 4 * (lane & 7); const f32x4 w = *(const f32x4*)(W + (size_t)(k0 + kk) * N + n0 + n4);
        scr[kk * 33 + n4] = w[0]; scr[kk * 33 + n4 + 1] = w[1]; scr[kk * 33 + n4 + 2] = w[2]; scr[kk * 33 + n4 + 3] = w[3]; }
    asm volatile("s_waitcnt lgkmcnt(0)" ::: "memory");
    const int c = lane & 7;
#pragma unroll
    for (int j = 0; j < 4; ++j) { const int n = (lane >> 3) + 8 * j; const LAS float* s = scr + (8 * c) * 33 + n;
        u32x4 o; o.x = pk2(s[0 * 33], s[1 * 33]); o.y = pk2(s[2 * 33], s[3 * 33]); o.z = pk2(s[4 * 33], s[5 * 33]); o.w = pk2(s[6 * 33], s[7 * 33]);
        *(u32x4*)(WT + (size_t)(drow0 + n) * pitch + koff + k0 + 8 * c) = o; }
    asm volatile("s_waitcnt lgkmcnt(0)" ::: "memory");
}
DI void phase_prep(const Params& p, LAS unsigned char* lds) {
    const int tid = fresh_tid(), lane = tid & 63, wave = __builtin_amdgcn_readfirstlane(tid >> 6);
    LAS float* scr = (LAS float*)(lds + wave * 16384);
    const int gw = blockIdx.x * 8 + wave, NGW = gridDim.x * 8;
    unsigned char* ws = p.ws;
    constexpr int I_ADA = 16 * 192, I_IN = 16 * 176, I_A = 8 * 32, I_O = 16 * 32, I_FI = 16 * 176, I_FO = 44 * 32;
    constexpr int NIT = I_ADA + I_IN + 2 * I_A + I_O + I_FI + I_FO;
    for (int it = gw; it < NIT; it += NGW) {
        int r = it;
        if (r < I_ADA) { const int kb = r / 192, nb = r % 192; transpose_item(p.w_ada, 6144, (bf16_t*)(ws + WS_WADA), 1024, 0, 64 * kb, 32 * nb, 32 * nb, scr, lane); continue; } r -= I_ADA;
        if (r < I_IN) { const int kb = r / 176, nb = r % 176, n0 = 32 * nb; int dr = n0;
            if (n0 >= 3584) { const int j = n0 < 4608 ? n0 - 3584 : n0 - 4608; dr = 3584 + 256 * (j >> 7) + (j & 127) + (n0 < 4608 ? 0 : 128); }
            transpose_item(p.w_in, INC, (bf16_t*)(ws + WS_WIN), 1024, 0, 64 * kb, n0, dr, scr, lane); continue; } r -= I_IN;
        if (r < I_A) { const int kb = r / 32, nb = r % 32; transpose_item(p.w_a, 1024, (bf16_t*)(ws + WS_WAB), 1024, 0, 64 * kb, 32 * nb, 32 * nb, scr, lane); continue; } r -= I_A;
        if (r < I_A) { const int kb = r / 32, nb = r % 32; transpose_item(p.w_b, 1024, (bf16_t*)(ws + WS_WAB), 1024, 512, 64 * kb, 32 * nb, 32 * nb, scr, lane); continue; } r -= I_A;
        if (r < I_O) { const int kb = r / 32, nb = r % 32; transpose_item(p.w_out, 1024, (bf16_t*)(ws + WS_WO), 1024, 0, 64 * kb, 32 * nb, 32 * nb, scr, lane); continue; } r -= I_O;
        if (r < I_FI) { const int kb = r / 176, nb = r % 176; const int n0 = 32 * nb; const int j0 = n0 < FF ? n0 : n0 - FF;
            transpose_item(p.w_ffn_in, INC, (bf16_t*)(ws + WS_WFI), 1024, 0, 64 * kb, n0, 256 * (j0 >> 7) + (j0 & 127) + (n0 < FF ? 0 : 128), scr, lane); continue; } r -= I_FI;
        { const int kb = r / 32, nb = r % 32; transpose_item(p.w_ffn_out, 1024, (bf16_t*)(ws + WS_WFO), FF, 0, 64 * kb, 32 * nb, 32 * nb, scr, lane); }
    }
    bf16_t* SC = (bf16_t*)(ws + WS_SC);
    for (int i = blockIdx.x * 512 + tid; i < 256 * 1024 / 2; i += gridDim.x * 512) { const int row = (2 * i) >> 10, col = (2 * i) & 1023; float a = 0.f, b = 0.f;
        if (row < NBATCH) { const float* c = row < 2 ? p.c_prompt + row * D : p.c_sample + (row - 2) * D; a = silu(c[col]); b = silu(c[col + 1]); }
        ((unsigned*)SC)[i] = pk2(a, b); }
}

DI float wave_sum(float v) {
#pragma unroll
    for (int o = 1; o < 64; o <<= 1) v += __shfl_xor(v, o);
    return v;
}
DI void phase_norm_mod(const float* xp, const float* xs, const float* nw, const float* mod, int sh_off, int sc_off, bf16_t* H) {
    const int tid = fresh_tid(), lane = tid & 63, wave = __builtin_amdgcn_readfirstlane(tid >> 6);
    const int gw = blockIdx.x * 8 + wave, NGW = gridDim.x * 8;
    for (int r = gw; r < T; r += NGW) {
        const float* xr = r < TP ? xp + (size_t)r * D : xs + (size_t)(r - TP) * D; const float* mb = mod + (size_t)batch_of(r) * 6144;
        f32x4 v[4]; float s = 0.f;
#pragma unroll
        for (int j = 0; j < 4; ++j) { v[j] = *(const f32x4*)(xr + 4 * lane + 256 * j); s += (v[j][0] * v[j][0] + v[j][1] * v[j][1]) + (v[j][2] * v[j][2] + v[j][3] * v[j][3]); }
        const float rstd = __builtin_amdgcn_rsqf(wave_sum(s) * (1.f / D) + EPS);
#pragma unroll
        for (int j = 0; j < 4; ++j) { const int col = 4 * lane + 256 * j; const f32x4 w = *(const f32x4*)(nw + col), sc = *(const f32x4*)(mb + sc_off + col), sh = *(const f32x4*)(mb + sh_off + col);
            const f32x4 h = v[j] * rstd * w * (sc + 1.f) + sh; u32x2 o; o.x = pk2(h[0], h[1]); o.y = pk2(h[2], h[3]);
            *(u32x2*)(H + (size_t)r * D + col) = o; }
    }
}
DI void phase_norm_mod_b(const bf16_t* xb, const float* nw, const float* mod, int sh_off, int sc_off, bf16_t* H, int r_lo = 0, int r_hi = T, int b_lo = 0) {
    const int tid = fresh_tid(), lane = tid & 63, wave = __builtin_amdgcn_readfirstlane(tid >> 6);
    const int gw = ((int)blockIdx.x - b_lo) * 8 + wave, NGW = ((int)gridDim.x - b_lo) * 8;
    for (int r = r_lo + gw; r < r_hi; r += NGW) {
        const bf16_t* xr = xb + (size_t)r * D; const float* mb = mod + (size_t)batch_of(r) * 6144;
        float v[2][8]; float s = 0.f;
#pragma unroll
        for (int j = 0; j < 2; ++j) { const u32x4 x = *(const u32x4*)(xr + 8 * lane + 512 * j);
#pragma unroll
            for (int i = 0; i < 4; ++i) { v[j][2 * i] = bflo(x[i]); v[j][2 * i + 1] = bfhi(x[i]); s += v[j][2 * i] * v[j][2 * i] + v[j][2 * i + 1] * v[j][2 * i + 1]; } }
        const float rstd = __builtin_amdgcn_rsqf(wave_sum(s) * (1.f / D) + EPS);
#pragma unroll
        for (int j = 0; j < 2; ++j) { const int col = 8 * lane + 512 * j; f32x4 h[2];
#pragma unroll
            for (int q = 0; q < 2; ++q) { const f32x4 w = *(const f32x4*)(nw + col + 4 * q), sc = *(const f32x4*)(mb + sc_off + col + 4 * q), sh = *(const f32x4*)(mb + sh_off + col + 4 * q);
                const f32x4 x = {v[j][4 * q], v[j][4 * q + 1], v[j][4 * q + 2], v[j][4 * q + 3]}; h[q] = x * rstd * w * (sc + 1.f) + sh; }
            *(u32x4*)(H + (size_t)r * D + col) = pack_row8(h[0], h[1]); }
    }
}
DI void phase_final_norm(const bf16_t* xb, float* y, const float* nw, int r_lo = 0, int r_hi = T, int b_lo = 0) {
    const int tid = fresh_tid(), lane = tid & 63, wave = __builtin_amdgcn_readfirstlane(tid >> 6);
    const int gw = ((int)blockIdx.x - b_lo) * 8 + wave, NGW = ((int)gridDim.x - b_lo) * 8;
    for (int r = r_lo + gw; r < r_hi; r += NGW) { const bf16_t* xr = xb + (size_t)r * D; float* yr = y + (size_t)r * D;
        float v[2][8]; float s = 0.f;
#pragma unroll
        for (int j = 0; j < 2; ++j) { const u32x4 x = *(const u32x4*)(xr + 8 * lane + 512 * j);
#pragma unroll
            for (int i = 0; i < 4; ++i) { v[j][2 * i] = bflo(x[i]); v[j][2 * i + 1] = bfhi(x[i]); s += v[j][2 * i] * v[j][2 * i] + v[j][2 * i + 1] * v[j][2 * i + 1]; } }
        const float rstd = __builtin_amdgcn_rsqf(wave_sum(s) * (1.f / D) + EPS);
#pragma unroll
        for (int j = 0; j < 2; ++j) { const int col = 8 * lane + 512 * j;
#pragma unroll
            for (int q = 0; q < 2; ++q) { const f32x4 x = {v[j][4 * q], v[j][4 * q + 1], v[j][4 * q + 2], v[j][4 * q + 3]}; *(f32x4*)(yr + col + 4 * q) = x * rstd * *(const f32x4*)(nw + col + 4 * q); } }
    }
}

DI void phase_final_norm_parts(const bf16_t* x1b, const float* part0, const float* part1, const float* g2mod, float* y, const float* nw) {
    const int tid = fresh_tid(), lane = tid & 63, wave = __builtin_amdgcn_readfirstlane(tid >> 6);
    const int gw = blockIdx.x * 8 + wave, NGW = gridDim.x * 8;
    for (int r = TP + gw; r < T; r += NGW) { const float* gb = g2mod + (size_t)batch_of(r) * 6144; const size_t po = (size_t)(r - TP) * D;
        f32x4 v[4]; float s = 0.f;
#pragma unroll
        for (int j = 0; j < 4; ++j) { const int col = 4 * lane + 256 * j; const u32x2 xb = *(const u32x2*)(x1b + (size_t)r * D + col);
            const f32x4 x = {bflo(xb.x), bfhi(xb.x), bflo(xb.y), bfhi(xb.y)};
            v[j] = x + *(const f32x4*)(gb + col) * (*(const f32x4*)(part0 + po + col) + *(const f32x4*)(part1 + po + col));
            s += (v[j][0] * v[j][0] + v[j][1] * v[j][1]) + (v[j][2] * v[j][2] + v[j][3] * v[j][3]); }
        const float rstd = __builtin_amdgcn_rsqf(wave_sum(s) * (1.f / D) + EPS);
#pragma unroll
        for (int j = 0; j < 4; ++j) { const int col = 4 * lane + 256 * j; *(f32x4*)(y + (size_t)r * D + col) = v[j] * rstd * *(const f32x4*)(nw + col); }
    }
}

DI void hgrn_u_item(const Params& p, int item, int lane) {
    const int c = item >> 4, rem = item & 15, h = rem >> 2, kt = rem & 3, l31 = lane & 31, hf = lane >> 5;
    const float* CUM = (const float*)(p.ws + WS_CUM); const bf16_t* KA = (const bf16_t*)(p.ws + WS_KA); const bf16_t* VA = (const bf16_t*)(p.ws + WS_VA); bf16_t* U = (bf16_t*)(p.ws + WS_U);
    const size_t hb = (size_t)h * T * 128; const int kcol = 32 * kt + l31;
    const float tot = CUM[hb + (size_t)(c * 64 + 63) * 128 + kcol];
    bf16x8 kdf[2][2];
#pragma unroll
    for (int st = 0; st < 2; ++st) { f32x16 kd;
#pragma unroll
        for (int r = 0; r < 16; ++r) { const size_t idx = hb + (size_t)(c * 64 + 32 * st + crow(r, hf)) * 128 + kcol; kd[r] = bf2f((short)KA[idx]) * __expf(tot - CUM[idx]); }
        kdf[st][0] = pack8(kd, 0); kdf[st][1] = pack8(kd, 1); }
    const bf16x8 id0 = ident_frag(0, l31, hf), id1 = ident_frag(1, l31, hf);
#pragma unroll
    for (int vt = 0; vt < 4; ++vt) { f32x16 dacc = zero16();
#pragma unroll
        for (int st = 0; st < 2; ++st) { const bf16_t* vp = VA + hb + (size_t)(c * 64 + 32 * st) * 128 + (4 * vt + hf) * 256 + l31 * 8;
            f32x16 vx = zero16(); vx = MFMA32(*(const bf16x8*)vp, id0, vx); vx = MFMA32(*(const bf16x8*)(vp + 512), id1, vx);
            dacc = MFMA32(kdf[st][0], pack8(vx, 0), dacc); dacc = MFMA32(kdf[st][1], pack8(vx, 1), dacc); }
        bf16_t* up = U + ((size_t)(c * 4 + h) * 128 + 32 * vt + l31) * 128 + 32 * kt + 8 * hf;
#pragma unroll
        for (int g = 0; g < 4; g += 2) { u32x2 o0, o1; o0.x = pk2(dacc[4 * g], dacc[4 * g + 1]); o0.y = pk2(dacc[4 * g + 2], dacc[4 * g + 3]); o1.x = pk2(dacc[4 * g + 4], dacc[4 * g + 5]); o1.y = pk2(dacc[4 * g + 6], dacc[4 * g + 7]);
            *(u32x4*)(up + 8 * g) = widen_pair(o0, o1); }
    }
}

DI void scan_prompt_item(const Params& p, int item, int lane) {
    const int bh = item >> 6, vp = item & 63, b = bh >> 2, h = bh & 3, kg = lane & 31, v0 = 2 * vp + (lane >> 5);
    const float* __restrict__ DEC = (const float*)(p.ws + WS_DEC) + (size_t)b * 256 * 512 + h * 128 + 4 * kg;
    const bf16_t* __restrict__ U = (const bf16_t*)(p.ws + WS_U) + ((size_t)(b * 256 * 4 + h) * 128 + v0) * 128 + 4 * kg;
    bf16_t* __restrict__ SST = (bf16_t*)(p.ws + WS_SST) + ((size_t)(b * 256 * 4 + h) * 128 + v0) * 128 + 4 * kg;
    f32x4 S0 = {0.f, 0.f, 0.f, 0.f};
    for (int n0 = 0; n0 < 256; n0 += 32) {
        f32x4 d[32]; u32x2 u[32];
#pragma unroll
        for (int i = 0; i < 32; ++i) { d[i] = *(const f32x4*)(DEC + (size_t)(n0 + i) * 512); u[i] = *(const u32x2*)(U + (size_t)(n0 + i) * 4 * 128 * 128); }
#pragma unroll
        for (int i = 0; i < 32; ++i) { u32x2 s; s.x = pk2(S0[0], S0[1]); s.y = pk2(S0[2], S0[3]); *(u32x2*)(SST + (size_t)(n0 + i) * 4 * 128 * 128) = s;
            S0[0] = d[i][0] * S0[0] + bflo(u[i].x); S0[1] = d[i][1] * S0[1] + bfhi(u[i].x); S0[2] = d[i][2] * S0[2] + bflo(u[i].y); S0[3] = d[i][3] * S0[3] + bfhi(u[i].y); }
    }
    float* sp = p.out + OFF_SP + ((size_t)bh * 128 + 4 * kg) * 128;
#pragma unroll
    for (int i = 0; i < 4; ++i) sp[(size_t)i * 128 + v0] = S0[i];
}
DI void scan_sample_item(const Params& p, int item, int lane) {
    const int bh = item >> 5, vq = item & 31, bs = bh >> 2, h = bh & 3, kg = lane & 31, vv = lane >> 5, c = 512 + bs;
    const float* DEC = (const float*)(p.ws + WS_DEC); const bf16_t* U = (const bf16_t*)(p.ws + WS_U); bf16_t* SST = (bf16_t*)(p.ws + WS_SST);
    const f32x4 d = *(const f32x4*)(DEC + (size_t)c * 512 + h * 128 + 4 * kg);
    const float* s0 = p.state + ((size_t)bh * 128 + 4 * kg) * 128; float* so = p.out + OFF_SS + ((size_t)bh * 128 + 4 * kg) * 128;
#pragma unroll
    for (int e = 0; e < 2; ++e) { const int v = 4 * vq + 2 * e + vv; const size_t o = ((size_t)(c * 4 + h) * 128 + v) * 128 + 4 * kg;
        const u32x2 u = *(const u32x2*)(U + o); f32x4 S;
#pragma unroll
        for (int i = 0; i < 4; ++i) S[i] = s0[(size_t)i * 128 + v];
        u32x2 s; s.x = pk2(S[0], S[1]); s.y = pk2(S[2], S[3]); *(u32x2*)(SST + o) = s;
        so[v] = d[0] * S[0] + bflo(u.x); so[128 + v] = d[1] * S[1] + bfhi(u.x); so[256 + v] = d[2] * S[2] + bflo(u.y); so[384 + v] = d[3] * S[3] + bfhi(u.y); }
}

DI void attn_item(const Params& p, int item, int lane, const LAS float* biasl) {
    const int c = item >> 3, h = item & 7, l31 = lane & 31, hf = lane >> 5;
    const bf16_t* KB = (const bf16_t*)(p.ws + WS_KB); const bf16_t* VB = (const bf16_t*)(p.ws + WS_VB);
    bf16x8 qf[2][4];
    { const bf16_t* qptr = (const bf16_t*)(p.ws + WS_QOB) + (size_t)(c * 64 + l31) * 1024 + 512 + h * 64;
#pragma unroll
    for (int qq = 0; qq < 2; ++qq)
#pragma unroll
        for (int ks = 0; ks < 4; ++ks) qf[qq][ks] = *(const bf16x8*)(qptr + (size_t)qq * 32 * 1024 + 16 * ks + 8 * hf); }
    const LAS float* bl = biasl + h * 192;
    f32x16 OT[2][2]; float mrun[2], lsum[2];
#pragma unroll
    for (int qq = 0; qq < 2; ++qq) { OT[qq][0] = zero16(); OT[qq][1] = zero16(); mrun[qq] = -1e30f; lsum[qq] = 0.f; }
    int ntile, ncache, db0, krow_first;
    if (c < 512) { const int n = c & 255, j0 = n < 8 ? n : 8; ntile = 2 * (j0 + 1); ncache = 0; db0 = 64 * j0; krow_first = (c - j0) * 64; }
    else { ntile = 18; ncache = 16; db0 = 512; krow_first = c * 64 - 512; }
    const int bs = c - 512;
    u32x4 nk[4], nv[4];
#define ATT_LOAD(i_) do { if ((i_) >= ncache) { const size_t ro_ = (((size_t)h * (T / 32) + (size_t)((krow_first >> 5) + (i_))) * 8 + hf) * 256 + l31 * 8;     \
            _Pragma("unroll") for (int ks = 0; ks < 4; ++ks) { nk[ks] = *(const u32x4*)(KB + ro_ + 512 * ks); nv[ks] = *(const u32x4*)(VB + ro_ + 512 * ks); } } } while (0)
    ATT_LOAD(0);
    for (int i = 0; i < ntile; ++i) {
        bf16x8 kf[4], vf[2][2];
        if (i < ncache) {
            const float* kp_ = p.cache_k + ((size_t)(bs * 512 + 32 * i + l31) * 8 + h) * 64 + 8 * hf; const float* vp_ = p.cache_v + ((size_t)(bs * 512 + 32 * i + l31) * 8 + h) * 64 + 8 * hf;
#pragma unroll
            for (int ks = 0; ks < 4; ++ks) { u32x4 w; const f32x4 a = *(const f32x4*)(kp_ + 16 * ks), b = *(const f32x4*)(kp_ + 16 * ks + 4), e = *(const f32x4*)(vp_ + 16 * ks), f = *(const f32x4*)(vp_ + 16 * ks + 4);
                w.x = pk2(a[0], a[1]); w.y = pk2(a[2], a[3]); w.z = pk2(b[0], b[1]); w.w = pk2(b[2], b[3]); kf[ks] = __builtin_bit_cast(bf16x8, w);
                w.x = pk2(e[0], e[1]); w.y = pk2(e[2], e[3]); w.z = pk2(f[0], f[1]); w.w = pk2(f[2], f[3]); vf[ks >> 1][ks & 1] = __builtin_bit_cast(bf16x8, w); }
        } else {
#pragma unroll
            for (int ks = 0; ks < 4; ++ks) { kf[ks] = __builtin_bit_cast(bf16x8, nk[ks]); vf[ks >> 1][ks & 1] = __builtin_bit_cast(bf16x8, nv[ks]); }
        }
        if (i + 1 < ntile) ATT_LOAD(i + 1);
        asm volatile("" ::: "memory");
        bf16x8 vxf[2][2];
        const int l31b = launder(l31); const bf16x8 id0 = ident_frag(0, l31b, hf), id1 = ident_frag(1, l31b, hf);
#pragma unroll
        for (int dt = 0; dt < 2; ++dt) { f32x16 vx = zero16(); vx = MFMA32(vf[dt][0], id0, vx); vx = MFMA32(vf[dt][1], id1, vx); vxf[dt][0] = pack8(vx, 0); vxf[dt][1] = pack8(vx, 1); }
#pragma unroll
        for (int qq = 0; qq < 2; ++qq) {
            f32x16 st = zero16();
#pragma unroll
            for (int ks = 0; ks < 4; ++ks) st = MFMA32(kf[ks], qf[qq][ks], st);
            const int dq = db0 + 32 * qq - 32 * i; float mt = -1e30f;
            if (dq - 31 >= 128) { const float bc = bl[191];
#pragma unroll
                for (int r = 0; r < 16; ++r) { const float s = st[r] * (0.125f * LOG2E) + bc; st[r] = s; mt = fmaxf(mt, s); }
            } else { const int dbase = dq + l31;
#pragma unroll
                for (int r = 0; r < 16; ++r) { int dist = dbase - crow(r, hf); dist = dist > 128 ? 128 : dist; const float s = st[r] * (0.125f * LOG2E) + bl[dist + 63]; st[r] = s; mt = fmaxf(mt, s); }
            }
            mt = fmaxf(mt, __shfl_xor(mt, 32));
            const float mnew = fmaxf(mrun[qq], mt), alpha = __builtin_amdgcn_exp2f(mrun[qq] - mnew); mrun[qq] = mnew;
            float ps = 0.f;
#pragma unroll
            for (int r = 0; r < 16; ++r) { st[r] = __builtin_amdgcn_exp2f(st[r] - mnew); ps += st[r]; }
            lsum[qq] = lsum[qq] * alpha + ps;
#pragma unroll
            for (int r = 0; r < 16; ++r) { OT[qq][0][r] *= alpha; OT[qq][1][r] *= alpha; }
            const bf16x8 pf0 = pack8(st, 0), pf1 = pack8(st, 1);
            OT[qq][0] = MFMA32(vxf[0][0], pf0, OT[qq][0]); OT[qq][0] = MFMA32(vxf[0][1], pf1, OT[qq][0]);
            OT[qq][1] = MFMA32(vxf[1][0], pf0, OT[qq][1]); OT[qq][1] = MFMA32(vxf[1][1], pf1, OT[qq][1]);
        }
    }
#undef ATT_LOAD
    bf16_t* qptr = (bf16_t*)(p.ws + WS_QOB) + (size_t)(c * 64 + launder(l31)) * 1024 + 512 + h * 64;
#pragma unroll
    for (int qq = 0; qq < 2; ++qq) { const float l = lsum[qq] + __shfl_xor(lsum[qq], 32), inv = 1.f / l; bf16_t* op = qptr + (size_t)qq * 32 * 1024;
#pragma unroll
        for (int dt = 0; dt < 2; ++dt)
#pragma unroll
            for (int g = 0; g < 4; g += 2) { u32x2 o0, o1; o0.x = pk2(OT[qq][dt][4 * g] * inv, OT[qq][dt][4 * g + 1] * inv); o0.y = pk2(OT[qq][dt][4 * g + 2] * inv, OT[qq][dt][4 * g + 3] * inv);
                o1.x = pk2(OT[qq][dt][4 * g + 4] * inv, OT[qq][dt][4 * g + 5] * inv); o1.y = pk2(OT[qq][dt][4 * g + 6] * inv, OT[qq][dt][4 * g + 7] * inv);
                *(u32x4*)(op + 32 * dt + 8 * (g + hf)) = widen_pair(o0, o1); } }
}

DI void hgrn_out_item(const Params& p, int item, int lane, bf16_t* obase = nullptr) {
    const int c = item >> 3, h = (item >> 1) & 3, tt = item & 1, l31 = lane & 31, hf = lane >> 5;
    const float* CUM = (const float*)(p.ws + WS_CUM); const bf16_t* KA = (const bf16_t*)(p.ws + WS_KA); const bf16_t* VA = (const bf16_t*)(p.ws + WS_VA);
    const bf16_t* GA = (const bf16_t*)(p.ws + WS_GA); const bf16_t* SST = (const bf16_t*)(p.ws + WS_SST);
    const int trow = c * 64 + 32 * tt + l31;
    bf16_t* qap = (bf16_t*)(p.ws + WS_QOB) + (size_t)trow * 1024 + h * 128;
    const size_t hb = (size_t)h * T * 128;
    const float* cumt = CUM + hb + (size_t)trow * 128; const float* refp = CUM + hb + (size_t)(c * 64 + 32) * 128;
    bf16x8 qd1[8], qd2[8], kdt[8];
    const bf16_t* kat = KA + hb + (size_t)trow * 128;
#pragma unroll
    for (int ks = 0; ks < 8; ++ks) { const int k0 = 16 * ks + 8 * hf; const bf16x8 q8 = *(const bf16x8*)(qap + k0), k8 = *(const bf16x8*)(kat + k0);
        const f32x4 c0 = *(const f32x4*)(cumt + k0), c1 = *(const f32x4*)(cumt + k0 + 4), r0 = *(const f32x4*)(refp + k0), r1 = *(const f32x4*)(refp + k0 + 4);
        float a[8], b[8], d[8];
#pragma unroll
        for (int j = 0; j < 8; ++j) { const float q = bf2f(q8[j]), cu = j < 4 ? c0[j & 3] : c1[j & 3], rf = j < 4 ? r0[j & 3] : r1[j & 3]; a[j] = q * __expf(cu - rf); b[j] = q * __expf(cu); d[j] = bf2f(k8[j]) * __expf(rf - cu); }
        qd1[ks] = pack8f(a); qd2[ks] = pack8f(b); kdt[ks] = pack8f(d); }
    f32x16 OT[4];
#pragma unroll
    for (int vt = 0; vt < 4; ++vt) OT[vt] = zero16();
    const bf16_t* sp = SST + ((size_t)(c * 4 + h) * 128 + l31) * 128 + 8 * hf;
#pragma unroll
    for (int vt = 0; vt < 4; ++vt) {
#pragma unroll
        for (int ks = 0; ks < 8; ++ks) OT[vt] = MFMA32(*(const bf16x8*)(sp + (size_t)vt * 32 * 128 + 16 * ks), qd2[ks], OT[vt]);
        __builtin_amdgcn_sched_barrier(0); }
    const bf16x8 id0 = ident_frag(0, l31, hf), id1 = ident_frag(1, l31, hf);
    for (int st = 0; st <= tt; ++st) {
        const int srow = c * 64 + 32 * st + l31; const bf16_t* kap = KA + hb + (size_t)srow * 128; const float* cums = CUM + hb + (size_t)srow * 128;
        f32x16 X = zero16();
        if (st == tt) {
#pragma unroll
            for (int ks = 0; ks < 8; ++ks) X = MFMA32(kdt[ks], qd1[ks], X);
        } else
#pragma unroll
        for (int ks = 0; ks < 8; ++ks) { const int k0 = 16 * ks + 8 * hf; const bf16x8 k8 = *(const bf16x8*)(kap + k0);
            const f32x4 c0 = *(const f32x4*)(cums + k0), c1 = *(const f32x4*)(cums + k0 + 4), r0 = *(const f32x4*)(refp + k0), r1 = *(const f32x4*)(refp + k0 + 4);
            float a[8];
#pragma unroll
            for (int j = 0; j < 8; ++j) { const float cu = j < 4 ? c0[j & 3] : c1[j & 3], rf = j < 4 ? r0[j & 3] : r1[j & 3]; a[j] = bf2f(k8[j]) * __expf(rf - cu); }
            X = MFMA32(pack8f(a), qd1[ks], X); }
        if (st == tt) {
#pragma unroll
            for (int r = 0; r < 16; ++r) if (crow(r, hf) > l31) X[r] = 0.f; }
        const bf16x8 xf0 = pack8(X, 0), xf1 = pack8(X, 1);
        const bf16_t* vp = VA + hb + (size_t)(c * 64 + 32 * st) * 128 + hf * 256 + l31 * 8;
#pragma unroll
        for (int vt = 0; vt < 4; ++vt) { f32x16 vx = zero16(); vx = MFMA32(*(const bf16x8*)(vp + 1024 * vt), id0, vx); vx = MFMA32(*(const bf16x8*)(vp + 1024 * vt + 512), id1, vx);
            OT[vt] = MFMA32(pack8(vx, 0), xf0, OT[vt]); OT[vt] = MFMA32(pack8(vx, 1), xf1, OT[vt]); }
    }
    float ss = 0.f;
#pragma unroll
    for (int vt = 0; vt < 4; ++vt)
#pragma unroll
        for (int r = 0; r < 16; ++r) ss += OT[vt][r] * OT[vt][r];
    ss += __shfl_xor(ss, 32);
    const float rstd = __builtin_amdgcn_rsqf(ss * (1.f / 128.f) + EPS);
    const bf16_t* gap = GA + hb + (size_t)trow * 128; const float* onp = p.out_norm + h * 128;
    if (obase) qap = obase + (size_t)trow * 512 + h * 128;
#pragma unroll
    for (int vt = 0; vt < 4; ++vt)
#pragma unroll
        for (int g = 0; g < 4; g += 2) { u32x2 ga0, ga1; narrow_pair(*(const u32x4*)(gap + 32 * vt + 8 * (g + hf)), ga0, ga1);
            u32x2 o0, o1;
            { const int v0 = 32 * vt + 8 * g + 4 * hf; const f32x4 on = *(const f32x4*)(onp + v0);
              o0.x = pk2(OT[vt][4 * g] * rstd * on[0] * bflo(ga0.x), OT[vt][4 * g + 1] * rstd * on[1] * bfhi(ga0.x)); o0.y = pk2(OT[vt][4 * g + 2] * rstd * on[2] * bflo(ga0.y), OT[vt][4 * g + 3] * rstd * on[3] * bfhi(ga0.y)); }
            { const int v0 = 32 * vt + 8 * (g + 1) + 4 * hf; const f32x4 on = *(const f32x4*)(onp + v0);
              o1.x = pk2(OT[vt][4 * g + 4] * rstd * on[0] * bflo(ga1.x), OT[vt][4 * g + 5] * rstd * on[1] * bfhi(ga1.x)); o1.y = pk2(OT[vt][4 * g + 6] * rstd * on[2] * bflo(ga1.y), OT[vt][4 * g + 7] * rstd * on[3] * bfhi(ga1.y)); }
            *(u32x4*)(qap + 32 * vt + 8 * (g + hf)) = widen_pair(o0, o1); }
}


#define XB_TMO      128
#define XB_XCNT(j)  (256  + 64 * (j))
#define XB_XSUB(j)  (1280 + 64 * (j))
#define XB_XGEN(j)  (2304 + 64 * (j))
#define XB_TOP      3328
#define XB_TOPGEN   3392
#define XCD_BAR_WORDS 3456
#define XB_SPIN_CAP (1u << 18)
DI unsigned xb_ld(unsigned* p)              { return __hip_atomic_load(p, __ATOMIC_RELAXED, __HIP_MEMORY_SCOPE_AGENT); }
DI unsigned xb_add(unsigned* p, unsigned v) { return __hip_atomic_fetch_add(p, v, __ATOMIC_RELAXED, __HIP_MEMORY_SCOPE_AGENT); }
DI unsigned xb_xcc_id() { return (unsigned)__builtin_amdgcn_s_getreg((3 << 11) | 20) & 0xFu; }
#define XB_SPIN(cond, bar) do { unsigned _sp = 0; while (cond) { __builtin_amdgcn_s_sleep(1); \
    if ((++_sp & 255u) == 0u) { if (xb_ld(&(bar)[XB_TMO])) break; if (_sp > XB_SPIN_CAP) { atomicAdd(&(bar)[XB_TMO], 1u); break; } } } } while (0)
struct XcdBarrier { unsigned* bar; unsigned x; volatile LAS unsigned* st; };
DI XcdBarrier xcd_barrier_post(unsigned* bar, volatile LAS unsigned* st) {
    XcdBarrier b; b.bar = bar; b.x = xb_xcc_id(); b.st = st;
    if (threadIdx.x == 0) (void)xb_add(&bar[XB_XCNT(b.x)], 1u);
    return b;
}
DI void xcd_barrier_complete(unsigned* bar, unsigned x, unsigned& nloc, unsigned& nx) {
    const unsigned G = gridDim.x * gridDim.y * gridDim.z;
    unsigned sum, cnt, mine, sp = 0u;
    for (;;) {
        sum = 0u; cnt = 0u; mine = 0u;
#pragma unroll
        for (unsigned j = 0; j < 16; ++j) { const unsigned c = xb_ld(&bar[XB_XCNT(j)]); sum += c; cnt += (c > 0u) ? 1u : 0u; mine = (j == x) ? c : mine; }
        if (sum == G) break;
        __builtin_amdgcn_s_sleep(1);
        if ((++sp & 255u) == 0u) { if (xb_ld(&bar[XB_TMO])) break; if (sp > XB_SPIN_CAP) { atomicAdd(&bar[XB_TMO], 1u); break; } }
    }
    nloc = mine > 0u ? mine : 1u; nx = cnt > 0u ? cnt : 1u;
}
DI void xcd_barrier(const XcdBarrier& b) {
    asm volatile("s_waitcnt vmcnt(0)" ::: "memory");
    __syncthreads();
    if (threadIdx.x == 0) {
        unsigned* bar = b.bar;
        __builtin_amdgcn_s_waitcnt(0);
        unsigned nloc = b.st[0], nx = b.st[1];
        if (nloc == 0u) { xcd_barrier_complete(bar, b.x, nloc, nx); b.st[0] = nloc; b.st[1] = nx; }
        const unsigned old = xb_add(&bar[XB_XSUB(b.x)], 1u);
        const unsigned gen = old / nloc;
        if (old + 1u == (gen + 1u) * nloc) {
            __builtin_amdgcn_fence(__ATOMIC_RELEASE, "agent");
            asm volatile("s_waitcnt vmcnt(0)" ::: "memory");
            const unsigned og = xb_add(&bar[XB_TOP], 1u);
            const unsigned tg = og / nx;
            if (og + 1u == (tg + 1u) * nx) xb_add(&bar[XB_TOPGEN], 1u);
            else XB_SPIN(xb_ld(&bar[XB_TOPGEN]) == tg, bar);
            __builtin_amdgcn_fence(__ATOMIC_ACQUIRE, "agent");
            xb_add(&bar[XB_XGEN(b.x)], 1u);
            asm volatile("s_waitcnt vmcnt(0)" ::: "memory");
        } else {
            XB_SPIN(xb_ld(&bar[XB_XGEN(b.x)]) == gen, bar);
            __builtin_amdgcn_fence(__ATOMIC_ACQUIRE, "agent");
            asm volatile("s_waitcnt vmcnt(0)" ::: "memory");
        }
    }
    __syncthreads();
}

__global__ void __launch_bounds__(512, 2) fwd_megakernel(Params p) {
    extern __shared__ __attribute__((aligned(16))) unsigned char lds_raw[];
    LAS unsigned char* lds = (LAS unsigned char*)lds_raw;
    cg::grid_group grid = cg::this_grid();
    const int G = gridDim.x, bx = blockIdx.x;
    volatile LAS unsigned* bst = (volatile LAS unsigned*)(lds + LDS_ST_OFF);
    if (threadIdx.x < 2) bst[threadIdx.x] = 0u;
    __syncthreads();
    const XcdBarrier xbar = xcd_barrier_post((unsigned*)(p.ws + WS_BAR), bst);
    if (threadIdx.x == 0) bst[2] = xb_add((unsigned*)(p.ws + WS_BAR) + 3712 + xbar.x, 1u);
#define GRID_BAR() xcd_barrier(xbar)
    unsigned char* ws = p.ws;
    float* MOD = (float*)(ws + WS_MOD); bf16_t* H = (bf16_t*)(ws + WS_H);

    phase_prep(p, lds);
    grid.sync();
    { pg8::Gemm g{(const bf16_t*)(ws + WS_SC), (const bf16_t*)(ws + WS_WADA), 256, 6144, 1024}; pg8::StaticOrder S; S.init(256, 6144, G, bx);
      EpiMod E{MOD, p.b_ada}; pg8::gemm_phase<EpiMod, pg8::StaticOrder, true, true>(lds, g, S, E); }
    GRID_BAR();
    int cv = bx;
    { unsigned* barw = (unsigned*)(p.ws + WS_BAR); bool uni = (G & 7) == 0;
#pragma unroll
      for (int j = 0; j < 16; ++j) { const unsigned c = xb_ld(&barw[XB_XCNT(j)]); uni = uni && (j < 8 ? c == (unsigned)(G >> 3) : c == 0u); }
      if (uni) cv = (int)xbar.x + 8 * (int)bst[2];
      cv = __builtin_amdgcn_readfirstlane(cv); }
    phase_norm_mod(p.x_prompt, p.x_sample, p.norm_mix, MOD, 0, 1024, H);
#if PROBE_DUP == 1
    GRID_BAR(); phase_norm_mod(p.x_prompt, p.x_sample, p.norm_mix, MOD, 0, 1024, H);
#endif
#if PROBE_DUP == 10
    GRID_BAR(); GRID_BAR(); GRID_BAR(); GRID_BAR(); GRID_BAR(); GRID_BAR(); GRID_BAR(); GRID_BAR(); GRID_BAR(); GRID_BAR();
#endif
    GRID_BAR();
    { pg8::Gemm g{H, (const bf16_t*)(ws + WS_WIN), T, INC, 1024}; pg8::StaticOrder S; S.init(T, INC, G, cv);
      EpiIn E{(bf16_t*)(ws + WS_QOB), (bf16_t*)(ws + WS_KA), (bf16_t*)(ws + WS_VA), (bf16_t*)(ws + WS_GA), (bf16_t*)(ws + WS_KB), (bf16_t*)(ws + WS_VB),
              (bf16_t*)(p.out), (bf16_t*)(p.out) + (size_t)T * 1024, (float*)(ws + WS_CUM), (float*)(ws + WS_DEC), p.lb_logits, p.out};
      pg8::gemm_phase<EpiIn, pg8::StaticOrder, true, true>(lds, g, S, E);
#if PROBE_DUP == 2
      GRID_BAR(); pg8::gemm_phase<EpiIn, pg8::StaticOrder, true, true>(lds, g, S, E);
#endif
    }
    GRID_BAR();
    { const int tid = fresh_tid(), lane = tid & 63, wave = __builtin_amdgcn_readfirstlane(tid >> 6);
      for (int it = wave * G + bx; it < NCH * 16; it += 8 * G) hgrn_u_item(p, it, lane);
#if PROBE_DUP == 3
      for (int it = wave * G + bx; it < NCH * 16; it += 8 * G) hgrn_u_item(p, it, lane);
#endif
    }
    GRID_BAR();
    {
        const int tid = fresh_tid(), lane = tid & 63, wave = __builtin_amdgcn_readfirstlane(tid >> 6);
        LAS float* biasl = (LAS float*)lds;
        for (int i = tid; i < 8 * 192; i += 512) biasl[i] = p.rel_bias[i] * LOG2E;
        __syncthreads();
#if PROBE_DUP == 41
        if (wave == 0) { for (int it = bx; it < 512; it += G) scan_prompt_item(p, it, lane); }
        GRID_BAR();
#endif
        if (wave == 0) { for (int it = bx; it < 512; it += G) scan_prompt_item(p, it, lane); }
        else {
            const int gw = (wave - 1) * G + bx, NGW = 7 * G;
            for (int it = gw; it < 4096; it += NGW) scan_sample_item(p, it, lane);
            const int x = __builtin_amdgcn_readfirstlane((int)xbar.x), ncu = __builtin_amdgcn_readfirstlane((int)bst[0]), nxcc = __builtin_amdgcn_readfirstlane((int)bst[1]), j = __builtin_amdgcn_readfirstlane((int)bst[2]);
            if (nxcc == 8 && x < 8 && ncu > 0 && j < ncu) {
                const int nslot = 7 * ncu, slot = (wave - 1) * ncu + j;
                for (int idx = slot; idx < 68 * 8; idx += nslot) { const int cc = idx >> 3, c = cc < 4 ? 512 + 4 * x + cc : 64 * x + (cc - 4); attn_item(p, c * 8 + (idx & 7), lane, biasl); }
            } else for (int it = gw; it < NCH * 8; it += NGW) attn_item(p, it, lane, biasl);
        }
    }
    GRID_BAR();
    { const int tid = fresh_tid(), lane = tid & 63, wave = __builtin_amdgcn_readfirstlane(tid >> 6);
#if PROBE_DUP == 5
      for (int it = wave * G + bx; it < NCH * 8; it += 8 * G) hgrn_out_item(p, it, lane, (bf16_t*)(ws + WS_U));
      GRID_BAR();
#endif
      for (int it = wave * G + bx; it < NCH * 8; it += 8 * G) hgrn_out_item(p, it, lane); }
    GRID_BAR();
    { pg8::Gemm g{(const bf16_t*)(ws + WS_QOB), (const bf16_t*)(ws + WS_WAB), T, 1024, 1024}; pg8::StaticOrder S; S.init(T, 1024, G, cv);
      EpiMerge E{(const bf16_t*)(p.out), (const bf16_t*)(p.out) + (size_t)T * 1024, (bf16_t*)(ws + WS_M)};
      pg8::gemm_phase<EpiMerge, pg8::StaticOrder, true, true>(lds, g, S, E); }
    GRID_BAR();
    const bool split_ps = G >= 64;
    { pg8::Gemm g{(const bf16_t*)(ws + WS_M), (const bf16_t*)(ws + WS_WO), T, 1024, 1024}; EpiRes<false> E{p.x_prompt, p.x_sample, nullptr, (bf16_t*)(ws + WS_X1B), MOD + 2048};
      if (split_ps) {
        { pg8::StaticOrder S; S.init(TP, 1024, G, cv); pg8::gemm_phase<EpiRes<false>, pg8::StaticOrder, true, true>(lds, g, S, E); }
        GRID_BAR();
        if (bx < 32) { pg8::StaticOrder S; S.init(TS, 1024, 32, bx, TP / 256); pg8::gemm_phase<EpiRes<false>, pg8::StaticOrder, true, true>(lds, g, S, E); }
        else phase_norm_mod_b((const bf16_t*)(ws + WS_X1B), p.norm_ffn, MOD, 3072, 4096, H, 0, TP, 32);
        GRID_BAR();
        phase_norm_mod_b((const bf16_t*)(ws + WS_X1B), p.norm_ffn, MOD, 3072, 4096, H, TP, T, 0);
      } else {
        pg8::StaticOrder S; S.init(T, 1024, G, cv); pg8::gemm_phase<EpiRes<false>, pg8::StaticOrder, true, true>(lds, g, S, E);
        GRID_BAR();
        phase_norm_mod_b((const bf16_t*)(ws + WS_X1B), p.norm_ffn, MOD, 3072, 4096, H);
      } }
    GRID_BAR();
    { pg8::Gemm g{H, (const bf16_t*)(ws + WS_WFI), T, INC, 1024}; pg8::StaticOrder S; S.init(T, INC, G, cv);
      EpiFfnIn E{(bf16_t*)(ws + WS_HID)}; pg8::gemm_phase<EpiFfnIn, pg8::StaticOrder, true, true>(lds, g, S, E);
#if PROBE_DUP == 9
      GRID_BAR(); pg8::gemm_phase<EpiFfnIn, pg8::StaticOrder, true, true>(lds, g, S, E);
#endif
    }
    GRID_BAR();
    { pg8::Gemm g{(const bf16_t*)(ws + WS_HID), (const bf16_t*)(ws + WS_WFO), T, 1024, FF}; EpiRes<true> E{nullptr, nullptr, (const bf16_t*)(ws + WS_X1B), (bf16_t*)(ws + WS_X2B), MOD + 5120};
      if (split_ps) {
        { pg8::StaticOrder S; S.init(TP, 1024, G, cv); pg8::gemm_phase<EpiRes<true>, pg8::StaticOrder, true, true>(lds, g, S, E); }
        GRID_BAR();
        float* PART = (float*)(ws + WS_CUM + 20 * MiB);
        if (bx < 64) { const int ks = bx >> 5; pg8::Gemm gs{(const bf16_t*)(ws + WS_HID) + ks * (FF / 2), (const bf16_t*)(ws + WS_WFO) + ks * (FF / 2), T, 1024, FF / 2, FF};
            pg8::StaticOrder S; S.init(TS, 1024, 32, bx & 31, TP / 256); EpiPart EP{PART + (size_t)ks * TS * D, TP}; pg8::gemm_phase<EpiPart, pg8::StaticOrder, true, true>(lds, gs, S, EP); }
        else phase_final_norm((const bf16_t*)(ws + WS_X2B), p.out, p.norm_final, 0, TP, 64);
        GRID_BAR();
        phase_final_norm_parts((const bf16_t*)(ws + WS_X1B), PART, PART + (size_t)TS * D, MOD + 5120, p.out, p.norm_final);
      } else {
        pg8::StaticOrder S; S.init(T, 1024, G, cv); pg8::gemm_phase<EpiRes<true>, pg8::StaticOrder, true, true>(lds, g, S, E);
        GRID_BAR();
        phase_final_norm((const bf16_t*)(ws + WS_X2B), p.out, p.norm_final);
      } }
}

extern "C" void kernel_launch(void* const* d_in, const int* in_sizes, int n_in, void* d_out, int out_size, void* d_ws, size_t ws_size, hipStream_t stream) {
    static int grid = 0;
    if (grid == 0) {
        if (n_in != 21 || (size_t)out_size != OUT_TOTAL || ws_size < WS_END) { fprintf(stderr, "kernel_launch: unexpected sizes n_in %d out %d ws %zu\n", n_in, out_size, ws_size); grid = -1; return; }
        int dev = 0, cus = 0, per = 0;
        (void)hipGetDevice(&dev); (void)hipDeviceGetAttribute(&cus, hipDeviceAttributeMultiprocessorCount, dev);
        (void)hipFuncSetAttribute((const void*)fwd_megakernel, hipFuncAttributeMaxDynamicSharedMemorySize, LDS_BYTES);
        (void)hipOccupancyMaxActiveBlocksPerMultiprocessor(&per, (const void*)fwd_megakernel, 512, LDS_BYTES);
        if (per < 1) per = 1;
        grid = cus * per; fprintf(stderr, "kernel_launch: grid %d (cus %d x %d)\n", grid, cus, per);
    }
    if (grid < 0) return;
    if (hipMemsetAsync((char*)d_ws + WS_BAR, 0, BAR_BYTES, stream) != hipSuccess) { fprintf(stderr, "kernel_launch: memset failed\n"); return; }
    Params p{};
    const float** f = (const float**)&p;
    for (int i = 0; i < 21; ++i) f[i] = (const float*)d_in[i];
    p.out = (float*)d_out; p.ws = (unsigned char*)d_ws;
    void* args[] = {&p};
    hipError_t e = hipLaunchCooperativeKernel((const void*)fwd_megakernel, dim3(grid), dim3(512), args, LDS_BYTES, stream);
    if (e != hipSuccess) fprintf(stderr, "cooperative launch failed: %s (grid %d)\n", hipGetErrorString(e), grid);
}
```

```cpp
#include <hip/hip_runtime.h>
#include <hip/hip_cooperative_groups.h>
#include <cstdio>
#include <cstdint>
namespace cg = cooperative_groups;
#ifndef PROBE_DUP
#define PROBE_DUP 0
#endif

#define DI __device__ __forceinline__
#define LAS __attribute__((address_space(3)))
typedef unsigned short bf16_t;
typedef short bf16x8 __attribute__((ext_vector_type(8)));
typedef float f32x4 __attribute__((ext_vector_type(4)));
typedef float f32x2 __attribute__((ext_vector_type(2)));
typedef float f32x16 __attribute__((ext_vector_type(16)));
typedef unsigned u32x4 __attribute__((ext_vector_type(4)));
typedef unsigned u32x2 __attribute__((ext_vector_type(2)));
typedef __bf16 bf2_t __attribute__((ext_vector_type(2)));

constexpr int D = 1024, TP = 32768, TS = 2048, T = TP + TS, NCH = T / 64, NBATCH = 34;
constexpr int INC = 5632, FF = 2816;
constexpr float EPS = 1e-6f, LOG2E = 1.4426950408889634f;
constexpr size_t OFF_Y = 0, OFF_SP = (size_t)T * D, OFF_KP = OFF_SP + 131072, OFF_VP = OFF_KP + 524288, OFF_SS = OFF_VP + 524288,
                 OFF_KS = OFF_SS + 2097152, OFF_VS = OFF_KS + 1048576, OUT_TOTAL = OFF_VS + 1048576;
constexpr size_t MiB = 1u << 20;
constexpr size_t WS_MOD = 1 * MiB, WS_DEC = 2 * MiB, WS_SC = 4 * MiB, WS_WADA = 5 * MiB, WS_WIN = 17 * MiB, WS_WAB = 28 * MiB, WS_WO = 30 * MiB,
                 WS_WFI = 32 * MiB, WS_WFO = 43 * MiB, WS_H = 50 * MiB, WS_QOB = 118 * MiB, WS_KA = 186 * MiB, WS_VA = 220 * MiB, WS_GA = 254 * MiB,
                 WS_KB = 288 * MiB, WS_VB = 322 * MiB, WS_CUM = 356 * MiB, WS_SST = 424 * MiB, WS_END = 492 * MiB;
constexpr size_t WS_U = WS_H, WS_M = WS_KA, WS_HID = WS_KA, WS_X1B = WS_QOB, WS_X2B = WS_H;
constexpr size_t WS_BAR = 0, BAR_BYTES = 16384;
constexpr int LDS_BYTES = 140 * 1024, LDS_ST_OFF = 136 * 1024;

struct Params {
    const float *x_prompt, *x_sample, *c_prompt, *c_sample, *state, *cache_k, *cache_v, *w_ada, *b_ada, *norm_mix, *w_in, *lb_logits, *out_norm,
                *w_a, *rel_bias, *w_b, *w_out, *norm_ffn, *w_ffn_in, *w_ffn_out, *norm_final;
    float* out; unsigned char* ws;
};

DI int fresh_tid() { int t = threadIdx.x; asm volatile("" : "+v"(t)); return t; }
DI int launder(int v) { asm volatile("" : "+v"(v)); return v; }
DI unsigned pk2(float a, float b) { f32x2 v = {a, b}; bf2_t r = __builtin_convertvector(v, bf2_t); return __builtin_bit_cast(unsigned, r); }
DI float bflo(unsigned u) { return __uint_as_float(u << 16); }
DI float bfhi(unsigned u) { return __uint_as_float(u & 0xffff0000u); }
DI float bf2f(short s) { return __uint_as_float(((unsigned)(unsigned short)s) << 16); }
DI float sigm(float x) { return __builtin_amdgcn_rcpf(1.f + __expf(-x)); }
DI float silu(float x) { return x * sigm(x); }
DI int batch_of(int r) { return r < TP ? (r >> 14) : 2 + ((r - TP) >> 6); }
DI int crow(int reg, int h) { return (reg & 3) + 8 * (reg >> 2) + 4 * h; }
DI bf16x8 pack8(const f32x16& x, int s) {
    u32x4 p; p.x = pk2(x[8 * s], x[8 * s + 1]); p.y = pk2(x[8 * s + 2], x[8 * s + 3]); p.z = pk2(x[8 * s + 4], x[8 * s + 5]); p.w = pk2(x[8 * s + 6], x[8 * s + 7]);
    return __builtin_bit_cast(bf16x8, p);
}
DI bf16x8 pack8f(const float* v) { u32x4 p; p.x = pk2(v[0], v[1]); p.y = pk2(v[2], v[3]); p.z = pk2(v[4], v[5]); p.w = pk2(v[6], v[7]); return __builtin_bit_cast(bf16x8, p); }
DI bf16x8 ident_frag(int ks, int l31, int hf) {
    const int jj = l31 - 16 * ks - 8 * hf; bf16x8 r;
#pragma unroll
    for (int j = 0; j < 8; ++j) r[j] = (j == jj) ? (short)0x3F80 : (short)0;
    return r;
}
DI u32x4 widen_pair(u32x2 pg, u32x2 pg1) { const auto rx = __builtin_amdgcn_permlane32_swap(pg.x, pg1.x, false, false), ry = __builtin_amdgcn_permlane32_swap(pg.y, pg1.y, false, false); return (u32x4){rx[0], ry[0], rx[1], ry[1]}; }
DI void narrow_pair(u32x4 d, u32x2& pg, u32x2& pg1) { const auto rx = __builtin_amdgcn_permlane32_swap(d.x, d.z, false, false), ry = __builtin_amdgcn_permlane32_swap(d.y, d.w, false, false); pg = (u32x2){rx[0], ry[0]}; pg1 = (u32x2){rx[1], ry[1]}; }
#define MFMA32(a, b, c) __builtin_amdgcn_mfma_f32_32x32x16_bf16((a), (b), (c), 0, 0, 0)
DI f32x16 zero16() { f32x16 z;
#pragma unroll
    for (int i = 0; i < 16; ++i) z[i] = 0.f; return z; }

namespace pg8 {
constexpr int BM = 256, BK = 64, HALF = 128, HTB = HALF * BK * 2, STAGE_BYTES = 8 * HTB, NXCD = 8, WGM = 8;
__host__ __device__ __forceinline__ int lds_byte(int r, int c) { const int st = (r >> 4) * 2 + (c >> 5), rr = r & 15, cc = c & 31, ob = rr * 64 + cc * 2; return st * 1024 + (ob ^ (((ob >> 9) & 1) << 5)); }
__host__ __device__ __forceinline__ void stage_rc(int b, int& R, int& C) { const int st = b / 1024, sb = b % 1024, swz = sb ^ (((sb >> 9) & 1) << 5); R = (st >> 1) * 16 + swz / 64; C = (st & 1) * 32 + (swz % 64) / 2; }
__host__ __device__ __forceinline__ int perm32(int rho) { const int n = rho >> 4, i = rho & 15; return 8 * (i >> 2) + 4 * n + (i & 3); }
struct Unit { int pm, pn; };
struct Gemm { const bf16_t* A; const bf16_t* Bt; int M, N, K, ld; };
struct StaticOrder {
    int nM, nN, nwg, G, c, pm_off;
    __device__ void init(int M, int N, int G_, int c_, int pm_off_ = 0) { nM = M / BM; nN = N / BM; nwg = nM * nN; G = G_; c = c_; pm_off = pm_off_; }
    __device__ bool next(int i, Unit& u) const {
        const long L = (long)i * G + c; if (L >= nwg) return false;
        int wgid = (int)L; { const int q = nwg / NXCD, r = nwg % NXCD, xcd = wgid % NXCD, off = wgid / NXCD; wgid = (xcd < r ? xcd * (q + 1) : r * (q + 1) + (xcd - r) * q) + off; }
        const int nig = WGM * nN, gid = wgid / nig, fm = gid * WGM, gsz = (nM - fm) < WGM ? (nM - fm) : WGM;
        u.pm = pm_off + fm + ((wgid % nig) % gsz); u.pn = (wgid % nig) / gsz; return true;
    }
};
template <class Epi, class Sched, bool ALIGN_EPI = false, bool SP2 = false>
__device__ __forceinline__ void gemm_phase(LAS unsigned char* lds, const Gemm g, const Sched& S, const Epi& E) {
    const int tid = fresh_tid(), wid = __builtin_amdgcn_readfirstlane(tid >> 6), lane = tid & 63, wr = wid >> 2, wc = wid & 3, fr = lane & 15, fq = lane >> 4;
    const int K = g.ld ? g.ld : g.K, nt = g.K / BK;
    unsigned voffA[2], voffB[2];
#pragma unroll
    for (int i = 0; i < 2; ++i) { int R, C; stage_rc(tid * 16 + i * 8192, R, C); const int Rb = Epi::PERM ? ((R & ~31) + perm32(R & 31)) : R;
        voffA[i] = (unsigned)(R * K + C) * 2u; voffB[i] = (unsigned)(Rb * K + C) * 2u; }
    const size_t kstep = (size_t)(BK * 2);
    const size_t hstep = (size_t)HALF * K * 2;
    const size_t tstep = 2 * hstep;
    const unsigned ldsw = (unsigned)wid * 1024u;
    const int aoff = lds_byte(wr * 64 + fr, fq * 8), boff = lds_byte(wc * 32 + fr, fq * 8);
#define PG8_SA(b, h) (((b) * 2 + (h)) * HTB)
#define PG8_SB(b, h) ((4 + (b) * 2 + (h)) * HTB)
#define PG8_STAGE(bufoff, gbase, voff) do { _Pragma("unroll") for (int _i = 0; _i < 2; ++_i) \
        __builtin_amdgcn_global_load_lds((const unsigned*)((const char*)(gbase) + (voff)[_i]), (LAS unsigned*)(lds + (bufoff) + ldsw + _i * 8192), 16, 0, 0); } while (0)
#define PG8_LDA(dst, b, h) do { _Pragma("unroll") for (int m = 0; m < 4; ++m) _Pragma("unroll") for (int k = 0; k < 2; ++k) dst[m][k] = *(const LAS bf16x8*)(lds + PG8_SA(b, h) + aoff + m * 2048 + k * 1024); } while (0)
#define PG8_LDB(dst, b, h) do { _Pragma("unroll") for (int n = 0; n < 2; ++n) _Pragma("unroll") for (int k = 0; k < 2; ++k) dst[n][k] = *(const LAS bf16x8*)(lds + PG8_SB(b, h) + boff + n * 2048 + k * 1024); } while (0)
#define PG8_MMA(ai, bj, At, Bt) do { __builtin_amdgcn_s_setprio(1); _Pragma("unroll") for (int m = 0; m < 4; ++m) _Pragma("unroll") for (int n = 0; n < 2; ++n) _Pragma("unroll") for (int k = 0; k < 2; ++k) \
        acc[ai][bj][m][n] = __builtin_amdgcn_mfma_f32_16x16x32_bf16(Bt[n][k], At[m][k], acc[ai][bj][m][n], 0, 0, 0); __builtin_amdgcn_s_setprio(0); } while (0)
#define PG8_WAIT_V(n) asm volatile("s_waitcnt vmcnt(" #n ")" ::: "memory")
#define PG8_WAIT_L(n) asm volatile("s_waitcnt lgkmcnt(" #n ")" ::: "memory")
#define PG8_BAR __builtin_amdgcn_s_barrier()
#define PG8_SCHED __builtin_amdgcn_sched_barrier(0)
    Unit cur, nxt; int ui = 0;
    if (!S.next(0, cur)) return;
    f32x4 acc[2][2][4][2];
#pragma unroll
    for (int a = 0; a < 2; ++a)
#pragma unroll
        for (int b = 0; b < 2; ++b)
#pragma unroll
            for (int m = 0; m < 4; ++m)
#pragma unroll
                for (int n = 0; n < 2; ++n) acc[a][b][m][n] = (f32x4){0.f, 0.f, 0.f, 0.f};
    bf16x8 At[4][2], B0[2][2], B1[2][2];
    const char* cA = (const char*)g.A + (size_t)cur.pm * tstep; const char* cB = (const char*)g.Bt + (size_t)cur.pn * tstep;
    if constexpr (SP2) {
        PG8_STAGE(PG8_SB(0, 0), cB, voffB); PG8_STAGE(PG8_SB(0, 1), cB + hstep, voffB); PG8_STAGE(PG8_SA(0, 0), cA, voffA); PG8_STAGE(PG8_SA(0, 1), cA + hstep, voffA);
        if (wr == 1) PG8_BAR;
        PG8_WAIT_V(2); PG8_BAR;
        PG8_STAGE(PG8_SB(1, 0), cB + kstep, voffB); PG8_STAGE(PG8_SA(1, 0), cA + kstep, voffA); PG8_STAGE(PG8_SB(1, 1), cB + hstep + kstep, voffB);
        PG8_WAIT_V(6); PG8_BAR;
    } else {
        PG8_STAGE(PG8_SB(0, 0), cB, voffB); PG8_STAGE(PG8_SA(0, 0), cA, voffA); PG8_STAGE(PG8_SB(0, 1), cB + hstep, voffB); PG8_STAGE(PG8_SA(0, 1), cA + hstep, voffA);
        if (wr == 1) PG8_BAR;
        PG8_WAIT_V(4); PG8_BAR;
        PG8_STAGE(PG8_SB(1, 0), cB + kstep, voffB); PG8_STAGE(PG8_SA(1, 0), cA + kstep, voffA); PG8_STAGE(PG8_SB(1, 1), cB + hstep + kstep, voffB);
        PG8_WAIT_V(6); PG8_BAR;
    }
    for (;;) {
        const bool has_next = S.next(ui + 1, nxt);
        const char* nA = has_next ? (const char*)g.A + (size_t)nxt.pm * tstep : cA; const char* nB = has_next ? (const char*)g.Bt + (size_t)nxt.pn * tstep : cB;
        for (int t = 0; t < nt; t += 2) {
            if constexpr (Epi::MIDK) { if (t == nt / 2) E.mid(acc, cur, wr, wc, fr, fq); }
            const bool last = (t == nt - 2);
            const char* a1 = cA + (size_t)(t + 1) * kstep;
            const char* a2 = last ? nA : cA + (size_t)(t + 2) * kstep; const char* b2 = last ? nB : cB + (size_t)(t + 2) * kstep;
            const char* a3 = a2 + kstep; const char* b3 = b2 + kstep;
            if constexpr (SP2) {
            PG8_LDB(B0, 0, 0); PG8_LDB(B1, 0, 1); PG8_SCHED; PG8_LDA(At, 0, 0); PG8_STAGE(PG8_SA(1, 1), a1 + hstep, voffA);
            PG8_WAIT_V(8); PG8_WAIT_L(0); PG8_BAR; PG8_MMA(0, 0, At, B0); PG8_MMA(0, 1, At, B1); PG8_BAR; PG8_SCHED;
            PG8_LDA(At, 0, 1); PG8_STAGE(PG8_SB(0, 0), b2, voffB); PG8_STAGE(PG8_SB(0, 1), b2 + hstep, voffB); PG8_STAGE(PG8_SA(0, 0), a2, voffA);
            PG8_WAIT_V(8); PG8_WAIT_L(0); PG8_BAR; PG8_MMA(1, 0, At, B0); PG8_MMA(1, 1, At, B1); PG8_BAR; PG8_SCHED;
            PG8_LDB(B0, 1, 0); PG8_LDB(B1, 1, 1); PG8_SCHED; PG8_LDA(At, 1, 0); PG8_STAGE(PG8_SA(0, 1), a2 + hstep, voffA);
            PG8_WAIT_V(8); PG8_WAIT_L(0); PG8_BAR; PG8_MMA(0, 0, At, B0); PG8_MMA(0, 1, At, B1); PG8_BAR; PG8_SCHED;
            PG8_LDA(At, 1, 1); PG8_STAGE(PG8_SB(1, 0), b3, voffB); PG8_STAGE(PG8_SB(1, 1), b3 + hstep, voffB); PG8_STAGE(PG8_SA(1, 0), a3, voffA);
            PG8_WAIT_V(8); PG8_WAIT_L(0); PG8_BAR; PG8_MMA(1, 0, At, B0); PG8_MMA(1, 1, At, B1); PG8_BAR; PG8_SCHED;
            } else {
            PG8_LDB(B0, 0, 0); PG8_SCHED; PG8_LDA(At, 0, 0); PG8_STAGE(PG8_SA(1, 1), a1 + hstep, voffA);
            PG8_WAIT_L(8); PG8_BAR; PG8_WAIT_L(0); PG8_MMA(0, 0, At, B0); PG8_BAR; PG8_SCHED;
            PG8_LDB(B1, 0, 1); PG8_STAGE(PG8_SB(0, 0), b2, voffB);
            PG8_BAR; PG8_WAIT_L(0); PG8_MMA(0, 1, At, B1); PG8_BAR;
            PG8_LDA(At, 0, 1); PG8_STAGE(PG8_SA(0, 0), a2, voffA);
            PG8_BAR; PG8_WAIT_L(0); PG8_MMA(1, 0, At, B0); PG8_BAR; PG8_SCHED;
            PG8_STAGE(PG8_SB(0, 1), b2 + hstep, voffB);
            PG8_WAIT_V(6); PG8_BAR; PG8_MMA(1, 1, At, B1); PG8_BAR;
            PG8_LDB(B0, 1, 0); PG8_SCHED; PG8_LDA(At, 1, 0); PG8_STAGE(PG8_SA(0, 1), a2 + hstep, voffA);
            PG8_WAIT_L(8); PG8_BAR; PG8_WAIT_L(0); PG8_MMA(0, 0, At, B0); PG8_BAR; PG8_SCHED;
            PG8_LDB(B1, 1, 1); PG8_STAGE(PG8_SB(1, 0), b3, voffB);
            PG8_BAR; PG8_WAIT_L(0); PG8_MMA(0, 1, At, B1); PG8_BAR;
            PG8_LDA(At, 1, 1); PG8_STAGE(PG8_SA(1, 0), a3, voffA);
            PG8_BAR; PG8_WAIT_L(0); PG8_MMA(1, 0, At, B0); PG8_BAR; PG8_SCHED;
            PG8_STAGE(PG8_SB(1, 1), b3 + hstep, voffB);
            PG8_WAIT_V(6); PG8_BAR; PG8_MMA(1, 1, At, B1); PG8_BAR;
            }
        }
        if constexpr (ALIGN_EPI) { if (wr == 0) PG8_BAR; }
        E(acc, cur, wr, wc, fr, fq);
        if (!has_next) break;
#pragma unroll
        for (int a = 0; a < 2; ++a)
#pragma unroll
            for (int b = 0; b < 2; ++b)
#pragma unroll
                for (int m = 0; m < 4; ++m)
#pragma unroll
                    for (int n = 0; n < 2; ++n) acc[a][b][m][n] = (f32x4){0.f, 0.f, 0.f, 0.f};
        cur = nxt; cA = nA; cB = nB; ++ui;
        if constexpr (ALIGN_EPI) { if (wr == 1) PG8_BAR; }
    }
    PG8_WAIT_V(0);
    if constexpr (!ALIGN_EPI) { if (wr == 0) PG8_BAR; }
    PG8_BAR;
#undef PG8_SA
#undef PG8_SB
#undef PG8_STAGE
#undef PG8_LDA
#undef PG8_LDB
#undef PG8_MMA
#undef PG8_WAIT_V
#undef PG8_WAIT_L
#undef PG8_BAR
#undef PG8_SCHED
}
}
using pg8::Unit;
typedef f32x4 Acc[2][2][4][2];

DI u32x4 pack_row8(const f32x4& v0, const f32x4& v1) { u32x4 w; w.x = pk2(v0[0], v0[1]); w.y = pk2(v0[2], v0[3]); w.z = pk2(v1[0], v1[1]); w.w = pk2(v1[2], v1[3]); return w; }

struct EpiMod {
    static constexpr bool PERM = false, MIDK = false;
    float* mod; const float* bias;
    DI void operator()(Acc& acc, const Unit& u, int wr, int wc, int fr, int fq) const {
        { const int t_ = fresh_tid(); fr = t_ & 15; fq = (t_ >> 4) & 3; }
        if (u.pm != 0 || wr != 0) return;
#pragma unroll
        for (int m = 0; m < 3; ++m) { const int r = 16 * m + fr; if (r < NBATCH) {
#pragma unroll
            for (int bj = 0; bj < 2; ++bj)
#pragma unroll
                for (int n = 0; n < 2; ++n) { const int col = u.pn * 256 + bj * 128 + wc * 32 + n * 16 + 4 * fq;
                    *(f32x4*)(mod + (size_t)r * 6144 + col) = acc[0][bj][m][n] + *(const f32x4*)(bias + col); } } }
    }
};

struct EpiIn {
    static constexpr bool PERM = true, MIDK = false;
    bf16_t *QOB, *KA, *VA, *GA, *KB, *VB, *SGA, *SGB; float *CUM, *DEC; const float* lbl; float* out;
    DI void operator()(Acc& acc, const Unit& u, int wr, int wc, int fr, int fq) const {
        { const int t_ = fresh_tid(); fr = t_ & 15; fq = (t_ >> 4) & 3; }
        const int pn = u.pn, rt = wr * 64 + fr, row0 = u.pm * 256 + rt, cw = wc * 32 + 8 * fq, lane = fq * 16 + fr;
        if (pn >= 14) {
            const size_t o0 = ((size_t)(u.pm * 8 + (pn - 14)) * 8 * 512 + (size_t)(wr * 4 + wc) * 64 + lane) * 8;
#pragma unroll
            for (int ai = 0; ai < 2; ++ai)
#pragma unroll
                for (int m = 0; m < 4; ++m) { f32x4 r0, r1, b0, b1;
#pragma unroll
                    for (int j = 0; j < 4; ++j) { b0[j] = fmaxf(sigm(acc[ai][1][m][0][j]), 1e-30f); b1[j] = fmaxf(sigm(acc[ai][1][m][1][j]), 1e-30f);
                        r0[j] = sigm(acc[ai][0][m][0][j]) * __builtin_amdgcn_rcpf(b0[j]); r1[j] = sigm(acc[ai][0][m][1][j]) * __builtin_amdgcn_rcpf(b1[j]); }
                    const size_t o = o0 + (size_t)(ai * 4 + m) * 512 * 8;
                    *(u32x4*)(SGA + o) = pack_row8(r0, r1); *(u32x4*)(SGB + o) = pack_row8(b0, b1); __builtin_amdgcn_sched_barrier(0); }
            return;
        }
        const int seg = pn >> 1, col0 = (pn & 1) * 256 + cw;
        if (seg == 1) {
#pragma unroll
            for (int bj = 0; bj < 2; ++bj) {
                float lb[2][4];
#pragma unroll
                for (int n = 0; n < 2; ++n)
#pragma unroll
                    for (int j = 0; j < 4; ++j) { const int c = col0 + bj * 128 + 4 * n + j; lb[n][j] = __builtin_amdgcn_rcpf(1.f + __expf(lbl[512 + c] - lbl[c])); }
#pragma unroll
                for (int ai = 0; ai < 2; ++ai) {
                    const size_t rbase = ((size_t)((pn & 1) * 2 + bj) * T + (u.pm * 256 + ai * 128 + wr * 64 + launder(fr))) * 128 + cw;
#pragma unroll
                    for (int m = 0; m < 4; ++m) { f32x4 k0, k1;
#pragma unroll
                        for (int j = 0; j < 4; ++j) {
                            float f = lb[0][j] + (1.f - lb[0][j]) * sigm(acc[ai][bj][m][0][j]); k0[j] = 1.f - f; acc[ai][bj][m][0][j] = __logf(f);
                            f = lb[1][j] + (1.f - lb[1][j]) * sigm(acc[ai][bj][m][1][j]); k1[j] = 1.f - f; acc[ai][bj][m][1][j] = __logf(f); }
                        *(u32x4*)(KA + rbase + (size_t)m * 16 * 128) = pack_row8(k0, k1); }
                    __builtin_amdgcn_sched_barrier(0);
#pragma unroll
                    for (int n = 0; n < 2; ++n)
#pragma unroll
                        for (int j = 0; j < 4; ++j) { float carry = 0.f;
#pragma unroll
                            for (int m = 0; m < 4; ++m) { float v = acc[ai][bj][m][n][j];
                                v += __int_as_float(__builtin_amdgcn_update_dpp(0, __float_as_int(v), 0x111, 0xf, 0xf, false));
                                v += __int_as_float(__builtin_amdgcn_update_dpp(0, __float_as_int(v), 0x112, 0xf, 0xf, false));
                                v += __int_as_float(__builtin_amdgcn_update_dpp(0, __float_as_int(v), 0x114, 0xf, 0xf, false));
                                v += __int_as_float(__builtin_amdgcn_update_dpp(0, __float_as_int(v), 0x118, 0xf, 0xf, false));
                                v += carry; carry = __shfl(v, lane | 15); acc[ai][bj][m][n][j] = v; } }
                    __builtin_amdgcn_sched_barrier(0);
#pragma unroll
                    for (int m = 0; m < 4; ++m) { float* cp = CUM + rbase + (size_t)m * 16 * 128; *(f32x4*)cp = acc[ai][bj][m][0]; *(f32x4*)(cp + 4) = acc[ai][bj][m][1]; }
                    if (fr == 15) {
#pragma unroll
                        for (int n = 0; n < 2; ++n) { f32x4 e;
#pragma unroll
                            for (int j = 0; j < 4; ++j) e[j] = __expf(acc[ai][bj][3][n][j]);
                            *(f32x4*)(DEC + (size_t)(u.pm * 4 + ai * 2 + wr) * 512 + col0 + bj * 128 + 4 * n) = e; } }
                    __builtin_amdgcn_sched_barrier(0);
                }
            }
            return;
        }
        bf16_t* dst; int pitch = 512; size_t bjoff = 128; float* o32 = nullptr;
        switch (seg) {
            case 0: dst = QOB + col0; pitch = 1024; break;
            case 2: dst = VA + (size_t)((pn & 1) * 2) * T * 128 + (cw >> 3) * 256; bjoff = (size_t)T * 128; break;
            case 3: dst = GA + (size_t)((pn & 1) * 2) * T * 128 + cw; pitch = 128; bjoff = (size_t)T * 128; break;
            case 4: dst = QOB + 512 + col0; pitch = 1024; break;
            default: dst = (seg == 5 ? KB : VB) + (size_t)((pn & 1) * 4 + (wc >> 1)) * (T / 32) * 2048 + ((wc & 1) * 4 + fq) * 256; bjoff = (size_t)2 * (T / 32) * 2048; break;
        }
        if (seg >= 5) {
            if (u.pm >= 128) o32 = out + (seg == 5 ? OFF_KS : OFF_VS) + (size_t)((u.pm - 128) * 256 + rt) * 512 + col0;
            else if ((u.pm & 63) >= 62) o32 = out + (seg == 5 ? OFF_KP : OFF_VP) + (size_t)((u.pm >> 6) * 512 + ((u.pm & 63) - 62) * 256 + rt) * 512 + col0;
        }
        const bool act = (seg == 0 || seg == 3);
#pragma unroll
        for (int ai = 0; ai < 2; ++ai)
#pragma unroll
            for (int m = 0; m < 4; ++m)
#pragma unroll
                for (int bj = 0; bj < 2; ++bj) { f32x4 v0 = acc[ai][bj][m][0], v1 = acc[ai][bj][m][1];
                    if (act) {
#pragma unroll
                        for (int j = 0; j < 4; ++j) { v0[j] = silu(v0[j]); v1[j] = silu(v1[j]); } }
                    const size_t ro = seg >= 5 ? (size_t)(u.pm * 8 + 2 * wr + 4 * ai + (m >> 1)) * 2048 + ((m & 1) * 16 + fr) * 8 : seg == 2 ? (size_t)(u.pm * 8 + 2 * wr + 4 * ai + (m >> 1)) * 4096 + ((m & 1) * 16 + fr) * 8 : (size_t)(row0 + ai * 128 + m * 16) * pitch;
                    *(u32x4*)(dst + ro + bj * bjoff) = pack_row8(v0, v1);
                    if (o32) { float* op = o32 + (size_t)(ai * 128 + m * 16) * 512 + bj * 128; *(f32x4*)op = v0; *(f32x4*)(op + 4) = v1; } __builtin_amdgcn_sched_barrier(0); }
    }
};

struct EpiMerge {
    static constexpr bool PERM = true, MIDK = true;
    const bf16_t *SGR, *SGB; bf16_t* Mo;
    DI void mid(Acc& acc, const Unit& u, int wr, int wc, int fr, int fq) const {
        { const int t_ = fresh_tid(); fr = t_ & 15; fq = (t_ >> 4) & 3; }
        const size_t gb = ((size_t)(u.pm * 8 + 2 * u.pn) * 8 * 512 + (size_t)(wr * 4 + wc) * 64 + (fq * 16 + fr)) * 8;
#pragma unroll
        for (int ai = 0; ai < 2; ++ai) { u32x4 a[4][2];
#pragma unroll
            for (int m = 0; m < 4; ++m)
#pragma unroll
                for (int bj = 0; bj < 2; ++bj) a[m][bj] = *(const u32x4*)(SGR + gb + ((size_t)bj * 8 + ai * 4 + m) * 512 * 8);
#pragma unroll
            for (int m = 0; m < 4; ++m)
#pragma unroll
                for (int bj = 0; bj < 2; ++bj)
#pragma unroll
                    for (int j = 0; j < 4; ++j) { acc[ai][bj][m][j >> 1][(j & 1) * 2] *= bflo(a[m][bj][j]); acc[ai][bj][m][j >> 1][(j & 1) * 2 + 1] *= bfhi(a[m][bj][j]); }
            __builtin_amdgcn_sched_barrier(0); }
    }
    DI void operator()(Acc& acc, const Unit& u, int wr, int wc, int fr, int fq) const {
        { const int t_ = fresh_tid(); fr = t_ & 15; fq = (t_ >> 4) & 3; }
        const size_t base = (size_t)(u.pm * 256 + wr * 64 + fr) * 1024 + u.pn * 256 + wc * 32 + 8 * fq;
        const size_t gb = ((size_t)(u.pm * 8 + 2 * u.pn) * 8 * 512 + (size_t)(wr * 4 + wc) * 64 + (fq * 16 + fr)) * 8;
#pragma unroll
        for (int ai = 0; ai < 2; ++ai) { u32x4 b[4][2];
#pragma unroll
            for (int m = 0; m < 4; ++m)
#pragma unroll
                for (int bj = 0; bj < 2; ++bj) b[m][bj] = *(const u32x4*)(SGB + gb + ((size_t)bj * 8 + ai * 4 + m) * 512 * 8);
#pragma unroll
            for (int m = 0; m < 4; ++m)
#pragma unroll
                for (int bj = 0; bj < 2; ++bj) { f32x4 v0 = acc[ai][bj][m][0], v1 = acc[ai][bj][m][1]; const u32x4 g = b[m][bj];
                    v0[0] *= bflo(g[0]); v0[1] *= bfhi(g[0]); v0[2] *= bflo(g[1]); v0[3] *= bfhi(g[1]);
                    v1[0] *= bflo(g[2]); v1[1] *= bfhi(g[2]); v1[2] *= bflo(g[3]); v1[3] *= bfhi(g[3]);
                    *(u32x4*)(Mo + base + (size_t)(ai * 128 + m * 16) * 1024 + bj * 128) = pack_row8(v0, v1); }
            __builtin_amdgcn_sched_barrier(0); }
    }
};

template <bool BASE_BF16> struct EpiRes {
    static constexpr bool PERM = true, MIDK = false;
    const float *xp, *xs; const bf16_t* xb; bf16_t* xo; const float* gmod;
    DI void operator()(Acc& acc, const Unit& u, int wr, int wc, int fr, int fq) const {
        { const int t_ = fresh_tid(); fr = t_ & 15; fq = (t_ >> 4) & 3; }
        const int colb = u.pn * 256 + wc * 32 + 8 * fq;
#pragma unroll
        for (int ai = 0; ai < 2; ++ai) { const int r0 = u.pm * 256 + ai * 128 + wr * 64 + fr;
            const float* g = gmod + (size_t)batch_of(r0) * 6144 + colb;
            f32x4 gv[2][2];
#pragma unroll
            for (int bj = 0; bj < 2; ++bj) { gv[bj][0] = *(const f32x4*)(g + bj * 128); gv[bj][1] = *(const f32x4*)(g + bj * 128 + 4); }
            bf16_t* orow = xo + (size_t)r0 * D + colb;
            if constexpr (BASE_BF16) {
                const bf16_t* xr = xb + (size_t)r0 * D + colb; u32x4 xv[4][2];
#pragma unroll
                for (int m = 0; m < 4; ++m)
#pragma unroll
                    for (int bj = 0; bj < 2; ++bj) xv[m][bj] = *(const u32x4*)(xr + (size_t)m * 16 * D + bj * 128);
#pragma unroll
                for (int m = 0; m < 4; ++m)
#pragma unroll
                    for (int bj = 0; bj < 2; ++bj) { const u32x4 x = xv[m][bj]; const f32x4 a0 = acc[ai][bj][m][0] * gv[bj][0], a1 = acc[ai][bj][m][1] * gv[bj][1];
                        f32x4 v0 = {bflo(x[0]) + a0[0], bfhi(x[0]) + a0[1], bflo(x[1]) + a0[2], bfhi(x[1]) + a0[3]}, v1 = {bflo(x[2]) + a1[0], bfhi(x[2]) + a1[1], bflo(x[3]) + a1[2], bfhi(x[3]) + a1[3]};
                        *(u32x4*)(orow + (size_t)m * 16 * D + bj * 128) = pack_row8(v0, v1); }
            } else {
                const float* xr = (r0 < TP ? xp + (size_t)r0 * D : xs + (size_t)(r0 - TP) * D) + colb; f32x4 xv[4][2][2];
#pragma unroll
                for (int m = 0; m < 4; ++m)
#pragma unroll
                    for (int bj = 0; bj < 2; ++bj) { xv[m][bj][0] = *(const f32x4*)(xr + (size_t)m * 16 * D + bj * 128); xv[m][bj][1] = *(const f32x4*)(xr + (size_t)m * 16 * D + bj * 128 + 4); }
#pragma unroll
                for (int m = 0; m < 4; ++m)
#pragma unroll
                    for (int bj = 0; bj < 2; ++bj) *(u32x4*)(orow + (size_t)m * 16 * D + bj * 128) = pack_row8(xv[m][bj][0] + gv[bj][0] * acc[ai][bj][m][0], xv[m][bj][1] + gv[bj][1] * acc[ai][bj][m][1]);
            }
            __builtin_amdgcn_sched_barrier(0); }
    }
};

struct EpiPart {
    static constexpr bool PERM = false, MIDK = false;
    float* part; int row0;
    DI void operator()(Acc& acc, const Unit& u, int wr, int wc, int fr, int fq) const {
        { const int t_ = fresh_tid(); fr = t_ & 15; fq = (t_ >> 4) & 3; }
#pragma unroll
        for (int ai = 0; ai < 2; ++ai)
#pragma unroll
            for (int m = 0; m < 4; ++m) { float* prow = part + (size_t)(u.pm * 256 + ai * 128 + wr * 64 + m * 16 + fr - row0) * D + u.pn * 256 + wc * 32 + 4 * fq;
#pragma unroll
                for (int bj = 0; bj < 2; ++bj)
#pragma unroll
                    for (int n = 0; n < 2; ++n) *(f32x4*)(prow + bj * 128 + n * 16) = acc[ai][bj][m][n];
                __builtin_amdgcn_sched_barrier(0); }
    }
};

struct EpiFfnIn {
    static constexpr bool PERM = true, MIDK = false;
    bf16_t* HID;
    DI void operator()(Acc& acc, const Unit& u, int wr, int wc, int fr, int fq) const {
        { const int t_ = fresh_tid(); fr = t_ & 15; fq = (t_ >> 4) & 3; }
        bf16_t* base = HID + (size_t)(u.pm * 256 + wr * 64 + fr) * FF + u.pn * 128 + wc * 32 + 8 * fq;
#pragma unroll
        for (int ai = 0; ai < 2; ++ai)
#pragma unroll
            for (int m = 0; m < 4; ++m) { f32x4 v0, v1;
#pragma unroll
                for (int j = 0; j < 4; ++j) { v0[j] = silu(acc[ai][0][m][0][j]) * acc[ai][1][m][0][j]; v1[j] = silu(acc[ai][0][m][1][j]) * acc[ai][1][m][1][j]; }
                *(u32x4*)(base + (size_t)(ai * 128 + m * 16) * FF) = pack_row8(v0, v1); __builtin_amdgcn_sched_barrier(0); }
    }
};

DI void transpose_item(const float* W, int N, bf16_t* WT, int pitch, int koff, int k0, int n0, int drow0, LAS float* scr, int lane) {
#pragma unroll
    for (int i = 0; i < 8; ++i) { const int kk = 8 * i + (lane >> 3), n4 = 4 * (lane & 7); const f32x4 w = *(const f32x4*)(W + (size_t)(k0 + kk) * N + n0 + n4);
        scr[kk * 33 + n4] = w[0]; scr[kk * 33 + n4 + 1] = w[1]; scr[kk * 33 + n4 + 2] = w[2]; scr[kk * 33 + n4 + 3] = w[3]; }
    asm volatile("s_waitcnt lgkmcnt(0)" ::: "memory");
    const int c = lane & 7;
#pragma unroll
    for (int j = 0; j < 4; ++j) { const int n = (lane >> 3) + 8 * j; const LAS float* s = scr + (8 * c) * 33 + n;
        u32x4 o; o.x = pk2(s[0 * 33], s[1 * 33]); o.y = pk2(s[2 * 33], s[3 * 33]); o.z = pk2(s[4 * 33], s[5 * 33]); o.w = pk2(s[6 * 33], s[7 * 33]);
        *(u32x4*)(WT + (size_t)(drow0 + n) * pitch + koff + k0 + 8 * c) = o; }
    asm volatile("s_waitcnt lgkmcnt(0)" ::: "memory");
}
DI void phase_prep(const Params& p, LAS unsigned char* lds) {
    const int tid = fresh_tid(), lane = tid & 63, wave = __builtin_amdgcn_readfirstlane(tid >> 6);
    LAS float* scr = (LAS float*)(lds + wave * 16384);
    const int gw = blockIdx.x * 8 + wave, NGW = gridDim.x * 8;
    unsigned char* ws = p.ws;
    constexpr int I_ADA = 16 * 192, I_IN = 16 * 176, I_A = 8 * 32, I_O = 16 * 32, I_FI = 16 * 176, I_FO = 44 * 32;
    constexpr int NIT = I_ADA + I_IN + 2 * I_A + I_O + I_FI + I_FO;
    for (int it = gw; it < NIT; it += NGW) {
        int r = it;
        if (r < I_ADA) { const int kb = r / 192, nb = r % 192; transpose_item(p.w_ada, 6144, (bf16_t*)(ws + WS_WADA), 1024, 0, 64 * kb, 32 * nb, 32 * nb, scr, lane); continue; } r -= I_ADA;
        if (r < I_IN) { const int kb = r / 176, nb = r % 176, n0 = 32 * nb; int dr = n0;
            if (n0 >= 3584) { const int j = n0 < 4608 ? n0 - 3584 : n0 - 4608; dr = 3584 + 256 * (j >> 7) + (j & 127) + (n0 < 4608 ? 0 : 128); }
            transpose_item(p.w_in, INC, (bf16_t*)(ws + WS_WIN), 1024, 0, 64 * kb, n0, dr, scr, lane); continue; } r -= I_IN;
        if (r < I_A) { const int kb = r / 32, nb = r % 32; transpose_item(p.w_a, 1024, (bf16_t*)(ws + WS_WAB), 1024, 0, 64 * kb, 32 * nb, 32 * nb, scr, lane); continue; } r -= I_A;
        if (r < I_A) { const int kb = r / 32, nb = r % 32; transpose_item(p.w_b, 1024, (bf16_t*)(ws + WS_WAB), 1024, 512, 64 * kb, 32 * nb, 32 * nb, scr, lane); continue; } r -= I_A;
        if (r < I_O) { const int kb = r / 32, nb = r % 32; transpose_item(p.w_out, 1024, (bf16_t*)(ws + WS_WO), 1024, 0, 64 * kb, 32 * nb, 32 * nb, scr, lane); continue; } r -= I_O;
        if (r < I_FI) { const int kb = r / 176, nb = r % 176; const int n0 = 32 * nb; const int j0 = n0 < FF ? n0 : n0 - FF;
            transpose_item(p.w_ffn_in, INC, (bf16_t*)(ws + WS_WFI), 1024, 0, 64 * kb, n0, 256 * (j0 >> 7) + (j0 & 127) + (n0 < FF ? 0 : 128), scr, lane); continue; } r -= I_FI;
        { const int kb = r / 32, nb = r % 32; transpose_item(p.w_ffn_out, 1024, (bf16_t*)(ws + WS_WFO), FF, 0, 64 * kb, 32 * nb, 32 * nb, scr, lane); }
    }
    bf16_t* SC = (bf16_t*)(ws + WS_SC);
    for (int i = blockIdx.x * 512 + tid; i < 256 * 1024 / 2; i += gridDim.x * 512) { const int row = (2 * i) >> 10, col = (2 * i) & 1023; float a = 0.f, b = 0.f;
        if (row < NBATCH) { const float* c = row < 2 ? p.c_prompt + row * D : p.c_sample + (row - 2) * D; a = silu(c[col]); b = silu(c[col + 1]); }
        ((unsigned*)SC)[i] = pk2(a, b); }
}

DI float wave_sum(float v) {
#pragma unroll
    for (int o = 1; o < 64; o <<= 1) v += __shfl_xor(v, o);
    return v;
}
DI void phase_norm_mod(const float* xp, const float* xs, const float* nw, const float* mod, int sh_off, int sc_off, bf16_t* H) {
    const int tid = fresh_tid(), lane = tid & 63, wave = __builtin_amdgcn_readfirstlane(tid >> 6);
    const int gw = blockIdx.x * 8 + wave, NGW = gridDim.x * 8;
    for (int r = gw; r < T; r += NGW) {
        const float* xr = r < TP ? xp + (size_t)r * D : xs + (size_t)(r - TP) * D; const float* mb = mod + (size_t)batch_of(r) * 6144;
        f32x4 v[4]; float s = 0.f;
#pragma unroll
        for (int j = 0; j < 4; ++j) { v[j] = *(const f32x4*)(xr + 4 * lane + 256 * j); s += (v[j][0] * v[j][0] + v[j][1] * v[j][1]) + (v[j][2] * v[j][2] + v[j][3] * v[j][3]); }
        const float rstd = __builtin_amdgcn_rsqf(wave_sum(s) * (1.f / D) + EPS);
#pragma unroll
        for (int j = 0; j < 4; ++j) { const int col = 4 * lane + 256 * j; const f32x4 w = *(const f32x4*)(nw + col), sc = *(const f32x4*)(mb + sc_off + col), sh = *(const f32x4*)(mb + sh_off + col);
            const f32x4 h = v[j] * rstd * w * (sc + 1.f) + sh; u32x2 o; o.x = pk2(h[0], h[1]); o.y = pk2(h[2], h[3]);
            *(u32x2*)(H + (size_t)r * D + col) = o; }
    }
}
DI void phase_norm_mod_b(const bf16_t* xb, const float* nw, const float* mod, int sh_off, int sc_off, bf16_t* H, int r_lo = 0, int r_hi = T, int b_lo = 0) {
    const int tid = fresh_tid(), lane = tid & 63, wave = __builtin_amdgcn_readfirstlane(tid >> 6);
    const int gw = ((int)blockIdx.x - b_lo) * 8 + wave, NGW = ((int)gridDim.x - b_lo) * 8;
    for (int r = r_lo + gw; r < r_hi; r += NGW) {
        const bf16_t* xr = xb + (size_t)r * D; const float* mb = mod + (size_t)batch_of(r) * 6144;
        float v[2][8]; float s = 0.f;
#pragma unroll
        for (int j = 0; j < 2; ++j) { const u32x4 x = *(const u32x4*)(xr + 8 * lane + 512 * j);
#pragma unroll
            for (int i = 0; i < 4; ++i) { v[j][2 * i] = bflo(x[i]); v[j][2 * i + 1] = bfhi(x[i]); s += v[j][2 * i] * v[j][2 * i] + v[j][2 * i + 1] * v[j][2 * i + 1]; } }
        const float rstd = __builtin_amdgcn_rsqf(wave_sum(s) * (1.f / D) + EPS);
#pragma unroll
        for (int j = 0; j < 2; ++j) { const int col = 8 * lane + 512 * j; f32x4 h[2];
#pragma unroll
            for (int q = 0; q < 2; ++q) { const f32x4 w = *(const f32x4*)(nw + col + 4 * q), sc = *(const f32x4*)(mb + sc_off + col + 4 * q), sh = *(const f32x4*)(mb + sh_off + col + 4 * q);
                const f32x4 x = {v[j][4 * q], v[j][4 * q + 1], v[j][4 * q + 2], v[j][4 * q + 3]}; h[q] = x * rstd * w * (sc + 1.f) + sh; }
            *(u32x4*)(H + (size_t)r * D + col) = pack_row8(h[0], h[1]); }
    }
}
DI void phase_final_norm(const bf16_t* xb, float* y, const float* nw, int r_lo = 0, int r_hi = T, int b_lo = 0) {
    const int tid = fresh_tid(), lane = tid & 63, wave = __builtin_amdgcn_readfirstlane(tid >> 6);
    const int gw = ((int)blockIdx.x - b_lo) * 8 + wave, NGW = ((int)gridDim.x - b_lo) * 8;
    for (int r = r_lo + gw; r < r_hi; r += NGW) { const bf16_t* xr = xb + (size_t)r * D; float* yr = y + (size_t)r * D;
        float v[2][8]; float s = 0.f;
#pragma unroll
        for (int j = 0; j < 2; ++j) { const u32x4 x = *(const u32x4*)(xr + 8 * lane + 512 * j);
#pragma unroll
            for (int i = 0; i < 4; ++i) { v[j][2 * i] = bflo(x[i]); v[j][2 * i + 1] = bfhi(x[i]); s += v[j][2 * i] * v[j][2 * i] + v[j][2 * i + 1] * v[j][2 * i + 1]; } }
        const float rstd = __builtin_amdgcn_rsqf(wave_sum(s) * (1.f / D) + EPS);
#pragma unroll
        for (int j = 0; j < 2; ++j) { const int col = 8 * lane + 512 * j;
#pragma unroll
            for (int q = 0; q < 2; ++q) { const f32x4 x = {v[j][4 * q], v[j][4 * q + 1], v[j][4 * q + 2], v[j][4 * q + 3]}; *(f32x4*)(yr + col + 4 * q) = x * rstd * *(const f32x4*)(nw + col + 4 * q); } }
    }
}

DI void phase_final_norm_parts(const bf16_t* x1b, const float* part0, const float* part1, const float* g2mod, float* y, const float* nw) {
    const int tid = fresh_tid(), lane = tid & 63, wave = __builtin_amdgcn_readfirstlane(tid >> 6);
    const int gw = blockIdx.x * 8 + wave, NGW = gridDim.x * 8;
    for (int r = TP + gw; r < T; r += NGW) { const float* gb = g2mod + (size_t)batch_of(r) * 6144; const size_t po = (size_t)(r - TP) * D;
        f32x4 v[4]; float s = 0.f;
#pragma unroll
        for (int j = 0; j < 4; ++j) { const int col = 4 * lane + 256 * j; const u32x2 xb = *(const u32x2*)(x1b + (size_t)r * D + col);
            const f32x4 x = {bflo(xb.x), bfhi(xb.x), bflo(xb.y), bfhi(xb.y)};
            v[j] = x + *(const f32x4*)(gb + col) * (*(const f32x4*)(part0 + po + col) + *(const f32x4*)(part1 + po + col));
            s += (v[j][0] * v[j][0] + v[j][1] * v[j][1]) + (v[j][2] * v[j][2] + v[j][3] * v[j][3]); }
        const float rstd = __builtin_amdgcn_rsqf(wave_sum(s) * (1.f / D) + EPS);
#pragma unroll
        for (int j = 0; j < 4; ++j) { const int col = 4 * lane + 256 * j; *(f32x4*)(y + (size_t)r * D + col) = v[j] * rstd * *(const f32x4*)(nw + col); }
    }
}

DI void hgrn_u_item(const Params& p, int item, int lane) {
    const int c = item >> 4, rem = item & 15, h = rem >> 2, kt = rem & 3, l31 = lane & 31, hf = lane >> 5;
    const float* CUM = (const float*)(p.ws + WS_CUM); const bf16_t* KA = (const bf16_t*)(p.ws + WS_KA); const bf16_t* VA = (const bf16_t*)(p.ws + WS_VA); bf16_t* U = (bf16_t*)(p.ws + WS_U);
    const size_t hb = (size_t)h * T * 128; const int kcol = 32 * kt + l31;
    const float tot = CUM[hb + (size_t)(c * 64 + 63) * 128 + kcol];
    bf16x8 kdf[2][2];
#pragma unroll
    for (int st = 0; st < 2; ++st) { f32x16 kd;
#pragma unroll
        for (int r = 0; r < 16; ++r) { const size_t idx = hb + (size_t)(c * 64 + 32 * st + crow(r, hf)) * 128 + kcol; kd[r] = bf2f((short)KA[idx]) * __expf(tot - CUM[idx]); }
        kdf[st][0] = pack8(kd, 0); kdf[st][1] = pack8(kd, 1); }
    const bf16x8 id0 = ident_frag(0, l31, hf), id1 = ident_frag(1, l31, hf);
#pragma unroll
    for (int vt = 0; vt < 4; ++vt) { f32x16 dacc = zero16();
#pragma unroll
        for (int st = 0; st < 2; ++st) { const bf16_t* vp = VA + hb + (size_t)(c * 64 + 32 * st) * 128 + (4 * vt + hf) * 256 + l31 * 8;
            f32x16 vx = zero16(); vx = MFMA32(*(const bf16x8*)vp, id0, vx); vx = MFMA32(*(const bf16x8*)(vp + 512), id1, vx);
            dacc = MFMA32(kdf[st][0], pack8(vx, 0), dacc); dacc = MFMA32(kdf[st][1], pack8(vx, 1), dacc); }
        bf16_t* up = U + ((size_t)(c * 4 + h) * 128 + 32 * vt + l31) * 128 + 32 * kt + 8 * hf;
#pragma unroll
        for (int g = 0; g < 4; g += 2) { u32x2 o0, o1; o0.x = pk2(dacc[4 * g], dacc[4 * g + 1]); o0.y = pk2(dacc[4 * g + 2], dacc[4 * g + 3]); o1.x = pk2(dacc[4 * g + 4], dacc[4 * g + 5]); o1.y = pk2(dacc[4 * g + 6], dacc[4 * g + 7]);
            *(u32x4*)(up + 8 * g) = widen_pair(o0, o1); }
    }
}

DI void scan_prompt_item(const Params& p, int item, int lane) {
    const int bh = item >> 6, vp = item & 63, b = bh >> 2, h = bh & 3, kg = lane & 31, v0 = 2 * vp + (lane >> 5);
    const float* __restrict__ DEC = (const float*)(p.ws + WS_DEC) + (size_t)b * 256 * 512 + h * 128 + 4 * kg;
    const bf16_t* __restrict__ U = (const bf16_t*)(p.ws + WS_U) + ((size_t)(b * 256 * 4 + h) * 128 + v0) * 128 + 4 * kg;
    bf16_t* __restrict__ SST = (bf16_t*)(p.ws + WS_SST) + ((size_t)(b * 256 * 4 + h) * 128 + v0) * 128 + 4 * kg;
    f32x4 S0 = {0.f, 0.f, 0.f, 0.f};
    for (int n0 = 0; n0 < 256; n0 += 32) {
        f32x4 d[32]; u32x2 u[32];
#pragma unroll
        for (int i = 0; i < 32; ++i) { d[i] = *(const f32x4*)(DEC + (size_t)(n0 + i) * 512); u[i] = *(const u32x2*)(U + (size_t)(n0 + i) * 4 * 128 * 128); }
#pragma unroll
        for (int i = 0; i < 32; ++i) { u32x2 s; s.x = pk2(S0[0], S0[1]); s.y = pk2(S0[2], S0[3]); *(u32x2*)(SST + (size_t)(n0 + i) * 4 * 128 * 128) = s;
            S0[0] = d[i][0] * S0[0] + bflo(u[i].x); S0[1] = d[i][1] * S0[1] + bfhi(u[i].x); S0[2] = d[i][2] * S0[2] + bflo(u[i].y); S0[3] = d[i][3] * S0[3] + bfhi(u[i].y); }
    }
    float* sp = p.out + OFF_SP + ((size_t)bh * 128 + 4 * kg) * 128;
#pragma unroll
    for (int i = 0; i < 4; ++i) sp[(size_t)i * 128 + v0] = S0[i];
}
DI void scan_sample_item(const Params& p, int item, int lane) {
    const int bh = item >> 5, sub = item & 31, bs = bh >> 2, h = bh & 3, k0 = 32 * (sub & 3) + 4 * (lane >> 3), vb = 16 * (sub >> 2) + (lane & 7), c = 512 + bs;
    const float* DEC = (const float*)(p.ws + WS_DEC); const bf16_t* U = (const bf16_t*)(p.ws + WS_U); bf16_t* SST = (bf16_t*)(p.ws + WS_SST);
    const f32x4 d = *(const f32x4*)(DEC + (size_t)c * 512 + h * 128 + k0);
    const float* s0 = p.state + ((size_t)bh * 128 + k0) * 128; float* so = p.out + OFF_SS + ((size_t)bh * 128 + k0) * 128;
#pragma unroll
    for (int e = 0; e < 2; ++e) { const int v = vb + 8 * e; const size_t o = ((size_t)(c * 4 + h) * 128 + v) * 128 + k0;
        const u32x2 u = *(const u32x2*)(U + o); f32x4 S;
#pragma unroll
        for (int i = 0; i < 4; ++i) S[i] = s0[(size_t)i * 128 + v];
        u32x2 s; s.x = pk2(S[0], S[1]); s.y = pk2(S[2], S[3]); *(u32x2*)(SST + o) = s;
        so[v] = d[0] * S[0] + bflo(u.x); so[128 + v] = d[1] * S[1] + bfhi(u.x); so[256 + v] = d[2] * S[2] + bflo(u.y); so[384 + v] = d[3] * S[3] + bfhi(u.y); }
}

DI void attn_item(const Params& p, int item, int lane, const LAS float* biasl) {
    const int c = item >> 3, h = item & 7, l31 = lane & 31, hf = lane >> 5;
    const bf16_t* KB = (const bf16_t*)(p.ws + WS_KB); const bf16_t* VB = (const bf16_t*)(p.ws + WS_VB);
    bf16x8 qf[2][4];
    { const bf16_t* qptr = (const bf16_t*)(p.ws + WS_QOB) + (size_t)(c * 64 + l31) * 1024 + 512 + h * 64;
#pragma unroll
    for (int qq = 0; qq < 2; ++qq)
#pragma unroll
        for (int ks = 0; ks < 4; ++ks) qf[qq][ks] = *(const bf16x8*)(qptr + (size_t)qq * 32 * 1024 + 16 * ks + 8 * hf); }
    const LAS float* bl = biasl + h * 192;
    f32x16 OT[2][2]; float mrun[2], lsum[2];
#pragma unroll
    for (int qq = 0; qq < 2; ++qq) { OT[qq][0] = zero16(); OT[qq][1] = zero16(); mrun[qq] = -1e30f; lsum[qq] = 0.f; }
    int ntile, ncache, db0, krow_first;
    if (c < 512) { const int n = c & 255, j0 = n < 8 ? n : 8; ntile = 2 * (j0 + 1); ncache = 0; db0 = 64 * j0; krow_first = (c - j0) * 64; }
    else { ntile = 18; ncache = 16; db0 = 512; krow_first = c * 64 - 512; }
    const int bs = c - 512;
    u32x4 nk[4], nv[4];
#define ATT_LOAD(i_) do { if ((i_) >= ncache) { const size_t ro_ = (((size_t)h * (T / 32) + (size_t)((krow_first >> 5) + (i_))) * 8 + hf) * 256 + l31 * 8;     \
            _Pragma("unroll") for (int ks = 0; ks < 4; ++ks) { nk[ks] = *(const u32x4*)(KB + ro_ + 512 * ks); nv[ks] = *(const u32x4*)(VB + ro_ + 512 * ks); } } } while (0)
    ATT_LOAD(0);
    for (int i = 0; i < ntile; ++i) {
        bf16x8 kf[4], vf[2][2];
        if (i < ncache) {
            const float* kp_ = p.cache_k + ((size_t)(bs * 512 + 32 * i + l31) * 8 + h) * 64 + 8 * hf; const float* vp_ = p.cache_v + ((size_t)(bs * 512 + 32 * i + l31) * 8 + h) * 64 + 8 * hf;
#pragma unroll
            for (int ks = 0; ks < 4; ++ks) { u32x4 w; const f32x4 a = *(const f32x4*)(kp_ + 16 * ks), b = *(const f32x4*)(kp_ + 16 * ks + 4), e = *(const f32x4*)(vp_ + 16 * ks), f = *(const f32x4*)(vp_ + 16 * ks + 4);
                w.x = pk2(a[0], a[1]); w.y = pk2(a[2], a[3]); w.z = pk2(b[0], b[1]); w.w = pk2(b[2], b[3]); kf[ks] = __builtin_bit_cast(bf16x8, w);
                w.x = pk2(e[0], e[1]); w.y = pk2(e[2], e[3]); w.z = pk2(f[0], f[1]); w.w = pk2(f[2], f[3]); vf[ks >> 1][ks & 1] = __builtin_bit_cast(bf16x8, w); }
        } else {
#pragma unroll
            for (int ks = 0; ks < 4; ++ks) { kf[ks] = __builtin_bit_cast(bf16x8, nk[ks]); vf[ks >> 1][ks & 1] = __builtin_bit_cast(bf16x8, nv[ks]); }
        }
        if (i + 1 < ntile) ATT_LOAD(i + 1);
        asm volatile("" ::: "memory");
        bf16x8 vxf[2][2];
        const int l31b = launder(l31); const bf16x8 id0 = ident_frag(0, l31b, hf), id1 = ident_frag(1, l31b, hf);
#pragma unroll
        for (int dt = 0; dt < 2; ++dt) { f32x16 vx = zero16(); vx = MFMA32(vf[dt][0], id0, vx); vx = MFMA32(vf[dt][1], id1, vx); vxf[dt][0] = pack8(vx, 0); vxf[dt][1] = pack8(vx, 1); }
#pragma unroll
        for (int qq = 0; qq < 2; ++qq) {
            f32x16 st = zero16();
#pragma unroll
            for (int ks = 0; ks < 4; ++ks) st = MFMA32(kf[ks], qf[qq][ks], st);
            const int dq = db0 + 32 * qq - 32 * i; float mt = -1e30f;
            if (dq - 31 >= 128) { const float bc = bl[191];
#pragma unroll
                for (int r = 0; r < 16; ++r) { const float s = st[r] * (0.125f * LOG2E) + bc; st[r] = s; mt = fmaxf(mt, s); }
            } else { const int dbase = dq + l31;
#pragma unroll
                for (int r = 0; r < 16; ++r) { int dist = dbase - crow(r, hf); dist = dist > 128 ? 128 : dist; const float s = st[r] * (0.125f * LOG2E) + bl[dist + 63]; st[r] = s; mt = fmaxf(mt, s); }
            }
            mt = fmaxf(mt, __shfl_xor(mt, 32));
            const float mnew = fmaxf(mrun[qq], mt), alpha = __builtin_amdgcn_exp2f(mrun[qq] - mnew); mrun[qq] = mnew;
            float ps = 0.f;
#pragma unroll
            for (int r = 0; r < 16; ++r) { st[r] = __builtin_amdgcn_exp2f(st[r] - mnew); ps += st[r]; }
            lsum[qq] = lsum[qq] * alpha + ps;
#pragma unroll
            for (int r = 0; r < 16; ++r) { OT[qq][0][r] *= alpha; OT[qq][1][r] *= alpha; }
            const bf16x8 pf0 = pack8(st, 0), pf1 = pack8(st, 1);
            OT[qq][0] = MFMA32(vxf[0][0], pf0, OT[qq][0]); OT[qq][0] = MFMA32(vxf[0][1], pf1, OT[qq][0]);
            OT[qq][1] = MFMA32(vxf[1][0], pf0, OT[qq][1]); OT[qq][1] = MFMA32(vxf[1][1], pf1, OT[qq][1]);
        }
    }
#undef ATT_LOAD
    bf16_t* qptr = (bf16_t*)(p.ws + WS_QOB) + (size_t)(c * 64 + launder(l31)) * 1024 + 512 + h * 64;
#pragma unroll
    for (int qq = 0; qq < 2; ++qq) { const float l = lsum[qq] + __shfl_xor(lsum[qq], 32), inv = 1.f / l; bf16_t* op = qptr + (size_t)qq * 32 * 1024;
#pragma unroll
        for (int dt = 0; dt < 2; ++dt)
#pragma unroll
            for (int g = 0; g < 4; g += 2) { u32x2 o0, o1; o0.x = pk2(OT[qq][dt][4 * g] * inv, OT[qq][dt][4 * g + 1] * inv); o0.y = pk2(OT[qq][dt][4 * g + 2] * inv, OT[qq][dt][4 * g + 3] * inv);
                o1.x = pk2(OT[qq][dt][4 * g + 4] * inv, OT[qq][dt][4 * g + 5] * inv); o1.y = pk2(OT[qq][dt][4 * g + 6] * inv, OT[qq][dt][4 * g + 7] * inv);
                *(u32x4*)(op + 32 * dt + 8 * (g + hf)) = widen_pair(o0, o1); } }
}

DI void hgrn_out_item(const Params& p, int item, int lane, bf16_t* obase = nullptr) {
    const int c = item >> 3, h = (item >> 1) & 3, tt = item & 1, l31 = lane & 31, hf = lane >> 5;
    const float* CUM = (const float*)(p.ws + WS_CUM); const bf16_t* KA = (const bf16_t*)(p.ws + WS_KA); const bf16_t* VA = (const bf16_t*)(p.ws + WS_VA);
    const bf16_t* GA = (const bf16_t*)(p.ws + WS_GA); const bf16_t* SST = (const bf16_t*)(p.ws + WS_SST);
    const int trow = c * 64 + 32 * tt + l31;
    bf16_t* qap = (bf16_t*)(p.ws + WS_QOB) + (size_t)trow * 1024 + h * 128;
    const size_t hb = (size_t)h * T * 128;
    const float* cumt = CUM + hb + (size_t)trow * 128; const float* refp = CUM + hb + (size_t)(c * 64 + 32) * 128;
    bf16x8 qd1[8], qd2[8], kdt[8];
    const bf16_t* kat = KA + hb + (size_t)trow * 128;
#pragma unroll
    for (int ks = 0; ks < 8; ++ks) { const int k0 = 16 * ks + 8 * hf; const bf16x8 q8 = *(const bf16x8*)(qap + k0), k8 = *(const bf16x8*)(kat + k0);
        const f32x4 c0 = *(const f32x4*)(cumt + k0), c1 = *(const f32x4*)(cumt + k0 + 4), r0 = *(const f32x4*)(refp + k0), r1 = *(const f32x4*)(refp + k0 + 4);
        float a[8], b[8], d[8];
#pragma unroll
        for (int j = 0; j < 8; ++j) { const float q = bf2f(q8[j]), cu = j < 4 ? c0[j & 3] : c1[j & 3], rf = j < 4 ? r0[j & 3] : r1[j & 3]; a[j] = q * __expf(cu - rf); b[j] = q * __expf(cu); d[j] = bf2f(k8[j]) * __expf(rf - cu); }
        qd1[ks] = pack8f(a); qd2[ks] = pack8f(b); kdt[ks] = pack8f(d); }
    f32x16 OT[4];
#pragma unroll
    for (int vt = 0; vt < 4; ++vt) OT[vt] = zero16();
    const bf16_t* sp = SST + ((size_t)(c * 4 + h) * 128 + l31) * 128 + 8 * hf;
#pragma unroll
    for (int vt = 0; vt < 4; ++vt) {
#pragma unroll
        for (int ks = 0; ks < 8; ++ks) OT[vt] = MFMA32(*(const bf16x8*)(sp + (size_t)vt * 32 * 128 + 16 * ks), qd2[ks], OT[vt]);
        __builtin_amdgcn_sched_barrier(0); }
    const bf16x8 id0 = ident_frag(0, l31, hf), id1 = ident_frag(1, l31, hf);
    for (int st = 0; st <= tt; ++st) {
        const int srow = c * 64 + 32 * st + l31; const bf16_t* kap = KA + hb + (size_t)srow * 128; const float* cums = CUM + hb + (size_t)srow * 128;
        f32x16 X = zero16();
        if (st == tt) {
#pragma unroll
            for (int ks = 0; ks < 8; ++ks) X = MFMA32(kdt[ks], qd1[ks], X);
        } else
#pragma unroll
        for (int ks = 0; ks < 8; ++ks) { const int k0 = 16 * ks + 8 * hf; const bf16x8 k8 = *(const bf16x8*)(kap + k0);
            const f32x4 c0 = *(const f32x4*)(cums + k0), c1 = *(const f32x4*)(cums + k0 + 4), r0 = *(const f32x4*)(refp + k0), r1 = *(const f32x4*)(refp + k0 + 4);
            float a[8];
#pragma unroll
            for (int j = 0; j < 8; ++j) { const float cu = j < 4 ? c0[j & 3] : c1[j & 3], rf = j < 4 ? r0[j & 3] : r1[j & 3]; a[j] = bf2f(k8[j]) * __expf(rf - cu); }
            X = MFMA32(pack8f(a), qd1[ks], X); }
        if (st == tt) {
#pragma unroll
            for (int r = 0; r < 16; ++r) if (crow(r, hf) > l31) X[r] = 0.f; }
        const bf16x8 xf0 = pack8(X, 0), xf1 = pack8(X, 1);
        const bf16_t* vp = VA + hb + (size_t)(c * 64 + 32 * st) * 128 + hf * 256 + l31 * 8;
#pragma unroll
        for (int vt = 0; vt < 4; ++vt) { f32x16 vx = zero16(); vx = MFMA32(*(const bf16x8*)(vp + 1024 * vt), id0, vx); vx = MFMA32(*(const bf16x8*)(vp + 1024 * vt + 512), id1, vx);
            OT[vt] = MFMA32(pack8(vx, 0), xf0, OT[vt]); OT[vt] = MFMA32(pack8(vx, 1), xf1, OT[vt]); }
    }
    float ss = 0.f;
#pragma unroll
    for (int vt = 0; vt < 4; ++vt)
#pragma unroll
        for (int r = 0; r < 16; ++r) ss += OT[vt][r] * OT[vt][r];
    ss += __shfl_xor(ss, 32);
    const float rstd = __builtin_amdgcn_rsqf(ss * (1.f / 128.f) + EPS);
    const bf16_t* gap = GA + hb + (size_t)trow * 128; const float* onp = p.out_norm + h * 128;
    if (obase) qap = obase + (size_t)trow * 512 + h * 128;
#pragma unroll
    for (int vt = 0; vt < 4; ++vt)
#pragma unroll
        for (int g = 0; g < 4; g += 2) { u32x2 ga0, ga1; narrow_pair(*(const u32x4*)(gap + 32 * vt + 8 * (g + hf)), ga0, ga1);
            u32x2 o0, o1;
            { const int v0 = 32 * vt + 8 * g + 4 * hf; const f32x4 on = *(const f32x4*)(onp + v0);
              o0.x = pk2(OT[vt][4 * g] * rstd * on[0] * bflo(ga0.x), OT[vt][4 * g + 1] * rstd * on[1] * bfhi(ga0.x)); o0.y = pk2(OT[vt][4 * g + 2] * rstd * on[2] * bflo(ga0.y), OT[vt][4 * g + 3] * rstd * on[3] * bfhi(ga0.y)); }
            { const int v0 = 32 * vt + 8 * (g + 1) + 4 * hf; const f32x4 on = *(const f32x4*)(onp + v0);
              o1.x = pk2(OT[vt][4 * g + 4] * rstd * on[0] * bflo(ga1.x), OT[vt][4 * g + 5] * rstd * on[1] * bfhi(ga1.x)); o1.y = pk2(OT[vt][4 * g + 6] * rstd * on[2] * bflo(ga1.y), OT[vt][4 * g + 7] * rstd * on[3] * bfhi(ga1.y)); }
            *(u32x4*)(qap + 32 * vt + 8 * (g + hf)) = widen_pair(o0, o1); }
}


#define XB_TMO      128
#define XB_XCNT(j)  (256  + 64 * (j))
#define XB_XSUB(j)  (1280 + 64 * (j))
#define XB_XGEN(j)  (2304 + 64 * (j))
#define XB_TOP      3328
#define XB_TOPGEN   3392
#define XCD_BAR_WORDS 3456
#define XB_SPIN_CAP (1u << 18)
DI unsigned xb_ld(unsigned* p)              { return __hip_atomic_load(p, __ATOMIC_RELAXED, __HIP_MEMORY_SCOPE_AGENT); }
DI unsigned xb_add(unsigned* p, unsigned v) { return __hip_atomic_fetch_add(p, v, __ATOMIC_RELAXED, __HIP_MEMORY_SCOPE_AGENT); }
DI unsigned xb_xcc_id() { return (unsigned)__builtin_amdgcn_s_getreg((3 << 11) | 20) & 0xFu; }
#define XB_SPIN(cond, bar) do { unsigned _sp = 0; while (cond) { __builtin_amdgcn_s_sleep(1); \
    if ((++_sp & 255u) == 0u) { if (xb_ld(&(bar)[XB_TMO])) break; if (_sp > XB_SPIN_CAP) { atomicAdd(&(bar)[XB_TMO], 1u); break; } } } } while (0)
struct XcdBarrier { unsigned* bar; unsigned x; volatile LAS unsigned* st; };
DI XcdBarrier xcd_barrier_post(unsigned* bar, volatile LAS unsigned* st) {
    XcdBarrier b; b.bar = bar; b.x = xb_xcc_id(); b.st = st;
    if (threadIdx.x == 0) (void)xb_add(&bar[XB_XCNT(b.x)], 1u);
    return b;
}
DI void xcd_barrier_complete(unsigned* bar, unsigned x, unsigned& nloc, unsigned& nx) {
    const unsigned G = gridDim.x * gridDim.y * gridDim.z;
    unsigned sum, cnt, mine, sp = 0u;
    for (;;) {
        sum = 0u; cnt = 0u; mine = 0u;
#pragma unroll
        for (unsigned j = 0; j < 16; ++j) { const unsigned c = xb_ld(&bar[XB_XCNT(j)]); sum += c; cnt += (c > 0u) ? 1u : 0u; mine = (j == x) ? c : mine; }
        if (sum == G) break;
        __builtin_amdgcn_s_sleep(1);
        if ((++sp & 255u) == 0u) { if (xb_ld(&bar[XB_TMO])) break; if (sp > XB_SPIN_CAP) { atomicAdd(&bar[XB_TMO], 1u); break; } }
    }
    nloc = mine > 0u ? mine : 1u; nx = cnt > 0u ? cnt : 1u;
}
DI void xcd_barrier(const XcdBarrier& b) {
    asm volatile("s_waitcnt vmcnt(0)" ::: "memory");
    __syncthreads();
    if (threadIdx.x == 0) {
        unsigned* bar = b.bar;
        __builtin_amdgcn_s_waitcnt(0);
        unsigned nloc = b.st[0], nx = b.st[1];
        if (nloc == 0u) { xcd_barrier_complete(bar, b.x, nloc, nx); b.st[0] = nloc; b.st[1] = nx; }
        const unsigned old = xb_add(&bar[XB_XSUB(b.x)], 1u);
        const unsigned gen = old / nloc;
        if (old + 1u == (gen + 1u) * nloc) {
            __builtin_amdgcn_fence(__ATOMIC_RELEASE, "agent");
            asm volatile("s_waitcnt vmcnt(0)" ::: "memory");
            const unsigned og = xb_add(&bar[XB_TOP], 1u);
            const unsigned tg = og / nx;
            if (og + 1u == (tg + 1u) * nx) xb_add(&bar[XB_TOPGEN], 1u);
            else XB_SPIN(xb_ld(&bar[XB_TOPGEN]) == tg, bar);
            __builtin_amdgcn_fence(__ATOMIC_ACQUIRE, "agent");
            xb_add(&bar[XB_XGEN(b.x)], 1u);
            asm volatile("s_waitcnt vmcnt(0)" ::: "memory");
        } else {
            XB_SPIN(xb_ld(&bar[XB_XGEN(b.x)]) == gen, bar);
            __builtin_amdgcn_fence(__ATOMIC_ACQUIRE, "agent");
            asm volatile("s_waitcnt vmcnt(0)" ::: "memory");
        }
    }
    __syncthreads();
}

__global__ void __launch_bounds__(512, 2) fwd_megakernel(Params p) {
    extern __shared__ __attribute__((aligned(16))) unsigned char lds_raw[];
    LAS unsigned char* lds = (LAS unsigned char*)lds_raw;
    cg::grid_group grid = cg::this_grid();
    const int G = gridDim.x, bx = blockIdx.x;
    volatile LAS unsigned* bst = (volatile LAS unsigned*)(lds + LDS_ST_OFF);
    if (threadIdx.x < 2) bst[threadIdx.x] = 0u;
    __syncthreads();
    const XcdBarrier xbar = xcd_barrier_post((unsigned*)(p.ws + WS_BAR), bst);
    if (threadIdx.x == 0) bst[2] = xb_add((unsigned*)(p.ws + WS_BAR) + 3712 + xbar.x, 1u);
#define GRID_BAR() xcd_barrier(xbar)
    unsigned char* ws = p.ws;
    float* MOD = (float*)(ws + WS_MOD); bf16_t* H = (bf16_t*)(ws + WS_H);

    phase_prep(p, lds);
    grid.sync();
    { pg8::Gemm g{(const bf16_t*)(ws + WS_SC), (const bf16_t*)(ws + WS_WADA), 256, 6144, 1024}; pg8::StaticOrder S; S.init(256, 6144, G, bx);
      EpiMod E{MOD, p.b_ada}; pg8::gemm_phase<EpiMod, pg8::StaticOrder, true, true>(lds, g, S, E); }
    GRID_BAR();
    int cv = bx;
    { unsigned* barw = (unsigned*)(p.ws + WS_BAR); bool uni = (G & 7) == 0;
#pragma unroll
      for (int j = 0; j < 16; ++j) { const unsigned c = xb_ld(&barw[XB_XCNT(j)]); uni = uni && (j < 8 ? c == (unsigned)(G >> 3) : c == 0u); }
      if (uni) cv = (int)xbar.x + 8 * (int)bst[2];
      cv = __builtin_amdgcn_readfirstlane(cv); }
    phase_norm_mod(p.x_prompt, p.x_sample, p.norm_mix, MOD, 0, 1024, H);
#if PROBE_DUP == 1
    GRID_BAR(); phase_norm_mod(p.x_prompt, p.x_sample, p.norm_mix, MOD, 0, 1024, H);
#endif
#if PROBE_DUP == 10
    GRID_BAR(); GRID_BAR(); GRID_BAR(); GRID_BAR(); GRID_BAR(); GRID_BAR(); GRID_BAR(); GRID_BAR(); GRID_BAR(); GRID_BAR();
#endif
    GRID_BAR();
    { pg8::Gemm g{H, (const bf16_t*)(ws + WS_WIN), T, INC, 1024}; pg8::StaticOrder S; S.init(T, INC, G, cv);
      EpiIn E{(bf16_t*)(ws + WS_QOB), (bf16_t*)(ws + WS_KA), (bf16_t*)(ws + WS_VA), (bf16_t*)(ws + WS_GA), (bf16_t*)(ws + WS_KB), (bf16_t*)(ws + WS_VB),
              (bf16_t*)(p.out), (bf16_t*)(p.out) + (size_t)T * 1024, (float*)(ws + WS_CUM), (float*)(ws + WS_DEC), p.lb_logits, p.out};
      pg8::gemm_phase<EpiIn, pg8::StaticOrder, true, true>(lds, g, S, E);
#if PROBE_DUP == 2
      GRID_BAR(); pg8::gemm_phase<EpiIn, pg8::StaticOrder, true, true>(lds, g, S, E);
#endif
    }
    GRID_BAR();
    { const int tid = fresh_tid(), lane = tid & 63, wave = __builtin_amdgcn_readfirstlane(tid >> 6);
      for (int it = wave * G + bx; it < NCH * 16; it += 8 * G) hgrn_u_item(p, it, lane);
#if PROBE_DUP == 3
      for (int it = wave * G + bx; it < NCH * 16; it += 8 * G) hgrn_u_item(p, it, lane);
#endif
    }
    GRID_BAR();
    {
        const int tid = fresh_tid(), lane = tid & 63, wave = __builtin_amdgcn_readfirstlane(tid >> 6);
        LAS float* biasl = (LAS float*)lds;
        for (int i = tid; i < 8 * 192; i += 512) biasl[i] = p.rel_bias[i] * LOG2E;
        __syncthreads();
#if PROBE_DUP == 41
        if (wave == 0) { for (int it = bx; it < 512; it += G) scan_prompt_item(p, it, lane); }
        GRID_BAR();
#endif
        if (wave == 0) { for (int it = bx; it < 512; it += G) scan_prompt_item(p, it, lane); }
        else {
            const int gw = (wave - 1) * G + bx, NGW = 7 * G;
            for (int it = gw; it < 4096; it += NGW) scan_sample_item(p, it, lane);
            const int x = __builtin_amdgcn_readfirstlane((int)xbar.x), ncu = __builtin_amdgcn_readfirstlane((int)bst[0]), nxcc = __builtin_amdgcn_readfirstlane((int)bst[1]), j = __builtin_amdgcn_readfirstlane((int)bst[2]);
            if (nxcc == 8 && x < 8 && ncu > 0 && j < ncu) {
                const int nslot = 7 * ncu, slot = (wave - 1) * ncu + j;
                for (int idx = slot; idx < 68 * 8; idx += nslot) { const int cc = idx >> 3, c = cc < 4 ? 512 + 4 * x + cc : 64 * x + (cc - 4); attn_item(p, c * 8 + (idx & 7), lane, biasl); }
            } else for (int it = gw; it < NCH * 8; it += NGW) attn_item(p, it, lane, biasl);
        }
    }
    GRID_BAR();
    { const int tid = fresh_tid(), lane = tid & 63, wave = __builtin_amdgcn_readfirstlane(tid >> 6);
#if PROBE_DUP == 5
      for (int it = wave * G + bx; it < NCH * 8; it += 8 * G) hgrn_out_item(p, it, lane, (bf16_t*)(ws + WS_U));
      GRID_BAR();
#endif
      for (int it = wave * G + bx; it < NCH * 8; it += 8 * G) hgrn_out_item(p, it, lane); }
    GRID_BAR();
    { pg8::Gemm g{(const bf16_t*)(ws + WS_QOB), (const bf16_t*)(ws + WS_WAB), T, 1024, 1024}; pg8::StaticOrder S; S.init(T, 1024, G, cv);
      EpiMerge E{(const bf16_t*)(p.out), (const bf16_t*)(p.out) + (size_t)T * 1024, (bf16_t*)(ws + WS_M)};
      pg8::gemm_phase<EpiMerge, pg8::StaticOrder, true, true>(lds, g, S, E); }
    GRID_BAR();
    const bool split_ps = G >= 64;
    { pg8::Gemm g{(const bf16_t*)(ws + WS_M), (const bf16_t*)(ws + WS_WO), T, 1024, 1024}; EpiRes<false> E{p.x_prompt, p.x_sample, nullptr, (bf16_t*)(ws + WS_X1B), MOD + 2048};
      if (split_ps) {
        { pg8::StaticOrder S; S.init(TP, 1024, G, cv); pg8::gemm_phase<EpiRes<false>, pg8::StaticOrder, true, true>(lds, g, S, E); }
        GRID_BAR();
        if (bx < 32) { pg8::StaticOrder S; S.init(TS, 1024, 32, bx, TP / 256); pg8::gemm_phase<EpiRes<false>, pg8::StaticOrder, true, true>(lds, g, S, E); }
        else phase_norm_mod_b((const bf16_t*)(ws + WS_X1B), p.norm_ffn, MOD, 3072, 4096, H, 0, TP, 32);
        GRID_BAR();
        phase_norm_mod_b((const bf16_t*)(ws + WS_X1B), p.norm_ffn, MOD, 3072, 4096, H, TP, T, 0);
      } else {
        pg8::StaticOrder S; S.init(T, 1024, G, cv); pg8::gemm_phase<EpiRes<false>, pg8::StaticOrder, true, true>(lds, g, S, E);
        GRID_BAR();
        phase_norm_mod_b((const bf16_t*)(ws + WS_X1B), p.norm_ffn, MOD, 3072, 4096, H);
      } }
    GRID_BAR();
    { pg8::Gemm g{H, (const bf16_t*)(ws + WS_WFI), T, INC, 1024}; pg8::StaticOrder S; S.init(T, INC, G, cv);
      EpiFfnIn E{(bf16_t*)(ws + WS_HID)}; pg8::gemm_phase<EpiFfnIn, pg8::StaticOrder, true, true>(lds, g, S, E);
#if PROBE_DUP == 9
      GRID_BAR(); pg8::gemm_phase<EpiFfnIn, pg8::StaticOrder, true, true>(lds, g, S, E);
#endif
    }
    GRID_BAR();
    { pg8::Gemm g{(const bf16_t*)(ws + WS_HID), (const bf16_t*)(ws + WS_WFO), T, 1024, FF}; EpiRes<true> E{nullptr, nullptr, (const bf16_t*)(ws + WS_X1B), (bf16_t*)(ws + WS_X2B), MOD + 5120};
      if (split_ps) {
        { pg8::StaticOrder S; S.init(TP, 1024, G, cv); pg8::gemm_phase<EpiRes<true>, pg8::StaticOrder, true, true>(lds, g, S, E); }
        GRID_BAR();
        float* PART = (float*)(ws + WS_CUM + 20 * MiB);
        if (bx < 64) { const int ks = bx >> 5; pg8::Gemm gs{(const bf16_t*)(ws + WS_HID) + ks * (FF / 2), (const bf16_t*)(ws + WS_WFO) + ks * (FF / 2), T, 1024, FF / 2, FF};
            pg8::StaticOrder S; S.init(TS, 1024, 32, bx & 31, TP / 256); EpiPart EP{PART + (size_t)ks * TS * D, TP}; pg8::gemm_phase<EpiPart, pg8::StaticOrder, true, true>(lds, gs, S, EP); }
        else phase_final_norm((const bf16_t*)(ws + WS_X2B), p.out, p.norm_final, 0, TP, 64);
        GRID_BAR();
        phase_final_norm_parts((const bf16_t*)(ws + WS_X1B), PART, PART + (size_t)TS * D, MOD + 5120, p.out, p.norm_final);
      } else {
        pg8::StaticOrder S; S.init(T, 1024, G, cv); pg8::gemm_phase<EpiRes<true>, pg8::StaticOrder, true, true>(lds, g, S, E);
        GRID_BAR();
        phase_final_norm((const bf16_t*)(ws + WS_X2B), p.out, p.norm_final);
      } }
}

extern "C" void kernel_launch(void* const* d_in, const int* in_sizes, int n_in, void* d_out, int out_size, void* d_ws, size_t ws_size, hipStream_t stream) {
    static int grid = 0;
    if (grid == 0) {
        if (n_in != 21 || (size_t)out_size != OUT_TOTAL || ws_size < WS_END) { fprintf(stderr, "kernel_launch: unexpected sizes n_in %d out %d ws %zu\n", n_in, out_size, ws_size); grid = -1; return; }
        int dev = 0, cus = 0, per = 0;
        (void)hipGetDevice(&dev); (void)hipDeviceGetAttribute(&cus, hipDeviceAttributeMultiprocessorCount, dev);
        (void)hipFuncSetAttribute((const void*)fwd_megakernel, hipFuncAttributeMaxDynamicSharedMemorySize, LDS_BYTES);
        (void)hipOccupancyMaxActiveBlocksPerMultiprocessor(&per, (const void*)fwd_megakernel, 512, LDS_BYTES);
        if (per < 1) per = 1;
        grid = cus * per; fprintf(stderr, "kernel_launch: grid %d (cus %d x %d)\n", grid, cus, per);
    }
    if (grid < 0) return;
    if (hipMemsetAsync((char*)d_ws + WS_BAR, 0, BAR_BYTES, stream) != hipSuccess) { fprintf(stderr, "kernel_launch: memset failed\n"); return; }
    Params p{};
    const float** f = (const float**)&p;
    for (int i = 0; i < 21; ++i) f[i] = (const float*)d_in[i];
    p.out = (float*)d_out; p.ws = (unsigned char*)d_ws;
    void* args[] = {&p};
    hipError_t e = hipLaunchCooperativeKernel((const void*)fwd_megakernel, dim3(grid), dim3(512), args, LDS_BYTES, stream);
    if (e != hipSuccess) fprintf(stderr, "cooperative launch failed: %s (grid %d)\n", hipGetErrorString(e), grid);
}
```

```cpp
#include <hip/hip_runtime.h>
#include <hip/hip_cooperative_groups.h>
#include <cstdio>
#include <cstdint>
namespace cg = cooperative_groups;
#ifndef PROBE_DUP
#define PROBE_DUP 0
#endif

#define DI __device__ __forceinline__
#define LAS __attribute__((address_space(3)))
typedef unsigned short bf16_t;
typedef short bf16x8 __attribute__((ext_vector_type(8)));
typedef float f32x4 __attribute__((ext_vector_type(4)));
typedef float f32x2 __attribute__((ext_vector_type(2)));
typedef float f32x16 __attribute__((ext_vector_type(16)));
typedef unsigned u32x4 __attribute__((ext_vector_type(4)));
typedef unsigned u32x2 __attribute__((ext_vector_type(2)));
typedef __bf16 bf2_t __attribute__((ext_vector_type(2)));

constexpr int D = 1024, TP = 32768, TS = 2048, T = TP + TS, NCH = T / 64, NBATCH = 34;
constexpr int INC = 5632, FF = 2816;
constexpr float EPS = 1e-6f, LOG2E = 1.4426950408889634f;
constexpr size_t OFF_Y = 0, OFF_SP = (size_t)T * D, OFF_KP = OFF_SP + 131072, OFF_VP = OFF_KP + 524288, OFF_SS = OFF_VP + 524288,
                 OFF_KS = OFF_SS + 2097152, OFF_VS = OFF_KS + 1048576, OUT_TOTAL = OFF_VS + 1048576;
constexpr size_t MiB = 1u << 20;
constexpr size_t WS_MOD = 1 * MiB, WS_DEC = 2 * MiB, WS_SC = 4 * MiB, WS_WADA = 5 * MiB, WS_WIN = 17 * MiB, WS_WAB = 28 * MiB, WS_WO = 30 * MiB,
                 WS_WFI = 32 * MiB, WS_WFO = 43 * MiB, WS_H = 50 * MiB, WS_QOB = 118 * MiB, WS_KA = 186 * MiB, WS_VA = 220 * MiB, WS_GA = 254 * MiB,
                 WS_KB = 288 * MiB, WS_VB = 322 * MiB, WS_CUM = 356 * MiB, WS_SST = 424 * MiB, WS_END = 492 * MiB;
constexpr size_t WS_U = WS_H, WS_M = WS_KA, WS_HID = WS_KA, WS_X1B = WS_QOB, WS_X2B = WS_H;
constexpr size_t WS_BAR = 0, BAR_BYTES = 16384;
constexpr int LDS_BYTES = 140 * 1024, LDS_ST_OFF = 136 * 1024;

struct Params {
    const float *x_prompt, *x_sample, *c_prompt, *c_sample, *state, *cache_k, *cache_v, *w_ada, *b_ada, *norm_mix, *w_in, *lb_logits, *out_norm,
                *w_a, *rel_bias, *w_b, *w_out, *norm_ffn, *w_ffn_in, *w_ffn_out, *norm_final;
    float* out; unsigned char* ws;
};

DI int fresh_tid() { int t = threadIdx.x; asm volatile("" : "+v"(t)); return t; }
DI int launder(int v) { asm volatile("" : "+v"(v)); return v; }
DI unsigned pk2(float a, float b) { f32x2 v = {a, b}; bf2_t r = __builtin_convertvector(v, bf2_t); return __builtin_bit_cast(unsigned, r); }
DI float bflo(unsigned u) { return __uint_as_float(u << 16); }
DI float bfhi(unsigned u) { return __uint_as_float(u & 0xffff0000u); }
DI float bf2f(short s) { return __uint_as_float(((unsigned)(unsigned short)s) << 16); }
DI float sigm(float x) { return __builtin_amdgcn_rcpf(1.f + __expf(-x)); }
DI float silu(float x) { return x * sigm(x); }
DI int batch_of(int r) { return r < TP ? (r >> 14) : 2 + ((r - TP) >> 6); }
DI int crow(int reg, int h) { return (reg & 3) + 8 * (reg >> 2) + 4 * h; }
DI bf16x8 pack8(const f32x16& x, int s) {
    u32x4 p; p.x = pk2(x[8 * s], x[8 * s + 1]); p.y = pk2(x[8 * s + 2], x[8 * s + 3]); p.z = pk2(x[8 * s + 4], x[8 * s + 5]); p.w = pk2(x[8 * s + 6], x[8 * s + 7]);
    return __builtin_bit_cast(bf16x8, p);
}
DI bf16x8 pack8f(const float* v) { u32x4 p; p.x = pk2(v[0], v[1]); p.y = pk2(v[2], v[3]); p.z = pk2(v[4], v[5]); p.w = pk2(v[6], v[7]); return __builtin_bit_cast(bf16x8, p); }
DI bf16x8 ident_frag(int ks, int l31, int hf) {
    const int jj = l31 - 16 * ks - 8 * hf; bf16x8 r;
#pragma unroll
    for (int j = 0; j < 8; ++j) r[j] = (j == jj) ? (short)0x3F80 : (short)0;
    return r;
}
DI u32x4 widen_pair(u32x2 pg, u32x2 pg1) { const auto rx = __builtin_amdgcn_permlane32_swap(pg.x, pg1.x, false, false), ry = __builtin_amdgcn_permlane32_swap(pg.y, pg1.y, false, false); return (u32x4){rx[0], ry[0], rx[1], ry[1]}; }
DI void narrow_pair(u32x4 d, u32x2& pg, u32x2& pg1) { const auto rx = __builtin_amdgcn_permlane32_swap(d.x, d.z, false, false), ry = __builtin_amdgcn_permlane32_swap(d.y, d.w, false, false); pg = (u32x2){rx[0], ry[0]}; pg1 = (u32x2){rx[1], ry[1]}; }
#define MFMA32(a, b, c) __builtin_amdgcn_mfma_f32_32x32x16_bf16((a), (b), (c), 0, 0, 0)
DI f32x16 zero16() { f32x16 z;
#pragma unroll
    for (int i = 0; i < 16; ++i) z[i] = 0.f; return z; }

namespace pg8 {
constexpr int BM = 256, BK = 64, HALF = 128, HTB = HALF * BK * 2, STAGE_BYTES = 8 * HTB, NXCD = 8, WGM = 8;
__host__ __device__ __forceinline__ int lds_byte(int r, int c) { const int st = (r >> 4) * 2 + (c >> 5), rr = r & 15, cc = c & 31, ob = rr * 64 + cc * 2; return st * 1024 + (ob ^ (((ob >> 9) & 1) << 5)); }
__host__ __device__ __forceinline__ void stage_rc(int b, int& R, int& C) { const int st = b / 1024, sb = b % 1024, swz = sb ^ (((sb >> 9) & 1) << 5); R = (st >> 1) * 16 + swz / 64; C = (st & 1) * 32 + (swz % 64) / 2; }
__host__ __device__ __forceinline__ int perm32(int rho) { const int n = rho >> 4, i = rho & 15; return 8 * (i >> 2) + 4 * n + (i & 3); }
struct Unit { int pm, pn; };
struct Gemm { const bf16_t* A; const bf16_t* Bt; int M, N, K, ld; };
struct StaticOrder {
    int nM, nN, nwg, G, c, pm_off;
    __device__ void init(int M, int N, int G_, int c_, int pm_off_ = 0) { nM = M / BM; nN = N / BM; nwg = nM * nN; G = G_; c = c_; pm_off = pm_off_; }
    __device__ bool next(int i, Unit& u) const {
        const long L = (long)i * G + c; if (L >= nwg) return false;
        int wgid = (int)L; { const int q = nwg / NXCD, r = nwg % NXCD, xcd = wgid % NXCD, off = wgid / NXCD; wgid = (xcd < r ? xcd * (q + 1) : r * (q + 1) + (xcd - r) * q) + off; }
        const int nig = WGM * nN, gid = wgid / nig, fm = gid * WGM, gsz = (nM - fm) < WGM ? (nM - fm) : WGM;
        u.pm = pm_off + fm + ((wgid % nig) % gsz); u.pn = (wgid % nig) / gsz; return true;
    }
};
template <class Epi, class Sched, bool ALIGN_EPI = false, bool SP2 = false>
__device__ __forceinline__ void gemm_phase(LAS unsigned char* lds, const Gemm g, const Sched& S, const Epi& E) {
    const int tid = fresh_tid(), wid = __builtin_amdgcn_readfirstlane(tid >> 6), lane = tid & 63, wr = wid >> 2, wc = wid & 3, fr = lane & 15, fq = lane >> 4;
    const int K = g.ld ? g.ld : g.K, nt = g.K / BK;
    unsigned voffA[2], voffB[2];
#pragma unroll
    for (int i = 0; i < 2; ++i) { int R, C; stage_rc(tid * 16 + i * 8192, R, C); const int Rb = Epi::PERM ? ((R & ~31) + perm32(R & 31)) : R;
        voffA[i] = (unsigned)(R * K + C) * 2u; voffB[i] = (unsigned)(Rb * K + C) * 2u; }
    const size_t kstep = (size_t)(BK * 2);
    const size_t hstep = (size_t)HALF * K * 2;
    const size_t tstep = 2 * hstep;
    const unsigned ldsw = (unsigned)wid * 1024u;
    const int aoff = lds_byte(wr * 64 + fr, fq * 8), boff = lds_byte(wc * 32 + fr, fq * 8);
#define PG8_SA(b, h) (((b) * 2 + (h)) * HTB)
#define PG8_SB(b, h) ((4 + (b) * 2 + (h)) * HTB)
#define PG8_STAGE(bufoff, gbase, voff) do { _Pragma("unroll") for (int _i = 0; _i < 2; ++_i) \
        __builtin_amdgcn_global_load_lds((const unsigned*)((const char*)(gbase) + (voff)[_i]), (LAS unsigned*)(lds + (bufoff) + ldsw + _i * 8192), 16, 0, 0); } while (0)
#define PG8_LDA(dst, b, h) do { _Pragma("unroll") for (int m = 0; m < 4; ++m) _Pragma("unroll") for (int k = 0; k < 2; ++k) dst[m][k] = *(const LAS bf16x8*)(lds + PG8_SA(b, h) + aoff + m * 2048 + k * 1024); } while (0)
#define PG8_LDB(dst, b, h) do { _Pragma("unroll") for (int n = 0; n < 2; ++n) _Pragma("unroll") for (int k = 0; k < 2; ++k) dst[n][k] = *(const LAS bf16x8*)(lds + PG8_SB(b, h) + boff + n * 2048 + k * 1024); } while (0)
#define PG8_MMA(ai, bj, At, Bt) do { __builtin_amdgcn_s_setprio(1); _Pragma("unroll") for (int m = 0; m < 4; ++m) _Pragma("unroll") for (int n = 0; n < 2; ++n) _Pragma("unroll") for (int k = 0; k < 2; ++k) \
        acc[ai][bj][m][n] = __builtin_amdgcn_mfma_f32_16x16x32_bf16(Bt[n][k], At[m][k], acc[ai][bj][m][n], 0, 0, 0); __builtin_amdgcn_s_setprio(0); } while (0)
#define PG8_WAIT_V(n) asm volatile("s_waitcnt vmcnt(" #n ")" ::: "memory")
#define PG8_WAIT_L(n) asm volatile("s_waitcnt lgkmcnt(" #n ")" ::: "memory")
#define PG8_BAR __builtin_amdgcn_s_barrier()
#define PG8_SCHED __builtin_amdgcn_sched_barrier(0)
    Unit cur, nxt; int ui = 0;
    if (!S.next(0, cur)) return;
    f32x4 acc[2][2][4][2];
#pragma unroll
    for (int a = 0; a < 2; ++a)
#pragma unroll
        for (int b = 0; b < 2; ++b)
#pragma unroll
            for (int m = 0; m < 4; ++m)
#pragma unroll
                for (int n = 0; n < 2; ++n) acc[a][b][m][n] = (f32x4){0.f, 0.f, 0.f, 0.f};
    bf16x8 At[4][2], B0[2][2], B1[2][2];
    const char* cA = (const char*)g.A + (size_t)cur.pm * tstep; const char* cB = (const char*)g.Bt + (size_t)cur.pn * tstep;
    if constexpr (SP2) {
        PG8_STAGE(PG8_SB(0, 0), cB, voffB); PG8_STAGE(PG8_SB(0, 1), cB + hstep, voffB); PG8_STAGE(PG8_SA(0, 0), cA, voffA); PG8_STAGE(PG8_SA(0, 1), cA + hstep, voffA);
        if (wr == 1) PG8_BAR;
        PG8_WAIT_V(2); PG8_BAR;
        PG8_STAGE(PG8_SB(1, 0), cB + kstep, voffB); PG8_STAGE(PG8_SA(1, 0), cA + kstep, voffA); PG8_STAGE(PG8_SB(1, 1), cB + hstep + kstep, voffB);
        PG8_WAIT_V(6); PG8_BAR;
    } else {
        PG8_STAGE(PG8_SB(0, 0), cB, voffB); PG8_STAGE(PG8_SA(0, 0), cA, voffA); PG8_STAGE(PG8_SB(0, 1), cB + hstep, voffB); PG8_STAGE(PG8_SA(0, 1), cA + hstep, voffA);
        if (wr == 1) PG8_BAR;
        PG8_WAIT_V(4); PG8_BAR;
        PG8_STAGE(PG8_SB(1, 0), cB + kstep, voffB); PG8_STAGE(PG8_SA(1, 0), cA + kstep, voffA); PG8_STAGE(PG8_SB(1, 1), cB + hstep + kstep, voffB);
        PG8_WAIT_V(6); PG8_BAR;
    }
    for (;;) {
        const bool has_next = S.next(ui + 1, nxt);
        const char* nA = has_next ? (const char*)g.A + (size_t)nxt.pm * tstep : cA; const char* nB = has_next ? (const char*)g.Bt + (size_t)nxt.pn * tstep : cB;
        for (int t = 0; t < nt; t += 2) {
            if constexpr (Epi::MIDK) { if (t == nt / 2) E.mid(acc, cur, wr, wc, fr, fq); }
            const bool last = (t == nt - 2);
            const char* a1 = cA + (size_t)(t + 1) * kstep;
            const char* a2 = last ? nA : cA + (size_t)(t + 2) * kstep; const char* b2 = last ? nB : cB + (size_t)(t + 2) * kstep;
            const char* a3 = a2 + kstep; const char* b3 = b2 + kstep;
            if constexpr (SP2) {
            PG8_LDB(B0, 0, 0); PG8_LDB(B1, 0, 1); PG8_SCHED; PG8_LDA(At, 0, 0); PG8_STAGE(PG8_SA(1, 1), a1 + hstep, voffA);
            PG8_WAIT_V(8); PG8_WAIT_L(0); PG8_BAR; PG8_MMA(0, 0, At, B0); PG8_MMA(0, 1, At, B1); PG8_BAR; PG8_SCHED;
            PG8_LDA(At, 0, 1); PG8_STAGE(PG8_SB(0, 0), b2, voffB); PG8_STAGE(PG8_SB(0, 1), b2 + hstep, voffB); PG8_STAGE(PG8_SA(0, 0), a2, voffA);
            PG8_WAIT_V(8); PG8_WAIT_L(0); PG8_BAR; PG8_MMA(1, 0, At, B0); PG8_MMA(1, 1, At, B1); PG8_BAR; PG8_SCHED;
            PG8_LDB(B0, 1, 0); PG8_LDB(B1, 1, 1); PG8_SCHED; PG8_LDA(At, 1, 0); PG8_STAGE(PG8_SA(0, 1), a2 + hstep, voffA);
            PG8_WAIT_V(8); PG8_WAIT_L(0); PG8_BAR; PG8_MMA(0, 0, At, B0); PG8_MMA(0, 1, At, B1); PG8_BAR; PG8_SCHED;
            PG8_LDA(At, 1, 1); PG8_STAGE(PG8_SB(1, 0), b3, voffB); PG8_STAGE(PG8_SB(1, 1), b3 + hstep, voffB); PG8_STAGE(PG8_SA(1, 0), a3, voffA);
            PG8_WAIT_V(8); PG8_WAIT_L(0); PG8_BAR; PG8_MMA(1, 0, At, B0); PG8_MMA(1, 1, At, B1); PG8_BAR; PG8_SCHED;
            } else {
            PG8_LDB(B0, 0, 0); PG8_SCHED; PG8_LDA(At, 0, 0); PG8_STAGE(PG8_SA(1, 1), a1 + hstep, voffA);
            PG8_WAIT_L(8); PG8_BAR; PG8_WAIT_L(0); PG8_MMA(0, 0, At, B0); PG8_BAR; PG8_SCHED;
            PG8_LDB(B1, 0, 1); PG8_STAGE(PG8_SB(0, 0), b2, voffB);
            PG8_BAR; PG8_WAIT_L(0); PG8_MMA(0, 1, At, B1); PG8_BAR;
            PG8_LDA(At, 0, 1); PG8_STAGE(PG8_SA(0, 0), a2, voffA);
            PG8_BAR; PG8_WAIT_L(0); PG8_MMA(1, 0, At, B0); PG8_BAR; PG8_SCHED;
            PG8_STAGE(PG8_SB(0, 1), b2 + hstep, voffB);
            PG8_WAIT_V(6); PG8_BAR; PG8_MMA(1, 1, At, B1); PG8_BAR;
            PG8_LDB(B0, 1, 0); PG8_SCHED; PG8_LDA(At, 1, 0); PG8_STAGE(PG8_SA(0, 1), a2 + hstep, voffA);
            PG8_WAIT_L(8); PG8_BAR; PG8_WAIT_L(0); PG8_MMA(0, 0, At, B0); PG8_BAR; PG8_SCHED;
            PG8_LDB(B1, 1, 1); PG8_STAGE(PG8_SB(1, 0), b3, voffB);
            PG8_BAR; PG8_WAIT_L(0); PG8_MMA(0, 1, At, B1); PG8_BAR;
            PG8_LDA(At, 1, 1); PG8_STAGE(PG8_SA(1, 0), a3, voffA);
            PG8_BAR; PG8_WAIT_L(0); PG8_MMA(1, 0, At, B0); PG8_BAR; PG8_SCHED;
            PG8_STAGE(PG8_SB(1, 1), b3 + hstep, voffB);
            PG8_WAIT_V(6); PG8_BAR; PG8_MMA(1, 1, At, B1); PG8_BAR;
            }
        }
        if constexpr (ALIGN_EPI) { if (wr == 0) PG8_BAR; }
        E(acc, cur, wr, wc, fr, fq);
        if (!has_next) break;
#pragma unroll
        for (int a = 0; a < 2; ++a)
#pragma unroll
            for (int b = 0; b < 2; ++b)
#pragma unroll
                for (int m = 0; m < 4; ++m)
#pragma unroll
                    for (int n = 0; n < 2; ++n) acc[a][b][m][n] = (f32x4){0.f, 0.f, 0.f, 0.f};
        cur = nxt; cA = nA; cB = nB; ++ui;
        if constexpr (ALIGN_EPI) { if (wr == 1) PG8_BAR; }
    }
    PG8_WAIT_V(0);
    if constexpr (!ALIGN_EPI) { if (wr == 0) PG8_BAR; }
    PG8_BAR;
#undef PG8_SA
#undef PG8_SB
#undef PG8_STAGE
#undef PG8_LDA
#undef PG8_LDB
#undef PG8_MMA
#undef PG8_WAIT_V
#undef PG8_WAIT_L
#undef PG8_BAR
#undef PG8_SCHED
}
}
using pg8::Unit;
typedef f32x4 Acc[2][2][4][2];

DI u32x4 pack_row8(const f32x4& v0, const f32x4& v1) { u32x4 w; w.x = pk2(v0[0], v0[1]); w.y = pk2(v0[2], v0[3]); w.z = pk2(v1[0], v1[1]); w.w = pk2(v1[2], v1[3]); return w; }

struct EpiMod {
    static constexpr bool PERM = false, MIDK = false;
    float* mod; const float* bias;
    DI void operator()(Acc& acc, const Unit& u, int wr, int wc, int fr, int fq) const {
        { const int t_ = fresh_tid(); fr = t_ & 15; fq = (t_ >> 4) & 3; }
        if (u.pm != 0 || wr != 0) return;
#pragma unroll
        for (int m = 0; m < 3; ++m) { const int r = 16 * m + fr; if (r < NBATCH) {
#pragma unroll
            for (int bj = 0; bj < 2; ++bj)
#pragma unroll
                for (int n = 0; n < 2; ++n) { const int col = u.pn * 256 + bj * 128 + wc * 32 + n * 16 + 4 * fq;
                    *(f32x4*)(mod + (size_t)r * 6144 + col) = acc[0][bj][m][n] + *(const f32x4*)(bias + col); } } }
    }
};

struct EpiIn {
    static constexpr bool PERM = true, MIDK = false;
    bf16_t *QOB, *KA, *VA, *GA, *KB, *VB, *SGA, *SGB; float *CUM, *DEC; const float* lbl; float* out;
    DI void operator()(Acc& acc, const Unit& u, int wr, int wc, int fr, int fq) const {
        { const int t_ = fresh_tid(); fr = t_ & 15; fq = (t_ >> 4) & 3; }
        const int pn = u.pn, rt = wr * 64 + fr, row0 = u.pm * 256 + rt, cw = wc * 32 + 8 * fq, lane = fq * 16 + fr;
        if (pn >= 14) {
            const size_t o0 = ((size_t)(u.pm * 8 + (pn - 14)) * 8 * 512 + (size_t)(wr * 4 + wc) * 64 + lane) * 8;
#pragma unroll
            for (int ai = 0; ai < 2; ++ai)
#pragma unroll
                for (int m = 0; m < 4; ++m) { f32x4 r0, r1, b0, b1;
#pragma unroll
                    for (int j = 0; j < 4; ++j) { b0[j] = fmaxf(sigm(acc[ai][1][m][0][j]), 1e-30f); b1[j] = fmaxf(sigm(acc[ai][1][m][1][j]), 1e-30f);
                        r0[j] = sigm(acc[ai][0][m][0][j]) * __builtin_amdgcn_rcpf(b0[j]); r1[j] = sigm(acc[ai][0][m][1][j]) * __builtin_amdgcn_rcpf(b1[j]); }
                    const size_t o = o0 + (size_t)(ai * 4 + m) * 512 * 8;
                    *(u32x4*)(SGA + o) = pack_row8(r0, r1); *(u32x4*)(SGB + o) = pack_row8(b0, b1); __builtin_amdgcn_sched_barrier(0); }
            return;
        }
        const int seg = pn >> 1, col0 = (pn & 1) * 256 + cw;
        if (seg == 1) {
#pragma unroll
            for (int bj = 0; bj < 2; ++bj) {
                float lb[2][4];
#pragma unroll
                for (int n = 0; n < 2; ++n)
#pragma unroll
                    for (int j = 0; j < 4; ++j) { const int c = col0 + bj * 128 + 4 * n + j; lb[n][j] = __builtin_amdgcn_rcpf(1.f + __expf(lbl[512 + c] - lbl[c])); }
#pragma unroll
                for (int ai = 0; ai < 2; ++ai) {
                    const size_t rbase = ((size_t)((pn & 1) * 2 + bj) * T + (u.pm * 256 + ai * 128 + wr * 64 + launder(fr))) * 128 + cw;
#pragma unroll
                    for (int m = 0; m < 4; ++m) { f32x4 k0, k1;
#pragma unroll
                        for (int j = 0; j < 4; ++j) {
                            float f = lb[0][j] + (1.f - lb[0][j]) * sigm(acc[ai][bj][m][0][j]); k0[j] = 1.f - f; acc[ai][bj][m][0][j] = __logf(f);
                            f = lb[1][j] + (1.f - lb[1][j]) * sigm(acc[ai][bj][m][1][j]); k1[j] = 1.f - f; acc[ai][bj][m][1][j] = __logf(f); }
                        *(u32x4*)(KA + rbase + (size_t)m * 16 * 128) = pack_row8(k0, k1); }
                    __builtin_amdgcn_sched_barrier(0);
#pragma unroll
                    for (int n = 0; n < 2; ++n)
#pragma unroll
                        for (int j = 0; j < 4; ++j) { float carry = 0.f;
#pragma unroll
                            for (int m = 0; m < 4; ++m) { float v = acc[ai][bj][m][n][j];
                                v += __int_as_float(__builtin_amdgcn_update_dpp(0, __float_as_int(v), 0x111, 0xf, 0xf, false));
                                v += __int_as_float(__builtin_amdgcn_update_dpp(0, __float_as_int(v), 0x112, 0xf, 0xf, false));
                                v += __int_as_float(__builtin_amdgcn_update_dpp(0, __float_as_int(v), 0x114, 0xf, 0xf, false));
                                v += __int_as_float(__builtin_amdgcn_update_dpp(0, __float_as_int(v), 0x118, 0xf, 0xf, false));
                                v += carry; carry = __shfl(v, lane | 15); acc[ai][bj][m][n][j] = v; } }
                    __builtin_amdgcn_sched_barrier(0);
#pragma unroll
                    for (int m = 0; m < 4; ++m) { float* cp = CUM + rbase + (size_t)m * 16 * 128; *(f32x4*)cp = acc[ai][bj][m][0]; *(f32x4*)(cp + 4) = acc[ai][bj][m][1]; }
                    if (fr == 15) {
#pragma unroll
                        for (int n = 0; n < 2; ++n) { f32x4 e;
#pragma unroll
                            for (int j = 0; j < 4; ++j) e[j] = __expf(acc[ai][bj][3][n][j]);
                            *(f32x4*)(DEC + (size_t)(u.pm * 4 + ai * 2 + wr) * 512 + col0 + bj * 128 + 4 * n) = e; } }
                    __builtin_amdgcn_sched_barrier(0);
                }
            }
            return;
        }
        bf16_t* dst; int pitch = 512; size_t bjoff = 128; float* o32 = nullptr;
        switch (seg) {
            case 0: dst = QOB + col0; pitch = 1024; break;
            case 2: dst = VA + (size_t)((pn & 1) * 2) * T * 128 + (cw >> 3) * 256; bjoff = (size_t)T * 128; break;
            case 3: dst = GA + (size_t)((pn & 1) * 2) * T * 128 + cw; pitch = 128; bjoff = (size_t)T * 128; break;
            case 4: dst = QOB + 512 + col0; pitch = 1024; break;
            default: dst = (seg == 5 ? KB : VB) + (size_t)((pn & 1) * 4 + (wc >> 1)) * (T / 32) * 2048 + ((wc & 1) * 4 + fq) * 256; bjoff = (size_t)2 * (T / 32) * 2048; break;
        }
        if (seg >= 5) {
            if (u.pm >= 128) o32 = out + (seg == 5 ? OFF_KS : OFF_VS) + (size_t)((u.pm - 128) * 256 + rt) * 512 + col0;
            else if ((u.pm & 63) >= 62) o32 = out + (seg == 5 ? OFF_KP : OFF_VP) + (size_t)((u.pm >> 6) * 512 + ((u.pm & 63) - 62) * 256 + rt) * 512 + col0;
        }
        const bool act = (seg == 0 || seg == 3);
#pragma unroll
        for (int ai = 0; ai < 2; ++ai)
#pragma unroll
            for (int m = 0; m < 4; ++m)
#pragma unroll
                for (int bj = 0; bj < 2; ++bj) { f32x4 v0 = acc[ai][bj][m][0], v1 = acc[ai][bj][m][1];
                    if (act) {
#pragma unroll
                        for (int j = 0; j < 4; ++j) { v0[j] = silu(v0[j]); v1[j] = silu(v1[j]); } }
                    const size_t ro = seg >= 5 ? (size_t)(u.pm * 8 + 2 * wr + 4 * ai + (m >> 1)) * 2048 + ((m & 1) * 16 + fr) * 8 : seg == 2 ? (size_t)(u.pm * 8 + 2 * wr + 4 * ai + (m >> 1)) * 4096 + ((m & 1) * 16 + fr) * 8 : (size_t)(row0 + ai * 128 + m * 16) * pitch;
                    *(u32x4*)(dst + ro + bj * bjoff) = pack_row8(v0, v1);
                    if (o32) { float* op = o32 + (size_t)(ai * 128 + m * 16) * 512 + bj * 128; *(f32x4*)op = v0; *(f32x4*)(op + 4) = v1; } __builtin_amdgcn_sched_barrier(0); }
    }
};

struct EpiMerge {
    static constexpr bool PERM = true, MIDK = true;
    const bf16_t *SGR, *SGB; bf16_t* Mo;
    DI void mid(Acc& acc, const Unit& u, int wr, int wc, int fr, int fq) const {
        { const int t_ = fresh_tid(); fr = t_ & 15; fq = (t_ >> 4) & 3; }
        const size_t gb = ((size_t)(u.pm * 8 + 2 * u.pn) * 8 * 512 + (size_t)(wr * 4 + wc) * 64 + (fq * 16 + fr)) * 8;
#pragma unroll
        for (int ai = 0; ai < 2; ++ai) { u32x4 a[4][2];
#pragma unroll
            for (int m = 0; m < 4; ++m)
#pragma unroll
                for (int bj = 0; bj < 2; ++bj) a[m][bj] = *(const u32x4*)(SGR + gb + ((size_t)bj * 8 + ai * 4 + m) * 512 * 8);
#pragma unroll
            for (int m = 0; m < 4; ++m)
#pragma unroll
                for (int bj = 0; bj < 2; ++bj)
#pragma unroll
                    for (int j = 0; j < 4; ++j) { acc[ai][bj][m][j >> 1][(j & 1) * 2] *= bflo(a[m][bj][j]); acc[ai][bj][m][j >> 1][(j & 1) * 2 + 1] *= bfhi(a[m][bj][j]); }
            __builtin_amdgcn_sched_barrier(0); }
    }
    DI void operator()(Acc& acc, const Unit& u, int wr, int wc, int fr, int fq) const {
        { const int t_ = fresh_tid(); fr = t_ & 15; fq = (t_ >> 4) & 3; }
        const size_t base = (size_t)(u.pm * 256 + wr * 64 + fr) * 1024 + u.pn * 256 + wc * 32 + 8 * fq;
        const size_t gb = ((size_t)(u.pm * 8 + 2 * u.pn) * 8 * 512 + (size_t)(wr * 4 + wc) * 64 + (fq * 16 + fr)) * 8;
#pragma unroll
        for (int ai = 0; ai < 2; ++ai) { u32x4 b[4][2];
#pragma unroll
            for (int m = 0; m < 4; ++m)
#pragma unroll
                for (int bj = 0; bj < 2; ++bj) b[m][bj] = *(const u32x4*)(SGB + gb + ((size_t)bj * 8 + ai * 4 + m) * 512 * 8);
#pragma unroll
            for (int m = 0; m < 4; ++m)
#pragma unroll
                for (int bj = 0; bj < 2; ++bj) { f32x4 v0 = acc[ai][bj][m][0], v1 = acc[ai][bj][m][1]; const u32x4 g = b[m][bj];
                    v0[0] *= bflo(g[0]); v0[1] *= bfhi(g[0]); v0[2] *= bflo(g[1]); v0[3] *= bfhi(g[1]);
                    v1[0] *= bflo(g[2]); v1[1] *= bfhi(g[2]); v1[2] *= bflo(g[3]); v1[3] *= bfhi(g[3]);
                    *(u32x4*)(Mo + base + (size_t)(ai * 128 + m * 16) * 1024 + bj * 128) = pack_row8(v0, v1); }
            __builtin_amdgcn_sched_barrier(0); }
    }
};

template <bool BASE_BF16> struct EpiRes {
    static constexpr bool PERM = true, MIDK = false;
    const float *xp, *xs; const bf16_t* xb; bf16_t* xo; const float* gmod;
    DI void operator()(Acc& acc, const Unit& u, int wr, int wc, int fr, int fq) const {
        { const int t_ = fresh_tid(); fr = t_ & 15; fq = (t_ >> 4) & 3; }
        const int colb = u.pn * 256 + wc * 32 + 8 * fq;
#pragma unroll
        for (int ai = 0; ai < 2; ++ai) { const int r0 = u.pm * 256 + ai * 128 + wr * 64 + fr;
            const float* g = gmod + (size_t)batch_of(r0) * 6144 + colb;
            f32x4 gv[2][2];
#pragma unroll
            for (int bj = 0; bj < 2; ++bj) { gv[bj][0] = *(const f32x4*)(g + bj * 128); gv[bj][1] = *(const f32x4*)(g + bj * 128 + 4); }
            bf16_t* orow = xo + (size_t)r0 * D + colb;
            if constexpr (BASE_BF16) {
                const bf16_t* xr = xb + (size_t)r0 * D + colb; u32x4 xv[4][2];
#pragma unroll
                for (int m = 0; m < 4; ++m)
#pragma unroll
                    for (int bj = 0; bj < 2; ++bj) xv[m][bj] = *(const u32x4*)(xr + (size_t)m * 16 * D + bj * 128);
#pragma unroll
                for (int m = 0; m < 4; ++m)
#pragma unroll
                    for (int bj = 0; bj < 2; ++bj) { const u32x4 x = xv[m][bj]; const f32x4 a0 = acc[ai][bj][m][0] * gv[bj][0], a1 = acc[ai][bj][m][1] * gv[bj][1];
                        f32x4 v0 = {bflo(x[0]) + a0[0], bfhi(x[0]) + a0[1], bflo(x[1]) + a0[2], bfhi(x[1]) + a0[3]}, v1 = {bflo(x[2]) + a1[0], bfhi(x[2]) + a1[1], bflo(x[3]) + a1[2], bfhi(x[3]) + a1[3]};
                        *(u32x4*)(orow + (size_t)m * 16 * D + bj * 128) = pack_row8(v0, v1); }
            } else {
                const float* xr = (r0 < TP ? xp + (size_t)r0 * D : xs + (size_t)(r0 - TP) * D) + colb; f32x4 xv[4][2][2];
#pragma unroll
                for (int m = 0; m < 4; ++m)
#pragma unroll
                    for (int bj = 0; bj < 2; ++bj) { xv[m][bj][0] = *(const f32x4*)(xr + (size_t)m * 16 * D + bj * 128); xv[m][bj][1] = *(const f32x4*)(xr + (size_t)m * 16 * D + bj * 128 + 4); }
#pragma unroll
                for (int m = 0; m < 4; ++m)
#pragma unroll
                    for (int bj = 0; bj < 2; ++bj) *(u32x4*)(orow + (size_t)m * 16 * D + bj * 128) = pack_row8(xv[m][bj][0] + gv[bj][0] * acc[ai][bj][m][0], xv[m][bj][1] + gv[bj][1] * acc[ai][bj][m][1]);
            }
            __builtin_amdgcn_sched_barrier(0); }
    }
};

struct EpiPart {
    static constexpr bool PERM = false, MIDK = false;
    float* part; int row0;
    DI void operator()(Acc& acc, const Unit& u, int wr, int wc, int fr, int fq) const {
        { const int t_ = fresh_tid(); fr = t_ & 15; fq = (t_ >> 4) & 3; }
#pragma unroll
        for (int ai = 0; ai < 2; ++ai)
#pragma unroll
            for (int m = 0; m < 4; ++m) { float* prow = part + (size_t)(u.pm * 256 + ai * 128 + wr * 64 + m * 16 + fr - row0) * D + u.pn * 256 + wc * 32 + 4 * fq;
#pragma unroll
                for (int bj = 0; bj < 2; ++bj)
#pragma unroll
                    for (int n = 0; n < 2; ++n) *(f32x4*)(prow + bj * 128 + n * 16) = acc[ai][bj][m][n];
                __builtin_amdgcn_sched_barrier(0); }
    }
};

struct EpiFfnIn {
    static constexpr bool PERM = true, MIDK = false;
    bf16_t* HID;
    DI void operator()(Acc& acc, const Unit& u, int wr, int wc, int fr, int fq) const {
        { const int t_ = fresh_tid(); fr = t_ & 15; fq = (t_ >> 4) & 3; }
        bf16_t* base = HID + (size_t)(u.pm * 256 + wr * 64 + fr) * FF + u.pn * 128 + wc * 32 + 8 * fq;
#pragma unroll
        for (int ai = 0; ai < 2; ++ai)
#pragma unroll
            for (int m = 0; m < 4; ++m) { f32x4 v0, v1;
#pragma unroll
                for (int j = 0; j < 4; ++j) { v0[j] = silu(acc[ai][0][m][0][j]) * acc[ai][1][m][0][j]; v1[j] = silu(acc[ai][0][m][1][j]) * acc[ai][1][m][1][j]; }
                *(u32x4*)(base + (size_t)(ai * 128 + m * 16) * FF) = pack_row8(v0, v1); __builtin_amdgcn_sched_barrier(0); }
    }
};

DI void transpose_item(const float* W, int N, bf16_t* WT, int pitch, int koff, int k0, int n0, int drow0, LAS float* scr, int lane) {
#pragma unroll
    for (int i = 0; i < 8; ++i) { const int kk = 8 * i + (lane >> 3), n4 = 4 * (lane & 7); const f32x4 w = *(const f32x4*)(W + (size_t)(k0 + kk) * N + n0 + n4);
        scr[kk * 33 + n4] = w[0]; scr[kk * 33 + n4 + 1] = w[1]; scr[kk * 33 + n4 + 2] = w[2]; scr[kk * 33 + n4 + 3] = w[3]; }
    asm volatile("s_waitcnt lgkmcnt(0)" ::: "memory");
    const int c = lane & 7;
#pragma unroll
    for (int j = 0; j < 4; ++j) { const int n = (lane >> 3) + 8 * j; const LAS float* s = scr + (8 * c) * 33 + n;
        u32x4 o; o.x = pk2(s[0 * 33], s[1 * 33]); o.y = pk2(s[2 * 33], s[3 * 33]); o.z = pk2(s[4 * 33], s[5 * 33]); o.w = pk2(s[6 * 33], s[7 * 33]);
        *(u32x4*)(WT + (size_t)(drow0 + n) * pitch + koff + k0 + 8 * c) = o; }
    asm volatile("s_waitcnt lgkmcnt(0)" ::: "memory");
}
DI void phase_prep(const Params& p, LAS unsigned char* lds) {
    const int tid = fresh_tid(), lane = tid & 63, wave = __builtin_amdgcn_readfirstlane(tid >> 6);
    LAS float* scr = (LAS float*)(lds + wave * 16384);
    const int gw = blockIdx.x * 8 + wave, NGW = gridDim.x * 8;
    unsigned char* ws = p.ws;
    constexpr int I_ADA = 16 * 192, I_IN = 16 * 176, I_A = 8 * 32, I_O = 16 * 32, I_FI = 16 * 176, I_FO = 44 * 32;
    constexpr int NIT = I_ADA + I_IN + 2 * I_A + I_O + I_FI + I_FO;
    for (int it = gw; it < NIT; it += NGW) {
        int r = it;
        if (r < I_ADA) { const int kb = r / 192, nb = r % 192; transpose_item(p.w_ada, 6144, (bf16_t*)(ws + WS_WADA), 1024, 0, 64 * kb, 32 * nb, 32 * nb, scr, lane); continue; } r -= I_ADA;
        if (r < I_IN) { const int kb = r / 176, nb = r % 176, n0 = 32 * nb; int dr = n0;
            if (n0 >= 3584) { const int j = n0 < 4608 ? n0 - 3584 : n0 - 4608; dr = 3584 + 256 * (j >> 7) + (j & 127) + (n0 < 4608 ? 0 : 128); }
            transpose_item(p.w_in, INC, (bf16_t*)(ws + WS_WIN), 1024, 0, 64 * kb, n0, dr, scr, lane); continue; } r -= I_IN;
        if (r < I_A) { const int kb = r / 32, nb = r % 32; transpose_item(p.w_a, 1024, (bf16_t*)(ws + WS_WAB), 1024, 0, 64 * kb, 32 * nb, 32 * nb, scr, lane); continue; } r -= I_A;
        if (r < I_A) { const int kb = r / 32, nb = r % 32; transpose_item(p.w_b, 1024, (bf16_t*)(ws + WS_WAB), 1024, 512, 64 * kb, 32 * nb, 32 * nb, scr, lane); continue; } r -= I_A;
        if (r < I_O) { const int kb = r / 32, nb = r % 32; transpose_item(p.w_out, 1024, (bf16_t*)(ws + WS_WO), 1024, 0, 64 * kb, 32 * nb, 32 * nb, scr, lane); continue; } r -= I_O;
        if (r < I_FI) { const int kb = r / 176, nb = r % 176; const int n0 = 32 * nb; const int j0 = n0 < FF ? n0 : n0 - FF;
            transpose_item(p.w_ffn_in, INC, (bf16_t*)(ws + WS_WFI), 1024, 0, 64 * kb, n0, 256 * (j0 >> 7) + (j0 & 127) + (n0 < FF ? 0 : 128), scr, lane); continue; } r -= I_FI;
        { const int kb = r / 32, nb = r % 32; transpose_item(p.w_ffn_out, 1024, (bf16_t*)(ws + WS_WFO), FF, 0, 64 * kb, 32 * nb, 32 * nb, scr, lane); }
    }
    bf16_t* SC = (bf16_t*)(ws + WS_SC);
    for (int i = blockIdx.x * 512 + tid; i < 256 * 1024 / 2; i += gridDim.x * 512) { const int row = (2 * i) >> 10, col = (2 * i) & 1023; float a = 0.f, b = 0.f;
        if (row < NBATCH) { const float* c = row < 2 ? p.c_prompt + row * D : p.c_sample + (row - 2) * D; a = silu(c[col]); b = silu(c[col + 1]); }
        ((unsigned*)SC)[i] = pk2(a, b); }
}

DI float wave_sum(float v) {
#pragma unroll
    for (int o = 1; o < 64; o <<= 1) v += __shfl_xor(v, o);
    return v;
}
DI void phase_norm_mod(const float* xp, const float* xs, const float* nw, const float* mod, int sh_off, int sc_off, bf16_t* H) {
    const int tid = fresh_tid(), lane = tid & 63, wave = __builtin_amdgcn_readfirstlane(tid >> 6);
    const int gw = blockIdx.x * 8 + wave, NGW = gridDim.x * 8;
    for (int r = gw; r < T; r += NGW) {
        const float* xr = r < TP ? xp + (size_t)r * D : xs + (size_t)(r - TP) * D; const float* mb = mod + (size_t)batch_of(r) * 6144;
        f32x4 v[4]; float s = 0.f;
#pragma unroll
        for (int j = 0; j < 4; ++j) { v[j] = *(const f32x4*)(xr + 4 * lane + 256 * j); s += (v[j][0] * v[j][0] + v[j][1] * v[j][1]) + (v[j][2] * v[j][2] + v[j][3] * v[j][3]); }
        const float rstd = __builtin_amdgcn_rsqf(wave_sum(s) * (1.f / D) + EPS);
#pragma unroll
        for (int j = 0; j < 4; ++j) { const int col = 4 * lane + 256 * j; const f32x4 w = *(const f32x4*)(nw + col), sc = *(const f32x4*)(mb + sc_off + col), sh = *(const f32x4*)(mb + sh_off + col);
            const f32x4 h = v[j] * rstd * w * (sc + 1.f) + sh; u32x2 o; o.x = pk2(h[0], h[1]); o.y = pk2(h[2], h[3]);
            *(u32x2*)(H + (size_t)r * D + col) = o; }
    }
}
DI void phase_norm_mod_b(const bf16_t* xb, const float* nw, const float* mod, int sh_off, int sc_off, bf16_t* H, int r_lo = 0, int r_hi = T, int b_lo = 0) {
    const int tid = fresh_tid(), lane = tid & 63, wave = __builtin_amdgcn_readfirstlane(tid >> 6);
    const int gw = ((int)blockIdx.x - b_lo) * 8 + wave, NGW = ((int)gridDim.x - b_lo) * 8;
    for (int r = r_lo + gw; r < r_hi; r += NGW) {
        const bf16_t* xr = xb + (size_t)r * D; const float* mb = mod + (size_t)batch_of(r) * 6144;
        float v[2][8]; float s = 0.f;
#pragma unroll
        for (int j = 0; j < 2; ++j) { const u32x4 x = *(const u32x4*)(xr + 8 * lane + 512 * j);
#pragma unroll
            for (int i = 0; i < 4; ++i) { v[j][2 * i] = bflo(x[i]); v[j][2 * i + 1] = bfhi(x[i]); s += v[j][2 * i] * v[j][2 * i] + v[j][2 * i + 1] * v[j][2 * i + 1]; } }
        const float rstd = __builtin_amdgcn_rsqf(wave_sum(s) * (1.f / D) + EPS);
#pragma unroll
        for (int j = 0; j < 2; ++j) { const int col = 8 * lane + 512 * j; f32x4 h[2];
#pragma unroll
            for (int q = 0; q < 2; ++q) { const f32x4 w = *(const f32x4*)(nw + col + 4 * q), sc = *(const f32x4*)(mb + sc_off + col + 4 * q), sh = *(const f32x4*)(mb + sh_off + col + 4 * q);
                const f32x4 x = {v[j][4 * q], v[j][4 * q + 1], v[j][4 * q + 2], v[j][4 * q + 3]}; h[q] = x * rstd * w * (sc + 1.f) + sh; }
            *(u32x4*)(H + (size_t)r * D + col) = pack_row8(h[0], h[1]); }
    }
}
DI void phase_final_norm(const bf16_t* xb, float* y, const float* nw, int r_lo = 0, int r_hi = T, int b_lo = 0) {
    const int tid = fresh_tid(), lane = tid & 63, wave = __builtin_amdgcn_readfirstlane(tid >> 6);
    const int gw = ((int)blockIdx.x - b_lo) * 8 + wave, NGW = ((int)gridDim.x - b_lo) * 8;
    for (int r = r_lo + gw; r < r_hi; r += NGW) { const bf16_t* xr = xb + (size_t)r * D; float* yr = y + (size_t)r * D;
        float v[2][8]; float s = 0.f;
#pragma unroll
        for (int j = 0; j < 2; ++j) { const u32x4 x = *(const u32x4*)(xr + 8 * lane + 512 * j);
#pragma unroll
            for (int i = 0; i < 4; ++i) { v[j][2 * i] = bflo(x[i]); v[j][2 * i + 1] = bfhi(x[i]); s += v[j][2 * i] * v[j][2 * i] + v[j][2 * i + 1] * v[j][2 * i + 1]; } }
        const float rstd = __builtin_amdgcn_rsqf(wave_sum(s) * (1.f / D) + EPS);
#pragma unroll
        for (int j = 0; j < 2; ++j) { const int col = 8 * lane + 512 * j;
#pragma unroll
            for (int q = 0; q < 2; ++q) { const f32x4 x = {v[j][4 * q], v[j][4 * q + 1], v[j][4 * q + 2], v[j][4 * q + 3]}; *(f32x4*)(yr + col + 4 * q) = x * rstd * *(const f32x4*)(nw + col + 4 * q); } }
    }
}

DI void phase_final_norm_parts(const bf16_t* x1b, const float* part0, const float* part1, const float* g2mod, float* y, const float* nw) {
    const int tid = fresh_tid(), lane = tid & 63, wave = __builtin_amdgcn_readfirstlane(tid >> 6);
    const int gw = blockIdx.x * 8 + wave, NGW = gridDim.x * 8;
    for (int r = TP + gw; r < T; r += NGW) { const float* gb = g2mod + (size_t)batch_of(r) * 6144; const size_t po = (size_t)(r - TP) * D;
        f32x4 v[4]; float s = 0.f;
#pragma unroll
        for (int j = 0; j < 4; ++j) { const int col = 4 * lane + 256 * j; const u32x2 xb = *(const u32x2*)(x1b + (size_t)r * D + col);
            const f32x4 x = {bflo(xb.x), bfhi(xb.x), bflo(xb.y), bfhi(xb.y)};
            v[j] = x + *(const f32x4*)(gb + col) * (*(const f32x4*)(part0 + po + col) + *(const f32x4*)(part1 + po + col));
            s += (v[j][0] * v[j][0] + v[j][1] * v[j][1]) + (v[j][2] * v[j][2] + v[j][3] * v[j][3]); }
        const float rstd = __builtin_amdgcn_rsqf(wave_sum(s) * (1.f / D) + EPS);
#pragma unroll
        for (int j = 0; j < 4; ++j) { const int col = 4 * lane + 256 * j; *(f32x4*)(y + (size_t)r * D + col) = v[j] * rstd * *(const f32x4*)(nw + col); }
    }
}

DI void hgrn_u_item(const Params& p, int item, int lane) {
    const int c = item >> 4, rem = item & 15, h = rem >> 2, kt = rem & 3, l31 = lane & 31, hf = lane >> 5;
    const float* CUM = (const float*)(p.ws + WS_CUM); const bf16_t* KA = (const bf16_t*)(p.ws + WS_KA); const bf16_t* VA = (const bf16_t*)(p.ws + WS_VA); bf16_t* U = (bf16_t*)(p.ws + WS_U);
    const size_t hb = (size_t)h * T * 128; const int kcol = 32 * kt + l31;
    const float tot = CUM[hb + (size_t)(c * 64 + 63) * 128 + kcol];
    bf16x8 kdf[2][2];
#pragma unroll
    for (int st = 0; st < 2; ++st) { f32x16 kd;
#pragma unroll
        for (int r = 0; r < 16; ++r) { const size_t idx = hb + (size_t)(c * 64 + 32 * st + crow(r, hf)) * 128 + kcol; kd[r] = bf2f((short)KA[idx]) * __expf(tot - CUM[idx]); }
        kdf[st][0] = pack8(kd, 0); kdf[st][1] = pack8(kd, 1); }
    const bf16x8 id0 = ident_frag(0, l31, hf), id1 = ident_frag(1, l31, hf);
#pragma unroll
    for (int vt = 0; vt < 4; ++vt) { f32x16 dacc = zero16();
#pragma unroll
        for (int st = 0; st < 2; ++st) { const bf16_t* vp = VA + hb + (size_t)(c * 64 + 32 * st) * 128 + (4 * vt + hf) * 256 + l31 * 8;
            f32x16 vx = zero16(); vx = MFMA32(*(const bf16x8*)vp, id0, vx); vx = MFMA32(*(const bf16x8*)(vp + 512), id1, vx);
            dacc = MFMA32(kdf[st][0], pack8(vx, 0), dacc); dacc = MFMA32(kdf[st][1], pack8(vx, 1), dacc); }
        bf16_t* up = U + ((size_t)(c * 4 + h) * 128 + 32 * vt + l31) * 128 + 32 * kt + 8 * hf;
#pragma unroll
        for (int g = 0; g < 4; g += 2) { u32x2 o0, o1; o0.x = pk2(dacc[4 * g], dacc[4 * g + 1]); o0.y = pk2(dacc[4 * g + 2], dacc[4 * g + 3]); o1.x = pk2(dacc[4 * g + 4], dacc[4 * g + 5]); o1.y = pk2(dacc[4 * g + 6], dacc[4 * g + 7]);
            *(u32x4*)(up + 8 * g) = widen_pair(o0, o1); }
    }
}

DI void scan_prompt_item(const Params& p, int item, int lane) {
    const int bh = item >> 6, vp = item & 63, b = bh >> 2, h = bh & 3, kg = lane & 31, v0 = 2 * vp + (lane >> 5);
    const float* __restrict__ DEC = (const float*)(p.ws + WS_DEC) + (size_t)b * 256 * 512 + h * 128 + 4 * kg;
    const bf16_t* __restrict__ U = (const bf16_t*)(p.ws + WS_U) + ((size_t)(b * 256 * 4 + h) * 128 + v0) * 128 + 4 * kg;
    bf16_t* __restrict__ SST = (bf16_t*)(p.ws + WS_SST) + ((size_t)(b * 256 * 4 + h) * 128 + v0) * 128 + 4 * kg;
    f32x4 S0 = {0.f, 0.f, 0.f, 0.f};
    for (int n0 = 0; n0 < 256; n0 += 32) {
        f32x4 d[32]; u32x2 u[32];
#pragma unroll
        for (int i = 0; i < 32; ++i) { d[i] = *(const f32x4*)(DEC + (size_t)(n0 + i) * 512); u[i] = *(const u32x2*)(U + (size_t)(n0 + i) * 4 * 128 * 128); }
#pragma unroll
        for (int i = 0; i < 32; ++i) { u32x2 s; s.x = pk2(S0[0], S0[1]); s.y = pk2(S0[2], S0[3]); *(u32x2*)(SST + (size_t)(n0 + i) * 4 * 128 * 128) = s;
            S0[0] = d[i][0] * S0[0] + bflo(u[i].x); S0[1] = d[i][1] * S0[1] + bfhi(u[i].x); S0[2] = d[i][2] * S0[2] + bflo(u[i].y); S0[3] = d[i][3] * S0[3] + bfhi(u[i].y); }
    }
    float* sp = p.out + OFF_SP + ((size_t)bh * 128 + 4 * kg) * 128;
#pragma unroll
    for (int i = 0; i < 4; ++i) sp[(size_t)i * 128 + v0] = S0[i];
}
DI void scan_sample_item(const Params& p, int item, int lane) {
    const int bh = item >> 5, sub = item & 31, bs = bh >> 2, h = bh & 3, k0 = 32 * (sub & 3) + 4 * (lane >> 3), vb = 16 * (sub >> 2) + (lane & 7), c = 512 + bs;
    const float* DEC = (const float*)(p.ws + WS_DEC); const bf16_t* U = (const bf16_t*)(p.ws + WS_U); bf16_t* SST = (bf16_t*)(p.ws + WS_SST);
    const f32x4 d = *(const f32x4*)(DEC + (size_t)c * 512 + h * 128 + k0);
    const float* s0 = p.state + ((size_t)bh * 128 + k0) * 128; float* so = p.out + OFF_SS + ((size_t)bh * 128 + k0) * 128;
#pragma unroll
    for (int e = 0; e < 2; ++e) { const int v = vb + 8 * e; const size_t o = ((size_t)(c * 4 + h) * 128 + v) * 128 + k0;
        const u32x2 u = *(const u32x2*)(U + o); f32x4 S;
#pragma unroll
        for (int i = 0; i < 4; ++i) S[i] = s0[(size_t)i * 128 + v];
        u32x2 s; s.x = pk2(S[0], S[1]); s.y = pk2(S[2], S[3]); *(u32x2*)(SST + o) = s;
        so[v] = d[0] * S[0] + bflo(u.x); so[128 + v] = d[1] * S[1] + bfhi(u.x); so[256 + v] = d[2] * S[2] + bflo(u.y); so[384 + v] = d[3] * S[3] + bfhi(u.y); }
}

DI void attn_item(const Params& p, int item, int lane, const LAS float* biasl) {
    const int c = item >> 3, h = item & 7, l31 = lane & 31, hf = lane >> 5;
    const bf16_t* KB = (const bf16_t*)(p.ws + WS_KB); const bf16_t* VB = (const bf16_t*)(p.ws + WS_VB);
    bf16x8 qf[2][4];
    { const bf16_t* qptr = (const bf16_t*)(p.ws + WS_QOB) + (size_t)(c * 64 + l31) * 1024 + 512 + h * 64;
#pragma unroll
    for (int qq = 0; qq < 2; ++qq)
#pragma unroll
        for (int ks = 0; ks < 4; ++ks) qf[qq][ks] = *(const bf16x8*)(qptr + (size_t)qq * 32 * 1024 + 16 * ks + 8 * hf); }
    const LAS float* bl = biasl + h * 192;
    f32x16 OT[2][2]; float mrun[2], lsum[2];
#pragma unroll
    for (int qq = 0; qq < 2; ++qq) { OT[qq][0] = zero16(); OT[qq][1] = zero16(); mrun[qq] = -1e30f; lsum[qq] = 0.f; }
    int ntile, ncache, db0, krow_first;
    if (c < 512) { const int n = c & 255, j0 = n < 8 ? n : 8; ntile = 2 * (j0 + 1); ncache = 0; db0 = 64 * j0; krow_first = (c - j0) * 64; }
    else { ntile = 18; ncache = 16; db0 = 512; krow_first = c * 64 - 512; }
    const int bs = c - 512;
    u32x4 nk[4], nv[4];
#define ATT_LOAD(i_) do { if ((i_) >= ncache) { const size_t ro_ = (((size_t)h * (T / 32) + (size_t)((krow_first >> 5) + (i_))) * 8 + hf) * 256 + l31 * 8;     \
            _Pragma("unroll") for (int ks = 0; ks < 4; ++ks) { nk[ks] = *(const u32x4*)(KB + ro_ + 512 * ks); nv[ks] = *(const u32x4*)(VB + ro_ + 512 * ks); } } } while (0)
    ATT_LOAD(0);
    for (int i = 0; i < ntile; ++i) {
        bf16x8 kf[4], vf[2][2];
        if (i < ncache) {
            const float* kp_ = p.cache_k + ((size_t)(bs * 512 + 32 * i + l31) * 8 + h) * 64 + 8 * hf; const float* vp_ = p.cache_v + ((size_t)(bs * 512 + 32 * i + l31) * 8 + h) * 64 + 8 * hf;
#pragma unroll
            for (int ks = 0; ks < 4; ++ks) { u32x4 w; const f32x4 a = *(const f32x4*)(kp_ + 16 * ks), b = *(const f32x4*)(kp_ + 16 * ks + 4), e = *(const f32x4*)(vp_ + 16 * ks), f = *(const f32x4*)(vp_ + 16 * ks + 4);
                w.x = pk2(a[0], a[1]); w.y = pk2(a[2], a[3]); w.z = pk2(b[0], b[1]); w.w = pk2(b[2], b[3]); kf[ks] = __builtin_bit_cast(bf16x8, w);
                w.x = pk2(e[0], e[1]); w.y = pk2(e[2], e[3]); w.z = pk2(f[0], f[1]); w.w = pk2(f[2], f[3]); vf[ks >> 1][ks & 1] = __builtin_bit_cast(bf16x8, w); }
        } else {
#pragma unroll
            for (int ks = 0; ks < 4; ++ks) { kf[ks] = __builtin_bit_cast(bf16x8, nk[ks]); vf[ks >> 1][ks & 1] = __builtin_bit_cast(bf16x8, nv[ks]); }
        }
        if (i + 1 < ntile) ATT_LOAD(i + 1);
        asm volatile("" ::: "memory");
        bf16x8 vxf[2][2];
        const int l31b = launder(l31); const bf16x8 id0 = ident_frag(0, l31b, hf), id1 = ident_frag(1, l31b, hf);
#pragma unroll
        for (int dt = 0; dt < 2; ++dt) { f32x16 vx = zero16(); vx = MFMA32(vf[dt][0], id0, vx); vx = MFMA32(vf[dt][1], id1, vx); vxf[dt][0] = pack8(vx, 0); vxf[dt][1] = pack8(vx, 1); }
#pragma unroll
        for (int qq = 0; qq < 2; ++qq) {
            f32x16 st = zero16();
#pragma unroll
            for (int ks = 0; ks < 4; ++ks) st = MFMA32(kf[ks], qf[qq][ks], st);
            const int dq = db0 + 32 * qq - 32 * i; float mt = -1e30f;
            if (dq - 31 >= 128) { const float bc = bl[191];
#pragma unroll
                for (int r = 0; r < 16; ++r) { const float s = st[r] * (0.125f * LOG2E) + bc; st[r] = s; mt = fmaxf(mt, s); }
            } else { const int dbase = dq + l31;
#pragma unroll
                for (int r = 0; r < 16; ++r) { int dist = dbase - crow(r, hf); dist = dist > 128 ? 128 : dist; const float s = st[r] * (0.125f * LOG2E) + bl[dist + 63]; st[r] = s; mt = fmaxf(mt, s); }
            }
            mt = fmaxf(mt, __shfl_xor(mt, 32));
            const float mnew = fmaxf(mrun[qq], mt), alpha = __builtin_amdgcn_exp2f(mrun[qq] - mnew); mrun[qq] = mnew;
            float ps = 0.f;
#pragma unroll
            for (int r = 0; r < 16; ++r) { st[r] = __builtin_amdgcn_exp2f(st[r] - mnew); ps += st[r]; }
            lsum[qq] = lsum[qq] * alpha + ps;
#pragma unroll
            for (int r = 0; r < 16; ++r) { OT[qq][0][r] *= alpha; OT[qq][1][r] *= alpha; }
            const bf16x8 pf0 = pack8(st, 0), pf1 = pack8(st, 1);
            OT[qq][0] = MFMA32(vxf[0][0], pf0, OT[qq][0]); OT[qq][0] = MFMA32(vxf[0][1], pf1, OT[qq][0]);
            OT[qq][1] = MFMA32(vxf[1][0], pf0, OT[qq][1]); OT[qq][1] = MFMA32(vxf[1][1], pf1, OT[qq][1]);
        }
    }
#undef ATT_LOAD
    bf16_t* qptr = (bf16_t*)(p.ws + WS_QOB) + (size_t)(c * 64 + launder(l31)) * 1024 + 512 + h * 64;
#pragma unroll
    for (int qq = 0; qq < 2; ++qq) { const float l = lsum[qq] + __shfl_xor(lsum[qq], 32), inv = 1.f / l; bf16_t* op = qptr + (size_t)qq * 32 * 1024;
#pragma unroll
        for (int dt = 0; dt < 2; ++dt)
#pragma unroll
            for (int g = 0; g < 4; g += 2) { u32x2 o0, o1; o0.x = pk2(OT[qq][dt][4 * g] * inv, OT[qq][dt][4 * g + 1] * inv); o0.y = pk2(OT[qq][dt][4 * g + 2] * inv, OT[qq][dt][4 * g + 3] * inv);
                o1.x = pk2(OT[qq][dt][4 * g + 4] * inv, OT[qq][dt][4 * g + 5] * inv); o1.y = pk2(OT[qq][dt][4 * g + 6] * inv, OT[qq][dt][4 * g + 7] * inv);
                *(u32x4*)(op + 32 * dt + 8 * (g + hf)) = widen_pair(o0, o1); } }
}

DI void hgrn_out_item(const Params& p, int item, int lane, bf16_t* obase = nullptr) {
    const int c = item >> 3, h = (item >> 1) & 3, tt = item & 1, l31 = lane & 31, hf = lane >> 5;
    const float* CUM = (const float*)(p.ws + WS_CUM); const bf16_t* KA = (const bf16_t*)(p.ws + WS_KA); const bf16_t* VA = (const bf16_t*)(p.ws + WS_VA);
    const bf16_t* GA = (const bf16_t*)(p.ws + WS_GA); const bf16_t* SST = (const bf16_t*)(p.ws + WS_SST);
    const int trow = c * 64 + 32 * tt + l31;
    bf16_t* qap = (bf16_t*)(p.ws + WS_QOB) + (size_t)trow * 1024 + h * 128;
    const size_t hb = (size_t)h * T * 128;
    const float* cumt = CUM + hb + (size_t)trow * 128; const float* refp = CUM + hb + (size_t)(c * 64 + 32) * 128;
    bf16x8 qd1[8], qd2[8], kdt[8];
    const bf16_t* kat = KA + hb + (size_t)trow * 128;
#pragma unroll
    for (int ks = 0; ks < 8; ++ks) { const int k0 = 16 * ks + 8 * hf; const bf16x8 q8 = *(const bf16x8*)(qap + k0), k8 = *(const bf16x8*)(kat + k0);
        const f32x4 c0 = *(const f32x4*)(cumt + k0), c1 = *(const f32x4*)(cumt + k0 + 4), r0 = *(const f32x4*)(refp + k0), r1 = *(const f32x4*)(refp + k0 + 4);
        float a[8], b[8], d[8];
#pragma unroll
        for (int j = 0; j < 8; ++j) { const float q = bf2f(q8[j]), cu = j < 4 ? c0[j & 3] : c1[j & 3], rf = j < 4 ? r0[j & 3] : r1[j & 3]; a[j] = q * __expf(cu - rf); b[j] = q * __expf(cu); d[j] = bf2f(k8[j]) * __expf(rf - cu); }
        qd1[ks] = pack8f(a); qd2[ks] = pack8f(b); kdt[ks] = pack8f(d); }
    f32x16 OT[4];
#pragma unroll
    for (int vt = 0; vt < 4; ++vt) OT[vt] = zero16();
    const bf16_t* sp = SST + ((size_t)(c * 4 + h) * 128 + l31) * 128 + 8 * hf;
#pragma unroll
    for (int vt = 0; vt < 4; ++vt) {
#pragma unroll
        for (int ks = 0; ks < 8; ++ks) OT[vt] = MFMA32(*(const bf16x8*)(sp + (size_t)vt * 32 * 128 + 16 * ks), qd2[ks], OT[vt]);
        __builtin_amdgcn_sched_barrier(0); }
    const bf16x8 id0 = ident_frag(0, l31, hf), id1 = ident_frag(1, l31, hf);
    for (int st = 0; st <= tt; ++st) {
        const int srow = c * 64 + 32 * st + l31; const bf16_t* kap = KA + hb + (size_t)srow * 128; const float* cums = CUM + hb + (size_t)srow * 128;
        f32x16 X = zero16();
        if (st == tt) {
#pragma unroll
            for (int ks = 0; ks < 8; ++ks) X = MFMA32(kdt[ks], qd1[ks], X);
        } else
#pragma unroll
        for (int ks = 0; ks < 8; ++ks) { const int k0 = 16 * ks + 8 * hf; const bf16x8 k8 = *(const bf16x8*)(kap + k0);
            const f32x4 c0 = *(const f32x4*)(cums + k0), c1 = *(const f32x4*)(cums + k0 + 4), r0 = *(const f32x4*)(refp + k0), r1 = *(const f32x4*)(refp + k0 + 4);
            float a[8];
#pragma unroll
            for (int j = 0; j < 8; ++j) { const float cu = j < 4 ? c0[j & 3] : c1[j & 3], rf = j < 4 ? r0[j & 3] : r1[j & 3]; a[j] = bf2f(k8[j]) * __expf(rf - cu); }
            X = MFMA32(pack8f(a), qd1[ks], X); }
        if (st == tt) {
#pragma unroll
            for (int r = 0; r < 16; ++r) if (crow(r, hf) > l31) X[r] = 0.f; }
        const bf16x8 xf0 = pack8(X, 0), xf1 = pack8(X, 1);
        const bf16_t* vp = VA + hb + (size_t)(c * 64 + 32 * st) * 128 + hf * 256 + l31 * 8;
#pragma unroll
        for (int vt = 0; vt < 4; ++vt) { f32x16 vx = zero16(); vx = MFMA32(*(const bf16x8*)(vp + 1024 * vt), id0, vx); vx = MFMA32(*(const bf16x8*)(vp + 1024 * vt + 512), id1, vx);
            OT[vt] = MFMA32(pack8(vx, 0), xf0, OT[vt]); OT[vt] = MFMA32(pack8(vx, 1), xf1, OT[vt]); }
    }
    float ss = 0.f;
#pragma unroll
    for (int vt = 0; vt < 4; ++vt)
#pragma unroll
        for (int r = 0; r < 16; ++r) ss += OT[vt][r] * OT[vt][r];
    ss += __shfl_xor(ss, 32);
    const float rstd = __builtin_amdgcn_rsqf(ss * (1.f / 128.f) + EPS);
    const bf16_t* gap = GA + hb + (size_t)trow * 128; const float* onp = p.out_norm + h * 128;
    if (obase) qap = obase + (size_t)trow * 512 + h * 128;
#pragma unroll
    for (int vt = 0; vt < 4; ++vt)
#pragma unroll
        for (int g = 0; g < 4; g += 2) { u32x2 ga0, ga1; narrow_pair(*(const u32x4*)(gap + 32 * vt + 8 * (g + hf)), ga0, ga1);
            u32x2 o0, o1;
            { const int v0 = 32 * vt + 8 * g + 4 * hf; const f32x4 on = *(const f32x4*)(onp + v0);
              o0.x = pk2(OT[vt][4 * g] * rstd * on[0] * bflo(ga0.x), OT[vt][4 * g + 1] * rstd * on[1] * bfhi(ga0.x)); o0.y = pk2(OT[vt][4 * g + 2] * rstd * on[2] * bflo(ga0.y), OT[vt][4 * g + 3] * rstd * on[3] * bfhi(ga0.y)); }
            { const int v0 = 32 * vt + 8 * (g + 1) + 4 * hf; const f32x4 on = *(const f32x4*)(onp + v0);
              o1.x = pk2(OT[vt][4 * g + 4] * rstd * on[0] * bflo(ga1.x), OT[vt][4 * g + 5] * rstd * on[1] * bfhi(ga1.x)); o1.y = pk2(OT[vt][4 * g + 6] * rstd * on[2] * bflo(ga1.y), OT[vt][4 * g + 7] * rstd * on[3] * bfhi(ga1.y)); }
            *(u32x4*)(qap + 32 * vt + 8 * (g + hf)) = widen_pair(o0, o1); }
}


#define XB_TMO      128
#define XB_XCNT(j)  (256  + 64 * (j))
#define XB_XSUB(j)  (1280 + 64 * (j))
#define XB_XGEN(j)  (2304 + 64 * (j))
#define XB_TOP      3328
#define XB_TOPGEN   3392
#define XCD_BAR_WORDS 3456
#define XB_SPIN_CAP (1u << 18)
DI unsigned xb_ld(unsigned* p)              { return __hip_atomic_load(p, __ATOMIC_RELAXED, __HIP_MEMORY_SCOPE_AGENT); }
DI unsigned xb_add(unsigned* p, unsigned v) { return __hip_atomic_fetch_add(p, v, __ATOMIC_RELAXED, __HIP_MEMORY_SCOPE_AGENT); }
DI unsigned xb_xcc_id() { return (unsigned)__builtin_amdgcn_s_getreg((3 << 11) | 20) & 0xFu; }
#define XB_SPIN(cond, bar) do { unsigned _sp = 0; while (cond) { __builtin_amdgcn_s_sleep(1); \
    if ((++_sp & 255u) == 0u) { if (xb_ld(&(bar)[XB_TMO])) break; if (_sp > XB_SPIN_CAP) { atomicAdd(&(bar)[XB_TMO], 1u); break; } } } } while (0)
struct XcdBarrier { unsigned* bar; unsigned x; volatile LAS unsigned* st; };
DI XcdBarrier xcd_barrier_post(unsigned* bar, volatile LAS unsigned* st) {
    XcdBarrier b; b.bar = bar; b.x = xb_xcc_id(); b.st = st;
    if (threadIdx.x == 0) (void)xb_add(&bar[XB_XCNT(b.x)], 1u);
    return b;
}
DI void xcd_barrier_complete(unsigned* bar, unsigned x, unsigned& nloc, unsigned& nx) {
    const unsigned G = gridDim.x * gridDim.y * gridDim.z;
    unsigned sum, cnt, mine, sp = 0u;
    for (;;) {
        sum = 0u; cnt = 0u; mine = 0u;
#pragma unroll
        for (unsigned j = 0; j < 16; ++j) { const unsigned c = xb_ld(&bar[XB_XCNT(j)]); sum += c; cnt += (c > 0u) ? 1u : 0u; mine = (j == x) ? c : mine; }
        if (sum == G) break;
        __builtin_amdgcn_s_sleep(1);
        if ((++sp & 255u) == 0u) { if (xb_ld(&bar[XB_TMO])) break; if (sp > XB_SPIN_CAP) { atomicAdd(&bar[XB_TMO], 1u); break; } }
    }
    nloc = mine > 0u ? mine : 1u; nx = cnt > 0u ? cnt : 1u;
}
DI void xcd_barrier(const XcdBarrier& b) {
    asm volatile("s_waitcnt vmcnt(0)" ::: "memory");
    __syncthreads();
    if (threadIdx.x == 0) {
        unsigned* bar = b.bar;
        __builtin_amdgcn_s_waitcnt(0);
        unsigned nloc = b.st[0], nx = b.st[1];
        if (nloc == 0u) { xcd_barrier_complete(bar, b.x, nloc, nx); b.st[0] = nloc; b.st[1] = nx; }
        const unsigned old = xb_add(&bar[XB_XSUB(b.x)], 1u);
        const unsigned gen = old / nloc;
        if (old + 1u == (gen + 1u) * nloc) {
            __builtin_amdgcn_fence(__ATOMIC_RELEASE, "agent");
            asm volatile("s_waitcnt vmcnt(0)" ::: "memory");
            const unsigned og = xb_add(&bar[XB_TOP], 1u);
            const unsigned tg = og / nx;
            if (og + 1u == (tg + 1u) * nx) xb_add(&bar[XB_TOPGEN], 1u);
            else XB_SPIN(xb_ld(&bar[XB_TOPGEN]) == tg, bar);
            __builtin_amdgcn_fence(__ATOMIC_ACQUIRE, "agent");
            xb_add(&bar[XB_XGEN(b.x)], 1u);
            asm volatile("s_waitcnt vmcnt(0)" ::: "memory");
        } else {
            XB_SPIN(xb_ld(&bar[XB_XGEN(b.x)]) == gen, bar);
            __builtin_amdgcn_fence(__ATOMIC_ACQUIRE, "agent");
            asm volatile("s_waitcnt vmcnt(0)" ::: "memory");
        }
    }
    __syncthreads();
}

__global__ void __launch_bounds__(512, 2) fwd_megakernel(Params p) {
    extern __shared__ __attribute__((aligned(16))) unsigned char lds_raw[];
    LAS unsigned char* lds = (LAS unsigned char*)lds_raw;
    cg::grid_group grid = cg::this_grid();
    const int G = gridDim.x, bx = blockIdx.x;
    volatile LAS unsigned* bst = (volatile LAS unsigned*)(lds + LDS_ST_OFF);
    if (threadIdx.x < 2) bst[threadIdx.x] = 0u;
    __syncthreads();
    const XcdBarrier xbar = xcd_barrier_post((unsigned*)(p.ws + WS_BAR), bst);
    if (threadIdx.x == 0) bst[2] = xb_add((unsigned*)(p.ws + WS_BAR) + 3712 + xbar.x, 1u);
#define GRID_BAR() xcd_barrier(xbar)
    unsigned char* ws = p.ws;
    float* MOD = (float*)(ws + WS_MOD); bf16_t* H = (bf16_t*)(ws + WS_H);

    phase_prep(p, lds);
    grid.sync();
    { pg8::Gemm g{(const bf16_t*)(ws + WS_SC), (const bf16_t*)(ws + WS_WADA), 256, 6144, 1024}; pg8::StaticOrder S; S.init(256, 6144, G, bx);
      EpiMod E{MOD, p.b_ada}; pg8::gemm_phase<EpiMod, pg8::StaticOrder, true, true>(lds, g, S, E); }
    GRID_BAR();
    int cv = bx;
    { unsigned* barw = (unsigned*)(p.ws + WS_BAR); bool uni = (G & 7) == 0;
#pragma unroll
      for (int j = 0; j < 16; ++j) { const unsigned c = xb_ld(&barw[XB_XCNT(j)]); uni = uni && (j < 8 ? c == (unsigned)(G >> 3) : c == 0u); }
      if (uni) cv = (int)xbar.x + 8 * (int)bst[2];
      cv = __builtin_amdgcn_readfirstlane(cv); }
    phase_norm_mod(p.x_prompt, p.x_sample, p.norm_mix, MOD, 0, 1024, H);
#if PROBE_DUP == 1
    GRID_BAR(); phase_norm_mod(p.x_prompt, p.x_sample, p.norm_mix, MOD, 0, 1024, H);
#endif
#if PROBE_DUP == 10
    GRID_BAR(); GRID_BAR(); GRID_BAR(); GRID_BAR(); GRID_BAR(); GRID_BAR(); GRID_BAR(); GRID_BAR(); GRID_BAR(); GRID_BAR();
#endif
    GRID_BAR();
    { pg8::Gemm g{H, (const bf16_t*)(ws + WS_WIN), T, INC, 1024}; pg8::StaticOrder S; S.init(T, INC, G, cv);
      EpiIn E{(bf16_t*)(ws + WS_QOB), (bf16_t*)(ws + WS_KA), (bf16_t*)(ws + WS_VA), (bf16_t*)(ws + WS_GA), (bf16_t*)(ws + WS_KB), (bf16_t*)(ws + WS_VB),
              (bf16_t*)(p.out), (bf16_t*)(p.out) + (size_t)T * 1024, (float*)(ws + WS_CUM), (float*)(ws + WS_DEC), p.lb_logits, p.out};
      pg8::gemm_phase<EpiIn, pg8::StaticOrder, true, true>(lds, g, S, E);
#if PROBE_DUP == 2
      GRID_BAR(); pg8::gemm_phase<EpiIn, pg8::StaticOrder, true, true>(lds, g, S, E);
#endif
    }
    GRID_BAR();
    { const int tid = fresh_tid(), lane = tid & 63, wave = __builtin_amdgcn_readfirstlane(tid >> 6);
      for (int q = bx + G * (wave >> 2); q < NCH * 4; q += 2 * G) hgrn_u_item(p, q * 4 + (wave & 3), lane);
#if PROBE_DUP == 3
      for (int it = wave * G + bx; it < NCH * 16; it += 8 * G) hgrn_u_item(p, it, lane);
#endif
    }
    GRID_BAR();
    {
        const int tid = fresh_tid(), lane = tid & 63, wave = __builtin_amdgcn_readfirstlane(tid >> 6);
        LAS float* biasl = (LAS float*)lds;
        for (int i = tid; i < 8 * 192; i += 512) biasl[i] = p.rel_bias[i] * LOG2E;
        __syncthreads();
#if PROBE_DUP == 41
        if (wave == 0) { for (int it = bx; it < 512; it += G) scan_prompt_item(p, it, lane); }
        GRID_BAR();
#endif
        if (wave == 0) { for (int it = bx; it < 512; it += G) scan_prompt_item(p, it, lane); }
        else {
            const int gw = (wave - 1) * G + bx, NGW = 7 * G;
            for (int it = gw; it < 4096; it += NGW) scan_sample_item(p, it, lane);
            const int x = __builtin_amdgcn_readfirstlane((int)xbar.x), ncu = __builtin_amdgcn_readfirstlane((int)bst[0]), nxcc = __builtin_amdgcn_readfirstlane((int)bst[1]), j = __builtin_amdgcn_readfirstlane((int)bst[2]);
            if (nxcc == 8 && x < 8 && ncu > 0 && j < ncu) {
                const int nslot = 7 * ncu, slot = (wave - 1) * ncu + j;
                for (int idx = slot; idx < 68 * 8; idx += nslot) { const int cc = idx >> 3, c = cc < 4 ? 512 + 4 * x + cc : 64 * x + (cc - 4); attn_item(p, c * 8 + (idx & 7), lane, biasl); }
            } else for (int it = gw; it < NCH * 8; it += NGW) attn_item(p, it, lane, biasl);
        }
    }
    GRID_BAR();
    { const int tid = fresh_tid(), lane = tid & 63, wave = __builtin_amdgcn_readfirstlane(tid >> 6);
#if PROBE_DUP == 5
      for (int it = wave * G + bx; it < NCH * 8; it += 8 * G) hgrn_out_item(p, it, lane, (bf16_t*)(ws + WS_U));
      GRID_BAR();
#endif
      for (int it = wave * G + bx; it < NCH * 8; it += 8 * G) hgrn_out_item(p, it, lane); }
    GRID_BAR();
    { pg8::Gemm g{(const bf16_t*)(ws + WS_QOB), (const bf16_t*)(ws + WS_WAB), T, 1024, 1024}; pg8::StaticOrder S; S.init(T, 1024, G, cv);
      EpiMerge E{(const bf16_t*)(p.out), (const bf16_t*)(p.out) + (size_t)T * 1024, (bf16_t*)(ws + WS_M)};
      pg8::gemm_phase<EpiMerge, pg8::StaticOrder, true, true>(lds, g, S, E); }
    GRID_BAR();
    const bool split_ps = G >= 64;
    { pg8::Gemm g{(const bf16_t*)(ws + WS_M), (const bf16_t*)(ws + WS_WO), T, 1024, 1024}; EpiRes<false> E{p.x_prompt, p.x_sample, nullptr, (bf16_t*)(ws + WS_X1B), MOD + 2048};
      if (split_ps) {
        { pg8::StaticOrder S; S.init(TP, 1024, G, cv); pg8::gemm_phase<EpiRes<false>, pg8::StaticOrder, true, true>(lds, g, S, E); }
        GRID_BAR();
        if (bx < 32) { pg8::StaticOrder S; S.init(TS, 1024, 32, bx, TP / 256); pg8::gemm_phase<EpiRes<false>, pg8::StaticOrder, true, true>(lds, g, S, E); }
        else phase_norm_mod_b((const bf16_t*)(ws + WS_X1B), p.norm_ffn, MOD, 3072, 4096, H, 0, TP, 32);
        GRID_BAR();
        phase_norm_mod_b((const bf16_t*)(ws + WS_X1B), p.norm_ffn, MOD, 3072, 4096, H, TP, T, 0);
      } else {
        pg8::StaticOrder S; S.init(T, 1024, G, cv); pg8::gemm_phase<EpiRes<false>, pg8::StaticOrder, true, true>(lds, g, S, E);
        GRID_BAR();
        phase_norm_mod_b((const bf16_t*)(ws + WS_X1B), p.norm_ffn, MOD, 3072, 4096, H);
      } }
    GRID_BAR();
    { pg8::Gemm g{H, (const bf16_t*)(ws + WS_WFI), T, INC, 1024}; pg8::StaticOrder S; S.init(T, INC, G, cv);
      EpiFfnIn E{(bf16_t*)(ws + WS_HID)}; pg8::gemm_phase<EpiFfnIn, pg8::StaticOrder, true, true>(lds, g, S, E);
#if PROBE_DUP == 9
      GRID_BAR(); pg8::gemm_phase<EpiFfnIn, pg8::StaticOrder, true, true>(lds, g, S, E);
#endif
    }
    GRID_BAR();
    { pg8::Gemm g{(const bf16_t*)(ws + WS_HID), (const bf16_t*)(ws + WS_WFO), T, 1024, FF}; EpiRes<true> E{nullptr, nullptr, (const bf16_t*)(ws + WS_X1B), (bf16_t*)(ws + WS_X2B), MOD + 5120};
      if (split_ps) {
        { pg8::StaticOrder S; S.init(TP, 1024, G, cv); pg8::gemm_phase<EpiRes<true>, pg8::StaticOrder, true, true>(lds, g, S, E); }
        GRID_BAR();
        float* PART = (float*)(ws + WS_CUM + 20 * MiB);
        if (bx < 64) { const int ks = bx >> 5; pg8::Gemm gs{(const bf16_t*)(ws + WS_HID) + ks * (FF / 2), (const bf16_t*)(ws + WS_WFO) + ks * (FF / 2), T, 1024, FF / 2, FF};
            pg8::StaticOrder S; S.init(TS, 1024, 32, bx & 31, TP / 256); EpiPart EP{PART + (size_t)ks * TS * D, TP}; pg8::gemm_phase<EpiPart, pg8::StaticOrder, true, true>(lds, gs, S, EP); }
        else phase_final_norm((const bf16_t*)(ws + WS_X2B), p.out, p.norm_final, 0, TP, 64);
        GRID_BAR();
        phase_final_norm_parts((const bf16_t*)(ws + WS_X1B), PART, PART + (size_t)TS * D, MOD + 5120, p.out, p.norm_final);
      } else {
        pg8::StaticOrder S; S.init(T, 1024, G, cv); pg8::gemm_phase<EpiRes<true>, pg8::StaticOrder, true, true>(lds, g, S, E);
        GRID_BAR();
        phase_final_norm((const bf16_t*)(ws + WS_X2B), p.out, p.norm_final);
      } }
}

extern "C" void kernel_launch(void* const* d_in, const int* in_sizes, int n_in, void* d_out, int out_size, void* d_ws, size_t ws_size, hipStream_t stream) {
    static int grid = 0;
    if (grid == 0) {
        if (n_in != 21 || (size_t)out_size != OUT_TOTAL || ws_size < WS_END) { fprintf(stderr, "kernel_launch: unexpected sizes n_in %d out %d ws %zu\n", n_in, out_size, ws_size); grid = -1; return; }
        int dev = 0, cus = 0, per = 0;
        (void)hipGetDevice(&dev); (void)hipDeviceGetAttribute(&cus, hipDeviceAttributeMultiprocessorCount, dev);
        (void)hipFuncSetAttribute((const void*)fwd_megakernel, hipFuncAttributeMaxDynamicSharedMemorySize, LDS_BYTES);
        (void)hipOccupancyMaxActiveBlocksPerMultiprocessor(&per, (const void*)fwd_megakernel, 512, LDS_BYTES);
        if (per < 1) per = 1;
        grid = cus * per; fprintf(stderr, "kernel_launch: grid %d (cus %d x %d)\n", grid, cus, per);
    }
    if (grid < 0) return;
    if (hipMemsetAsync((char*)d_ws + WS_BAR, 0, BAR_BYTES, stream) != hipSuccess) { fprintf(stderr, "kernel_launch: memset failed\n"); return; }
    Params p{};
    const float** f = (const float**)&p;
    for (int i = 0; i < 21; ++i) f[i] = (const float*)d_in[i];
    p.out = (float*)d_out; p.ws = (unsigned char*)d_ws;
    void* args[] = {&p};
    hipError_t e = hipLaunchCooperativeKernel((const void*)fwd_megakernel, dim3(grid), dim3(512), args, LDS_BYTES, stream);
    if (e != hipSuccess) fprintf(stderr, "cooperative launch failed: %s (grid %d)\n", hipGetErrorString(e), grid);
}
```

```cpp
#include <hip/hip_runtime.h>
#include <hip/hip_cooperative_groups.h>
#include <cstdio>
#include <cstdint>
namespace cg = cooperative_groups;
#ifndef PROBE_DUP
#define PROBE_DUP 0
#endif

#define DI __device__ __forceinline__
#define LAS __attribute__((address_space(3)))
typedef unsigned short bf16_t;
typedef short bf16x8 __attribute__((ext_vector_type(8)));
typedef float f32x4 __attribute__((ext_vector_type(4)));
typedef float f32x2 __attribute__((ext_vector_type(2)));
typedef float f32x16 __attribute__((ext_vector_type(16)));
typedef unsigned u32x4 __attribute__((ext_vector_type(4)));
typedef unsigned u32x2 __attribute__((ext_vector_type(2)));
typedef __bf16 bf2_t __attribute__((ext_vector_type(2)));

constexpr int D = 1024, TP = 32768, TS = 2048, T = TP + TS, NCH = T / 64, NBATCH = 34;
constexpr int INC = 5632, FF = 2816;
constexpr float EPS = 1e-6f, LOG2E = 1.4426950408889634f;
constexpr size_t OFF_Y = 0, OFF_SP = (size_t)T * D, OFF_KP = OFF_SP + 131072, OFF_VP = OFF_KP + 524288, OFF_SS = OFF_VP + 524288,
                 OFF_KS = OFF_SS + 2097152, OFF_VS = OFF_KS + 1048576, OUT_TOTAL = OFF_VS + 1048576;
constexpr size_t MiB = 1u << 20;
constexpr size_t WS_MOD = 1 * MiB, WS_DEC = 2 * MiB, WS_SC = 4 * MiB, WS_WADA = 5 * MiB, WS_WIN = 17 * MiB, WS_WAB = 28 * MiB, WS_WO = 30 * MiB,
                 WS_WFI = 32 * MiB, WS_WFO = 43 * MiB, WS_H = 50 * MiB, WS_QOB = 118 * MiB, WS_KA = 186 * MiB, WS_VA = 220 * MiB, WS_GA = 254 * MiB,
                 WS_KB = 288 * MiB, WS_VB = 322 * MiB, WS_CUM = 356 * MiB, WS_SST = 424 * MiB, WS_END = 492 * MiB;
constexpr size_t WS_U = WS_H, WS_M = WS_KA, WS_HID = WS_KA, WS_X1B = WS_QOB, WS_X2B = WS_H;
constexpr size_t WS_BAR = 0, BAR_BYTES = 16384;
constexpr int LDS_BYTES = 140 * 1024, LDS_ST_OFF = 136 * 1024;

struct Params {
    const float *x_prompt, *x_sample, *c_prompt, *c_sample, *state, *cache_k, *cache_v, *w_ada, *b_ada, *norm_mix, *w_in, *lb_logits, *out_norm,
                *w_a, *rel_bias, *w_b, *w_out, *norm_ffn, *w_ffn_in, *w_ffn_out, *norm_final;
    float* out; unsigned char* ws;
};

DI int fresh_tid() { int t = threadIdx.x; asm volatile("" : "+v"(t)); return t; }
DI int launder(int v) { asm volatile("" : "+v"(v)); return v; }
DI unsigned pk2(float a, float b) { f32x2 v = {a, b}; bf2_t r = __builtin_convertvector(v, bf2_t); return __builtin_bit_cast(unsigned, r); }
DI float bflo(unsigned u) { return __uint_as_float(u << 16); }
DI float bfhi(unsigned u) { return __uint_as_float(u & 0xffff0000u); }
DI float bf2f(short s) { return __uint_as_float(((unsigned)(unsigned short)s) << 16); }
DI float sigm(float x) { return __builtin_amdgcn_rcpf(1.f + __expf(-x)); }
DI float silu(float x) { return x * sigm(x); }
DI int batch_of(int r) { return r < TP ? (r >> 14) : 2 + ((r - TP) >> 6); }
DI int crow(int reg, int h) { return (reg & 3) + 8 * (reg >> 2) + 4 * h; }
DI bf16x8 pack8(const f32x16& x, int s) {
    u32x4 p; p.x = pk2(x[8 * s], x[8 * s + 1]); p.y = pk2(x[8 * s + 2], x[8 * s + 3]); p.z = pk2(x[8 * s + 4], x[8 * s + 5]); p.w = pk2(x[8 * s + 6], x[8 * s + 7]);
    return __builtin_bit_cast(bf16x8, p);
}
DI bf16x8 pack8f(const float* v) { u32x4 p; p.x = pk2(v[0], v[1]); p.y = pk2(v[2], v[3]); p.z = pk2(v[4], v[5]); p.w = pk2(v[6], v[7]); return __builtin_bit_cast(bf16x8, p); }
DI bf16x8 ident_frag(int ks, int l31, int hf) {
    const int jj = l31 - 16 * ks - 8 * hf; bf16x8 r;
#pragma unroll
    for (int j = 0; j < 8; ++j) r[j] = (j == jj) ? (short)0x3F80 : (short)0;
    return r;
}
DI u32x4 widen_pair(u32x2 pg, u32x2 pg1) { const auto rx = __builtin_amdgcn_permlane32_swap(pg.x, pg1.x, false, false), ry = __builtin_amdgcn_permlane32_swap(pg.y, pg1.y, false, false); return (u32x4){rx[0], ry[0], rx[1], ry[1]}; }
DI void narrow_pair(u32x4 d, u32x2& pg, u32x2& pg1) { const auto rx = __builtin_amdgcn_permlane32_swap(d.x, d.z, false, false), ry = __builtin_amdgcn_permlane32_swap(d.y, d.w, false, false); pg = (u32x2){rx[0], ry[0]}; pg1 = (u32x2){rx[1], ry[1]}; }
#define MFMA32(a, b, c) __builtin_amdgcn_mfma_f32_32x32x16_bf16((a), (b), (c), 0, 0, 0)
DI f32x16 zero16() { f32x16 z;
#pragma unroll
    for (int i = 0; i < 16; ++i) z[i] = 0.f; return z; }

namespace pg8 {
constexpr int BM = 256, BK = 64, HALF = 128, HTB = HALF * BK * 2, STAGE_BYTES = 8 * HTB, NXCD = 8, WGM = 8;
__host__ __device__ __forceinline__ int lds_byte(int r, int c) { const int st = (r >> 4) * 2 + (c >> 5), rr = r & 15, cc = c & 31, ob = rr * 64 + cc * 2; return st * 1024 + (ob ^ (((ob >> 9) & 1) << 5)); }
__host__ __device__ __forceinline__ void stage_rc(int b, int& R, int& C) { const int st = b / 1024, sb = b % 1024, swz = sb ^ (((sb >> 9) & 1) << 5); R = (st >> 1) * 16 + swz / 64; C = (st & 1) * 32 + (swz % 64) / 2; }
__host__ __device__ __forceinline__ int perm32(int rho) { const int n = rho >> 4, i = rho & 15; return 8 * (i >> 2) + 4 * n + (i & 3); }
struct Unit { int pm, pn; };
struct Gemm { const bf16_t* A; const bf16_t* Bt; int M, N, K, ld; };
struct StaticOrder {
    int nM, nN, nwg, G, c, pm_off;
    __device__ void init(int M, int N, int G_, int c_, int pm_off_ = 0) { nM = M / BM; nN = N / BM; nwg = nM * nN; G = G_; c = c_; pm_off = pm_off_; }
    __device__ bool next(int i, Unit& u) const {
        const long L = (long)i * G + c; if (L >= nwg) return false;
        int wgid = (int)L; { const int q = nwg / NXCD, r = nwg % NXCD, xcd = wgid % NXCD, off = wgid / NXCD; wgid = (xcd < r ? xcd * (q + 1) : r * (q + 1) + (xcd - r) * q) + off; }
        const int nig = WGM * nN, gid = wgid / nig, fm = gid * WGM, gsz = (nM - fm) < WGM ? (nM - fm) : WGM;
        u.pm = pm_off + fm + ((wgid % nig) % gsz); u.pn = (wgid % nig) / gsz; return true;
    }
};
template <class Epi, class Sched, bool ALIGN_EPI = false, bool SP2 = false>
__device__ __forceinline__ void gemm_phase(LAS unsigned char* lds, const Gemm g, const Sched& S, const Epi& E) {
    const int tid = fresh_tid(), wid = __builtin_amdgcn_readfirstlane(tid >> 6), lane = tid & 63, wr = wid >> 2, wc = wid & 3, fr = lane & 15, fq = lane >> 4;
    const int K = g.ld ? g.ld : g.K, nt = g.K / BK;
    unsigned voffA[2], voffB[2];
#pragma unroll
    for (int i = 0; i < 2; ++i) { int R, C; stage_rc(tid * 16 + i * 8192, R, C); const int Rb = Epi::PERM ? ((R & ~31) + perm32(R & 31)) : R;
        voffA[i] = (unsigned)(R * K + C) * 2u; voffB[i] = (unsigned)(Rb * K + C) * 2u; }
    const size_t kstep = (size_t)(BK * 2);
    const size_t hstep = (size_t)HALF * K * 2;
    const size_t tstep = 2 * hstep;
    const unsigned ldsw = (unsigned)wid * 1024u;
    const int aoff = lds_byte(wr * 64 + fr, fq * 8), boff = lds_byte(wc * 32 + fr, fq * 8);
#define PG8_SA(b, h) (((b) * 2 + (h)) * HTB)
#define PG8_SB(b, h) ((4 + (b) * 2 + (h)) * HTB)
#define PG8_STAGE(bufoff, gbase, voff) do { _Pragma("unroll") for (int _i = 0; _i < 2; ++_i) \
        __builtin_amdgcn_global_load_lds((const unsigned*)((const char*)(gbase) + (voff)[_i]), (LAS unsigned*)(lds + (bufoff) + ldsw + _i * 8192), 16, 0, 0); } while (0)
#define PG8_LDA(dst, b, h) do { _Pragma("unroll") for (int m = 0; m < 4; ++m) _Pragma("unroll") for (int k = 0; k < 2; ++k) dst[m][k] = *(const LAS bf16x8*)(lds + PG8_SA(b, h) + aoff + m * 2048 + k * 1024); } while (0)
#define PG8_LDB(dst, b, h) do { _Pragma("unroll") for (int n = 0; n < 2; ++n) _Pragma("unroll") for (int k = 0; k < 2; ++k) dst[n][k] = *(const LAS bf16x8*)(lds + PG8_SB(b, h) + boff + n * 2048 + k * 1024); } while (0)
#define PG8_MMA(ai, bj, At, Bt) do { __builtin_amdgcn_s_setprio(1); _Pragma("unroll") for (int m = 0; m < 4; ++m) _Pragma("unroll") for (int n = 0; n < 2; ++n) _Pragma("unroll") for (int k = 0; k < 2; ++k) \
        acc[ai][bj][m][n] = __builtin_amdgcn_mfma_f32_16x16x32_bf16(Bt[n][k], At[m][k], acc[ai][bj][m][n], 0, 0, 0); __builtin_amdgcn_s_setprio(0); } while (0)
#define PG8_WAIT_V(n) asm volatile("s_waitcnt vmcnt(" #n ")" ::: "memory")
#define PG8_WAIT_L(n) asm volatile("s_waitcnt lgkmcnt(" #n ")" ::: "memory")
#define PG8_BAR __builtin_amdgcn_s_barrier()
#define PG8_SCHED __builtin_amdgcn_sched_barrier(0)
    Unit cur, nxt; int ui = 0;
    if (!S.next(0, cur)) return;
    f32x4 acc[2][2][4][2];
#pragma unroll
    for (int a = 0; a < 2; ++a)
#pragma unroll
        for (int b = 0; b < 2; ++b)
#pragma unroll
            for (int m = 0; m < 4; ++m)
#pragma unroll
                for (int n = 0; n < 2; ++n) acc[a][b][m][n] = (f32x4){0.f, 0.f, 0.f, 0.f};
    bf16x8 At[4][2], B0[2][2], B1[2][2];
    const char* cA = (const char*)g.A + (size_t)cur.pm * tstep; const char* cB = (const char*)g.Bt + (size_t)cur.pn * tstep;
    if constexpr (SP2) {
        PG8_STAGE(PG8_SB(0, 0), cB, voffB); PG8_STAGE(PG8_SB(0, 1), cB + hstep, voffB); PG8_STAGE(PG8_SA(0, 0), cA, voffA); PG8_STAGE(PG8_SA(0, 1), cA + hstep, voffA);
        if (wr == 1) PG8_BAR;
        PG8_WAIT_V(2); PG8_BAR;
        PG8_STAGE(PG8_SB(1, 0), cB + kstep, voffB); PG8_STAGE(PG8_SA(1, 0), cA + kstep, voffA); PG8_STAGE(PG8_SB(1, 1), cB + hstep + kstep, voffB);
        PG8_WAIT_V(6); PG8_BAR;
    } else {
        PG8_STAGE(PG8_SB(0, 0), cB, voffB); PG8_STAGE(PG8_SA(0, 0), cA, voffA); PG8_STAGE(PG8_SB(0, 1), cB + hstep, voffB); PG8_STAGE(PG8_SA(0, 1), cA + hstep, voffA);
        if (wr == 1) PG8_BAR;
        PG8_WAIT_V(4); PG8_BAR;
        PG8_STAGE(PG8_SB(1, 0), cB + kstep, voffB); PG8_STAGE(PG8_SA(1, 0), cA + kstep, voffA); PG8_STAGE(PG8_SB(1, 1), cB + hstep + kstep, voffB);
        PG8_WAIT_V(6); PG8_BAR;
    }
    for (;;) {
        const bool has_next = S.next(ui + 1, nxt);
        const char* nA = has_next ? (const char*)g.A + (size_t)nxt.pm * tstep : cA; const char* nB = has_next ? (const char*)g.Bt + (size_t)nxt.pn * tstep : cB;
        for (int t = 0; t < nt; t += 2) {
            if constexpr (Epi::MIDK) { if (t == nt / 2) E.mid(acc, cur, wr, wc, fr, fq); }
            const bool last = (t == nt - 2);
            const char* a1 = cA + (size_t)(t + 1) * kstep;
            const char* a2 = last ? nA : cA + (size_t)(t + 2) * kstep; const char* b2 = last ? nB : cB + (size_t)(t + 2) * kstep;
            const char* a3 = a2 + kstep; const char* b3 = b2 + kstep;
            if constexpr (SP2) {
            PG8_LDB(B0, 0, 0); PG8_LDB(B1, 0, 1); PG8_SCHED; PG8_LDA(At, 0, 0); PG8_STAGE(PG8_SA(1, 1), a1 + hstep, voffA);
            PG8_WAIT_V(8); PG8_WAIT_L(0); PG8_BAR; PG8_MMA(0, 0, At, B0); PG8_MMA(0, 1, At, B1); PG8_BAR; PG8_SCHED;
            PG8_LDA(At, 0, 1); PG8_STAGE(PG8_SB(0, 0), b2, voffB); PG8_STAGE(PG8_SB(0, 1), b2 + hstep, voffB); PG8_STAGE(PG8_SA(0, 0), a2, voffA);
            PG8_WAIT_V(8); PG8_WAIT_L(0); PG8_BAR; PG8_MMA(1, 0, At, B0); PG8_MMA(1, 1, At, B1); PG8_BAR; PG8_SCHED;
            PG8_LDB(B0, 1, 0); PG8_LDB(B1, 1, 1); PG8_SCHED; PG8_LDA(At, 1, 0); PG8_STAGE(PG8_SA(0, 1), a2 + hstep, voffA);
            PG8_WAIT_V(8); PG8_WAIT_L(0); PG8_BAR; PG8_MMA(0, 0, At, B0); PG8_MMA(0, 1, At, B1); PG8_BAR; PG8_SCHED;
            PG8_LDA(At, 1, 1); PG8_STAGE(PG8_SB(1, 0), b3, voffB); PG8_STAGE(PG8_SB(1, 1), b3 + hstep, voffB); PG8_STAGE(PG8_SA(1, 0), a3, voffA);
            PG8_WAIT_V(8); PG8_WAIT_L(0); PG8_BAR; PG8_MMA(1, 0, At, B0); PG8_MMA(1, 1, At, B1); PG8_BAR; PG8_SCHED;
            } else {
            PG8_LDB(B0, 0, 0); PG8_SCHED; PG8_LDA(At, 0, 0); PG8_STAGE(PG8_SA(1, 1), a1 + hstep, voffA);
            PG8_WAIT_L(8); PG8_BAR; PG8_WAIT_L(0); PG8_MMA(0, 0, At, B0); PG8_BAR; PG8_SCHED;
            PG8_LDB(B1, 0, 1); PG8_STAGE(PG8_SB(0, 0), b2, voffB);
            PG8_BAR; PG8_WAIT_L(0); PG8_MMA(0, 1, At, B1); PG8_BAR;
            PG8_LDA(At, 0, 1); PG8_STAGE(PG8_SA(0, 0), a2, voffA);
            PG8_BAR; PG8_WAIT_L(0); PG8_MMA(1, 0, At, B0); PG8_BAR; PG8_SCHED;
            PG8_STAGE(PG8_SB(0, 1), b2 + hstep, voffB);
            PG8_WAIT_V(6); PG8_BAR; PG8_MMA(1, 1, At, B1); PG8_BAR;
            PG8_LDB(B0, 1, 0); PG8_SCHED; PG8_LDA(At, 1, 0); PG8_STAGE(PG8_SA(0, 1), a2 + hstep, voffA);
            PG8_WAIT_L(8); PG8_BAR; PG8_WAIT_L(0); PG8_MMA(0, 0, At, B0); PG8_BAR; PG8_SCHED;
            PG8_LDB(B1, 1, 1); PG8_STAGE(PG8_SB(1, 0), b3, voffB);
            PG8_BAR; PG8_WAIT_L(0); PG8_MMA(0, 1, At, B1); PG8_BAR;
            PG8_LDA(At, 1, 1); PG8_STAGE(PG8_SA(1, 0), a3, voffA);
            PG8_BAR; PG8_WAIT_L(0); PG8_MMA(1, 0, At, B0); PG8_BAR; PG8_SCHED;
            PG8_STAGE(PG8_SB(1, 1), b3 + hstep, voffB);
            PG8_WAIT_V(6); PG8_BAR; PG8_MMA(1, 1, At, B1); PG8_BAR;
            }
        }
        if constexpr (ALIGN_EPI) { if (wr == 0) PG8_BAR; }
        E(acc, cur, wr, wc, fr, fq);
        if (!has_next) break;
#pragma unroll
        for (int a = 0; a < 2; ++a)
#pragma unroll
            for (int b = 0; b < 2; ++b)
#pragma unroll
                for (int m = 0; m < 4; ++m)
#pragma unroll
                    for (int n = 0; n < 2; ++n) acc[a][b][m][n] = (f32x4){0.f, 0.f, 0.f, 0.f};
        cur = nxt; cA = nA; cB = nB; ++ui;
        if constexpr (ALIGN_EPI) { if (wr == 1) PG8_BAR; }
    }
    PG8_WAIT_V(0);
    if constexpr (!ALIGN_EPI) { if (wr == 0) PG8_BAR; }
    PG8_BAR;
#undef PG8_SA
#undef PG8_SB
#undef PG8_STAGE
#undef PG8_LDA
#undef PG8_LDB
#undef PG8_MMA
#undef PG8_WAIT_V
#undef PG8_WAIT_L
#undef PG8_BAR
#undef PG8_SCHED
}
}
using pg8::Unit;
typedef f32x4 Acc[2][2][4][2];

DI u32x4 pack_row8(const f32x4& v0, const f32x4& v1) { u32x4 w; w.x = pk2(v0[0], v0[1]); w.y = pk2(v0[2], v0[3]); w.z = pk2(v1[0], v1[1]); w.w = pk2(v1[2], v1[3]); return w; }

struct EpiMod {
    static constexpr bool PERM = false, MIDK = false;
    float* mod; const float* bias;
    DI void operator()(Acc& acc, const Unit& u, int wr, int wc, int fr, int fq) const {
        { const int t_ = fresh_tid(); fr = t_ & 15; fq = (t_ >> 4) & 3; }
        if (u.pm != 0 || wr != 0) return;
#pragma unroll
        for (int m = 0; m < 3; ++m) { const int r = 16 * m + fr; if (r < NBATCH) {
#pragma unroll
            for (int bj = 0; bj < 2; ++bj)
#pragma unroll
                for (int n = 0; n < 2; ++n) { const int col = u.pn * 256 + bj * 128 + wc * 32 + n * 16 + 4 * fq;
                    *(f32x4*)(mod + (size_t)r * 6144 + col) = acc[0][bj][m][n] + *(const f32x4*)(bias + col); } } }
    }
};

struct EpiIn {
    static constexpr bool PERM = true, MIDK = false;
    bf16_t *QOB, *KA, *VA, *GA, *KB, *VB, *SGA, *SGB; float *CUM, *DEC; const float* lbl; float* out;
    DI void operator()(Acc& acc, const Unit& u, int wr, int wc, int fr, int fq) const {
        { const int t_ = fresh_tid(); fr = t_ & 15; fq = (t_ >> 4) & 3; }
        const int pn = u.pn, rt = wr * 64 + fr, row0 = u.pm * 256 + rt, cw = wc * 32 + 8 * fq, lane = fq * 16 + fr;
        if (pn >= 14) {
            const size_t o0 = ((size_t)(u.pm * 8 + (pn - 14)) * 8 * 512 + (size_t)(wr * 4 + wc) * 64 + lane) * 8;
#pragma unroll
            for (int ai = 0; ai < 2; ++ai)
#pragma unroll
                for (int m = 0; m < 4; ++m) { f32x4 r0, r1, b0, b1;
#pragma unroll
                    for (int j = 0; j < 4; ++j) { b0[j] = fmaxf(sigm(acc[ai][1][m][0][j]), 1e-30f); b1[j] = fmaxf(sigm(acc[ai][1][m][1][j]), 1e-30f);
                        r0[j] = sigm(acc[ai][0][m][0][j]) * __builtin_amdgcn_rcpf(b0[j]); r1[j] = sigm(acc[ai][0][m][1][j]) * __builtin_amdgcn_rcpf(b1[j]); }
                    const size_t o = o0 + (size_t)(ai * 4 + m) * 512 * 8;
                    *(u32x4*)(SGA + o) = pack_row8(r0, r1); *(u32x4*)(SGB + o) = pack_row8(b0, b1); __builtin_amdgcn_sched_barrier(0); }
            return;
        }
        const int seg = pn >> 1, col0 = (pn & 1) * 256 + cw;
        if (seg == 1) {
#pragma unroll
            for (int bj = 0; bj < 2; ++bj) {
                float lb[2][4];
#pragma unroll
                for (int n = 0; n < 2; ++n)
#pragma unroll
                    for (int j = 0; j < 4; ++j) { const int c = col0 + bj * 128 + 4 * n + j; lb[n][j] = __builtin_amdgcn_rcpf(1.f + __expf(lbl[512 + c] - lbl[c])); }
#pragma unroll
                for (int ai = 0; ai < 2; ++ai) {
                    const size_t rbase = ((size_t)((pn & 1) * 2 + bj) * T + (u.pm * 256 + ai * 128 + wr * 64 + launder(fr))) * 128 + cw;
#pragma unroll
                    for (int m = 0; m < 4; ++m) { f32x4 k0, k1;
#pragma unroll
                        for (int j = 0; j < 4; ++j) {
                            float f = lb[0][j] + (1.f - lb[0][j]) * sigm(acc[ai][bj][m][0][j]); k0[j] = 1.f - f; acc[ai][bj][m][0][j] = __logf(f);
                            f = lb[1][j] + (1.f - lb[1][j]) * sigm(acc[ai][bj][m][1][j]); k1[j] = 1.f - f; acc[ai][bj][m][1][j] = __logf(f); }
                        *(u32x4*)(KA + rbase + (size_t)m * 16 * 128) = pack_row8(k0, k1); }
                    __builtin_amdgcn_sched_barrier(0);
#pragma unroll
                    for (int n = 0; n < 2; ++n)
#pragma unroll
                        for (int j = 0; j < 4; ++j) { float carry = 0.f;
#pragma unroll
                            for (int m = 0; m < 4; ++m) { float v = acc[ai][bj][m][n][j];
                                v += __int_as_float(__builtin_amdgcn_update_dpp(0, __float_as_int(v), 0x111, 0xf, 0xf, false));
                                v += __int_as_float(__builtin_amdgcn_update_dpp(0, __float_as_int(v), 0x112, 0xf, 0xf, false));
                                v += __int_as_float(__builtin_amdgcn_update_dpp(0, __float_as_int(v), 0x114, 0xf, 0xf, false));
                                v += __int_as_float(__builtin_amdgcn_update_dpp(0, __float_as_int(v), 0x118, 0xf, 0xf, false));
                                v += carry; carry = __shfl(v, lane | 15); acc[ai][bj][m][n][j] = v; } }
                    __builtin_amdgcn_sched_barrier(0);
#pragma unroll
                    for (int m = 0; m < 4; ++m) { float* cp = CUM + rbase + (size_t)m * 16 * 128; *(f32x4*)cp = acc[ai][bj][m][0]; *(f32x4*)(cp + 4) = acc[ai][bj][m][1]; }
                    if (fr == 15) {
#pragma unroll
                        for (int n = 0; n < 2; ++n) { f32x4 e;
#pragma unroll
                            for (int j = 0; j < 4; ++j) e[j] = __expf(acc[ai][bj][3][n][j]);
                            *(f32x4*)(DEC + (size_t)(u.pm * 4 + ai * 2 + wr) * 512 + col0 + bj * 128 + 4 * n) = e; } }
                    __builtin_amdgcn_sched_barrier(0);
                }
            }
            return;
        }
        bf16_t* dst; int pitch = 512; size_t bjoff = 128; float* o32 = nullptr;
        switch (seg) {
            case 0: dst = QOB + col0; pitch = 1024; break;
            case 2: dst = VA + (size_t)((pn & 1) * 2) * T * 128 + (cw >> 3) * 256; bjoff = (size_t)T * 128; break;
            case 3: dst = GA + (size_t)((pn & 1) * 2) * T * 128 + cw; pitch = 128; bjoff = (size_t)T * 128; break;
            case 4: dst = QOB + 512 + col0; pitch = 1024; break;
            default: dst = (seg == 5 ? KB : VB) + (size_t)((pn & 1) * 4 + (wc >> 1)) * (T / 32) * 2048 + ((wc & 1) * 4 + fq) * 256; bjoff = (size_t)2 * (T / 32) * 2048; break;
        }
        if (seg >= 5) {
            if (u.pm >= 128) o32 = out + (seg == 5 ? OFF_KS : OFF_VS) + (size_t)((u.pm - 128) * 256 + rt) * 512 + col0;
            else if ((u.pm & 63) >= 62) o32 = out + (seg == 5 ? OFF_KP : OFF_VP) + (size_t)((u.pm >> 6) * 512 + ((u.pm & 63) - 62) * 256 + rt) * 512 + col0;
        }
        const bool act = (seg == 0 || seg == 3);
#pragma unroll
        for (int ai = 0; ai < 2; ++ai)
#pragma unroll
            for (int m = 0; m < 4; ++m)
#pragma unroll
                for (int bj = 0; bj < 2; ++bj) { f32x4 v0 = acc[ai][bj][m][0], v1 = acc[ai][bj][m][1];
                    if (act) {
#pragma unroll
                        for (int j = 0; j < 4; ++j) { v0[j] = silu(v0[j]); v1[j] = silu(v1[j]); } }
                    const size_t ro = seg >= 5 ? (size_t)(u.pm * 8 + 2 * wr + 4 * ai + (m >> 1)) * 2048 + ((m & 1) * 16 + fr) * 8 : seg == 2 ? (size_t)(u.pm * 8 + 2 * wr + 4 * ai + (m >> 1)) * 4096 + ((m & 1) * 16 + fr) * 8 : (size_t)(row0 + ai * 128 + m * 16) * pitch;
                    *(u32x4*)(dst + ro + bj * bjoff) = pack_row8(v0, v1);
                    if (o32) { float* op = o32 + (size_t)(ai * 128 + m * 16) * 512 + bj * 128; *(f32x4*)op = v0; *(f32x4*)(op + 4) = v1; } __builtin_amdgcn_sched_barrier(0); }
    }
};

struct EpiMerge {
    static constexpr bool PERM = true, MIDK = true;
    const bf16_t *SGR, *SGB; bf16_t* Mo;
    DI void mid(Acc& acc, const Unit& u, int wr, int wc, int fr, int fq) const {
        { const int t_ = fresh_tid(); fr = t_ & 15; fq = (t_ >> 4) & 3; }
        const size_t gb = ((size_t)(u.pm * 8 + 2 * u.pn) * 8 * 512 + (size_t)(wr * 4 + wc) * 64 + (fq * 16 + fr)) * 8;
#pragma unroll
        for (int ai = 0; ai < 2; ++ai) { u32x4 a[4][2];
#pragma unroll
            for (int m = 0; m < 4; ++m)
#pragma unroll
                for (int bj = 0; bj < 2; ++bj) a[m][bj] = *(const u32x4*)(SGR + gb + ((size_t)bj * 8 + ai * 4 + m) * 512 * 8);
#pragma unroll
            for (int m = 0; m < 4; ++m)
#pragma unroll
                for (int bj = 0; bj < 2; ++bj)
#pragma unroll
                    for (int j = 0; j < 4; ++j) { acc[ai][bj][m][j >> 1][(j & 1) * 2] *= bflo(a[m][bj][j]); acc[ai][bj][m][j >> 1][(j & 1) * 2 + 1] *= bfhi(a[m][bj][j]); }
            __builtin_amdgcn_sched_barrier(0); }
    }
    DI void operator()(Acc& acc, const Unit& u, int wr, int wc, int fr, int fq) const {
        { const int t_ = fresh_tid(); fr = t_ & 15; fq = (t_ >> 4) & 3; }
        const size_t base = (size_t)(u.pm * 256 + wr * 64 + fr) * 1024 + u.pn * 256 + wc * 32 + 8 * fq;
        const size_t gb = ((size_t)(u.pm * 8 + 2 * u.pn) * 8 * 512 + (size_t)(wr * 4 + wc) * 64 + (fq * 16 + fr)) * 8;
#pragma unroll
        for (int ai = 0; ai < 2; ++ai) { u32x4 b[4][2];
#pragma unroll
            for (int m = 0; m < 4; ++m)
#pragma unroll
                for (int bj = 0; bj < 2; ++bj) b[m][bj] = *(const u32x4*)(SGB + gb + ((size_t)bj * 8 + ai * 4 + m) * 512 * 8);
#pragma unroll
            for (int m = 0; m < 4; ++m)
#pragma unroll
                for (int bj = 0; bj < 2; ++bj) { f32x4 v0 = acc[ai][bj][m][0], v1 = acc[ai][bj][m][1]; const u32x4 g = b[m][bj];
                    v0[0] *= bflo(g[0]); v0[1] *= bfhi(g[0]); v0[2] *= bflo(g[1]); v0[3] *= bfhi(g[1]);
                    v1[0] *= bflo(g[2]); v1[1] *= bfhi(g[2]); v1[2] *= bflo(g[3]); v1[3] *= bfhi(g[3]);
                    *(u32x4*)(Mo + base + (size_t)(ai * 128 + m * 16) * 1024 + bj * 128) = pack_row8(v0, v1); }
            __builtin_amdgcn_sched_barrier(0); }
    }
};

template <bool BASE_BF16> struct EpiRes {
    static constexpr bool PERM = true, MIDK = false;
    const float *xp, *xs; const bf16_t* xb; bf16_t* xo; const float* gmod;
    DI void operator()(Acc& acc, const Unit& u, int wr, int wc, int fr, int fq) const {
        { const int t_ = fresh_tid(); fr = t_ & 15; fq = (t_ >> 4) & 3; }
        const int colb = u.pn * 256 + wc * 32 + 8 * fq;
#pragma unroll
        for (int ai = 0; ai < 2; ++ai) { const int r0 = u.pm * 256 + ai * 128 + wr * 64 + fr;
            const float* g = gmod + (size_t)batch_of(r0) * 6144 + colb;
            f32x4 gv[2][2];
#pragma unroll
            for (int bj = 0; bj < 2; ++bj) { gv[bj][0] = *(const f32x4*)(g + bj * 128); gv[bj][1] = *(const f32x4*)(g + bj * 128 + 4); }
            bf16_t* orow = xo + (size_t)r0 * D + colb;
            if constexpr (BASE_BF16) {
                const bf16_t* xr = xb + (size_t)r0 * D + colb; u32x4 xv[4][2];
#pragma unroll
                for (int m = 0; m < 4; ++m)
#pragma unroll
                    for (int bj = 0; bj < 2; ++bj) xv[m][bj] = *(const u32x4*)(xr + (size_t)m * 16 * D + bj * 128);
#pragma unroll
                for (int m = 0; m < 4; ++m)
#pragma unroll
                    for (int bj = 0; bj < 2; ++bj) { const u32x4 x = xv[m][bj]; const f32x4 a0 = acc[ai][bj][m][0] * gv[bj][0], a1 = acc[ai][bj][m][1] * gv[bj][1];
                        f32x4 v0 = {bflo(x[0]) + a0[0], bfhi(x[0]) + a0[1], bflo(x[1]) + a0[2], bfhi(x[1]) + a0[3]}, v1 = {bflo(x[2]) + a1[0], bfhi(x[2]) + a1[1], bflo(x[3]) + a1[2], bfhi(x[3]) + a1[3]};
                        *(u32x4*)(orow + (size_t)m * 16 * D + bj * 128) = pack_row8(v0, v1); }
            } else {
                const float* xr = (r0 < TP ? xp + (size_t)r0 * D : xs + (size_t)(r0 - TP) * D) + colb; f32x4 xv[4][2][2];
#pragma unroll
                for (int m = 0; m < 4; ++m)
#pragma unroll
                    for (int bj = 0; bj < 2; ++bj) { xv[m][bj][0] = *(const f32x4*)(xr + (size_t)m * 16 * D + bj * 128); xv[m][bj][1] = *(const f32x4*)(xr + (size_t)m * 16 * D + bj * 128 + 4); }
#pragma unroll
                for (int m = 0; m < 4; ++m)
#pragma unroll
                    for (int bj = 0; bj < 2; ++bj) *(u32x4*)(orow + (size_t)m * 16 * D + bj * 128) = pack_row8(xv[m][bj][0] + gv[bj][0] * acc[ai][bj][m][0], xv[m][bj][1] + gv[bj][1] * acc[ai][bj][m][1]);
            }
            __builtin_amdgcn_sched_barrier(0); }
    }
};

struct EpiPart {
    static constexpr bool PERM = false, MIDK = false;
    float* part; int row0;
    DI void operator()(Acc& acc, const Unit& u, int wr, int wc, int fr, int fq) const {
        { const int t_ = fresh_tid(); fr = t_ & 15; fq = (t_ >> 4) & 3; }
#pragma unroll
        for (int ai = 0; ai < 2; ++ai)
#pragma unroll
            for (int m = 0; m < 4; ++m) { float* prow = part + (size_t)(u.pm * 256 + ai * 128 + wr * 64 + m * 16 + fr - row0) * D + u.pn * 256 + wc * 32 + 4 * fq;
#pragma unroll
                for (int bj = 0; bj < 2; ++bj)
#pragma unroll
                    for (int n = 0; n < 2; ++n) *(f32x4*)(prow + bj * 128 + n * 16) = acc[ai][bj][m][n];
                __builtin_amdgcn_sched_barrier(0); }
    }
};

struct EpiFfnIn {
    static constexpr bool PERM = true, MIDK = false;
    bf16_t* HID;
    DI void operator()(Acc& acc, const Unit& u, int wr, int wc, int fr, int fq) const {
        { const int t_ = fresh_tid(); fr = t_ & 15; fq = (t_ >> 4) & 3; }
        bf16_t* base = HID + (size_t)(u.pm * 256 + wr * 64 + fr) * FF + u.pn * 128 + wc * 32 + 8 * fq;
#pragma unroll
        for (int ai = 0; ai < 2; ++ai)
#pragma unroll
            for (int m = 0; m < 4; ++m) { f32x4 v0, v1;
#pragma unroll
                for (int j = 0; j < 4; ++j) { v0[j] = silu(acc[ai][0][m][0][j]) * acc[ai][1][m][0][j]; v1[j] = silu(acc[ai][0][m][1][j]) * acc[ai][1][m][1][j]; }
                *(u32x4*)(base + (size_t)(ai * 128 + m * 16) * FF) = pack_row8(v0, v1); __builtin_amdgcn_sched_barrier(0); }
    }
};

DI void transpose_item(const float* W, int N, bf16_t* WT, int pitch, int koff, int k0, int n0, int drow0, LAS float* scr, int lane) {
#pragma unroll
    for (int i = 0; i < 8; ++i) { const int kk = 8 * i + (lane >> 3), n4 = 4 * (lane & 7); const f32x4 w = *(const f32x4*)(W + (size_t)(k0 + kk) * N + n0 + n4);
        scr[kk * 33 + n4] = w[0]; scr[kk * 33 + n4 + 1] = w[1]; scr[kk * 33 + n4 + 2] = w[2]; scr[kk * 33 + n4 + 3] = w[3]; }
    asm volatile("s_waitcnt lgkmcnt(0)" ::: "memory");
    const int c = lane & 7;
#pragma unroll
    for (int j = 0; j < 4; ++j) { const int n = (lane >> 3) + 8 * j; const LAS float* s = scr + (8 * c) * 33 + n;
        u32x4 o; o.x = pk2(s[0 * 33], s[1 * 33]); o.y = pk2(s[2 * 33], s[3 * 33]); o.z = pk2(s[4 * 33], s[5 * 33]); o.w = pk2(s[6 * 33], s[7 * 33]);
        *(u32x4*)(WT + (size_t)(drow0 + n) * pitch + koff + k0 + 8 * c) = o; }
    asm volatile("s_waitcnt lgkmcnt(0)" ::: "memory");
}
DI void phase_prep(const Params& p, LAS unsigned char* lds) {
    const int tid = fresh_tid(), lane = tid & 63, wave = __builtin_amdgcn_readfirstlane(tid >> 6);
    LAS float* scr = (LAS float*)(lds + wave * 16384);
    const int gw = blockIdx.x * 8 + wave, NGW = gridDim.x * 8;
    unsigned char* ws = p.ws;
    constexpr int I_ADA = 16 * 192, I_IN = 16 * 176, I_A = 8 * 32, I_O = 16 * 32, I_FI = 16 * 176, I_FO = 44 * 32;
    constexpr int NIT = I_ADA + I_IN + 2 * I_A + I_O + I_FI + I_FO;
    for (int it = gw; it < NIT; it += NGW) {
        int r = it;
        if (r < I_ADA) { const int kb = r / 192, nb = r % 192; transpose_item(p.w_ada, 6144, (bf16_t*)(ws + WS_WADA), 1024, 0, 64 * kb, 32 * nb, 32 * nb, scr, lane); continue; } r -= I_ADA;
        if (r < I_IN) { const int kb = r / 176, nb = r % 176, n0 = 32 * nb; int dr = n0;
            if (n0 >= 3584) { const int j = n0 < 4608 ? n0 - 3584 : n0 - 4608; dr = 3584 + 256 * (j >> 7) + (j & 127) + (n0 < 4608 ? 0 : 128); }
            transpose_item(p.w_in, INC, (bf16_t*)(ws + WS_WIN), 1024, 0, 64 * kb, n0, dr, scr, lane); continue; } r -= I_IN;
        if (r < I_A) { const int kb = r / 32, nb = r % 32; transpose_item(p.w_a, 1024, (bf16_t*)(ws + WS_WAB), 1024, 0, 64 * kb, 32 * nb, 32 * nb, scr, lane); continue; } r -= I_A;
        if (r < I_A) { const int kb = r / 32, nb = r % 32; transpose_item(p.w_b, 1024, (bf16_t*)(ws + WS_WAB), 1024, 512, 64 * kb, 32 * nb, 32 * nb, scr, lane); continue; } r -= I_A;
        if (r < I_O) { const int kb = r / 32, nb = r % 32; transpose_item(p.w_out, 1024, (bf16_t*)(ws + WS_WO), 1024, 0, 64 * kb, 32 * nb, 32 * nb, scr, lane); continue; } r -= I_O;
        if (r < I_FI) { const int kb = r / 176, nb = r % 176; const int n0 = 32 * nb; const int j0 = n0 < FF ? n0 : n0 - FF;
            transpose_item(p.w_ffn_in, INC, (bf16_t*)(ws + WS_WFI), 1024, 0, 64 * kb, n0, 256 * (j0 >> 7) + (j0 & 127) + (n0 < FF ? 0 : 128), scr, lane); continue; } r -= I_FI;
        { const int kb = r / 32, nb = r % 32; transpose_item(p.w_ffn_out, 1024, (bf16_t*)(ws + WS_WFO), FF, 0, 64 * kb, 32 * nb, 32 * nb, scr, lane); }
    }
    bf16_t* SC = (bf16_t*)(ws + WS_SC);
    for (int i = blockIdx.x * 512 + tid; i < 256 * 1024 / 2; i += gridDim.x * 512) { const int row = (2 * i) >> 10, col = (2 * i) & 1023; float a = 0.f, b = 0.f;
        if (row < NBATCH) { const float* c = row < 2 ? p.c_prompt + row * D : p.c_sample + (row - 2) * D; a = silu(c[col]); b = silu(c[col + 1]); }
        ((unsigned*)SC)[i] = pk2(a, b); }
}

DI float wave_sum(float v) {
#pragma unroll
    for (int o = 1; o < 64; o <<= 1) v += __shfl_xor(v, o);
    return v;
}
DI void phase_norm_mod(const float* xp, const float* xs, const float* nw, const float* mod, int sh_off, int sc_off, bf16_t* H) {
    const int tid = fresh_tid(), lane = tid & 63, wave = __builtin_amdgcn_readfirstlane(tid >> 6);
    const int gw = blockIdx.x * 8 + wave, NGW = gridDim.x * 8;
    for (int r = gw; r < T; r += NGW) {
        const float* xr = r < TP ? xp + (size_t)r * D : xs + (size_t)(r - TP) * D; const float* mb = mod + (size_t)batch_of(r) * 6144;
        f32x4 v[4]; float s = 0.f;
#pragma unroll
        for (int j = 0; j < 4; ++j) { v[j] = *(const f32x4*)(xr + 4 * lane + 256 * j); s += (v[j][0] * v[j][0] + v[j][1] * v[j][1]) + (v[j][2] * v[j][2] + v[j][3] * v[j][3]); }
        const float rstd = __builtin_amdgcn_rsqf(wave_sum(s) * (1.f / D) + EPS);
#pragma unroll
        for (int j = 0; j < 4; ++j) { const int col = 4 * lane + 256 * j; const f32x4 w = *(const f32x4*)(nw + col), sc = *(const f32x4*)(mb + sc_off + col), sh = *(const f32x4*)(mb + sh_off + col);
            const f32x4 h = v[j] * rstd * w * (sc + 1.f) + sh; u32x2 o; o.x = pk2(h[0], h[1]); o.y = pk2(h[2], h[3]);
            *(u32x2*)(H + (size_t)r * D + col) = o; }
    }
}
DI void phase_norm_mod_b(const bf16_t* xb, const float* nw, const float* mod, int sh_off, int sc_off, bf16_t* H, int r_lo = 0, int r_hi = T, int b_lo = 0) {
    const int tid = fresh_tid(), lane = tid & 63, wave = __builtin_amdgcn_readfirstlane(tid >> 6);
    const int gw = ((int)blockIdx.x - b_lo) * 8 + wave, NGW = ((int)gridDim.x - b_lo) * 8;
    for (int r = r_lo + gw; r < r_hi; r += NGW) {
        const bf16_t* xr = xb + (size_t)r * D; const float* mb = mod + (size_t)batch_of(r) * 6144;
        float v[2][8]; float s = 0.f;
#pragma unroll
        for (int j = 0; j < 2; ++j) { const u32x4 x = *(const u32x4*)(xr + 8 * lane + 512 * j);
#pragma unroll
            for (int i = 0; i < 4; ++i) { v[j][2 * i] = bflo(x[i]); v[j][2 * i + 1] = bfhi(x[i]); s += v[j][2 * i] * v[j][2 * i] + v[j][2 * i + 1] * v[j][2 * i + 1]; } }
        const float rstd = __builtin_amdgcn_rsqf(wave_sum(s) * (1.f / D) + EPS);
#pragma unroll
        for (int j = 0; j < 2; ++j) { const int col = 8 * lane + 512 * j; f32x4 h[2];
#pragma unroll
            for (int q = 0; q < 2; ++q) { const f32x4 w = *(const f32x4*)(nw + col + 4 * q), sc = *(const f32x4*)(mb + sc_off + col + 4 * q), sh = *(const f32x4*)(mb + sh_off + col + 4 * q);
                const f32x4 x = {v[j][4 * q], v[j][4 * q + 1], v[j][4 * q + 2], v[j][4 * q + 3]}; h[q] = x * rstd * w * (sc + 1.f) + sh; }
            *(u32x4*)(H + (size_t)r * D + col) = pack_row8(h[0], h[1]); }
    }
}
DI void phase_final_norm(const bf16_t* xb, float* y, const float* nw, int r_lo = 0, int r_hi = T, int b_lo = 0) {
    const int tid = fresh_tid(), lane = tid & 63, wave = __builtin_amdgcn_readfirstlane(tid >> 6);
    const int gw = ((int)blockIdx.x - b_lo) * 8 + wave, NGW = ((int)gridDim.x - b_lo) * 8;
    for (int r = r_lo + gw; r < r_hi; r += NGW) { const bf16_t* xr = xb + (size_t)r * D; float* yr = y + (size_t)r * D;
        float v[2][8]; float s = 0.f;
#pragma unroll
        for (int j = 0; j < 2; ++j) { const u32x4 x = *(const u32x4*)(xr + 8 * lane + 512 * j);
#pragma unroll
            for (int i = 0; i < 4; ++i) { v[j][2 * i] = bflo(x[i]); v[j][2 * i + 1] = bfhi(x[i]); s += v[j][2 * i] * v[j][2 * i] + v[j][2 * i + 1] * v[j][2 * i + 1]; } }
        const float rstd = __builtin_amdgcn_rsqf(wave_sum(s) * (1.f / D) + EPS);
#pragma unroll
        for (int j = 0; j < 2; ++j) { const int col = 8 * lane + 512 * j;
#pragma unroll
            for (int q = 0; q < 2; ++q) { const f32x4 x = {v[j][4 * q], v[j][4 * q + 1], v[j][4 * q + 2], v[j][4 * q + 3]}; *(f32x4*)(yr + col + 4 * q) = x * rstd * *(const f32x4*)(nw + col + 4 * q); } }
    }
}

DI void phase_final_norm_parts(const bf16_t* x1b, const float* part0, const float* part1, const float* g2mod, float* y, const float* nw) {
    const int tid = fresh_tid(), lane = tid & 63, wave = __builtin_amdgcn_readfirstlane(tid >> 6);
    const int gw = blockIdx.x * 8 + wave, NGW = gridDim.x * 8;
    for (int r = TP + gw; r < T; r += NGW) { const float* gb = g2mod + (size_t)batch_of(r) * 6144; const size_t po = (size_t)(r - TP) * D;
        f32x4 v[4]; float s = 0.f;
#pragma unroll
        for (int j = 0; j < 4; ++j) { const int col = 4 * lane + 256 * j; const u32x2 xb = *(const u32x2*)(x1b + (size_t)r * D + col);
            const f32x4 x = {bflo(xb.x), bfhi(xb.x), bflo(xb.y), bfhi(xb.y)};
            v[j] = x + *(const f32x4*)(gb + col) * (*(const f32x4*)(part0 + po + col) + *(const f32x4*)(part1 + po + col));
            s += (v[j][0] * v[j][0] + v[j][1] * v[j][1]) + (v[j][2] * v[j][2] + v[j][3] * v[j][3]); }
        const float rstd = __builtin_amdgcn_rsqf(wave_sum(s) * (1.f / D) + EPS);
#pragma unroll
        for (int j = 0; j < 4; ++j) { const int col = 4 * lane + 256 * j; *(f32x4*)(y + (size_t)r * D + col) = v[j] * rstd * *(const f32x4*)(nw + col); }
    }
}

DI void hgrn_u_item(const Params& p, int item, int lane) {
    const int c = item >> 4, rem = item & 15, h = rem >> 2, kt = rem & 3, l31 = lane & 31, hf = lane >> 5;
    const float* CUM = (const float*)(p.ws + WS_CUM); const bf16_t* KA = (const bf16_t*)(p.ws + WS_KA); const bf16_t* VA = (const bf16_t*)(p.ws + WS_VA); bf16_t* U = (bf16_t*)(p.ws + WS_U);
    const size_t hb = (size_t)h * T * 128; const int kcol = 32 * kt + l31;
    const float tot = CUM[hb + (size_t)(c * 64 + 63) * 128 + kcol];
    bf16x8 kdf[2][2];
#pragma unroll
    for (int st = 0; st < 2; ++st) { f32x16 kd;
#pragma unroll
        for (int r = 0; r < 16; ++r) { const size_t idx = hb + (size_t)(c * 64 + 32 * st + crow(r, hf)) * 128 + kcol; kd[r] = bf2f((short)KA[idx]) * __expf(tot - CUM[idx]); }
        kdf[st][0] = pack8(kd, 0); kdf[st][1] = pack8(kd, 1); }
    const bf16x8 id0 = ident_frag(0, l31, hf), id1 = ident_frag(1, l31, hf);
#pragma unroll
    for (int vt = 0; vt < 4; ++vt) { f32x16 dacc = zero16();
#pragma unroll
        for (int st = 0; st < 2; ++st) { const bf16_t* vp = VA + hb + (size_t)(c * 64 + 32 * st) * 128 + (4 * vt + hf) * 256 + l31 * 8;
            f32x16 vx = zero16(); vx = MFMA32(*(const bf16x8*)vp, id0, vx); vx = MFMA32(*(const bf16x8*)(vp + 512), id1, vx);
            dacc = MFMA32(kdf[st][0], pack8(vx, 0), dacc); dacc = MFMA32(kdf[st][1], pack8(vx, 1), dacc); }
        bf16_t* up = U + ((size_t)(c * 4 + h) * 128 + 32 * vt + l31) * 128 + 32 * kt + 8 * hf;
#pragma unroll
        for (int g = 0; g < 4; g += 2) { u32x2 o0, o1; o0.x = pk2(dacc[4 * g], dacc[4 * g + 1]); o0.y = pk2(dacc[4 * g + 2], dacc[4 * g + 3]); o1.x = pk2(dacc[4 * g + 4], dacc[4 * g + 5]); o1.y = pk2(dacc[4 * g + 6], dacc[4 * g + 7]);
            *(u32x4*)(up + 8 * g) = widen_pair(o0, o1); }
    }
}

DI void scan_prompt_item(const Params& p, int item, int lane) {
    const int bh = item >> 6, vp = item & 63, b = bh >> 2, h = bh & 3, kg = lane & 31, v0 = 2 * vp + (lane >> 5);
    const float* __restrict__ DEC = (const float*)(p.ws + WS_DEC) + (size_t)b * 256 * 512 + h * 128 + 4 * kg;
    const bf16_t* __restrict__ U = (const bf16_t*)(p.ws + WS_U) + ((size_t)(b * 256 * 4 + h) * 128 + v0) * 128 + 4 * kg;
    bf16_t* __restrict__ SST = (bf16_t*)(p.ws + WS_SST) + ((size_t)(b * 256 * 4 + h) * 128 + v0) * 128 + 4 * kg;
    f32x4 S0 = {0.f, 0.f, 0.f, 0.f};
    for (int n0 = 0; n0 < 256; n0 += 32) {
        f32x4 d[32]; u32x2 u[32];
#pragma unroll
        for (int i = 0; i < 32; ++i) { d[i] = *(const f32x4*)(DEC + (size_t)(n0 + i) * 512); u[i] = *(const u32x2*)(U + (size_t)(n0 + i) * 4 * 128 * 128); }
#pragma unroll
        for (int i = 0; i < 32; ++i) { u32x2 s; s.x = pk2(S0[0], S0[1]); s.y = pk2(S0[2], S0[3]); *(u32x2*)(SST + (size_t)(n0 + i) * 4 * 128 * 128) = s;
            S0[0] = d[i][0] * S0[0] + bflo(u[i].x); S0[1] = d[i][1] * S0[1] + bfhi(u[i].x); S0[2] = d[i][2] * S0[2] + bflo(u[i].y); S0[3] = d[i][3] * S0[3] + bfhi(u[i].y); }
    }
    float* sp = p.out + OFF_SP + ((size_t)bh * 128 + 4 * kg) * 128;
#pragma unroll
    for (int i = 0; i < 4; ++i) sp[(size_t)i * 128 + v0] = S0[i];
}
DI void scan_sample_item(const Params& p, int item, int lane) {
    const int bh = item >> 5, sub = item & 31, bs = bh >> 2, h = bh & 3, k0 = 32 * (sub & 3) + 4 * (lane >> 3), vb = 16 * (sub >> 2) + (lane & 7), c = 512 + bs;
    const float* DEC = (const float*)(p.ws + WS_DEC); const bf16_t* U = (const bf16_t*)(p.ws + WS_U); bf16_t* SST = (bf16_t*)(p.ws + WS_SST);
    const f32x4 d = *(const f32x4*)(DEC + (size_t)c * 512 + h * 128 + k0);
    const float* s0 = p.state + ((size_t)bh * 128 + k0) * 128; float* so = p.out + OFF_SS + ((size_t)bh * 128 + k0) * 128;
#pragma unroll
    for (int e = 0; e < 2; ++e) { const int v = vb + 8 * e; const size_t o = ((size_t)(c * 4 + h) * 128 + v) * 128 + k0;
        const u32x2 u = *(const u32x2*)(U + o); f32x4 S;
#pragma unroll
        for (int i = 0; i < 4; ++i) S[i] = s0[(size_t)i * 128 + v];
        u32x2 s; s.x = pk2(S[0], S[1]); s.y = pk2(S[2], S[3]); *(u32x2*)(SST + o) = s;
        so[v] = d[0] * S[0] + bflo(u.x); so[128 + v] = d[1] * S[1] + bfhi(u.x); so[256 + v] = d[2] * S[2] + bflo(u.y); so[384 + v] = d[3] * S[3] + bfhi(u.y); }
}

DI void attn_item(const Params& p, int item, int lane, const LAS float* biasl) {
    const int c = item >> 3, h = item & 7, l31 = lane & 31, hf = lane >> 5;
    const bf16_t* KB = (const bf16_t*)(p.ws + WS_KB); const bf16_t* VB = (const bf16_t*)(p.ws + WS_VB);
    bf16x8 qf[2][4];
    { const bf16_t* qptr = (const bf16_t*)(p.ws + WS_QOB) + (size_t)(c * 64 + l31) * 1024 + 512 + h * 64;
#pragma unroll
    for (int qq = 0; qq < 2; ++qq)
#pragma unroll
        for (int ks = 0; ks < 4; ++ks) qf[qq][ks] = *(const bf16x8*)(qptr + (size_t)qq * 32 * 1024 + 16 * ks + 8 * hf); }
    const LAS float* bl = biasl + h * 192;
    f32x16 OT[2][2]; float mrun[2], lsum[2];
#pragma unroll
    for (int qq = 0; qq < 2; ++qq) { OT[qq][0] = zero16(); OT[qq][1] = zero16(); mrun[qq] = -1e30f; lsum[qq] = 0.f; }
    int ntile, ncache, db0, krow_first;
    if (c < 512) { const int n = c & 255, j0 = n < 8 ? n : 8; ntile = 2 * (j0 + 1); ncache = 0; db0 = 64 * j0; krow_first = (c - j0) * 64; }
    else { ntile = 18; ncache = 16; db0 = 512; krow_first = c * 64 - 512; }
    const int bs = c - 512;
    u32x4 nk[4], nv[4];
#define ATT_LOAD(i_) do { if ((i_) >= ncache) { const size_t ro_ = (((size_t)h * (T / 32) + (size_t)((krow_first >> 5) + (i_))) * 8 + hf) * 256 + l31 * 8;     \
            _Pragma("unroll") for (int ks = 0; ks < 4; ++ks) { nk[ks] = *(const u32x4*)(KB + ro_ + 512 * ks); nv[ks] = *(const u32x4*)(VB + ro_ + 512 * ks); } } } while (0)
    ATT_LOAD(0);
    for (int i = 0; i < ntile; ++i) {
        bf16x8 kf[4], vf[2][2];
        if (i < ncache) {
            const float* kp_ = p.cache_k + ((size_t)(bs * 512 + 32 * i + l31) * 8 + h) * 64 + 8 * hf; const float* vp_ = p.cache_v + ((size_t)(bs * 512 + 32 * i + l31) * 8 + h) * 64 + 8 * hf;
#pragma unroll
            for (int ks = 0; ks < 4; ++ks) { u32x4 w; const f32x4 a = *(const f32x4*)(kp_ + 16 * ks), b = *(const f32x4*)(kp_ + 16 * ks + 4), e = *(const f32x4*)(vp_ + 16 * ks), f = *(const f32x4*)(vp_ + 16 * ks + 4);
                w.x = pk2(a[0], a[1]); w.y = pk2(a[2], a[3]); w.z = pk2(b[0], b[1]); w.w = pk2(b[2], b[3]); kf[ks] = __builtin_bit_cast(bf16x8, w);
                w.x = pk2(e[0], e[1]); w.y = pk2(e[2], e[3]); w.z = pk2(f[0], f[1]); w.w = pk2(f[2], f[3]); vf[ks >> 1][ks & 1] = __builtin_bit_cast(bf16x8, w); }
        } else {
#pragma unroll
            for (int ks = 0; ks < 4; ++ks) { kf[ks] = __builtin_bit_cast(bf16x8, nk[ks]); vf[ks >> 1][ks & 1] = __builtin_bit_cast(bf16x8, nv[ks]); }
        }
        if (i + 1 < ntile) ATT_LOAD(i + 1);
        asm volatile("" ::: "memory");
        bf16x8 vxf[2][2];
        const int l31b = launder(l31); const bf16x8 id0 = ident_frag(0, l31b, hf), id1 = ident_frag(1, l31b, hf);
#pragma unroll
        for (int dt = 0; dt < 2; ++dt) { f32x16 vx = zero16(); vx = MFMA32(vf[dt][0], id0, vx); vx = MFMA32(vf[dt][1], id1, vx); vxf[dt][0] = pack8(vx, 0); vxf[dt][1] = pack8(vx, 1); }
#pragma unroll
        for (int qq = 0; qq < 2; ++qq) {
            f32x16 st = zero16();
#pragma unroll
            for (int ks = 0; ks < 4; ++ks) st = MFMA32(kf[ks], qf[qq][ks], st);
            const int dq = db0 + 32 * qq - 32 * i; float mt = -1e30f;
            if (dq - 31 >= 128) { const float bc = bl[191];
#pragma unroll
                for (int r = 0; r < 16; ++r) { const float s = st[r] * (0.125f * LOG2E) + bc; st[r] = s; mt = fmaxf(mt, s); }
            } else { const int dbase = dq + l31;
#pragma unroll
                for (int r = 0; r < 16; ++r) { int dist = dbase - crow(r, hf); dist = dist > 128 ? 128 : dist; const float s = st[r] * (0.125f * LOG2E) + bl[dist + 63]; st[r] = s; mt = fmaxf(mt, s); }
            }
            mt = fmaxf(mt, __shfl_xor(mt, 32));
            float mnew = mrun[qq];
            if (__any(mt > mrun[qq] + 8.f)) { mnew = fmaxf(mrun[qq], mt); const float alpha = __builtin_amdgcn_exp2f(mrun[qq] - mnew); mrun[qq] = mnew; lsum[qq] *= alpha;
#pragma unroll
                for (int r = 0; r < 16; ++r) { OT[qq][0][r] *= alpha; OT[qq][1][r] *= alpha; } }
            float ps = 0.f;
#pragma unroll
            for (int r = 0; r < 16; ++r) { st[r] = __builtin_amdgcn_exp2f(st[r] - mnew); ps += st[r]; }
            lsum[qq] += ps;
            const bf16x8 pf0 = pack8(st, 0), pf1 = pack8(st, 1);
            OT[qq][0] = MFMA32(vxf[0][0], pf0, OT[qq][0]); OT[qq][0] = MFMA32(vxf[0][1], pf1, OT[qq][0]);
            OT[qq][1] = MFMA32(vxf[1][0], pf0, OT[qq][1]); OT[qq][1] = MFMA32(vxf[1][1], pf1, OT[qq][1]);
        }
    }
#undef ATT_LOAD
    bf16_t* qptr = (bf16_t*)(p.ws + WS_QOB) + (size_t)(c * 64 + launder(l31)) * 1024 + 512 + h * 64;
#pragma unroll
    for (int qq = 0; qq < 2; ++qq) { const float l = lsum[qq] + __shfl_xor(lsum[qq], 32), inv = 1.f / l; bf16_t* op = qptr + (size_t)qq * 32 * 1024;
#pragma unroll
        for (int dt = 0; dt < 2; ++dt)
#pragma unroll
            for (int g = 0; g < 4; g += 2) { u32x2 o0, o1; o0.x = pk2(OT[qq][dt][4 * g] * inv, OT[qq][dt][4 * g + 1] * inv); o0.y = pk2(OT[qq][dt][4 * g + 2] * inv, OT[qq][dt][4 * g + 3] * inv);
                o1.x = pk2(OT[qq][dt][4 * g + 4] * inv, OT[qq][dt][4 * g + 5] * inv); o1.y = pk2(OT[qq][dt][4 * g + 6] * inv, OT[qq][dt][4 * g + 7] * inv);
                *(u32x4*)(op + 32 * dt + 8 * (g + hf)) = widen_pair(o0, o1); } }
}

DI void hgrn_out_item(const Params& p, int item, int lane, bf16_t* obase = nullptr) {
    const int c = item >> 3, h = (item >> 1) & 3, tt = item & 1, l31 = lane & 31, hf = lane >> 5;
    const float* CUM = (const float*)(p.ws + WS_CUM); const bf16_t* KA = (const bf16_t*)(p.ws + WS_KA); const bf16_t* VA = (const bf16_t*)(p.ws + WS_VA);
    const bf16_t* GA = (const bf16_t*)(p.ws + WS_GA); const bf16_t* SST = (const bf16_t*)(p.ws + WS_SST);
    const int trow = c * 64 + 32 * tt + l31;
    bf16_t* qap = (bf16_t*)(p.ws + WS_QOB) + (size_t)trow * 1024 + h * 128;
    const size_t hb = (size_t)h * T * 128;
    const float* cumt = CUM + hb + (size_t)trow * 128; const float* refp = CUM + hb + (size_t)(c * 64 + 32) * 128;
    bf16x8 qd1[8], qd2[8], kdt[8];
    const bf16_t* kat = KA + hb + (size_t)trow * 128;
#pragma unroll
    for (int ks = 0; ks < 8; ++ks) { const int k0 = 16 * ks + 8 * hf; const bf16x8 q8 = *(const bf16x8*)(qap + k0), k8 = *(const bf16x8*)(kat + k0);
        const f32x4 c0 = *(const f32x4*)(cumt + k0), c1 = *(const f32x4*)(cumt + k0 + 4), r0 = *(const f32x4*)(refp + k0), r1 = *(const f32x4*)(refp + k0 + 4);
        float a[8], b[8], d[8];
#pragma unroll
        for (int j = 0; j < 8; ++j) { const float q = bf2f(q8[j]), cu = j < 4 ? c0[j & 3] : c1[j & 3], rf = j < 4 ? r0[j & 3] : r1[j & 3]; a[j] = q * __expf(cu - rf); b[j] = q * __expf(cu); d[j] = bf2f(k8[j]) * __expf(rf - cu); }
        qd1[ks] = pack8f(a); qd2[ks] = pack8f(b); kdt[ks] = pack8f(d); }
    f32x16 OT[4];
#pragma unroll
    for (int vt = 0; vt < 4; ++vt) OT[vt] = zero16();
    const bf16_t* sp = SST + ((size_t)(c * 4 + h) * 128 + l31) * 128 + 8 * hf;
#pragma unroll
    for (int vt = 0; vt < 4; ++vt) {
#pragma unroll
        for (int ks = 0; ks < 8; ++ks) OT[vt] = MFMA32(*(const bf16x8*)(sp + (size_t)vt * 32 * 128 + 16 * ks), qd2[ks], OT[vt]);
        __builtin_amdgcn_sched_barrier(0); }
    const bf16x8 id0 = ident_frag(0, l31, hf), id1 = ident_frag(1, l31, hf);
    for (int st = 0; st <= tt; ++st) {
        const int srow = c * 64 + 32 * st + l31; const bf16_t* kap = KA + hb + (size_t)srow * 128; const float* cums = CUM + hb + (size_t)srow * 128;
        f32x16 X = zero16();
        if (st == tt) {
#pragma unroll
            for (int ks = 0; ks < 8; ++ks) X = MFMA32(kdt[ks], qd1[ks], X);
        } else
#pragma unroll
        for (int ks = 0; ks < 8; ++ks) { const int k0 = 16 * ks + 8 * hf; const bf16x8 k8 = *(const bf16x8*)(kap + k0);
            const f32x4 c0 = *(const f32x4*)(cums + k0), c1 = *(const f32x4*)(cums + k0 + 4), r0 = *(const f32x4*)(refp + k0), r1 = *(const f32x4*)(refp + k0 + 4);
            float a[8];
#pragma unroll
            for (int j = 0; j < 8; ++j) { const float cu = j < 4 ? c0[j & 3] : c1[j & 3], rf = j < 4 ? r0[j & 3] : r1[j & 3]; a[j] = bf2f(k8[j]) * __expf(rf - cu); }
            X = MFMA32(pack8f(a), qd1[ks], X); }
        if (st == tt) {
#pragma unroll
            for (int r = 0; r < 16; ++r) if (crow(r, hf) > l31) X[r] = 0.f; }
        const bf16x8 xf0 = pack8(X, 0), xf1 = pack8(X, 1);
        const bf16_t* vp = VA + hb + (size_t)(c * 64 + 32 * st) * 128 + hf * 256 + l31 * 8;
#pragma unroll
        for (int vt = 0; vt < 4; ++vt) { f32x16 vx = zero16(); vx = MFMA32(*(const bf16x8*)(vp + 1024 * vt), id0, vx); vx = MFMA32(*(const bf16x8*)(vp + 1024 * vt + 512), id1, vx);
            OT[vt] = MFMA32(pack8(vx, 0), xf0, OT[vt]); OT[vt] = MFMA32(pack8(vx, 1), xf1, OT[vt]); }
    }
    float ss = 0.f;
#pragma unroll
    for (int vt = 0; vt < 4; ++vt)
#pragma unroll
        for (int r = 0; r < 16; ++r) ss += OT[vt][r] * OT[vt][r];
    ss += __shfl_xor(ss, 32);
    const float rstd = __builtin_amdgcn_rsqf(ss * (1.f / 128.f) + EPS);
    const bf16_t* gap = GA + hb + (size_t)trow * 128; const float* onp = p.out_norm + h * 128;
    if (obase) qap = obase + (size_t)trow * 512 + h * 128;
#pragma unroll
    for (int vt = 0; vt < 4; ++vt)
#pragma unroll
        for (int g = 0; g < 4; g += 2) { u32x2 ga0, ga1; narrow_pair(*(const u32x4*)(gap + 32 * vt + 8 * (g + hf)), ga0, ga1);
            u32x2 o0, o1;
            { const int v0 = 32 * vt + 8 * g + 4 * hf; const f32x4 on = *(const f32x4*)(onp + v0);
              o0.x = pk2(OT[vt][4 * g] * rstd * on[0] * bflo(ga0.x), OT[vt][4 * g + 1] * rstd * on[1] * bfhi(ga0.x)); o0.y = pk2(OT[vt][4 * g + 2] * rstd * on[2] * bflo(ga0.y), OT[vt][4 * g + 3] * rstd * on[3] * bfhi(ga0.y)); }
            { const int v0 = 32 * vt + 8 * (g + 1) + 4 * hf; const f32x4 on = *(const f32x4*)(onp + v0);
              o1.x = pk2(OT[vt][4 * g + 4] * rstd * on[0] * bflo(ga1.x), OT[vt][4 * g + 5] * rstd * on[1] * bfhi(ga1.x)); o1.y = pk2(OT[vt][4 * g + 6] * rstd * on[2] * bflo(ga1.y), OT[vt][4 * g + 7] * rstd * on[3] * bfhi(ga1.y)); }
            *(u32x4*)(qap + 32 * vt + 8 * (g + hf)) = widen_pair(o0, o1); }
}


#define XB_TMO      128
#define XB_XCNT(j)  (256  + 64 * (j))
#define XB_XSUB(j)  (1280 + 64 * (j))
#define XB_XGEN(j)  (2304 + 64 * (j))
#define XB_TOP      3328
#define XB_TOPGEN   3392
#define XCD_BAR_WORDS 3456
#define XB_SPIN_CAP (1u << 18)
DI unsigned xb_ld(unsigned* p)              { return __hip_atomic_load(p, __ATOMIC_RELAXED, __HIP_MEMORY_SCOPE_AGENT); }
DI unsigned xb_add(unsigned* p, unsigned v) { return __hip_atomic_fetch_add(p, v, __ATOMIC_RELAXED, __HIP_MEMORY_SCOPE_AGENT); }
DI unsigned xb_xcc_id() { return (unsigned)__builtin_amdgcn_s_getreg((3 << 11) | 20) & 0xFu; }
#define XB_SPIN(cond, bar) do { unsigned _sp = 0; while (cond) { __builtin_amdgcn_s_sleep(1); \
    if ((++_sp & 255u) == 0u) { if (xb_ld(&(bar)[XB_TMO])) break; if (_sp > XB_SPIN_CAP) { atomicAdd(&(bar)[XB_TMO], 1u); break; } } } } while (0)
struct XcdBarrier { unsigned* bar; unsigned x; volatile LAS unsigned* st; };
DI XcdBarrier xcd_barrier_post(unsigned* bar, volatile LAS unsigned* st) {
    XcdBarrier b; b.bar = bar; b.x = xb_xcc_id(); b.st = st;
    if (threadIdx.x == 0) (void)xb_add(&bar[XB_XCNT(b.x)], 1u);
    return b;
}
DI void xcd_barrier_complete(unsigned* bar, unsigned x, unsigned& nloc, unsigned& nx) {
    const unsigned G = gridDim.x * gridDim.y * gridDim.z;
    unsigned sum, cnt, mine, sp = 0u;
    for (;;) {
        sum = 0u; cnt = 0u; mine = 0u;
#pragma unroll
        for (unsigned j = 0; j < 16; ++j) { const unsigned c = xb_ld(&bar[XB_XCNT(j)]); sum += c; cnt += (c > 0u) ? 1u : 0u; mine = (j == x) ? c : mine; }
        if (sum == G) break;
        __builtin_amdgcn_s_sleep(1);
        if ((++sp & 255u) == 0u) { if (xb_ld(&bar[XB_TMO])) break; if (sp > XB_SPIN_CAP) { atomicAdd(&bar[XB_TMO], 1u); break; } }
    }
    nloc = mine > 0u ? mine : 1u; nx = cnt > 0u ? cnt : 1u;
}
DI void xcd_barrier(const XcdBarrier& b) {
    asm volatile("s_waitcnt vmcnt(0)" ::: "memory");
    __syncthreads();
    if (threadIdx.x == 0) {
        unsigned* bar = b.bar;
        __builtin_amdgcn_s_waitcnt(0);
        unsigned nloc = b.st[0], nx = b.st[1];
        if (nloc == 0u) { xcd_barrier_complete(bar, b.x, nloc, nx); b.st[0] = nloc; b.st[1] = nx; }
        const unsigned old = xb_add(&bar[XB_XSUB(b.x)], 1u);
        const unsigned gen = old / nloc;
        if (old + 1u == (gen + 1u) * nloc) {
            __builtin_amdgcn_fence(__ATOMIC_RELEASE, "agent");
            asm volatile("s_waitcnt vmcnt(0)" ::: "memory");
            const unsigned og = xb_add(&bar[XB_TOP], 1u);
            const unsigned tg = og / nx;
            if (og + 1u == (tg + 1u) * nx) xb_add(&bar[XB_TOPGEN], 1u);
            else XB_SPIN(xb_ld(&bar[XB_TOPGEN]) == tg, bar);
            __builtin_amdgcn_fence(__ATOMIC_ACQUIRE, "agent");
            xb_add(&bar[XB_XGEN(b.x)], 1u);
            asm volatile("s_waitcnt vmcnt(0)" ::: "memory");
        } else {
            XB_SPIN(xb_ld(&bar[XB_XGEN(b.x)]) == gen, bar);
            __builtin_amdgcn_fence(__ATOMIC_ACQUIRE, "agent");
            asm volatile("s_waitcnt vmcnt(0)" ::: "memory");
        }
    }
    __syncthreads();
}

__global__ void __launch_bounds__(512, 2) fwd_megakernel(Params p) {
    extern __shared__ __attribute__((aligned(16))) unsigned char lds_raw[];
    LAS unsigned char* lds = (LAS unsigned char*)lds_raw;
    cg::grid_group grid = cg::this_grid();
    const int G = gridDim.x, bx = blockIdx.x;
    volatile LAS unsigned* bst = (volatile LAS unsigned*)(lds + LDS_ST_OFF);
    if (threadIdx.x < 2) bst[threadIdx.x] = 0u;
    __syncthreads();
    const XcdBarrier xbar = xcd_barrier_post((unsigned*)(p.ws + WS_BAR), bst);
    if (threadIdx.x == 0) bst[2] = xb_add((unsigned*)(p.ws + WS_BAR) + 3712 + xbar.x, 1u);
#define GRID_BAR() xcd_barrier(xbar)
    unsigned char* ws = p.ws;
    float* MOD = (float*)(ws + WS_MOD); bf16_t* H = (bf16_t*)(ws + WS_H);

    phase_prep(p, lds);
    grid.sync();
    { pg8::Gemm g{(const bf16_t*)(ws + WS_SC), (const bf16_t*)(ws + WS_WADA), 256, 6144, 1024}; pg8::StaticOrder S; S.init(256, 6144, G, bx);
      EpiMod E{MOD, p.b_ada}; pg8::gemm_phase<EpiMod, pg8::StaticOrder, true, true>(lds, g, S, E); }
    GRID_BAR();
    int cv = bx;
    { unsigned* barw = (unsigned*)(p.ws + WS_BAR); bool uni = (G & 7) == 0;
#pragma unroll
      for (int j = 0; j < 16; ++j) { const unsigned c = xb_ld(&barw[XB_XCNT(j)]); uni = uni && (j < 8 ? c == (unsigned)(G >> 3) : c == 0u); }
      if (uni) cv = (int)xbar.x + 8 * (int)bst[2];
      cv = __builtin_amdgcn_readfirstlane(cv); }
    phase_norm_mod(p.x_prompt, p.x_sample, p.norm_mix, MOD, 0, 1024, H);
#if PROBE_DUP == 1
    GRID_BAR(); phase_norm_mod(p.x_prompt, p.x_sample, p.norm_mix, MOD, 0, 1024, H);
#endif
#if PROBE_DUP == 10
    GRID_BAR(); GRID_BAR(); GRID_BAR(); GRID_BAR(); GRID_BAR(); GRID_BAR(); GRID_BAR(); GRID_BAR(); GRID_BAR(); GRID_BAR();
#endif
    GRID_BAR();
    { pg8::Gemm g{H, (const bf16_t*)(ws + WS_WIN), T, INC, 1024}; pg8::StaticOrder S; S.init(T, INC, G, cv);
      EpiIn E{(bf16_t*)(ws + WS_QOB), (bf16_t*)(ws + WS_KA), (bf16_t*)(ws + WS_VA), (bf16_t*)(ws + WS_GA), (bf16_t*)(ws + WS_KB), (bf16_t*)(ws + WS_VB),
              (bf16_t*)(p.out), (bf16_t*)(p.out) + (size_t)T * 1024, (float*)(ws + WS_CUM), (float*)(ws + WS_DEC), p.lb_logits, p.out};
      pg8::gemm_phase<EpiIn, pg8::StaticOrder, true, true>(lds, g, S, E);
#if PROBE_DUP == 2
      GRID_BAR(); pg8::gemm_phase<EpiIn, pg8::StaticOrder, true, true>(lds, g, S, E);
#endif
    }
    GRID_BAR();
    { const int tid = fresh_tid(), lane = tid & 63, wave = __builtin_amdgcn_readfirstlane(tid >> 6);
      for (int q = bx + G * (wave >> 2); q < NCH * 4; q += 2 * G) hgrn_u_item(p, q * 4 + (wave & 3), lane);
#if PROBE_DUP == 3
      for (int it = wave * G + bx; it < NCH * 16; it += 8 * G) hgrn_u_item(p, it, lane);
#endif
    }
    GRID_BAR();
    {
        const int tid = fresh_tid(), lane = tid & 63, wave = __builtin_amdgcn_readfirstlane(tid >> 6);
        LAS float* biasl = (LAS float*)lds;
        for (int i = tid; i < 8 * 192; i += 512) biasl[i] = p.rel_bias[i] * LOG2E;
        __syncthreads();
#if PROBE_DUP == 41
        if (wave == 0) { for (int it = bx; it < 512; it += G) scan_prompt_item(p, it, lane); }
        GRID_BAR();
#endif
        if (wave == 0) { for (int it = bx; it < 512; it += G) scan_prompt_item(p, it, lane); }
        else {
            const int gw = (wave - 1) * G + bx, NGW = 7 * G;
            for (int it = gw; it < 4096; it += NGW) scan_sample_item(p, it, lane);
            const int x = __builtin_amdgcn_readfirstlane((int)xbar.x), ncu = __builtin_amdgcn_readfirstlane((int)bst[0]), nxcc = __builtin_amdgcn_readfirstlane((int)bst[1]), j = __builtin_amdgcn_readfirstlane((int)bst[2]);
            if (nxcc == 8 && x < 8 && ncu > 0 && j < ncu) {
                const int nslot = 7 * ncu, slot = (wave - 1) * ncu + j;
                for (int idx = slot; idx < 68 * 8; idx += nslot) { const int cc = idx >> 3, c = cc < 4 ? 512 + 4 * x + cc : 64 * x + (cc - 4); attn_item(p, c * 8 + (idx & 7), lane, biasl); }
            } else for (int it = gw; it < NCH * 8; it += NGW) attn_item(p, it, lane, biasl);
        }
    }
    GRID_BAR();
    { const int tid = fresh_tid(), lane = tid & 63, wave = __builtin_amdgcn_readfirstlane(tid >> 6);
#if PROBE_DUP == 5
      for (int it = wave * G + bx; it < NCH * 8; it += 8 * G) hgrn_out_item(p, it, lane, (bf16_t*)(ws + WS_U));
      GRID_BAR();
#endif
      for (int it = wave * G + bx; it < NCH * 8; it += 8 * G) hgrn_out_item(p, it, lane); }
    GRID_BAR();
    { pg8::Gemm g{(const bf16_t*)(ws + WS_QOB), (const bf16_t*)(ws + WS_WAB), T, 1024, 1024}; pg8::StaticOrder S; S.init(T, 1024, G, cv);
      EpiMerge E{(const bf16_t*)(p.out), (const bf16_t*)(p.out) + (size_t)T * 1024, (bf16_t*)(ws + WS_M)};
      pg8::gemm_phase<EpiMerge, pg8::StaticOrder, true, true>(lds, g, S, E); }
    GRID_BAR();
    const bool split_ps = G >= 64;
    { pg8::Gemm g{(const bf16_t*)(ws + WS_M), (const bf16_t*)(ws + WS_WO), T, 1024, 1024}; EpiRes<false> E{p.x_prompt, p.x_sample, nullptr, (bf16_t*)(ws + WS_X1B), MOD + 2048};
      if (split_ps) {
        { pg8::StaticOrder S; S.init(TP, 1024, G, cv); pg8::gemm_phase<EpiRes<false>, pg8::StaticOrder, true, true>(lds, g, S, E); }
        GRID_BAR();
        if (bx < 32) { pg8::StaticOrder S; S.init(TS, 1024, 32, bx, TP / 256); pg8::gemm_phase<EpiRes<false>, pg8::StaticOrder, true, true>(lds, g, S, E); }
        else phase_norm_mod_b((const bf16_t*)(ws + WS_X1B), p.norm_ffn, MOD, 3072, 4096, H, 0, TP, 32);
        GRID_BAR();
        phase_norm_mod_b((const bf16_t*)(ws + WS_X1B), p.norm_ffn, MOD, 3072, 4096, H, TP, T, 0);
      } else {
        pg8::StaticOrder S; S.init(T, 1024, G, cv); pg8::gemm_phase<EpiRes<false>, pg8::StaticOrder, true, true>(lds, g, S, E);
        GRID_BAR();
        phase_norm_mod_b((const bf16_t*)(ws + WS_X1B), p.norm_ffn, MOD, 3072, 4096, H);
      } }
    GRID_BAR();
    { pg8::Gemm g{H, (const bf16_t*)(ws + WS_WFI), T, INC, 1024}; pg8::StaticOrder S; S.init(T, INC, G, cv);
      EpiFfnIn E{(bf16_t*)(ws + WS_HID)}; pg8::gemm_phase<EpiFfnIn, pg8::StaticOrder, true, true>(lds, g, S, E);
#if PROBE_DUP == 9
      GRID_BAR(); pg8::gemm_phase<EpiFfnIn, pg8::StaticOrder, true, true>(lds, g, S, E);
#endif
    }
    GRID_BAR();
    { pg8::Gemm g{(const bf16_t*)(ws + WS_HID), (const bf16_t*)(ws + WS_WFO), T, 1024, FF}; EpiRes<true> E{nullptr, nullptr, (const bf16_t*)(ws + WS_X1B), (bf16_t*)(ws + WS_X2B), MOD + 5120};
      if (split_ps) {
        { pg8::StaticOrder S; S.init(TP, 1024, G, cv); pg8::gemm_phase<EpiRes<true>, pg8::StaticOrder, true, true>(lds, g, S, E); }
        GRID_BAR();
        float* PART = (float*)(ws + WS_CUM + 20 * MiB);
        if (bx < 64) { const int ks = bx >> 5; pg8::Gemm gs{(const bf16_t*)(ws + WS_HID) + ks * (FF / 2), (const bf16_t*)(ws + WS_WFO) + ks * (FF / 2), T, 1024, FF / 2, FF};
            pg8::StaticOrder S; S.init(TS, 1024, 32, bx & 31, TP / 256); EpiPart EP{PART + (size_t)ks * TS * D, TP}; pg8::gemm_phase<EpiPart, pg8::StaticOrder, true, true>(lds, gs, S, EP); }
        else phase_final_norm((const bf16_t*)(ws + WS_X2B), p.out, p.norm_final, 0, TP, 64);
        GRID_BAR();
        phase_final_norm_parts((const bf16_t*)(ws + WS_X1B), PART, PART + (size_t)TS * D, MOD + 5120, p.out, p.norm_final);
      } else {
        pg8::StaticOrder S; S.init(T, 1024, G, cv); pg8::gemm_phase<EpiRes<true>, pg8::StaticOrder, true, true>(lds, g, S, E);
        GRID_BAR();
        phase_final_norm((const bf16_t*)(ws + WS_X2B), p.out, p.norm_final);
      } }
}

extern "C" void kernel_launch(void* const* d_in, const int* in_sizes, int n_in, void* d_out, int out_size, void* d_ws, size_t ws_size, hipStream_t stream) {
    static int grid = 0;
    if (grid == 0) {
        if (n_in != 21 || (size_t)out_size != OUT_TOTAL || ws_size < WS_END) { fprintf(stderr, "kernel_launch: unexpected sizes n_in %d out %d ws %zu\n", n_in, out_size, ws_size); grid = -1; return; }
        int dev = 0, cus = 0, per = 0;
        (void)hipGetDevice(&dev); (void)hipDeviceGetAttribute(&cus, hipDeviceAttributeMultiprocessorCount, dev);
        (void)hipFuncSetAttribute((const void*)fwd_megakernel, hipFuncAttributeMaxDynamicSharedMemorySize, LDS_BYTES);
        (void)hipOccupancyMaxActiveBlocksPerMultiprocessor(&per, (const void*)fwd_megakernel, 512, LDS_BYTES);
        if (per < 1) per = 1;
        grid = cus * per; fprintf(stderr, "kernel_launch: grid %d (cus %d x %d)\n", grid, cus, per);
    }
    if (grid < 0) return;
    if (hipMemsetAsync((char*)d_ws + WS_BAR, 0, BAR_BYTES, stream) != hipSuccess) { fprintf(stderr, "kernel_launch: memset failed\n"); return; }
    Params p{};
    const float** f = (const float**)&p;
    for (int i = 0; i < 21; ++i) f[i] = (const float*)d_in[i];
    p.out = (float*)d_out; p.ws = (unsigned char*)d_ws;
    void* args[] = {&p};
    hipError_t e = hipLaunchCooperativeKernel((const void*)fwd_megakernel, dim3(grid), dim3(512), args, LDS_BYTES, stream);
    if (e != hipSuccess) fprintf(stderr, "cooperative launch failed: %s (grid %d)\n", hipGetErrorString(e), grid);
}
```
